# Optimizing an MI355X kernel written in HIP

```python
import math
import jax
import jax.numpy as jnp
from jax import lax
import numpy as np

D_MODEL = 1024
BATCH = 32
SEQ = 2048
DEPTH = 2

D_MIX = D_MODEL
D_GROUP = D_MIX // 4

HY_PROJ = 3 * D_GROUP
HY_SHORT = 3
HY_POS_DIM = 33
HY_FILT_HIDDEN = 64
HY_FAST_DECAY_PCT = 0.3
HY_SLOW_DECAY_PCT = 1.5
HY_DECAY_TARGET = 1e-2

M_HEADS = 4
M_HEADDIM = D_GROUP // M_HEADS
M_STATE = 64
M_GROUPS = 2
M_CONV = 5
M_CHUNK = 128
M_XBC = D_GROUP + 2 * M_GROUPS * M_STATE
M_PROJ = D_GROUP + M_XBC + 2 * M_HEADS

A_HEADS = 4
A_HEADDIM = D_GROUP // A_HEADS
A_PATTERNS = ((128, 1), (512, 4), (2048, 16))
A_PROJ = 3 * D_GROUP
N_BUCKETS = 32
MAX_DISTANCE = 1024

H_HEADS = 4
H_EXPAND = D_GROUP // H_HEADS
H_HEADDIM = D_GROUP // H_HEADS
H_CHUNK = 32
H_PROJ = 5 * D_GROUP

N_IN = HY_PROJ + M_PROJ + A_PROJ + H_PROJ

N_EXPERTS = 16
EC_CAPACITY = 2
D_FF_EXPERT = 1024

EPS = 1e-6
F32 = jnp.float32

kernel_name = "hybrid_parallel_heads_encoder"


def rmsnorm(x, w):
    xf = x.astype(F32)
    r = lax.rsqrt(jnp.mean(xf * xf, axis=-1, keepdims=True) + EPS)
    return (xf * r).astype(x.dtype) * w


def centered_dwconv(u, w):
    k = w.shape[0]
    c = u.shape[-1]
    return lax.conv_general_dilated(
        u, w[:, None, :].astype(u.dtype), window_strides=(1,),
        padding=((k // 2, k // 2),), dimension_numbers=("NWC", "WIO", "NWC"),
        feature_group_count=c)


def hyena_filters(L, w1, b1, w2, b2, freq, w3):
    t = jnp.linspace(0.0, 1.0, L, dtype=F32)[:, None]
    bands = (HY_POS_DIM - 1) // 2
    ang_pos = 2.0 * math.pi * jnp.arange(L, dtype=F32) / L
    f = jnp.linspace(1e-4, bands - 1, bands, dtype=F32)
    ang = ang_pos[:, None] * f[None, :]
    z = jnp.concatenate([t, jnp.cos(ang), -jnp.sin(ang)], axis=-1)
    freq = freq.astype(F32)
    h = jnp.sin(freq * (z @ w1.astype(F32) + b1.astype(F32)))
    h = jnp.sin(freq * (h @ w2.astype(F32) + b2.astype(F32)))
    h = h @ w3.astype(F32)
    max_decay = math.log(HY_DECAY_TARGET) / HY_FAST_DECAY_PCT
    min_decay = math.log(HY_DECAY_TARGET) / HY_SLOW_DECAY_PCT
    deltas = jnp.abs(jnp.linspace(min_decay, max_decay, D_GROUP, dtype=F32))
    decay = jnp.exp(-t * deltas[None, :])
    h = h.reshape(L, 2, D_GROUP) * decay[:, None, :]
    return h[:, 0], h[:, 1]


def bidir_fftconv(u, h_fwd, h_bwd, bias):
    L = u.shape[1]
    k = jnp.concatenate([h_fwd, jnp.zeros_like(h_fwd[:1]), h_bwd[:0:-1]], axis=0)
    kf = jnp.fft.rfft(k, n=2 * L, axis=0)
    uf = jnp.fft.rfft(u, n=2 * L, axis=1)
    y = jnp.fft.irfft(uf * kf[None], n=2 * L, axis=1)[:, :L]
    return y + u * bias.astype(F32)


def hyena_mixer(p, conv_w, w1, b1, w2, b2, freq, w3, fbias):
    L = p.shape[1]
    u = centered_dwconv(p, conv_w).astype(F32)
    x0, x1, v = jnp.split(u, 3, axis=-1)
    hf, hb = hyena_filters(L, w1, b1, w2, b2, freq, w3)
    y = x0 * bidir_fftconv(v * x1, hf, hb, fbias)
    return y.astype(p.dtype)


def ssd_chunked(x, dt, A, Bm, Cm):
    b, L, h, pd = x.shape
    n = Bm.shape[-1]
    nc = L // M_CHUNK
    xd = (x * dt[..., None]).reshape(b, nc, M_CHUNK, h, pd)
    Bc = Bm.reshape(b, nc, M_CHUNK, h, n)
    Cc = Cm.reshape(b, nc, M_CHUNK, h, n)
    a_cum = jnp.cumsum((dt * A).reshape(b, nc, M_CHUNK, h), axis=2)
    seg = a_cum[:, :, :, None, :] - a_cum[:, :, None, :, :]
    causal = jnp.tril(jnp.ones((M_CHUNK, M_CHUNK), bool))[None, None, :, :, None]
    Lmat = jnp.exp(jnp.where(causal, seg, -jnp.inf))
    cb = jnp.einsum("bclhn,bcshn->bclsh", Cc, Bc) * Lmat
    y_diag = jnp.einsum("bclsh,bcshp->bclhp", cb, xd)
    decay_to_end = jnp.exp(a_cum[:, :, -1:, :] - a_cum)
    chunk_states = jnp.einsum("bclhn,bclhp->bchpn", Bc, xd * decay_to_end[..., None])
    chunk_decay = jnp.exp(a_cum[:, :, -1, :])

    def step(S, inp):
        st, dec = inp
        return S * dec[..., None, None] + st, S

    S0 = jnp.zeros((b, h, pd, n), F32)
    _, prev = lax.scan(step, S0, (jnp.moveaxis(chunk_states, 1, 0), jnp.moveaxis(chunk_decay, 1, 0)))
    prev = jnp.moveaxis(prev, 0, 1)
    y_off = jnp.einsum("bclhn,bchpn->bclhp", Cc * jnp.exp(a_cum)[..., None], prev)
    return (y_diag + y_off).reshape(b, L, h, pd)


def mamba2_mixer(p, conv_w, conv_b, dt_bias, A_log, Dskip, norm_w):
    b, L, _ = p.shape
    z, xbc, dt_raw = jnp.split(p, [D_GROUP, D_GROUP + M_XBC], axis=-1)
    xbc = jax.nn.silu(centered_dwconv(xbc, conv_w) + conv_b).astype(F32)
    xs, Bm, Cm = jnp.split(xbc, [D_GROUP, D_GROUP + M_GROUPS * M_STATE], axis=-1)
    xs = xs.reshape(b, L, M_HEADS, M_HEADDIM)
    rep = M_HEADS // M_GROUPS
    Bm = jnp.repeat(Bm.reshape(b, L, M_GROUPS, M_STATE), rep, axis=2)
    Cm = jnp.repeat(Cm.reshape(b, L, M_GROUPS, M_STATE), rep, axis=2)
    dt = jax.nn.softplus(dt_raw.astype(F32).reshape(b, L, 2, M_HEADS) + dt_bias.astype(F32))
    A = -jnp.exp(A_log.astype(F32))
    fl = lambda t: jnp.flip(t, axis=1)
    y_f = ssd_chunked(xs, dt[:, :, 0], A[0], Bm, Cm)
    y_b = fl(ssd_chunked(fl(xs), fl(dt[:, :, 1]), A[1], fl(Bm), fl(Cm)))
    y = y_f + y_b + xs * Dskip.astype(F32)[:, None]
    y = y.reshape(b, L, D_GROUP) * jax.nn.silu(z.astype(F32))
    return rmsnorm(y, norm_w.astype(F32)).astype(p.dtype)


def t5_bucket(rel):
    nb = N_BUCKETS // 2
    max_exact = nb // 2
    ret = (rel > 0).astype(jnp.int32) * nb
    n = jnp.abs(rel)
    nf = jnp.maximum(n, 1).astype(F32)
    large = max_exact + (jnp.log(nf / max_exact) / math.log(MAX_DISTANCE / max_exact)
                         * (nb - max_exact)).astype(jnp.int32)
    large = jnp.minimum(large, nb - 1)
    return ret + jnp.where(n < max_exact, n, large)


def band_attention_parts(q, k, v, rel_bias, dil, band):
    b, h, L, dh = q.shape
    n = L // dil
    nb = -(-n // band)
    npad = nb * band

    def to_sub(t):
        t = t.reshape(b, h, n, dil, dh).transpose(0, 1, 3, 2, 4)
        return jnp.pad(t, ((0, 0), (0, 0), (0, 0), (0, npad - n), (0, 0)))

    def kv_band(t):
        tp = jnp.pad(to_sub(t), ((0, 0), (0, 0), (0, 0), (band, band), (0, 0)))
        tp = tp.reshape(b, h, dil, nb + 2, band, dh)
        return jnp.concatenate([tp[:, :, :, :-2], tp[:, :, :, 1:-1], tp[:, :, :, 2:]], axis=4)

    qs = to_sub(q).reshape(b, h, dil, nb, band, dh)
    kb = kv_band(k)
    vb = kv_band(v)
    rel = jnp.arange(3 * band)[None, :] - band - jnp.arange(band)[:, None]
    bias = jnp.transpose(rel_bias.astype(F32)[t5_bucket(rel * dil)], (2, 0, 1))
    kidx = jnp.arange(nb)[:, None, None] * band + band + rel[None] - band + jnp.arange(band)[None, :, None]
    valid = (jnp.abs(rel)[None] <= band) & (kidx >= 0) & (kidx < n)
    logits = jnp.einsum("bhrnqd,bhrnkd->bhrnqk", qs, kb) + bias[None, :, None, None]
    logits = jnp.where(valid, logits, -jnp.inf)
    m = jnp.max(logits, axis=-1)
    m = jnp.where(jnp.isfinite(m), m, 0.0)
    pr = jnp.exp(logits - m[..., None])
    den = jnp.sum(pr, axis=-1)
    num = jnp.einsum("bhrnqk,bhrnkd->bhrnqd", pr, vb)

    def from_sub(t):
        t = t.reshape(b, h, dil, npad, *t.shape[5:])[:, :, :, :n]
        return jnp.moveaxis(t, 2, 3).reshape(b, h, L, *t.shape[4:])

    return from_sub(num), from_sub(den), from_sub(m)


def dilated_attention_mixer(p, rel_bias):
    b, L, _ = p.shape
    q, k, v = jnp.split(p.astype(F32), 3, axis=-1)
    heads = lambda t: t.reshape(b, L, A_HEADS, A_HEADDIM).transpose(0, 2, 1, 3)
    q, k, v = heads(q) * (A_HEADDIM ** -0.5), heads(k), heads(v)
    parts = [band_attention_parts(q, k, v, rel_bias, d, w // (2 * d)) for (w, d) in A_PATTERNS]
    m_all = jnp.max(jnp.stack([pt[2] for pt in parts]), axis=0)
    num = 0.0
    den = 0.0
    for n_i, d_i, m_i in parts:
        w_i = jnp.exp(m_i - m_all)
        num = num + w_i[..., None] * n_i
        den = den + w_i * d_i
    o = num / den[..., None]
    return o.transpose(0, 2, 1, 3).reshape(b, L, D_GROUP).astype(p.dtype)


def gla_chunked(q, k, v, g):
    b, L, h, e = q.shape
    pd = v.shape[-1]
    nc = L // H_CHUNK
    rs = lambda t: t.reshape(b, nc, H_CHUNK, h, t.shape[-1])
    q, k, v, g = rs(q), rs(k), rs(v), rs(g)
    gc = jnp.cumsum(g, axis=2)
    ref = gc[:, :, H_CHUNK // 2 - 1:H_CHUNK // 2]
    scores = jnp.einsum("bclhe,bcshe->bchls", q * jnp.exp(gc - ref), k * jnp.exp(ref - gc))
    mask = jnp.tril(jnp.ones((H_CHUNK, H_CHUNK), bool))
    scores = jnp.where(mask, scores, 0.0)
    o_intra = jnp.einsum("bchls,bcshp->bclhp", scores, v)
    g_last = gc[:, :, -1:]
    U = jnp.einsum("bclhe,bclhp->bchep", k * jnp.exp(g_last - gc), v)
    a = jnp.exp(g_last[:, :, 0])

    def step(S, inp):
        u_c, a_c = inp
        return a_c[..., None] * S + u_c, S

    S0 = jnp.zeros((b, h, e, pd), F32)
    _, prev = lax.scan(step, S0, (jnp.moveaxis(U, 1, 0), jnp.moveaxis(a, 1, 0)))
    prev = jnp.moveaxis(prev, 0, 1)
    o_inter = jnp.einsum("bclhe,bchep->bclhp", q * jnp.exp(gc), prev)
    return (o_intra + o_inter).reshape(b, L, h, pd)


def hgrn2_mixer(p, lb, norm_w):
    b, L, _ = p.shape
    q, f_fwd, f_bwd, i, g = jnp.split(p.astype(F32), 5, axis=-1)
    hs = lambda t, d: t.reshape(b, L, H_HEADS, d)
    q = hs(jax.nn.silu(q), H_EXPAND)
    i = hs(i, H_HEADDIM)
    lb = lb.reshape(2, H_HEADS, H_EXPAND)

    def gates(fpre, lbd):
        fpre = hs(fpre, H_EXPAND)
        f = lbd + (1.0 - lbd) * jax.nn.sigmoid(fpre)
        return jnp.log(f), (1.0 - lbd) * jax.nn.sigmoid(-fpre)

    gf, kf = gates(f_fwd, lb[0])
    gb, kb = gates(f_bwd, lb[1])
    fl = lambda t: jnp.flip(t, axis=1)
    o = gla_chunked(q, kf, i, gf) + fl(gla_chunked(fl(q), fl(kb), fl(i), fl(gb)))
    o = rmsnorm(o, norm_w.astype(F32)) * jax.nn.silu(hs(g, H_HEADDIM))
    return o.reshape(b, L, D_GROUP).astype(p.dtype)


def expert_choice_moe(x, w_router, w_gate, w_up, w_down):
    b, L, d = x.shape
    cap = EC_CAPACITY * L // N_EXPERTS
    aff = jax.nn.softmax((x @ w_router).astype(F32), axis=-1)
    gate, idx = lax.top_k(jnp.swapaxes(aff, 1, 2), cap)
    xe = jax.vmap(lambda xb, ib: xb[ib])(x, idx)
    hdn = jax.nn.silu(jnp.einsum("becd,edf->becf", xe, w_gate)) * jnp.einsum("becd,edf->becf", xe, w_up)
    ye = jnp.einsum("becf,efd->becd", hdn, w_down) * gate[..., None].astype(x.dtype)
    return jax.vmap(lambda ib, yb: jnp.zeros((L, d), yb.dtype).at[ib.reshape(-1)].add(yb.reshape(-1, d)))(idx, ye)


def setup_inputs(seed: int = 0) -> dict:
    key = jax.random.key(seed)
    ks = jax.random.split(key, 27)
    nrm = lambda k, shape, std: std * jax.random.normal(k, shape, F32)
    gain = lambda k, shape: 1.0 + 0.05 * jax.random.normal(k, shape, F32)
    dt0 = jnp.exp(jax.random.uniform(ks[15], (DEPTH, 2, M_HEADS), F32, math.log(1e-3), math.log(1e-1)))
    return {
        "x": jax.random.normal(ks[0], (BATCH, SEQ, D_MODEL), F32),
        "w_in": nrm(ks[1], (DEPTH, D_MODEL, N_IN), D_MODEL ** -0.5),
        "w_out": nrm(ks[2], (DEPTH, D_MIX, D_MODEL), D_MIX ** -0.5),
        "norm_mix_w": gain(ks[3], (DEPTH, D_MODEL)),
        "norm_ffn_w": gain(ks[4], (DEPTH, D_MODEL)),
        "hy_conv_w": nrm(ks[5], (DEPTH, HY_SHORT, HY_PROJ), HY_SHORT ** -0.5),
        "hy_pos_w1": nrm(ks[6], (DEPTH, HY_POS_DIM, HY_FILT_HIDDEN), HY_POS_DIM ** -0.5),
        "hy_pos_b1": nrm(ks[7], (DEPTH, HY_FILT_HIDDEN), 0.1),
        "hy_pos_w2": nrm(ks[8], (DEPTH, HY_FILT_HIDDEN, HY_FILT_HIDDEN), HY_FILT_HIDDEN ** -0.5),
        "hy_pos_b2": nrm(ks[9], (DEPTH, HY_FILT_HIDDEN), 0.1),
        "hy_sin_freq": gain(ks[10], (DEPTH, HY_FILT_HIDDEN)),
        "hy_pos_w3": nrm(ks[11], (DEPTH, HY_FILT_HIDDEN, 2 * D_GROUP), 0.1 * HY_FILT_HIDDEN ** -0.5),
        "hy_filt_bias": nrm(ks[12], (DEPTH, D_GROUP), 1.0),
        "m_conv_w": nrm(ks[13], (DEPTH, M_CONV, M_XBC), M_CONV ** -0.5),
        "m_conv_b": nrm(ks[14], (DEPTH, M_XBC), 0.02),
        "m_dt_bias": dt0 + jnp.log(-jnp.expm1(-dt0)),
        "m_A_log": jnp.log(jax.random.uniform(ks[16], (DEPTH, 2, M_HEADS), F32, 1.0, 16.0)),
        "m_D": gain(ks[17], (DEPTH, M_HEADS)),
        "m_norm_w": gain(ks[18], (DEPTH, D_GROUP)),
        "rel_bias": nrm(ks[19], (N_BUCKETS, A_HEADS), 0.5),
        "hg_lb": nrm(ks[20], (DEPTH, 2, D_GROUP), 1.0),
        "hg_norm_w": gain(ks[21], (DEPTH, H_HEADDIM)),
        "router_w": nrm(ks[22], (DEPTH, D_MODEL, N_EXPERTS), D_MODEL ** -0.5),
        "moe_w_gate": nrm(ks[23], (DEPTH, N_EXPERTS, D_MODEL, D_FF_EXPERT), D_MODEL ** -0.5),
        "moe_w_up": nrm(ks[24], (DEPTH, N_EXPERTS, D_MODEL, D_FF_EXPERT), D_MODEL ** -0.5),
        "moe_w_down": nrm(ks[25], (DEPTH, N_EXPERTS, D_FF_EXPERT, D_MODEL), D_FF_EXPERT ** -0.5),
        "final_norm_w": gain(ks[26], (D_MODEL,)),
    }


def reference(x, w_in, w_out, norm_mix_w, norm_ffn_w, hy_conv_w, hy_pos_w1, hy_pos_b1, hy_pos_w2,
              hy_pos_b2, hy_sin_freq, hy_pos_w3, hy_filt_bias, m_conv_w, m_conv_b, m_dt_bias, m_A_log,
              m_D, m_norm_w, rel_bias, hg_lb, hg_norm_w, router_w, moe_w_gate, moe_w_up, moe_w_down,
              final_norm_w):
    sm = jax.nn.softmax(hg_lb.astype(F32), axis=0)
    lower_bounds = jnp.cumsum(sm, axis=0) - sm[:1]
    splits = [HY_PROJ, HY_PROJ + M_PROJ, HY_PROJ + M_PROJ + A_PROJ]
    for l in range(DEPTH):
        hn = rmsnorm(x, norm_mix_w[l])
        proj = hn @ w_in[l]
        pa, pb, pc, pd = jnp.split(proj, splits, axis=-1)
        ya = hyena_mixer(pa, hy_conv_w[l], hy_pos_w1[l], hy_pos_b1[l], hy_pos_w2[l], hy_pos_b2[l],
                         hy_sin_freq[l], hy_pos_w3[l], hy_filt_bias[l])
        yb = mamba2_mixer(pb, m_conv_w[l], m_conv_b[l], m_dt_bias[l], m_A_log[l], m_D[l], m_norm_w[l])
        yc = dilated_attention_mixer(pc, rel_bias)
        yd = hgrn2_mixer(pd, lower_bounds[l], hg_norm_w[l])
        mix = jnp.concatenate([ya, yb, yc, yd], axis=-1).astype(x.dtype)
        x = x + mix @ w_out[l]
        x = x + expert_choice_moe(rmsnorm(x, norm_ffn_w[l]), router_w[l], moe_w_gate[l],
                                  moe_w_up[l], moe_w_down[l])
    return rmsnorm(x, final_norm_w)
```

```cpp
#define N_LAUNCH_MODE 21
#include <hip/hip_runtime.h>
#include <cstdio>
#include <cstdint>

#define LAS __attribute__((address_space(3)))
#define DI __device__ __forceinline__
typedef unsigned short bf16_t;
typedef short bf16x8 __attribute__((ext_vector_type(8)));
typedef short s16x4 __attribute__((ext_vector_type(4)));
typedef float f32x2 __attribute__((ext_vector_type(2)));
typedef float f32x4 __attribute__((ext_vector_type(4)));
typedef float f32x16 __attribute__((ext_vector_type(16)));
typedef unsigned u32x2 __attribute__((ext_vector_type(2)));
typedef unsigned u32x4 __attribute__((ext_vector_type(4)));
typedef int i32x4 __attribute__((ext_vector_type(4)));
typedef __bf16 bfv2 __attribute__((ext_vector_type(2)));

DI unsigned pk2(float lo, float hi) { f32x2 v = {lo, hi}; return __builtin_bit_cast(unsigned, __builtin_convertvector(v, bfv2)); }
DI unsigned short f2bf(float f) { return (unsigned short)(pk2(f, 0.f) & 0xffffu); }
DI float bf2f(unsigned short b) { return __uint_as_float((unsigned)b << 16); }
DI float bflo(unsigned u) { return __uint_as_float(u << 16); }
DI float bfhi(unsigned u) { return __uint_as_float(u & 0xffff0000u); }
DI float wave_sum(float v) {
#pragma unroll
    for (int o = 1; o < 64; o <<= 1) v += __shfl_xor(v, o);
    return v;
}
DI float silu_f(float x) { return x / (1.0f + __expf(-x)); }
DI float sigmoid_f(float x) { return 1.0f / (1.0f + __expf(-x)); }
DI int tid_opaque() { int t = threadIdx.x; asm volatile("" : "+v"(t)); return t; }
#define LDS_WAIT() asm volatile("s_waitcnt lgkmcnt(0)" ::: "memory")
#define VM_WAIT() asm volatile("s_waitcnt vmcnt(0)" ::: "memory")
#define MFMA32(a, b, c) __builtin_amdgcn_mfma_f32_32x32x16_bf16((a), (b), (c), 0, 0, 0)

constexpr int NB = 32, SEQ = 2048, DM = 1024, NTOK = NB * SEQ;
constexpr int NIN_REF = 3592, NPROJ = 3584;
constexpr int PC_HY = 0, PC_MZ = 768, PC_MX = 1024, PC_AQ = 1536, PC_AK = 1792, PC_AV = 2048, PC_HQ = 2304, PC_HF = 2560, PC_HI = 3072, PC_HG = 3328;
constexpr int NEXP = 16, CAP = 256, NSLOT = NB * NEXP * CAP;
constexpr float EPSN = 1e-6f;

constexpr size_t MiB = 1u << 20;
constexpr size_t WS_CTL = 0, CTL_ZERO_BYTES = 64 * 1024;
constexpr size_t WS_DT = 1 * MiB, WS_AFF = 3 * MiB, WS_SLOT = 7 * MiB, WS_SELI = 11 * MiB, WS_SELG = 11 * MiB + 512 * 1024, WS_KFILT = 12 * MiB, WS_MSQ = 14 * MiB;
constexpr size_t WS_XB = 64 * MiB, WS_WIN = 320 * MiB, WS_WOUT = 327 * MiB, WS_WGU = 329 * MiB, WS_WD = 393 * MiB, WS_HN = 432 * MiB, WS_PROJ = 560 * MiB, WS_YE = WS_PROJ, WS_END = 1008 * MiB;
constexpr size_t DO_HW = 0, DO_HX0 = 32 * MiB, DO_YAT = 64 * MiB, DO_MXBC = 96 * MiB, DO_MY = 160 * MiB, DO_MST = 192 * MiB, DO_HST = 224 * MiB, DO_HDN = 0;
constexpr int CW_BAR = 1024;

constexpr int LDS_MISC = 147456, LDS_BYTES = LDS_MISC + 256;

struct Params {
    const float *x, *w_in, *w_out, *norm_mix_w, *norm_ffn_w, *hy_conv_w, *hy_w1, *hy_b1, *hy_w2, *hy_b2, *hy_freq, *hy_w3, *hy_fbias,
                *m_conv_w, *m_conv_b, *m_dt_bias, *m_A_log, *m_D, *m_norm_w, *rel_bias, *hg_lb, *hg_norm_w, *router_w, *moe_wg, *moe_wu, *moe_wd, *final_w;
    float* out; unsigned char* ws;
    int ph_lo, ph_hi;
};

#define XB_TMO      128
#define XB_XCNT(j)  (256  + 64 * (j))
#define XB_XSUB(j)  (1280 + 64 * (j))
#define XB_XGEN(j)  (2304 + 64 * (j))
#define XB_TOP      3328
#define XB_TOPGEN   3392
#define XCD_BAR_WORDS 3456
#define XB_SPIN_CAP (1u << 18)
__device__ __forceinline__ unsigned xb_ld(unsigned* p)              { return __hip_atomic_load(p, __ATOMIC_RELAXED, __HIP_MEMORY_SCOPE_AGENT); }
__device__ __forceinline__ unsigned xb_add(unsigned* p, unsigned v) { return __hip_atomic_fetch_add(p, v, __ATOMIC_RELAXED, __HIP_MEMORY_SCOPE_AGENT); }
__device__ __forceinline__ unsigned xb_xcc_id() { return (unsigned)__builtin_amdgcn_s_getreg((3 << 11) | 20) & 0xFu; }
#define XB_SPIN(cond, bar) do { unsigned _sp = 0; while (cond) { __builtin_amdgcn_s_sleep(1); \
    if ((++_sp & 255u) == 0u) { if (xb_ld(&(bar)[XB_TMO])) break; if (_sp > XB_SPIN_CAP) { atomicAdd(&(bar)[XB_TMO], 1u); break; } } } } while (0)
struct XcdBarrier { unsigned* bar; unsigned x; volatile LAS unsigned* st; };
__device__ __forceinline__ XcdBarrier xcd_barrier_post(unsigned* bar, volatile LAS unsigned* st) {
    XcdBarrier b; b.bar = bar; b.x = xb_xcc_id(); b.st = st;
    if (threadIdx.x == 0) (void)xb_add(&bar[XB_XCNT(b.x)], 1u);
    return b;
}
__device__ __forceinline__ void xcd_barrier_complete(unsigned* bar, unsigned x, unsigned& nloc, unsigned& nx) {
    const unsigned G = gridDim.x * gridDim.y * gridDim.z;
    unsigned sum, cnt, mine, sp = 0u;
    for (;;) {
        sum = 0u; cnt = 0u; mine = 0u;
#pragma unroll
        for (unsigned j = 0; j < 16; ++j) { const unsigned c = xb_ld(&bar[XB_XCNT(j)]); sum += c; cnt += (c > 0u) ? 1u : 0u; mine = (j == x) ? c : mine; }
        if (sum == G) break;
        __builtin_amdgcn_s_sleep(1);
        if ((++sp & 255u) == 0u) { if (xb_ld(&bar[XB_TMO])) break; if (sp > XB_SPIN_CAP) { atomicAdd(&bar[XB_TMO], 1u); break; } }
    }
    nloc = mine > 0u ? mine : 1u; nx = cnt > 0u ? cnt : 1u;
}
__device__ __forceinline__ void xcd_barrier(const XcdBarrier& b) {
    asm volatile("s_waitcnt vmcnt(0)" ::: "memory");
    __syncthreads();
    if (threadIdx.x == 0) {
        unsigned* bar = b.bar;
        __builtin_amdgcn_s_waitcnt(0);
        unsigned nloc = b.st[0], nx = b.st[1];
        if (nloc == 0u) { xcd_barrier_complete(bar, b.x, nloc, nx); b.st[0] = nloc; b.st[1] = nx; }
        const unsigned old = xb_add(&bar[XB_XSUB(b.x)], 1u);
        const unsigned gen = old / nloc;
        if (old + 1u == (gen + 1u) * nloc) {
            __builtin_amdgcn_fence(__ATOMIC_RELEASE, "agent");
            asm volatile("s_waitcnt vmcnt(0)" ::: "memory");
            const unsigned og = xb_add(&bar[XB_TOP], 1u);
            const unsigned tg = og / nx;
            if (og + 1u == (tg + 1u) * nx) xb_add(&bar[XB_TOPGEN], 1u);
            else XB_SPIN(xb_ld(&bar[XB_TOPGEN]) == tg, bar);
            __builtin_amdgcn_fence(__ATOMIC_ACQUIRE, "agent");
            xb_add(&bar[XB_XGEN(b.x)], 1u);
            asm volatile("s_waitcnt vmcnt(0)" ::: "memory");
        } else {
            XB_SPIN(xb_ld(&bar[XB_XGEN(b.x)]) == gen, bar);
            __builtin_amdgcn_fence(__ATOMIC_ACQUIRE, "agent");
            asm volatile("s_waitcnt vmcnt(0)" ::: "memory");
        }
    }
    __syncthreads();
}

namespace pg8 {
constexpr int BM = 256, BK = 64, HALF = 128, HTB = HALF * BK * 2, STAGE_BYTES = 8 * HTB, NXCD = 8, WGM = 8;
__host__ __device__ __forceinline__ int lds_byte(int r, int c) { const int st = (r >> 4) * 2 + (c >> 5), rr = r & 15, cc = c & 31, ob = rr * 64 + cc * 2; return st * 1024 + (ob ^ (((ob >> 9) & 1) << 5)); }
__host__ __device__ __forceinline__ void stage_rc(int b, int& R, int& C) { const int st = b / 1024, sb = b % 1024, swz = sb ^ (((sb >> 9) & 1) << 5); R = (st >> 1) * 16 + swz / 64; C = (st & 1) * 32 + (swz % 64) / 2; }
__host__ __device__ __forceinline__ int perm32(int rho) { const int n = rho >> 4, i = rho & 15; return 8 * (i >> 2) + 4 * n + (i & 3); }
struct Unit { int pm, pn; };
struct StaticOrder {
    int nM, nN, nwg, G, c;
    __device__ void init(int nM_, int nN_, int G_, int c_) { nM = nM_; nN = nN_; nwg = nM * nN; G = G_; c = c_; }
    __device__ bool next(int i, Unit& u) const {
        const long L = (long)i * G + c; if (L >= nwg) return false;
        int wgid = (int)L; { const int q = nwg / NXCD, r = nwg % NXCD, xcd = wgid % NXCD, off = wgid / NXCD; wgid = (xcd < r ? xcd * (q + 1) : r * (q + 1) + (xcd - r) * q) + off; }
        const int nig = WGM * nN, gid = wgid / nig, fm = gid * WGM, gsz = (nM - fm) < WGM ? (nM - fm) : WGM;
        u.pm = fm + ((wgid % nig) % gsz); u.pn = (wgid % nig) / gsz; return true;
    }
};
template <class Epi, class Sched, class Addr>
__device__ __forceinline__ void gemm_phase(LAS unsigned char* lds, const char* Abase, const char* Bbase, int K, const Sched& S, const Addr& AD, const Epi& E) {
    const int tid = tid_opaque(), wid = __builtin_amdgcn_readfirstlane(tid >> 6), lane = tid & 63, wr = wid >> 2, wc = wid & 3, fr = lane & 15, fq = lane >> 4;
    const int nt = K / BK;
    int Rr[2]; unsigned Cc[2], voffB[2], voffA[2];
#pragma unroll
    for (int i = 0; i < 2; ++i) { int R, C; stage_rc(tid * 16 + i * 8192, R, C); const int Rb = Epi::PERM ? ((R & ~31) + perm32(R & 31)) : R;
        Rr[i] = R; Cc[i] = (unsigned)C * 2u; voffA[i] = (unsigned)(R * K + C) * 2u; voffB[i] = (unsigned)(Rb * K + C) * 2u; }
    const size_t kstep = (size_t)(BK * 2);
    const size_t hstep = (size_t)HALF * K * 2;
    const unsigned ldsw = (unsigned)wid * 1024u;
    const int aoff = lds_byte(wr * 64 + fr, fq * 8), boff = lds_byte(wc * 32 + fr, fq * 8);
#define PG8_SA(b, h) (((b) * 2 + (h)) * HTB)
#define PG8_SB(b, h) ((4 + (b) * 2 + (h)) * HTB)
#define PG8_STAGE(bufoff, gbase, voff) do { _Pragma("unroll") for (int _i = 0; _i < 2; ++_i) \
        __builtin_amdgcn_global_load_lds((const unsigned*)((const char*)(gbase) + (voff)[_i]), (LAS unsigned*)(lds + (bufoff) + ldsw + _i * 8192), 16, 0, 0); } while (0)
#define PG8_STAGE_A(bufoff, kb, h, un) do { if constexpr (Addr::LOADS) { _Pragma("unroll") for (int _i = 0; _i < 2; ++_i) \
        __builtin_amdgcn_global_load_lds((const unsigned*)(Abase + (kb) + ((un) ? on[h][_i] : oc[h][_i])), (LAS unsigned*)(lds + (bufoff) + ldsw + _i * 8192), 16, 0, 0); } \
      else { const char* _ab = ((un) ? nA : cA) + (kb) + (size_t)(h) * hstep; _Pragma("unroll") for (int _i = 0; _i < 2; ++_i) \
        __builtin_amdgcn_global_load_lds((const unsigned*)(_ab + voffA[_i]), (LAS unsigned*)(lds + (bufoff) + ldsw + _i * 8192), 16, 0, 0); } } while (0)
#define PG8_LDA(dst, b, h) do { _Pragma("unroll") for (int m = 0; m < 4; ++m) _Pragma("unroll") for (int k = 0; k < 2; ++k) dst[m][k] = *(const LAS bf16x8*)(lds + PG8_SA(b, h) + aoff + m * 2048 + k * 1024); } while (0)
#define PG8_LDB(dst, b, h) do { _Pragma("unroll") for (int n = 0; n < 2; ++n) _Pragma("unroll") for (int k = 0; k < 2; ++k) dst[n][k] = *(const LAS bf16x8*)(lds + PG8_SB(b, h) + boff + n * 2048 + k * 1024); } while (0)
#define PG8_MMA(ai, bj, At, Bt) do { __builtin_amdgcn_s_setprio(1); _Pragma("unroll") for (int m = 0; m < 4; ++m) _Pragma("unroll") for (int n = 0; n < 2; ++n) _Pragma("unroll") for (int k = 0; k < 2; ++k) \
        acc[ai][bj][m][n] = __builtin_amdgcn_mfma_f32_16x16x32_bf16(Bt[n][k], At[m][k], acc[ai][bj][m][n], 0, 0, 0); __builtin_amdgcn_s_setprio(0); } while (0)
#define PG8_WAIT_V(n) asm volatile("s_waitcnt vmcnt(" #n ")" ::: "memory")
#define PG8_WAIT_L(n) asm volatile("s_waitcnt lgkmcnt(" #n ")" ::: "memory")
#define PG8_BAR __builtin_amdgcn_s_barrier()
#define PG8_SCHED __builtin_amdgcn_sched_barrier(0)
    Unit cur, nxt; int ui = 0;
    if (!S.next(0, cur)) return;
    f32x4 acc[2][2][4][2];
#pragma unroll
    for (int a = 0; a < 2; ++a)
#pragma unroll
        for (int b = 0; b < 2; ++b)
#pragma unroll
            for (int m = 0; m < 4; ++m)
#pragma unroll
                for (int n = 0; n < 2; ++n) acc[a][b][m][n] = (f32x4){0.f, 0.f, 0.f, 0.f};
    bf16x8 At[4][2], B0[2][2], B1[2][2];
    unsigned oc[2][2], on[2][2];
    const char* cA = Abase; const char* nA = Abase;
    if constexpr (Addr::LOADS) {
#pragma unroll
        for (int h = 0; h < 2; ++h)
#pragma unroll
            for (int i = 0; i < 2; ++i) { oc[h][i] = AD.arow(cur, h * HALF + Rr[i]) + Cc[i]; on[h][i] = oc[h][i]; }
        PG8_WAIT_V(0);
    } else { cA = Abase + AD.arow(cur, 0); nA = cA; }
    const char* cB = Bbase + AD.boff(cur);
    PG8_STAGE(PG8_SB(0, 0), cB, voffB); PG8_STAGE_A(PG8_SA(0, 0), 0, 0, false); PG8_STAGE(PG8_SB(0, 1), cB + hstep, voffB); PG8_STAGE_A(PG8_SA(0, 1), 0, 1, false);
    if (wr == 1) PG8_BAR;
    PG8_WAIT_V(4); PG8_BAR;
    PG8_STAGE(PG8_SB(1, 0), cB + kstep, voffB); PG8_STAGE_A(PG8_SA(1, 0), kstep, 0, false); PG8_STAGE(PG8_SB(1, 1), cB + hstep + kstep, voffB);
    PG8_WAIT_V(6); PG8_BAR;
    for (;;) {
        const bool has_next = S.next(ui + 1, nxt);
        if (has_next) {
            if constexpr (Addr::LOADS) {
#pragma unroll
                for (int h = 0; h < 2; ++h)
#pragma unroll
                    for (int i = 0; i < 2; ++i) on[h][i] = AD.arow(nxt, h * HALF + Rr[i]) + Cc[i];
                PG8_WAIT_V(0);
            } else nA = Abase + AD.arow(nxt, 0);
        } else nA = cA;
        const char* nB = has_next ? Bbase + AD.boff(nxt) : cB;
        for (int t = 0; t < nt; t += 2) {
            const bool last = (t == nt - 2);
            const bool un = last && has_next;
            const size_t k1 = (size_t)(t + 1) * kstep;
            const size_t k2 = last ? 0 : (size_t)(t + 2) * kstep, k3 = k2 + kstep;
            const char* b2 = last ? nB : cB + (size_t)(t + 2) * kstep;
            const char* b3 = b2 + kstep;
            PG8_LDB(B0, 0, 0); PG8_SCHED; PG8_LDA(At, 0, 0); PG8_STAGE_A(PG8_SA(1, 1), k1, 1, false);
            PG8_WAIT_L(8); PG8_BAR; PG8_WAIT_L(0); PG8_MMA(0, 0, At, B0); PG8_BAR; PG8_SCHED;
            PG8_LDB(B1, 0, 1); PG8_STAGE(PG8_SB(0, 0), b2, voffB);
            PG8_BAR; PG8_WAIT_L(0); PG8_MMA(0, 1, At, B1); PG8_BAR;
            PG8_LDA(At, 0, 1); PG8_STAGE_A(PG8_SA(0, 0), k2, 0, un);
            PG8_BAR; PG8_WAIT_L(0); PG8_MMA(1, 0, At, B0); PG8_BAR; PG8_SCHED;
            PG8_STAGE(PG8_SB(0, 1), b2 + hstep, voffB);
            PG8_WAIT_V(6); PG8_BAR; PG8_MMA(1, 1, At, B1); PG8_BAR;
            PG8_LDB(B0, 1, 0); PG8_SCHED; PG8_LDA(At, 1, 0); PG8_STAGE_A(PG8_SA(0, 1), k2, 1, un);
            PG8_WAIT_L(8); PG8_BAR; PG8_WAIT_L(0); PG8_MMA(0, 0, At, B0); PG8_BAR; PG8_SCHED;
            PG8_LDB(B1, 1, 1); PG8_STAGE(PG8_SB(1, 0), b3, voffB);
            PG8_BAR; PG8_WAIT_L(0); PG8_MMA(0, 1, At, B1); PG8_BAR;
            PG8_LDA(At, 1, 1); PG8_STAGE_A(PG8_SA(1, 0), k3, 0, un);
            PG8_BAR; PG8_WAIT_L(0); PG8_MMA(1, 0, At, B0); PG8_BAR; PG8_SCHED;
            PG8_STAGE(PG8_SB(1, 1), b3 + hstep, voffB);
            PG8_WAIT_V(6); PG8_BAR; PG8_MMA(1, 1, At, B1); PG8_BAR;
        }
        E(acc, cur, wr, wc, fr, fq);
        if (!has_next) break;
#pragma unroll
        for (int a = 0; a < 2; ++a)
#pragma unroll
            for (int b = 0; b < 2; ++b)
#pragma unroll
                for (int m = 0; m < 4; ++m)
#pragma unroll
                    for (int n = 0; n < 2; ++n) acc[a][b][m][n] = (f32x4){0.f, 0.f, 0.f, 0.f};
        cur = nxt; cB = nB; cA = nA; ++ui;
        if constexpr (Addr::LOADS) {
#pragma unroll
            for (int h = 0; h < 2; ++h)
#pragma unroll
                for (int i = 0; i < 2; ++i) oc[h][i] = on[h][i]; }
    }
    PG8_WAIT_V(0);
    if (wr == 0) PG8_BAR;
    PG8_BAR;
#undef PG8_SA
#undef PG8_SB
#undef PG8_STAGE
#undef PG8_STAGE_A
#undef PG8_LDA
#undef PG8_LDB
#undef PG8_MMA
#undef PG8_WAIT_V
#undef PG8_WAIT_L
#undef PG8_BAR
#undef PG8_SCHED
}
}

#ifndef EN_HY
#define EN_HY 1
#endif
#ifndef EN_MA
#define EN_MA 1
#endif
#ifndef EN_AT
#define EN_AT 1
#endif
#ifndef EN_HG
#define EN_HG 1
#endif
#ifndef EN_MOE
#define EN_MOE 1
#endif

DI void transpose_item(const float* W, int ld, int k0, int n0, bf16_t* dst, int drow0, float scale, LAS float* scr, int lane) {
#pragma unroll 8
    for (int i = 0; i < 32; ++i) { const int kk = 2 * i + (lane >> 5); scr[kk * 33 + (lane & 31)] = W[(size_t)(k0 + kk) * ld + n0 + (lane & 31)]; }
    LDS_WAIT();
    const int c = lane & 7;
#pragma unroll
    for (int j = 0; j < 4; ++j) { const int n = (lane >> 3) + 8 * j; const LAS float* s = scr + (8 * c) * 33 + n;
        u32x4 o; o.x = pk2(s[0 * 33] * scale, s[1 * 33] * scale); o.y = pk2(s[2 * 33] * scale, s[3 * 33] * scale); o.z = pk2(s[4 * 33] * scale, s[5 * 33] * scale); o.w = pk2(s[6 * 33] * scale, s[7 * 33] * scale);
        *(u32x4*)(dst + (size_t)(drow0 + n) * 1024 + k0 + 8 * c) = o; }
    LDS_WAIT();
}

DI void hyena_filter_pos(const Params& P, int l, int pos, int lane, bf16_t* kfilt) {
    const float TWO_PI = 6.283185307179586f;
    const float tpos = (float)pos * (1.0f / 2047.0f);
    float z = 0.f;
    if (lane == 0) z = tpos;
    else if (lane <= 32) { const int bnd = (lane - 1) & 15; const float f = 1e-4f + (float)bnd * ((15.0f - 1e-4f) / 15.0f);
        const float angp = TWO_PI * (float)pos / 2048.0f; const float ang = angp * f; z = (lane <= 16) ? cosf(ang) : -sinf(ang); }
    const float* w1 = P.hy_w1 + (size_t)l * 33 * 64; const float* w2 = P.hy_w2 + (size_t)l * 64 * 64; const float* w3 = P.hy_w3 + (size_t)l * 64 * 512;
    const float fr = P.hy_freq[l * 64 + lane];
    float a = P.hy_b1[l * 64 + lane];
    for (int i = 0; i < 33; ++i) a += __shfl(z, i) * w1[i * 64 + lane];
    const float h1 = sinf(fr * a);
    float a2 = P.hy_b2[l * 64 + lane];
    for (int i = 0; i < 64; ++i) a2 += __shfl(h1, i) * w2[i * 64 + lane];
    const float h2 = sinf(fr * a2);
    float h3[8];
#pragma unroll
    for (int k = 0; k < 8; ++k) h3[k] = 0.f;
    for (int i = 0; i < 64; ++i) { const float hv = __shfl(h2, i);
#pragma unroll
        for (int k = 0; k < 8; ++k) h3[k] += hv * w3[i * 512 + k * 64 + lane]; }
    const float min_decay = -3.0701134573253944f, max_decay = -15.350567286626972f;
#pragma unroll
    for (int k = 0; k < 8; ++k) { const int cp = k * 64 + lane, c = cp & 255;
        const float delta = fabsf(min_decay + (float)c * ((max_decay - min_decay) / 255.0f));
        float v = h3[k] * expf(-tpos * delta);
        if (cp < 256) { if (pos == 0) { v += P.hy_fbias[l * 256 + c]; kfilt[(size_t)c * 4096 + 4095] = 0; } kfilt[(size_t)c * 4096 + 2047 - pos] = f2bf(v); }
        else if (pos >= 1) kfilt[(size_t)c * 4096 + 2047 + pos] = f2bf(v); }
}

template <bool FINAL>
DI void pre_row(const Params& P, int l, int m, int lane, const LAS f32x4* dtw, const float* nw) {
    unsigned char* ws = P.ws;
    float* XB = (float*)(ws + WS_XB);
    const bool first = (!FINAL && l == 0);
    const float* src = first ? P.x : XB;
    const f32x4* xr = (const f32x4*)(src + (size_t)m * DM) + lane;
    f32x4 v[4];
#pragma unroll
    for (int j = 0; j < 4; ++j) v[j] = xr[64 * j];
    if (!first && EN_MOE) {
        const int* slot = (const int*)(ws + WS_SLOT) + (size_t)m * 16; const int b = m >> 11;
        const bf16_t* YE = (const bf16_t*)(ws + WS_YE);
        for (int e = 0; e < 16; ++e) { const int s = __builtin_amdgcn_readfirstlane(slot[e]);
            if (s >= 0) { const u32x2* yr = (const u32x2*)(YE + ((size_t)((b * 16 + e) * 256 + s)) * DM) + lane;
#pragma unroll
                for (int j = 0; j < 4; ++j) { const u32x2 y = yr[64 * j]; v[j].x += bflo(y.x); v[j].y += bfhi(y.x); v[j].z += bflo(y.y); v[j].w += bfhi(y.y); } } }
    }
    float s = 0.f;
#pragma unroll
    for (int j = 0; j < 4; ++j) s += (v[j].x * v[j].x + v[j].y * v[j].y) + (v[j].z * v[j].z + v[j].w * v[j].w);
    const float r = 1.0f / sqrtf(wave_sum(s) * (1.0f / DM) + EPSN);
    if (FINAL) {
        f32x4* o = (f32x4*)(P.out + (size_t)m * DM) + lane;
#pragma unroll
        for (int j = 0; j < 4; ++j) { const f32x4 w = ((const f32x4*)nw)[64 * j + lane]; o[64 * j] = v[j] * r * w; }
        return;
    }
    if (!first) { f32x4* o = (f32x4*)(XB + (size_t)m * DM) + lane;
#pragma unroll
        for (int j = 0; j < 4; ++j) o[64 * j] = v[j]; }
    float d[8];
#pragma unroll
    for (int c = 0; c < 8; ++c) d[c] = 0.f;
#pragma unroll
    for (int j = 0; j < 4; ++j) {
        const float xv[4] = {v[j].x, v[j].y, v[j].z, v[j].w};
#pragma unroll
        for (int q = 0; q < 4; ++q) { const f32x4 w0 = dtw[((j * 4 + q) * 2 + 0) * 64 + lane], w1 = dtw[((j * 4 + q) * 2 + 1) * 64 + lane];
            d[0] += xv[q] * w0.x; d[1] += xv[q] * w0.y; d[2] += xv[q] * w0.z; d[3] += xv[q] * w0.w; d[4] += xv[q] * w1.x; d[5] += xv[q] * w1.y; d[6] += xv[q] * w1.z; d[7] += xv[q] * w1.w; }
    }
    float mine = 0.f;
#pragma unroll
    for (int c = 0; c < 8; ++c) { const float t = wave_sum(d[c]); mine = (lane == c) ? t : mine; }
    if (lane < 8) ((float*)(ws + WS_DT))[(size_t)m * 8 + lane] = mine * r;
    u32x2* o8 = (u32x2*)((bf16_t*)(ws + WS_HN) + (size_t)m * DM) + lane;
#pragma unroll
    for (int j = 0; j < 4; ++j) { const f32x4 w = ((const f32x4*)nw)[64 * j + lane]; u32x2 o; o.x = pk2(v[j].x * r * w.x, v[j].y * r * w.y); o.y = pk2(v[j].z * r * w.z, v[j].w * r * w.w); o8[64 * j] = o; }
}

DI void phase_pre(const Params& P, int l, LAS unsigned char* lds) {
    const int tid = tid_opaque(), lane = tid & 63, wave = tid >> 6;
    const int gw = blockIdx.x * 8 + wave, NGW = gridDim.x * 8;
    unsigned char* ws = P.ws;
    LAS float* dtwf = (LAS float*)lds;
    for (int i = tid; i < 1024 * 8; i += 512) { const int k = i >> 3, c = i & 7; const int j = k >> 8, ln = (k & 255) >> 2, q = k & 3;
        dtwf[((((j * 4 + q) * 2 + (c >> 2)) * 64 + ln) << 2) + (c & 3)] = P.norm_mix_w[l * DM + k] * P.w_in[((size_t)l * DM + k) * NIN_REF + 1536 + c]; }
    __syncthreads();
    if (EN_HY) for (int pos = gw; pos < SEQ; pos += NGW) hyena_filter_pos(P, l, pos, lane, (bf16_t*)(ws + WS_KFILT));
    {
        LAS float* scr = (LAS float*)(lds + 32768 + wave * 8448);
        constexpr int I_A = 16 * 48, I_B = 16 * 64, I_O = 16 * 32, I_E = 16 * 32 * 16;
        constexpr int NITEMS = I_A + I_B + I_O + 3 * I_E;
        bf16_t* WinT = (bf16_t*)(ws + WS_WIN); bf16_t* WoutT = (bf16_t*)(ws + WS_WOUT); bf16_t* WguT = (bf16_t*)(ws + WS_WGU); bf16_t* WdT = (bf16_t*)(ws + WS_WD);
        for (int it = gw; it < NITEMS; it += NGW) {
            int r = it;
            if (r < I_A) { const int kb = r / 48, nb = r % 48; transpose_item(P.w_in + (size_t)l * DM * NIN_REF, NIN_REF, 64 * kb, 32 * nb, WinT, 32 * nb, 1.0f, scr, lane); continue; } r -= I_A;
            if (r < I_B) { const int kb = r / 64, nb = r % 64; const int drow = 1536 + 32 * nb; transpose_item(P.w_in + (size_t)l * DM * NIN_REF, NIN_REF, 64 * kb, 1544 + 32 * nb, WinT, drow, drow < PC_AK ? 0.125f : 1.0f, scr, lane); continue; } r -= I_B;
            if (r < I_O) { const int kb = r / 32, nb = r % 32; transpose_item(P.w_out + (size_t)l * DM * DM, DM, 64 * kb, 32 * nb, WoutT, 32 * nb, 1.0f, scr, lane); continue; } r -= I_O;
            const int which = r / I_E; r -= which * I_E;
            const int e = r / 512, kb = (r % 512) / 32, nb = r % 32;
            const size_t wofs = ((size_t)l * NEXP + e) * DM * DM;
            if (which == 0)      transpose_item(P.moe_wg + wofs, DM, 64 * kb, 32 * nb, WguT, e * 2048 + ((32 * nb) >> 7) * 256 + ((32 * nb) & 127), 1.0f, scr, lane);
            else if (which == 1) transpose_item(P.moe_wu + wofs, DM, 64 * kb, 32 * nb, WguT, e * 2048 + ((32 * nb) >> 7) * 256 + 128 + ((32 * nb) & 127), 1.0f, scr, lane);
            else                 transpose_item(P.moe_wd + wofs, DM, 64 * kb, 32 * nb, WdT, e * 1024 + 32 * nb, 1.0f, scr, lane);
        }
    }
    const float* nw = P.norm_mix_w + l * DM;
    for (int m = gw; m < NTOK; m += NGW) { asm volatile("" ::: "memory"); pre_row<false>(P, l, m, lane, (const LAS f32x4*)dtwf, nw); }
}
DI void phase_final(const Params& P) {
    const int tid = tid_opaque(), lane = tid & 63, wave = tid >> 6;
    const int gw = blockIdx.x * 8 + wave, NGW = gridDim.x * 8;
    for (int m = gw; m < NTOK; m += NGW) pre_row<true>(P, 1, m, lane, nullptr, P.final_w);
}

struct AddrPlain { static constexpr bool LOADS = false; int K; int nb_rows;
    DI unsigned arow(const pg8::Unit& u, int r) const { return (unsigned)(u.pm * 256 + r) * (unsigned)(K * 2); }
    DI size_t boff(const pg8::Unit& u) const { return (size_t)u.pn * 256 * K * 2; } };
struct AddrGateUp { static constexpr bool LOADS = true; const int* seli;
    DI unsigned arow(const pg8::Unit& u, int r) const { const int b = u.pm >> 4; const int t = seli[u.pm * 256 + r]; return (unsigned)(b * SEQ + t) * (unsigned)(DM * 2); }
    DI size_t boff(const pg8::Unit& u) const { return ((size_t)(u.pm & 15) * 2048 + (size_t)u.pn * 256) * DM * 2; } };
struct AddrDown { static constexpr bool LOADS = false;
    DI unsigned arow(const pg8::Unit& u, int r) const { return (unsigned)(u.pm * 256 + r) * (unsigned)(DM * 2); }
    DI size_t boff(const pg8::Unit& u) const { return ((size_t)(u.pm & 15) * 1024 + (size_t)u.pn * 256) * DM * 2; } };

struct EpiProj { static constexpr bool PERM = true; bf16_t* O;
    DI void operator()(const f32x4 (&acc)[2][2][4][2], const pg8::Unit& u, int wr, int wc, int fr, int fq) const {
        const int row0 = u.pm * 256 + wr * 64 + fr, col0 = u.pn * 256 + wc * 32 + 8 * fq;
#pragma unroll
        for (int ai = 0; ai < 2; ++ai)
#pragma unroll
            for (int m = 0; m < 4; ++m) { bf16_t* rowp = O + (size_t)(row0 + ai * 128 + m * 16) * NPROJ + col0;
#pragma unroll
                for (int bj = 0; bj < 2; ++bj) { const f32x4 v0 = acc[ai][bj][m][0], v1 = acc[ai][bj][m][1];
                    u32x4 w; w.x = pk2(v0[0], v0[1]); w.y = pk2(v0[2], v0[3]); w.z = pk2(v1[0], v1[1]); w.w = pk2(v1[2], v1[3]);
                    *(u32x4*)(rowp + bj * 128) = w; } }
    } };
struct EpiRes { static constexpr bool PERM = false; const float* base; float* out;
    DI void operator()(const f32x4 (&acc)[2][2][4][2], const pg8::Unit& u, int wr, int wc, int fr, int fq) const {
        const int row0 = u.pm * 256 + wr * 64 + fr, col0 = u.pn * 256 + wc * 32 + 4 * fq;
#pragma unroll
        for (int ai = 0; ai < 2; ++ai)
#pragma unroll
            for (int m = 0; m < 4; ++m) { const size_t off = (size_t)(row0 + ai * 128 + m * 16) * DM + col0;
#pragma unroll
                for (int bj = 0; bj < 2; ++bj)
#pragma unroll
                    for (int n = 0; n < 2; ++n) { const f32x4 bs = *(const f32x4*)(base + off + bj * 128 + n * 16); *(f32x4*)(out + off + bj * 128 + n * 16) = bs + acc[ai][bj][m][n]; } }
    } };
struct EpiGateUp { static constexpr bool PERM = true; bf16_t* H;
    DI void operator()(const f32x4 (&acc)[2][2][4][2], const pg8::Unit& u, int wr, int wc, int fr, int fq) const {
        const int row0 = u.pm * 256 + wr * 64 + fr, col0 = u.pn * 128 + wc * 32 + 8 * fq;
#pragma unroll
        for (int ai = 0; ai < 2; ++ai)
#pragma unroll
            for (int m = 0; m < 4; ++m) { bf16_t* rowp = H + (size_t)(row0 + ai * 128 + m * 16) * DM + col0;
                float hv[8];
#pragma unroll
                for (int n = 0; n < 2; ++n)
#pragma unroll
                    for (int j = 0; j < 4; ++j) { const float g = acc[ai][0][m][n][j], up = acc[ai][1][m][n][j]; hv[n * 4 + j] = silu_f(g) * up; }
                u32x4 w; w.x = pk2(hv[0], hv[1]); w.y = pk2(hv[2], hv[3]); w.z = pk2(hv[4], hv[5]); w.w = pk2(hv[6], hv[7]);
                *(u32x4*)rowp = w; }
    } };
struct EpiDown { static constexpr bool PERM = true; bf16_t* Y; const float* gate;
    DI void operator()(const f32x4 (&acc)[2][2][4][2], const pg8::Unit& u, int wr, int wc, int fr, int fq) const {
        const int row0 = u.pm * 256 + wr * 64 + fr, col0 = u.pn * 256 + wc * 32 + 8 * fq;
#pragma unroll
        for (int ai = 0; ai < 2; ++ai)
#pragma unroll
            for (int m = 0; m < 4; ++m) { const int row = row0 + ai * 128 + m * 16; const float g = gate[row]; bf16_t* rowp = Y + (size_t)row * DM + col0;
#pragma unroll
                for (int bj = 0; bj < 2; ++bj) { const f32x4 v0 = acc[ai][bj][m][0] * g, v1 = acc[ai][bj][m][1] * g;
                    u32x4 w; w.x = pk2(v0[0], v0[1]); w.y = pk2(v0[2], v0[3]); w.z = pk2(v1[0], v1[1]); w.w = pk2(v1[2], v1[3]);
                    *(u32x4*)(rowp + bj * 128) = w; } }
    } };

DI void phase_premix(const Params& P, int l) {
    const int tid = tid_opaque(), lane = tid & 63, wave = tid >> 6;
    const int gw = blockIdx.x * 8 + wave, NGW = gridDim.x * 8;
    unsigned char* ws = P.ws;
    const bf16_t* proj = (const bf16_t*)(ws + WS_PROJ);
    unsigned char* dsc = (unsigned char*)P.out;
    if (EN_HY) {
        bf16_t* HW = (bf16_t*)(dsc + DO_HW); bf16_t* HX0 = (bf16_t*)(dsc + DO_HX0);
        const float* cw = P.hy_conv_w + (size_t)l * 3 * 768;
        for (int it = gw; it < NB * 32 * 4; it += NGW) {
            const int ct = it & 3, tt = (it >> 2) & 31, b = it >> 7;
            const int c = ct * 64 + lane, t0 = tt * 64;
            float w0[3], w1[3], w2[3];
#pragma unroll
            for (int j = 0; j < 3; ++j) { w0[j] = cw[j * 768 + c]; w1[j] = cw[j * 768 + 256 + c]; w2[j] = cw[j * 768 + 512 + c]; }
            const bf16_t* pr = proj + (size_t)b * SEQ * NPROJ + c;
            bf16_t* hwp = HW + ((size_t)c * NB + b) * SEQ + t0; bf16_t* hxp = HX0 + ((size_t)c * NB + b) * SEQ + t0;
            float a0, a1, a2, b0, b1, b2, c0, c1, c2;
            { const int t = t0 - 1; const bool ok = t >= 0; const bf16_t* q = pr + (size_t)(ok ? t : 0) * NPROJ; a0 = ok ? bf2f(q[0]) : 0.f; a1 = ok ? bf2f(q[256]) : 0.f; a2 = ok ? bf2f(q[512]) : 0.f; }
            { const bf16_t* q = pr + (size_t)t0 * NPROJ; b0 = bf2f(q[0]); b1 = bf2f(q[256]); b2 = bf2f(q[512]); }
#pragma unroll 1
            for (int t8 = 0; t8 < 64; t8 += 8) {
                unsigned hwv[4], hxv[4]; float ph = 0.f, px = 0.f;
#pragma unroll
                for (int i = 0; i < 8; ++i) { const int t = t0 + t8 + i + 1; const bool ok = t < SEQ; const bf16_t* q = pr + (size_t)(ok ? t : SEQ - 1) * NPROJ;
                    c0 = ok ? bf2f(q[0]) : 0.f; c1 = ok ? bf2f(q[256]) : 0.f; c2 = ok ? bf2f(q[512]) : 0.f;
                    const float u0 = w0[0] * a0 + w0[1] * b0 + w0[2] * c0, u1 = w1[0] * a1 + w1[1] * b1 + w1[2] * c1, u2 = w2[0] * a2 + w2[1] * b2 + w2[2] * c2;
                    const float hv = u2 * u1;
                    if (i & 1) { hwv[i >> 1] = pk2(ph, hv); hxv[i >> 1] = pk2(px, u0); } else { ph = hv; px = u0; }
                    a0 = b0; a1 = b1; a2 = b2; b0 = c0; b1 = c1; b2 = c2; }
                *(u32x4*)(hwp + t8) = (u32x4){hwv[0], hwv[1], hwv[2], hwv[3]}; *(u32x4*)(hxp + t8) = (u32x4){hxv[0], hxv[1], hxv[2], hxv[3]};
            }
        }
    }
    if (EN_MA) {
        bf16_t* MX = (bf16_t*)(dsc + DO_MXBC);
        const float* cw = P.m_conv_w + (size_t)l * 5 * 512; const float* cb = P.m_conv_b + (size_t)l * 512;
        const int gt = blockIdx.x * 512 + tid, NGT = gridDim.x * 512;
        for (int it = gt; it < NTOK * 64; it += NGT) {
            const int ch = (it & 63) * 8, m = it >> 6, t = m & (SEQ - 1);
            float a[8];
#pragma unroll
            for (int i = 0; i < 8; ++i) a[i] = cb[ch + i];
#pragma unroll
            for (int j = 0; j < 5; ++j) { const int tt = t + j - 2; if (tt >= 0 && tt < SEQ) {
                const u32x4 v = *(const u32x4*)(proj + (size_t)(m + j - 2) * NPROJ + PC_MX + ch);
                const f32x4 wa = *(const f32x4*)(cw + j * 512 + ch), wb = *(const f32x4*)(cw + j * 512 + ch + 4);
                a[0] += wa.x * bflo(v.x); a[1] += wa.y * bfhi(v.x); a[2] += wa.z * bflo(v.y); a[3] += wa.w * bfhi(v.y);
                a[4] += wb.x * bflo(v.z); a[5] += wb.y * bfhi(v.z); a[6] += wb.z * bflo(v.w); a[7] += wb.w * bfhi(v.w); } }
            u32x4 o; o.x = pk2(silu_f(a[0]), silu_f(a[1])); o.y = pk2(silu_f(a[2]), silu_f(a[3])); o.z = pk2(silu_f(a[4]), silu_f(a[5])); o.w = pk2(silu_f(a[6]), silu_f(a[7]));
            *(u32x4*)(MX + (size_t)m * 512 + ch) = o;
        }
    }
}

DI void phase_finalize(const Params& P, int l) {
    const int tid = tid_opaque(), lane = tid & 63, wave = tid >> 6;
    const int gw = blockIdx.x * 8 + wave, NGW = gridDim.x * 8;
    unsigned char* ws = P.ws; unsigned char* dsc = (unsigned char*)P.out;
    bf16_t* MIX = (bf16_t*)(ws + WS_HN);
    {
        const bf16_t* YAT = (const bf16_t*)(dsc + DO_YAT);
        for (int it = gw; it < NB * 32 * 4; it += NGW) {
            const int ct = it & 3, tt = (it >> 2) & 31, b = it >> 7;
            const int c = ct * 64 + lane, t0 = tt * 64;
            const bf16_t* src = YAT + ((size_t)c * NB + b) * SEQ + t0;
            bf16_t* dst = MIX + ((size_t)b * SEQ + t0) * DM + c;
#pragma unroll 2
            for (int t8 = 0; t8 < 64; t8 += 8) {
                u32x4 v = EN_HY ? *(const u32x4*)(src + t8) : (u32x4){0u, 0u, 0u, 0u};
                const unsigned w[4] = {v.x, v.y, v.z, v.w};
#pragma unroll
                for (int i = 0; i < 8; ++i) dst[(size_t)(t8 + i) * DM] = (bf16_t)((i & 1) ? (w[i >> 1] >> 16) : (w[i >> 1] & 0xffffu));
            }
        }
    }
    {
        const bf16_t* MY = (const bf16_t*)(dsc + DO_MY); const float* msq = (const float*)(ws + WS_MSQ); const float* nw = P.m_norm_w + l * 256;
        const int gt = blockIdx.x * 512 + tid, NGT = gridDim.x * 512;
        for (int it = gt; it < NTOK * 32; it += NGT) {
            const int ch = (it & 31) * 8, m = it >> 5;
            u32x4 o = {0u, 0u, 0u, 0u};
            if (EN_MA) {
                const f32x4 sq = *(const f32x4*)(msq + (size_t)m * 4);
                const float r = 1.0f / sqrtf(((sq.x + sq.y) + (sq.z + sq.w)) * (1.0f / 256.0f) + EPSN);
                const u32x4 v = *(const u32x4*)(MY + (size_t)m * 256 + ch);
                const f32x4 wa = *(const f32x4*)(nw + ch), wb = *(const f32x4*)(nw + ch + 4);
                o.x = pk2(bflo(v.x) * r * wa.x, bfhi(v.x) * r * wa.y); o.y = pk2(bflo(v.y) * r * wa.z, bfhi(v.y) * r * wa.w);
                o.z = pk2(bflo(v.z) * r * wb.x, bfhi(v.z) * r * wb.y); o.w = pk2(bflo(v.w) * r * wb.z, bfhi(v.w) * r * wb.w);
            }
            *(u32x4*)(MIX + (size_t)m * DM + 256 + ch) = o;
        }
    }
#if !EN_AT || !EN_HG
    {
        const int gt = blockIdx.x * 512 + tid, NGT = gridDim.x * 512;
        for (int it = gt; it < NTOK * 32; it += NGT) { const int ch = (it & 31) * 8, m = it >> 5;
            if (!EN_AT) *(u32x4*)(MIX + (size_t)m * DM + 512 + ch) = (u32x4){0u, 0u, 0u, 0u};
            if (!EN_HG) *(u32x4*)(MIX + (size_t)m * DM + 768 + ch) = (u32x4){0u, 0u, 0u, 0u}; }
    }
#endif
}

DI void phase_ffnpre(const Params& P, int l, LAS unsigned char* lds) {
    const int tid = tid_opaque(), lane = tid & 63, wave = tid >> 6;
    const int gw = blockIdx.x * 8 + wave, NGW = gridDim.x * 8;
    unsigned char* ws = P.ws;
    LAS float* rwf = (LAS float*)lds;
    for (int i = tid; i < 1024 * 16; i += 512) { const int k = i >> 4, c = i & 15; const int j = k >> 8, ln = (k & 255) >> 2, q = k & 3;
        rwf[((((j * 4 + q) * 4 + (c >> 2)) * 64 + ln) << 2) + (c & 3)] = P.norm_ffn_w[l * DM + k] * P.router_w[((size_t)l * DM + k) * 16 + c]; }
    __syncthreads();
    const LAS f32x4* rw = (const LAS f32x4*)rwf;
    const float* XB = (const float*)(ws + WS_XB); const float* nw = P.norm_ffn_w + l * DM;
    float* aff = (float*)(ws + WS_AFF);
    for (int m = gw; m < NTOK; m += NGW) {
        asm volatile("" ::: "memory");
        const f32x4* xr = (const f32x4*)(XB + (size_t)m * DM) + lane;
        f32x4 v[4]; float s = 0.f;
#pragma unroll
        for (int j = 0; j < 4; ++j) { v[j] = xr[64 * j]; s += (v[j].x * v[j].x + v[j].y * v[j].y) + (v[j].z * v[j].z + v[j].w * v[j].w); }
        const float r = 1.0f / sqrtf(wave_sum(s) * (1.0f / DM) + EPSN);
        float d[16];
#pragma unroll
        for (int c = 0; c < 16; ++c) d[c] = 0.f;
#pragma unroll
        for (int j = 0; j < 4; ++j) {
            const float xv[4] = {v[j].x, v[j].y, v[j].z, v[j].w};
#pragma unroll
            for (int q = 0; q < 4; ++q)
#pragma unroll
                for (int g = 0; g < 4; ++g) { const f32x4 w = rw[((j * 4 + q) * 4 + g) * 64 + lane];
                    d[4 * g] += xv[q] * w.x; d[4 * g + 1] += xv[q] * w.y; d[4 * g + 2] += xv[q] * w.z; d[4 * g + 3] += xv[q] * w.w; }
        }
        float mine = 0.f;
#pragma unroll
        for (int c = 0; c < 16; ++c) { const float t = wave_sum(d[c]); mine = (lane == c) ? t : mine; }
        float lg = (lane < 16) ? mine * r : -3.0e38f;
        float mx = lg;
#pragma unroll
        for (int o = 1; o < 16; o <<= 1) mx = fmaxf(mx, __shfl_xor(mx, o));
        float ex = (lane < 16) ? expf(lg - mx) : 0.f, se = ex;
#pragma unroll
        for (int o = 1; o < 16; o <<= 1) se += __shfl_xor(se, o);
        if (lane < 16) aff[((size_t)(m >> 11) * 16 + lane) * SEQ + (m & (SEQ - 1))] = ex / se;
        u32x2* o8 = (u32x2*)((bf16_t*)(ws + WS_HN) + (size_t)m * DM) + lane;
#pragma unroll
        for (int j = 0; j < 4; ++j) { const f32x4 w = ((const f32x4*)nw)[64 * j + lane]; u32x2 o; o.x = pk2(v[j].x * r * w.x, v[j].y * r * w.y); o.y = pk2(v[j].z * r * w.z, v[j].w * r * w.w); o8[64 * j] = o; }
    }
}

DI void phase_topk(const Params& P, LAS unsigned char* lds) {
    const int tid = tid_opaque();
    unsigned char* ws = P.ws;
    const float* aff = (const float*)(ws + WS_AFF);
    int* slot = (int*)(ws + WS_SLOT); int* seli = (int*)(ws + WS_SELI); float* selg = (float*)(ws + WS_SELG);
    LAS float* av = (LAS float*)lds;
    for (int u = blockIdx.x; u < NB * NEXP; u += gridDim.x) {
        const int b = u >> 4, e = u & 15;
        __syncthreads();
        for (int i = tid; i < SEQ; i += 512) av[i] = aff[(size_t)u * SEQ + i];
        __syncthreads();
        float mv[4]; int rk[4];
#pragma unroll
        for (int q = 0; q < 4; ++q) { mv[q] = av[tid + 512 * q]; rk[q] = 0; }
        for (int j4 = 0; j4 < SEQ; j4 += 4) {
            const f32x4 a = *(const LAS f32x4*)(av + j4);
            const float aj[4] = {a.x, a.y, a.z, a.w};
#pragma unroll
            for (int jj = 0; jj < 4; ++jj)
#pragma unroll
                for (int q = 0; q < 4; ++q) { const int i = tid + 512 * q, j = j4 + jj; rk[q] += (aj[jj] > mv[q] || (aj[jj] == mv[q] && j < i)) ? 1 : 0; }
        }
#pragma unroll
        for (int q = 0; q < 4; ++q) { const int i = tid + 512 * q; const bool sel = rk[q] < CAP;
            slot[((size_t)b * SEQ + i) * 16 + e] = sel ? rk[q] : -1;
            if (sel) { seli[u * CAP + rk[q]] = i; selg[u * CAP + rk[q]] = mv[q]; } }
    }
}

DI bf16x8 mk8(unsigned a, unsigned b, unsigned c, unsigned d) { u32x4 v = {a, b, c, d}; return __builtin_bit_cast(bf16x8, v); }
DI bf16x8 cat44(u32x2 lo, u32x2 hi) { u32x4 v = {lo.x, lo.y, hi.x, hi.y}; return __builtin_bit_cast(bf16x8, v); }
DI int crow(int reg, int hh) { return (reg & 3) + 8 * (reg >> 2) + 4 * hh; }
#define PACK_STEP(x, s) mk8(pk2((x)[8 * (s)], (x)[8 * (s) + 1]), pk2((x)[8 * (s) + 2], (x)[8 * (s) + 3]), pk2((x)[8 * (s) + 4], (x)[8 * (s) + 5]), pk2((x)[8 * (s) + 6], (x)[8 * (s) + 7]))

DI void hyena_unit(const Params& P, int c, LAS unsigned char* lds) {
    const int tid = tid_opaque(), lane = tid & 63, w = __builtin_amdgcn_readfirstlane(tid >> 6), r = lane & 31, hh = lane >> 5;
    constexpr int CPS = 8224;
    unsigned char* ws = P.ws; unsigned char* dsc = (unsigned char*)P.out;
    const bf16_t* kf = (const bf16_t*)(ws + WS_KFILT) + (size_t)c * 4096;
    __syncthreads();
    for (int idx = tid; idx < 8 * 4096; idx += 512) { const int p = idx >> 12, i = idx & 4095, mi = i + p;
        *(LAS bf16_t*)(lds + p * CPS + i * 2) = (mi < 4096) ? kf[mi] : (bf16_t)0; }
    __syncthreads();
    const bf16_t* hw = (const bf16_t*)(dsc + DO_HW) + ((size_t)c * NB + r) * SEQ + 8 * hh;
    f32x16 acc[8];
#pragma unroll
    for (int i = 0; i < 8; ++i)
#pragma unroll
        for (int q = 0; q < 16; ++q) acc[i][q] = 0.f;
    const int p = 7 - (r & 7);
    const LAS unsigned char* abase = lds + p * CPS + (2047 - 256 * w - r + 8 * hh - p) * 2;
#pragma unroll 2
    for (int s0 = 0; s0 < SEQ; s0 += 16) {
        const bf16x8 bfr = *(const bf16x8*)(hw + s0);
#pragma unroll
        for (int i = 0; i < 8; ++i) { const bf16x8 afr = *(const LAS bf16x8*)(abase + (s0 - 32 * i) * 2); acc[i] = MFMA32(afr, bfr, acc[i]); }
    }
    const bf16_t* hx = (const bf16_t*)(dsc + DO_HX0) + ((size_t)c * NB + r) * SEQ;
    bf16_t* ya = (bf16_t*)(dsc + DO_YAT) + ((size_t)c * NB + r) * SEQ;
#pragma unroll
    for (int i = 0; i < 8; ++i)
#pragma unroll
        for (int g = 0; g < 4; ++g) { const int t = 256 * w + 32 * i + 8 * g + 4 * hh;
            const u32x2 xv = *(const u32x2*)(hx + t);
            u32x2 o; o.x = pk2(acc[i][4 * g] * bflo(xv.x), acc[i][4 * g + 1] * bfhi(xv.x)); o.y = pk2(acc[i][4 * g + 2] * bflo(xv.y), acc[i][4 * g + 3] * bfhi(xv.y));
            *(u32x2*)(ya + t) = o; }
}

DI int t5_bucket(int rel) {
    const int ret = rel > 0 ? 16 : 0; const int n = rel < 0 ? -rel : rel;
    if (n < 8) return ret + n;
    const float nf = (float)n;
    int large = 8 + (int)(logf(nf / 8.0f) / 4.852030263919617f * 8.0f);
    large = large < 15 ? large : 15;
    return ret + large;
}
DI void attn_unit(const Params& P, int u, LAS unsigned char* lds) {
    const int qb = u & 7, h = (u >> 3) & 3, b = u >> 5;
    const int tid = tid_opaque(), lane = tid & 63, w = __builtin_amdgcn_readfirstlane(tid >> 6), c = lane & 31, hh = lane >> 5;
    LAS float* Ost = (LAS float*)lds;
    LAS float* Mst = (LAS float*)(lds + 69632);
    LAS float* Lst = Mst + 256;
    LAS float* biasT = (LAS float*)(lds + 69632 + 2048);
    LAS unsigned short* Vt = (LAS unsigned short*)(lds + 69632 + 2048 + 8256 + w * 4608);
    unsigned char* ws = P.ws;
    __syncthreads();
    for (int i = tid; i < 2049; i += 512) biasT[i] = P.rel_bias[t5_bucket(i - 1024) * 4 + h];
    __syncthreads();
    const bf16_t* pb = (const bf16_t*)(ws + WS_PROJ) + (size_t)b * SEQ * NPROJ;
    bf16_t* MIX = (bf16_t*)(ws + WS_HN);
    const int Q0 = qb * 256;
#pragma unroll 1
    for (int pp = 0; pp < 4; ++pp) {
        const int pat = pp < 2 ? pp : 2;
        int d, rho, uq0, nq;
        if (pat == 0) { d = 1; rho = 0; uq0 = Q0 + 32 * w; nq = 32; }
        else if (pat == 1) { d = 4; rho = w & 3; uq0 = (Q0 >> 2) + 32 * (w >> 2); nq = 32; }
        else { d = 16; rho = 2 * w + (pp - 2); uq0 = Q0 >> 4; nq = 16; }
        const int uk0 = uq0 - 64, nsub = SEQ / d;
        const int cq = (c < nq) ? c : c - nq;
        const int qpos = (uq0 + cq) * d + rho, ql = qpos - Q0;
        bf16x8 qf[4];
#pragma unroll
        for (int ks = 0; ks < 4; ++ks) qf[ks] = *(const bf16x8*)(pb + (size_t)qpos * NPROJ + PC_AQ + h * 64 + 16 * ks + 8 * hh);
        float mrun = -1.0e30f, lrun = 0.f; f32x16 OT[2];
#pragma unroll
        for (int dt = 0; dt < 2; ++dt)
#pragma unroll
            for (int q = 0; q < 16; ++q) OT[dt][q] = 0.f;
        if (pat != 0) { mrun = Mst[ql]; lrun = Lst[ql];
#pragma unroll
            for (int dt = 0; dt < 2; ++dt)
#pragma unroll
                for (int g = 0; g < 4; ++g) { const f32x4 v = *(const LAS f32x4*)(Ost + ql * 68 + 32 * dt + 8 * g + 4 * hh);
                    OT[dt][4 * g] = v.x; OT[dt][4 * g + 1] = v.y; OT[dt][4 * g + 2] = v.z; OT[dt][4 * g + 3] = v.w; } }
#pragma unroll 1
        for (int kt = 0; kt < 5; ++kt) {
            const int ukr = uk0 + 32 * kt + c;
            const int ukc = ukr < 0 ? 0 : (ukr >= nsub ? nsub - 1 : ukr);
            const bf16_t* krow = pb + (size_t)(ukc * d + rho) * NPROJ + h * 64;
            bf16x8 kf[4];
#pragma unroll
            for (int ks = 0; ks < 4; ++ks) kf[ks] = *(const bf16x8*)(krow + PC_AK + 16 * ks + 8 * hh);
#pragma unroll
            for (int i = 0; i < 4; ++i) { const int ch = hh + 2 * i; const u32x4 vv = *(const u32x4*)(krow + PC_AV + 8 * ch);
                const unsigned vw[4] = {vv.x, vv.y, vv.z, vv.w};
#pragma unroll
                for (int e = 0; e < 8; ++e) Vt[(8 * ch + e) * 36 + c] = (unsigned short)((e & 1) ? (vw[e >> 1] >> 16) : (vw[e >> 1] & 0xffffu)); }
            f32x16 st;
#pragma unroll
            for (int q = 0; q < 16; ++q) st[q] = 0.f;
#pragma unroll
            for (int ks = 0; ks < 4; ++ks) st = MFMA32(kf[ks], qf[ks], st);
            float tmax = -INFINITY; float lg[16];
#pragma unroll
            for (int q = 0; q < 16; ++q) { const int uk = uk0 + 32 * kt + crow(q, hh); const int rel = uk - (uq0 + cq);
                const bool valid = (rel >= -64) && (rel <= 64) && (uk >= 0) && (uk < nsub);
                const int bi = rel * d + 1024; const float bv = biasT[bi < 0 ? 0 : (bi > 2048 ? 2048 : bi)];
                lg[q] = valid ? st[q] + bv : -INFINITY; tmax = fmaxf(tmax, lg[q]); }
            tmax = fmaxf(tmax, __shfl_xor(tmax, 32));
            const float mnew = fmaxf(mrun, tmax), alpha = __expf(mrun - mnew);
            float psum = 0.f;
#pragma unroll
            for (int q = 0; q < 16; ++q) { lg[q] = __expf(lg[q] - mnew); psum += lg[q]; }
            psum += __shfl_xor(psum, 32);
            lrun = lrun * alpha + psum; mrun = mnew;
#pragma unroll
            for (int dt = 0; dt < 2; ++dt)
#pragma unroll
                for (int q = 0; q < 16; ++q) OT[dt][q] *= alpha;
            LDS_WAIT();
#pragma unroll
            for (int s = 0; s < 2; ++s) { const bf16x8 pf = PACK_STEP(lg, s);
#pragma unroll
                for (int dt = 0; dt < 2; ++dt) { const LAS unsigned short* vr = Vt + (32 * dt + c) * 36 + 16 * s + 4 * hh;
                    const bf16x8 af = cat44(*(const LAS u32x2*)vr, *(const LAS u32x2*)(vr + 8));
                    OT[dt] = MFMA32(af, pf, OT[dt]); } }
            LDS_WAIT();
        }
        if (pat != 2) {
            if (hh == 0) { Mst[ql] = mrun; Lst[ql] = lrun; }
#pragma unroll
            for (int dt = 0; dt < 2; ++dt)
#pragma unroll
                for (int g = 0; g < 4; ++g) *(LAS f32x4*)(Ost + ql * 68 + 32 * dt + 8 * g + 4 * hh) = (f32x4){OT[dt][4 * g], OT[dt][4 * g + 1], OT[dt][4 * g + 2], OT[dt][4 * g + 3]};
        } else if (c < 16) {
            const float inv = 1.0f / lrun;
            bf16_t* orow = MIX + ((size_t)b * SEQ + qpos) * DM + 512 + h * 64;
#pragma unroll
            for (int dt = 0; dt < 2; ++dt)
#pragma unroll
                for (int g = 0; g < 4; ++g) { u32x2 o; o.x = pk2(OT[dt][4 * g] * inv, OT[dt][4 * g + 1] * inv); o.y = pk2(OT[dt][4 * g + 2] * inv, OT[dt][4 * g + 3] * inv);
                    *(u32x2*)(orow + 32 * dt + 8 * g + 4 * hh) = o; }
        }
        if (pp != 2) __syncthreads();
    }
}

DI float softplus_f(float x) { return x > 20.f ? x : log1pf(expf(x)); }
DI void mamba_unit(const Params& P, int l, int u, LAS unsigned char* lds) {
    const int b = u >> 2, h = u & 3, g = h >> 1;
    const int tid = tid_opaque(), lane = tid & 63, w = __builtin_amdgcn_readfirstlane(tid >> 6), c32 = lane & 31, hh = lane >> 5;
    LAS unsigned char* wl = lds + w * 15616;
    LAS unsigned short* xdT = (LAS unsigned short*)wl;
    LAS unsigned short* xwT = xdT + 64 * 40;
    LAS unsigned short* BT = xwT + 64 * 40;
    LAS float* dtv = (LAS float*)(wl + 15360);
    LAS float* acum = dtv + 32;
    LAS float* Atot = (LAS float*)(lds + 8 * 15616);
    unsigned char* ws = P.ws; unsigned char* dsc = (unsigned char*)P.out;
    const bf16_t* xbc = (const bf16_t*)(dsc + DO_MXBC) + (size_t)b * SEQ * 512;
    const float* dtr = (const float*)(ws + WS_DT) + (size_t)b * SEQ * 8;
    const bf16_t* proj = (const bf16_t*)(ws + WS_PROJ) + (size_t)b * SEQ * NPROJ;
    bf16_t* MY = (bf16_t*)(dsc + DO_MY) + (size_t)b * SEQ * 256;
    float* msq = (float*)(ws + WS_MSQ) + (size_t)b * SEQ * 4;
    float* stsc = (float*)(dsc + DO_MST) + (size_t)u * (2 * 8 * 4096);
    const float Dsk = P.m_D[l * 4 + h];
    __syncthreads();
#pragma unroll 1
    for (int pass = 0; pass < 2; ++pass) {
#pragma unroll 1
        for (int dir = 0; dir < 2; ++dir) {
            const float dtb = P.m_dt_bias[l * 8 + dir * 4 + h], Aneg = -expf(P.m_A_log[l * 8 + dir * 4 + h]);
            f32x16 ST[2][2];
#pragma unroll
            for (int a = 0; a < 2; ++a)
#pragma unroll
                for (int q = 0; q < 2; ++q)
#pragma unroll
                    for (int i = 0; i < 16; ++i) ST[a][q][i] = 0.f;
            if (pass == 1) {
                const int nv = dir ? 7 - w : w;
                for (int k = 0; k < nv; ++k) { const int v = dir ? 7 - k : k; const float dec = Atot[dir * 8 + v];
                    const float* sp = stsc + (size_t)(dir * 8 + v) * 4096 + lane;
#pragma unroll
                    for (int a = 0; a < 2; ++a)
#pragma unroll
                        for (int q = 0; q < 2; ++q)
#pragma unroll
                            for (int i = 0; i < 16; ++i) ST[a][q][i] = ST[a][q][i] * dec + sp[((a * 2 + q) * 16 + i) * 64]; }
            }
            float atot = 0.f;
#pragma unroll 1
            for (int ci = 0; ci < 8; ++ci) {
                const int c0 = 256 * w + 32 * (dir ? 7 - ci : ci);
#define MTK(j) (dir ? c0 + 31 - (j) : c0 + (j))
                {
                    const float dt = softplus_f(dtr[(size_t)MTK(c32) * 8 + dir * 4 + h] + dtb);
                    float ac = dt * Aneg;
#pragma unroll
                    for (int o = 1; o < 32; o <<= 1) { const float t = __shfl_up(ac, o, 32); if (c32 >= o) ac += t; }
                    if (lane < 32) { dtv[c32] = dt; acum[c32] = ac; }
                }
                LDS_WAIT();
                const float aend = acum[31];
                {
                    const bf16_t* xp = xbc + h * 64 + lane; const bf16_t* bp = xbc + 256 + g * 64 + lane;
#pragma unroll
                    for (int j8 = 0; j8 < 32; j8 += 8) {
                        float xd[8], xw[8]; unsigned short bb[8];
#pragma unroll
                        for (int j = 0; j < 8; ++j) { const size_t ro = (size_t)MTK(j8 + j) * 512; const float xv = bf2f(xp[ro]) * dtv[j8 + j];
                            xd[j] = xv; xw[j] = xv * __expf(aend - acum[j8 + j]); bb[j] = bp[ro]; }
                        *(LAS u32x4*)(xdT + lane * 40 + j8) = (u32x4){pk2(xd[0], xd[1]), pk2(xd[2], xd[3]), pk2(xd[4], xd[5]), pk2(xd[6], xd[7])};
                        *(LAS u32x4*)(xwT + lane * 40 + j8) = (u32x4){pk2(xw[0], xw[1]), pk2(xw[2], xw[3]), pk2(xw[4], xw[5]), pk2(xw[6], xw[7])};
                        *(LAS u32x4*)(BT + lane * 40 + j8) = (u32x4){(unsigned)bb[0] | ((unsigned)bb[1] << 16), (unsigned)bb[2] | ((unsigned)bb[3] << 16), (unsigned)bb[4] | ((unsigned)bb[5] << 16), (unsigned)bb[6] | ((unsigned)bb[7] << 16)};
                    }
                }
                LDS_WAIT();
                if (pass == 1) {
                    const bf16_t* brow = xbc + (size_t)MTK(c32) * 512 + 256 + g * 64 + 8 * hh;
                    f32x16 GT;
#pragma unroll
                    for (int i = 0; i < 16; ++i) GT[i] = 0.f;
#pragma unroll
                    for (int ks = 0; ks < 4; ++ks) GT = MFMA32(*(const bf16x8*)(brow + 16 * ks), *(const bf16x8*)(brow + 128 + 16 * ks), GT);
                    const float acl = acum[c32];
#pragma unroll
                    for (int i = 0; i < 16; ++i) { const int s = crow(i, hh); GT[i] = (s <= c32) ? GT[i] * __expf(acl - acum[s]) : 0.f; }
                    f32x16 Y[2], Y2[2];
#pragma unroll
                    for (int pt = 0; pt < 2; ++pt)
#pragma unroll
                        for (int i = 0; i < 16; ++i) { Y[pt][i] = 0.f; Y2[pt][i] = 0.f; }
#pragma unroll
                    for (int s = 0; s < 2; ++s) { const bf16x8 pa = PACK_STEP(GT, s);
#pragma unroll
                        for (int pt = 0; pt < 2; ++pt) { const LAS unsigned short* xr = xdT + (32 * pt + c32) * 40 + 16 * s + 4 * hh;
                            Y[pt] = MFMA32(pa, cat44(*(const LAS u32x2*)xr, *(const LAS u32x2*)(xr + 8)), Y[pt]); } }
                    const bf16_t* crw = xbc + (size_t)MTK(c32) * 512 + 384 + g * 64 + 4 * hh;
#pragma unroll
                    for (int nt = 0; nt < 2; ++nt)
#pragma unroll
                        for (int s = 0; s < 2; ++s) { const bf16x8 ca = cat44(*(const u32x2*)(crw + 32 * nt + 16 * s), *(const u32x2*)(crw + 32 * nt + 16 * s + 8));
#pragma unroll
                            for (int pt = 0; pt < 2; ++pt) Y2[pt] = MFMA32(ca, PACK_STEP(ST[nt][pt], s), Y2[pt]); }
#pragma unroll
                    for (int i = 0; i < 16; ++i) { const int lr = crow(i, hh); const int tk = MTK(lr); const float el = __expf(acum[lr]);
                        float sq = 0.f;
#pragma unroll
                        for (int pt = 0; pt < 2; ++pt) { const int pc = h * 64 + 32 * pt + c32; float y = Y[pt][i] + el * Y2[pt][i];
                            bf16_t* dst = MY + (size_t)tk * 256 + pc;
                            if (dir == 0) { y += Dsk * bf2f(xbc[(size_t)tk * 512 + pc]); *dst = f2bf(y); }
                            else { y += bf2f(*dst); y *= silu_f(bf2f(proj[(size_t)tk * NPROJ + PC_MZ + pc])); *dst = f2bf(y); sq += y * y; } }
                        if (dir == 1) {
#pragma unroll
                            for (int o = 1; o < 32; o <<= 1) sq += __shfl_xor(sq, o);
                            if (c32 == 0) msq[(size_t)tk * 4 + h] = sq; }
                    }
                }
                {
                    const float de = __expf(aend);
#pragma unroll
                    for (int nt = 0; nt < 2; ++nt)
#pragma unroll
                        for (int pt = 0; pt < 2; ++pt)
#pragma unroll
                            for (int i = 0; i < 16; ++i) ST[nt][pt][i] *= de;
#pragma unroll
                    for (int s = 0; s < 2; ++s)
#pragma unroll
                        for (int nt = 0; nt < 2; ++nt) { const bf16x8 ba = *(const LAS bf16x8*)(BT + (32 * nt + c32) * 40 + 16 * s + 8 * hh);
#pragma unroll
                            for (int pt = 0; pt < 2; ++pt) ST[nt][pt] = MFMA32(ba, *(const LAS bf16x8*)(xwT + (32 * pt + c32) * 40 + 16 * s + 8 * hh), ST[nt][pt]); }
                }
                atot += aend;
                LDS_WAIT();
#undef MTK
            }
            if (pass == 0) {
                float* sp = stsc + (size_t)(dir * 8 + w) * 4096 + lane;
#pragma unroll
                for (int a = 0; a < 2; ++a)
#pragma unroll
                    for (int q = 0; q < 2; ++q)
#pragma unroll
                        for (int i = 0; i < 16; ++i) sp[((a * 2 + q) * 16 + i) * 64] = ST[a][q][i];
                if (lane == 0) Atot[dir * 8 + w] = __expf(atot);
            }
            VM_WAIT();
        }
        if (pass == 0) { VM_WAIT(); __syncthreads(); }
    }
    __syncthreads();
}

DI void hgrn_unit(const Params& P, int l, int u, LAS unsigned char* lds) {
    const int b = u >> 2, h = u & 3;
    const int tid = tid_opaque(), lane = tid & 63, w = __builtin_amdgcn_readfirstlane(tid >> 6), c32 = lane & 31, hh = lane >> 5;
    LAS unsigned char* wl = lds + w * 15104;
    LAS unsigned short* qd = (LAS unsigned short*)wl;
    LAS unsigned short* kd = qd + 32 * 72;
    LAS unsigned short* vT = kd + 32 * 72;
    LAS float* eref = (LAS float*)(wl + 14336);
    LAS float* eglr = eref + 64;
    LAS float* egl = eglr + 64;
    LAS float* Atot = (LAS float*)(lds + 8 * 15104);
    unsigned char* ws = P.ws; unsigned char* dsc = (unsigned char*)P.out;
    const bf16_t* proj = (const bf16_t*)(ws + WS_PROJ) + (size_t)b * SEQ * NPROJ;
    bf16_t* MIX = (bf16_t*)(ws + WS_HN) + (size_t)b * SEQ * DM;
    float* stsc = (float*)(dsc + DO_HST) + (size_t)u * (2 * 8 * 4096);
    bf16x8 ident[2];
#pragma unroll
    for (int s = 0; s < 2; ++s) { unsigned short e[8];
#pragma unroll
        for (int j = 0; j < 8; ++j) e[j] = (16 * s + 8 * hh + j == c32) ? (unsigned short)0x3f80 : (unsigned short)0;
        ident[s] = mk8((unsigned)e[0] | ((unsigned)e[1] << 16), (unsigned)e[2] | ((unsigned)e[3] << 16), (unsigned)e[4] | ((unsigned)e[5] << 16), (unsigned)e[6] | ((unsigned)e[7] << 16)); }
    __syncthreads();
#pragma unroll 1
    for (int pass = 0; pass < 2; ++pass) {
#pragma unroll 1
        for (int dir = 0; dir < 2; ++dir) {
            float lb = 0.f;
            if (l == 1) { const float h0 = P.hg_lb[(0 * 2 + dir) * 256 + h * 64 + lane], h1 = P.hg_lb[(1 * 2 + dir) * 256 + h * 64 + lane]; lb = 1.0f / (1.0f + expf(h0 - h1)); }
            f32x16 S[2][2];
#pragma unroll
            for (int a = 0; a < 2; ++a)
#pragma unroll
                for (int q = 0; q < 2; ++q)
#pragma unroll
                    for (int i = 0; i < 16; ++i) S[a][q][i] = 0.f;
            if (pass == 1) {
                const int nv = dir ? 7 - w : w;
                for (int k = 0; k < nv; ++k) { const int v = dir ? 7 - k : k; const LAS float* at = Atot + (dir * 8 + v) * 64;
                    const float* sp = stsc + (size_t)(dir * 8 + v) * 4096 + lane;
#pragma unroll
                    for (int a = 0; a < 2; ++a)
#pragma unroll
                        for (int i = 0; i < 16; ++i) { const float dec = at[32 * a + crow(i, hh)];
#pragma unroll
                            for (int q = 0; q < 2; ++q) S[a][q][i] = S[a][q][i] * dec + sp[((a * 2 + q) * 16 + i) * 64]; } }
            }
            float gtot = 0.f;
#pragma unroll 1
            for (int ci = 0; ci < 8; ++ci) {
                const int c0 = 256 * w + 32 * (dir ? 7 - ci : ci);
#define HTK(j) (dir ? c0 + 31 - (j) : c0 + (j))
                {
                    const bf16_t* qp = proj + PC_HQ + h * 64 + lane; const bf16_t* fp = proj + PC_HF + dir * 256 + h * 64 + lane; const bf16_t* vp = proj + PC_HI + h * 64 + lane;
                    float gcv[32], qv[32], kv[32]; float run = 0.f;
#pragma unroll
                    for (int j = 0; j < 32; ++j) { const size_t ro = (size_t)HTK(j) * NPROJ; const float fpre = bf2f(fp[ro]);
                        const float sg = sigmoid_f(fpre), f = lb + (1.0f - lb) * sg;
                        run += __logf(f); gcv[j] = run; qv[j] = silu_f(bf2f(qp[ro])); kv[j] = (1.0f - lb) * sigmoid_f(-fpre); }
                    const float ref = gcv[15], gl = gcv[31];
                    eref[lane] = __expf(ref); eglr[lane] = __expf(gl - ref); egl[lane] = __expf(gl); gtot += gl;
#pragma unroll
                    for (int j = 0; j < 32; ++j) { qd[j * 72 + lane] = f2bf(qv[j] * __expf(gcv[j] - ref)); kd[j * 72 + lane] = f2bf(kv[j] * __expf(ref - gcv[j])); }
#pragma unroll
                    for (int j8 = 0; j8 < 32; j8 += 8) { unsigned short vb[8];
#pragma unroll
                        for (int j = 0; j < 8; ++j) vb[j] = vp[(size_t)HTK(j8 + j) * NPROJ];
                        *(LAS u32x4*)(vT + lane * 40 + j8) = (u32x4){(unsigned)vb[0] | ((unsigned)vb[1] << 16), (unsigned)vb[2] | ((unsigned)vb[3] << 16), (unsigned)vb[4] | ((unsigned)vb[5] << 16), (unsigned)vb[6] | ((unsigned)vb[7] << 16)}; }
                }
                LDS_WAIT();
                bf16x8 vperm[2][2];
#pragma unroll
                for (int s = 0; s < 2; ++s)
#pragma unroll
                    for (int pt = 0; pt < 2; ++pt) { const LAS unsigned short* vr = vT + (32 * pt + c32) * 40 + 16 * s + 4 * hh; vperm[s][pt] = cat44(*(const LAS u32x2*)vr, *(const LAS u32x2*)(vr + 8)); }
                if (pass == 1) {
                    f32x16 SC;
#pragma unroll
                    for (int i = 0; i < 16; ++i) SC[i] = 0.f;
#pragma unroll
                    for (int ks = 0; ks < 4; ++ks) SC = MFMA32(*(const LAS bf16x8*)(kd + c32 * 72 + 16 * ks + 8 * hh), *(const LAS bf16x8*)(qd + c32 * 72 + 16 * ks + 8 * hh), SC);
#pragma unroll
                    for (int i = 0; i < 16; ++i) SC[i] = (crow(i, hh) <= c32) ? SC[i] : 0.f;
                    f32x16 O[2];
#pragma unroll
                    for (int pt = 0; pt < 2; ++pt)
#pragma unroll
                        for (int i = 0; i < 16; ++i) O[pt][i] = 0.f;
#pragma unroll
                    for (int s = 0; s < 2; ++s) { const bf16x8 pa = PACK_STEP(SC, s);
#pragma unroll
                        for (int pt = 0; pt < 2; ++pt) O[pt] = MFMA32(pa, vperm[s][pt], O[pt]); }
#pragma unroll
                    for (int et = 0; et < 2; ++et)
#pragma unroll
                        for (int s = 0; s < 2; ++s) { const LAS unsigned short* qr = qd + c32 * 72 + 32 * et + 16 * s + 4 * hh;
                            const bf16x8 qa = cat44(*(const LAS u32x2*)qr, *(const LAS u32x2*)(qr + 8));
                            float er[8];
#pragma unroll
                            for (int j = 0; j < 8; ++j) er[j] = eref[32 * et + crow(8 * s + j, hh)];
#pragma unroll
                            for (int pt = 0; pt < 2; ++pt) { const f32x16& sv = S[et][pt];
                                const bf16x8 sb = mk8(pk2(sv[8 * s] * er[0], sv[8 * s + 1] * er[1]), pk2(sv[8 * s + 2] * er[2], sv[8 * s + 3] * er[3]), pk2(sv[8 * s + 4] * er[4], sv[8 * s + 5] * er[5]), pk2(sv[8 * s + 6] * er[6], sv[8 * s + 7] * er[7]));
                                O[pt] = MFMA32(qa, sb, O[pt]); } }
                    const float nwa = P.hg_norm_w[l * 64 + c32], nwb = P.hg_norm_w[l * 64 + 32 + c32];
#pragma unroll
                    for (int i = 0; i < 16; ++i) { const int lr = crow(i, hh); const int tk = HTK(lr);
                        bf16_t* dst = MIX + (size_t)tk * DM + 768 + h * 64 + c32;
                        if (dir == 0) { dst[0] = f2bf(O[0][i]); dst[32] = f2bf(O[1][i]); }
                        else { const float o0 = O[0][i] + bf2f(dst[0]), o1 = O[1][i] + bf2f(dst[32]);
                            float sq = o0 * o0 + o1 * o1;
#pragma unroll
                            for (int o = 1; o < 32; o <<= 1) sq += __shfl_xor(sq, o);
                            const float rn = 1.0f / sqrtf(sq * (1.0f / 64.0f) + EPSN);
                            const bf16_t* gp = proj + (size_t)tk * NPROJ + PC_HG + h * 64 + c32;
                            dst[0] = f2bf(o0 * rn * nwa * silu_f(bf2f(gp[0]))); dst[32] = f2bf(o1 * rn * nwb * silu_f(bf2f(gp[32]))); } }
                }
                {
#pragma unroll
                    for (int et = 0; et < 2; ++et) {
                        f32x16 X;
#pragma unroll
                        for (int i = 0; i < 16; ++i) X[i] = 0.f;
#pragma unroll
                        for (int s = 0; s < 2; ++s) X = MFMA32(*(const LAS bf16x8*)(kd + c32 * 72 + 32 * et + 16 * s + 8 * hh), ident[s], X);
                        const float sc = eglr[32 * et + c32];
#pragma unroll
                        for (int i = 0; i < 16; ++i) X[i] *= sc;
                        float dg[16];
#pragma unroll
                        for (int i = 0; i < 16; ++i) dg[i] = egl[32 * et + crow(i, hh)];
#pragma unroll
                        for (int pt = 0; pt < 2; ++pt) {
#pragma unroll
                            for (int i = 0; i < 16; ++i) S[et][pt][i] *= dg[i];
#pragma unroll
                            for (int s = 0; s < 2; ++s) S[et][pt] = MFMA32(PACK_STEP(X, s), vperm[s][pt], S[et][pt]); }
                    }
                }
                LDS_WAIT();
#undef HTK
            }
            if (pass == 0) {
                float* sp = stsc + (size_t)(dir * 8 + w) * 4096 + lane;
#pragma unroll
                for (int a = 0; a < 2; ++a)
#pragma unroll
                    for (int q = 0; q < 2; ++q)
#pragma unroll
                        for (int i = 0; i < 16; ++i) sp[((a * 2 + q) * 16 + i) * 64] = S[a][q][i];
                Atot[(dir * 8 + w) * 64 + lane] = __expf(gtot);
            }
            VM_WAIT();
        }
        if (pass == 0) { VM_WAIT(); __syncthreads(); }
    }
    __syncthreads();
}

DI void phase_mixers(const Params& P, int l, LAS unsigned char* lds) {
    const int G = gridDim.x, bid = blockIdx.x;
    if (EN_HY) for (int c = bid; c < 256; c += G) hyena_unit(P, c, lds);
    if (EN_AT) for (int u = bid; u < NB * 4 * 8; u += G) attn_unit(P, u, lds);
    if (EN_MA) for (int u = bid; u < 128; u += G) mamba_unit(P, l, u, lds);
    if (EN_HG) for (int u = (bid + G - (128 % G)) % G; u < 128; u += G) hgrn_unit(P, l, u, lds);
}

constexpr int N_PHASES = 21;
__global__ void __launch_bounds__(512, 2) fwd_kernel(Params P) {
    extern __shared__ __attribute__((aligned(16))) unsigned char lds_raw[];
    LAS unsigned char* lds = (LAS unsigned char*)lds_raw;
    volatile LAS unsigned* MISC = (volatile LAS unsigned*)(lds + LDS_MISC);
    if (threadIdx.x < 64) MISC[threadIdx.x] = 0u;
    __syncthreads();
    unsigned char* ws = P.ws;
    const int lo = P.ph_lo, hi = P.ph_hi;
    XcdBarrier bar; bar.bar = (unsigned*)(ws + WS_CTL) + CW_BAR; bar.x = 0; bar.st = nullptr;
    if (hi - lo > 1) bar = xcd_barrier_post((unsigned*)(ws + WS_CTL) + CW_BAR, MISC + 8);
#define IN(k) (lo <= (k) && (k) < hi)
#define SEAM(k) do { if (IN(k) && IN((k) + 1)) xcd_barrier(bar); } while (0)
    const int G = gridDim.x, bid = blockIdx.x;
#pragma unroll 1
    for (int l = 0; l < 2; ++l) {
        const int p0 = 10 * l;
        if (IN(p0 + 0)) { phase_pre(P, l, lds); }
        SEAM(p0 + 0);
        if (IN(p0 + 1)) {
            pg8::StaticOrder S; S.init(NTOK / 256, NPROJ / 256, G, bid); AddrPlain AD{DM, 0}; EpiProj E{(bf16_t*)(ws + WS_PROJ)};
            pg8::gemm_phase(lds, (const char*)(ws + WS_HN), (const char*)(ws + WS_WIN), DM, S, AD, E);
        }
        SEAM(p0 + 1);
        if (IN(p0 + 2)) { phase_premix(P, l); }
        SEAM(p0 + 2);
        if (IN(p0 + 3)) { phase_mixers(P, l, lds); }
        SEAM(p0 + 3);
        if (IN(p0 + 4)) { phase_finalize(P, l); }
        SEAM(p0 + 4);
        if (IN(p0 + 5)) {
            pg8::StaticOrder S; S.init(NTOK / 256, DM / 256, G, bid); AddrPlain AD{DM, 0}; EpiRes E{l == 0 ? P.x : (const float*)(ws + WS_XB), (float*)(ws + WS_XB)};
            pg8::gemm_phase(lds, (const char*)(ws + WS_HN), (const char*)(ws + WS_WOUT), DM, S, AD, E);
        }
        SEAM(p0 + 5);
        if (IN(p0 + 6)) { if (EN_MOE) phase_ffnpre(P, l, lds); }
        SEAM(p0 + 6);
        if (IN(p0 + 7)) { if (EN_MOE) phase_topk(P, lds); }
        SEAM(p0 + 7);
        if (IN(p0 + 8)) { if (EN_MOE) {
            pg8::StaticOrder S; S.init(NSLOT / 256, 2048 / 256, G, bid); AddrGateUp AD{(const int*)(ws + WS_SELI)}; EpiGateUp E{(bf16_t*)((unsigned char*)P.out + DO_HDN)};
            pg8::gemm_phase(lds, (const char*)(ws + WS_HN), (const char*)(ws + WS_WGU), DM, S, AD, E); } }
        SEAM(p0 + 8);
        if (IN(p0 + 9)) { if (EN_MOE) {
            pg8::StaticOrder S; S.init(NSLOT / 256, DM / 256, G, bid); AddrDown AD{}; EpiDown E{(bf16_t*)(ws + WS_YE), (const float*)(ws + WS_SELG)};
            pg8::gemm_phase(lds, (const char*)P.out + DO_HDN, (const char*)(ws + WS_WD), DM, S, AD, E); } }
        SEAM(p0 + 9);
    }
    if (IN(20)) phase_final(P);
#undef IN
#undef SEAM
}

#ifndef N_LAUNCH_MODE
#define N_LAUNCH_MODE 1
#endif
extern "C" void kernel_launch(void* const* d_in, const int* in_sizes, int n_in, void* d_out, int out_size, void* d_ws, size_t ws_size, hipStream_t stream) {
    static int grid = 0;
    if (grid == 0) {
        if (n_in != 27 || in_sizes[0] != NTOK * DM || out_size != NTOK * DM || ws_size < WS_END) {
            fprintf(stderr, "kernel_launch: unexpected shapes (n_in %d, in0 %d, out %d, ws %zu, need %zu)\n", n_in, n_in > 0 ? in_sizes[0] : -1, out_size, ws_size, (size_t)WS_END); grid = -1; return; }
        int dev = 0, cus = 0, per_cu = 0;
        if (hipGetDevice(&dev) != hipSuccess || hipDeviceGetAttribute(&cus, hipDeviceAttributeMultiprocessorCount, dev) != hipSuccess) { grid = -1; return; }
        if (hipFuncSetAttribute((const void*)fwd_kernel, hipFuncAttributeMaxDynamicSharedMemorySize, LDS_BYTES) != hipSuccess) { fprintf(stderr, "kernel_launch: hipFuncSetAttribute failed\n"); grid = -1; return; }
        if (hipOccupancyMaxActiveBlocksPerMultiprocessor(&per_cu, (const void*)fwd_kernel, 512, LDS_BYTES) != hipSuccess || per_cu < 1) { fprintf(stderr, "kernel_launch: occupancy query says %d\n", per_cu); (void)hipGetLastError(); }
        grid = cus;
    }
    if (grid < 0) return;
    if (hipMemsetAsync((char*)d_ws + WS_CTL, 0, CTL_ZERO_BYTES, stream) != hipSuccess) return;
    Params p{};
    const float** pp = (const float**)&p;
    for (int i = 0; i < 27; ++i) pp[i] = (const float*)d_in[i];
    p.out = (float*)d_out; p.ws = (unsigned char*)d_ws;
    if (N_LAUNCH_MODE == 1) { p.ph_lo = 0; p.ph_hi = N_PHASES; hipLaunchKernelGGL(fwd_kernel, dim3(grid), dim3(512), LDS_BYTES, stream, p); }
    else for (int k = 0; k < N_PHASES; ++k) { p.ph_lo = k; p.ph_hi = k + 1; hipLaunchKernelGGL(fwd_kernel, dim3(grid), dim3(512), LDS_BYTES, stream, p); }
}
```

```cpp
#define N_LAUNCH_MODE 1
#include <hip/hip_runtime.h>
#include <cstdio>
#include <cstdint>

#define LAS __attribute__((address_space(3)))
#define DI __device__ __forceinline__
typedef unsigned short bf16_t;
typedef short bf16x8 __attribute__((ext_vector_type(8)));
typedef short s16x4 __attribute__((ext_vector_type(4)));
typedef float f32x2 __attribute__((ext_vector_type(2)));
typedef float f32x4 __attribute__((ext_vector_type(4)));
typedef float f32x16 __attribute__((ext_vector_type(16)));
typedef unsigned u32x2 __attribute__((ext_vector_type(2)));
typedef unsigned u32x4 __attribute__((ext_vector_type(4)));
typedef int i32x4 __attribute__((ext_vector_type(4)));
typedef __bf16 bfv2 __attribute__((ext_vector_type(2)));

DI unsigned pk2(float lo, float hi) { f32x2 v = {lo, hi}; return __builtin_bit_cast(unsigned, __builtin_convertvector(v, bfv2)); }
DI unsigned short f2bf(float f) { return (unsigned short)(pk2(f, 0.f) & 0xffffu); }
DI float bf2f(unsigned short b) { return __uint_as_float((unsigned)b << 16); }
DI float bflo(unsigned u) { return __uint_as_float(u << 16); }
DI float bfhi(unsigned u) { return __uint_as_float(u & 0xffff0000u); }
DI float wave_sum(float v) {
#pragma unroll
    for (int o = 1; o < 64; o <<= 1) v += __shfl_xor(v, o);
    return v;
}
DI float silu_f(float x) { return x / (1.0f + __expf(-x)); }
DI float sigmoid_f(float x) { return 1.0f / (1.0f + __expf(-x)); }
DI int tid_opaque() { int t = threadIdx.x; asm volatile("" : "+v"(t)); return t; }
#define LDS_WAIT() asm volatile("s_waitcnt lgkmcnt(0)" ::: "memory")
#define VM_WAIT() asm volatile("s_waitcnt vmcnt(0)" ::: "memory")
#define MFMA32(a, b, c) __builtin_amdgcn_mfma_f32_32x32x16_bf16((a), (b), (c), 0, 0, 0)

constexpr int NB = 32, SEQ = 2048, DM = 1024, NTOK = NB * SEQ;
constexpr int NIN_REF = 3592, NPROJ = 3584;
constexpr int PC_HY = 0, PC_MZ = 768, PC_MX = 1024, PC_AQ = 1536, PC_AK = 1792, PC_AV = 2048, PC_HQ = 2304, PC_HF = 2560, PC_HI = 3072, PC_HG = 3328;
constexpr int NEXP = 16, CAP = 256, NSLOT = NB * NEXP * CAP;
constexpr float EPSN = 1e-6f;

constexpr size_t MiB = 1u << 20;
constexpr size_t WS_CTL = 0, CTL_ZERO_BYTES = 64 * 1024;
constexpr size_t WS_DT = 1 * MiB, WS_AFF = 3 * MiB, WS_SLOT = 7 * MiB, WS_SELI = 11 * MiB, WS_SELG = 11 * MiB + 512 * 1024, WS_KFILT = 12 * MiB, WS_MSQ = 14 * MiB;
constexpr size_t WS_XB = 64 * MiB, WS_WIN = 320 * MiB, WS_WOUT = 327 * MiB, WS_WGU = 329 * MiB, WS_WD = 393 * MiB, WS_HN = 432 * MiB, WS_PROJ = 560 * MiB, WS_YE = WS_PROJ, WS_END = 1008 * MiB;
constexpr size_t DO_HW = 0, DO_HX0 = 32 * MiB, DO_YAT = 64 * MiB, DO_MXBC = 96 * MiB, DO_MY = 160 * MiB, DO_MST = 192 * MiB, DO_HST = 224 * MiB, DO_HDN = 0;
constexpr int CW_BAR = 1024;

constexpr int LDS_MISC = 147456, LDS_BYTES = LDS_MISC + 256;

struct Params {
    const float *x, *w_in, *w_out, *norm_mix_w, *norm_ffn_w, *hy_conv_w, *hy_w1, *hy_b1, *hy_w2, *hy_b2, *hy_freq, *hy_w3, *hy_fbias,
                *m_conv_w, *m_conv_b, *m_dt_bias, *m_A_log, *m_D, *m_norm_w, *rel_bias, *hg_lb, *hg_norm_w, *router_w, *moe_wg, *moe_wu, *moe_wd, *final_w;
    float* out; unsigned char* ws;
    int ph_lo, ph_hi;
};

#define XB_TMO      128
#define XB_XCNT(j)  (256  + 64 * (j))
#define XB_XSUB(j)  (1280 + 64 * (j))
#define XB_XGEN(j)  (2304 + 64 * (j))
#define XB_TOP      3328
#define XB_TOPGEN   3392
#define XCD_BAR_WORDS 3456
#define XB_SPIN_CAP (1u << 18)
__device__ __forceinline__ unsigned xb_ld(unsigned* p)              { return __hip_atomic_load(p, __ATOMIC_RELAXED, __HIP_MEMORY_SCOPE_AGENT); }
__device__ __forceinline__ unsigned xb_add(unsigned* p, unsigned v) { return __hip_atomic_fetch_add(p, v, __ATOMIC_RELAXED, __HIP_MEMORY_SCOPE_AGENT); }
__device__ __forceinline__ unsigned xb_xcc_id() { return (unsigned)__builtin_amdgcn_s_getreg((3 << 11) | 20) & 0xFu; }
#define XB_SPIN(cond, bar) do { unsigned _sp = 0; while (cond) { __builtin_amdgcn_s_sleep(1); \
    if ((++_sp & 255u) == 0u) { if (xb_ld(&(bar)[XB_TMO])) break; if (_sp > XB_SPIN_CAP) { atomicAdd(&(bar)[XB_TMO], 1u); break; } } } } while (0)
struct XcdBarrier { unsigned* bar; unsigned x; volatile LAS unsigned* st; };
__device__ __forceinline__ XcdBarrier xcd_barrier_post(unsigned* bar, volatile LAS unsigned* st) {
    XcdBarrier b; b.bar = bar; b.x = xb_xcc_id(); b.st = st;
    if (threadIdx.x == 0) (void)xb_add(&bar[XB_XCNT(b.x)], 1u);
    return b;
}
__device__ __forceinline__ void xcd_barrier_complete(unsigned* bar, unsigned x, unsigned& nloc, unsigned& nx) {
    const unsigned G = gridDim.x * gridDim.y * gridDim.z;
    unsigned sum, cnt, mine, sp = 0u;
    for (;;) {
        sum = 0u; cnt = 0u; mine = 0u;
#pragma unroll
        for (unsigned j = 0; j < 16; ++j) { const unsigned c = xb_ld(&bar[XB_XCNT(j)]); sum += c; cnt += (c > 0u) ? 1u : 0u; mine = (j == x) ? c : mine; }
        if (sum == G) break;
        __builtin_amdgcn_s_sleep(1);
        if ((++sp & 255u) == 0u) { if (xb_ld(&bar[XB_TMO])) break; if (sp > XB_SPIN_CAP) { atomicAdd(&bar[XB_TMO], 1u); break; } }
    }
    nloc = mine > 0u ? mine : 1u; nx = cnt > 0u ? cnt : 1u;
}
__device__ __forceinline__ void xcd_barrier(const XcdBarrier& b) {
    asm volatile("s_waitcnt vmcnt(0)" ::: "memory");
    __syncthreads();
    if (threadIdx.x == 0) {
        unsigned* bar = b.bar;
        __builtin_amdgcn_s_waitcnt(0);
        unsigned nloc = b.st[0], nx = b.st[1];
        if (nloc == 0u) { xcd_barrier_complete(bar, b.x, nloc, nx); b.st[0] = nloc; b.st[1] = nx; }
        const unsigned old = xb_add(&bar[XB_XSUB(b.x)], 1u);
        const unsigned gen = old / nloc;
        if (old + 1u == (gen + 1u) * nloc) {
            __builtin_amdgcn_fence(__ATOMIC_RELEASE, "agent");
            asm volatile("s_waitcnt vmcnt(0)" ::: "memory");
            const unsigned og = xb_add(&bar[XB_TOP], 1u);
            const unsigned tg = og / nx;
            if (og + 1u == (tg + 1u) * nx) xb_add(&bar[XB_TOPGEN], 1u);
            else XB_SPIN(xb_ld(&bar[XB_TOPGEN]) == tg, bar);
            __builtin_amdgcn_fence(__ATOMIC_ACQUIRE, "agent");
            xb_add(&bar[XB_XGEN(b.x)], 1u);
            asm volatile("s_waitcnt vmcnt(0)" ::: "memory");
        } else {
            XB_SPIN(xb_ld(&bar[XB_XGEN(b.x)]) == gen, bar);
            __builtin_amdgcn_fence(__ATOMIC_ACQUIRE, "agent");
            asm volatile("s_waitcnt vmcnt(0)" ::: "memory");
        }
    }
    __syncthreads();
}

namespace pg8 {
constexpr int BM = 256, BK = 64, HALF = 128, HTB = HALF * BK * 2, STAGE_BYTES = 8 * HTB, NXCD = 8, WGM = 8;
__host__ __device__ __forceinline__ int lds_byte(int r, int c) { const int st = (r >> 4) * 2 + (c >> 5), rr = r & 15, cc = c & 31, ob = rr * 64 + cc * 2; return st * 1024 + (ob ^ (((ob >> 9) & 1) << 5)); }
__host__ __device__ __forceinline__ void stage_rc(int b, int& R, int& C) { const int st = b / 1024, sb = b % 1024, swz = sb ^ (((sb >> 9) & 1) << 5); R = (st >> 1) * 16 + swz / 64; C = (st & 1) * 32 + (swz % 64) / 2; }
__host__ __device__ __forceinline__ int perm32(int rho) { const int n = rho >> 4, i = rho & 15; return 8 * (i >> 2) + 4 * n + (i & 3); }
struct Unit { int pm, pn; };
struct StaticOrder {
    int nM, nN, nwg, G, c;
    __device__ void init(int nM_, int nN_, int G_, int c_) { nM = nM_; nN = nN_; nwg = nM * nN; G = G_; c = c_; }
    __device__ bool next(int i, Unit& u) const {
        const long L = (long)i * G + c; if (L >= nwg) return false;
        int wgid = (int)L; { const int q = nwg / NXCD, r = nwg % NXCD, xcd = wgid % NXCD, off = wgid / NXCD; wgid = (xcd < r ? xcd * (q + 1) : r * (q + 1) + (xcd - r) * q) + off; }
        const int nig = WGM * nN, gid = wgid / nig, fm = gid * WGM, gsz = (nM - fm) < WGM ? (nM - fm) : WGM;
        u.pm = fm + ((wgid % nig) % gsz); u.pn = (wgid % nig) / gsz; return true;
    }
};
template <class Epi, class Sched, class Addr>
__device__ __forceinline__ void gemm_phase(LAS unsigned char* lds, const char* Abase, const char* Bbase, int K, const Sched& S, const Addr& AD, const Epi& E) {
    const int tid = tid_opaque(), wid = __builtin_amdgcn_readfirstlane(tid >> 6), lane = tid & 63, wr = wid >> 2, wc = wid & 3, fr = lane & 15, fq = lane >> 4;
    const int nt = K / BK;
    int Rr[2]; unsigned Cc[2], voffB[2], voffA[2];
#pragma unroll
    for (int i = 0; i < 2; ++i) { int R, C; stage_rc(tid * 16 + i * 8192, R, C); const int Rb = Epi::PERM ? ((R & ~31) + perm32(R & 31)) : R;
        Rr[i] = R; Cc[i] = (unsigned)C * 2u; voffA[i] = (unsigned)(R * K + C) * 2u; voffB[i] = (unsigned)(Rb * K + C) * 2u; }
    const size_t kstep = (size_t)(BK * 2);
    const size_t hstep = (size_t)HALF * K * 2;
    const unsigned ldsw = (unsigned)wid * 1024u;
    const int aoff = lds_byte(wr * 64 + fr, fq * 8), boff = lds_byte(wc * 32 + fr, fq * 8);
#define PG8_SA(b, h) (((b) * 2 + (h)) * HTB)
#define PG8_SB(b, h) ((4 + (b) * 2 + (h)) * HTB)
#define PG8_STAGE(bufoff, gbase, voff) do { _Pragma("unroll") for (int _i = 0; _i < 2; ++_i) \
        __builtin_amdgcn_global_load_lds((const unsigned*)((const char*)(gbase) + (voff)[_i]), (LAS unsigned*)(lds + (bufoff) + ldsw + _i * 8192), 16, 0, 0); } while (0)
#define PG8_STAGE_A(bufoff, kb, h, un) do { if constexpr (Addr::LOADS) { _Pragma("unroll") for (int _i = 0; _i < 2; ++_i) \
        __builtin_amdgcn_global_load_lds((const unsigned*)(Abase + (kb) + ((un) ? on[h][_i] : oc[h][_i])), (LAS unsigned*)(lds + (bufoff) + ldsw + _i * 8192), 16, 0, 0); } \
      else { const char* _ab = ((un) ? nA : cA) + (kb) + (size_t)(h) * hstep; _Pragma("unroll") for (int _i = 0; _i < 2; ++_i) \
        __builtin_amdgcn_global_load_lds((const unsigned*)(_ab + voffA[_i]), (LAS unsigned*)(lds + (bufoff) + ldsw + _i * 8192), 16, 0, 0); } } while (0)
#define PG8_LDA(dst, b, h) do { _Pragma("unroll") for (int m = 0; m < 4; ++m) _Pragma("unroll") for (int k = 0; k < 2; ++k) dst[m][k] = *(const LAS bf16x8*)(lds + PG8_SA(b, h) + aoff + m * 2048 + k * 1024); } while (0)
#define PG8_LDB(dst, b, h) do { _Pragma("unroll") for (int n = 0; n < 2; ++n) _Pragma("unroll") for (int k = 0; k < 2; ++k) dst[n][k] = *(const LAS bf16x8*)(lds + PG8_SB(b, h) + boff + n * 2048 + k * 1024); } while (0)
#define PG8_MMA(ai, bj, At, Bt) do { __builtin_amdgcn_s_setprio(1); _Pragma("unroll") for (int m = 0; m < 4; ++m) _Pragma("unroll") for (int n = 0; n < 2; ++n) _Pragma("unroll") for (int k = 0; k < 2; ++k) \
        acc[ai][bj][m][n] = __builtin_amdgcn_mfma_f32_16x16x32_bf16(Bt[n][k], At[m][k], acc[ai][bj][m][n], 0, 0, 0); __builtin_amdgcn_s_setprio(0); } while (0)
#define PG8_WAIT_V(n) asm volatile("s_waitcnt vmcnt(" #n ")" ::: "memory")
#define PG8_WAIT_L(n) asm volatile("s_waitcnt lgkmcnt(" #n ")" ::: "memory")
#define PG8_BAR __builtin_amdgcn_s_barrier()
#define PG8_SCHED __builtin_amdgcn_sched_barrier(0)
    Unit cur, nxt; int ui = 0;
    if (!S.next(0, cur)) return;
    f32x4 acc[2][2][4][2];
#pragma unroll
    for (int a = 0; a < 2; ++a)
#pragma unroll
        for (int b = 0; b < 2; ++b)
#pragma unroll
            for (int m = 0; m < 4; ++m)
#pragma unroll
                for (int n = 0; n < 2; ++n) acc[a][b][m][n] = (f32x4){0.f, 0.f, 0.f, 0.f};
    bf16x8 At[4][2], B0[2][2], B1[2][2];
    unsigned oc[2][2], on[2][2];
    const char* cA = Abase; const char* nA = Abase;
    if constexpr (Addr::LOADS) {
#pragma unroll
        for (int h = 0; h < 2; ++h)
#pragma unroll
            for (int i = 0; i < 2; ++i) { oc[h][i] = AD.arow(cur, h * HALF + Rr[i]) + Cc[i]; on[h][i] = oc[h][i]; }
        PG8_WAIT_V(0);
    } else { cA = Abase + AD.arow(cur, 0); nA = cA; }
    const char* cB = Bbase + AD.boff(cur);
    PG8_STAGE(PG8_SB(0, 0), cB, voffB); PG8_STAGE_A(PG8_SA(0, 0), 0, 0, false); PG8_STAGE(PG8_SB(0, 1), cB + hstep, voffB); PG8_STAGE_A(PG8_SA(0, 1), 0, 1, false);
    if (wr == 1) PG8_BAR;
    PG8_WAIT_V(4); PG8_BAR;
    PG8_STAGE(PG8_SB(1, 0), cB + kstep, voffB); PG8_STAGE_A(PG8_SA(1, 0), kstep, 0, false); PG8_STAGE(PG8_SB(1, 1), cB + hstep + kstep, voffB);
    PG8_WAIT_V(6); PG8_BAR;
    for (;;) {
        const bool has_next = S.next(ui + 1, nxt);
        if (has_next) {
            if constexpr (Addr::LOADS) {
#pragma unroll
                for (int h = 0; h < 2; ++h)
#pragma unroll
                    for (int i = 0; i < 2; ++i) on[h][i] = AD.arow(nxt, h * HALF + Rr[i]) + Cc[i];
                PG8_WAIT_V(0);
            } else nA = Abase + AD.arow(nxt, 0);
        } else nA = cA;
        const char* nB = has_next ? Bbase + AD.boff(nxt) : cB;
        for (int t = 0; t < nt; t += 2) {
            const bool last = (t == nt - 2);
            const bool un = last && has_next;
            const size_t k1 = (size_t)(t + 1) * kstep;
            const size_t k2 = last ? 0 : (size_t)(t + 2) * kstep, k3 = k2 + kstep;
            const char* b2 = last ? nB : cB + (size_t)(t + 2) * kstep;
            const char* b3 = b2 + kstep;
            PG8_LDB(B0, 0, 0); PG8_SCHED; PG8_LDA(At, 0, 0); PG8_STAGE_A(PG8_SA(1, 1), k1, 1, false);
            PG8_WAIT_L(8); PG8_BAR; PG8_WAIT_L(0); PG8_MMA(0, 0, At, B0); PG8_BAR; PG8_SCHED;
            PG8_LDB(B1, 0, 1); PG8_STAGE(PG8_SB(0, 0), b2, voffB);
            PG8_BAR; PG8_WAIT_L(0); PG8_MMA(0, 1, At, B1); PG8_BAR;
            PG8_LDA(At, 0, 1); PG8_STAGE_A(PG8_SA(0, 0), k2, 0, un);
            PG8_BAR; PG8_WAIT_L(0); PG8_MMA(1, 0, At, B0); PG8_BAR; PG8_SCHED;
            PG8_STAGE(PG8_SB(0, 1), b2 + hstep, voffB);
            PG8_WAIT_V(6); PG8_BAR; PG8_MMA(1, 1, At, B1); PG8_BAR;
            PG8_LDB(B0, 1, 0); PG8_SCHED; PG8_LDA(At, 1, 0); PG8_STAGE_A(PG8_SA(0, 1), k2, 1, un);
            PG8_WAIT_L(8); PG8_BAR; PG8_WAIT_L(0); PG8_MMA(0, 0, At, B0); PG8_BAR; PG8_SCHED;
            PG8_LDB(B1, 1, 1); PG8_STAGE(PG8_SB(1, 0), b3, voffB);
            PG8_BAR; PG8_WAIT_L(0); PG8_MMA(0, 1, At, B1); PG8_BAR;
            PG8_LDA(At, 1, 1); PG8_STAGE_A(PG8_SA(1, 0), k3, 0, un);
            PG8_BAR; PG8_WAIT_L(0); PG8_MMA(1, 0, At, B0); PG8_BAR; PG8_SCHED;
            PG8_STAGE(PG8_SB(1, 1), b3 + hstep, voffB);
            PG8_WAIT_V(6); PG8_BAR; PG8_MMA(1, 1, At, B1); PG8_BAR;
        }
        E(acc, cur, wr, wc, fr, fq);
        if (!has_next) break;
#pragma unroll
        for (int a = 0; a < 2; ++a)
#pragma unroll
            for (int b = 0; b < 2; ++b)
#pragma unroll
                for (int m = 0; m < 4; ++m)
#pragma unroll
                    for (int n = 0; n < 2; ++n) acc[a][b][m][n] = (f32x4){0.f, 0.f, 0.f, 0.f};
        cur = nxt; cB = nB; cA = nA; ++ui;
        if constexpr (Addr::LOADS) {
#pragma unroll
            for (int h = 0; h < 2; ++h)
#pragma unroll
                for (int i = 0; i < 2; ++i) oc[h][i] = on[h][i]; }
    }
    PG8_WAIT_V(0);
    if (wr == 0) PG8_BAR;
    PG8_BAR;
#undef PG8_SA
#undef PG8_SB
#undef PG8_STAGE
#undef PG8_STAGE_A
#undef PG8_LDA
#undef PG8_LDB
#undef PG8_MMA
#undef PG8_WAIT_V
#undef PG8_WAIT_L
#undef PG8_BAR
#undef PG8_SCHED
}
}

#ifndef EN_HY
#define EN_HY 1
#endif
#ifndef EN_MA
#define EN_MA 1
#endif
#ifndef EN_AT
#define EN_AT 1
#endif
#ifndef EN_HG
#define EN_HG 1
#endif
#ifndef EN_MOE
#define EN_MOE 1
#endif

DI void transpose_item(const float* W, int ld, int k0, int n0, bf16_t* dst, int drow0, float scale, LAS float* scr, int lane) {
#pragma unroll 8
    for (int i = 0; i < 32; ++i) { const int kk = 2 * i + (lane >> 5); scr[kk * 33 + (lane & 31)] = W[(size_t)(k0 + kk) * ld + n0 + (lane & 31)]; }
    LDS_WAIT();
    const int c = lane & 7;
#pragma unroll
    for (int j = 0; j < 4; ++j) { const int n = (lane >> 3) + 8 * j; const LAS float* s = scr + (8 * c) * 33 + n;
        u32x4 o; o.x = pk2(s[0 * 33] * scale, s[1 * 33] * scale); o.y = pk2(s[2 * 33] * scale, s[3 * 33] * scale); o.z = pk2(s[4 * 33] * scale, s[5 * 33] * scale); o.w = pk2(s[6 * 33] * scale, s[7 * 33] * scale);
        *(u32x4*)(dst + (size_t)(drow0 + n) * 1024 + k0 + 8 * c) = o; }
    LDS_WAIT();
}

DI void hyena_filter_pos(const Params& P, int l, int pos, int lane, bf16_t* kfilt) {
    const float TWO_PI = 6.283185307179586f;
    const float tpos = (float)pos * (1.0f / 2047.0f);
    float z = 0.f;
    if (lane == 0) z = tpos;
    else if (lane <= 32) { const int bnd = (lane - 1) & 15; const float f = 1e-4f + (float)bnd * ((15.0f - 1e-4f) / 15.0f);
        const float angp = TWO_PI * (float)pos / 2048.0f; const float ang = angp * f; z = (lane <= 16) ? cosf(ang) : -sinf(ang); }
    const float* w1 = P.hy_w1 + (size_t)l * 33 * 64; const float* w2 = P.hy_w2 + (size_t)l * 64 * 64; const float* w3 = P.hy_w3 + (size_t)l * 64 * 512;
    const float fr = P.hy_freq[l * 64 + lane];
    float a = P.hy_b1[l * 64 + lane];
    for (int i = 0; i < 33; ++i) a += __shfl(z, i) * w1[i * 64 + lane];
    const float h1 = sinf(fr * a);
    float a2 = P.hy_b2[l * 64 + lane];
    for (int i = 0; i < 64; ++i) a2 += __shfl(h1, i) * w2[i * 64 + lane];
    const float h2 = sinf(fr * a2);
    float h3[8];
#pragma unroll
    for (int k = 0; k < 8; ++k) h3[k] = 0.f;
    for (int i = 0; i < 64; ++i) { const float hv = __shfl(h2, i);
#pragma unroll
        for (int k = 0; k < 8; ++k) h3[k] += hv * w3[i * 512 + k * 64 + lane]; }
    const float min_decay = -3.0701134573253944f, max_decay = -15.350567286626972f;
#pragma unroll
    for (int k = 0; k < 8; ++k) { const int cp = k * 64 + lane, c = cp & 255;
        const float delta = fabsf(min_decay + (float)c * ((max_decay - min_decay) / 255.0f));
        float v = h3[k] * expf(-tpos * delta);
        if (cp < 256) { if (pos == 0) { v += P.hy_fbias[l * 256 + c]; kfilt[(size_t)c * 4096 + 4095] = 0; } kfilt[(size_t)c * 4096 + 2047 - pos] = f2bf(v); }
        else if (pos >= 1) kfilt[(size_t)c * 4096 + 2047 + pos] = f2bf(v); }
}

template <bool FINAL>
DI void pre_row(const Params& P, int l, int m, int lane, const LAS f32x4* dtw, const float* nw) {
    unsigned char* ws = P.ws;
    float* XB = (float*)(ws + WS_XB);
    const bool first = (!FINAL && l == 0);
    const float* src = first ? P.x : XB;
    const f32x4* xr = (const f32x4*)(src + (size_t)m * DM) + lane;
    f32x4 v[4];
#pragma unroll
    for (int j = 0; j < 4; ++j) v[j] = xr[64 * j];
    if (!first && EN_MOE) {
        const int* slot = (const int*)(ws + WS_SLOT) + (size_t)m * 16; const int b = m >> 11;
        const bf16_t* YE = (const bf16_t*)(ws + WS_YE);
        for (int e = 0; e < 16; ++e) { const int s = __builtin_amdgcn_readfirstlane(slot[e]);
            if (s >= 0) { const u32x2* yr = (const u32x2*)(YE + ((size_t)((b * 16 + e) * 256 + s)) * DM) + lane;
#pragma unroll
                for (int j = 0; j < 4; ++j) { const u32x2 y = yr[64 * j]; v[j].x += bflo(y.x); v[j].y += bfhi(y.x); v[j].z += bflo(y.y); v[j].w += bfhi(y.y); } } }
    }
    float s = 0.f;
#pragma unroll
    for (int j = 0; j < 4; ++j) s += (v[j].x * v[j].x + v[j].y * v[j].y) + (v[j].z * v[j].z + v[j].w * v[j].w);
    const float r = 1.0f / sqrtf(wave_sum(s) * (1.0f / DM) + EPSN);
    if (FINAL) {
        f32x4* o = (f32x4*)(P.out + (size_t)m * DM) + lane;
#pragma unroll
        for (int j = 0; j < 4; ++j) { const f32x4 w = ((const f32x4*)nw)[64 * j + lane]; o[64 * j] = v[j] * r * w; }
        return;
    }
    if (!first) { f32x4* o = (f32x4*)(XB + (size_t)m * DM) + lane;
#pragma unroll
        for (int j = 0; j < 4; ++j) o[64 * j] = v[j]; }
    float d[8];
#pragma unroll
    for (int c = 0; c < 8; ++c) d[c] = 0.f;
#pragma unroll
    for (int j = 0; j < 4; ++j) {
        const float xv[4] = {v[j].x, v[j].y, v[j].z, v[j].w};
#pragma unroll
        for (int q = 0; q < 4; ++q) { const f32x4 w0 = dtw[((j * 4 + q) * 2 + 0) * 64 + lane], w1 = dtw[((j * 4 + q) * 2 + 1) * 64 + lane];
            d[0] += xv[q] * w0.x; d[1] += xv[q] * w0.y; d[2] += xv[q] * w0.z; d[3] += xv[q] * w0.w; d[4] += xv[q] * w1.x; d[5] += xv[q] * w1.y; d[6] += xv[q] * w1.z; d[7] += xv[q] * w1.w; }
    }
    float mine = 0.f;
#pragma unroll
    for (int c = 0; c < 8; ++c) { const float t = wave_sum(d[c]); mine = (lane == c) ? t : mine; }
    if (lane < 8) ((float*)(ws + WS_DT))[(size_t)m * 8 + lane] = mine * r;
    u32x2* o8 = (u32x2*)((bf16_t*)(ws + WS_HN) + (size_t)m * DM) + lane;
#pragma unroll
    for (int j = 0; j < 4; ++j) { const f32x4 w = ((const f32x4*)nw)[64 * j + lane]; u32x2 o; o.x = pk2(v[j].x * r * w.x, v[j].y * r * w.y); o.y = pk2(v[j].z * r * w.z, v[j].w * r * w.w); o8[64 * j] = o; }
}

DI void phase_pre(const Params& P, int l, LAS unsigned char* lds) {
    const int tid = tid_opaque(), lane = tid & 63, wave = tid >> 6;
    const int gw = blockIdx.x * 8 + wave, NGW = gridDim.x * 8;
    unsigned char* ws = P.ws;
    LAS float* dtwf = (LAS float*)lds;
    for (int i = tid; i < 1024 * 8; i += 512) { const int k = i >> 3, c = i & 7; const int j = k >> 8, ln = (k & 255) >> 2, q = k & 3;
        dtwf[((((j * 4 + q) * 2 + (c >> 2)) * 64 + ln) << 2) + (c & 3)] = P.norm_mix_w[l * DM + k] * P.w_in[((size_t)l * DM + k) * NIN_REF + 1536 + c]; }
    __syncthreads();
    if (EN_HY) for (int pos = gw; pos < SEQ; pos += NGW) hyena_filter_pos(P, l, pos, lane, (bf16_t*)(ws + WS_KFILT));
    {
        LAS float* scr = (LAS float*)(lds + 32768 + wave * 8448);
        constexpr int I_A = 16 * 48, I_B = 16 * 64, I_O = 16 * 32, I_E = 16 * 32 * 16;
        constexpr int NITEMS = I_A + I_B + I_O + 3 * I_E;
        bf16_t* WinT = (bf16_t*)(ws + WS_WIN); bf16_t* WoutT = (bf16_t*)(ws + WS_WOUT); bf16_t* WguT = (bf16_t*)(ws + WS_WGU); bf16_t* WdT = (bf16_t*)(ws + WS_WD);
        for (int it = gw; it < NITEMS; it += NGW) {
            int r = it;
            if (r < I_A) { const int kb = r / 48, nb = r % 48; transpose_item(P.w_in + (size_t)l * DM * NIN_REF, NIN_REF, 64 * kb, 32 * nb, WinT, 32 * nb, 1.0f, scr, lane); continue; } r -= I_A;
            if (r < I_B) { const int kb = r / 64, nb = r % 64; const int drow = 1536 + 32 * nb; transpose_item(P.w_in + (size_t)l * DM * NIN_REF, NIN_REF, 64 * kb, 1544 + 32 * nb, WinT, drow, drow < PC_AK ? 0.125f : 1.0f, scr, lane); continue; } r -= I_B;
            if (r < I_O) { const int kb = r / 32, nb = r % 32; transpose_item(P.w_out + (size_t)l * DM * DM, DM, 64 * kb, 32 * nb, WoutT, 32 * nb, 1.0f, scr, lane); continue; } r -= I_O;
            const int which = r / I_E; r -= which * I_E;
            const int e = r / 512, kb = (r % 512) / 32, nb = r % 32;
            const size_t wofs = ((size_t)l * NEXP + e) * DM * DM;
            if (which == 0)      transpose_item(P.moe_wg + wofs, DM, 64 * kb, 32 * nb, WguT, e * 2048 + ((32 * nb) >> 7) * 256 + ((32 * nb) & 127), 1.0f, scr, lane);
            else if (which == 1) transpose_item(P.moe_wu + wofs, DM, 64 * kb, 32 * nb, WguT, e * 2048 + ((32 * nb) >> 7) * 256 + 128 + ((32 * nb) & 127), 1.0f, scr, lane);
            else                 transpose_item(P.moe_wd + wofs, DM, 64 * kb, 32 * nb, WdT, e * 1024 + 32 * nb, 1.0f, scr, lane);
        }
    }
    const float* nw = P.norm_mix_w + l * DM;
    for (int m = gw; m < NTOK; m += NGW) { asm volatile("" ::: "memory"); pre_row<false>(P, l, m, lane, (const LAS f32x4*)dtwf, nw); }
}
DI void phase_final(const Params& P) {
    const int tid = tid_opaque(), lane = tid & 63, wave = tid >> 6;
    const int gw = blockIdx.x * 8 + wave, NGW = gridDim.x * 8;
    for (int m = gw; m < NTOK; m += NGW) pre_row<true>(P, 1, m, lane, nullptr, P.final_w);
}

struct AddrPlain { static constexpr bool LOADS = false; int K; int nb_rows;
    DI unsigned arow(const pg8::Unit& u, int r) const { return (unsigned)(u.pm * 256 + r) * (unsigned)(K * 2); }
    DI size_t boff(const pg8::Unit& u) const { return (size_t)u.pn * 256 * K * 2; } };
struct AddrGateUp { static constexpr bool LOADS = true; const int* seli;
    DI unsigned arow(const pg8::Unit& u, int r) const { const int b = u.pm >> 4; const int t = seli[u.pm * 256 + r]; return (unsigned)(b * SEQ + t) * (unsigned)(DM * 2); }
    DI size_t boff(const pg8::Unit& u) const { return ((size_t)(u.pm & 15) * 2048 + (size_t)u.pn * 256) * DM * 2; } };
struct AddrDown { static constexpr bool LOADS = false;
    DI unsigned arow(const pg8::Unit& u, int r) const { return (unsigned)(u.pm * 256 + r) * (unsigned)(DM * 2); }
    DI size_t boff(const pg8::Unit& u) const { return ((size_t)(u.pm & 15) * 1024 + (size_t)u.pn * 256) * DM * 2; } };

struct EpiProj { static constexpr bool PERM = true; bf16_t* O;
    DI void operator()(const f32x4 (&acc)[2][2][4][2], const pg8::Unit& u, int wr, int wc, int fr, int fq) const {
        const int row0 = u.pm * 256 + wr * 64 + fr, col0 = u.pn * 256 + wc * 32 + 8 * fq;
#pragma unroll
        for (int ai = 0; ai < 2; ++ai)
#pragma unroll
            for (int m = 0; m < 4; ++m) { bf16_t* rowp = O + (size_t)(row0 + ai * 128 + m * 16) * NPROJ + col0;
#pragma unroll
                for (int bj = 0; bj < 2; ++bj) { const f32x4 v0 = acc[ai][bj][m][0], v1 = acc[ai][bj][m][1];
                    u32x4 w; w.x = pk2(v0[0], v0[1]); w.y = pk2(v0[2], v0[3]); w.z = pk2(v1[0], v1[1]); w.w = pk2(v1[2], v1[3]);
                    *(u32x4*)(rowp + bj * 128) = w; } }
    } };
struct EpiRes { static constexpr bool PERM = false; const float* base; float* out;
    DI void operator()(const f32x4 (&acc)[2][2][4][2], const pg8::Unit& u, int wr, int wc, int fr, int fq) const {
        const int row0 = u.pm * 256 + wr * 64 + fr, col0 = u.pn * 256 + wc * 32 + 4 * fq;
#pragma unroll
        for (int ai = 0; ai < 2; ++ai)
#pragma unroll
            for (int m = 0; m < 4; ++m) { const size_t off = (size_t)(row0 + ai * 128 + m * 16) * DM + col0;
#pragma unroll
                for (int bj = 0; bj < 2; ++bj)
#pragma unroll
                    for (int n = 0; n < 2; ++n) { const f32x4 bs = *(const f32x4*)(base + off + bj * 128 + n * 16); *(f32x4*)(out + off + bj * 128 + n * 16) = bs + acc[ai][bj][m][n]; } }
    } };
struct EpiGateUp { static constexpr bool PERM = true; bf16_t* H;
    DI void operator()(const f32x4 (&acc)[2][2][4][2], const pg8::Unit& u, int wr, int wc, int fr, int fq) const {
        const int row0 = u.pm * 256 + wr * 64 + fr, col0 = u.pn * 128 + wc * 32 + 8 * fq;
#pragma unroll
        for (int ai = 0; ai < 2; ++ai)
#pragma unroll
            for (int m = 0; m < 4; ++m) { bf16_t* rowp = H + (size_t)(row0 + ai * 128 + m * 16) * DM + col0;
                float hv[8];
#pragma unroll
                for (int n = 0; n < 2; ++n)
#pragma unroll
                    for (int j = 0; j < 4; ++j) { const float g = acc[ai][0][m][n][j], up = acc[ai][1][m][n][j]; hv[n * 4 + j] = silu_f(g) * up; }
                u32x4 w; w.x = pk2(hv[0], hv[1]); w.y = pk2(hv[2], hv[3]); w.z = pk2(hv[4], hv[5]); w.w = pk2(hv[6], hv[7]);
                *(u32x4*)rowp = w; }
    } };
struct EpiDown { static constexpr bool PERM = true; bf16_t* Y; const float* gate;
    DI void operator()(const f32x4 (&acc)[2][2][4][2], const pg8::Unit& u, int wr, int wc, int fr, int fq) const {
        const int row0 = u.pm * 256 + wr * 64 + fr, col0 = u.pn * 256 + wc * 32 + 8 * fq;
#pragma unroll
        for (int ai = 0; ai < 2; ++ai)
#pragma unroll
            for (int m = 0; m < 4; ++m) { const int row = row0 + ai * 128 + m * 16; const float g = gate[row]; bf16_t* rowp = Y + (size_t)row * DM + col0;
#pragma unroll
                for (int bj = 0; bj < 2; ++bj) { const f32x4 v0 = acc[ai][bj][m][0] * g, v1 = acc[ai][bj][m][1] * g;
                    u32x4 w; w.x = pk2(v0[0], v0[1]); w.y = pk2(v0[2], v0[3]); w.z = pk2(v1[0], v1[1]); w.w = pk2(v1[2], v1[3]);
                    *(u32x4*)(rowp + bj * 128) = w; } }
    } };

DI void phase_premix(const Params& P, int l) {
    const int tid = tid_opaque(), lane = tid & 63, wave = tid >> 6;
    const int gw = blockIdx.x * 8 + wave, NGW = gridDim.x * 8;
    unsigned char* ws = P.ws;
    const bf16_t* proj = (const bf16_t*)(ws + WS_PROJ);
    unsigned char* dsc = (unsigned char*)P.out;
    if (EN_HY) {
        bf16_t* HW = (bf16_t*)(dsc + DO_HW); bf16_t* HX0 = (bf16_t*)(dsc + DO_HX0);
        const float* cw = P.hy_conv_w + (size_t)l * 3 * 768;
        for (int it = gw; it < NB * 32 * 4; it += NGW) {
            const int ct = it & 3, tt = (it >> 2) & 31, b = it >> 7;
            const int c = ct * 64 + lane, t0 = tt * 64;
            float w0[3], w1[3], w2[3];
#pragma unroll
            for (int j = 0; j < 3; ++j) { w0[j] = cw[j * 768 + c]; w1[j] = cw[j * 768 + 256 + c]; w2[j] = cw[j * 768 + 512 + c]; }
            const bf16_t* pr = proj + (size_t)b * SEQ * NPROJ + c;
            bf16_t* hwp = HW + ((size_t)c * NB + b) * SEQ + t0; bf16_t* hxp = HX0 + ((size_t)c * NB + b) * SEQ + t0;
            float a0, a1, a2, b0, b1, b2, c0, c1, c2;
            { const int t = t0 - 1; const bool ok = t >= 0; const bf16_t* q = pr + (size_t)(ok ? t : 0) * NPROJ; a0 = ok ? bf2f(q[0]) : 0.f; a1 = ok ? bf2f(q[256]) : 0.f; a2 = ok ? bf2f(q[512]) : 0.f; }
            { const bf16_t* q = pr + (size_t)t0 * NPROJ; b0 = bf2f(q[0]); b1 = bf2f(q[256]); b2 = bf2f(q[512]); }
#pragma unroll 1
            for (int t8 = 0; t8 < 64; t8 += 8) {
                unsigned hwv[4], hxv[4]; float ph = 0.f, px = 0.f;
#pragma unroll
                for (int i = 0; i < 8; ++i) { const int t = t0 + t8 + i + 1; const bool ok = t < SEQ; const bf16_t* q = pr + (size_t)(ok ? t : SEQ - 1) * NPROJ;
                    c0 = ok ? bf2f(q[0]) : 0.f; c1 = ok ? bf2f(q[256]) : 0.f; c2 = ok ? bf2f(q[512]) : 0.f;
                    const float u0 = w0[0] * a0 + w0[1] * b0 + w0[2] * c0, u1 = w1[0] * a1 + w1[1] * b1 + w1[2] * c1, u2 = w2[0] * a2 + w2[1] * b2 + w2[2] * c2;
                    const float hv = u2 * u1;
                    if (i & 1) { hwv[i >> 1] = pk2(ph, hv); hxv[i >> 1] = pk2(px, u0); } else { ph = hv; px = u0; }
                    a0 = b0; a1 = b1; a2 = b2; b0 = c0; b1 = c1; b2 = c2; }
                *(u32x4*)(hwp + t8) = (u32x4){hwv[0], hwv[1], hwv[2], hwv[3]}; *(u32x4*)(hxp + t8) = (u32x4){hxv[0], hxv[1], hxv[2], hxv[3]};
            }
        }
    }
    if (EN_MA) {
        bf16_t* MX = (bf16_t*)(dsc + DO_MXBC);
        const float* cw = P.m_conv_w + (size_t)l * 5 * 512; const float* cb = P.m_conv_b + (size_t)l * 512;
        const int gt = blockIdx.x * 512 + tid, NGT = gridDim.x * 512;
        for (int it = gt; it < NTOK * 64; it += NGT) {
            const int ch = (it & 63) * 8, m = it >> 6, t = m & (SEQ - 1);
            float a[8];
#pragma unroll
            for (int i = 0; i < 8; ++i) a[i] = cb[ch + i];
#pragma unroll
            for (int j = 0; j < 5; ++j) { const int tt = t + j - 2; if (tt >= 0 && tt < SEQ) {
                const u32x4 v = *(const u32x4*)(proj + (size_t)(m + j - 2) * NPROJ + PC_MX + ch);
                const f32x4 wa = *(const f32x4*)(cw + j * 512 + ch), wb = *(const f32x4*)(cw + j * 512 + ch + 4);
                a[0] += wa.x * bflo(v.x); a[1] += wa.y * bfhi(v.x); a[2] += wa.z * bflo(v.y); a[3] += wa.w * bfhi(v.y);
                a[4] += wb.x * bflo(v.z); a[5] += wb.y * bfhi(v.z); a[6] += wb.z * bflo(v.w); a[7] += wb.w * bfhi(v.w); } }
            u32x4 o; o.x = pk2(silu_f(a[0]), silu_f(a[1])); o.y = pk2(silu_f(a[2]), silu_f(a[3])); o.z = pk2(silu_f(a[4]), silu_f(a[5])); o.w = pk2(silu_f(a[6]), silu_f(a[7]));
            *(u32x4*)(MX + (size_t)m * 512 + ch) = o;
        }
    }
}

DI void phase_finalize(const Params& P, int l) {
    const int tid = tid_opaque(), lane = tid & 63, wave = tid >> 6;
    const int gw = blockIdx.x * 8 + wave, NGW = gridDim.x * 8;
    unsigned char* ws = P.ws; unsigned char* dsc = (unsigned char*)P.out;
    bf16_t* MIX = (bf16_t*)(ws + WS_HN);
    {
        const bf16_t* YAT = (const bf16_t*)(dsc + DO_YAT);
        for (int it = gw; it < NB * 32 * 4; it += NGW) {
            const int ct = it & 3, tt = (it >> 2) & 31, b = it >> 7;
            const int c = ct * 64 + lane, t0 = tt * 64;
            const bf16_t* src = YAT + ((size_t)c * NB + b) * SEQ + t0;
            bf16_t* dst = MIX + ((size_t)b * SEQ + t0) * DM + c;
#pragma unroll 2
            for (int t8 = 0; t8 < 64; t8 += 8) {
                u32x4 v = EN_HY ? *(const u32x4*)(src + t8) : (u32x4){0u, 0u, 0u, 0u};
                const unsigned w[4] = {v.x, v.y, v.z, v.w};
#pragma unroll
                for (int i = 0; i < 8; ++i) dst[(size_t)(t8 + i) * DM] = (bf16_t)((i & 1) ? (w[i >> 1] >> 16) : (w[i >> 1] & 0xffffu));
            }
        }
    }
    {
        const bf16_t* MY = (const bf16_t*)(dsc + DO_MY); const float* msq = (const float*)(ws + WS_MSQ); const float* nw = P.m_norm_w + l * 256;
        const int gt = blockIdx.x * 512 + tid, NGT = gridDim.x * 512;
        for (int it = gt; it < NTOK * 32; it += NGT) {
            const int ch = (it & 31) * 8, m = it >> 5;
            u32x4 o = {0u, 0u, 0u, 0u};
            if (EN_MA) {
                const f32x4 sq = *(const f32x4*)(msq + (size_t)m * 4);
                const float r = 1.0f / sqrtf(((sq.x + sq.y) + (sq.z + sq.w)) * (1.0f / 256.0f) + EPSN);
                const u32x4 v = *(const u32x4*)(MY + (size_t)m * 256 + ch);
                const f32x4 wa = *(const f32x4*)(nw + ch), wb = *(const f32x4*)(nw + ch + 4);
                o.x = pk2(bflo(v.x) * r * wa.x, bfhi(v.x) * r * wa.y); o.y = pk2(bflo(v.y) * r * wa.z, bfhi(v.y) * r * wa.w);
                o.z = pk2(bflo(v.z) * r * wb.x, bfhi(v.z) * r * wb.y); o.w = pk2(bflo(v.w) * r * wb.z, bfhi(v.w) * r * wb.w);
            }
            *(u32x4*)(MIX + (size_t)m * DM + 256 + ch) = o;
        }
    }
#if !EN_AT || !EN_HG
    {
        const int gt = blockIdx.x * 512 + tid, NGT = gridDim.x * 512;
        for (int it = gt; it < NTOK * 32; it += NGT) { const int ch = (it & 31) * 8, m = it >> 5;
            if (!EN_AT) *(u32x4*)(MIX + (size_t)m * DM + 512 + ch) = (u32x4){0u, 0u, 0u, 0u};
            if (!EN_HG) *(u32x4*)(MIX + (size_t)m * DM + 768 + ch) = (u32x4){0u, 0u, 0u, 0u}; }
    }
#endif
}

DI void phase_ffnpre(const Params& P, int l, LAS unsigned char* lds) {
    const int tid = tid_opaque(), lane = tid & 63, wave = tid >> 6;
    const int gw = blockIdx.x * 8 + wave, NGW = gridDim.x * 8;
    unsigned char* ws = P.ws;
    LAS float* rwf = (LAS float*)lds;
    for (int i = tid; i < 1024 * 16; i += 512) { const int k = i >> 4, c = i & 15; const int j = k >> 8, ln = (k & 255) >> 2, q = k & 3;
        rwf[((((j * 4 + q) * 4 + (c >> 2)) * 64 + ln) << 2) + (c & 3)] = P.norm_ffn_w[l * DM + k] * P.router_w[((size_t)l * DM + k) * 16 + c]; }
    __syncthreads();
    const LAS f32x4* rw = (const LAS f32x4*)rwf;
    const float* XB = (const float*)(ws + WS_XB); const float* nw = P.norm_ffn_w + l * DM;
    float* aff = (float*)(ws + WS_AFF);
    for (int m = gw; m < NTOK; m += NGW) {
        asm volatile("" ::: "memory");
        const f32x4* xr = (const f32x4*)(XB + (size_t)m * DM) + lane;
        f32x4 v[4]; float s = 0.f;
#pragma unroll
        for (int j = 0; j < 4; ++j) { v[j] = xr[64 * j]; s += (v[j].x * v[j].x + v[j].y * v[j].y) + (v[j].z * v[j].z + v[j].w * v[j].w); }
        const float r = 1.0f / sqrtf(wave_sum(s) * (1.0f / DM) + EPSN);
        float d[16];
#pragma unroll
        for (int c = 0; c < 16; ++c) d[c] = 0.f;
#pragma unroll
        for (int j = 0; j < 4; ++j) {
            const float xv[4] = {v[j].x, v[j].y, v[j].z, v[j].w};
#pragma unroll
            for (int q = 0; q < 4; ++q)
#pragma unroll
                for (int g = 0; g < 4; ++g) { const f32x4 w = rw[((j * 4 + q) * 4 + g) * 64 + lane];
                    d[4 * g] += xv[q] * w.x; d[4 * g + 1] += xv[q] * w.y; d[4 * g + 2] += xv[q] * w.z; d[4 * g + 3] += xv[q] * w.w; }
        }
        float mine = 0.f;
#pragma unroll
        for (int c = 0; c < 16; ++c) { const float t = wave_sum(d[c]); mine = (lane == c) ? t : mine; }
        float lg = (lane < 16) ? mine * r : -3.0e38f;
        float mx = lg;
#pragma unroll
        for (int o = 1; o < 16; o <<= 1) mx = fmaxf(mx, __shfl_xor(mx, o));
        float ex = (lane < 16) ? expf(lg - mx) : 0.f, se = ex;
#pragma unroll
        for (int o = 1; o < 16; o <<= 1) se += __shfl_xor(se, o);
        if (lane < 16) aff[((size_t)(m >> 11) * 16 + lane) * SEQ + (m & (SEQ - 1))] = ex / se;
        u32x2* o8 = (u32x2*)((bf16_t*)(ws + WS_HN) + (size_t)m * DM) + lane;
#pragma unroll
        for (int j = 0; j < 4; ++j) { const f32x4 w = ((const f32x4*)nw)[64 * j + lane]; u32x2 o; o.x = pk2(v[j].x * r * w.x, v[j].y * r * w.y); o.y = pk2(v[j].z * r * w.z, v[j].w * r * w.w); o8[64 * j] = o; }
    }
}

DI void phase_topk(const Params& P, LAS unsigned char* lds) {
    const int tid = tid_opaque();
    unsigned char* ws = P.ws;
    const float* aff = (const float*)(ws + WS_AFF);
    int* slot = (int*)(ws + WS_SLOT); int* seli = (int*)(ws + WS_SELI); float* selg = (float*)(ws + WS_SELG);
    LAS float* av = (LAS float*)lds;
    for (int u = blockIdx.x; u < NB * NEXP; u += gridDim.x) {
        const int b = u >> 4, e = u & 15;
        __syncthreads();
        for (int i = tid; i < SEQ; i += 512) av[i] = aff[(size_t)u * SEQ + i];
        __syncthreads();
        float mv[4]; int rk[4];
#pragma unroll
        for (int q = 0; q < 4; ++q) { mv[q] = av[tid + 512 * q]; rk[q] = 0; }
        for (int j4 = 0; j4 < SEQ; j4 += 4) {
            const f32x4 a = *(const LAS f32x4*)(av + j4);
            const float aj[4] = {a.x, a.y, a.z, a.w};
#pragma unroll
            for (int jj = 0; jj < 4; ++jj)
#pragma unroll
                for (int q = 0; q < 4; ++q) { const int i = tid + 512 * q, j = j4 + jj; rk[q] += (aj[jj] > mv[q] || (aj[jj] == mv[q] && j < i)) ? 1 : 0; }
        }
#pragma unroll
        for (int q = 0; q < 4; ++q) { const int i = tid + 512 * q; const bool sel = rk[q] < CAP;
            slot[((size_t)b * SEQ + i) * 16 + e] = sel ? rk[q] : -1;
            if (sel) { seli[u * CAP + rk[q]] = i; selg[u * CAP + rk[q]] = mv[q]; } }
    }
}

DI bf16x8 mk8(unsigned a, unsigned b, unsigned c, unsigned d) { u32x4 v = {a, b, c, d}; return __builtin_bit_cast(bf16x8, v); }
DI bf16x8 cat44(u32x2 lo, u32x2 hi) { u32x4 v = {lo.x, lo.y, hi.x, hi.y}; return __builtin_bit_cast(bf16x8, v); }
DI int crow(int reg, int hh) { return (reg & 3) + 8 * (reg >> 2) + 4 * hh; }
#define PACK_STEP(x, s) mk8(pk2((x)[8 * (s)], (x)[8 * (s) + 1]), pk2((x)[8 * (s) + 2], (x)[8 * (s) + 3]), pk2((x)[8 * (s) + 4], (x)[8 * (s) + 5]), pk2((x)[8 * (s) + 6], (x)[8 * (s) + 7]))

DI void hyena_unit(const Params& P, int c, LAS unsigned char* lds) {
    const int tid = tid_opaque(), lane = tid & 63, w = __builtin_amdgcn_readfirstlane(tid >> 6), r = lane & 31, hh = lane >> 5;
    constexpr int CPS = 8224;
    unsigned char* ws = P.ws; unsigned char* dsc = (unsigned char*)P.out;
    const bf16_t* kf = (const bf16_t*)(ws + WS_KFILT) + (size_t)c * 4096;
    __syncthreads();
    for (int idx = tid; idx < 8 * 4096; idx += 512) { const int p = idx >> 12, i = idx & 4095, mi = i + p;
        *(LAS bf16_t*)(lds + p * CPS + i * 2) = (mi < 4096) ? kf[mi] : (bf16_t)0; }
    __syncthreads();
    const bf16_t* hw = (const bf16_t*)(dsc + DO_HW) + ((size_t)c * NB + r) * SEQ + 8 * hh;
    f32x16 acc[8];
#pragma unroll
    for (int i = 0; i < 8; ++i)
#pragma unroll
        for (int q = 0; q < 16; ++q) acc[i][q] = 0.f;
    const int p = 7 - (r & 7);
    const LAS unsigned char* abase = lds + p * CPS + (2047 - 256 * w - r + 8 * hh - p) * 2;
#pragma unroll 2
    for (int s0 = 0; s0 < SEQ; s0 += 16) {
        const bf16x8 bfr = *(const bf16x8*)(hw + s0);
#pragma unroll
        for (int i = 0; i < 8; ++i) { const bf16x8 afr = *(const LAS bf16x8*)(abase + (s0 - 32 * i) * 2); acc[i] = MFMA32(afr, bfr, acc[i]); }
    }
    const bf16_t* hx = (const bf16_t*)(dsc + DO_HX0) + ((size_t)c * NB + r) * SEQ;
    bf16_t* ya = (bf16_t*)(dsc + DO_YAT) + ((size_t)c * NB + r) * SEQ;
#pragma unroll
    for (int i = 0; i < 8; ++i)
#pragma unroll
        for (int g = 0; g < 4; ++g) { const int t = 256 * w + 32 * i + 8 * g + 4 * hh;
            const u32x2 xv = *(const u32x2*)(hx + t);
            u32x2 o; o.x = pk2(acc[i][4 * g] * bflo(xv.x), acc[i][4 * g + 1] * bfhi(xv.x)); o.y = pk2(acc[i][4 * g + 2] * bflo(xv.y), acc[i][4 * g + 3] * bfhi(xv.y));
            *(u32x2*)(ya + t) = o; }
}

DI int t5_bucket(int rel) {
    const int ret = rel > 0 ? 16 : 0; const int n = rel < 0 ? -rel : rel;
    if (n < 8) return ret + n;
    const float nf = (float)n;
    int large = 8 + (int)(logf(nf / 8.0f) / 4.852030263919617f * 8.0f);
    large = large < 15 ? large : 15;
    return ret + large;
}
DI void attn_unit(const Params& P, int u, LAS unsigned char* lds) {
    const int qb = u & 7, h = (u >> 3) & 3, b = u >> 5;
    const int tid = tid_opaque(), lane = tid & 63, w = __builtin_amdgcn_readfirstlane(tid >> 6), c = lane & 31, hh = lane >> 5;
    LAS float* Ost = (LAS float*)lds;
    LAS float* Mst = (LAS float*)(lds + 69632);
    LAS float* Lst = Mst + 256;
    LAS float* biasT = (LAS float*)(lds + 69632 + 2048);
    LAS unsigned short* Vt = (LAS unsigned short*)(lds + 69632 + 2048 + 8256 + w * 4608);
    unsigned char* ws = P.ws;
    __syncthreads();
    for (int i = tid; i < 2049; i += 512) biasT[i] = P.rel_bias[t5_bucket(i - 1024) * 4 + h];
    __syncthreads();
    const bf16_t* pb = (const bf16_t*)(ws + WS_PROJ) + (size_t)b * SEQ * NPROJ;
    bf16_t* MIX = (bf16_t*)(ws + WS_HN);
    const int Q0 = qb * 256;
#pragma unroll 1
    for (int pp = 0; pp < 4; ++pp) {
        const int pat = pp < 2 ? pp : 2;
        int d, rho, uq0, nq;
        if (pat == 0) { d = 1; rho = 0; uq0 = Q0 + 32 * w; nq = 32; }
        else if (pat == 1) { d = 4; rho = w & 3; uq0 = (Q0 >> 2) + 32 * (w >> 2); nq = 32; }
        else { d = 16; rho = 2 * w + (pp - 2); uq0 = Q0 >> 4; nq = 16; }
        const int uk0 = uq0 - 64, nsub = SEQ / d;
        const int cq = (c < nq) ? c : c - nq;
        const int qpos = (uq0 + cq) * d + rho, ql = qpos - Q0;
        bf16x8 qf[4];
#pragma unroll
        for (int ks = 0; ks < 4; ++ks) qf[ks] = *(const bf16x8*)(pb + (size_t)qpos * NPROJ + PC_AQ + h * 64 + 16 * ks + 8 * hh);
        float mrun = -1.0e30f, lrun = 0.f; f32x16 OT[2];
#pragma unroll
        for (int dt = 0; dt < 2; ++dt)
#pragma unroll
            for (int q = 0; q < 16; ++q) OT[dt][q] = 0.f;
        if (pat != 0) { mrun = Mst[ql]; lrun = Lst[ql];
#pragma unroll
            for (int dt = 0; dt < 2; ++dt)
#pragma unroll
                for (int g = 0; g < 4; ++g) { const f32x4 v = *(const LAS f32x4*)(Ost + ql * 68 + 32 * dt + 8 * g + 4 * hh);
                    OT[dt][4 * g] = v.x; OT[dt][4 * g + 1] = v.y; OT[dt][4 * g + 2] = v.z; OT[dt][4 * g + 3] = v.w; } }
#pragma unroll 1
        for (int kt = 0; kt < 5; ++kt) {
            const int ukr = uk0 + 32 * kt + c;
            const int ukc = ukr < 0 ? 0 : (ukr >= nsub ? nsub - 1 : ukr);
            const bf16_t* krow = pb + (size_t)(ukc * d + rho) * NPROJ + h * 64;
            bf16x8 kf[4];
#pragma unroll
            for (int ks = 0; ks < 4; ++ks) kf[ks] = *(const bf16x8*)(krow + PC_AK + 16 * ks + 8 * hh);
#pragma unroll
            for (int i = 0; i < 4; ++i) { const int ch = hh + 2 * i; const u32x4 vv = *(const u32x4*)(krow + PC_AV + 8 * ch);
                const unsigned vw[4] = {vv.x, vv.y, vv.z, vv.w};
#pragma unroll
                for (int e = 0; e < 8; ++e) Vt[(8 * ch + e) * 36 + c] = (unsigned short)((e & 1) ? (vw[e >> 1] >> 16) : (vw[e >> 1] & 0xffffu)); }
            f32x16 st;
#pragma unroll
            for (int q = 0; q < 16; ++q) st[q] = 0.f;
#pragma unroll
            for (int ks = 0; ks < 4; ++ks) st = MFMA32(kf[ks], qf[ks], st);
            float tmax = -INFINITY; float lg[16];
#pragma unroll
            for (int q = 0; q < 16; ++q) { const int uk = uk0 + 32 * kt + crow(q, hh); const int rel = uk - (uq0 + cq);
                const bool valid = (rel >= -64) && (rel <= 64) && (uk >= 0) && (uk < nsub);
                const int bi = rel * d + 1024; const float bv = biasT[bi < 0 ? 0 : (bi > 2048 ? 2048 : bi)];
                lg[q] = valid ? st[q] + bv : -INFINITY; tmax = fmaxf(tmax, lg[q]); }
            tmax = fmaxf(tmax, __shfl_xor(tmax, 32));
            const float mnew = fmaxf(mrun, tmax), alpha = __expf(mrun - mnew);
            float psum = 0.f;
#pragma unroll
            for (int q = 0; q < 16; ++q) { lg[q] = __expf(lg[q] - mnew); psum += lg[q]; }
            psum += __shfl_xor(psum, 32);
            lrun = lrun * alpha + psum; mrun = mnew;
#pragma unroll
            for (int dt = 0; dt < 2; ++dt)
#pragma unroll
                for (int q = 0; q < 16; ++q) OT[dt][q] *= alpha;
            LDS_WAIT();
#pragma unroll
            for (int s = 0; s < 2; ++s) { const bf16x8 pf = PACK_STEP(lg, s);
#pragma unroll
                for (int dt = 0; dt < 2; ++dt) { const LAS unsigned short* vr = Vt + (32 * dt + c) * 36 + 16 * s + 4 * hh;
                    const bf16x8 af = cat44(*(const LAS u32x2*)vr, *(const LAS u32x2*)(vr + 8));
                    OT[dt] = MFMA32(af, pf, OT[dt]); } }
            LDS_WAIT();
        }
        if (pat != 2) {
            if (hh == 0) { Mst[ql] = mrun; Lst[ql] = lrun; }
#pragma unroll
            for (int dt = 0; dt < 2; ++dt)
#pragma unroll
                for (int g = 0; g < 4; ++g) *(LAS f32x4*)(Ost + ql * 68 + 32 * dt + 8 * g + 4 * hh) = (f32x4){OT[dt][4 * g], OT[dt][4 * g + 1], OT[dt][4 * g + 2], OT[dt][4 * g + 3]};
        } else if (c < 16) {
            const float inv = 1.0f / lrun;
            bf16_t* orow = MIX + ((size_t)b * SEQ + qpos) * DM + 512 + h * 64;
#pragma unroll
            for (int dt = 0; dt < 2; ++dt)
#pragma unroll
                for (int g = 0; g < 4; ++g) { u32x2 o; o.x = pk2(OT[dt][4 * g] * inv, OT[dt][4 * g + 1] * inv); o.y = pk2(OT[dt][4 * g + 2] * inv, OT[dt][4 * g + 3] * inv);
                    *(u32x2*)(orow + 32 * dt + 8 * g + 4 * hh) = o; }
        }
        if (pp != 2) __syncthreads();
    }
}

DI float softplus_f(float x) { return x > 20.f ? x : log1pf(expf(x)); }
DI void mamba_unit(const Params& P, int l, int u, LAS unsigned char* lds) {
    const int b = u >> 2, h = u & 3, g = h >> 1;
    const int tid = tid_opaque(), lane = tid & 63, w = __builtin_amdgcn_readfirstlane(tid >> 6), c32 = lane & 31, hh = lane >> 5;
    LAS unsigned char* wl = lds + w * 15616;
    LAS unsigned short* xdT = (LAS unsigned short*)wl;
    LAS unsigned short* xwT = xdT + 64 * 40;
    LAS unsigned short* BT = xwT + 64 * 40;
    LAS float* dtv = (LAS float*)(wl + 15360);
    LAS float* acum = dtv + 32;
    LAS float* Atot = (LAS float*)(lds + 8 * 15616);
    unsigned char* ws = P.ws; unsigned char* dsc = (unsigned char*)P.out;
    const bf16_t* xbc = (const bf16_t*)(dsc + DO_MXBC) + (size_t)b * SEQ * 512;
    const float* dtr = (const float*)(ws + WS_DT) + (size_t)b * SEQ * 8;
    const bf16_t* proj = (const bf16_t*)(ws + WS_PROJ) + (size_t)b * SEQ * NPROJ;
    bf16_t* MY = (bf16_t*)(dsc + DO_MY) + (size_t)b * SEQ * 256;
    float* msq = (float*)(ws + WS_MSQ) + (size_t)b * SEQ * 4;
    float* stsc = (float*)(dsc + DO_MST) + (size_t)u * (2 * 8 * 4096);
    const float Dsk = P.m_D[l * 4 + h];
    __syncthreads();
#pragma unroll 1
    for (int pass = 0; pass < 2; ++pass) {
#pragma unroll 1
        for (int dir = 0; dir < 2; ++dir) {
            const float dtb = P.m_dt_bias[l * 8 + dir * 4 + h], Aneg = -expf(P.m_A_log[l * 8 + dir * 4 + h]);
            f32x16 ST[2][2];
#pragma unroll
            for (int a = 0; a < 2; ++a)
#pragma unroll
                for (int q = 0; q < 2; ++q)
#pragma unroll
                    for (int i = 0; i < 16; ++i) ST[a][q][i] = 0.f;
            if (pass == 1) {
                const int nv = dir ? 7 - w : w;
                for (int k = 0; k < nv; ++k) { const int v = dir ? 7 - k : k; const float dec = Atot[dir * 8 + v];
                    const float* sp = stsc + (size_t)(dir * 8 + v) * 4096 + lane;
#pragma unroll
                    for (int a = 0; a < 2; ++a)
#pragma unroll
                        for (int q = 0; q < 2; ++q)
#pragma unroll
                            for (int i = 0; i < 16; ++i) ST[a][q][i] = ST[a][q][i] * dec + sp[((a * 2 + q) * 16 + i) * 64]; }
            }
            float atot = 0.f;
#pragma unroll 1
            for (int ci = 0; ci < 8; ++ci) {
                const int c0 = 256 * w + 32 * (dir ? 7 - ci : ci);
#define MTK(j) (dir ? c0 + 31 - (j) : c0 + (j))
                {
                    const float dt = softplus_f(dtr[(size_t)MTK(c32) * 8 + dir * 4 + h] + dtb);
                    float ac = dt * Aneg;
#pragma unroll
                    for (int o = 1; o < 32; o <<= 1) { const float t = __shfl_up(ac, o, 32); if (c32 >= o) ac += t; }
                    if (lane < 32) { dtv[c32] = dt; acum[c32] = ac; }
                }
                LDS_WAIT();
                const float aend = acum[31];
                {
                    const bf16_t* xp = xbc + h * 64 + lane; const bf16_t* bp = xbc + 256 + g * 64 + lane;
#pragma unroll
                    for (int j8 = 0; j8 < 32; j8 += 8) {
                        float xd[8], xw[8]; unsigned short bb[8];
#pragma unroll
                        for (int j = 0; j < 8; ++j) { const size_t ro = (size_t)MTK(j8 + j) * 512; const float xv = bf2f(xp[ro]) * dtv[j8 + j];
                            xd[j] = xv; xw[j] = xv * __expf(aend - acum[j8 + j]); bb[j] = bp[ro]; }
                        *(LAS u32x4*)(xdT + lane * 40 + j8) = (u32x4){pk2(xd[0], xd[1]), pk2(xd[2], xd[3]), pk2(xd[4], xd[5]), pk2(xd[6], xd[7])};
                        *(LAS u32x4*)(xwT + lane * 40 + j8) = (u32x4){pk2(xw[0], xw[1]), pk2(xw[2], xw[3]), pk2(xw[4], xw[5]), pk2(xw[6], xw[7])};
                        *(LAS u32x4*)(BT + lane * 40 + j8) = (u32x4){(unsigned)bb[0] | ((unsigned)bb[1] << 16), (unsigned)bb[2] | ((unsigned)bb[3] << 16), (unsigned)bb[4] | ((unsigned)bb[5] << 16), (unsigned)bb[6] | ((unsigned)bb[7] << 16)};
                    }
                }
                LDS_WAIT();
                if (pass == 1) {
                    const bf16_t* brow = xbc + (size_t)MTK(c32) * 512 + 256 + g * 64 + 8 * hh;
                    f32x16 GT;
#pragma unroll
                    for (int i = 0; i < 16; ++i) GT[i] = 0.f;
#pragma unroll
                    for (int ks = 0; ks < 4; ++ks) GT = MFMA32(*(const bf16x8*)(brow + 16 * ks), *(const bf16x8*)(brow + 128 + 16 * ks), GT);
                    const float acl = acum[c32];
#pragma unroll
                    for (int i = 0; i < 16; ++i) { const int s = crow(i, hh); GT[i] = (s <= c32) ? GT[i] * __expf(acl - acum[s]) : 0.f; }
                    f32x16 Y[2], Y2[2];
#pragma unroll
                    for (int pt = 0; pt < 2; ++pt)
#pragma unroll
                        for (int i = 0; i < 16; ++i) { Y[pt][i] = 0.f; Y2[pt][i] = 0.f; }
#pragma unroll
                    for (int s = 0; s < 2; ++s) { const bf16x8 pa = PACK_STEP(GT, s);
#pragma unroll
                        for (int pt = 0; pt < 2; ++pt) { const LAS unsigned short* xr = xdT + (32 * pt + c32) * 40 + 16 * s + 4 * hh;
                            Y[pt] = MFMA32(pa, cat44(*(const LAS u32x2*)xr, *(const LAS u32x2*)(xr + 8)), Y[pt]); } }
                    const bf16_t* crw = xbc + (size_t)MTK(c32) * 512 + 384 + g * 64 + 4 * hh;
#pragma unroll
                    for (int nt = 0; nt < 2; ++nt)
#pragma unroll
                        for (int s = 0; s < 2; ++s) { const bf16x8 ca = cat44(*(const u32x2*)(crw + 32 * nt + 16 * s), *(const u32x2*)(crw + 32 * nt + 16 * s + 8));
#pragma unroll
                            for (int pt = 0; pt < 2; ++pt) Y2[pt] = MFMA32(ca, PACK_STEP(ST[nt][pt], s), Y2[pt]); }
#pragma unroll
                    for (int i = 0; i < 16; ++i) { const int lr = crow(i, hh); const int tk = MTK(lr); const float el = __expf(acum[lr]);
                        float sq = 0.f;
#pragma unroll
                        for (int pt = 0; pt < 2; ++pt) { const int pc = h * 64 + 32 * pt + c32; float y = Y[pt][i] + el * Y2[pt][i];
                            bf16_t* dst = MY + (size_t)tk * 256 + pc;
                            if (dir == 0) { y += Dsk * bf2f(xbc[(size_t)tk * 512 + pc]); *dst = f2bf(y); }
                            else { y += bf2f(*dst); y *= silu_f(bf2f(proj[(size_t)tk * NPROJ + PC_MZ + pc])); *dst = f2bf(y); sq += y * y; } }
                        if (dir == 1) {
#pragma unroll
                            for (int o = 1; o < 32; o <<= 1) sq += __shfl_xor(sq, o);
                            if (c32 == 0) msq[(size_t)tk * 4 + h] = sq; }
                    }
                }
                {
                    const float de = __expf(aend);
#pragma unroll
                    for (int nt = 0; nt < 2; ++nt)
#pragma unroll
                        for (int pt = 0; pt < 2; ++pt)
#pragma unroll
                            for (int i = 0; i < 16; ++i) ST[nt][pt][i] *= de;
#pragma unroll
                    for (int s = 0; s < 2; ++s)
#pragma unroll
                        for (int nt = 0; nt < 2; ++nt) { const bf16x8 ba = *(const LAS bf16x8*)(BT + (32 * nt + c32) * 40 + 16 * s + 8 * hh);
#pragma unroll
                            for (int pt = 0; pt < 2; ++pt) ST[nt][pt] = MFMA32(ba, *(const LAS bf16x8*)(xwT + (32 * pt + c32) * 40 + 16 * s + 8 * hh), ST[nt][pt]); }
                }
                atot += aend;
                LDS_WAIT();
#undef MTK
            }
            if (pass == 0) {
                float* sp = stsc + (size_t)(dir * 8 + w) * 4096 + lane;
#pragma unroll
                for (int a = 0; a < 2; ++a)
#pragma unroll
                    for (int q = 0; q < 2; ++q)
#pragma unroll
                        for (int i = 0; i < 16; ++i) sp[((a * 2 + q) * 16 + i) * 64] = ST[a][q][i];
                if (lane == 0) Atot[dir * 8 + w] = __expf(atot);
            }
            VM_WAIT();
        }
        if (pass == 0) { VM_WAIT(); __syncthreads(); }
    }
    __syncthreads();
}

DI void hgrn_unit(const Params& P, int l, int u, LAS unsigned char* lds) {
    const int b = u >> 2, h = u & 3;
    const int tid = tid_opaque(), lane = tid & 63, w = __builtin_amdgcn_readfirstlane(tid >> 6), c32 = lane & 31, hh = lane >> 5;
    LAS unsigned char* wl = lds + w * 15104;
    LAS unsigned short* qd = (LAS unsigned short*)wl;
    LAS unsigned short* kd = qd + 32 * 72;
    LAS unsigned short* vT = kd + 32 * 72;
    LAS float* eref = (LAS float*)(wl + 14336);
    LAS float* eglr = eref + 64;
    LAS float* egl = eglr + 64;
    LAS float* Atot = (LAS float*)(lds + 8 * 15104);
    unsigned char* ws = P.ws; unsigned char* dsc = (unsigned char*)P.out;
    const bf16_t* proj = (const bf16_t*)(ws + WS_PROJ) + (size_t)b * SEQ * NPROJ;
    bf16_t* MIX = (bf16_t*)(ws + WS_HN) + (size_t)b * SEQ * DM;
    float* stsc = (float*)(dsc + DO_HST) + (size_t)u * (2 * 8 * 4096);
    bf16x8 ident[2];
#pragma unroll
    for (int s = 0; s < 2; ++s) { unsigned short e[8];
#pragma unroll
        for (int j = 0; j < 8; ++j) e[j] = (16 * s + 8 * hh + j == c32) ? (unsigned short)0x3f80 : (unsigned short)0;
        ident[s] = mk8((unsigned)e[0] | ((unsigned)e[1] << 16), (unsigned)e[2] | ((unsigned)e[3] << 16), (unsigned)e[4] | ((unsigned)e[5] << 16), (unsigned)e[6] | ((unsigned)e[7] << 16)); }
    __syncthreads();
#pragma unroll 1
    for (int pass = 0; pass < 2; ++pass) {
#pragma unroll 1
        for (int dir = 0; dir < 2; ++dir) {
            float lb = 0.f;
            if (l == 1) { const float h0 = P.hg_lb[(0 * 2 + dir) * 256 + h * 64 + lane], h1 = P.hg_lb[(1 * 2 + dir) * 256 + h * 64 + lane]; lb = 1.0f / (1.0f + expf(h0 - h1)); }
            f32x16 S[2][2];
#pragma unroll
            for (int a = 0; a < 2; ++a)
#pragma unroll
                for (int q = 0; q < 2; ++q)
#pragma unroll
                    for (int i = 0; i < 16; ++i) S[a][q][i] = 0.f;
            if (pass == 1) {
                const int nv = dir ? 7 - w : w;
                for (int k = 0; k < nv; ++k) { const int v = dir ? 7 - k : k; const LAS float* at = Atot + (dir * 8 + v) * 64;
                    const float* sp = stsc + (size_t)(dir * 8 + v) * 4096 + lane;
#pragma unroll
                    for (int a = 0; a < 2; ++a)
#pragma unroll
                        for (int i = 0; i < 16; ++i) { const float dec = at[32 * a + crow(i, hh)];
#pragma unroll
                            for (int q = 0; q < 2; ++q) S[a][q][i] = S[a][q][i] * dec + sp[((a * 2 + q) * 16 + i) * 64]; } }
            }
            float gtot = 0.f;
#pragma unroll 1
            for (int ci = 0; ci < 8; ++ci) {
                const int c0 = 256 * w + 32 * (dir ? 7 - ci : ci);
#define HTK(j) (dir ? c0 + 31 - (j) : c0 + (j))
                {
                    const bf16_t* qp = proj + PC_HQ + h * 64 + lane; const bf16_t* fp = proj + PC_HF + dir * 256 + h * 64 + lane; const bf16_t* vp = proj + PC_HI + h * 64 + lane;
                    float gcv[32], qv[32], kv[32]; float run = 0.f;
#pragma unroll
                    for (int j = 0; j < 32; ++j) { const size_t ro = (size_t)HTK(j) * NPROJ; const float fpre = bf2f(fp[ro]);
                        const float sg = sigmoid_f(fpre), f = lb + (1.0f - lb) * sg;
                        run += __logf(f); gcv[j] = run; qv[j] = silu_f(bf2f(qp[ro])); kv[j] = (1.0f - lb) * sigmoid_f(-fpre); }
                    const float ref = gcv[15], gl = gcv[31];
                    eref[lane] = __expf(ref); eglr[lane] = __expf(gl - ref); egl[lane] = __expf(gl); gtot += gl;
#pragma unroll
                    for (int j = 0; j < 32; ++j) { qd[j * 72 + lane] = f2bf(qv[j] * __expf(gcv[j] - ref)); kd[j * 72 + lane] = f2bf(kv[j] * __expf(ref - gcv[j])); }
#pragma unroll
                    for (int j8 = 0; j8 < 32; j8 += 8) { unsigned short vb[8];
#pragma unroll
                        for (int j = 0; j < 8; ++j) vb[j] = vp[(size_t)HTK(j8 + j) * NPROJ];
                        *(LAS u32x4*)(vT + lane * 40 + j8) = (u32x4){(unsigned)vb[0] | ((unsigned)vb[1] << 16), (unsigned)vb[2] | ((unsigned)vb[3] << 16), (unsigned)vb[4] | ((unsigned)vb[5] << 16), (unsigned)vb[6] | ((unsigned)vb[7] << 16)}; }
                }
                LDS_WAIT();
                bf16x8 vperm[2][2];
#pragma unroll
                for (int s = 0; s < 2; ++s)
#pragma unroll
                    for (int pt = 0; pt < 2; ++pt) { const LAS unsigned short* vr = vT + (32 * pt + c32) * 40 + 16 * s + 4 * hh; vperm[s][pt] = cat44(*(const LAS u32x2*)vr, *(const LAS u32x2*)(vr + 8)); }
                if (pass == 1) {
                    f32x16 SC;
#pragma unroll
                    for (int i = 0; i < 16; ++i) SC[i] = 0.f;
#pragma unroll
                    for (int ks = 0; ks < 4; ++ks) SC = MFMA32(*(const LAS bf16x8*)(kd + c32 * 72 + 16 * ks + 8 * hh), *(const LAS bf16x8*)(qd + c32 * 72 + 16 * ks + 8 * hh), SC);
#pragma unroll
                    for (int i = 0; i < 16; ++i) SC[i] = (crow(i, hh) <= c32) ? SC[i] : 0.f;
                    f32x16 O[2];
#pragma unroll
                    for (int pt = 0; pt < 2; ++pt)
#pragma unroll
                        for (int i = 0; i < 16; ++i) O[pt][i] = 0.f;
#pragma unroll
                    for (int s = 0; s < 2; ++s) { const bf16x8 pa = PACK_STEP(SC, s);
#pragma unroll
                        for (int pt = 0; pt < 2; ++pt) O[pt] = MFMA32(pa, vperm[s][pt], O[pt]); }
#pragma unroll
                    for (int et = 0; et < 2; ++et)
#pragma unroll
                        for (int s = 0; s < 2; ++s) { const LAS unsigned short* qr = qd + c32 * 72 + 32 * et + 16 * s + 4 * hh;
                            const bf16x8 qa = cat44(*(const LAS u32x2*)qr, *(const LAS u32x2*)(qr + 8));
                            float er[8];
#pragma unroll
                            for (int j = 0; j < 8; ++j) er[j] = eref[32 * et + crow(8 * s + j, hh)];
#pragma unroll
                            for (int pt = 0; pt < 2; ++pt) { const f32x16& sv = S[et][pt];
                                const bf16x8 sb = mk8(pk2(sv[8 * s] * er[0], sv[8 * s + 1] * er[1]), pk2(sv[8 * s + 2] * er[2], sv[8 * s + 3] * er[3]), pk2(sv[8 * s + 4] * er[4], sv[8 * s + 5] * er[5]), pk2(sv[8 * s + 6] * er[6], sv[8 * s + 7] * er[7]));
                                O[pt] = MFMA32(qa, sb, O[pt]); } }
                    const float nwa = P.hg_norm_w[l * 64 + c32], nwb = P.hg_norm_w[l * 64 + 32 + c32];
#pragma unroll
                    for (int i = 0; i < 16; ++i) { const int lr = crow(i, hh); const int tk = HTK(lr);
                        bf16_t* dst = MIX + (size_t)tk * DM + 768 + h * 64 + c32;
                        if (dir == 0) { dst[0] = f2bf(O[0][i]); dst[32] = f2bf(O[1][i]); }
                        else { const float o0 = O[0][i] + bf2f(dst[0]), o1 = O[1][i] + bf2f(dst[32]);
                            float sq = o0 * o0 + o1 * o1;
#pragma unroll
                            for (int o = 1; o < 32; o <<= 1) sq += __shfl_xor(sq, o);
                            const float rn = 1.0f / sqrtf(sq * (1.0f / 64.0f) + EPSN);
                            const bf16_t* gp = proj + (size_t)tk * NPROJ + PC_HG + h * 64 + c32;
                            dst[0] = f2bf(o0 * rn * nwa * silu_f(bf2f(gp[0]))); dst[32] = f2bf(o1 * rn * nwb * silu_f(bf2f(gp[32]))); } }
                }
                {
#pragma unroll
                    for (int et = 0; et < 2; ++et) {
                        f32x16 X;
#pragma unroll
                        for (int i = 0; i < 16; ++i) X[i] = 0.f;
#pragma unroll
                        for (int s = 0; s < 2; ++s) X = MFMA32(*(const LAS bf16x8*)(kd + c32 * 72 + 32 * et + 16 * s + 8 * hh), ident[s], X);
                        const float sc = eglr[32 * et + c32];
#pragma unroll
                        for (int i = 0; i < 16; ++i) X[i] *= sc;
                        float dg[16];
#pragma unroll
                        for (int i = 0; i < 16; ++i) dg[i] = egl[32 * et + crow(i, hh)];
#pragma unroll
                        for (int pt = 0; pt < 2; ++pt) {
#pragma unroll
                            for (int i = 0; i < 16; ++i) S[et][pt][i] *= dg[i];
#pragma unroll
                            for (int s = 0; s < 2; ++s) S[et][pt] = MFMA32(PACK_STEP(X, s), vperm[s][pt], S[et][pt]); }
                    }
                }
                LDS_WAIT();
#undef HTK
            }
            if (pass == 0) {
                float* sp = stsc + (size_t)(dir * 8 + w) * 4096 + lane;
#pragma unroll
                for (int a = 0; a < 2; ++a)
#pragma unroll
                    for (int q = 0; q < 2; ++q)
#pragma unroll
                        for (int i = 0; i < 16; ++i) sp[((a * 2 + q) * 16 + i) * 64] = S[a][q][i];
                Atot[(dir * 8 + w) * 64 + lane] = __expf(gtot);
            }
            VM_WAIT();
        }
        if (pass == 0) { VM_WAIT(); __syncthreads(); }
    }
    __syncthreads();
}

DI void phase_mixers(const Params& P, int l, LAS unsigned char* lds) {
    const int G = gridDim.x, bid = blockIdx.x;
    if (EN_HY) for (int c = bid; c < 256; c += G) hyena_unit(P, c, lds);
    if (EN_AT) for (int u = bid; u < NB * 4 * 8; u += G) attn_unit(P, u, lds);
    if (EN_MA) for (int u = bid; u < 128; u += G) mamba_unit(P, l, u, lds);
    if (EN_HG) for (int u = (bid + G - (128 % G)) % G; u < 128; u += G) hgrn_unit(P, l, u, lds);
}

constexpr int N_PHASES = 21;
__global__ void __launch_bounds__(512, 2) fwd_kernel(Params P) {
    extern __shared__ __attribute__((aligned(16))) unsigned char lds_raw[];
    LAS unsigned char* lds = (LAS unsigned char*)lds_raw;
    volatile LAS unsigned* MISC = (volatile LAS unsigned*)(lds + LDS_MISC);
    if (threadIdx.x < 64) MISC[threadIdx.x] = 0u;
    __syncthreads();
    unsigned char* ws = P.ws;
    const int lo = P.ph_lo, hi = P.ph_hi;
    XcdBarrier bar; bar.bar = (unsigned*)(ws + WS_CTL) + CW_BAR; bar.x = 0; bar.st = nullptr;
    if (hi - lo > 1) bar = xcd_barrier_post((unsigned*)(ws + WS_CTL) + CW_BAR, MISC + 8);
#define IN(k) (lo <= (k) && (k) < hi)
#define SEAM(k) do { if (IN(k) && IN((k) + 1)) xcd_barrier(bar); } while (0)
    const int G = gridDim.x, bid = blockIdx.x;
#pragma unroll 1
    for (int l = 0; l < 2; ++l) {
        const int p0 = 10 * l;
        if (IN(p0 + 0)) { phase_pre(P, l, lds); }
        SEAM(p0 + 0);
        if (IN(p0 + 1)) {
            pg8::StaticOrder S; S.init(NTOK / 256, NPROJ / 256, G, bid); AddrPlain AD{DM, 0}; EpiProj E{(bf16_t*)(ws + WS_PROJ)};
            pg8::gemm_phase(lds, (const char*)(ws + WS_HN), (const char*)(ws + WS_WIN), DM, S, AD, E);
        }
        SEAM(p0 + 1);
        if (IN(p0 + 2)) { phase_premix(P, l); }
        SEAM(p0 + 2);
        if (IN(p0 + 3)) { phase_mixers(P, l, lds); }
        SEAM(p0 + 3);
        if (IN(p0 + 4)) { phase_finalize(P, l); }
        SEAM(p0 + 4);
        if (IN(p0 + 5)) {
            pg8::StaticOrder S; S.init(NTOK / 256, DM / 256, G, bid); AddrPlain AD{DM, 0}; EpiRes E{l == 0 ? P.x : (const float*)(ws + WS_XB), (float*)(ws + WS_XB)};
            pg8::gemm_phase(lds, (const char*)(ws + WS_HN), (const char*)(ws + WS_WOUT), DM, S, AD, E);
        }
        SEAM(p0 + 5);
        if (IN(p0 + 6)) { if (EN_MOE) phase_ffnpre(P, l, lds); }
        SEAM(p0 + 6);
        if (IN(p0 + 7)) { if (EN_MOE) phase_topk(P, lds); }
        SEAM(p0 + 7);
        if (IN(p0 + 8)) { if (EN_MOE) {
            pg8::StaticOrder S; S.init(NSLOT / 256, 2048 / 256, G, bid); AddrGateUp AD{(const int*)(ws + WS_SELI)}; EpiGateUp E{(bf16_t*)((unsigned char*)P.out + DO_HDN)};
            pg8::gemm_phase(lds, (const char*)(ws + WS_HN), (const char*)(ws + WS_WGU), DM, S, AD, E); } }
        SEAM(p0 + 8);
        if (IN(p0 + 9)) { if (EN_MOE) {
            pg8::StaticOrder S; S.init(NSLOT / 256, DM / 256, G, bid); AddrDown AD{}; EpiDown E{(bf16_t*)(ws + WS_YE), (const float*)(ws + WS_SELG)};
            pg8::gemm_phase(lds, (const char*)P.out + DO_HDN, (const char*)(ws + WS_WD), DM, S, AD, E); } }
        SEAM(p0 + 9);
    }
    if (IN(20)) phase_final(P);
#undef IN
#undef SEAM
}

#ifndef N_LAUNCH_MODE
#define N_LAUNCH_MODE 1
#endif
extern "C" void kernel_launch(void* const* d_in, const int* in_sizes, int n_in, void* d_out, int out_size, void* d_ws, size_t ws_size, hipStream_t stream) {
    static int grid = 0;
    if (grid == 0) {
        if (n_in != 27 || in_sizes[0] != NTOK * DM || out_size != NTOK * DM || ws_size < WS_END) {
            fprintf(stderr, "kernel_launch: unexpected shapes (n_in %d, in0 %d, out %d, ws %zu, need %zu)\n", n_in, n_in > 0 ? in_sizes[0] : -1, out_size, ws_size, (size_t)WS_END); grid = -1; return; }
        int dev = 0, cus = 0, per_cu = 0;
        if (hipGetDevice(&dev) != hipSuccess || hipDeviceGetAttribute(&cus, hipDeviceAttributeMultiprocessorCount, dev) != hipSuccess) { grid = -1; return; }
        if (hipFuncSetAttribute((const void*)fwd_kernel, hipFuncAttributeMaxDynamicSharedMemorySize, LDS_BYTES) != hipSuccess) { fprintf(stderr, "kernel_launch: hipFuncSetAttribute failed\n"); grid = -1; return; }
        if (hipOccupancyMaxActiveBlocksPerMultiprocessor(&per_cu, (const void*)fwd_kernel, 512, LDS_BYTES) != hipSuccess || per_cu < 1) { fprintf(stderr, "kernel_launch: occupancy query says %d\n", per_cu); (void)hipGetLastError(); }
        grid = cus;
    }
    if (grid < 0) return;
    if (hipMemsetAsync((char*)d_ws + WS_CTL, 0, CTL_ZERO_BYTES, stream) != hipSuccess) return;
    Params p{};
    const float** pp = (const float**)&p;
    for (int i = 0; i < 27; ++i) pp[i] = (const float*)d_in[i];
    p.out = (float*)d_out; p.ws = (unsigned char*)d_ws;
    if (N_LAUNCH_MODE == 1) { p.ph_lo = 0; p.ph_hi = N_PHASES; hipLaunchKernelGGL(fwd_kernel, dim3(grid), dim3(512), LDS_BYTES, stream, p); }
    else for (int k = 0; k < N_PHASES; ++k) { p.ph_lo = k; p.ph_hi = k + 1; hipLaunchKernelGGL(fwd_kernel, dim3(grid), dim3(512), LDS_BYTES, stream, p); }
}
```

```cpp
#define N_LAUNCH_MODE 1
#include <hip/hip_runtime.h>
#include <cstdio>
#include <cstdint>

#define LAS __attribute__((address_space(3)))
#define DI __device__ __forceinline__
typedef unsigned short bf16_t;
typedef short bf16x8 __attribute__((ext_vector_type(8)));
typedef short s16x4 __attribute__((ext_vector_type(4)));
typedef float f32x2 __attribute__((ext_vector_type(2)));
typedef float f32x4 __attribute__((ext_vector_type(4)));
typedef float f32x16 __attribute__((ext_vector_type(16)));
typedef unsigned u32x2 __attribute__((ext_vector_type(2)));
typedef unsigned u32x4 __attribute__((ext_vector_type(4)));
typedef int i32x4 __attribute__((ext_vector_type(4)));
typedef __bf16 bfv2 __attribute__((ext_vector_type(2)));

DI unsigned pk2(float lo, float hi) { f32x2 v = {lo, hi}; return __builtin_bit_cast(unsigned, __builtin_convertvector(v, bfv2)); }
DI unsigned short f2bf(float f) { return (unsigned short)(pk2(f, 0.f) & 0xffffu); }
DI float bf2f(unsigned short b) { return __uint_as_float((unsigned)b << 16); }
DI float bflo(unsigned u) { return __uint_as_float(u << 16); }
DI float bfhi(unsigned u) { return __uint_as_float(u & 0xffff0000u); }
DI float wave_sum(float v) {
#pragma unroll
    for (int o = 1; o < 64; o <<= 1) v += __shfl_xor(v, o);
    return v;
}
DI float silu_f(float x) { return x / (1.0f + __expf(-x)); }
DI float sigmoid_f(float x) { return 1.0f / (1.0f + __expf(-x)); }
DI int tid_opaque() { int t = threadIdx.x; asm volatile("" : "+v"(t)); return t; }
DI bf16x8 mk8u(unsigned a, unsigned b, unsigned c, unsigned d) { u32x4 v = {a, b, c, d}; return __builtin_bit_cast(bf16x8, v); }
#define LDS_WAIT() asm volatile("s_waitcnt lgkmcnt(0)" ::: "memory")
#define VM_WAIT() asm volatile("s_waitcnt vmcnt(0)" ::: "memory")
#define MFMA32(a, b, c) __builtin_amdgcn_mfma_f32_32x32x16_bf16((a), (b), (c), 0, 0, 0)

constexpr int NB = 32, SEQ = 2048, DM = 1024, NTOK = NB * SEQ;
constexpr int NIN_REF = 3592, NPROJ = 3584;
constexpr int PC_HY = 0, PC_MZ = 768, PC_MX = 1024, PC_AQ = 1536, PC_AK = 1792, PC_AV = 2048, PC_HQ = 2304, PC_HF = 2560, PC_HI = 3072, PC_HG = 3328;
constexpr int NEXP = 16, CAP = 256, NSLOT = NB * NEXP * CAP;
constexpr float EPSN = 1e-6f;

constexpr size_t MiB = 1u << 20;
constexpr size_t WS_CTL = 0, CTL_ZERO_BYTES = 64 * 1024;
constexpr size_t WS_DT = 1 * MiB, WS_AFF = 3 * MiB, WS_SLOT = 7 * MiB, WS_SELI = 11 * MiB, WS_SELG = 11 * MiB + 512 * 1024, WS_KFILT = 12 * MiB, WS_MSQ = 14 * MiB, WS_RS = 15 * MiB, WS_SELR = 15 * MiB + 512 * 1024;
constexpr size_t WS_XB = 64 * MiB, WS_WIN = 320 * MiB, WS_WOUT = 327 * MiB, WS_WGU = 329 * MiB, WS_WD = 393 * MiB, WS_HN = 432 * MiB, WS_PROJ = 560 * MiB, WS_YE = WS_PROJ, WS_END = 1008 * MiB, WS_MYB = WS_WGU, WS_OB = WS_WGU + 32 * MiB;
constexpr size_t DO_HW = 0, DO_HX0 = 32 * MiB, DO_YAT = 64 * MiB, DO_MXBC = 96 * MiB, DO_MY = 160 * MiB, DO_MST = 192 * MiB, DO_HST = 224 * MiB, DO_HDN = 0;
constexpr int CW_BAR = 1024;

constexpr int LDS_MISC = 147456, LDS_BYTES = LDS_MISC + 256;

struct Params {
    const float *x, *w_in, *w_out, *norm_mix_w, *norm_ffn_w, *hy_conv_w, *hy_w1, *hy_b1, *hy_w2, *hy_b2, *hy_freq, *hy_w3, *hy_fbias,
                *m_conv_w, *m_conv_b, *m_dt_bias, *m_A_log, *m_D, *m_norm_w, *rel_bias, *hg_lb, *hg_norm_w, *router_w, *moe_wg, *moe_wu, *moe_wd, *final_w;
    float* out; unsigned char* ws;
    int ph_lo, ph_hi;
};

#define XB_TMO      128
#define XB_XCNT(j)  (256  + 64 * (j))
#define XB_XSUB(j)  (1280 + 64 * (j))
#define XB_XGEN(j)  (2304 + 64 * (j))
#define XB_TOP      3328
#define XB_TOPGEN   3392
#define XCD_BAR_WORDS 3456
#define XB_SPIN_CAP (1u << 18)
__device__ __forceinline__ unsigned xb_ld(unsigned* p)              { return __hip_atomic_load(p, __ATOMIC_RELAXED, __HIP_MEMORY_SCOPE_AGENT); }
__device__ __forceinline__ unsigned xb_add(unsigned* p, unsigned v) { return __hip_atomic_fetch_add(p, v, __ATOMIC_RELAXED, __HIP_MEMORY_SCOPE_AGENT); }
__device__ __forceinline__ unsigned xb_xcc_id() { return (unsigned)__builtin_amdgcn_s_getreg((3 << 11) | 20) & 0xFu; }
#define XB_SPIN(cond, bar) do { unsigned _sp = 0; while (cond) { __builtin_amdgcn_s_sleep(1); \
    if ((++_sp & 255u) == 0u) { if (xb_ld(&(bar)[XB_TMO])) break; if (_sp > XB_SPIN_CAP) { atomicAdd(&(bar)[XB_TMO], 1u); break; } } } } while (0)
struct XcdBarrier { unsigned* bar; unsigned x; volatile LAS unsigned* st; };
__device__ __forceinline__ XcdBarrier xcd_barrier_post(unsigned* bar, volatile LAS unsigned* st) {
    XcdBarrier b; b.bar = bar; b.x = xb_xcc_id(); b.st = st;
    if (threadIdx.x == 0) (void)xb_add(&bar[XB_XCNT(b.x)], 1u);
    return b;
}
__device__ __forceinline__ void xcd_barrier_complete(unsigned* bar, unsigned x, unsigned& nloc, unsigned& nx) {
    const unsigned G = gridDim.x * gridDim.y * gridDim.z;
    unsigned sum, cnt, mine, sp = 0u;
    for (;;) {
        sum = 0u; cnt = 0u; mine = 0u;
#pragma unroll
        for (unsigned j = 0; j < 16; ++j) { const unsigned c = xb_ld(&bar[XB_XCNT(j)]); sum += c; cnt += (c > 0u) ? 1u : 0u; mine = (j == x) ? c : mine; }
        if (sum == G) break;
        __builtin_amdgcn_s_sleep(1);
        if ((++sp & 255u) == 0u) { if (xb_ld(&bar[XB_TMO])) break; if (sp > XB_SPIN_CAP) { atomicAdd(&bar[XB_TMO], 1u); break; } }
    }
    nloc = mine > 0u ? mine : 1u; nx = cnt > 0u ? cnt : 1u;
}
__device__ __forceinline__ void xcd_barrier(const XcdBarrier& b) {
    asm volatile("s_waitcnt vmcnt(0)" ::: "memory");
    __syncthreads();
    if (threadIdx.x == 0) {
        unsigned* bar = b.bar;
        __builtin_amdgcn_s_waitcnt(0);
        unsigned nloc = b.st[0], nx = b.st[1];
        if (nloc == 0u) { xcd_barrier_complete(bar, b.x, nloc, nx); b.st[0] = nloc; b.st[1] = nx; }
        const unsigned old = xb_add(&bar[XB_XSUB(b.x)], 1u);
        const unsigned gen = old / nloc;
        if (old + 1u == (gen + 1u) * nloc) {
            __builtin_amdgcn_fence(__ATOMIC_RELEASE, "agent");
            asm volatile("s_waitcnt vmcnt(0)" ::: "memory");
            const unsigned og = xb_add(&bar[XB_TOP], 1u);
            const unsigned tg = og / nx;
            if (og + 1u == (tg + 1u) * nx) xb_add(&bar[XB_TOPGEN], 1u);
            else XB_SPIN(xb_ld(&bar[XB_TOPGEN]) == tg, bar);
            __builtin_amdgcn_fence(__ATOMIC_ACQUIRE, "agent");
            xb_add(&bar[XB_XGEN(b.x)], 1u);
            asm volatile("s_waitcnt vmcnt(0)" ::: "memory");
        } else {
            XB_SPIN(xb_ld(&bar[XB_XGEN(b.x)]) == gen, bar);
            __builtin_amdgcn_fence(__ATOMIC_ACQUIRE, "agent");
            asm volatile("s_waitcnt vmcnt(0)" ::: "memory");
        }
    }
    __syncthreads();
}

namespace pg8 {
constexpr int BM = 256, BK = 64, HALF = 128, HTB = HALF * BK * 2, STAGE_BYTES = 8 * HTB, NXCD = 8, WGM = 8;
__host__ __device__ __forceinline__ int lds_byte(int r, int c) { const int st = (r >> 4) * 2 + (c >> 5), rr = r & 15, cc = c & 31, ob = rr * 64 + cc * 2; return st * 1024 + (ob ^ (((ob >> 9) & 1) << 5)); }
__host__ __device__ __forceinline__ void stage_rc(int b, int& R, int& C) { const int st = b / 1024, sb = b % 1024, swz = sb ^ (((sb >> 9) & 1) << 5); R = (st >> 1) * 16 + swz / 64; C = (st & 1) * 32 + (swz % 64) / 2; }
__host__ __device__ __forceinline__ int perm32(int rho) { const int n = rho >> 4, i = rho & 15; return 8 * (i >> 2) + 4 * n + (i & 3); }
struct Unit { int pm, pn; };
struct StaticOrder {
    int nM, nN, nwg, G, c;
    __device__ void init(int nM_, int nN_, int G_, int c_) { nM = nM_; nN = nN_; nwg = nM * nN; G = G_; c = c_; }
    __device__ bool next(int i, Unit& u) const {
        const long L = (long)i * G + c; if (L >= nwg) return false;
        int wgid = (int)L; { const int q = nwg / NXCD, r = nwg % NXCD, xcd = wgid % NXCD, off = wgid / NXCD; wgid = (xcd < r ? xcd * (q + 1) : r * (q + 1) + (xcd - r) * q) + off; }
        const int nig = WGM * nN, gid = wgid / nig, fm = gid * WGM, gsz = (nM - fm) < WGM ? (nM - fm) : WGM;
        u.pm = fm + ((wgid % nig) % gsz); u.pn = (wgid % nig) / gsz; return true;
    }
};
template <class Epi, class Sched, class Addr>
__device__ __forceinline__ void gemm_phase(LAS unsigned char* lds, const char* Abase, const char* Bbase, int K, const Sched& S, const Addr& AD, const Epi& E) {
    const int tid = tid_opaque(), wid = __builtin_amdgcn_readfirstlane(tid >> 6), lane = tid & 63, wr = wid >> 2, wc = wid & 3, fr = lane & 15, fq = lane >> 4;
    const int nt = K / BK;
    int Rr[2]; unsigned Cc[2], voffB[2], voffA[2];
#pragma unroll
    for (int i = 0; i < 2; ++i) { int R, C; stage_rc(tid * 16 + i * 8192, R, C); const int Rb = Epi::PERM ? ((R & ~31) + perm32(R & 31)) : R;
        Rr[i] = R; Cc[i] = (unsigned)C * 2u; voffA[i] = (unsigned)(R * K + C) * 2u; voffB[i] = (unsigned)(Rb * K + C) * 2u; }
    const size_t kstep = (size_t)(BK * 2);
    const size_t hstep = (size_t)HALF * K * 2;
    const unsigned ldsw = (unsigned)wid * 1024u;
    const int aoff = lds_byte(wr * 64 + fr, fq * 8), boff = lds_byte(wc * 32 + fr, fq * 8);
#define PG8_SA(b, h) (((b) * 2 + (h)) * HTB)
#define PG8_SB(b, h) ((4 + (b) * 2 + (h)) * HTB)
#define PG8_STAGE(bufoff, gbase, voff) do { _Pragma("unroll") for (int _i = 0; _i < 2; ++_i) \
        __builtin_amdgcn_global_load_lds((const unsigned*)((const char*)(gbase) + (voff)[_i]), (LAS unsigned*)(lds + (bufoff) + ldsw + _i * 8192), 16, 0, 0); } while (0)
#define PG8_STAGE_A(bufoff, kb, h, un) do { if constexpr (Addr::LOADS) { _Pragma("unroll") for (int _i = 0; _i < 2; ++_i) \
        __builtin_amdgcn_global_load_lds((const unsigned*)(Abase + (kb) + ((un) ? on[h][_i] : oc[h][_i])), (LAS unsigned*)(lds + (bufoff) + ldsw + _i * 8192), 16, 0, 0); } \
      else { const char* _ab = ((un) ? nA : cA) + (kb) + (size_t)(h) * hstep; _Pragma("unroll") for (int _i = 0; _i < 2; ++_i) \
        __builtin_amdgcn_global_load_lds((const unsigned*)(_ab + voffA[_i]), (LAS unsigned*)(lds + (bufoff) + ldsw + _i * 8192), 16, 0, 0); } } while (0)
#define PG8_LDA(dst, b, h) do { _Pragma("unroll") for (int m = 0; m < 4; ++m) _Pragma("unroll") for (int k = 0; k < 2; ++k) dst[m][k] = *(const LAS bf16x8*)(lds + PG8_SA(b, h) + aoff + m * 2048 + k * 1024); } while (0)
#define PG8_LDB(dst, b, h) do { _Pragma("unroll") for (int n = 0; n < 2; ++n) _Pragma("unroll") for (int k = 0; k < 2; ++k) dst[n][k] = *(const LAS bf16x8*)(lds + PG8_SB(b, h) + boff + n * 2048 + k * 1024); } while (0)
#define PG8_MMA(ai, bj, At, Bt) do { __builtin_amdgcn_s_setprio(1); _Pragma("unroll") for (int m = 0; m < 4; ++m) _Pragma("unroll") for (int n = 0; n < 2; ++n) _Pragma("unroll") for (int k = 0; k < 2; ++k) \
        acc[ai][bj][m][n] = __builtin_amdgcn_mfma_f32_16x16x32_bf16(Bt[n][k], At[m][k], acc[ai][bj][m][n], 0, 0, 0); __builtin_amdgcn_s_setprio(0); } while (0)
#define PG8_WAIT_V(n) asm volatile("s_waitcnt vmcnt(" #n ")" ::: "memory")
#define PG8_WAIT_L(n) asm volatile("s_waitcnt lgkmcnt(" #n ")" ::: "memory")
#define PG8_BAR __builtin_amdgcn_s_barrier()
#define PG8_SCHED __builtin_amdgcn_sched_barrier(0)
    Unit cur, nxt; int ui = 0;
    if (!S.next(0, cur)) return;
    f32x4 acc[2][2][4][2];
#pragma unroll
    for (int a = 0; a < 2; ++a)
#pragma unroll
        for (int b = 0; b < 2; ++b)
#pragma unroll
            for (int m = 0; m < 4; ++m)
#pragma unroll
                for (int n = 0; n < 2; ++n) acc[a][b][m][n] = (f32x4){0.f, 0.f, 0.f, 0.f};
    bf16x8 At[4][2], B0[2][2], B1[2][2];
    unsigned oc[2][2], on[2][2];
    const char* cA = Abase; const char* nA = Abase;
    if constexpr (Addr::LOADS) {
#pragma unroll
        for (int h = 0; h < 2; ++h)
#pragma unroll
            for (int i = 0; i < 2; ++i) { oc[h][i] = AD.arow(cur, h * HALF + Rr[i]) + Cc[i]; on[h][i] = oc[h][i]; }
        PG8_WAIT_V(0);
    } else { cA = Abase + AD.arow(cur, 0); nA = cA; }
    const char* cB = Bbase + AD.boff(cur);
    PG8_STAGE(PG8_SB(0, 0), cB, voffB); PG8_STAGE_A(PG8_SA(0, 0), 0, 0, false); PG8_STAGE(PG8_SB(0, 1), cB + hstep, voffB); PG8_STAGE_A(PG8_SA(0, 1), 0, 1, false);
    if (wr == 1) PG8_BAR;
    PG8_WAIT_V(4); PG8_BAR;
    PG8_STAGE(PG8_SB(1, 0), cB + kstep, voffB); PG8_STAGE_A(PG8_SA(1, 0), kstep, 0, false); PG8_STAGE(PG8_SB(1, 1), cB + hstep + kstep, voffB);
    PG8_WAIT_V(6); PG8_BAR;
    for (;;) {
        const bool has_next = S.next(ui + 1, nxt);
        if (has_next) {
            if constexpr (Addr::LOADS) {
#pragma unroll
                for (int h = 0; h < 2; ++h)
#pragma unroll
                    for (int i = 0; i < 2; ++i) on[h][i] = AD.arow(nxt, h * HALF + Rr[i]) + Cc[i];
                PG8_WAIT_V(0);
            } else nA = Abase + AD.arow(nxt, 0);
        } else nA = cA;
        const char* nB = has_next ? Bbase + AD.boff(nxt) : cB;
        for (int t = 0; t < nt; t += 2) {
            const bool last = (t == nt - 2);
            const bool un = last && has_next;
            const size_t k1 = (size_t)(t + 1) * kstep;
            const size_t k2 = last ? 0 : (size_t)(t + 2) * kstep, k3 = k2 + kstep;
            const char* b2 = last ? nB : cB + (size_t)(t + 2) * kstep;
            const char* b3 = b2 + kstep;
            PG8_LDB(B0, 0, 0); PG8_SCHED; PG8_LDA(At, 0, 0); PG8_STAGE_A(PG8_SA(1, 1), k1, 1, false);
            PG8_WAIT_L(8); PG8_BAR; PG8_WAIT_L(0); PG8_MMA(0, 0, At, B0); PG8_BAR; PG8_SCHED;
            PG8_LDB(B1, 0, 1); PG8_STAGE(PG8_SB(0, 0), b2, voffB);
            PG8_BAR; PG8_WAIT_L(0); PG8_MMA(0, 1, At, B1); PG8_BAR;
            PG8_LDA(At, 0, 1); PG8_STAGE_A(PG8_SA(0, 0), k2, 0, un);
            PG8_BAR; PG8_WAIT_L(0); PG8_MMA(1, 0, At, B0); PG8_BAR; PG8_SCHED;
            PG8_STAGE(PG8_SB(0, 1), b2 + hstep, voffB);
            PG8_WAIT_V(6); PG8_BAR; PG8_MMA(1, 1, At, B1); PG8_BAR;
            PG8_LDB(B0, 1, 0); PG8_SCHED; PG8_LDA(At, 1, 0); PG8_STAGE_A(PG8_SA(0, 1), k2, 1, un);
            PG8_WAIT_L(8); PG8_BAR; PG8_WAIT_L(0); PG8_MMA(0, 0, At, B0); PG8_BAR; PG8_SCHED;
            PG8_LDB(B1, 1, 1); PG8_STAGE(PG8_SB(1, 0), b3, voffB);
            PG8_BAR; PG8_WAIT_L(0); PG8_MMA(0, 1, At, B1); PG8_BAR;
            PG8_LDA(At, 1, 1); PG8_STAGE_A(PG8_SA(1, 0), k3, 0, un);
            PG8_BAR; PG8_WAIT_L(0); PG8_MMA(1, 0, At, B0); PG8_BAR; PG8_SCHED;
            PG8_STAGE(PG8_SB(1, 1), b3 + hstep, voffB);
            PG8_WAIT_V(6); PG8_BAR; PG8_MMA(1, 1, At, B1); PG8_BAR;
        }
        E(acc, cur, wr, wc, fr, fq);
        if (!has_next) break;
#pragma unroll
        for (int a = 0; a < 2; ++a)
#pragma unroll
            for (int b = 0; b < 2; ++b)
#pragma unroll
                for (int m = 0; m < 4; ++m)
#pragma unroll
                    for (int n = 0; n < 2; ++n) acc[a][b][m][n] = (f32x4){0.f, 0.f, 0.f, 0.f};
        cur = nxt; cB = nB; cA = nA; ++ui;
        if constexpr (Addr::LOADS) {
#pragma unroll
            for (int h = 0; h < 2; ++h)
#pragma unroll
                for (int i = 0; i < 2; ++i) oc[h][i] = on[h][i]; }
    }
    PG8_WAIT_V(0);
    if (wr == 0) PG8_BAR;
    PG8_BAR;
#undef PG8_SA
#undef PG8_SB
#undef PG8_STAGE
#undef PG8_STAGE_A
#undef PG8_LDA
#undef PG8_LDB
#undef PG8_MMA
#undef PG8_WAIT_V
#undef PG8_WAIT_L
#undef PG8_BAR
#undef PG8_SCHED
}
}

#ifndef EN_HY
#define EN_HY 1
#endif
#ifndef EN_MA
#define EN_MA 1
#endif
#ifndef EN_AT
#define EN_AT 1
#endif
#ifndef EN_HG
#define EN_HG 1
#endif
#ifndef EN_MOE
#define EN_MOE 1
#endif

DI void transpose_item(const float* W, int ld, int k0, int n0, bf16_t* dst, int drow0, float scale, LAS float* scr, int lane) {
#pragma unroll 8
    for (int i = 0; i < 32; ++i) { const int kk = 2 * i + (lane >> 5); scr[kk * 33 + (lane & 31)] = W[(size_t)(k0 + kk) * ld + n0 + (lane & 31)]; }
    LDS_WAIT();
    const int c = lane & 7;
#pragma unroll
    for (int j = 0; j < 4; ++j) { const int n = (lane >> 3) + 8 * j; const LAS float* s = scr + (8 * c) * 33 + n;
        u32x4 o; o.x = pk2(s[0 * 33] * scale, s[1 * 33] * scale); o.y = pk2(s[2 * 33] * scale, s[3 * 33] * scale); o.z = pk2(s[4 * 33] * scale, s[5 * 33] * scale); o.w = pk2(s[6 * 33] * scale, s[7 * 33] * scale);
        *(u32x4*)(dst + (size_t)(drow0 + n) * 1024 + k0 + 8 * c) = o; }
    LDS_WAIT();
}

DI void hyena_filter_pos(const Params& P, int l, int pos, int lane, bf16_t* kfilt) {
    const float TWO_PI = 6.283185307179586f;
    const float tpos = (float)pos * (1.0f / 2047.0f);
    float z = 0.f;
    if (lane == 0) z = tpos;
    else if (lane <= 32) { const int bnd = (lane - 1) & 15; const float f = 1e-4f + (float)bnd * ((15.0f - 1e-4f) / 15.0f);
        const float angp = TWO_PI * (float)pos / 2048.0f; const float ang = angp * f; z = (lane <= 16) ? cosf(ang) : -sinf(ang); }
    const float* w1 = P.hy_w1 + (size_t)l * 33 * 64; const float* w2 = P.hy_w2 + (size_t)l * 64 * 64; const float* w3 = P.hy_w3 + (size_t)l * 64 * 512;
    const float fr = P.hy_freq[l * 64 + lane];
    float a = P.hy_b1[l * 64 + lane];
    for (int i = 0; i < 33; ++i) a += __shfl(z, i) * w1[i * 64 + lane];
    const float h1 = sinf(fr * a);
    float a2 = P.hy_b2[l * 64 + lane];
    for (int i = 0; i < 64; ++i) a2 += __shfl(h1, i) * w2[i * 64 + lane];
    const float h2 = sinf(fr * a2);
    float h3[8];
#pragma unroll
    for (int k = 0; k < 8; ++k) h3[k] = 0.f;
    for (int i = 0; i < 64; ++i) { const float hv = __shfl(h2, i);
#pragma unroll
        for (int k = 0; k < 8; ++k) h3[k] += hv * w3[i * 512 + k * 64 + lane]; }
    const float min_decay = -3.0701134573253944f, max_decay = -15.350567286626972f;
#pragma unroll
    for (int k = 0; k < 8; ++k) { const int cp = k * 64 + lane, c = cp & 255;
        const float delta = fabsf(min_decay + (float)c * ((max_decay - min_decay) / 255.0f));
        float v = h3[k] * expf(-tpos * delta);
        if (cp < 256) { if (pos == 0) { v += P.hy_fbias[l * 256 + c]; kfilt[(size_t)c * 4096 + 4095] = 0; } kfilt[(size_t)c * 4096 + 2047 - pos] = f2bf(v); }
        else if (pos >= 1) kfilt[(size_t)c * 4096 + 2047 + pos] = f2bf(v); }
}

template <bool FINAL>
DI void pre_row(const Params& P, int l, int m, int lane, const LAS f32x4* dtw, const float* nw) {
    unsigned char* ws = P.ws;
    float* XB = (float*)(ws + WS_XB);
    const bool first = (!FINAL && l == 0);
    const float* src = first ? P.x : XB;
    const f32x4* xr = (const f32x4*)(src + (size_t)m * DM) + lane;
    f32x4 v[4];
#pragma unroll
    for (int j = 0; j < 4; ++j) v[j] = xr[64 * j];
    if (!first && EN_MOE) {
        const int* slot = (const int*)(ws + WS_SLOT) + (size_t)m * 16; const int b = m >> 11;
        const bf16_t* YE = (const bf16_t*)(ws + WS_YE);
        for (int e = 0; e < 16; ++e) { const int s = __builtin_amdgcn_readfirstlane(slot[e]);
            if (s >= 0) { const u32x2* yr = (const u32x2*)(YE + ((size_t)((b * 16 + e) * 256 + s)) * DM) + lane;
#pragma unroll
                for (int j = 0; j < 4; ++j) { const u32x2 y = yr[64 * j]; v[j].x += bflo(y.x); v[j].y += bfhi(y.x); v[j].z += bflo(y.y); v[j].w += bfhi(y.y); } } }
    }
    float s = 0.f;
#pragma unroll
    for (int j = 0; j < 4; ++j) s += (v[j].x * v[j].x + v[j].y * v[j].y) + (v[j].z * v[j].z + v[j].w * v[j].w);
    const float r = 1.0f / sqrtf(wave_sum(s) * (1.0f / DM) + EPSN);
    if (FINAL) {
        f32x4* o = (f32x4*)(P.out + (size_t)m * DM) + lane;
#pragma unroll
        for (int j = 0; j < 4; ++j) { const f32x4 w = ((const f32x4*)nw)[64 * j + lane]; o[64 * j] = v[j] * r * w; }
        return;
    }
    if (!first) { f32x4* o = (f32x4*)(XB + (size_t)m * DM) + lane;
#pragma unroll
        for (int j = 0; j < 4; ++j) o[64 * j] = v[j]; }
    float d[8];
#pragma unroll
    for (int c = 0; c < 8; ++c) d[c] = 0.f;
#pragma unroll
    for (int j = 0; j < 4; ++j) {
        const float xv[4] = {v[j].x, v[j].y, v[j].z, v[j].w};
#pragma unroll
        for (int q = 0; q < 4; ++q) { const f32x4 w0 = dtw[((j * 4 + q) * 2 + 0) * 64 + lane], w1 = dtw[((j * 4 + q) * 2 + 1) * 64 + lane];
            d[0] += xv[q] * w0.x; d[1] += xv[q] * w0.y; d[2] += xv[q] * w0.z; d[3] += xv[q] * w0.w; d[4] += xv[q] * w1.x; d[5] += xv[q] * w1.y; d[6] += xv[q] * w1.z; d[7] += xv[q] * w1.w; }
    }
    float mine = 0.f;
#pragma unroll
    for (int c = 0; c < 8; ++c) { const float t = wave_sum(d[c]); mine = (lane == c) ? t : mine; }
    if (lane < 8) ((float*)(ws + WS_DT))[(size_t)m * 8 + lane] = mine * r;
    u32x2* o8 = (u32x2*)((bf16_t*)(ws + WS_HN) + (size_t)m * DM) + lane;
#pragma unroll
    for (int j = 0; j < 4; ++j) { const f32x4 w = ((const f32x4*)nw)[64 * j + lane]; u32x2 o; o.x = pk2(v[j].x * r * w.x, v[j].y * r * w.y); o.y = pk2(v[j].z * r * w.z, v[j].w * r * w.w); o8[64 * j] = o; }
}

DI void phase_pre(const Params& P, int l, LAS unsigned char* lds) {
    const int tid = tid_opaque(), lane = tid & 63, wave = tid >> 6;
    const int gw = blockIdx.x * 8 + wave, NGW = gridDim.x * 8;
    unsigned char* ws = P.ws;
    LAS float* dtwf = (LAS float*)lds;
    for (int i = tid; i < 1024 * 8; i += 512) { const int k = i >> 3, c = i & 7; const int j = k >> 8, ln = (k & 255) >> 2, q = k & 3;
        dtwf[((((j * 4 + q) * 2 + (c >> 2)) * 64 + ln) << 2) + (c & 3)] = P.norm_mix_w[l * DM + k] * P.w_in[((size_t)l * DM + k) * NIN_REF + 1536 + c]; }
    __syncthreads();
    if (EN_HY) for (int pos = gw; pos < SEQ; pos += NGW) hyena_filter_pos(P, l, pos, lane, (bf16_t*)(ws + WS_KFILT));
    {
        LAS float* scr = (LAS float*)(lds + 32768 + wave * 8448);
        constexpr int I_A = 16 * 48, I_B = 16 * 64, I_O = 16 * 32, I_E = 16 * 32 * 16;
        constexpr int NITEMS = I_A + I_B + I_O; (void)I_E;
        bf16_t* WinT = (bf16_t*)(ws + WS_WIN); bf16_t* WoutT = (bf16_t*)(ws + WS_WOUT); bf16_t* WguT = (bf16_t*)(ws + WS_WGU); bf16_t* WdT = (bf16_t*)(ws + WS_WD);
        for (int it = gw; it < NITEMS; it += NGW) {
            int r = it;
            if (r < I_A) { const int kb = r / 48, nb = r % 48; transpose_item(P.w_in + (size_t)l * DM * NIN_REF, NIN_REF, 64 * kb, 32 * nb, WinT, 32 * nb, 1.0f, scr, lane); continue; } r -= I_A;
            if (r < I_B) { const int kb = r / 64, nb = r % 64; const int drow = 1536 + 32 * nb; transpose_item(P.w_in + (size_t)l * DM * NIN_REF, NIN_REF, 64 * kb, 1544 + 32 * nb, WinT, drow, drow < PC_AK ? 0.125f : 1.0f, scr, lane); continue; } r -= I_B;
            { const int kb = r / 32, nb = r % 32; transpose_item(P.w_out + (size_t)l * DM * DM, DM, 64 * kb, 32 * nb, WoutT, 32 * nb, 1.0f, scr, lane); }
            (void)WguT; (void)WdT;
        }
    }
    const float* nw = P.norm_mix_w + l * DM;
    for (int m = gw; m < NTOK; m += NGW) { asm volatile("" ::: "memory"); pre_row<false>(P, l, m, lane, (const LAS f32x4*)dtwf, nw); }
}
DI void phase_final(const Params& P) {
    const int tid = tid_opaque(), lane = tid & 63, wave = tid >> 6;
    const int gw = blockIdx.x * 8 + wave, NGW = gridDim.x * 8;
    for (int m = gw; m < NTOK; m += NGW) pre_row<true>(P, 1, m, lane, nullptr, P.final_w);
}

struct AddrPlain { static constexpr bool LOADS = false; int K; int nb_rows;
    DI unsigned arow(const pg8::Unit& u, int r) const { return (unsigned)(u.pm * 256 + r) * (unsigned)(K * 2); }
    DI size_t boff(const pg8::Unit& u) const { return (size_t)u.pn * 256 * K * 2; } };
struct AddrGateUp { static constexpr bool LOADS = true; const int* seli;
    DI unsigned arow(const pg8::Unit& u, int r) const { const int b = u.pm >> 4; const int t = seli[u.pm * 256 + r]; return (unsigned)(b * SEQ + t) * (unsigned)(DM * 2); }
    DI size_t boff(const pg8::Unit& u) const { return ((size_t)(u.pm & 15) * 2048 + (size_t)u.pn * 256) * DM * 2; } };
struct AddrDown { static constexpr bool LOADS = false;
    DI unsigned arow(const pg8::Unit& u, int r) const { return (unsigned)(u.pm * 256 + r) * (unsigned)(DM * 2); }
    DI size_t boff(const pg8::Unit& u) const { return ((size_t)(u.pm & 15) * 1024 + (size_t)u.pn * 256) * DM * 2; } };

struct EpiProj { static constexpr bool PERM = true; bf16_t* O;
    DI void operator()(const f32x4 (&acc)[2][2][4][2], const pg8::Unit& u, int wr, int wc, int fr, int fq) const {
        const int row0 = u.pm * 256 + wr * 64 + fr, col0 = u.pn * 256 + wc * 32 + 8 * fq;
#pragma unroll
        for (int ai = 0; ai < 2; ++ai)
#pragma unroll
            for (int m = 0; m < 4; ++m) { bf16_t* rowp = O + (size_t)(row0 + ai * 128 + m * 16) * NPROJ + col0;
#pragma unroll
                for (int bj = 0; bj < 2; ++bj) { const f32x4 v0 = acc[ai][bj][m][0], v1 = acc[ai][bj][m][1];
                    u32x4 w; w.x = pk2(v0[0], v0[1]); w.y = pk2(v0[2], v0[3]); w.z = pk2(v1[0], v1[1]); w.w = pk2(v1[2], v1[3]);
                    *(u32x4*)(rowp + bj * 128) = w; } }
    } };
struct EpiRes { static constexpr bool PERM = false; const float* base; float* out;
    DI void operator()(const f32x4 (&acc)[2][2][4][2], const pg8::Unit& u, int wr, int wc, int fr, int fq) const {
        const int row0 = u.pm * 256 + wr * 64 + fr, col0 = u.pn * 256 + wc * 32 + 4 * fq;
#pragma unroll
        for (int ai = 0; ai < 2; ++ai)
#pragma unroll
            for (int m = 0; m < 4; ++m) { const size_t off = (size_t)(row0 + ai * 128 + m * 16) * DM + col0;
#pragma unroll
                for (int bj = 0; bj < 2; ++bj)
#pragma unroll
                    for (int n = 0; n < 2; ++n) { const f32x4 bs = *(const f32x4*)(base + off + bj * 128 + n * 16); *(f32x4*)(out + off + bj * 128 + n * 16) = bs + acc[ai][bj][m][n]; } }
    } };
struct EpiGateUp { static constexpr bool PERM = true; bf16_t* H; const float* selr;
    DI void operator()(const f32x4 (&acc)[2][2][4][2], const pg8::Unit& u, int wr, int wc, int fr, int fq) const {
        const int row0 = u.pm * 256 + wr * 64 + fr, col0 = u.pn * 128 + wc * 32 + 8 * fq;
#pragma unroll
        for (int ai = 0; ai < 2; ++ai)
#pragma unroll
            for (int m = 0; m < 4; ++m) { bf16_t* rowp = H + (size_t)(row0 + ai * 128 + m * 16) * DM + col0; const float rr = selr[row0 + ai * 128 + m * 16];
                float hv[8];
#pragma unroll
                for (int n = 0; n < 2; ++n)
#pragma unroll
                    for (int j = 0; j < 4; ++j) { const float g = acc[ai][0][m][n][j] * rr, up = acc[ai][1][m][n][j] * rr; hv[n * 4 + j] = silu_f(g) * up; }
                u32x4 w; w.x = pk2(hv[0], hv[1]); w.y = pk2(hv[2], hv[3]); w.z = pk2(hv[4], hv[5]); w.w = pk2(hv[6], hv[7]);
                *(u32x4*)rowp = w; }
    } };
struct EpiDown { static constexpr bool PERM = true; bf16_t* Y; const float* gate;
    DI void operator()(const f32x4 (&acc)[2][2][4][2], const pg8::Unit& u, int wr, int wc, int fr, int fq) const {
        const int row0 = u.pm * 256 + wr * 64 + fr, col0 = u.pn * 256 + wc * 32 + 8 * fq;
#pragma unroll
        for (int ai = 0; ai < 2; ++ai)
#pragma unroll
            for (int m = 0; m < 4; ++m) { const int row = row0 + ai * 128 + m * 16; const float g = gate[row]; bf16_t* rowp = Y + (size_t)row * DM + col0;
#pragma unroll
                for (int bj = 0; bj < 2; ++bj) { const f32x4 v0 = acc[ai][bj][m][0] * g, v1 = acc[ai][bj][m][1] * g;
                    u32x4 w; w.x = pk2(v0[0], v0[1]); w.y = pk2(v0[2], v0[3]); w.z = pk2(v1[0], v1[1]); w.w = pk2(v1[2], v1[3]);
                    *(u32x4*)(rowp + bj * 128) = w; } }
    } };

DI void phase_premix(const Params& P, int l) {
    const int tid = tid_opaque(), lane = tid & 63, wave = tid >> 6;
    const int gw = blockIdx.x * 8 + wave, NGW = gridDim.x * 8;
    unsigned char* ws = P.ws;
    const bf16_t* proj = (const bf16_t*)(ws + WS_PROJ);
    unsigned char* dsc = (unsigned char*)P.out;
    if (EN_HY) {
        bf16_t* HW = (bf16_t*)(dsc + DO_HW); bf16_t* HX0 = (bf16_t*)(dsc + DO_HX0);
        const float* cw = P.hy_conv_w + (size_t)l * 3 * 768;
        for (int it = gw; it < NB * 32 * 4; it += NGW) {
            const int ct = it & 3, tt = (it >> 2) & 31, b = it >> 7;
            const int c = ct * 64 + lane, t0 = tt * 64;
            float w0[3], w1[3], w2[3];
#pragma unroll
            for (int j = 0; j < 3; ++j) { w0[j] = cw[j * 768 + c]; w1[j] = cw[j * 768 + 256 + c]; w2[j] = cw[j * 768 + 512 + c]; }
            const bf16_t* pr = proj + (size_t)b * SEQ * NPROJ + c;
            bf16_t* hwp = HW + ((size_t)c * NB + b) * SEQ + t0; bf16_t* hxp = HX0 + ((size_t)c * NB + b) * SEQ + t0;
            float a0, a1, a2, b0, b1, b2, c0, c1, c2;
            { const int t = t0 - 1; const bool ok = t >= 0; const bf16_t* q = pr + (size_t)(ok ? t : 0) * NPROJ; a0 = ok ? bf2f(q[0]) : 0.f; a1 = ok ? bf2f(q[256]) : 0.f; a2 = ok ? bf2f(q[512]) : 0.f; }
            { const bf16_t* q = pr + (size_t)t0 * NPROJ; b0 = bf2f(q[0]); b1 = bf2f(q[256]); b2 = bf2f(q[512]); }
#pragma unroll 1
            for (int t8 = 0; t8 < 64; t8 += 8) {
                unsigned hwv[4], hxv[4]; float ph = 0.f, px = 0.f;
#pragma unroll
                for (int i = 0; i < 8; ++i) { const int t = t0 + t8 + i + 1; const bool ok = t < SEQ; const bf16_t* q = pr + (size_t)(ok ? t : SEQ - 1) * NPROJ;
                    c0 = ok ? bf2f(q[0]) : 0.f; c1 = ok ? bf2f(q[256]) : 0.f; c2 = ok ? bf2f(q[512]) : 0.f;
                    const float u0 = w0[0] * a0 + w0[1] * b0 + w0[2] * c0, u1 = w1[0] * a1 + w1[1] * b1 + w1[2] * c1, u2 = w2[0] * a2 + w2[1] * b2 + w2[2] * c2;
                    const float hv = u2 * u1;
                    if (i & 1) { hwv[i >> 1] = pk2(ph, hv); hxv[i >> 1] = pk2(px, u0); } else { ph = hv; px = u0; }
                    a0 = b0; a1 = b1; a2 = b2; b0 = c0; b1 = c1; b2 = c2; }
                *(u32x4*)(hwp + t8) = (u32x4){hwv[0], hwv[1], hwv[2], hwv[3]}; *(u32x4*)(hxp + t8) = (u32x4){hxv[0], hxv[1], hxv[2], hxv[3]};
            }
        }
    }
    if (EN_MA) {
        bf16_t* MX = (bf16_t*)(dsc + DO_MXBC);
        const float* cw = P.m_conv_w + (size_t)l * 5 * 512; const float* cb = P.m_conv_b + (size_t)l * 512;
        const int gt = blockIdx.x * 512 + tid, NGT = gridDim.x * 512;
        for (int it = gt; it < NTOK * 64; it += NGT) {
            const int ch = (it & 63) * 8, m = it >> 6, t = m & (SEQ - 1);
            float a[8];
#pragma unroll
            for (int i = 0; i < 8; ++i) a[i] = cb[ch + i];
#pragma unroll
            for (int j = 0; j < 5; ++j) { const int tt = t + j - 2; if (tt >= 0 && tt < SEQ) {
                const u32x4 v = *(const u32x4*)(proj + (size_t)(m + j - 2) * NPROJ + PC_MX + ch);
                const f32x4 wa = *(const f32x4*)(cw + j * 512 + ch), wb = *(const f32x4*)(cw + j * 512 + ch + 4);
                a[0] += wa.x * bflo(v.x); a[1] += wa.y * bfhi(v.x); a[2] += wa.z * bflo(v.y); a[3] += wa.w * bfhi(v.y);
                a[4] += wb.x * bflo(v.z); a[5] += wb.y * bfhi(v.z); a[6] += wb.z * bflo(v.w); a[7] += wb.w * bfhi(v.w); } }
            u32x4 o; o.x = pk2(silu_f(a[0]), silu_f(a[1])); o.y = pk2(silu_f(a[2]), silu_f(a[3])); o.z = pk2(silu_f(a[4]), silu_f(a[5])); o.w = pk2(silu_f(a[6]), silu_f(a[7]));
            *(u32x4*)(MX + (size_t)m * 512 + ch) = o;
        }
    }
}

DI void phase_finalize(const Params& P, int l) {
    const int tid = tid_opaque(), lane = tid & 63, wave = tid >> 6;
    const int gw = blockIdx.x * 8 + wave, NGW = gridDim.x * 8;
    unsigned char* ws = P.ws; unsigned char* dsc = (unsigned char*)P.out;
    bf16_t* MIX = (bf16_t*)(ws + WS_HN);
    {
        const bf16_t* YAT = (const bf16_t*)(dsc + DO_YAT);
        for (int it = gw; it < NB * 32 * 4; it += NGW) {
            const int ct = it & 3, tt = (it >> 2) & 31, b = it >> 7;
            const int c = ct * 64 + lane, t0 = tt * 64;
            const bf16_t* src = YAT + ((size_t)c * NB + b) * SEQ + t0;
            bf16_t* dst = MIX + ((size_t)b * SEQ + t0) * DM + c;
#pragma unroll 2
            for (int t8 = 0; t8 < 64; t8 += 8) {
                u32x4 v = EN_HY ? *(const u32x4*)(src + t8) : (u32x4){0u, 0u, 0u, 0u};
                const unsigned w[4] = {v.x, v.y, v.z, v.w};
#pragma unroll
                for (int i = 0; i < 8; ++i) dst[(size_t)(t8 + i) * DM] = (bf16_t)((i & 1) ? (w[i >> 1] >> 16) : (w[i >> 1] & 0xffffu));
            }
        }
    }
    {
        const bf16_t* MYF = (const bf16_t*)(dsc + DO_MY); const bf16_t* MYB = (const bf16_t*)(ws + WS_MYB); const bf16_t* MX = (const bf16_t*)(dsc + DO_MXBC);
        const bf16_t* proj = (const bf16_t*)(ws + WS_PROJ); const float* nw = P.m_norm_w + l * 256;
        const int gt = blockIdx.x * 512 + tid, NGT = gridDim.x * 512;
        for (int it = gt; it < NTOK * 32; it += NGT) {
            const int ch = (it & 31) * 8, m = it >> 5;
            u32x4 o = {0u, 0u, 0u, 0u};
            if (EN_MA) {
                const u32x4 yf = *(const u32x4*)(MYF + (size_t)m * 256 + ch), yb = *(const u32x4*)(MYB + (size_t)m * 256 + ch), xv = *(const u32x4*)(MX + (size_t)m * 512 + ch), zv = *(const u32x4*)(proj + (size_t)m * NPROJ + PC_MZ + ch);
                const float Dk = P.m_D[l * 4 + (ch >> 6)];
                const unsigned yfw[4] = {yf.x, yf.y, yf.z, yf.w}, ybw[4] = {yb.x, yb.y, yb.z, yb.w}, xw[4] = {xv.x, xv.y, xv.z, xv.w}, zw[4] = {zv.x, zv.y, zv.z, zv.w};
                float y[8]; float sq = 0.f;
#pragma unroll
                for (int j = 0; j < 4; ++j) { y[2 * j] = (bflo(yfw[j]) + bflo(ybw[j]) + Dk * bflo(xw[j])) * silu_f(bflo(zw[j])); y[2 * j + 1] = (bfhi(yfw[j]) + bfhi(ybw[j]) + Dk * bfhi(xw[j])) * silu_f(bfhi(zw[j]));
                    sq += y[2 * j] * y[2 * j] + y[2 * j + 1] * y[2 * j + 1]; }
#pragma unroll
                for (int of = 1; of < 32; of <<= 1) sq += __shfl_xor(sq, of);
                const float r = 1.0f / sqrtf(sq * (1.0f / 256.0f) + EPSN);
                const f32x4 wa = *(const f32x4*)(nw + ch), wb = *(const f32x4*)(nw + ch + 4);
                o.x = pk2(y[0] * r * wa.x, y[1] * r * wa.y); o.y = pk2(y[2] * r * wa.z, y[3] * r * wa.w); o.z = pk2(y[4] * r * wb.x, y[5] * r * wb.y); o.w = pk2(y[6] * r * wb.z, y[7] * r * wb.w);
            }
            *(u32x4*)(MIX + (size_t)m * DM + 256 + ch) = o;
        }
    }
    if (EN_HG) {
        const bf16_t* OB = (const bf16_t*)(ws + WS_OB); const bf16_t* proj = (const bf16_t*)(ws + WS_PROJ); const float* nw = P.hg_norm_w + l * 64;
        const int gt = blockIdx.x * 512 + tid, NGT = gridDim.x * 512;
        for (int it = gt; it < NTOK * 32; it += NGT) {
            const int ch = (it & 31) * 8, m = it >> 5;
            const u32x4 of = *(const u32x4*)(MIX + (size_t)m * DM + 768 + ch), ob = *(const u32x4*)(OB + (size_t)m * 256 + ch), gv = *(const u32x4*)(proj + (size_t)m * NPROJ + PC_HG + ch);
            const unsigned ofw[4] = {of.x, of.y, of.z, of.w}, obw[4] = {ob.x, ob.y, ob.z, ob.w}, gw4[4] = {gv.x, gv.y, gv.z, gv.w};
            float y[8]; float sq = 0.f;
#pragma unroll
            for (int j = 0; j < 4; ++j) { y[2 * j] = bflo(ofw[j]) + bflo(obw[j]); y[2 * j + 1] = bfhi(ofw[j]) + bfhi(obw[j]); sq += y[2 * j] * y[2 * j] + y[2 * j + 1] * y[2 * j + 1]; }
#pragma unroll
            for (int o2 = 1; o2 < 8; o2 <<= 1) sq += __shfl_xor(sq, o2);
            const float r = 1.0f / sqrtf(sq * (1.0f / 64.0f) + EPSN);
            const f32x4 wa = *(const f32x4*)(nw + (ch & 63)), wb = *(const f32x4*)(nw + (ch & 63) + 4);
            u32x4 o;
            o.x = pk2(y[0] * r * wa.x * silu_f(bflo(gw4[0])), y[1] * r * wa.y * silu_f(bfhi(gw4[0]))); o.y = pk2(y[2] * r * wa.z * silu_f(bflo(gw4[1])), y[3] * r * wa.w * silu_f(bfhi(gw4[1])));
            o.z = pk2(y[4] * r * wb.x * silu_f(bflo(gw4[2])), y[5] * r * wb.y * silu_f(bfhi(gw4[2]))); o.w = pk2(y[6] * r * wb.z * silu_f(bflo(gw4[3])), y[7] * r * wb.w * silu_f(bfhi(gw4[3])));
            *(u32x4*)(MIX + (size_t)m * DM + 768 + ch) = o;
        }
    }
#if !EN_AT || !EN_HG
    {
        const int gt = blockIdx.x * 512 + tid, NGT = gridDim.x * 512;
        for (int it = gt; it < NTOK * 32; it += NGT) { const int ch = (it & 31) * 8, m = it >> 5;
            if (!EN_AT) *(u32x4*)(MIX + (size_t)m * DM + 512 + ch) = (u32x4){0u, 0u, 0u, 0u};
            if (!EN_HG) *(u32x4*)(MIX + (size_t)m * DM + 768 + ch) = (u32x4){0u, 0u, 0u, 0u}; }
    }
#endif
}

DI void phase_ffnpre(const Params& P, int l, LAS unsigned char* lds) {
    const int tid = tid_opaque(), lane = tid & 63, wave = tid >> 6, r = lane & 15, q = lane >> 4;
    const int gw = blockIdx.x * 8 + wave, NGW = gridDim.x * 8;
    unsigned char* ws = P.ws;
    LAS u32x4* Wh = (LAS u32x4*)lds;
    LAS u32x4* Wl = Wh + 32 * 64;
    for (int i = tid; i < 32 * 64; i += 512) { const int s = i >> 6, ln = i & 63, e = ln & 15, qq = ln >> 4; float wv[8]; unsigned hi[4], lo[4];
#pragma unroll
        for (int j = 0; j < 8; ++j) { const int k = 32 * s + 8 * qq + j; wv[j] = P.norm_ffn_w[l * DM + k] * P.router_w[((size_t)l * DM + k) * 16 + e]; }
#pragma unroll
        for (int j = 0; j < 4; ++j) { hi[j] = pk2(wv[2 * j], wv[2 * j + 1]); lo[j] = pk2(wv[2 * j] - bflo(hi[j]), wv[2 * j + 1] - bfhi(hi[j])); }
        Wh[i] = (u32x4){hi[0], hi[1], hi[2], hi[3]}; Wl[i] = (u32x4){lo[0], lo[1], lo[2], lo[3]}; }
    __syncthreads();
    const float* XB = (const float*)(ws + WS_XB); const float* nw = P.norm_ffn_w + l * DM + 8 * q;
    float* aff = (float*)(ws + WS_AFF); float* rs = (float*)(ws + WS_RS);
    bf16_t* XN = (bf16_t*)(ws + WS_HN);
    for (int grp = gw; grp < NTOK / 16; grp += NGW) {
        const int m0 = grp * 16;
        const float* xrow = XB + (size_t)(m0 + r) * DM + 8 * q; bf16_t* orow = XN + (size_t)(m0 + r) * DM + 8 * q;
        f32x4 acc = {0.f, 0.f, 0.f, 0.f}; float ss = 0.f;
#pragma unroll 4
        for (int s = 0; s < 32; ++s) {
            const f32x4 a = *(const f32x4*)(xrow + 32 * s), b = *(const f32x4*)(xrow + 32 * s + 4);
            const f32x4 wa = *(const f32x4*)(nw + 32 * s), wb = *(const f32x4*)(nw + 32 * s + 4);
            ss += (a.x * a.x + a.y * a.y) + (a.z * a.z + a.w * a.w) + (b.x * b.x + b.y * b.y) + (b.z * b.z + b.w * b.w);
            const unsigned h0 = pk2(a.x, a.y), h1 = pk2(a.z, a.w), h2 = pk2(b.x, b.y), h3 = pk2(b.z, b.w);
            const unsigned l0 = pk2(a.x - bflo(h0), a.y - bfhi(h0)), l1 = pk2(a.z - bflo(h1), a.w - bfhi(h1)), l2 = pk2(b.x - bflo(h2), b.y - bfhi(h2)), l3 = pk2(b.z - bflo(h3), b.w - bfhi(h3));
            const bf16x8 ah = mk8u(h0, h1, h2, h3), al = mk8u(l0, l1, l2, l3);
            const bf16x8 wh = __builtin_bit_cast(bf16x8, Wh[s * 64 + lane]), wl = __builtin_bit_cast(bf16x8, Wl[s * 64 + lane]);
            acc = __builtin_amdgcn_mfma_f32_16x16x32_bf16(ah, wh, acc, 0, 0, 0);
            acc = __builtin_amdgcn_mfma_f32_16x16x32_bf16(ah, wl, acc, 0, 0, 0);
            acc = __builtin_amdgcn_mfma_f32_16x16x32_bf16(al, wh, acc, 0, 0, 0);
            *(u32x4*)(orow + 32 * s) = (u32x4){pk2(a.x * wa.x, a.y * wa.y), pk2(a.z * wa.z, a.w * wa.w), pk2(b.x * wb.x, b.y * wb.y), pk2(b.z * wb.z, b.w * wb.w)};
        }
        ss += __shfl_xor(ss, 16); ss += __shfl_xor(ss, 32);
        const float rinv = 1.0f / sqrtf(ss * (1.0f / DM) + EPSN);
        if (q == 0) rs[m0 + r] = rinv;
#pragma unroll
        for (int i = 0; i < 4; ++i) {
            const float lg = acc[i] * __shfl(rinv, 4 * q + i);
            float mx = lg;
#pragma unroll
            for (int o = 1; o < 16; o <<= 1) mx = fmaxf(mx, __shfl_xor(mx, o));
            const float ex = expf(lg - mx); float se = ex;
#pragma unroll
            for (int o = 1; o < 16; o <<= 1) se += __shfl_xor(se, o);
            const int m = m0 + 4 * q + i;
            aff[((size_t)(m >> 11) * 16 + r) * SEQ + (m & (SEQ - 1))] = ex / se;
        }
    }
}

DI int wave_sum_i(int v) {
#pragma unroll
    for (int o = 1; o < 64; o <<= 1) v += __shfl_xor(v, o);
    return v;
}
DI int block_excl_scan(int c, int lane, int wave, LAS int* ws8, int* tot) {
    int inc = c;
#pragma unroll
    for (int o = 1; o < 64; o <<= 1) { const int t = __shfl_up(inc, o); if (lane >= o) inc += t; }
    if (lane == 63) ws8[wave] = inc;
    __syncthreads();
    int base = 0, total = 0;
#pragma unroll
    for (int w = 0; w < 8; ++w) { const int t = ws8[w]; base += (w < wave) ? t : 0; total += t; }
    *tot = total;
    return base + inc - c;
}
DI void phase_topk(const Params& P, int l, LAS unsigned char* lds) {
    const int tid = tid_opaque(), lane = tid & 63, wave = tid >> 6;
    unsigned char* ws = P.ws;
    const float* aff = (const float*)(ws + WS_AFF); const float* rs = (const float*)(ws + WS_RS);
    int* slot = (int*)(ws + WS_SLOT); int* seli = (int*)(ws + WS_SELI); float* selg = (float*)(ws + WS_SELG); float* selr = (float*)(ws + WS_SELR);
    LAS int* wsum = (LAS int*)lds;
    for (int u = blockIdx.x; u < NB * NEXP; u += gridDim.x) {
        const int b = u >> 4, e = u & 15;
        __syncthreads();
        const u32x4 k4 = *(const u32x4*)(aff + (size_t)u * SEQ + 4 * tid);
        const unsigned kk[4] = {k4.x, k4.y, k4.z, k4.w};
        unsigned prefix = 0u;
#pragma unroll 1
        for (int bit = 30; bit >= 0; --bit) {
            const unsigned cand = prefix | (1u << bit);
            int c = (kk[0] >= cand) + (kk[1] >= cand) + (kk[2] >= cand) + (kk[3] >= cand);
            c = wave_sum_i(c);
            if (lane == 0) wsum[(bit & 1) * 8 + wave] = c;
            __syncthreads();
            int tot = 0;
#pragma unroll
            for (int w = 0; w < 8; ++w) tot += wsum[(bit & 1) * 8 + w];
            if (tot >= CAP) prefix = cand;
        }
        const unsigned thr = prefix;
        int cgt = (kk[0] > thr) + (kk[1] > thr) + (kk[2] > thr) + (kk[3] > thr), ngt;
        (void)block_excl_scan(cgt, lane, wave, wsum + 16, &ngt);
        const int need = CAP - ngt;
        const int ceq = (kk[0] == thr) + (kk[1] == thr) + (kk[2] == thr) + (kk[3] == thr); int neq;
        int eqr = block_excl_scan(ceq, lane, wave, wsum + 24, &neq);
        bool sel[4]; int cs = 0;
#pragma unroll
        for (int j = 0; j < 4; ++j) { const bool eq = kk[j] == thr; sel[j] = (kk[j] > thr) || (eq && eqr < need); eqr += eq ? 1 : 0; cs += sel[j] ? 1 : 0; }
        int nsel; int sb = block_excl_scan(cs, lane, wave, wsum + 32, &nsel);
#pragma unroll
        for (int j = 0; j < 4; ++j) { const int i = 4 * tid + j;
            slot[((size_t)b * SEQ + i) * 16 + e] = sel[j] ? sb : -1;
            if (sel[j]) { seli[u * CAP + sb] = i; selg[u * CAP + sb] = __uint_as_float(kk[j]); selr[u * CAP + sb] = rs[(size_t)b * SEQ + i]; ++sb; } }
    }
    __syncthreads();
    {
        const int gw = blockIdx.x * 8 + wave, NGW = gridDim.x * 8;
        LAS float* scr = (LAS float*)(lds + 4096 + wave * 8448);
        bf16_t* WguT = (bf16_t*)(ws + WS_WGU); bf16_t* WdT = (bf16_t*)(ws + WS_WD);
        constexpr int I_E = 16 * 32 * 16;
        for (int it = gw; it < 3 * I_E; it += NGW) {
            const int which = it / I_E; const int r = it - which * I_E;
            const int e = r / 512, kb = (r % 512) / 32, nb = r % 32;
            const size_t wofs = ((size_t)l * NEXP + e) * DM * DM;
            if (which == 0)      transpose_item(P.moe_wg + wofs, DM, 64 * kb, 32 * nb, WguT, e * 2048 + ((32 * nb) >> 7) * 256 + ((32 * nb) & 127), 1.0f, scr, lane);
            else if (which == 1) transpose_item(P.moe_wu + wofs, DM, 64 * kb, 32 * nb, WguT, e * 2048 + ((32 * nb) >> 7) * 256 + 128 + ((32 * nb) & 127), 1.0f, scr, lane);
            else                 transpose_item(P.moe_wd + wofs, DM, 64 * kb, 32 * nb, WdT, e * 1024 + 32 * nb, 1.0f, scr, lane);
        }
    }
}

DI bf16x8 mk8(unsigned a, unsigned b, unsigned c, unsigned d) { u32x4 v = {a, b, c, d}; return __builtin_bit_cast(bf16x8, v); }
DI bf16x8 cat44(u32x2 lo, u32x2 hi) { u32x4 v = {lo.x, lo.y, hi.x, hi.y}; return __builtin_bit_cast(bf16x8, v); }
DI u32x4 ldg16(const void* ub, unsigned off) { return *(const u32x4*)((const char*)ub + off); }
DI u32x2 ldg8(const void* ub, unsigned off) { return *(const u32x2*)((const char*)ub + off); }
DI void stg2(void* ub, unsigned off, unsigned short v) { *(unsigned short*)((char*)ub + off) = v; }
DI int crow(int reg, int hh) { return (reg & 3) + 8 * (reg >> 2) + 4 * hh; }
#define PACK_STEP(x, s) mk8(pk2((x)[8 * (s)], (x)[8 * (s) + 1]), pk2((x)[8 * (s) + 2], (x)[8 * (s) + 3]), pk2((x)[8 * (s) + 4], (x)[8 * (s) + 5]), pk2((x)[8 * (s) + 6], (x)[8 * (s) + 7]))

DI void hyena_unit(const Params& P, int c, LAS unsigned char* lds) {
    const int tid = tid_opaque(), lane = tid & 63, w = __builtin_amdgcn_readfirstlane(tid >> 6), r = lane & 31, hh = lane >> 5;
    constexpr int CPS = 8224;
    unsigned char* ws = P.ws; unsigned char* dsc = (unsigned char*)P.out;
    const bf16_t* kf = (const bf16_t*)(ws + WS_KFILT) + (size_t)c * 4096;
    __syncthreads();
    for (int idx = tid; idx < 8 * 4096; idx += 512) { const int p = idx >> 12, i = idx & 4095, mi = i + p;
        *(LAS bf16_t*)(lds + p * CPS + i * 2) = (mi < 4096) ? kf[mi] : (bf16_t)0; }
    __syncthreads();
    const bf16_t* hw = (const bf16_t*)(dsc + DO_HW) + ((size_t)c * NB + r) * SEQ + 8 * hh;
    f32x16 acc[8];
#pragma unroll
    for (int i = 0; i < 8; ++i)
#pragma unroll
        for (int q = 0; q < 16; ++q) acc[i][q] = 0.f;
    const int p = 7 - (r & 7);
    const LAS unsigned char* abase = lds + p * CPS + (2047 - 256 * w - r + 8 * hh - p) * 2;
#pragma unroll 2
    for (int s0 = 0; s0 < SEQ; s0 += 16) {
        const bf16x8 bfr = *(const bf16x8*)(hw + s0);
#pragma unroll
        for (int i = 0; i < 8; ++i) { const bf16x8 afr = *(const LAS bf16x8*)(abase + (s0 - 32 * i) * 2); acc[i] = MFMA32(afr, bfr, acc[i]); }
    }
    const bf16_t* hx = (const bf16_t*)(dsc + DO_HX0) + ((size_t)c * NB + r) * SEQ;
    bf16_t* ya = (bf16_t*)(dsc + DO_YAT) + ((size_t)c * NB + r) * SEQ;
#pragma unroll
    for (int i = 0; i < 8; ++i)
#pragma unroll
        for (int g = 0; g < 4; ++g) { const int t = 256 * w + 32 * i + 8 * g + 4 * hh;
            const u32x2 xv = *(const u32x2*)(hx + t);
            u32x2 o; o.x = pk2(acc[i][4 * g] * bflo(xv.x), acc[i][4 * g + 1] * bfhi(xv.x)); o.y = pk2(acc[i][4 * g + 2] * bflo(xv.y), acc[i][4 * g + 3] * bfhi(xv.y));
            *(u32x2*)(ya + t) = o; }
}

DI int t5_bucket(int rel) {
    const int ret = rel > 0 ? 16 : 0; const int n = rel < 0 ? -rel : rel;
    if (n < 8) return ret + n;
    const float nf = (float)n;
    int large = 8 + (int)(logf(nf / 8.0f) / 4.852030263919617f * 8.0f);
    large = large < 15 ? large : 15;
    return ret + large;
}
DI void attn_unit(const Params& P, int u, LAS unsigned char* lds) {
    const int qb = u & 7, h = (u >> 3) & 3, b = u >> 5;
    const int tid = tid_opaque(), lane = tid & 63, w = __builtin_amdgcn_readfirstlane(tid >> 6), c = lane & 31, hh = lane >> 5;
    LAS float* Ost = (LAS float*)lds;
    LAS float* Mst = (LAS float*)(lds + 69632);
    LAS float* Lst = Mst + 256;
    LAS float* biasT = (LAS float*)(lds + 69632 + 2048);
    LAS unsigned short* Vt = (LAS unsigned short*)(lds + 69632 + 2048 + 8256 + w * 4608);
    unsigned char* ws = P.ws;
    __syncthreads();
    for (int i = tid; i < 2049; i += 512) biasT[i] = P.rel_bias[t5_bucket(i - 1024) * 4 + h];
    __syncthreads();
    const bf16_t* pb = (const bf16_t*)(ws + WS_PROJ) + (size_t)b * SEQ * NPROJ;
    bf16_t* MIX = (bf16_t*)(ws + WS_HN);
    const int Q0 = qb * 256;
#pragma unroll 1
    for (int pp = 0; pp < 4; ++pp) {
        const int pat = pp < 2 ? pp : 2;
        int d, rho, uq0, nq;
        if (pat == 0) { d = 1; rho = 0; uq0 = Q0 + 32 * w; nq = 32; }
        else if (pat == 1) { d = 4; rho = w & 3; uq0 = (Q0 >> 2) + 32 * (w >> 2); nq = 32; }
        else { d = 16; rho = 2 * w + (pp - 2); uq0 = Q0 >> 4; nq = 16; }
        const int uk0 = uq0 - 64, nsub = SEQ / d;
        const int cq = (c < nq) ? c : c - nq;
        const int qpos = (uq0 + cq) * d + rho, ql = qpos - Q0;
        bf16x8 qf[4];
#pragma unroll
        for (int ks = 0; ks < 4; ++ks) qf[ks] = *(const bf16x8*)(pb + (size_t)qpos * NPROJ + PC_AQ + h * 64 + 16 * ks + 8 * hh);
        float mrun = -1.0e30f, lrun = 0.f; f32x16 OT[2];
#pragma unroll
        for (int dt = 0; dt < 2; ++dt)
#pragma unroll
            for (int q = 0; q < 16; ++q) OT[dt][q] = 0.f;
        if (pat != 0) { mrun = Mst[ql]; lrun = Lst[ql];
#pragma unroll
            for (int dt = 0; dt < 2; ++dt)
#pragma unroll
                for (int g = 0; g < 4; ++g) { const f32x4 v = *(const LAS f32x4*)(Ost + ql * 68 + 32 * dt + 8 * g + 4 * hh);
                    OT[dt][4 * g] = v.x; OT[dt][4 * g + 1] = v.y; OT[dt][4 * g + 2] = v.z; OT[dt][4 * g + 3] = v.w; } }
#pragma unroll 1
        for (int kt = 0; kt < 5; ++kt) {
            const int ukr = uk0 + 32 * kt + c;
            const int ukc = ukr < 0 ? 0 : (ukr >= nsub ? nsub - 1 : ukr);
            const bf16_t* krow = pb + (size_t)(ukc * d + rho) * NPROJ + h * 64;
            bf16x8 kf[4];
#pragma unroll
            for (int ks = 0; ks < 4; ++ks) kf[ks] = *(const bf16x8*)(krow + PC_AK + 16 * ks + 8 * hh);
#pragma unroll
            for (int i = 0; i < 4; ++i) { const int ch = hh + 2 * i; const u32x4 vv = *(const u32x4*)(krow + PC_AV + 8 * ch);
                const unsigned vw[4] = {vv.x, vv.y, vv.z, vv.w};
#pragma unroll
                for (int e = 0; e < 8; ++e) Vt[(8 * ch + e) * 36 + c] = (unsigned short)((e & 1) ? (vw[e >> 1] >> 16) : (vw[e >> 1] & 0xffffu)); }
            f32x16 st;
#pragma unroll
            for (int q = 0; q < 16; ++q) st[q] = 0.f;
#pragma unroll
            for (int ks = 0; ks < 4; ++ks) st = MFMA32(kf[ks], qf[ks], st);
            float tmax = -INFINITY; float lg[16];
#pragma unroll
            for (int q = 0; q < 16; ++q) { const int uk = uk0 + 32 * kt + crow(q, hh); const int rel = uk - (uq0 + cq);
                const bool valid = (rel >= -64) && (rel <= 64) && (uk >= 0) && (uk < nsub);
                const int bi = rel * d + 1024; const float bv = biasT[bi < 0 ? 0 : (bi > 2048 ? 2048 : bi)];
                lg[q] = valid ? st[q] + bv : -INFINITY; tmax = fmaxf(tmax, lg[q]); }
            tmax = fmaxf(tmax, __shfl_xor(tmax, 32));
            const float mnew = fmaxf(mrun, tmax), alpha = __expf(mrun - mnew);
            float psum = 0.f;
#pragma unroll
            for (int q = 0; q < 16; ++q) { lg[q] = __expf(lg[q] - mnew); psum += lg[q]; }
            psum += __shfl_xor(psum, 32);
            lrun = lrun * alpha + psum; mrun = mnew;
#pragma unroll
            for (int dt = 0; dt < 2; ++dt)
#pragma unroll
                for (int q = 0; q < 16; ++q) OT[dt][q] *= alpha;
            LDS_WAIT();
#pragma unroll
            for (int s = 0; s < 2; ++s) { const bf16x8 pf = PACK_STEP(lg, s);
#pragma unroll
                for (int dt = 0; dt < 2; ++dt) { const LAS unsigned short* vr = Vt + (32 * dt + c) * 36 + 16 * s + 4 * hh;
                    const bf16x8 af = cat44(*(const LAS u32x2*)vr, *(const LAS u32x2*)(vr + 8));
                    OT[dt] = MFMA32(af, pf, OT[dt]); } }
            LDS_WAIT();
        }
        if (pat != 2) {
            if (hh == 0) { Mst[ql] = mrun; Lst[ql] = lrun; }
#pragma unroll
            for (int dt = 0; dt < 2; ++dt)
#pragma unroll
                for (int g = 0; g < 4; ++g) *(LAS f32x4*)(Ost + ql * 68 + 32 * dt + 8 * g + 4 * hh) = (f32x4){OT[dt][4 * g], OT[dt][4 * g + 1], OT[dt][4 * g + 2], OT[dt][4 * g + 3]};
        } else if (c < 16) {
            const float inv = 1.0f / lrun;
            bf16_t* orow = MIX + ((size_t)b * SEQ + qpos) * DM + 512 + h * 64;
#pragma unroll
            for (int dt = 0; dt < 2; ++dt)
#pragma unroll
                for (int g = 0; g < 4; ++g) { u32x2 o; o.x = pk2(OT[dt][4 * g] * inv, OT[dt][4 * g + 1] * inv); o.y = pk2(OT[dt][4 * g + 2] * inv, OT[dt][4 * g + 3] * inv);
                    *(u32x2*)(orow + 32 * dt + 8 * g + 4 * hh) = o; }
        }
        if (pp != 2) __syncthreads();
    }
}

DI float softplus_f(float x) { return x > 20.f ? x : log1pf(expf(x)); }
DI unsigned short hsel(const u32x4& v, int c) { const unsigned w = (c >> 1) == 0 ? v.x : ((c >> 1) == 1 ? v.y : ((c >> 1) == 2 ? v.z : v.w)); return (unsigned short)((c & 1) ? (w >> 16) : (w & 0xffffu)); }
DI void mamba_unit(const Params& P, int l, int u, LAS unsigned char* lds) {
    const int dir = u & 1, h = (u >> 1) & 3, b = u >> 3, g = h >> 1;
    const int tid = tid_opaque(), lane_f = tid & 63, w = __builtin_amdgcn_readfirstlane(tid >> 6);
    LAS unsigned char* wl = lds + w * 15616;
    LAS unsigned short* xdT = (LAS unsigned short*)wl;
    LAS unsigned short* xwT = xdT + 64 * 40;
    LAS unsigned short* BT = xwT + 64 * 40;
    LAS float* dtv = (LAS float*)(wl + 15360);
    LAS float* acum = dtv + 32;
    LAS float* Atot = (LAS float*)(lds + 8 * 15616);
    unsigned char* ws = P.ws; unsigned char* dsc = (unsigned char*)P.out;
    const bf16_t* xbc = (const bf16_t*)(dsc + DO_MXBC) + (size_t)b * SEQ * 512;
    const float* dtr = (const float*)(ws + WS_DT) + (size_t)b * SEQ * 8 + dir * 4 + h;
    bf16_t* MYD = (bf16_t*)(dir ? (ws + WS_MYB) : (dsc + DO_MY)) + (size_t)b * SEQ * 256 + h * 64;
    float* stsc = (float*)(dsc + DO_MST) + (size_t)u * (8 * 4096);
    const float dtb = P.m_dt_bias[l * 8 + dir * 4 + h], Aneg = -expf(P.m_A_log[l * 8 + dir * 4 + h]);
    __syncthreads();
#define MTK(c0, j) (dir ? (c0) + 31 - (j) : (c0) + (j))
#define MCH(ci) (256 * w + 32 * (dir ? 7 - (ci) : (ci)))
#pragma unroll 1
    for (int pass = 0; pass < 2; ++pass) {
        int lane_p = lane_f; asm volatile("" : "+v"(lane_p));
        const int lane = lane_p, c32 = lane_p & 31, hh = lane_p >> 5, tg = lane_p >> 3, cg = lane_p & 7;
        f32x16 ST[2][2];
#pragma unroll
        for (int a = 0; a < 2; ++a)
#pragma unroll
            for (int q = 0; q < 2; ++q)
#pragma unroll
                for (int i = 0; i < 16; ++i) ST[a][q][i] = 0.f;
        if (pass == 1) {
            const int nv = dir ? 7 - w : w;
            for (int k = 0; k < nv; ++k) { const int v = dir ? 7 - k : k; const float dec = Atot[v];
                const f32x4* sp = (const f32x4*)(stsc + (size_t)v * 4096 + lane * 64);
#pragma unroll
                for (int a = 0; a < 2; ++a)
#pragma unroll
                    for (int q = 0; q < 2; ++q)
#pragma unroll
                        for (int i4 = 0; i4 < 4; ++i4) { const f32x4 t = sp[(a * 2 + q) * 4 + i4];
                            ST[a][q][4 * i4] = ST[a][q][4 * i4] * dec + t.x; ST[a][q][4 * i4 + 1] = ST[a][q][4 * i4 + 1] * dec + t.y; ST[a][q][4 * i4 + 2] = ST[a][q][4 * i4 + 2] * dec + t.z; ST[a][q][4 * i4 + 3] = ST[a][q][4 * i4 + 3] * dec + t.w; } }
        }
        float atot = 0.f;
        u32x4 rx[4], rB[4]; float rdt;
        { const int c0 = MCH(0);
#pragma unroll
          for (int i = 0; i < 4; ++i) { const unsigned ro = (unsigned)(MTK(c0, 4 * tg + i) * 512 + 8 * cg) * 2u; rx[i] = ldg16(xbc + h * 64, ro); rB[i] = ldg16(xbc + 256 + g * 64, ro); }
          rdt = *(const float*)((const char*)dtr + (unsigned)(MTK(c0, c32) * 32)); }
#pragma unroll 1
        for (int ci = 0; ci < 8; ++ci) {
            int lane_i = lane; asm volatile("" : "+v"(lane_i));
            const int c32 = lane_i & 31, hh = lane_i >> 5, tg = lane_i >> 3, cg = lane_i & 7;
            const int c0 = MCH(ci);
            {
                const float dt = softplus_f(rdt + dtb);
                float ac = dt * Aneg;
#pragma unroll
                for (int o = 1; o < 32; o <<= 1) { const float t = __shfl_up(ac, o, 32); if (c32 >= o) ac += t; }
                if (lane < 32) { dtv[c32] = dt; acum[c32] = ac; }
            }
            LDS_WAIT();
            const float aend = acum[31];
            {
                const f32x4 d4 = *(const LAS f32x4*)(dtv + 4 * tg), a4 = *(const LAS f32x4*)(acum + 4 * tg);
                const float dj[4] = {d4.x, d4.y, d4.z, d4.w};
                const float wj[4] = {__expf(aend - a4.x), __expf(aend - a4.y), __expf(aend - a4.z), __expf(aend - a4.w)};
#pragma unroll
                for (int c = 0; c < 8; ++c) {
                    float xd[4]; unsigned short bb[4];
#pragma unroll
                    for (int i = 0; i < 4; ++i) { xd[i] = bf2f(hsel(rx[i], c)) * dj[i]; bb[i] = hsel(rB[i], c); }
                    *(LAS u32x2*)(xdT + (8 * cg + c) * 40 + 4 * tg) = (u32x2){pk2(xd[0], xd[1]), pk2(xd[2], xd[3])};
                    *(LAS u32x2*)(xwT + (8 * cg + c) * 40 + 4 * tg) = (u32x2){pk2(xd[0] * wj[0], xd[1] * wj[1]), pk2(xd[2] * wj[2], xd[3] * wj[3])};
                    *(LAS u32x2*)(BT + (8 * cg + c) * 40 + 4 * tg) = (u32x2){(unsigned)bb[0] | ((unsigned)bb[1] << 16), (unsigned)bb[2] | ((unsigned)bb[3] << 16)};
                    __builtin_amdgcn_sched_barrier(0);
                }
            }
            if (ci < 7) { const int c1 = MCH(ci + 1);
#pragma unroll
                for (int i = 0; i < 4; ++i) { const unsigned ro = (unsigned)(MTK(c1, 4 * tg + i) * 512 + 8 * cg) * 2u; rx[i] = ldg16(xbc + h * 64, ro); rB[i] = ldg16(xbc + 256 + g * 64, ro); }
                rdt = *(const float*)((const char*)dtr + (unsigned)(MTK(c1, c32) * 32)); }
            LDS_WAIT();
            if (pass == 1) {
                const unsigned bro = (unsigned)(MTK(c0, c32) * 512 + 8 * hh) * 2u;
                f32x16 GT;
#pragma unroll
                for (int i = 0; i < 16; ++i) GT[i] = 0.f;
#pragma unroll
                for (int ks = 0; ks < 4; ++ks) GT = MFMA32(__builtin_bit_cast(bf16x8, ldg16(xbc + 256 + g * 64 + 16 * ks, bro)), __builtin_bit_cast(bf16x8, ldg16(xbc + 384 + g * 64 + 16 * ks, bro)), GT);
                const float acl = acum[c32];
#pragma unroll
                for (int i = 0; i < 16; ++i) { const int s = crow(i, hh); GT[i] = (s <= c32) ? GT[i] * __expf(acl - acum[s]) : 0.f; }
                f32x16 Y[2];
#pragma unroll
                for (int pt = 0; pt < 2; ++pt)
#pragma unroll
                    for (int i = 0; i < 16; ++i) Y[pt][i] = 0.f;
#pragma unroll
                for (int s = 0; s < 2; ++s) { const bf16x8 pa = PACK_STEP(GT, s);
#pragma unroll
                    for (int pt = 0; pt < 2; ++pt) { const LAS unsigned short* xr = xdT + (32 * pt + c32) * 40 + 16 * s + 4 * hh;
                        Y[pt] = MFMA32(pa, cat44(*(const LAS u32x2*)xr, *(const LAS u32x2*)(xr + 8)), Y[pt]); } }
                const unsigned cro = (unsigned)(MTK(c0, c32) * 512 + 4 * hh) * 2u;
                const float el = __expf(acl);
#pragma unroll
                for (int nt = 0; nt < 2; ++nt)
#pragma unroll
                    for (int s = 0; s < 2; ++s) { const u32x2 clo = ldg8(xbc + 384 + g * 64 + 32 * nt + 16 * s, cro), chi = ldg8(xbc + 384 + g * 64 + 32 * nt + 16 * s + 8, cro);
                        const bf16x8 ca = mk8(pk2(bflo(clo.x) * el, bfhi(clo.x) * el), pk2(bflo(clo.y) * el, bfhi(clo.y) * el), pk2(bflo(chi.x) * el, bfhi(chi.x) * el), pk2(bflo(chi.y) * el, bfhi(chi.y) * el));
#pragma unroll
                        for (int pt = 0; pt < 2; ++pt) Y[pt] = MFMA32(ca, PACK_STEP(ST[nt][pt], s), Y[pt]); }
#pragma unroll
                for (int i = 0; i < 16; ++i) { const unsigned oo = (unsigned)(MTK(c0, crow(i, hh)) * 256 + c32) * 2u; stg2(MYD, oo, f2bf(Y[0][i])); stg2(MYD + 32, oo, f2bf(Y[1][i])); }
            }
            {
                const float de = __expf(aend);
#pragma unroll
                for (int nt = 0; nt < 2; ++nt)
#pragma unroll
                    for (int pt = 0; pt < 2; ++pt)
#pragma unroll
                        for (int i = 0; i < 16; ++i) ST[nt][pt][i] *= de;
#pragma unroll
                for (int s = 0; s < 2; ++s)
#pragma unroll
                    for (int nt = 0; nt < 2; ++nt) { const bf16x8 ba = *(const LAS bf16x8*)(BT + (32 * nt + c32) * 40 + 16 * s + 8 * hh);
#pragma unroll
                        for (int pt = 0; pt < 2; ++pt) ST[nt][pt] = MFMA32(ba, *(const LAS bf16x8*)(xwT + (32 * pt + c32) * 40 + 16 * s + 8 * hh), ST[nt][pt]); }
            }
            atot += aend;
            LDS_WAIT();
        }
        if (pass == 0) {
            f32x4* sp = (f32x4*)(stsc + (size_t)w * 4096 + lane * 64);
#pragma unroll
            for (int a = 0; a < 2; ++a)
#pragma unroll
                for (int q = 0; q < 2; ++q)
#pragma unroll
                    for (int i4 = 0; i4 < 4; ++i4) sp[(a * 2 + q) * 4 + i4] = (f32x4){ST[a][q][4 * i4], ST[a][q][4 * i4 + 1], ST[a][q][4 * i4 + 2], ST[a][q][4 * i4 + 3]};
            if (lane == 0) Atot[w] = __expf(atot);
            VM_WAIT(); __syncthreads();
        }
    }
#undef MTK
#undef MCH
    __syncthreads();
}

DI void hgrn_unit(const Params& P, int l, int u, LAS unsigned char* lds) {
    const int dir = u & 1, h = (u >> 1) & 3, b = u >> 3;
    const int tid = tid_opaque(), lane_f = tid & 63, w = __builtin_amdgcn_readfirstlane(tid >> 6);
    LAS unsigned char* wl = lds + w * 15104;
    LAS unsigned short* qd = (LAS unsigned short*)wl;
    LAS unsigned short* kd = qd + 32 * 72;
    LAS unsigned short* vT = kd + 32 * 72;
    LAS float* eref = (LAS float*)(wl + 14336);
    LAS float* eglr = eref + 64;
    LAS float* egl = eglr + 64;
    LAS float* lbt = (LAS float*)(lds + 8 * 15104 + 2048 + w * 512);
    LAS float* gsum = lbt + 64;
    LAS float* Atot = (LAS float*)(lds + 8 * 15104);
    unsigned char* ws = P.ws; unsigned char* dsc = (unsigned char*)P.out;
    const bf16_t* proj = (const bf16_t*)(ws + WS_PROJ) + (size_t)b * SEQ * NPROJ;
    bf16_t* OD = (dir ? (bf16_t*)(ws + WS_OB) + (size_t)b * SEQ * 256 + h * 64 : (bf16_t*)(ws + WS_HN) + (size_t)b * SEQ * DM + 768 + h * 64);
    const int ostride = dir ? 256 : DM;
    float* stsc = (float*)(dsc + DO_HST) + (size_t)u * (8 * 4096);
    __syncthreads();
    { float lb = 0.f;
      if (l == 1) { const float h0 = P.hg_lb[(0 * 2 + dir) * 256 + h * 64 + lane_f], h1 = P.hg_lb[(1 * 2 + dir) * 256 + h * 64 + lane_f]; lb = 1.0f / (1.0f + expf(h0 - h1)); }
      lbt[lane_f] = lb; }
    LDS_WAIT();
#define HTK(c0, j) (dir ? (c0) + 31 - (j) : (c0) + (j))
#define HCH(ci) (256 * w + 32 * (dir ? 7 - (ci) : (ci)))
#pragma unroll 1
    for (int pass = 0; pass < 2; ++pass) {
        int lane_p = lane_f; asm volatile("" : "+v"(lane_p));
        const int lane = lane_p, c32 = lane_p & 31, hh = lane_p >> 5, tg = lane_p >> 3, cg = lane_p & 7;
        f32x16 S[2][2];
#pragma unroll
        for (int a = 0; a < 2; ++a)
#pragma unroll
            for (int q = 0; q < 2; ++q)
#pragma unroll
                for (int i = 0; i < 16; ++i) S[a][q][i] = 0.f;
        if (pass == 1) {
            const int nv = dir ? 7 - w : w;
            for (int k = 0; k < nv; ++k) { const int v = dir ? 7 - k : k; const LAS float* at = Atot + v * 64;
                const f32x4* sp = (const f32x4*)(stsc + (size_t)v * 4096 + lane * 64);
#pragma unroll
                for (int a = 0; a < 2; ++a)
#pragma unroll
                    for (int i4 = 0; i4 < 4; ++i4) { const f32x4 dec = *(const LAS f32x4*)(at + 32 * a + 8 * i4 + 4 * hh);
#pragma unroll
                        for (int q = 0; q < 2; ++q) { const f32x4 t = sp[(a * 2 + q) * 4 + i4];
                            S[a][q][4 * i4] = S[a][q][4 * i4] * dec.x + t.x; S[a][q][4 * i4 + 1] = S[a][q][4 * i4 + 1] * dec.y + t.y; S[a][q][4 * i4 + 2] = S[a][q][4 * i4 + 2] * dec.z + t.z; S[a][q][4 * i4 + 3] = S[a][q][4 * i4 + 3] * dec.w + t.w; } } }
        }
        gsum[lane] = 0.f;
        u32x4 rf[4];
        { const int c0 = HCH(0);
#pragma unroll
          for (int i = 0; i < 4; ++i) { const unsigned ro = (unsigned)(HTK(c0, 4 * tg + i) * NPROJ + 8 * cg) * 2u;
              rf[i] = ldg16(proj + PC_HF + dir * 256 + h * 64, ro); } }
#pragma unroll 1
        for (int ci = 0; ci < 8; ++ci) {
            int lane_i = lane; asm volatile("" : "+v"(lane_i));
            const int c32 = lane_i & 31, hh = lane_i >> 5, tg = lane_i >> 3, cg = lane_i & 7;
            const int c0 = HCH(ci);
            {
                float qprev[4], kprev[4];
                u32x4 rv[4], rq[4];
#pragma unroll
                for (int i = 0; i < 4; ++i) { const unsigned ro = (unsigned)(HTK(c0, 4 * tg + i) * NPROJ + 8 * cg) * 2u; rv[i] = ldg16(proj + PC_HI + h * 64, ro); rq[i] = (pass == 1) ? ldg16(proj + PC_HQ + h * 64, ro) : (u32x4){0u, 0u, 0u, 0u}; }
                const f32x4 lb0 = *(const LAS f32x4*)(lbt + 8 * cg), lb1 = *(const LAS f32x4*)(lbt + 8 * cg + 4);
                const float lbv[8] = {lb0.x, lb0.y, lb0.z, lb0.w, lb1.x, lb1.y, lb1.z, lb1.w};
#pragma unroll
                for (int c = 0; c < 8; ++c) {
                    const float lb = lbv[c], oml = 1.0f - lb;
                    float gcl[4], kr[4];
#pragma unroll
                    for (int i = 0; i < 4; ++i) { const float fpre = bf2f(hsel(rf[i], c)); const float en = __expf(-fpre), sg = 1.0f / (1.0f + en);
                        const float gg = __logf(lb + oml * sg); gcl[i] = (i == 0) ? gg : gcl[i - 1] + gg; kr[i] = oml * en * sg; }
                    float incl = gcl[3];
#pragma unroll
                    for (int o = 8; o < 64; o <<= 1) { const float t = __shfl_up(incl, o); if (lane >= o) incl += t; }
                    const float excl = incl - gcl[3];
                    const float ref = __shfl(incl, 24 + cg), glast = __shfl(incl, 56 + cg);
                    if (tg == 0) { eref[8 * cg + c] = __expf(ref); eglr[8 * cg + c] = __expf(glast - ref); egl[8 * cg + c] = __expf(glast); gsum[8 * cg + c] += glast; }
                    float kv[4], qv[4];
#pragma unroll
                    for (int i = 0; i < 4; ++i) { const float dlt = excl + gcl[i] - ref; kv[i] = kr[i] * __expf(-dlt);
                        if (pass == 1) { const float qr = bf2f(hsel(rq[i], c)); qv[i] = qr / (1.0f + __expf(-qr)) * __expf(dlt); } else qv[i] = 0.f; }
                    if (c & 1) {
#pragma unroll
                        for (int i = 0; i < 4; ++i) { *(LAS unsigned*)(kd + (4 * tg + i) * 72 + 8 * cg + c - 1) = pk2(kprev[i], kv[i]);
                            if (pass == 1) *(LAS unsigned*)(qd + (4 * tg + i) * 72 + 8 * cg + c - 1) = pk2(qprev[i], qv[i]); }
                    } else {
#pragma unroll
                        for (int i = 0; i < 4; ++i) { kprev[i] = kv[i]; qprev[i] = qv[i]; }
                    }
                    __builtin_amdgcn_sched_barrier(0);
                }
#pragma unroll
                for (int c = 0; c < 8; ++c) { unsigned short vb[4];
#pragma unroll
                    for (int i = 0; i < 4; ++i) vb[i] = hsel(rv[i], c);
                    *(LAS u32x2*)(vT + (8 * cg + c) * 40 + 4 * tg) = (u32x2){(unsigned)vb[0] | ((unsigned)vb[1] << 16), (unsigned)vb[2] | ((unsigned)vb[3] << 16)}; }
            }
            if (ci < 7) { const int c1 = HCH(ci + 1);
#pragma unroll
                for (int i = 0; i < 4; ++i) { const unsigned ro = (unsigned)(HTK(c1, 4 * tg + i) * NPROJ + 8 * cg) * 2u;
                    rf[i] = ldg16(proj + PC_HF + dir * 256 + h * 64, ro); } }
            LDS_WAIT(); __builtin_amdgcn_sched_barrier(0);
            bf16x8 vperm[2][2];
#pragma unroll
            for (int s = 0; s < 2; ++s)
#pragma unroll
                for (int pt = 0; pt < 2; ++pt) { const LAS unsigned short* vr = vT + (32 * pt + c32) * 40 + 16 * s + 4 * hh; vperm[s][pt] = cat44(*(const LAS u32x2*)vr, *(const LAS u32x2*)(vr + 8)); }
            if (pass == 1) {
                f32x16 SC;
#pragma unroll
                for (int i = 0; i < 16; ++i) SC[i] = 0.f;
#pragma unroll
                for (int ks = 0; ks < 4; ++ks) SC = MFMA32(*(const LAS bf16x8*)(kd + c32 * 72 + 16 * ks + 8 * hh), *(const LAS bf16x8*)(qd + c32 * 72 + 16 * ks + 8 * hh), SC);
#pragma unroll
                for (int i = 0; i < 16; ++i) SC[i] = (crow(i, hh) <= c32) ? SC[i] : 0.f;
                const bf16x8 pa0 = PACK_STEP(SC, 0), pa1 = PACK_STEP(SC, 1);
                bf16x8 qa[2][2];
#pragma unroll
                for (int et = 0; et < 2; ++et)
#pragma unroll
                    for (int s = 0; s < 2; ++s) { const LAS unsigned short* qr = qd + c32 * 72 + 32 * et + 16 * s + 4 * hh; qa[et][s] = cat44(*(const LAS u32x2*)qr, *(const LAS u32x2*)(qr + 8)); }
#pragma unroll
                for (int pt = 0; pt < 2; ++pt) {
                    f32x16 O;
#pragma unroll
                    for (int i = 0; i < 16; ++i) O[i] = 0.f;
                    O = MFMA32(pa0, vperm[0][pt], O); O = MFMA32(pa1, vperm[1][pt], O);
#pragma unroll
                    for (int et = 0; et < 2; ++et)
#pragma unroll
                        for (int s = 0; s < 2; ++s) { const f32x4 e0 = *(const LAS f32x4*)(eref + 32 * et + 16 * s + 4 * hh), e1 = *(const LAS f32x4*)(eref + 32 * et + 16 * s + 8 + 4 * hh);
                            const f32x16& sv = S[et][pt];
                            const bf16x8 sb = mk8(pk2(sv[8 * s] * e0.x, sv[8 * s + 1] * e0.y), pk2(sv[8 * s + 2] * e0.z, sv[8 * s + 3] * e0.w), pk2(sv[8 * s + 4] * e1.x, sv[8 * s + 5] * e1.y), pk2(sv[8 * s + 6] * e1.z, sv[8 * s + 7] * e1.w));
                            O = MFMA32(qa[et][s], sb, O); }
#pragma unroll
                    for (int i = 0; i < 16; ++i) { const unsigned oo = (unsigned)(HTK(c0, crow(i, hh)) * ostride + c32) * 2u; stg2(OD + 32 * pt, oo, f2bf(O[i])); }
                    __builtin_amdgcn_sched_barrier(0);
                }
            }
            __builtin_amdgcn_sched_barrier(0);
            {
#pragma unroll
                for (int et = 0; et < 2; ++et) {
                    f32x16 X;
#pragma unroll
                    for (int i = 0; i < 16; ++i) X[i] = 0.f;
#pragma unroll
                    for (int s = 0; s < 2; ++s) { unsigned idw[4];
#pragma unroll
                        for (int j = 0; j < 4; ++j) { const int k0 = 16 * s + 8 * hh + 2 * j; idw[j] = (k0 == c32 ? 0x3f80u : 0u) | (k0 + 1 == c32 ? 0x3f800000u : 0u); }
                        X = MFMA32(*(const LAS bf16x8*)(kd + c32 * 72 + 32 * et + 16 * s + 8 * hh), mk8(idw[0], idw[1], idw[2], idw[3]), X); }
                    const float sc = eglr[32 * et + c32];
#pragma unroll
                    for (int i = 0; i < 16; ++i) X[i] *= sc;
                    float dg[16];
#pragma unroll
                    for (int i = 0; i < 16; ++i) dg[i] = egl[32 * et + crow(i, hh)];
#pragma unroll
                    for (int pt = 0; pt < 2; ++pt) {
#pragma unroll
                        for (int i = 0; i < 16; ++i) S[et][pt][i] *= dg[i];
#pragma unroll
                        for (int s = 0; s < 2; ++s) S[et][pt] = MFMA32(PACK_STEP(X, s), vperm[s][pt], S[et][pt]); }
                }
            }
            LDS_WAIT();
        }
        if (pass == 0) {
            f32x4* sp = (f32x4*)(stsc + (size_t)w * 4096 + lane * 64);
#pragma unroll
            for (int a = 0; a < 2; ++a)
#pragma unroll
                for (int q = 0; q < 2; ++q)
#pragma unroll
                    for (int i4 = 0; i4 < 4; ++i4) sp[(a * 2 + q) * 4 + i4] = (f32x4){S[a][q][4 * i4], S[a][q][4 * i4 + 1], S[a][q][4 * i4 + 2], S[a][q][4 * i4 + 3]};
            LDS_WAIT(); Atot[w * 64 + lane] = __expf(gsum[lane]);
            VM_WAIT(); __syncthreads();
        }
    }
#undef HTK
#undef HCH
    __syncthreads();
}

DI void phase_mixers(const Params& P, int l, LAS unsigned char* lds) {
    const int G = gridDim.x, bid = blockIdx.x;
#ifndef REP_PHASE
#define REP_PHASE -1
#endif
#define MREPS(k) _Pragma("unroll 1") for (int _r = 0; _r < ((REP_PHASE == (k)) ? 2 : 1); ++_r)
    if (EN_HY) MREPS(30) for (int c = bid; c < 256; c += G) hyena_unit(P, c, lds);
    if (EN_AT) MREPS(31) for (int u = bid; u < NB * 4 * 8; u += G) attn_unit(P, u, lds);
    if (EN_MA) MREPS(32) for (int u = bid; u < 256; u += G) mamba_unit(P, l, u, lds);
    if (EN_HG) MREPS(33) for (int u = bid; u < 256; u += G) hgrn_unit(P, l, u, lds);
}

constexpr int N_PHASES = 21;
#ifndef REP_PHASE
#define REP_PHASE -1
#endif
#define REPS(k) for (int _rep = 0, _nrep = ((REP_PHASE == (k)) && ((k) != 0 && (k) != 5 || l == 0)) ? 2 : 1; _rep < _nrep; ++_rep)
__global__ void __launch_bounds__(512, 2) fwd_kernel(Params P) {
    extern __shared__ __attribute__((aligned(16))) unsigned char lds_raw[];
    LAS unsigned char* lds = (LAS unsigned char*)lds_raw;
    volatile LAS unsigned* MISC = (volatile LAS unsigned*)(lds + LDS_MISC);
    if (threadIdx.x < 64) MISC[threadIdx.x] = 0u;
    __syncthreads();
    unsigned char* ws = P.ws;
    const int lo = P.ph_lo, hi = P.ph_hi;
    XcdBarrier bar; bar.bar = (unsigned*)(ws + WS_CTL) + CW_BAR; bar.x = 0; bar.st = nullptr;
    if (hi - lo > 1) bar = xcd_barrier_post((unsigned*)(ws + WS_CTL) + CW_BAR, MISC + 8);
#define IN(k) (lo <= (k) && (k) < hi)
#define SEAM(k) do { if (IN(k) && IN((k) + 1)) xcd_barrier(bar); } while (0)
    const int G = gridDim.x, bid = blockIdx.x;
#pragma unroll 1
    for (int l = 0; l < 2; ++l) {
        const int p0 = 10 * l;
        if (IN(p0 + 0)) { _Pragma("unroll 1") REPS(0) phase_pre(P, l, lds); }
        SEAM(p0 + 0);
        if (IN(p0 + 1)) { _Pragma("unroll 1") REPS(1) {
            pg8::StaticOrder S; S.init(NTOK / 256, NPROJ / 256, G, bid); AddrPlain AD{DM, 0}; EpiProj E{(bf16_t*)(ws + WS_PROJ)};
            pg8::gemm_phase(lds, (const char*)(ws + WS_HN), (const char*)(ws + WS_WIN), DM, S, AD, E);
        } }
        SEAM(p0 + 1);
        if (IN(p0 + 2)) { _Pragma("unroll 1") REPS(2) phase_premix(P, l); }
        SEAM(p0 + 2);
        if (IN(p0 + 3)) { _Pragma("unroll 1") REPS(3) phase_mixers(P, l, lds); }
        SEAM(p0 + 3);
        if (IN(p0 + 4)) { _Pragma("unroll 1") REPS(4) phase_finalize(P, l); }
        SEAM(p0 + 4);
        if (IN(p0 + 5)) { _Pragma("unroll 1") REPS(5) {
            pg8::StaticOrder S; S.init(NTOK / 256, DM / 256, G, bid); AddrPlain AD{DM, 0}; EpiRes E{l == 0 ? P.x : (const float*)(ws + WS_XB), (float*)(ws + WS_XB)};
            pg8::gemm_phase(lds, (const char*)(ws + WS_HN), (const char*)(ws + WS_WOUT), DM, S, AD, E);
        } }
        SEAM(p0 + 5);
        if (IN(p0 + 6)) { if (EN_MOE) { _Pragma("unroll 1") REPS(6) phase_ffnpre(P, l, lds); } }
        SEAM(p0 + 6);
        if (IN(p0 + 7)) { if (EN_MOE) { _Pragma("unroll 1") REPS(7) phase_topk(P, l, lds); } }
        SEAM(p0 + 7);
        if (IN(p0 + 8)) { if (EN_MOE) _Pragma("unroll 1") REPS(8) {
            pg8::StaticOrder S; S.init(NSLOT / 256, 2048 / 256, G, bid); AddrGateUp AD{(const int*)(ws + WS_SELI)}; EpiGateUp E{(bf16_t*)((unsigned char*)P.out + DO_HDN), (const float*)(ws + WS_SELR)};
            pg8::gemm_phase(lds, (const char*)(ws + WS_HN), (const char*)(ws + WS_WGU), DM, S, AD, E); } }
        SEAM(p0 + 8);
        if (IN(p0 + 9)) { if (EN_MOE) _Pragma("unroll 1") REPS(9) {
            pg8::StaticOrder S; S.init(NSLOT / 256, DM / 256, G, bid); AddrDown AD{}; EpiDown E{(bf16_t*)(ws + WS_YE), (const float*)(ws + WS_SELG)};
            pg8::gemm_phase(lds, (const char*)P.out + DO_HDN, (const char*)(ws + WS_WD), DM, S, AD, E); } }
        SEAM(p0 + 9);
    }
    if (IN(20)) phase_final(P);
#undef IN
#undef SEAM
}

#ifndef N_LAUNCH_MODE
#define N_LAUNCH_MODE 1
#endif
extern "C" void kernel_launch(void* const* d_in, const int* in_sizes, int n_in, void* d_out, int out_size, void* d_ws, size_t ws_size, hipStream_t stream) {
    static int grid = 0;
    if (grid == 0) {
        if (n_in != 27 || in_sizes[0] != NTOK * DM || out_size != NTOK * DM || ws_size < WS_END) {
            fprintf(stderr, "kernel_launch: unexpected shapes (n_in %d, in0 %d, out %d, ws %zu, need %zu)\n", n_in, n_in > 0 ? in_sizes[0] : -1, out_size, ws_size, (size_t)WS_END); grid = -1; return; }
        int dev = 0, cus = 0, per_cu = 0;
        if (hipGetDevice(&dev) != hipSuccess || hipDeviceGetAttribute(&cus, hipDeviceAttributeMultiprocessorCount, dev) != hipSuccess) { grid = -1; return; }
        if (hipFuncSetAttribute((const void*)fwd_kernel, hipFuncAttributeMaxDynamicSharedMemorySize, LDS_BYTES) != hipSuccess) { fprintf(stderr, "kernel_launch: hipFuncSetAttribute failed\n"); grid = -1; return; }
        if (hipOccupancyMaxActiveBlocksPerMultiprocessor(&per_cu, (const void*)fwd_kernel, 512, LDS_BYTES) != hipSuccess || per_cu < 1) { fprintf(stderr, "kernel_launch: occupancy query says %d\n", per_cu); (void)hipGetLastError(); }
        grid = cus;
    }
    if (grid < 0) return;
    if (hipMemsetAsync((char*)d_ws + WS_CTL, 0, CTL_ZERO_BYTES, stream) != hipSuccess) return;
    Params p{};
    const float** pp = (const float**)&p;
    for (int i = 0; i < 27; ++i) pp[i] = (const float*)d_in[i];
    p.out = (float*)d_out; p.ws = (unsigned char*)d_ws;
    if (N_LAUNCH_MODE == 1) { p.ph_lo = 0; p.ph_hi = N_PHASES; hipLaunchKernelGGL(fwd_kernel, dim3(grid), dim3(512), LDS_BYTES, stream, p); }
    else for (int k = 0; k < N_PHASES; ++k) { p.ph_lo = k; p.ph_hi = k + 1; hipLaunchKernelGGL(fwd_kernel, dim3(grid), dim3(512), LDS_BYTES, stream, p); }
}
```

```cpp
#define N_LAUNCH_MODE 1
#include <hip/hip_runtime.h>
#include <cstdio>
#include <cstdint>

#define LAS __attribute__((address_space(3)))
#define DI __device__ __forceinline__
typedef unsigned short bf16_t;
typedef short bf16x8 __attribute__((ext_vector_type(8)));
typedef short s16x4 __attribute__((ext_vector_type(4)));
typedef float f32x2 __attribute__((ext_vector_type(2)));
typedef float f32x4 __attribute__((ext_vector_type(4)));
typedef float f32x16 __attribute__((ext_vector_type(16)));
typedef unsigned u32x2 __attribute__((ext_vector_type(2)));
typedef unsigned u32x4 __attribute__((ext_vector_type(4)));
typedef int i32x4 __attribute__((ext_vector_type(4)));
typedef __bf16 bfv2 __attribute__((ext_vector_type(2)));

DI unsigned pk2(float lo, float hi) { f32x2 v = {lo, hi}; return __builtin_bit_cast(unsigned, __builtin_convertvector(v, bfv2)); }
DI unsigned short f2bf(float f) { return (unsigned short)(pk2(f, 0.f) & 0xffffu); }
DI float bf2f(unsigned short b) { return __uint_as_float((unsigned)b << 16); }
DI float bflo(unsigned u) { return __uint_as_float(u << 16); }
DI float bfhi(unsigned u) { return __uint_as_float(u & 0xffff0000u); }
DI float wave_sum(float v) {
#pragma unroll
    for (int o = 1; o < 64; o <<= 1) v += __shfl_xor(v, o);
    return v;
}
DI float silu_f(float x) { return x / (1.0f + __expf(-x)); }
DI float sigmoid_f(float x) { return 1.0f / (1.0f + __expf(-x)); }
DI int tid_opaque() { int t = threadIdx.x; asm volatile("" : "+v"(t)); return t; }
DI bf16x8 mk8u(unsigned a, unsigned b, unsigned c, unsigned d) { u32x4 v = {a, b, c, d}; return __builtin_bit_cast(bf16x8, v); }
#define LDS_WAIT() asm volatile("s_waitcnt lgkmcnt(0)" ::: "memory")
#define VM_WAIT() asm volatile("s_waitcnt vmcnt(0)" ::: "memory")
#define MFMA32(a, b, c) __builtin_amdgcn_mfma_f32_32x32x16_bf16((a), (b), (c), 0, 0, 0)

constexpr int NB = 32, SEQ = 2048, DM = 1024, NTOK = NB * SEQ;
constexpr int NIN_REF = 3592, NPROJ = 3584;
constexpr int PC_HY = 0, PC_MZ = 768, PC_MX = 1024, PC_AQ = 1536, PC_AK = 1792, PC_AV = 2048, PC_HQ = 2304, PC_HF = 2560, PC_HI = 3072, PC_HG = 3328;
constexpr int NEXP = 16, CAP = 256, NSLOT = NB * NEXP * CAP;
constexpr float EPSN = 1e-6f;

constexpr size_t MiB = 1u << 20;
constexpr size_t WS_CTL = 0, CTL_ZERO_BYTES = 64 * 1024;
constexpr size_t WS_DT = 1 * MiB, WS_AFF = 3 * MiB, WS_SLOT = 7 * MiB, WS_SELI = 11 * MiB, WS_SELG = 11 * MiB + 512 * 1024, WS_KFILT = 12 * MiB, WS_MSQ = 14 * MiB, WS_RS = 15 * MiB, WS_SELR = 15 * MiB + 512 * 1024;
constexpr size_t WS_XB = 64 * MiB, WS_WIN = 320 * MiB, WS_WOUT = 327 * MiB, WS_WGU = 329 * MiB, WS_WD = 393 * MiB, WS_HN = 432 * MiB, WS_PROJ = 560 * MiB, WS_YE = WS_PROJ, WS_END = 1008 * MiB, WS_MYB = WS_WGU, WS_OB = WS_WGU + 32 * MiB;
constexpr size_t DO_HW = 0, DO_HX0 = 32 * MiB, DO_YAT = 64 * MiB, DO_MXBC = 96 * MiB, DO_MY = 160 * MiB, DO_MST = 192 * MiB, DO_HST = 224 * MiB, DO_HDN = 0;
constexpr int CW_BAR = 1024;

constexpr int LDS_MISC = 147456, LDS_BYTES = LDS_MISC + 256;

struct Params {
    const float *x, *w_in, *w_out, *norm_mix_w, *norm_ffn_w, *hy_conv_w, *hy_w1, *hy_b1, *hy_w2, *hy_b2, *hy_freq, *hy_w3, *hy_fbias,
                *m_conv_w, *m_conv_b, *m_dt_bias, *m_A_log, *m_D, *m_norm_w, *rel_bias, *hg_lb, *hg_norm_w, *router_w, *moe_wg, *moe_wu, *moe_wd, *final_w;
    float* out; unsigned char* ws;
    int ph_lo, ph_hi;
};

#define XB_TMO      128
#define XB_XCNT(j)  (256  + 64 * (j))
#define XB_XSUB(j)  (1280 + 64 * (j))
#define XB_XGEN(j)  (2304 + 64 * (j))
#define XB_TOP      3328
#define XB_TOPGEN   3392
#define XCD_BAR_WORDS 3456
#define XB_SPIN_CAP (1u << 18)
__device__ __forceinline__ unsigned xb_ld(unsigned* p)              { return __hip_atomic_load(p, __ATOMIC_RELAXED, __HIP_MEMORY_SCOPE_AGENT); }
__device__ __forceinline__ unsigned xb_add(unsigned* p, unsigned v) { return __hip_atomic_fetch_add(p, v, __ATOMIC_RELAXED, __HIP_MEMORY_SCOPE_AGENT); }
__device__ __forceinline__ unsigned xb_xcc_id() { return (unsigned)__builtin_amdgcn_s_getreg((3 << 11) | 20) & 0xFu; }
#define XB_SPIN(cond, bar) do { unsigned _sp = 0; while (cond) { __builtin_amdgcn_s_sleep(1); \
    if ((++_sp & 255u) == 0u) { if (xb_ld(&(bar)[XB_TMO])) break; if (_sp > XB_SPIN_CAP) { atomicAdd(&(bar)[XB_TMO], 1u); break; } } } } while (0)
struct XcdBarrier { unsigned* bar; unsigned x; volatile LAS unsigned* st; };
__device__ __forceinline__ XcdBarrier xcd_barrier_post(unsigned* bar, volatile LAS unsigned* st) {
    XcdBarrier b; b.bar = bar; b.x = xb_xcc_id(); b.st = st;
    if (threadIdx.x == 0) (void)xb_add(&bar[XB_XCNT(b.x)], 1u);
    return b;
}
__device__ __forceinline__ void xcd_barrier_complete(unsigned* bar, unsigned x, unsigned& nloc, unsigned& nx) {
    const unsigned G = gridDim.x * gridDim.y * gridDim.z;
    unsigned sum, cnt, mine, sp = 0u;
    for (;;) {
        sum = 0u; cnt = 0u; mine = 0u;
#pragma unroll
        for (unsigned j = 0; j < 16; ++j) { const unsigned c = xb_ld(&bar[XB_XCNT(j)]); sum += c; cnt += (c > 0u) ? 1u : 0u; mine = (j == x) ? c : mine; }
        if (sum == G) break;
        __builtin_amdgcn_s_sleep(1);
        if ((++sp & 255u) == 0u) { if (xb_ld(&bar[XB_TMO])) break; if (sp > XB_SPIN_CAP) { atomicAdd(&bar[XB_TMO], 1u); break; } }
    }
    nloc = mine > 0u ? mine : 1u; nx = cnt > 0u ? cnt : 1u;
}
__device__ __forceinline__ void xcd_barrier(const XcdBarrier& b) {
    asm volatile("s_waitcnt vmcnt(0)" ::: "memory");
    __syncthreads();
    if (threadIdx.x == 0) {
        unsigned* bar = b.bar;
        __builtin_amdgcn_s_waitcnt(0);
        unsigned nloc = b.st[0], nx = b.st[1];
        if (nloc == 0u) { xcd_barrier_complete(bar, b.x, nloc, nx); b.st[0] = nloc; b.st[1] = nx; }
        const unsigned old = xb_add(&bar[XB_XSUB(b.x)], 1u);
        const unsigned gen = old / nloc;
        if (old + 1u == (gen + 1u) * nloc) {
            __builtin_amdgcn_fence(__ATOMIC_RELEASE, "agent");
            asm volatile("s_waitcnt vmcnt(0)" ::: "memory");
            const unsigned og = xb_add(&bar[XB_TOP], 1u);
            const unsigned tg = og / nx;
            if (og + 1u == (tg + 1u) * nx) xb_add(&bar[XB_TOPGEN], 1u);
            else XB_SPIN(xb_ld(&bar[XB_TOPGEN]) == tg, bar);
            __builtin_amdgcn_fence(__ATOMIC_ACQUIRE, "agent");
            xb_add(&bar[XB_XGEN(b.x)], 1u);
            asm volatile("s_waitcnt vmcnt(0)" ::: "memory");
        } else {
            XB_SPIN(xb_ld(&bar[XB_XGEN(b.x)]) == gen, bar);
            __builtin_amdgcn_fence(__ATOMIC_ACQUIRE, "agent");
            asm volatile("s_waitcnt vmcnt(0)" ::: "memory");
        }
    }
    __syncthreads();
}

namespace pg8 {
constexpr int BM = 256, BK = 64, HALF = 128, HTB = HALF * BK * 2, STAGE_BYTES = 8 * HTB, NXCD = 8, WGM = 8;
__host__ __device__ __forceinline__ int lds_byte(int r, int c) { const int st = (r >> 4) * 2 + (c >> 5), rr = r & 15, cc = c & 31, ob = rr * 64 + cc * 2; return st * 1024 + (ob ^ (((ob >> 9) & 1) << 5)); }
__host__ __device__ __forceinline__ void stage_rc(int b, int& R, int& C) { const int st = b / 1024, sb = b % 1024, swz = sb ^ (((sb >> 9) & 1) << 5); R = (st >> 1) * 16 + swz / 64; C = (st & 1) * 32 + (swz % 64) / 2; }
__host__ __device__ __forceinline__ int perm32(int rho) { const int n = rho >> 4, i = rho & 15; return 8 * (i >> 2) + 4 * n + (i & 3); }
struct Unit { int pm, pn; };
struct StaticOrder {
    int nM, nN, nwg, G, c;
    __device__ void init(int nM_, int nN_, int G_, int c_) { nM = nM_; nN = nN_; nwg = nM * nN; G = G_; c = c_; }
    __device__ bool next(int i, Unit& u) const {
        const long L = (long)i * G + c; if (L >= nwg) return false;
        int wgid = (int)L; { const int q = nwg / NXCD, r = nwg % NXCD, xcd = wgid % NXCD, off = wgid / NXCD; wgid = (xcd < r ? xcd * (q + 1) : r * (q + 1) + (xcd - r) * q) + off; }
        const int nig = WGM * nN, gid = wgid / nig, fm = gid * WGM, gsz = (nM - fm) < WGM ? (nM - fm) : WGM;
        u.pm = fm + ((wgid % nig) % gsz); u.pn = (wgid % nig) / gsz; return true;
    }
};
template <class Epi, class Sched, class Addr>
__device__ __forceinline__ void gemm_phase(LAS unsigned char* lds, const char* Abase, const char* Bbase, int K, const Sched& S, const Addr& AD, const Epi& E) {
    const int tid = tid_opaque(), wid = __builtin_amdgcn_readfirstlane(tid >> 6), lane = tid & 63, wr = wid >> 2, wc = wid & 3, fr = lane & 15, fq = lane >> 4;
    const int nt = K / BK;
    int Rr[2]; unsigned Cc[2], voffB[2], voffA[2];
#pragma unroll
    for (int i = 0; i < 2; ++i) { int R, C; stage_rc(tid * 16 + i * 8192, R, C); const int Rb = Epi::PERM ? ((R & ~31) + perm32(R & 31)) : R;
        Rr[i] = R; Cc[i] = (unsigned)C * 2u; voffA[i] = (unsigned)(R * K + C) * 2u; voffB[i] = (unsigned)(Rb * K + C) * 2u; }
    const size_t kstep = (size_t)(BK * 2);
    const size_t hstep = (size_t)HALF * K * 2;
    const unsigned ldsw = (unsigned)wid * 1024u;
    const int aoff = lds_byte(wr * 64 + fr, fq * 8), boff = lds_byte(wc * 32 + fr, fq * 8);
#define PG8_SA(b, h) (((b) * 2 + (h)) * HTB)
#define PG8_SB(b, h) ((4 + (b) * 2 + (h)) * HTB)
#define PG8_STAGE(bufoff, gbase, voff) do { _Pragma("unroll") for (int _i = 0; _i < 2; ++_i) \
        __builtin_amdgcn_global_load_lds((const unsigned*)((const char*)(gbase) + (voff)[_i]), (LAS unsigned*)(lds + (bufoff) + ldsw + _i * 8192), 16, 0, 0); } while (0)
#define PG8_STAGE_A(bufoff, kb, h, un) do { if constexpr (Addr::LOADS) { _Pragma("unroll") for (int _i = 0; _i < 2; ++_i) \
        __builtin_amdgcn_global_load_lds((const unsigned*)(Abase + (kb) + ((un) ? on[h][_i] : oc[h][_i])), (LAS unsigned*)(lds + (bufoff) + ldsw + _i * 8192), 16, 0, 0); } \
      else { const char* _ab = ((un) ? nA : cA) + (kb) + (size_t)(h) * hstep; _Pragma("unroll") for (int _i = 0; _i < 2; ++_i) \
        __builtin_amdgcn_global_load_lds((const unsigned*)(_ab + voffA[_i]), (LAS unsigned*)(lds + (bufoff) + ldsw + _i * 8192), 16, 0, 0); } } while (0)
#define PG8_LDA(dst, b, h) do { _Pragma("unroll") for (int m = 0; m < 4; ++m) _Pragma("unroll") for (int k = 0; k < 2; ++k) dst[m][k] = *(const LAS bf16x8*)(lds + PG8_SA(b, h) + aoff + m * 2048 + k * 1024); } while (0)
#define PG8_LDB(dst, b, h) do { _Pragma("unroll") for (int n = 0; n < 2; ++n) _Pragma("unroll") for (int k = 0; k < 2; ++k) dst[n][k] = *(const LAS bf16x8*)(lds + PG8_SB(b, h) + boff + n * 2048 + k * 1024); } while (0)
#define PG8_MMA(ai, bj, At, Bt) do { __builtin_amdgcn_s_setprio(1); _Pragma("unroll") for (int m = 0; m < 4; ++m) _Pragma("unroll") for (int n = 0; n < 2; ++n) _Pragma("unroll") for (int k = 0; k < 2; ++k) \
        acc[ai][bj][m][n] = __builtin_amdgcn_mfma_f32_16x16x32_bf16(Bt[n][k], At[m][k], acc[ai][bj][m][n], 0, 0, 0); __builtin_amdgcn_s_setprio(0); } while (0)
#define PG8_WAIT_V(n) asm volatile("s_waitcnt vmcnt(" #n ")" ::: "memory")
#define PG8_WAIT_L(n) asm volatile("s_waitcnt lgkmcnt(" #n ")" ::: "memory")
#define PG8_BAR __builtin_amdgcn_s_barrier()
#define PG8_SCHED __builtin_amdgcn_sched_barrier(0)
    Unit cur, nxt; int ui = 0;
    if (!S.next(0, cur)) return;
    f32x4 acc[2][2][4][2];
#pragma unroll
    for (int a = 0; a < 2; ++a)
#pragma unroll
        for (int b = 0; b < 2; ++b)
#pragma unroll
            for (int m = 0; m < 4; ++m)
#pragma unroll
                for (int n = 0; n < 2; ++n) acc[a][b][m][n] = (f32x4){0.f, 0.f, 0.f, 0.f};
    bf16x8 At[4][2], B0[2][2], B1[2][2];
    unsigned oc[2][2], on[2][2];
    const char* cA = Abase; const char* nA = Abase;
    if constexpr (Addr::LOADS) {
        {
            Unit tu;
            for (int k = 0; k < 16 && S.next(k, tu); ++k)
                for (int r = tid; r < 256; r += 512) ((LAS unsigned*)(lds + STAGE_BYTES))[k * 256 + r] = AD.arow(tu, r);
            __syncthreads();
        }
#pragma unroll
        for (int h = 0; h < 2; ++h)
#pragma unroll
            for (int i = 0; i < 2; ++i) { oc[h][i] = AD.arow_lds(lds + STAGE_BYTES, 0, cur, h * HALF + Rr[i]) + Cc[i]; on[h][i] = oc[h][i]; }
        PG8_WAIT_V(0);
    } else { cA = Abase + AD.arow(cur, 0); nA = cA; }
    const char* cB = Bbase + AD.boff(cur);
    PG8_STAGE(PG8_SB(0, 0), cB, voffB); PG8_STAGE_A(PG8_SA(0, 0), 0, 0, false); PG8_STAGE(PG8_SB(0, 1), cB + hstep, voffB); PG8_STAGE_A(PG8_SA(0, 1), 0, 1, false);
    if (wr == 1) PG8_BAR;
    PG8_WAIT_V(4); PG8_BAR;
    PG8_STAGE(PG8_SB(1, 0), cB + kstep, voffB); PG8_STAGE_A(PG8_SA(1, 0), kstep, 0, false); PG8_STAGE(PG8_SB(1, 1), cB + hstep + kstep, voffB);
    PG8_WAIT_V(6); PG8_BAR;
    for (;;) {
        const bool has_next = S.next(ui + 1, nxt);
        if (has_next) {
            if constexpr (Addr::LOADS) {
#pragma unroll
                for (int h = 0; h < 2; ++h)
#pragma unroll
                    for (int i = 0; i < 2; ++i) on[h][i] = AD.arow_lds(lds + STAGE_BYTES, ui + 1, nxt, h * HALF + Rr[i]) + Cc[i];
            } else nA = Abase + AD.arow(nxt, 0);
        } else nA = cA;
        const char* nB = has_next ? Bbase + AD.boff(nxt) : cB;
        for (int t = 0; t < nt; t += 2) {
            const bool last = (t == nt - 2);
            const bool un = last && has_next;
            const size_t k1 = (size_t)(t + 1) * kstep;
            const size_t k2 = last ? 0 : (size_t)(t + 2) * kstep, k3 = k2 + kstep;
            const char* b2 = last ? nB : cB + (size_t)(t + 2) * kstep;
            const char* b3 = b2 + kstep;
            PG8_LDB(B0, 0, 0); PG8_SCHED; PG8_LDA(At, 0, 0); PG8_STAGE_A(PG8_SA(1, 1), k1, 1, false);
            PG8_WAIT_L(8); PG8_BAR; PG8_WAIT_L(0); PG8_MMA(0, 0, At, B0); PG8_BAR; PG8_SCHED;
            PG8_LDB(B1, 0, 1); PG8_STAGE(PG8_SB(0, 0), b2, voffB);
            PG8_BAR; PG8_WAIT_L(0); PG8_MMA(0, 1, At, B1); PG8_BAR;
            PG8_LDA(At, 0, 1); PG8_STAGE_A(PG8_SA(0, 0), k2, 0, un);
            PG8_BAR; PG8_WAIT_L(0); PG8_MMA(1, 0, At, B0); PG8_BAR; PG8_SCHED;
            PG8_STAGE(PG8_SB(0, 1), b2 + hstep, voffB);
            PG8_WAIT_V(6); PG8_BAR; PG8_MMA(1, 1, At, B1); PG8_BAR;
            PG8_LDB(B0, 1, 0); PG8_SCHED; PG8_LDA(At, 1, 0); PG8_STAGE_A(PG8_SA(0, 1), k2, 1, un);
            PG8_WAIT_L(8); PG8_BAR; PG8_WAIT_L(0); PG8_MMA(0, 0, At, B0); PG8_BAR; PG8_SCHED;
            PG8_LDB(B1, 1, 1); PG8_STAGE(PG8_SB(1, 0), b3, voffB);
            PG8_BAR; PG8_WAIT_L(0); PG8_MMA(0, 1, At, B1); PG8_BAR;
            PG8_LDA(At, 1, 1); PG8_STAGE_A(PG8_SA(1, 0), k3, 0, un);
            PG8_BAR; PG8_WAIT_L(0); PG8_MMA(1, 0, At, B0); PG8_BAR; PG8_SCHED;
            PG8_STAGE(PG8_SB(1, 1), b3 + hstep, voffB);
            PG8_WAIT_V(6); PG8_BAR; PG8_MMA(1, 1, At, B1); PG8_BAR;
        }
        E(acc, cur, wr, wc, fr, fq);
        if (!has_next) break;
#pragma unroll
        for (int a = 0; a < 2; ++a)
#pragma unroll
            for (int b = 0; b < 2; ++b)
#pragma unroll
                for (int m = 0; m < 4; ++m)
#pragma unroll
                    for (int n = 0; n < 2; ++n) acc[a][b][m][n] = (f32x4){0.f, 0.f, 0.f, 0.f};
        cur = nxt; cB = nB; cA = nA; ++ui;
        if constexpr (Addr::LOADS) {
#pragma unroll
            for (int h = 0; h < 2; ++h)
#pragma unroll
                for (int i = 0; i < 2; ++i) oc[h][i] = on[h][i]; }
    }
    PG8_WAIT_V(0);
    if (wr == 0) PG8_BAR;
    PG8_BAR;
#undef PG8_SA
#undef PG8_SB
#undef PG8_STAGE
#undef PG8_STAGE_A
#undef PG8_LDA
#undef PG8_LDB
#undef PG8_MMA
#undef PG8_WAIT_V
#undef PG8_WAIT_L
#undef PG8_BAR
#undef PG8_SCHED
}
}

#ifndef EN_HY
#define EN_HY 1
#endif
#ifndef EN_MA
#define EN_MA 1
#endif
#ifndef EN_AT
#define EN_AT 1
#endif
#ifndef EN_HG
#define EN_HG 1
#endif
#ifndef EN_MOE
#define EN_MOE 1
#endif

DI void transpose_item(const float* W, int ld, int k0, int n0, bf16_t* dst, int drow0, float scale, LAS float* scr, int lane) {
#pragma unroll 8
    for (int i = 0; i < 32; ++i) { const int kk = 2 * i + (lane >> 5); scr[kk * 33 + (lane & 31)] = W[(size_t)(k0 + kk) * ld + n0 + (lane & 31)]; }
    LDS_WAIT();
    const int c = lane & 7;
#pragma unroll
    for (int j = 0; j < 4; ++j) { const int n = (lane >> 3) + 8 * j; const LAS float* s = scr + (8 * c) * 33 + n;
        u32x4 o; o.x = pk2(s[0 * 33] * scale, s[1 * 33] * scale); o.y = pk2(s[2 * 33] * scale, s[3 * 33] * scale); o.z = pk2(s[4 * 33] * scale, s[5 * 33] * scale); o.w = pk2(s[6 * 33] * scale, s[7 * 33] * scale);
        *(u32x4*)(dst + (size_t)(drow0 + n) * 1024 + k0 + 8 * c) = o; }
    LDS_WAIT();
}

DI void hyena_filter_pos(const Params& P, int l, int pos, int lane, bf16_t* kfilt) {
    const float TWO_PI = 6.283185307179586f;
    const float tpos = (float)pos * (1.0f / 2047.0f);
    float z = 0.f;
    if (lane == 0) z = tpos;
    else if (lane <= 32) { const int bnd = (lane - 1) & 15; const float f = 1e-4f + (float)bnd * ((15.0f - 1e-4f) / 15.0f);
        const float angp = TWO_PI * (float)pos / 2048.0f; const float ang = angp * f; z = (lane <= 16) ? cosf(ang) : -sinf(ang); }
    const float* w1 = P.hy_w1 + (size_t)l * 33 * 64; const float* w2 = P.hy_w2 + (size_t)l * 64 * 64; const float* w3 = P.hy_w3 + (size_t)l * 64 * 512;
    const float fr = P.hy_freq[l * 64 + lane];
    float a = P.hy_b1[l * 64 + lane];
    for (int i = 0; i < 33; ++i) a += __shfl(z, i) * w1[i * 64 + lane];
    const float h1 = sinf(fr * a);
    float a2 = P.hy_b2[l * 64 + lane];
    for (int i = 0; i < 64; ++i) a2 += __shfl(h1, i) * w2[i * 64 + lane];
    const float h2 = sinf(fr * a2);
    float h3[8];
#pragma unroll
    for (int k = 0; k < 8; ++k) h3[k] = 0.f;
    for (int i = 0; i < 64; ++i) { const float hv = __shfl(h2, i);
#pragma unroll
        for (int k = 0; k < 8; ++k) h3[k] += hv * w3[i * 512 + k * 64 + lane]; }
    const float min_decay = -3.0701134573253944f, max_decay = -15.350567286626972f;
#pragma unroll
    for (int k = 0; k < 8; ++k) { const int cp = k * 64 + lane, c = cp & 255;
        const float delta = fabsf(min_decay + (float)c * ((max_decay - min_decay) / 255.0f));
        float v = h3[k] * expf(-tpos * delta);
        if (cp < 256) { if (pos == 0) { v += P.hy_fbias[l * 256 + c]; kfilt[(size_t)c * 4096 + 4095] = 0; } kfilt[(size_t)c * 4096 + 2047 - pos] = f2bf(v); }
        else if (pos >= 1) kfilt[(size_t)c * 4096 + 2047 + pos] = f2bf(v); }
}

template <bool FINAL>
DI void pre_row(const Params& P, int l, int m, int lane, const LAS f32x4* dtw, const float* nw) {
    unsigned char* ws = P.ws;
    float* XB = (float*)(ws + WS_XB);
    const bool first = (!FINAL && l == 0);
    const float* src = first ? P.x : XB;
    const f32x4* xr = (const f32x4*)(src + (size_t)m * DM) + lane;
    f32x4 v[4];
#pragma unroll
    for (int j = 0; j < 4; ++j) v[j] = xr[64 * j];
    if (!first && EN_MOE) {
        const int* slot = (const int*)(ws + WS_SLOT) + (size_t)m * 16; const int b = m >> 11;
        const bf16_t* YE = (const bf16_t*)(ws + WS_YE);
        for (int e = 0; e < 16; ++e) { const int s = __builtin_amdgcn_readfirstlane(slot[e]);
            if (s >= 0) { const u32x2* yr = (const u32x2*)(YE + ((size_t)((b * 16 + e) * 256 + s)) * DM) + lane;
#pragma unroll
                for (int j = 0; j < 4; ++j) { const u32x2 y = yr[64 * j]; v[j].x += bflo(y.x); v[j].y += bfhi(y.x); v[j].z += bflo(y.y); v[j].w += bfhi(y.y); } } }
    }
    float s = 0.f;
#pragma unroll
    for (int j = 0; j < 4; ++j) s += (v[j].x * v[j].x + v[j].y * v[j].y) + (v[j].z * v[j].z + v[j].w * v[j].w);
    const float r = 1.0f / sqrtf(wave_sum(s) * (1.0f / DM) + EPSN);
    if (FINAL) {
        f32x4* o = (f32x4*)(P.out + (size_t)m * DM) + lane;
#pragma unroll
        for (int j = 0; j < 4; ++j) { const f32x4 w = ((const f32x4*)nw)[64 * j + lane]; o[64 * j] = v[j] * r * w; }
        return;
    }
    if (!first) { f32x4* o = (f32x4*)(XB + (size_t)m * DM) + lane;
#pragma unroll
        for (int j = 0; j < 4; ++j) o[64 * j] = v[j]; }
    float d[8];
#pragma unroll
    for (int c = 0; c < 8; ++c) d[c] = 0.f;
#pragma unroll
    for (int j = 0; j < 4; ++j) {
        const float xv[4] = {v[j].x, v[j].y, v[j].z, v[j].w};
#pragma unroll
        for (int q = 0; q < 4; ++q) { const f32x4 w0 = dtw[((j * 4 + q) * 2 + 0) * 64 + lane], w1 = dtw[((j * 4 + q) * 2 + 1) * 64 + lane];
            d[0] += xv[q] * w0.x; d[1] += xv[q] * w0.y; d[2] += xv[q] * w0.z; d[3] += xv[q] * w0.w; d[4] += xv[q] * w1.x; d[5] += xv[q] * w1.y; d[6] += xv[q] * w1.z; d[7] += xv[q] * w1.w; }
    }
    float mine = 0.f;
#pragma unroll
    for (int c = 0; c < 8; ++c) { const float t = wave_sum(d[c]); mine = (lane == c) ? t : mine; }
    if (lane < 8) ((float*)(ws + WS_DT))[(size_t)m * 8 + lane] = mine * r;
    u32x2* o8 = (u32x2*)((bf16_t*)(ws + WS_HN) + (size_t)m * DM) + lane;
#pragma unroll
    for (int j = 0; j < 4; ++j) { const f32x4 w = ((const f32x4*)nw)[64 * j + lane]; u32x2 o; o.x = pk2(v[j].x * r * w.x, v[j].y * r * w.y); o.y = pk2(v[j].z * r * w.z, v[j].w * r * w.w); o8[64 * j] = o; }
}

DI void phase_pre(const Params& P, int l, LAS unsigned char* lds) {
    const int tid = tid_opaque(), lane = tid & 63, wave = tid >> 6;
    const int gw = blockIdx.x * 8 + wave, NGW = gridDim.x * 8;
    unsigned char* ws = P.ws;
    LAS float* dtwf = (LAS float*)lds;
    for (int i = tid; i < 1024 * 8; i += 512) { const int k = i >> 3, c = i & 7; const int j = k >> 8, ln = (k & 255) >> 2, q = k & 3;
        dtwf[((((j * 4 + q) * 2 + (c >> 2)) * 64 + ln) << 2) + (c & 3)] = P.norm_mix_w[l * DM + k] * P.w_in[((size_t)l * DM + k) * NIN_REF + 1536 + c]; }
    __syncthreads();
    if (EN_HY) for (int pos = gw; pos < SEQ; pos += NGW) hyena_filter_pos(P, l, pos, lane, (bf16_t*)(ws + WS_KFILT));
    {
        LAS float* scr = (LAS float*)(lds + 32768 + wave * 8448);
        constexpr int I_A = 16 * 48, I_B = 16 * 64, I_O = 16 * 32, I_E = 16 * 32 * 16;
        constexpr int NITEMS = I_A + I_B + I_O; (void)I_E;
        bf16_t* WinT = (bf16_t*)(ws + WS_WIN); bf16_t* WoutT = (bf16_t*)(ws + WS_WOUT); bf16_t* WguT = (bf16_t*)(ws + WS_WGU); bf16_t* WdT = (bf16_t*)(ws + WS_WD);
        for (int it = gw; it < NITEMS; it += NGW) {
            int r = it;
            if (r < I_A) { const int kb = r / 48, nb = r % 48; transpose_item(P.w_in + (size_t)l * DM * NIN_REF, NIN_REF, 64 * kb, 32 * nb, WinT, 32 * nb, 1.0f, scr, lane); continue; } r -= I_A;
            if (r < I_B) { const int kb = r / 64, nb = r % 64; const int drow = 1536 + 32 * nb; transpose_item(P.w_in + (size_t)l * DM * NIN_REF, NIN_REF, 64 * kb, 1544 + 32 * nb, WinT, drow, drow < PC_AK ? 0.125f : 1.0f, scr, lane); continue; } r -= I_B;
            { const int kb = r / 32, nb = r % 32; transpose_item(P.w_out + (size_t)l * DM * DM, DM, 64 * kb, 32 * nb, WoutT, 32 * nb, 1.0f, scr, lane); }
            (void)WguT; (void)WdT;
        }
    }
    const float* nw = P.norm_mix_w + l * DM;
    for (int m = gw; m < NTOK; m += NGW) { asm volatile("" ::: "memory"); pre_row<false>(P, l, m, lane, (const LAS f32x4*)dtwf, nw); }
}
DI void phase_final(const Params& P) {
    const int tid = tid_opaque(), lane = tid & 63, wave = tid >> 6;
    const int gw = blockIdx.x * 8 + wave, NGW = gridDim.x * 8;
    for (int m = gw; m < NTOK; m += NGW) pre_row<true>(P, 1, m, lane, nullptr, P.final_w);
}

struct AddrPlain { static constexpr bool LOADS = false; int K; int nb_rows;
    DI unsigned arow(const pg8::Unit& u, int r) const { return (unsigned)(u.pm * 256 + r) * (unsigned)(K * 2); }
    DI size_t boff(const pg8::Unit& u) const { return (size_t)u.pn * 256 * K * 2; } };
DI int moe_panel(int r) { return (r & 31) * 16 + (r >> 5); }
struct AddrGateUp { static constexpr bool LOADS = true; const int* seli;
    DI unsigned arow(const pg8::Unit& u, int r) const { const int b = u.pm & 31; const int t = seli[moe_panel(u.pm) * 256 + r]; return (unsigned)(b * SEQ + t) * (unsigned)(DM * 2); }
    DI unsigned arow_lds(const LAS unsigned char* tab, int k, const pg8::Unit&, int r) const { return ((const LAS unsigned*)tab)[k * 256 + r]; }
    DI size_t boff(const pg8::Unit& u) const { return ((size_t)(u.pm >> 5) * 2048 + (size_t)u.pn * 256) * DM * 2; } };
struct AddrDown { static constexpr bool LOADS = false;
    DI unsigned arow(const pg8::Unit& u, int r) const { return (unsigned)(moe_panel(u.pm) * 256 + r) * (unsigned)(DM * 2); }
    DI size_t boff(const pg8::Unit& u) const { return ((size_t)(u.pm >> 5) * 1024 + (size_t)u.pn * 256) * DM * 2; } };

struct EpiProj { static constexpr bool PERM = true; bf16_t* O;
    DI void operator()(const f32x4 (&acc)[2][2][4][2], const pg8::Unit& u, int wr, int wc, int fr, int fq) const {
        const int row0 = u.pm * 256 + wr * 64 + fr, col0 = u.pn * 256 + wc * 32 + 8 * fq;
#pragma unroll
        for (int ai = 0; ai < 2; ++ai)
#pragma unroll
            for (int m = 0; m < 4; ++m) { bf16_t* rowp = O + (size_t)(row0 + ai * 128 + m * 16) * NPROJ + col0;
#pragma unroll
                for (int bj = 0; bj < 2; ++bj) { const f32x4 v0 = acc[ai][bj][m][0], v1 = acc[ai][bj][m][1];
                    u32x4 w; w.x = pk2(v0[0], v0[1]); w.y = pk2(v0[2], v0[3]); w.z = pk2(v1[0], v1[1]); w.w = pk2(v1[2], v1[3]);
                    *(u32x4*)(rowp + bj * 128) = w; } }
    } };
struct EpiRes { static constexpr bool PERM = false; const float* base; float* out;
    DI void operator()(const f32x4 (&acc)[2][2][4][2], const pg8::Unit& u, int wr, int wc, int fr, int fq) const {
        const int row0 = u.pm * 256 + wr * 64 + fr, col0 = u.pn * 256 + wc * 32 + 4 * fq;
#pragma unroll
        for (int ai = 0; ai < 2; ++ai)
#pragma unroll
            for (int m = 0; m < 4; ++m) { const size_t off = (size_t)(row0 + ai * 128 + m * 16) * DM + col0;
#pragma unroll
                for (int bj = 0; bj < 2; ++bj)
#pragma unroll
                    for (int n = 0; n < 2; ++n) { const f32x4 bs = *(const f32x4*)(base + off + bj * 128 + n * 16); *(f32x4*)(out + off + bj * 128 + n * 16) = bs + acc[ai][bj][m][n]; } }
    } };
struct EpiGateUp { static constexpr bool PERM = true; bf16_t* H; const float* selr;
    DI void operator()(const f32x4 (&acc)[2][2][4][2], const pg8::Unit& u, int wr, int wc, int fr, int fq) const {
        const int row0 = moe_panel(u.pm) * 256 + wr * 64 + fr, col0 = u.pn * 128 + wc * 32 + 8 * fq;
#pragma unroll
        for (int ai = 0; ai < 2; ++ai)
#pragma unroll
            for (int m = 0; m < 4; ++m) { bf16_t* rowp = H + (size_t)(row0 + ai * 128 + m * 16) * DM + col0; const float rr = selr[row0 + ai * 128 + m * 16];
                float hv[8];
#pragma unroll
                for (int n = 0; n < 2; ++n)
#pragma unroll
                    for (int j = 0; j < 4; ++j) { const float g = acc[ai][0][m][n][j] * rr, up = acc[ai][1][m][n][j] * rr; hv[n * 4 + j] = silu_f(g) * up; }
                u32x4 w; w.x = pk2(hv[0], hv[1]); w.y = pk2(hv[2], hv[3]); w.z = pk2(hv[4], hv[5]); w.w = pk2(hv[6], hv[7]);
                *(u32x4*)rowp = w; }
    } };
struct EpiDown { static constexpr bool PERM = true; bf16_t* Y; const float* gate;
    DI void operator()(const f32x4 (&acc)[2][2][4][2], const pg8::Unit& u, int wr, int wc, int fr, int fq) const {
        const int row0 = moe_panel(u.pm) * 256 + wr * 64 + fr, col0 = u.pn * 256 + wc * 32 + 8 * fq;
#pragma unroll
        for (int ai = 0; ai < 2; ++ai)
#pragma unroll
            for (int m = 0; m < 4; ++m) { const int row = row0 + ai * 128 + m * 16; const float g = gate[row]; bf16_t* rowp = Y + (size_t)row * DM + col0;
#pragma unroll
                for (int bj = 0; bj < 2; ++bj) { const f32x4 v0 = acc[ai][bj][m][0] * g, v1 = acc[ai][bj][m][1] * g;
                    u32x4 w; w.x = pk2(v0[0], v0[1]); w.y = pk2(v0[2], v0[3]); w.z = pk2(v1[0], v1[1]); w.w = pk2(v1[2], v1[3]);
                    *(u32x4*)(rowp + bj * 128) = w; } }
    } };

DI void phase_premix(const Params& P, int l) {
    const int tid = tid_opaque(), lane = tid & 63, wave = tid >> 6;
    const int gw = blockIdx.x * 8 + wave, NGW = gridDim.x * 8;
    unsigned char* ws = P.ws;
    const bf16_t* proj = (const bf16_t*)(ws + WS_PROJ);
    unsigned char* dsc = (unsigned char*)P.out;
    if (EN_HY) {
        bf16_t* HW = (bf16_t*)(dsc + DO_HW); bf16_t* HX0 = (bf16_t*)(dsc + DO_HX0);
        const float* cw = P.hy_conv_w + (size_t)l * 3 * 768;
        for (int it = gw; it < NB * 32 * 4; it += NGW) {
            const int ct = it & 3, tt = (it >> 2) & 31, b = it >> 7;
            const int c = ct * 64 + lane, t0 = tt * 64;
            float w0[3], w1[3], w2[3];
#pragma unroll
            for (int j = 0; j < 3; ++j) { w0[j] = cw[j * 768 + c]; w1[j] = cw[j * 768 + 256 + c]; w2[j] = cw[j * 768 + 512 + c]; }
            const bf16_t* pr = proj + (size_t)b * SEQ * NPROJ + c;
            bf16_t* hwp = HW + ((size_t)c * NB + b) * SEQ + t0; bf16_t* hxp = HX0 + ((size_t)c * NB + b) * SEQ + t0;
            float a0, a1, a2, b0, b1, b2, c0, c1, c2;
            { const int t = t0 - 1; const bool ok = t >= 0; const bf16_t* q = pr + (size_t)(ok ? t : 0) * NPROJ; a0 = ok ? bf2f(q[0]) : 0.f; a1 = ok ? bf2f(q[256]) : 0.f; a2 = ok ? bf2f(q[512]) : 0.f; }
            { const bf16_t* q = pr + (size_t)t0 * NPROJ; b0 = bf2f(q[0]); b1 = bf2f(q[256]); b2 = bf2f(q[512]); }
#pragma unroll 1
            for (int t8 = 0; t8 < 64; t8 += 8) {
                unsigned hwv[4], hxv[4]; float ph = 0.f, px = 0.f;
#pragma unroll
                for (int i = 0; i < 8; ++i) { const int t = t0 + t8 + i + 1; const bool ok = t < SEQ; const bf16_t* q = pr + (size_t)(ok ? t : SEQ - 1) * NPROJ;
                    c0 = ok ? bf2f(q[0]) : 0.f; c1 = ok ? bf2f(q[256]) : 0.f; c2 = ok ? bf2f(q[512]) : 0.f;
                    const float u0 = w0[0] * a0 + w0[1] * b0 + w0[2] * c0, u1 = w1[0] * a1 + w1[1] * b1 + w1[2] * c1, u2 = w2[0] * a2 + w2[1] * b2 + w2[2] * c2;
                    const float hv = u2 * u1;
                    if (i & 1) { hwv[i >> 1] = pk2(ph, hv); hxv[i >> 1] = pk2(px, u0); } else { ph = hv; px = u0; }
                    a0 = b0; a1 = b1; a2 = b2; b0 = c0; b1 = c1; b2 = c2; }
                *(u32x4*)(hwp + t8) = (u32x4){hwv[0], hwv[1], hwv[2], hwv[3]}; *(u32x4*)(hxp + t8) = (u32x4){hxv[0], hxv[1], hxv[2], hxv[3]};
            }
        }
    }
    if (EN_MA) {
        bf16_t* MX = (bf16_t*)(dsc + DO_MXBC);
        const float* cw = P.m_conv_w + (size_t)l * 5 * 512; const float* cb = P.m_conv_b + (size_t)l * 512;
        const int gt = blockIdx.x * 512 + tid, NGT = gridDim.x * 512;
        for (int it = gt; it < NTOK * 64; it += NGT) {
            const int ch = (it & 63) * 8, m = it >> 6, t = m & (SEQ - 1);
            float a[8];
#pragma unroll
            for (int i = 0; i < 8; ++i) a[i] = cb[ch + i];
#pragma unroll
            for (int j = 0; j < 5; ++j) { const int tt = t + j - 2; if (tt >= 0 && tt < SEQ) {
                const u32x4 v = *(const u32x4*)(proj + (size_t)(m + j - 2) * NPROJ + PC_MX + ch);
                const f32x4 wa = *(const f32x4*)(cw + j * 512 + ch), wb = *(const f32x4*)(cw + j * 512 + ch + 4);
                a[0] += wa.x * bflo(v.x); a[1] += wa.y * bfhi(v.x); a[2] += wa.z * bflo(v.y); a[3] += wa.w * bfhi(v.y);
                a[4] += wb.x * bflo(v.z); a[5] += wb.y * bfhi(v.z); a[6] += wb.z * bflo(v.w); a[7] += wb.w * bfhi(v.w); } }
            u32x4 o; o.x = pk2(silu_f(a[0]), silu_f(a[1])); o.y = pk2(silu_f(a[2]), silu_f(a[3])); o.z = pk2(silu_f(a[4]), silu_f(a[5])); o.w = pk2(silu_f(a[6]), silu_f(a[7]));
            *(u32x4*)(MX + (size_t)m * 512 + ch) = o;
        }
    }
}

DI void phase_finalize(const Params& P, int l) {
    const int tid = tid_opaque(), lane = tid & 63, wave = tid >> 6;
    const int gw = blockIdx.x * 8 + wave, NGW = gridDim.x * 8;
    unsigned char* ws = P.ws; unsigned char* dsc = (unsigned char*)P.out;
    bf16_t* MIX = (bf16_t*)(ws + WS_HN);
    {
        const bf16_t* YAT = (const bf16_t*)(dsc + DO_YAT);
        for (int it = gw; it < NB * 32 * 4; it += NGW) {
            const int ct = it & 3, tt = (it >> 2) & 31, b = it >> 7;
            const int c = ct * 64 + lane, t0 = tt * 64;
            const bf16_t* src = YAT + ((size_t)c * NB + b) * SEQ + t0;
            bf16_t* dst = MIX + ((size_t)b * SEQ + t0) * DM + c;
#pragma unroll 2
            for (int t8 = 0; t8 < 64; t8 += 8) {
                u32x4 v = EN_HY ? *(const u32x4*)(src + t8) : (u32x4){0u, 0u, 0u, 0u};
                const unsigned w[4] = {v.x, v.y, v.z, v.w};
#pragma unroll
                for (int i = 0; i < 8; ++i) dst[(size_t)(t8 + i) * DM] = (bf16_t)((i & 1) ? (w[i >> 1] >> 16) : (w[i >> 1] & 0xffffu));
            }
        }
    }
    {
        const bf16_t* MYF = (const bf16_t*)(dsc + DO_MY); const bf16_t* MYB = (const bf16_t*)(ws + WS_MYB); const bf16_t* MX = (const bf16_t*)(dsc + DO_MXBC);
        const bf16_t* proj = (const bf16_t*)(ws + WS_PROJ); const float* nw = P.m_norm_w + l * 256;
        const int gt = blockIdx.x * 512 + tid, NGT = gridDim.x * 512;
        for (int it = gt; it < NTOK * 32; it += NGT) {
            const int ch = (it & 31) * 8, m = it >> 5;
            u32x4 o = {0u, 0u, 0u, 0u};
            if (EN_MA) {
                const u32x4 yf = *(const u32x4*)(MYF + (size_t)m * 256 + ch), yb = *(const u32x4*)(MYB + (size_t)m * 256 + ch), xv = *(const u32x4*)(MX + (size_t)m * 512 + ch), zv = *(const u32x4*)(proj + (size_t)m * NPROJ + PC_MZ + ch);
                const float Dk = P.m_D[l * 4 + (ch >> 6)];
                const unsigned yfw[4] = {yf.x, yf.y, yf.z, yf.w}, ybw[4] = {yb.x, yb.y, yb.z, yb.w}, xw[4] = {xv.x, xv.y, xv.z, xv.w}, zw[4] = {zv.x, zv.y, zv.z, zv.w};
                float y[8]; float sq = 0.f;
#pragma unroll
                for (int j = 0; j < 4; ++j) { y[2 * j] = (bflo(yfw[j]) + bflo(ybw[j]) + Dk * bflo(xw[j])) * silu_f(bflo(zw[j])); y[2 * j + 1] = (bfhi(yfw[j]) + bfhi(ybw[j]) + Dk * bfhi(xw[j])) * silu_f(bfhi(zw[j]));
                    sq += y[2 * j] * y[2 * j] + y[2 * j + 1] * y[2 * j + 1]; }
#pragma unroll
                for (int of = 1; of < 32; of <<= 1) sq += __shfl_xor(sq, of);
                const float r = 1.0f / sqrtf(sq * (1.0f / 256.0f) + EPSN);
                const f32x4 wa = *(const f32x4*)(nw + ch), wb = *(const f32x4*)(nw + ch + 4);
                o.x = pk2(y[0] * r * wa.x, y[1] * r * wa.y); o.y = pk2(y[2] * r * wa.z, y[3] * r * wa.w); o.z = pk2(y[4] * r * wb.x, y[5] * r * wb.y); o.w = pk2(y[6] * r * wb.z, y[7] * r * wb.w);
            }
            *(u32x4*)(MIX + (size_t)m * DM + 256 + ch) = o;
        }
    }
    if (EN_HG) {
        const bf16_t* OB = (const bf16_t*)(ws + WS_OB); const bf16_t* proj = (const bf16_t*)(ws + WS_PROJ); const float* nw = P.hg_norm_w + l * 64;
        const int gt = blockIdx.x * 512 + tid, NGT = gridDim.x * 512;
        for (int it = gt; it < NTOK * 32; it += NGT) {
            const int ch = (it & 31) * 8, m = it >> 5;
            const u32x4 of = *(const u32x4*)(MIX + (size_t)m * DM + 768 + ch), ob = *(const u32x4*)(OB + (size_t)m * 256 + ch), gv = *(const u32x4*)(proj + (size_t)m * NPROJ + PC_HG + ch);
            const unsigned ofw[4] = {of.x, of.y, of.z, of.w}, obw[4] = {ob.x, ob.y, ob.z, ob.w}, gw4[4] = {gv.x, gv.y, gv.z, gv.w};
            float y[8]; float sq = 0.f;
#pragma unroll
            for (int j = 0; j < 4; ++j) { y[2 * j] = bflo(ofw[j]) + bflo(obw[j]); y[2 * j + 1] = bfhi(ofw[j]) + bfhi(obw[j]); sq += y[2 * j] * y[2 * j] + y[2 * j + 1] * y[2 * j + 1]; }
#pragma unroll
            for (int o2 = 1; o2 < 8; o2 <<= 1) sq += __shfl_xor(sq, o2);
            const float r = 1.0f / sqrtf(sq * (1.0f / 64.0f) + EPSN);
            const f32x4 wa = *(const f32x4*)(nw + (ch & 63)), wb = *(const f32x4*)(nw + (ch & 63) + 4);
            u32x4 o;
            o.x = pk2(y[0] * r * wa.x * silu_f(bflo(gw4[0])), y[1] * r * wa.y * silu_f(bfhi(gw4[0]))); o.y = pk2(y[2] * r * wa.z * silu_f(bflo(gw4[1])), y[3] * r * wa.w * silu_f(bfhi(gw4[1])));
            o.z = pk2(y[4] * r * wb.x * silu_f(bflo(gw4[2])), y[5] * r * wb.y * silu_f(bfhi(gw4[2]))); o.w = pk2(y[6] * r * wb.z * silu_f(bflo(gw4[3])), y[7] * r * wb.w * silu_f(bfhi(gw4[3])));
            *(u32x4*)(MIX + (size_t)m * DM + 768 + ch) = o;
        }
    }
#if !EN_AT || !EN_HG
    {
        const int gt = blockIdx.x * 512 + tid, NGT = gridDim.x * 512;
        for (int it = gt; it < NTOK * 32; it += NGT) { const int ch = (it & 31) * 8, m = it >> 5;
            if (!EN_AT) *(u32x4*)(MIX + (size_t)m * DM + 512 + ch) = (u32x4){0u, 0u, 0u, 0u};
            if (!EN_HG) *(u32x4*)(MIX + (size_t)m * DM + 768 + ch) = (u32x4){0u, 0u, 0u, 0u}; }
    }
#endif
}

DI void phase_ffnpre(const Params& P, int l, LAS unsigned char* lds) {
    const int tid = tid_opaque(), lane = tid & 63, wave = tid >> 6, r = lane & 15, q = lane >> 4;
    const int gw = blockIdx.x * 8 + wave, NGW = gridDim.x * 8;
    unsigned char* ws = P.ws;
    LAS u32x4* Wh = (LAS u32x4*)lds;
    LAS u32x4* Wl = Wh + 32 * 64;
    for (int i = tid; i < 32 * 64; i += 512) { const int s = i >> 6, ln = i & 63, e = ln & 15, qq = ln >> 4; float wv[8]; unsigned hi[4], lo[4];
#pragma unroll
        for (int j = 0; j < 8; ++j) { const int k = 32 * s + 8 * qq + j; wv[j] = P.norm_ffn_w[l * DM + k] * P.router_w[((size_t)l * DM + k) * 16 + e]; }
#pragma unroll
        for (int j = 0; j < 4; ++j) { hi[j] = pk2(wv[2 * j], wv[2 * j + 1]); lo[j] = pk2(wv[2 * j] - bflo(hi[j]), wv[2 * j + 1] - bfhi(hi[j])); }
        Wh[i] = (u32x4){hi[0], hi[1], hi[2], hi[3]}; Wl[i] = (u32x4){lo[0], lo[1], lo[2], lo[3]}; }
    __syncthreads();
    const float* XB = (const float*)(ws + WS_XB); const float* nw = P.norm_ffn_w + l * DM + 8 * q;
    float* aff = (float*)(ws + WS_AFF); float* rs = (float*)(ws + WS_RS);
    bf16_t* XN = (bf16_t*)(ws + WS_HN);
    for (int grp = gw; grp < NTOK / 16; grp += NGW) {
        const int m0 = grp * 16;
        const float* xrow = XB + (size_t)(m0 + r) * DM + 8 * q; bf16_t* orow = XN + (size_t)(m0 + r) * DM + 8 * q;
        f32x4 acc = {0.f, 0.f, 0.f, 0.f}; float ss = 0.f;
#pragma unroll 4
        for (int s = 0; s < 32; ++s) {
            const f32x4 a = *(const f32x4*)(xrow + 32 * s), b = *(const f32x4*)(xrow + 32 * s + 4);
            const f32x4 wa = *(const f32x4*)(nw + 32 * s), wb = *(const f32x4*)(nw + 32 * s + 4);
            ss += (a.x * a.x + a.y * a.y) + (a.z * a.z + a.w * a.w) + (b.x * b.x + b.y * b.y) + (b.z * b.z + b.w * b.w);
            const unsigned h0 = pk2(a.x, a.y), h1 = pk2(a.z, a.w), h2 = pk2(b.x, b.y), h3 = pk2(b.z, b.w);
            const unsigned l0 = pk2(a.x - bflo(h0), a.y - bfhi(h0)), l1 = pk2(a.z - bflo(h1), a.w - bfhi(h1)), l2 = pk2(b.x - bflo(h2), b.y - bfhi(h2)), l3 = pk2(b.z - bflo(h3), b.w - bfhi(h3));
            const bf16x8 ah = mk8u(h0, h1, h2, h3), al = mk8u(l0, l1, l2, l3);
            const bf16x8 wh = __builtin_bit_cast(bf16x8, Wh[s * 64 + lane]), wl = __builtin_bit_cast(bf16x8, Wl[s * 64 + lane]);
            acc = __builtin_amdgcn_mfma_f32_16x16x32_bf16(ah, wh, acc, 0, 0, 0);
            acc = __builtin_amdgcn_mfma_f32_16x16x32_bf16(ah, wl, acc, 0, 0, 0);
            acc = __builtin_amdgcn_mfma_f32_16x16x32_bf16(al, wh, acc, 0, 0, 0);
            *(u32x4*)(orow + 32 * s) = (u32x4){pk2(a.x * wa.x, a.y * wa.y), pk2(a.z * wa.z, a.w * wa.w), pk2(b.x * wb.x, b.y * wb.y), pk2(b.z * wb.z, b.w * wb.w)};
        }
        ss += __shfl_xor(ss, 16); ss += __shfl_xor(ss, 32);
        const float rinv = 1.0f / sqrtf(ss * (1.0f / DM) + EPSN);
        if (q == 0) rs[m0 + r] = rinv;
#pragma unroll
        for (int i = 0; i < 4; ++i) {
            const float lg = acc[i] * __shfl(rinv, 4 * q + i);
            float mx = lg;
#pragma unroll
            for (int o = 1; o < 16; o <<= 1) mx = fmaxf(mx, __shfl_xor(mx, o));
            const float ex = expf(lg - mx); float se = ex;
#pragma unroll
            for (int o = 1; o < 16; o <<= 1) se += __shfl_xor(se, o);
            const int m = m0 + 4 * q + i;
            aff[((size_t)(m >> 11) * 16 + r) * SEQ + (m & (SEQ - 1))] = ex / se;
        }
    }
}

DI int wave_sum_i(int v) {
#pragma unroll
    for (int o = 1; o < 64; o <<= 1) v += __shfl_xor(v, o);
    return v;
}
DI int block_excl_scan(int c, int lane, int wave, LAS int* ws8, int* tot) {
    int inc = c;
#pragma unroll
    for (int o = 1; o < 64; o <<= 1) { const int t = __shfl_up(inc, o); if (lane >= o) inc += t; }
    if (lane == 63) ws8[wave] = inc;
    __syncthreads();
    int base = 0, total = 0;
#pragma unroll
    for (int w = 0; w < 8; ++w) { const int t = ws8[w]; base += (w < wave) ? t : 0; total += t; }
    *tot = total;
    return base + inc - c;
}
DI void phase_topk(const Params& P, int l, LAS unsigned char* lds) {
    const int tid = tid_opaque(), lane = tid & 63, wave = tid >> 6;
    unsigned char* ws = P.ws;
    const float* aff = (const float*)(ws + WS_AFF); const float* rs = (const float*)(ws + WS_RS);
    int* slot = (int*)(ws + WS_SLOT); int* seli = (int*)(ws + WS_SELI); float* selg = (float*)(ws + WS_SELG); float* selr = (float*)(ws + WS_SELR);
    LAS int* wsum = (LAS int*)lds;
    for (int u = blockIdx.x; u < NB * NEXP; u += gridDim.x) {
        const int b = u >> 4, e = u & 15;
        __syncthreads();
        const u32x4 k4 = *(const u32x4*)(aff + (size_t)u * SEQ + 4 * tid);
        const unsigned kk[4] = {k4.x, k4.y, k4.z, k4.w};
        unsigned prefix = 0u;
#pragma unroll 1
        for (int bit = 30; bit >= 0; --bit) {
            const unsigned cand = prefix | (1u << bit);
            int c = (kk[0] >= cand) + (kk[1] >= cand) + (kk[2] >= cand) + (kk[3] >= cand);
            c = wave_sum_i(c);
            if (lane == 0) wsum[(bit & 1) * 8 + wave] = c;
            __syncthreads();
            int tot = 0;
#pragma unroll
            for (int w = 0; w < 8; ++w) tot += wsum[(bit & 1) * 8 + w];
            if (tot >= CAP) prefix = cand;
        }
        const unsigned thr = prefix;
        int cgt = (kk[0] > thr) + (kk[1] > thr) + (kk[2] > thr) + (kk[3] > thr), ngt;
        (void)block_excl_scan(cgt, lane, wave, wsum + 16, &ngt);
        const int need = CAP - ngt;
        const int ceq = (kk[0] == thr) + (kk[1] == thr) + (kk[2] == thr) + (kk[3] == thr); int neq;
        int eqr = block_excl_scan(ceq, lane, wave, wsum + 24, &neq);
        bool sel[4]; int cs = 0;
#pragma unroll
        for (int j = 0; j < 4; ++j) { const bool eq = kk[j] == thr; sel[j] = (kk[j] > thr) || (eq && eqr < need); eqr += eq ? 1 : 0; cs += sel[j] ? 1 : 0; }
        int nsel; int sb = block_excl_scan(cs, lane, wave, wsum + 32, &nsel);
#pragma unroll
        for (int j = 0; j < 4; ++j) { const int i = 4 * tid + j;
            slot[((size_t)b * SEQ + i) * 16 + e] = sel[j] ? sb : -1;
            if (sel[j]) { seli[u * CAP + sb] = i; selg[u * CAP + sb] = __uint_as_float(kk[j]); selr[u * CAP + sb] = rs[(size_t)b * SEQ + i]; ++sb; } }
    }
    __syncthreads();
    {
        const int gw = blockIdx.x * 8 + wave, NGW = gridDim.x * 8;
        LAS float* scr = (LAS float*)(lds + 4096 + wave * 8448);
        bf16_t* WguT = (bf16_t*)(ws + WS_WGU); bf16_t* WdT = (bf16_t*)(ws + WS_WD);
        constexpr int I_E = 16 * 32 * 16;
        for (int it = gw; it < 3 * I_E; it += NGW) {
            const int which = it / I_E; const int r = it - which * I_E;
            const int e = r / 512, kb = (r % 512) / 32, nb = r % 32;
            const size_t wofs = ((size_t)l * NEXP + e) * DM * DM;
            if (which == 0)      transpose_item(P.moe_wg + wofs, DM, 64 * kb, 32 * nb, WguT, e * 2048 + ((32 * nb) >> 7) * 256 + ((32 * nb) & 127), 1.0f, scr, lane);
            else if (which == 1) transpose_item(P.moe_wu + wofs, DM, 64 * kb, 32 * nb, WguT, e * 2048 + ((32 * nb) >> 7) * 256 + 128 + ((32 * nb) & 127), 1.0f, scr, lane);
            else                 transpose_item(P.moe_wd + wofs, DM, 64 * kb, 32 * nb, WdT, e * 1024 + 32 * nb, 1.0f, scr, lane);
        }
    }
}

DI bf16x8 mk8(unsigned a, unsigned b, unsigned c, unsigned d) { u32x4 v = {a, b, c, d}; return __builtin_bit_cast(bf16x8, v); }
DI bf16x8 cat44(u32x2 lo, u32x2 hi) { u32x4 v = {lo.x, lo.y, hi.x, hi.y}; return __builtin_bit_cast(bf16x8, v); }
DI u32x4 ldg16(const void* ub, unsigned off) { return *(const u32x4*)((const char*)ub + off); }
DI u32x2 ldg8(const void* ub, unsigned off) { return *(const u32x2*)((const char*)ub + off); }
DI void stg2(void* ub, unsigned off, unsigned short v) { *(unsigned short*)((char*)ub + off) = v; }
DI int crow(int reg, int hh) { return (reg & 3) + 8 * (reg >> 2) + 4 * hh; }
#define PACK_STEP(x, s) mk8(pk2((x)[8 * (s)], (x)[8 * (s) + 1]), pk2((x)[8 * (s) + 2], (x)[8 * (s) + 3]), pk2((x)[8 * (s) + 4], (x)[8 * (s) + 5]), pk2((x)[8 * (s) + 6], (x)[8 * (s) + 7]))

DI void hyena_unit(const Params& P, int c, LAS unsigned char* lds) {
    const int tid = tid_opaque(), lane = tid & 63, w = __builtin_amdgcn_readfirstlane(tid >> 6), r = lane & 31, hh = lane >> 5;
    constexpr int CPS = 8224;
    unsigned char* ws = P.ws; unsigned char* dsc = (unsigned char*)P.out;
    const bf16_t* kf = (const bf16_t*)(ws + WS_KFILT) + (size_t)c * 4096;
    __syncthreads();
    for (int idx = tid; idx < 8 * 4096; idx += 512) { const int p = idx >> 12, i = idx & 4095, mi = i + p;
        *(LAS bf16_t*)(lds + p * CPS + i * 2) = (mi < 4096) ? kf[mi] : (bf16_t)0; }
    __syncthreads();
    const bf16_t* hw = (const bf16_t*)(dsc + DO_HW) + ((size_t)c * NB + r) * SEQ + 8 * hh;
    f32x16 acc[8];
#pragma unroll
    for (int i = 0; i < 8; ++i)
#pragma unroll
        for (int q = 0; q < 16; ++q) acc[i][q] = 0.f;
    const int p = 7 - (r & 7);
    const LAS unsigned char* abase = lds + p * CPS + (2047 - 256 * w - r + 8 * hh - p) * 2;
#pragma unroll 2
    for (int s0 = 0; s0 < SEQ; s0 += 16) {
        const bf16x8 bfr = *(const bf16x8*)(hw + s0);
#pragma unroll
        for (int i = 0; i < 8; ++i) { const bf16x8 afr = *(const LAS bf16x8*)(abase + (s0 - 32 * i) * 2); acc[i] = MFMA32(afr, bfr, acc[i]); }
    }
    const bf16_t* hx = (const bf16_t*)(dsc + DO_HX0) + ((size_t)c * NB + r) * SEQ;
    bf16_t* ya = (bf16_t*)(dsc + DO_YAT) + ((size_t)c * NB + r) * SEQ;
#pragma unroll
    for (int i = 0; i < 8; ++i)
#pragma unroll
        for (int g = 0; g < 4; ++g) { const int t = 256 * w + 32 * i + 8 * g + 4 * hh;
            const u32x2 xv = *(const u32x2*)(hx + t);
            u32x2 o; o.x = pk2(acc[i][4 * g] * bflo(xv.x), acc[i][4 * g + 1] * bfhi(xv.x)); o.y = pk2(acc[i][4 * g + 2] * bflo(xv.y), acc[i][4 * g + 3] * bfhi(xv.y));
            *(u32x2*)(ya + t) = o; }
}

DI int t5_bucket(int rel) {
    const int ret = rel > 0 ? 16 : 0; const int n = rel < 0 ? -rel : rel;
    if (n < 8) return ret + n;
    const float nf = (float)n;
    int large = 8 + (int)(logf(nf / 8.0f) / 4.852030263919617f * 8.0f);
    large = large < 15 ? large : 15;
    return ret + large;
}
DI void attn_unit(const Params& P, int u, LAS unsigned char* lds) {
    const int qb = u & 7, h = (u >> 3) & 3, b = u >> 5;
    const int tid = tid_opaque(), lane = tid & 63, w = __builtin_amdgcn_readfirstlane(tid >> 6), c = lane & 31, hh = lane >> 5;
    LAS float* Ost = (LAS float*)lds;
    LAS float* Mst = (LAS float*)(lds + 69632);
    LAS float* Lst = Mst + 256;
    LAS float* biasT = (LAS float*)(lds + 69632 + 2048);
    LAS unsigned char* Vr = lds + 69632 + 2048 + 8256 + w * 6144;
    unsigned char* ws = P.ws;
    __syncthreads();
    for (int i = tid; i < 768; i += 512) { const int pat = i >> 8, rel = (i & 255) - 128, dd = pat == 0 ? 1 : (pat == 1 ? 4 : 16);
        biasT[i] = (rel >= -64 && rel <= 64) ? P.rel_bias[t5_bucket(rel * dd) * 4 + h] : -INFINITY; }
    __syncthreads();
    const bf16_t* pb = (const bf16_t*)(ws + WS_PROJ) + (size_t)b * SEQ * NPROJ;
    bf16_t* MIX = (bf16_t*)(ws + WS_HN);
    const int Q0 = qb * 256;
#pragma unroll 1
    for (int pp = 0; pp < 4; ++pp) {
        const int pat = pp < 2 ? pp : 2;
        int d, rho, uq0, nq;
        if (pat == 0) { d = 1; rho = 0; uq0 = Q0 + 32 * w; nq = 32; }
        else if (pat == 1) { d = 4; rho = w & 3; uq0 = (Q0 >> 2) + 32 * (w >> 2); nq = 32; }
        else { d = 16; rho = 2 * w + (pp - 2); uq0 = Q0 >> 4; nq = 16; }
        const int uk0 = uq0 - 64, nsub = SEQ / d;
        const int cq = (c < nq) ? c : c - nq;
        const int qpos = (uq0 + cq) * d + rho, ql = qpos - Q0;
        bf16x8 qf[4];
#pragma unroll
        for (int ks = 0; ks < 4; ++ks) qf[ks] = *(const bf16x8*)(pb + (size_t)qpos * NPROJ + PC_AQ + h * 64 + 16 * ks + 8 * hh);
        float mrun = -1.0e30f, lrun = 0.f; f32x16 OT[2];
#pragma unroll
        for (int dt = 0; dt < 2; ++dt)
#pragma unroll
            for (int q = 0; q < 16; ++q) OT[dt][q] = 0.f;
        if (pat != 0) { mrun = Mst[ql]; lrun = Lst[ql];
#pragma unroll
            for (int dt = 0; dt < 2; ++dt)
#pragma unroll
                for (int g = 0; g < 4; ++g) { const f32x4 v = *(const LAS f32x4*)(Ost + ql * 68 + 32 * dt + 8 * g + 4 * hh);
                    OT[dt][4 * g] = v.x; OT[dt][4 * g + 1] = v.y; OT[dt][4 * g + 2] = v.z; OT[dt][4 * g + 3] = v.w; } }
        bf16x8 kf[4]; u32x4 vraw[4];
        {   const int ukr = uk0 + c; const int ukc = ukr < 0 ? 0 : (ukr >= nsub ? nsub - 1 : ukr);
            const unsigned ko = (unsigned)((ukc * d + rho) * NPROJ + h * 64) * 2u;
#pragma unroll
            for (int ks = 0; ks < 4; ++ks) kf[ks] = __builtin_bit_cast(bf16x8, ldg16(pb + PC_AK + 16 * ks + 8 * hh, ko));
#pragma unroll
            for (int i = 0; i < 4; ++i) vraw[i] = ldg16(pb + PC_AV + 8 * (hh + 2 * i), ko); }
        const int i16 = lane & 15, trq = i16 >> 2, trp = i16 & 3;
        const unsigned troff = (unsigned)((4 * hh + trq) * 192 + (16 * ((lane >> 4) & 1) + 4 * trp) * 2);
#pragma unroll 1
        for (int kt = 0; kt < 5; ++kt) {
#pragma unroll
            for (int i = 0; i < 4; ++i) *(LAS u32x4*)(Vr + c * 192 + 16 * (hh + 2 * i)) = vraw[i];
            f32x16 st;
#pragma unroll
            for (int q = 0; q < 16; ++q) st[q] = 0.f;
#pragma unroll
            for (int ks = 0; ks < 4; ++ks) st = MFMA32(kf[ks], qf[ks], st);
            if (kt < 4) {
                const int ukr = uk0 + 32 * (kt + 1) + c; const int ukc = ukr < 0 ? 0 : (ukr >= nsub ? nsub - 1 : ukr);
                const unsigned ko = (unsigned)((ukc * d + rho) * NPROJ + h * 64) * 2u;
#pragma unroll
                for (int ks = 0; ks < 4; ++ks) kf[ks] = __builtin_bit_cast(bf16x8, ldg16(pb + PC_AK + 16 * ks + 8 * hh, ko));
#pragma unroll
                for (int i = 0; i < 4; ++i) vraw[i] = ldg16(pb + PC_AV + 8 * (hh + 2 * i), ko); }
            float tmax = -INFINITY; float lg[16];
            {
                const LAS float* tbp = biasT + pat * 256 + (32 * kt + 64 - cq + 4 * hh);
                const int tlo = uk0 + 32 * kt;
                if (tlo >= 0 && tlo + 31 < nsub) {
#pragma unroll
                    for (int q = 0; q < 16; ++q) { lg[q] = st[q] + tbp[(q & 3) + 8 * (q >> 2)]; tmax = fmaxf(tmax, lg[q]); }
                } else {
#pragma unroll
                    for (int q = 0; q < 16; ++q) { const int uk = tlo + crow(q, hh); lg[q] = (uk >= 0 && uk < nsub) ? st[q] + tbp[(q & 3) + 8 * (q >> 2)] : -INFINITY; tmax = fmaxf(tmax, lg[q]); }
                }
            }
            tmax = fmaxf(tmax, __shfl_xor(tmax, 32));
            if (__any(tmax > mrun + 8.0f)) {
                const float mnew = fmaxf(mrun, tmax), alpha = __expf(mrun - mnew);
                lrun *= alpha; mrun = mnew;
#pragma unroll
                for (int dt = 0; dt < 2; ++dt)
#pragma unroll
                    for (int q = 0; q < 16; ++q) OT[dt][q] *= alpha;
            }
            float psum = 0.f;
#pragma unroll
            for (int q = 0; q < 16; ++q) { lg[q] = __expf(lg[q] - mrun); psum += lg[q]; }
            psum += __shfl_xor(psum, 32);
            lrun += psum;
            LDS_WAIT();
#pragma unroll
            for (int s = 0; s < 2; ++s) { const bf16x8 pf = PACK_STEP(lg, s);
#pragma unroll
                for (int dt = 0; dt < 2; ++dt) {
                    const s16x4 lo = __builtin_amdgcn_ds_read_tr16_b64_v4i16((LAS s16x4*)(Vr + troff + (16 * s) * 192 + 64 * dt));
                    const s16x4 hi = __builtin_amdgcn_ds_read_tr16_b64_v4i16((LAS s16x4*)(Vr + troff + (16 * s + 8) * 192 + 64 * dt));
                    const bf16x8 af = __builtin_shufflevector(lo, hi, 0, 1, 2, 3, 4, 5, 6, 7);
                    OT[dt] = MFMA32(af, pf, OT[dt]); } }
            LDS_WAIT();
        }
        if (pat != 2) {
            if (hh == 0) { Mst[ql] = mrun; Lst[ql] = lrun; }
#pragma unroll
            for (int dt = 0; dt < 2; ++dt)
#pragma unroll
                for (int g = 0; g < 4; ++g) *(LAS f32x4*)(Ost + ql * 68 + 32 * dt + 8 * g + 4 * hh) = (f32x4){OT[dt][4 * g], OT[dt][4 * g + 1], OT[dt][4 * g + 2], OT[dt][4 * g + 3]};
        } else if (c < 16) {
            const float inv = 1.0f / lrun;
            bf16_t* orow = MIX + ((size_t)b * SEQ + qpos) * DM + 512 + h * 64;
#pragma unroll
            for (int dt = 0; dt < 2; ++dt)
#pragma unroll
                for (int g = 0; g < 4; ++g) { u32x2 o; o.x = pk2(OT[dt][4 * g] * inv, OT[dt][4 * g + 1] * inv); o.y = pk2(OT[dt][4 * g + 2] * inv, OT[dt][4 * g + 3] * inv);
                    *(u32x2*)(orow + 32 * dt + 8 * g + 4 * hh) = o; }
        }
        if (pp != 2) __syncthreads();
    }
}

DI float softplus_f(float x) { return x > 20.f ? x : log1pf(expf(x)); }
DI unsigned short hsel(const u32x4& v, int c) { const unsigned w = (c >> 1) == 0 ? v.x : ((c >> 1) == 1 ? v.y : ((c >> 1) == 2 ? v.z : v.w)); return (unsigned short)((c & 1) ? (w >> 16) : (w & 0xffffu)); }
DI void mamba_unit(const Params& P, int l, int u, LAS unsigned char* lds) {
    const int dir = u & 1, h = (u >> 1) & 3, b = u >> 3, g = h >> 1;
    const int tid = tid_opaque(), lane_f = tid & 63, w = __builtin_amdgcn_readfirstlane(tid >> 6);
    LAS unsigned char* wl = lds + w * 15616;
    LAS unsigned short* xdT = (LAS unsigned short*)wl;
    LAS unsigned short* xwT = xdT + 64 * 40;
    LAS unsigned short* BT = xwT + 64 * 40;
    LAS float* dtv = (LAS float*)(wl + 15360);
    LAS float* acum = dtv + 32;
    LAS float* Atot = (LAS float*)(lds + 8 * 15616);
    unsigned char* ws = P.ws; unsigned char* dsc = (unsigned char*)P.out;
    const bf16_t* xbc = (const bf16_t*)(dsc + DO_MXBC) + (size_t)b * SEQ * 512;
    const float* dtr = (const float*)(ws + WS_DT) + (size_t)b * SEQ * 8 + dir * 4 + h;
    bf16_t* MYD = (bf16_t*)(dir ? (ws + WS_MYB) : (dsc + DO_MY)) + (size_t)b * SEQ * 256 + h * 64;
    float* stsc = (float*)(dsc + DO_MST) + (size_t)u * (8 * 4096);
    const float dtb = P.m_dt_bias[l * 8 + dir * 4 + h], Aneg = -expf(P.m_A_log[l * 8 + dir * 4 + h]);
    __syncthreads();
#define MTK(c0, j) (dir ? (c0) + 31 - (j) : (c0) + (j))
#define MCH(ci) (256 * w + 32 * (dir ? 7 - (ci) : (ci)))
#pragma unroll 1
    for (int pass = 0; pass < 2; ++pass) {
        int lane_p = lane_f; asm volatile("" : "+v"(lane_p));
        const int lane = lane_p, c32 = lane_p & 31, hh = lane_p >> 5, tg = lane_p >> 3, cg = lane_p & 7;
        f32x16 ST[2][2];
#pragma unroll
        for (int a = 0; a < 2; ++a)
#pragma unroll
            for (int q = 0; q < 2; ++q)
#pragma unroll
                for (int i = 0; i < 16; ++i) ST[a][q][i] = 0.f;
        if (pass == 1) {
            const int nv = dir ? 7 - w : w;
            for (int k = 0; k < nv; ++k) { const int v = dir ? 7 - k : k; const float dec = Atot[v];
                const f32x4* sp = (const f32x4*)(stsc + (size_t)v * 4096 + lane * 64);
#pragma unroll
                for (int a = 0; a < 2; ++a)
#pragma unroll
                    for (int q = 0; q < 2; ++q)
#pragma unroll
                        for (int i4 = 0; i4 < 4; ++i4) { const f32x4 t = sp[(a * 2 + q) * 4 + i4];
                            ST[a][q][4 * i4] = ST[a][q][4 * i4] * dec + t.x; ST[a][q][4 * i4 + 1] = ST[a][q][4 * i4 + 1] * dec + t.y; ST[a][q][4 * i4 + 2] = ST[a][q][4 * i4 + 2] * dec + t.z; ST[a][q][4 * i4 + 3] = ST[a][q][4 * i4 + 3] * dec + t.w; } }
        }
        float atot = 0.f;
        u32x4 rx[4], rB[4]; float rdt;
        { const int c0 = MCH(0);
#pragma unroll
          for (int i = 0; i < 4; ++i) { const unsigned ro = (unsigned)(MTK(c0, 4 * tg + i) * 512 + 8 * cg) * 2u; rx[i] = ldg16(xbc + h * 64, ro); rB[i] = ldg16(xbc + 256 + g * 64, ro); }
          rdt = *(const float*)((const char*)dtr + (unsigned)(MTK(c0, c32) * 32)); }
#pragma unroll 1
        for (int ci = 0; ci < 8; ++ci) {
            int lane_i = lane; asm volatile("" : "+v"(lane_i));
            const int c32 = lane_i & 31, hh = lane_i >> 5, tg = lane_i >> 3, cg = lane_i & 7;
            const int c0 = MCH(ci);
            {
                const float dt = softplus_f(rdt + dtb);
                float ac = dt * Aneg;
#pragma unroll
                for (int o = 1; o < 32; o <<= 1) { const float t = __shfl_up(ac, o, 32); if (c32 >= o) ac += t; }
                if (lane < 32) { dtv[c32] = dt; acum[c32] = ac; }
            }
            LDS_WAIT();
            const float aend = acum[31];
            {
                const f32x4 d4 = *(const LAS f32x4*)(dtv + 4 * tg), a4 = *(const LAS f32x4*)(acum + 4 * tg);
                const float dj[4] = {d4.x, d4.y, d4.z, d4.w};
                const float wj[4] = {__expf(aend - a4.x), __expf(aend - a4.y), __expf(aend - a4.z), __expf(aend - a4.w)};
#pragma unroll
                for (int c = 0; c < 8; ++c) {
                    float xd[4]; unsigned short bb[4];
#pragma unroll
                    for (int i = 0; i < 4; ++i) { xd[i] = bf2f(hsel(rx[i], c)) * dj[i]; bb[i] = hsel(rB[i], c); }
                    *(LAS u32x2*)(xdT + (8 * cg + c) * 40 + 4 * tg) = (u32x2){pk2(xd[0], xd[1]), pk2(xd[2], xd[3])};
                    *(LAS u32x2*)(xwT + (8 * cg + c) * 40 + 4 * tg) = (u32x2){pk2(xd[0] * wj[0], xd[1] * wj[1]), pk2(xd[2] * wj[2], xd[3] * wj[3])};
                    *(LAS u32x2*)(BT + (8 * cg + c) * 40 + 4 * tg) = (u32x2){(unsigned)bb[0] | ((unsigned)bb[1] << 16), (unsigned)bb[2] | ((unsigned)bb[3] << 16)};
                    __builtin_amdgcn_sched_barrier(0);
                }
            }
            if (ci < 7) { const int c1 = MCH(ci + 1);
#pragma unroll
                for (int i = 0; i < 4; ++i) { const unsigned ro = (unsigned)(MTK(c1, 4 * tg + i) * 512 + 8 * cg) * 2u; rx[i] = ldg16(xbc + h * 64, ro); rB[i] = ldg16(xbc + 256 + g * 64, ro); }
                rdt = *(const float*)((const char*)dtr + (unsigned)(MTK(c1, c32) * 32)); }
            LDS_WAIT();
            if (pass == 1) {
                const unsigned bro = (unsigned)(MTK(c0, c32) * 512 + 8 * hh) * 2u;
                f32x16 GT;
#pragma unroll
                for (int i = 0; i < 16; ++i) GT[i] = 0.f;
#pragma unroll
                for (int ks = 0; ks < 4; ++ks) GT = MFMA32(__builtin_bit_cast(bf16x8, ldg16(xbc + 256 + g * 64 + 16 * ks, bro)), __builtin_bit_cast(bf16x8, ldg16(xbc + 384 + g * 64 + 16 * ks, bro)), GT);
                const float acl = acum[c32];
#pragma unroll
                for (int i = 0; i < 16; ++i) { const int s = crow(i, hh); GT[i] = (s <= c32) ? GT[i] * __expf(acl - acum[s]) : 0.f; }
                f32x16 Y[2];
#pragma unroll
                for (int pt = 0; pt < 2; ++pt)
#pragma unroll
                    for (int i = 0; i < 16; ++i) Y[pt][i] = 0.f;
#pragma unroll
                for (int s = 0; s < 2; ++s) { const bf16x8 pa = PACK_STEP(GT, s);
#pragma unroll
                    for (int pt = 0; pt < 2; ++pt) { const LAS unsigned short* xr = xdT + (32 * pt + c32) * 40 + 16 * s + 4 * hh;
                        Y[pt] = MFMA32(pa, cat44(*(const LAS u32x2*)xr, *(const LAS u32x2*)(xr + 8)), Y[pt]); } }
                const unsigned cro = (unsigned)(MTK(c0, c32) * 512 + 4 * hh) * 2u;
                const float el = __expf(acl);
#pragma unroll
                for (int nt = 0; nt < 2; ++nt)
#pragma unroll
                    for (int s = 0; s < 2; ++s) { const u32x2 clo = ldg8(xbc + 384 + g * 64 + 32 * nt + 16 * s, cro), chi = ldg8(xbc + 384 + g * 64 + 32 * nt + 16 * s + 8, cro);
                        const bf16x8 ca = mk8(pk2(bflo(clo.x) * el, bfhi(clo.x) * el), pk2(bflo(clo.y) * el, bfhi(clo.y) * el), pk2(bflo(chi.x) * el, bfhi(chi.x) * el), pk2(bflo(chi.y) * el, bfhi(chi.y) * el));
#pragma unroll
                        for (int pt = 0; pt < 2; ++pt) Y[pt] = MFMA32(ca, PACK_STEP(ST[nt][pt], s), Y[pt]); }
#pragma unroll
                for (int i = 0; i < 16; ++i) { const unsigned oo = (unsigned)(MTK(c0, crow(i, hh)) * 256 + c32) * 2u; stg2(MYD, oo, f2bf(Y[0][i])); stg2(MYD + 32, oo, f2bf(Y[1][i])); }
            }
            {
                const float de = __expf(aend);
#pragma unroll
                for (int nt = 0; nt < 2; ++nt)
#pragma unroll
                    for (int pt = 0; pt < 2; ++pt)
#pragma unroll
                        for (int i = 0; i < 16; ++i) ST[nt][pt][i] *= de;
#pragma unroll
                for (int s = 0; s < 2; ++s)
#pragma unroll
                    for (int nt = 0; nt < 2; ++nt) { const bf16x8 ba = *(const LAS bf16x8*)(BT + (32 * nt + c32) * 40 + 16 * s + 8 * hh);
#pragma unroll
                        for (int pt = 0; pt < 2; ++pt) ST[nt][pt] = MFMA32(ba, *(const LAS bf16x8*)(xwT + (32 * pt + c32) * 40 + 16 * s + 8 * hh), ST[nt][pt]); }
            }
            atot += aend;
            LDS_WAIT();
        }
        if (pass == 0) {
            f32x4* sp = (f32x4*)(stsc + (size_t)w * 4096 + lane * 64);
#pragma unroll
            for (int a = 0; a < 2; ++a)
#pragma unroll
                for (int q = 0; q < 2; ++q)
#pragma unroll
                    for (int i4 = 0; i4 < 4; ++i4) sp[(a * 2 + q) * 4 + i4] = (f32x4){ST[a][q][4 * i4], ST[a][q][4 * i4 + 1], ST[a][q][4 * i4 + 2], ST[a][q][4 * i4 + 3]};
            if (lane == 0) Atot[w] = __expf(atot);
            VM_WAIT(); __syncthreads();
        }
    }
#undef MTK
#undef MCH
    __syncthreads();
}

DI void hgrn_unit(const Params& P, int l, int u, LAS unsigned char* lds) {
    const int dir = u & 1, h = (u >> 1) & 3, b = u >> 3;
    const int tid = tid_opaque(), lane_f = tid & 63, w = __builtin_amdgcn_readfirstlane(tid >> 6);
    LAS unsigned char* wl = lds + w * 15104;
    LAS unsigned short* qd = (LAS unsigned short*)wl;
    LAS unsigned short* kd = qd + 32 * 72;
    LAS unsigned short* vT = kd + 32 * 72;
    LAS float* eref = (LAS float*)(wl + 14336);
    LAS float* eglr = eref + 64;
    LAS float* egl = eglr + 64;
    LAS float* lbt = (LAS float*)(lds + 8 * 15104 + 2048 + w * 512);
    LAS float* gsum = lbt + 64;
    LAS float* Atot = (LAS float*)(lds + 8 * 15104);
    unsigned char* ws = P.ws; unsigned char* dsc = (unsigned char*)P.out;
    const bf16_t* proj = (const bf16_t*)(ws + WS_PROJ) + (size_t)b * SEQ * NPROJ;
    bf16_t* OD = (dir ? (bf16_t*)(ws + WS_OB) + (size_t)b * SEQ * 256 + h * 64 : (bf16_t*)(ws + WS_HN) + (size_t)b * SEQ * DM + 768 + h * 64);
    const int ostride = dir ? 256 : DM;
    float* stsc = (float*)(dsc + DO_HST) + (size_t)u * (8 * 4096);
    __syncthreads();
    { float lb = 0.f;
      if (l == 1) { const float h0 = P.hg_lb[(0 * 2 + dir) * 256 + h * 64 + lane_f], h1 = P.hg_lb[(1 * 2 + dir) * 256 + h * 64 + lane_f]; lb = 1.0f / (1.0f + expf(h0 - h1)); }
      lbt[lane_f] = lb; }
    LDS_WAIT();
#define HTK(c0, j) (dir ? (c0) + 31 - (j) : (c0) + (j))
#define HCH(ci) (256 * w + 32 * (dir ? 7 - (ci) : (ci)))
#pragma unroll 1
    for (int pass = 0; pass < 2; ++pass) {
        int lane_p = lane_f; asm volatile("" : "+v"(lane_p));
        const int lane = lane_p, c32 = lane_p & 31, hh = lane_p >> 5, tg = lane_p >> 3, cg = lane_p & 7;
        f32x16 S[2][2];
#pragma unroll
        for (int a = 0; a < 2; ++a)
#pragma unroll
            for (int q = 0; q < 2; ++q)
#pragma unroll
                for (int i = 0; i < 16; ++i) S[a][q][i] = 0.f;
        if (pass == 1) {
            const int nv = dir ? 7 - w : w;
            for (int k = 0; k < nv; ++k) { const int v = dir ? 7 - k : k; const LAS float* at = Atot + v * 64;
                const f32x4* sp = (const f32x4*)(stsc + (size_t)v * 4096 + lane * 64);
#pragma unroll
                for (int a = 0; a < 2; ++a)
#pragma unroll
                    for (int i4 = 0; i4 < 4; ++i4) { const f32x4 dec = *(const LAS f32x4*)(at + 32 * a + 8 * i4 + 4 * hh);
#pragma unroll
                        for (int q = 0; q < 2; ++q) { const f32x4 t = sp[(a * 2 + q) * 4 + i4];
                            S[a][q][4 * i4] = S[a][q][4 * i4] * dec.x + t.x; S[a][q][4 * i4 + 1] = S[a][q][4 * i4 + 1] * dec.y + t.y; S[a][q][4 * i4 + 2] = S[a][q][4 * i4 + 2] * dec.z + t.z; S[a][q][4 * i4 + 3] = S[a][q][4 * i4 + 3] * dec.w + t.w; } } }
        }
        gsum[lane] = 0.f;
        u32x4 rf[4], rq[4];
        { const int c0 = HCH(0);
#pragma unroll
          for (int i = 0; i < 4; ++i) { const unsigned ro = (unsigned)(HTK(c0, 4 * tg + i) * NPROJ + 8 * cg) * 2u;
              rf[i] = ldg16(proj + PC_HF + dir * 256 + h * 64, ro); rq[i] = (pass == 1) ? ldg16(proj + PC_HQ + h * 64, ro) : (u32x4){0u, 0u, 0u, 0u}; } }
#pragma unroll 1
        for (int ci = 0; ci < 8; ++ci) {
            int lane_i = lane; asm volatile("" : "+v"(lane_i));
            const int c32 = lane_i & 31, hh = lane_i >> 5, tg = lane_i >> 3, cg = lane_i & 7;
            const int c0 = HCH(ci);
            {
                float qprev[4], kprev[4];
                u32x4 rv[4];
#pragma unroll
                for (int i = 0; i < 4; ++i) { const unsigned ro = (unsigned)(HTK(c0, 4 * tg + i) * NPROJ + 8 * cg) * 2u; rv[i] = ldg16(proj + PC_HI + h * 64, ro); }
                const f32x4 lb0 = *(const LAS f32x4*)(lbt + 8 * cg), lb1 = *(const LAS f32x4*)(lbt + 8 * cg + 4);
                const float lbv[8] = {lb0.x, lb0.y, lb0.z, lb0.w, lb1.x, lb1.y, lb1.z, lb1.w};
#pragma unroll
                for (int c = 0; c < 8; ++c) {
                    const float lb = lbv[c], oml = 1.0f - lb;
                    float gcl[4], kr[4];
#pragma unroll
                    for (int i = 0; i < 4; ++i) { const float fpre = bf2f(hsel(rf[i], c)); const float en = __expf(-fpre), sg = 1.0f / (1.0f + en);
                        const float gg = __logf(lb + oml * sg); gcl[i] = (i == 0) ? gg : gcl[i - 1] + gg; kr[i] = oml * en * sg; }
                    float incl = gcl[3];
#pragma unroll
                    for (int o = 8; o < 64; o <<= 1) { const float t = __shfl_up(incl, o); if (lane >= o) incl += t; }
                    const float excl = incl - gcl[3];
                    const float ref = __shfl(incl, 24 + cg), glast = __shfl(incl, 56 + cg);
                    if (tg == 0) { eref[8 * cg + c] = __expf(ref); eglr[8 * cg + c] = __expf(glast - ref); egl[8 * cg + c] = __expf(glast); gsum[8 * cg + c] += glast; }
                    float kv[4], qv[4];
#pragma unroll
                    for (int i = 0; i < 4; ++i) { const float dlt = excl + gcl[i] - ref; kv[i] = kr[i] * __expf(-dlt);
                        if (pass == 1) { const float qr = bf2f(hsel(rq[i], c)); qv[i] = qr / (1.0f + __expf(-qr)) * __expf(dlt); } else qv[i] = 0.f; }
                    if (c & 1) {
#pragma unroll
                        for (int i = 0; i < 4; ++i) { *(LAS unsigned*)(kd + (4 * tg + i) * 72 + 8 * cg + c - 1) = pk2(kprev[i], kv[i]);
                            if (pass == 1) *(LAS unsigned*)(qd + (4 * tg + i) * 72 + 8 * cg + c - 1) = pk2(qprev[i], qv[i]); }
                    } else {
#pragma unroll
                        for (int i = 0; i < 4; ++i) { kprev[i] = kv[i]; qprev[i] = qv[i]; }
                    }
                    __builtin_amdgcn_sched_barrier(0);
                }
#pragma unroll
                for (int c = 0; c < 8; ++c) { unsigned short vb[4];
#pragma unroll
                    for (int i = 0; i < 4; ++i) vb[i] = hsel(rv[i], c);
                    *(LAS u32x2*)(vT + (8 * cg + c) * 40 + 4 * tg) = (u32x2){(unsigned)vb[0] | ((unsigned)vb[1] << 16), (unsigned)vb[2] | ((unsigned)vb[3] << 16)}; }
            }
            if (ci < 7) { const int c1 = HCH(ci + 1);
#pragma unroll
                for (int i = 0; i < 4; ++i) { const unsigned ro = (unsigned)(HTK(c1, 4 * tg + i) * NPROJ + 8 * cg) * 2u;
                    rf[i] = ldg16(proj + PC_HF + dir * 256 + h * 64, ro); if (pass == 1) rq[i] = ldg16(proj + PC_HQ + h * 64, ro); } }
            LDS_WAIT(); __builtin_amdgcn_sched_barrier(0);
            bf16x8 vperm[2][2];
#pragma unroll
            for (int s = 0; s < 2; ++s)
#pragma unroll
                for (int pt = 0; pt < 2; ++pt) { const LAS unsigned short* vr = vT + (32 * pt + c32) * 40 + 16 * s + 4 * hh; vperm[s][pt] = cat44(*(const LAS u32x2*)vr, *(const LAS u32x2*)(vr + 8)); }
            if (pass == 1) {
                f32x16 SC;
#pragma unroll
                for (int i = 0; i < 16; ++i) SC[i] = 0.f;
#pragma unroll
                for (int ks = 0; ks < 4; ++ks) SC = MFMA32(*(const LAS bf16x8*)(kd + c32 * 72 + 16 * ks + 8 * hh), *(const LAS bf16x8*)(qd + c32 * 72 + 16 * ks + 8 * hh), SC);
#pragma unroll
                for (int i = 0; i < 16; ++i) SC[i] = (crow(i, hh) <= c32) ? SC[i] : 0.f;
                const bf16x8 pa0 = PACK_STEP(SC, 0), pa1 = PACK_STEP(SC, 1);
                bf16x8 qa[2][2];
#pragma unroll
                for (int et = 0; et < 2; ++et)
#pragma unroll
                    for (int s = 0; s < 2; ++s) { const LAS unsigned short* qr = qd + c32 * 72 + 32 * et + 16 * s + 4 * hh; qa[et][s] = cat44(*(const LAS u32x2*)qr, *(const LAS u32x2*)(qr + 8)); }
#pragma unroll
                for (int pt = 0; pt < 2; ++pt) {
                    f32x16 O;
#pragma unroll
                    for (int i = 0; i < 16; ++i) O[i] = 0.f;
                    O = MFMA32(pa0, vperm[0][pt], O); O = MFMA32(pa1, vperm[1][pt], O);
#pragma unroll
                    for (int et = 0; et < 2; ++et)
#pragma unroll
                        for (int s = 0; s < 2; ++s) { const f32x4 e0 = *(const LAS f32x4*)(eref + 32 * et + 16 * s + 4 * hh), e1 = *(const LAS f32x4*)(eref + 32 * et + 16 * s + 8 + 4 * hh);
                            const f32x16& sv = S[et][pt];
                            const bf16x8 sb = mk8(pk2(sv[8 * s] * e0.x, sv[8 * s + 1] * e0.y), pk2(sv[8 * s + 2] * e0.z, sv[8 * s + 3] * e0.w), pk2(sv[8 * s + 4] * e1.x, sv[8 * s + 5] * e1.y), pk2(sv[8 * s + 6] * e1.z, sv[8 * s + 7] * e1.w));
                            O = MFMA32(qa[et][s], sb, O); }
#pragma unroll
                    for (int i = 0; i < 16; ++i) { const unsigned oo = (unsigned)(HTK(c0, crow(i, hh)) * ostride + c32) * 2u; stg2(OD + 32 * pt, oo, f2bf(O[i])); }
                    __builtin_amdgcn_sched_barrier(0);
                }
            }
            __builtin_amdgcn_sched_barrier(0);
            {
#pragma unroll
                for (int et = 0; et < 2; ++et) {
                    f32x16 X;
#pragma unroll
                    for (int i = 0; i < 16; ++i) X[i] = 0.f;
#pragma unroll
                    for (int s = 0; s < 2; ++s) { unsigned idw[4];
#pragma unroll
                        for (int j = 0; j < 4; ++j) { const int k0 = 16 * s + 8 * hh + 2 * j; idw[j] = (k0 == c32 ? 0x3f80u : 0u) | (k0 + 1 == c32 ? 0x3f800000u : 0u); }
                        X = MFMA32(*(const LAS bf16x8*)(kd + c32 * 72 + 32 * et + 16 * s + 8 * hh), mk8(idw[0], idw[1], idw[2], idw[3]), X); }
                    const float sc = eglr[32 * et + c32];
#pragma unroll
                    for (int i = 0; i < 16; ++i) X[i] *= sc;
                    float dg[16];
#pragma unroll
                    for (int i = 0; i < 16; ++i) dg[i] = egl[32 * et + crow(i, hh)];
#pragma unroll
                    for (int pt = 0; pt < 2; ++pt) {
#pragma unroll
                        for (int i = 0; i < 16; ++i) S[et][pt][i] *= dg[i];
#pragma unroll
                        for (int s = 0; s < 2; ++s) S[et][pt] = MFMA32(PACK_STEP(X, s), vperm[s][pt], S[et][pt]); }
                }
            }
            LDS_WAIT();
        }
        if (pass == 0) {
            f32x4* sp = (f32x4*)(stsc + (size_t)w * 4096 + lane * 64);
#pragma unroll
            for (int a = 0; a < 2; ++a)
#pragma unroll
                for (int q = 0; q < 2; ++q)
#pragma unroll
                    for (int i4 = 0; i4 < 4; ++i4) sp[(a * 2 + q) * 4 + i4] = (f32x4){S[a][q][4 * i4], S[a][q][4 * i4 + 1], S[a][q][4 * i4 + 2], S[a][q][4 * i4 + 3]};
            LDS_WAIT(); Atot[w * 64 + lane] = __expf(gsum[lane]);
            VM_WAIT(); __syncthreads();
        }
    }
#undef HTK
#undef HCH
    __syncthreads();
}

DI void phase_mixers(const Params& P, int l, LAS unsigned char* lds) {
    const int G = gridDim.x, bid = blockIdx.x;
#ifndef REP_PHASE
#define REP_PHASE -1
#endif
#define MREPS(k) _Pragma("unroll 1") for (int _r = 0; _r < ((REP_PHASE == (k)) ? 2 : 1); ++_r)
    if (EN_HY) MREPS(30) for (int c = bid; c < 256; c += G) hyena_unit(P, c, lds);
    if (EN_AT) MREPS(31) {
        if ((G & 7) == 0) { const int xcd = bid & 7, j = bid >> 3, per = G >> 3;
            for (int base = 0; base < NB * 4 * 8; base += G) { const int u = base + xcd * per + j; if (u < NB * 4 * 8) attn_unit(P, u, lds); } }
        else for (int u = bid; u < NB * 4 * 8; u += G) attn_unit(P, u, lds); }
    if (EN_MA) MREPS(32) for (int u = bid; u < 256; u += G) mamba_unit(P, l, u, lds);
    if (EN_HG) MREPS(33) for (int u = bid; u < 256; u += G) hgrn_unit(P, l, u, lds);
}

constexpr int N_PHASES = 21;
#ifndef REP_PHASE
#define REP_PHASE -1
#endif
#define REPS(k) for (int _rep = 0, _nrep = ((REP_PHASE == (k)) && ((k) != 0 && (k) != 5 || l == 0)) ? 2 : 1; _rep < _nrep; ++_rep)
__global__ void __launch_bounds__(512, 2) fwd_kernel(Params P) {
    extern __shared__ __attribute__((aligned(16))) unsigned char lds_raw[];
    LAS unsigned char* lds = (LAS unsigned char*)lds_raw;
    volatile LAS unsigned* MISC = (volatile LAS unsigned*)(lds + LDS_MISC);
    if (threadIdx.x < 64) MISC[threadIdx.x] = 0u;
    __syncthreads();
    unsigned char* ws = P.ws;
    const int lo = P.ph_lo, hi = P.ph_hi;
    XcdBarrier bar; bar.bar = (unsigned*)(ws + WS_CTL) + CW_BAR; bar.x = 0; bar.st = nullptr;
    if (hi - lo > 1) bar = xcd_barrier_post((unsigned*)(ws + WS_CTL) + CW_BAR, MISC + 8);
#define IN(k) (lo <= (k) && (k) < hi)
#define SEAM(k) do { if (IN(k) && IN((k) + 1)) xcd_barrier(bar); } while (0)
    const int G = gridDim.x, bid = blockIdx.x;
#pragma unroll 1
    for (int l = 0; l < 2; ++l) {
        const int p0 = 10 * l;
        if (IN(p0 + 0)) { _Pragma("unroll 1") REPS(0) phase_pre(P, l, lds); }
        SEAM(p0 + 0);
        if (IN(p0 + 1)) { _Pragma("unroll 1") REPS(1) {
            pg8::StaticOrder S; S.init(NTOK / 256, NPROJ / 256, G, bid); AddrPlain AD{DM, 0}; EpiProj E{(bf16_t*)(ws + WS_PROJ)};
            pg8::gemm_phase(lds, (const char*)(ws + WS_HN), (const char*)(ws + WS_WIN), DM, S, AD, E);
        } }
        SEAM(p0 + 1);
        if (IN(p0 + 2)) { _Pragma("unroll 1") REPS(2) phase_premix(P, l); }
        SEAM(p0 + 2);
        if (IN(p0 + 3)) { _Pragma("unroll 1") REPS(3) phase_mixers(P, l, lds); }
        SEAM(p0 + 3);
        if (IN(p0 + 4)) { _Pragma("unroll 1") REPS(4) phase_finalize(P, l); }
        SEAM(p0 + 4);
        if (IN(p0 + 5)) { _Pragma("unroll 1") REPS(5) {
            pg8::StaticOrder S; S.init(NTOK / 256, DM / 256, G, bid); AddrPlain AD{DM, 0}; EpiRes E{l == 0 ? P.x : (const float*)(ws + WS_XB), (float*)(ws + WS_XB)};
            pg8::gemm_phase(lds, (const char*)(ws + WS_HN), (const char*)(ws + WS_WOUT), DM, S, AD, E);
        } }
        SEAM(p0 + 5);
        if (IN(p0 + 6)) { if (EN_MOE) { _Pragma("unroll 1") REPS(6) phase_ffnpre(P, l, lds); } }
        SEAM(p0 + 6);
        if (IN(p0 + 7)) { if (EN_MOE) { _Pragma("unroll 1") REPS(7) phase_topk(P, l, lds); } }
        SEAM(p0 + 7);
        if (IN(p0 + 8)) { if (EN_MOE) _Pragma("unroll 1") REPS(8) {
            pg8::StaticOrder S; S.init(NSLOT / 256, 2048 / 256, G, bid); AddrGateUp AD{(const int*)(ws + WS_SELI)}; EpiGateUp E{(bf16_t*)((unsigned char*)P.out + DO_HDN), (const float*)(ws + WS_SELR)};
            pg8::gemm_phase(lds, (const char*)(ws + WS_HN), (const char*)(ws + WS_WGU), DM, S, AD, E); } }
        SEAM(p0 + 8);
        if (IN(p0 + 9)) { if (EN_MOE) _Pragma("unroll 1") REPS(9) {
            pg8::StaticOrder S; S.init(NSLOT / 256, DM / 256, G, bid); AddrDown AD{}; EpiDown E{(bf16_t*)(ws + WS_YE), (const float*)(ws + WS_SELG)};
            pg8::gemm_phase(lds, (const char*)P.out + DO_HDN, (const char*)(ws + WS_WD), DM, S, AD, E); } }
        SEAM(p0 + 9);
    }
#ifdef PROBE_BARS
    if (hi - lo > 1) for (int i = 0; i < PROBE_BARS; ++i) xcd_barrier(bar);
#endif
    if (IN(20)) phase_final(P);
#undef IN
#undef SEAM
}

#ifndef N_LAUNCH_MODE
#define N_LAUNCH_MODE 1
#endif
extern "C" void kernel_launch(void* const* d_in, const int* in_sizes, int n_in, void* d_out, int out_size, void* d_ws, size_t ws_size, hipStream_t stream) {
    static int grid = 0;
    if (grid == 0) {
        if (n_in != 27 || in_sizes[0] != NTOK * DM || out_size != NTOK * DM || ws_size < WS_END) {
            fprintf(stderr, "kernel_launch: unexpected shapes (n_in %d, in0 %d, out %d, ws %zu, need %zu)\n", n_in, n_in > 0 ? in_sizes[0] : -1, out_size, ws_size, (size_t)WS_END); grid = -1; return; }
        int dev = 0, cus = 0, per_cu = 0;
        if (hipGetDevice(&dev) != hipSuccess || hipDeviceGetAttribute(&cus, hipDeviceAttributeMultiprocessorCount, dev) != hipSuccess) { grid = -1; return; }
        if (hipFuncSetAttribute((const void*)fwd_kernel, hipFuncAttributeMaxDynamicSharedMemorySize, LDS_BYTES) != hipSuccess) { fprintf(stderr, "kernel_launch: hipFuncSetAttribute failed\n"); grid = -1; return; }
        if (hipOccupancyMaxActiveBlocksPerMultiprocessor(&per_cu, (const void*)fwd_kernel, 512, LDS_BYTES) != hipSuccess || per_cu < 1) { fprintf(stderr, "kernel_launch: occupancy query says %d\n", per_cu); (void)hipGetLastError(); }
        grid = cus;
    }
    if (grid < 0) return;
    if (hipMemsetAsync((char*)d_ws + WS_CTL, 0, CTL_ZERO_BYTES, stream) != hipSuccess) return;
    Params p{};
    const float** pp = (const float**)&p;
    for (int i = 0; i < 27; ++i) pp[i] = (const float*)d_in[i];
    p.out = (float*)d_out; p.ws = (unsigned char*)d_ws;
    if (N_LAUNCH_MODE == 1) { p.ph_lo = 0; p.ph_hi = N_PHASES; hipLaunchKernelGGL(fwd_kernel, dim3(grid), dim3(512), LDS_BYTES, stream, p); }
    else for (int k = 0; k < N_PHASES; ++k) { p.ph_lo = k; p.ph_hi = k + 1; hipLaunchKernelGGL(fwd_kernel, dim3(grid), dim3(512), LDS_BYTES, stream, p); }
}
```

```cpp
#define N_LAUNCH_MODE 1
#include <hip/hip_runtime.h>
#include <cstdio>
#include <cstdint>

#define LAS __attribute__((address_space(3)))
#define DI __device__ __forceinline__
typedef unsigned short bf16_t;
typedef short bf16x8 __attribute__((ext_vector_type(8)));
typedef short s16x4 __attribute__((ext_vector_type(4)));
typedef float f32x2 __attribute__((ext_vector_type(2)));
typedef float f32x4 __attribute__((ext_vector_type(4)));
typedef float f32x16 __attribute__((ext_vector_type(16)));
typedef unsigned u32x2 __attribute__((ext_vector_type(2)));
typedef unsigned u32x4 __attribute__((ext_vector_type(4)));
typedef int i32x4 __attribute__((ext_vector_type(4)));
typedef __bf16 bfv2 __attribute__((ext_vector_type(2)));

DI unsigned pk2(float lo, float hi) { f32x2 v = {lo, hi}; return __builtin_bit_cast(unsigned, __builtin_convertvector(v, bfv2)); }
DI unsigned short f2bf(float f) { return (unsigned short)(pk2(f, 0.f) & 0xffffu); }
DI float bf2f(unsigned short b) { return __uint_as_float((unsigned)b << 16); }
DI float bflo(unsigned u) { return __uint_as_float(u << 16); }
DI float bfhi(unsigned u) { return __uint_as_float(u & 0xffff0000u); }
DI unsigned pk4_fp8(float a, float b, float c, float d) {
    a = fminf(fmaxf(a, -440.f), 440.f); b = fminf(fmaxf(b, -440.f), 440.f); c = fminf(fmaxf(c, -440.f), 440.f); d = fminf(fmaxf(d, -440.f), 440.f);
    int v = 0; v = __builtin_amdgcn_cvt_pk_fp8_f32(a, b, v, false); v = __builtin_amdgcn_cvt_pk_fp8_f32(c, d, v, true); return (unsigned)v; }
DI int lane_now() { int ln; asm volatile("v_mbcnt_lo_u32_b32 %0, -1, 0\n\tv_mbcnt_hi_u32_b32 %0, -1, %0" : "=v"(ln)); return ln; }
template <class T> DI T bperm_(int idx4, T v) { return __builtin_bit_cast(T, __builtin_amdgcn_ds_bpermute(idx4, __builtin_bit_cast(int, v))); }
template <class T> DI T shfl_xor_l(T v, int m, int self) { return bperm_(((self ^ m) & 63) << 2, v); }
template <class T> DI T shfl_up_l(T v, int o, int self, int width = 64) { int idx = self - o; if (idx < (self & ~(width - 1))) idx = self; return bperm_(idx << 2, v); }
template <class T> DI T shfl_xor_(T v, int m) { return shfl_xor_l(v, m, lane_now()); }
template <class T> DI T shfl_up_(T v, int o, int width = 64) { return shfl_up_l(v, o, lane_now(), width); }
template <class T> DI T shfl_(T v, int src) { return bperm_((src & 63) << 2, v); }
#ifndef HIP_SHFL
#define __shfl_xor shfl_xor_
#define __shfl_up shfl_up_
#define __shfl shfl_
#endif
DI float wave_sum(float v) {
#pragma unroll
    for (int o = 1; o < 64; o <<= 1) v += __shfl_xor(v, o);
    return v;
}
DI float silu_f(float x) { return x * __builtin_amdgcn_rcpf(1.0f + __expf(-x)); }
DI float sigmoid_f(float x) { return __builtin_amdgcn_rcpf(1.0f + __expf(-x)); }
#ifdef OLD_TID
DI int tid_opaque(int wv) { int t = wv * 64 + (int)__builtin_amdgcn_mbcnt_hi(~0u, __builtin_amdgcn_mbcnt_lo(~0u, 0u)); asm volatile("" : "+v"(t)); return t; }
#else
DI int tid_opaque(int wv) { int ln; asm volatile("v_mbcnt_lo_u32_b32 %0, -1, 0\n\tv_mbcnt_hi_u32_b32 %0, -1, %0" : "=v"(ln) :: "memory"); return wv * 64 + ln; }
#endif
DI float xhalf_max(float x) { const auto r = __builtin_amdgcn_permlane32_swap(__float_as_uint(x), __float_as_uint(x), false, false); return fmaxf(__uint_as_float(r[0]), __uint_as_float(r[1])); }
DI float xhalf_sum(float x) { const auto r = __builtin_amdgcn_permlane32_swap(__float_as_uint(x), __float_as_uint(x), false, false); return __uint_as_float(r[0]) + __uint_as_float(r[1]); }
DI bf16x8 mk8u(unsigned a, unsigned b, unsigned c, unsigned d) { u32x4 v = {a, b, c, d}; return __builtin_bit_cast(bf16x8, v); }
#define LDS_WAIT() asm volatile("s_waitcnt lgkmcnt(0)" ::: "memory")
#define VM_WAIT() asm volatile("s_waitcnt vmcnt(0)" ::: "memory")
#define MFMA32(a, b, c) __builtin_amdgcn_mfma_f32_32x32x16_bf16((a), (b), (c), 0, 0, 0)

constexpr int NB = 32, SEQ = 2048, DM = 1024, NTOK = NB * SEQ;
constexpr int NIN_REF = 3592, NPROJ = 3584;
constexpr int PC_HY = 0, PC_MZ = 768, PC_MX = 1024, PC_AQ = 1536, PC_AK = 1792, PC_AV = 2048, PC_HQ = 2304, PC_HF = 2560, PC_HI = 3072, PC_HG = 3328;
constexpr int NEXP = 16, CAP = 256, NSLOT = NB * NEXP * CAP;
constexpr float EPSN = 1e-6f;

constexpr size_t MiB = 1u << 20;
constexpr size_t WS_CTL = 0, CTL_ZERO_BYTES = 64 * 1024;
constexpr size_t WS_DT = 1 * MiB, WS_AFF = 3 * MiB, WS_SLOT = 7 * MiB, WS_SELI = 11 * MiB, WS_SELG = 11 * MiB + 512 * 1024, WS_KFILT = 12 * MiB, WS_MSQ = 14 * MiB, WS_RS = 15 * MiB, WS_SELR = 15 * MiB + 512 * 1024;
constexpr size_t WS_XB = 64 * MiB, WS_WIN = 320 * MiB, WS_WOUT = 327 * MiB, WS_WGU = 329 * MiB, WS_WD = 393 * MiB, WS_HN = 432 * MiB, WS_PROJ = 560 * MiB, WS_YE = WS_PROJ, WS_END = 1008 * MiB, WS_MYB = WS_WGU, WS_OB = WS_WGU + 32 * MiB;
constexpr size_t DO_HW = 0, DO_HX0 = 32 * MiB, DO_YAT = 64 * MiB, DO_MXBC = 96 * MiB, DO_MY = 160 * MiB, DO_MST = 192 * MiB, DO_HST = 224 * MiB, DO_HDN = 0;
constexpr int CW_BAR = 1024;

constexpr int LDS_MISC = 163840 - 256, LDS_BYTES = 163840;

struct Params {
    const float *x, *w_in, *w_out, *norm_mix_w, *norm_ffn_w, *hy_conv_w, *hy_w1, *hy_b1, *hy_w2, *hy_b2, *hy_freq, *hy_w3, *hy_fbias,
                *m_conv_w, *m_conv_b, *m_dt_bias, *m_A_log, *m_D, *m_norm_w, *rel_bias, *hg_lb, *hg_norm_w, *router_w, *moe_wg, *moe_wu, *moe_wd, *final_w;
    float* out; unsigned char* ws;
    int ph_lo, ph_hi, wv, pad;
};

#define XB_TMO      128
#define XB_XCNT(j)  (256  + 64 * (j))
#define XB_XSUB(j)  (1280 + 64 * (j))
#define XB_XGEN(j)  (2304 + 64 * (j))
#define XB_TOP      3328
#define XB_TOPGEN   3392
#define XCD_BAR_WORDS 3456
#define XB_SPIN_CAP (1u << 18)
__device__ __forceinline__ unsigned xb_ld(unsigned* p)              { return __hip_atomic_load(p, __ATOMIC_RELAXED, __HIP_MEMORY_SCOPE_AGENT); }
__device__ __forceinline__ unsigned xb_add(unsigned* p, unsigned v) { return __hip_atomic_fetch_add(p, v, __ATOMIC_RELAXED, __HIP_MEMORY_SCOPE_AGENT); }
__device__ __forceinline__ unsigned xb_xcc_id() { return (unsigned)__builtin_amdgcn_s_getreg((3 << 11) | 20) & 0xFu; }
#define XB_SPIN(cond, bar) do { unsigned _sp = 0; while (cond) { __builtin_amdgcn_s_sleep(1); \
    if ((++_sp & 255u) == 0u) { if (xb_ld(&(bar)[XB_TMO])) break; if (_sp > XB_SPIN_CAP) { atomicAdd(&(bar)[XB_TMO], 1u); break; } } } } while (0)
struct XcdBarrier { unsigned* bar; unsigned x; volatile LAS unsigned* st; };
__device__ __forceinline__ XcdBarrier xcd_barrier_post(unsigned* bar, volatile LAS unsigned* st) {
    XcdBarrier b; b.bar = bar; b.x = xb_xcc_id(); b.st = st;
    if (threadIdx.x == 0) (void)xb_add(&bar[XB_XCNT(b.x)], 1u);
    return b;
}
__device__ __forceinline__ void xcd_barrier_complete(unsigned* bar, unsigned x, unsigned& nloc, unsigned& nx) {
    const unsigned G = gridDim.x * gridDim.y * gridDim.z;
    unsigned sum, cnt, mine, sp = 0u;
    for (;;) {
        sum = 0u; cnt = 0u; mine = 0u;
#pragma unroll
        for (unsigned j = 0; j < 16; ++j) { const unsigned c = xb_ld(&bar[XB_XCNT(j)]); sum += c; cnt += (c > 0u) ? 1u : 0u; mine = (j == x) ? c : mine; }
        if (sum == G) break;
        __builtin_amdgcn_s_sleep(1);
        if ((++sp & 255u) == 0u) { if (xb_ld(&bar[XB_TMO])) break; if (sp > XB_SPIN_CAP) { atomicAdd(&bar[XB_TMO], 1u); break; } }
    }
    nloc = mine > 0u ? mine : 1u; nx = cnt > 0u ? cnt : 1u;
}
__device__ __forceinline__ void xcd_barrier(const XcdBarrier& b) {
    asm volatile("s_waitcnt vmcnt(0)" ::: "memory");
    __syncthreads();
    if (threadIdx.x == 0) {
        unsigned* bar = b.bar; asm volatile("" : "+s"(bar));
        __builtin_amdgcn_s_waitcnt(0);
        unsigned nloc = b.st[0], nx = b.st[1];
        if (nloc == 0u) { xcd_barrier_complete(bar, b.x, nloc, nx); b.st[0] = nloc; b.st[1] = nx; }
        const unsigned old = xb_add(&bar[XB_XSUB(b.x)], 1u);
        const unsigned gen = old / nloc;
        if (old + 1u == (gen + 1u) * nloc) {
            __builtin_amdgcn_fence(__ATOMIC_RELEASE, "agent");
            asm volatile("s_waitcnt vmcnt(0)" ::: "memory");
            const unsigned og = xb_add(&bar[XB_TOP], 1u);
            const unsigned tg = og / nx;
            if (og + 1u == (tg + 1u) * nx) xb_add(&bar[XB_TOPGEN], 1u);
            else XB_SPIN(xb_ld(&bar[XB_TOPGEN]) == tg, bar);
            __builtin_amdgcn_fence(__ATOMIC_ACQUIRE, "agent");
            xb_add(&bar[XB_XGEN(b.x)], 1u);
            asm volatile("s_waitcnt vmcnt(0)" ::: "memory");
        } else {
            XB_SPIN(xb_ld(&bar[XB_XGEN(b.x)]) == gen, bar);
            __builtin_amdgcn_fence(__ATOMIC_ACQUIRE, "agent");
            asm volatile("s_waitcnt vmcnt(0)" ::: "memory");
        }
    }
    __syncthreads();
}

namespace pg8 {
constexpr int BM = 256, BK = 64, HALF = 128, HTB = HALF * BK * 2, STAGE_BYTES = 8 * HTB, NXCD = 8, WGM = 8;
__host__ __device__ __forceinline__ int lds_byte(int r, int c) { const int st = (r >> 4) * 2 + (c >> 5), rr = r & 15, cc = c & 31, ob = rr * 64 + cc * 2; return st * 1024 + (ob ^ (((ob >> 9) & 1) << 5)); }
__host__ __device__ __forceinline__ void stage_rc(int b, int& R, int& C) { const int st = b / 1024, sb = b % 1024, swz = sb ^ (((sb >> 9) & 1) << 5); R = (st >> 1) * 16 + swz / 64; C = (st & 1) * 32 + (swz % 64) / 2; }
__host__ __device__ __forceinline__ int perm32(int rho) { const int n = rho >> 4, i = rho & 15; return 8 * (i >> 2) + 4 * n + (i & 3); }
struct Unit { int pm, pn; };
typedef int i32x8 __attribute__((ext_vector_type(8)));
typedef int i32x32 __attribute__((ext_vector_type(32)));
#define INS4(V, P, X) do { const i32x4 _x = (X); (V)[(P)] = _x.x; (V)[(P) + 1] = _x.y; (V)[(P) + 2] = _x.z; (V)[(P) + 3] = _x.w; } while (0)
#define EXT8(V, P) ((i32x8){(V)[(P)], (V)[(P) + 1], (V)[(P) + 2], (V)[(P) + 3], (V)[(P) + 4], (V)[(P) + 5], (V)[(P) + 6], (V)[(P) + 7]})
DI i32x8 cat88(bf16x8 lo, bf16x8 hi) { const i32x4 a = __builtin_bit_cast(i32x4, lo), b = __builtin_bit_cast(i32x4, hi); return (i32x8){a.x, a.y, a.z, a.w, b.x, b.y, b.z, b.w}; }
struct StaticOrder {
    int nM, nN, nwg, G, c;
    __device__ void init(int nM_, int nN_, int G_, int c_) { nM = nM_; nN = nN_; nwg = nM * nN; G = G_; c = c_; }
    __device__ bool next(int i, Unit& u) const {
        const long L = (long)i * G + c; if (L >= nwg) return false;
        int wgid = (int)L; { const int q = nwg / NXCD, r = nwg % NXCD, xcd = wgid % NXCD, off = wgid / NXCD; wgid = (xcd < r ? xcd * (q + 1) : r * (q + 1) + (xcd - r) * q) + off; }
        const int nig = WGM * nN, gid = wgid / nig, fm = gid * WGM, gsz = (nM - fm) < WGM ? (nM - fm) : WGM;
        u.pm = fm + ((wgid % nig) % gsz); u.pn = (wgid % nig) / gsz; return true;
    }
};
#ifndef TPROBE
#define TPROBE 0
#endif
#ifndef TPGEMM
#define TPGEMM 0
#endif
#define GP_T() ({ asm volatile("" ::: "memory"); unsigned _t = (unsigned)__builtin_amdgcn_s_memrealtime(); asm volatile("" ::: "memory"); _t; })
#define GP_ON(k) (TPROBE == (k) && Epi::PID == TPGEMM)
template <class Epi, class Sched, class Addr, bool F8 = false>
__device__ __forceinline__ void gemm_phase(LAS unsigned char* lds, const char* Abase, const char* Bbase, int K, const Sched& S, const Addr& AD, const Epi& E, int wv, unsigned* lds_ws_ctl = nullptr) {
    const int tid = tid_opaque(wv), wid = __builtin_amdgcn_readfirstlane(tid >> 6), lane = tid & 63, wr = wid >> 2, wc = wid & 3, fr = lane & 15, fq = lane >> 4;
    unsigned gp_acc = 0, gp_tot = 0, gp_t0 = 0, gp_t1 = 0; if (TPROBE >= 40 && TPROBE < 50 && Epi::PID == TPGEMM) gp_t0 = GP_T();
    const int KB = F8 ? K : 2 * K;
    const int nt = KB / 128;
    int Rr[2]; unsigned Cc[2], voffB[2], voffA[2];
#pragma unroll
    for (int i = 0; i < 2; ++i) { int R, C; stage_rc(tid * 16 + i * 8192, R, C); const int Rb = Epi::PERM ? ((R & ~31) + perm32(R & 31)) : R;
        Rr[i] = R; Cc[i] = (unsigned)C * 2u; voffA[i] = (unsigned)(R * KB + C * 2); voffB[i] = (unsigned)(Rb * KB + C * 2); }
    const size_t kstep = (size_t)(BK * 2);
    const size_t hstep = (size_t)HALF * KB;
    const unsigned ldsw = (unsigned)wid * 1024u;
    const int aoff = F8 ? lds_byte(wr * 64 + fr, fq * 16) : lds_byte(wr * 64 + fr, fq * 8), boff = F8 ? lds_byte(wc * 32 + fr, fq * 16) : lds_byte(wc * 32 + fr, fq * 8);
    const int aoff1 = F8 ? lds_byte(wr * 64 + fr, fq * 16 + 8) : aoff + 1024, boff1 = F8 ? lds_byte(wc * 32 + fr, fq * 16 + 8) : boff + 1024;
#define PG8_SA(b, h) (((b) * 2 + (h)) * HTB)
#define PG8_SB(b, h) ((4 + (b) * 2 + (h)) * HTB)
#define PG8_STAGE(bufoff, gbase, voff) do { _Pragma("unroll") for (int _i = 0; _i < 2; ++_i) \
        __builtin_amdgcn_global_load_lds((const unsigned*)((const char*)(gbase) + (voff)[_i]), (LAS unsigned*)(lds + (bufoff) + ldsw + _i * 8192), 16, 0, 0); } while (0)
#define PG8_STAGE_A(bufoff, kb, h, un) do { if constexpr (Addr::LOADS) { _Pragma("unroll") for (int _i = 0; _i < 2; ++_i) \
        __builtin_amdgcn_global_load_lds((const unsigned*)(Abase + (kb) + ((un) ? on[h][_i] : oc[h][_i])), (LAS unsigned*)(lds + (bufoff) + ldsw + _i * 8192), 16, 0, 0); } \
      else { const char* _ab = ((un) ? nA : cA) + (kb) + (size_t)(h) * hstep; _Pragma("unroll") for (int _i = 0; _i < 2; ++_i) \
        __builtin_amdgcn_global_load_lds((const unsigned*)(_ab + voffA[_i]), (LAS unsigned*)(lds + (bufoff) + ldsw + _i * 8192), 16, 0, 0); } } while (0)
#define PG8_BSEL_B0 0
#define PG8_BSEL_B1 16
#define PG8_LDA(dst, b, h) do { if constexpr (F8) { _Pragma("unroll") for (int m = 0; m < 4; ++m) { INS4(AA, 8 * m, *(const LAS i32x4*)(lds + PG8_SA(b, h) + aoff + m * 2048)); INS4(AA, 8 * m + 4, *(const LAS i32x4*)(lds + PG8_SA(b, h) + aoff + 16 + m * 2048)); } } \
      else { _Pragma("unroll") for (int m = 0; m < 4; ++m) _Pragma("unroll") for (int k = 0; k < 2; ++k) dst[m][k] = *(const LAS bf16x8*)(lds + PG8_SA(b, h) + (k ? aoff1 : aoff) + m * 2048); } } while (0)
#define PG8_LDB(dst, b, h) do { if constexpr (F8) { _Pragma("unroll") for (int n = 0; n < 2; ++n) { INS4(BB, PG8_BSEL_##dst + 8 * n, *(const LAS i32x4*)(lds + PG8_SB(b, h) + boff + n * 2048)); INS4(BB, PG8_BSEL_##dst + 8 * n + 4, *(const LAS i32x4*)(lds + PG8_SB(b, h) + boff + 16 + n * 2048)); } } \
      else { _Pragma("unroll") for (int n = 0; n < 2; ++n) _Pragma("unroll") for (int k = 0; k < 2; ++k) dst[n][k] = *(const LAS bf16x8*)(lds + PG8_SB(b, h) + (k ? boff1 : boff) + n * 2048); } } while (0)
#define PG8_MMA(ai, bj, At, Bt) do { __builtin_amdgcn_s_setprio(1); if constexpr (F8) { _Pragma("unroll") for (int m = 0; m < 4; ++m) _Pragma("unroll") for (int n = 0; n < 2; ++n) \
        { const i32x8 _b8 = EXT8(BB, PG8_BSEL_##Bt + 8 * n), _a8 = EXT8(AA, 8 * m); \
          asm volatile("s_nop 1\n\tv_mfma_scale_f32_16x16x128_f8f6f4 %0, %1, %2, %0, %3, %4 op_sel_hi:[0,0,0]" : "+v"(acc[ai][bj][m][n]) : "v"(_b8), "v"(_a8), "v"(scw), "v"(scx)); } } \
      else { _Pragma("unroll") for (int m = 0; m < 4; ++m) _Pragma("unroll") for (int n = 0; n < 2; ++n) _Pragma("unroll") for (int k = 0; k < 2; ++k) \
        acc[ai][bj][m][n] = __builtin_amdgcn_mfma_f32_16x16x32_bf16(Bt[n][k], At[m][k], acc[ai][bj][m][n], 0, 0, 0); } __builtin_amdgcn_s_setprio(0); } while (0)
#define PG8_WAIT_V(n) asm volatile("s_waitcnt vmcnt(" #n ")" ::: "memory")
#define PG8_WAIT_L(n) asm volatile("s_waitcnt lgkmcnt(" #n ")" ::: "memory")
#define PG8_BAR __builtin_amdgcn_s_barrier()
#define PG8_SCHED __builtin_amdgcn_sched_barrier(0)
    int scw = 0, scx = 0; if constexpr (F8) { scw = Addr::SC_W; scx = Addr::SC_X; } (void)scw; (void)scx;
    Unit cur, nxt; int ui = 0;
    if (!S.next(0, cur)) return;
#ifdef STAG_TICKS
    {
        const unsigned long long t0 = __builtin_amdgcn_s_memrealtime(); const unsigned long long dl = (unsigned long long)(((blockIdx.x >> 3) & 7) * STAG_TICKS);
        while (__builtin_amdgcn_s_memrealtime() - t0 < dl) __builtin_amdgcn_s_sleep(16);
    }
#endif
    f32x4 acc[2][2][4][2];
#pragma unroll
    for (int a = 0; a < 2; ++a)
#pragma unroll
        for (int b = 0; b < 2; ++b)
#pragma unroll
            for (int m = 0; m < 4; ++m)
#pragma unroll
                for (int n = 0; n < 2; ++n) acc[a][b][m][n] = (f32x4){0.f, 0.f, 0.f, 0.f};
    bf16x8 At[4][2], B0[2][2], B1[2][2]; i32x32 AA, BB; (void)At; (void)B0; (void)B1; (void)AA; (void)BB;
    unsigned oc[2][2], on[2][2];
    const char* cA = Abase; const char* nA = Abase;
    if constexpr (Epi::ROWTAB) {
        Unit tu;
        for (int k = 0; k < 16 && S.next(k, tu); ++k)
            for (int r = tid; r < 256; r += 512) ((LAS float*)(lds + STAGE_BYTES + 8192))[k * 256 + r] = E.rowscale(tu, r);
        if constexpr (!Addr::LOADS) __syncthreads();
    }
    if constexpr (Addr::LOADS) {
        {
            Unit tu;
            for (int k = 0; k < 16 && S.next(k, tu); ++k)
                for (int r = tid; r < 256; r += 512) ((LAS unsigned short*)(lds + STAGE_BYTES))[k * 256 + r] = AD.arow_tok(tu, r);
            __syncthreads();
        }
#pragma unroll
        for (int h = 0; h < 2; ++h)
#pragma unroll
            for (int i = 0; i < 2; ++i) { oc[h][i] = AD.arow_lds(lds + STAGE_BYTES, 0, cur, h * HALF + Rr[i]) + Cc[i]; on[h][i] = oc[h][i]; }
        PG8_WAIT_V(0);
    } else { cA = Abase + AD.arow(cur, 0); nA = cA; }
    const char* cB = Bbase + AD.boff(cur);
    PG8_STAGE(PG8_SB(0, 0), cB, voffB); PG8_STAGE_A(PG8_SA(0, 0), 0, 0, false); PG8_STAGE(PG8_SB(0, 1), cB + hstep, voffB); PG8_STAGE_A(PG8_SA(0, 1), 0, 1, false);
    if (wr == 1) PG8_BAR;
    PG8_WAIT_V(4); PG8_BAR;
    PG8_STAGE(PG8_SB(1, 0), cB + kstep, voffB); PG8_STAGE_A(PG8_SA(1, 0), kstep, 0, false); PG8_STAGE(PG8_SB(1, 1), cB + hstep + kstep, voffB);
    PG8_WAIT_V(6); PG8_BAR;
    for (;;) {
        const bool has_next = S.next(ui + 1, nxt);
        if (has_next) {
            if constexpr (Addr::LOADS) {
#pragma unroll
                for (int h = 0; h < 2; ++h)
#pragma unroll
                    for (int i = 0; i < 2; ++i) on[h][i] = AD.arow_lds(lds + STAGE_BYTES, ui + 1, nxt, h * HALF + Rr[i]) + Cc[i];
            } else nA = Abase + AD.arow(nxt, 0);
        } else nA = cA;
        const char* nB = has_next ? Bbase + AD.boff(nxt) : cB;
        if (GP_ON(41)) gp_t1 = GP_T();
#pragma unroll 1
        for (int t = 0; t < nt; t += 2) {
            if (GP_ON(43) && t == 0) gp_t1 = GP_T();
            if (GP_ON(44) && t == 2) gp_t1 = GP_T();
            const bool last = (t == nt - 2);
            const bool un = last && has_next;
            const size_t k1 = (size_t)(t + 1) * kstep;
            const size_t k2 = last ? 0 : (size_t)(t + 2) * kstep, k3 = k2 + kstep;
            const char* b2 = last ? nB : cB + (size_t)(t + 2) * kstep;
            const char* b3 = b2 + kstep;
            PG8_LDB(B0, 0, 0); PG8_SCHED; PG8_LDA(At, 0, 0); PG8_STAGE_A(PG8_SA(1, 1), k1, 1, false);
            PG8_WAIT_L(8); PG8_BAR; PG8_WAIT_L(0); PG8_MMA(0, 0, At, B0); PG8_BAR; PG8_SCHED;
            PG8_LDB(B1, 0, 1); PG8_STAGE(PG8_SB(0, 0), b2, voffB);
            PG8_BAR; PG8_WAIT_L(0); PG8_MMA(0, 1, At, B1); PG8_BAR;
            PG8_LDA(At, 0, 1); PG8_STAGE_A(PG8_SA(0, 0), k2, 0, un);
            PG8_BAR; PG8_WAIT_L(0); PG8_MMA(1, 0, At, B0); PG8_BAR; PG8_SCHED;
            PG8_STAGE(PG8_SB(0, 1), b2 + hstep, voffB);
            PG8_WAIT_V(6); PG8_BAR; PG8_MMA(1, 1, At, B1); PG8_BAR;
            PG8_LDB(B0, 1, 0); PG8_SCHED; PG8_LDA(At, 1, 0); PG8_STAGE_A(PG8_SA(0, 1), k2, 1, un);
            PG8_WAIT_L(8); PG8_BAR; PG8_WAIT_L(0); PG8_MMA(0, 0, At, B0); PG8_BAR; PG8_SCHED;
            PG8_LDB(B1, 1, 1); PG8_STAGE(PG8_SB(1, 0), b3, voffB);
            PG8_BAR; PG8_WAIT_L(0); PG8_MMA(0, 1, At, B1); PG8_BAR;
            PG8_LDA(At, 1, 1); PG8_STAGE_A(PG8_SA(1, 0), k3, 0, un);
            PG8_BAR; PG8_WAIT_L(0); PG8_MMA(1, 0, At, B0); PG8_BAR; PG8_SCHED;
            PG8_STAGE(PG8_SB(1, 1), b3 + hstep, voffB);
            PG8_WAIT_V(6); PG8_BAR; PG8_MMA(1, 1, At, B1); PG8_BAR;
            if (GP_ON(43) && t == 0) gp_acc += GP_T() - gp_t1;
            if (GP_ON(44) && t == 2) gp_acc += GP_T() - gp_t1;
        }
        if (GP_ON(41)) gp_acc += GP_T() - gp_t1;
        if (GP_ON(42)) gp_t1 = GP_T();
        if constexpr (F8) asm volatile("s_nop 15\n\ts_nop 15" ::: "memory");
        E(acc, cur, wr, wc, fr, fq, (const LAS float*)(lds + STAGE_BYTES + 8192) + ui * 256);
        if (GP_ON(42)) gp_acc += GP_T() - gp_t1;
        if (!has_next) break;
#pragma unroll
        for (int a = 0; a < 2; ++a)
#pragma unroll
            for (int b = 0; b < 2; ++b)
#pragma unroll
                for (int m = 0; m < 4; ++m)
#pragma unroll
                    for (int n = 0; n < 2; ++n) acc[a][b][m][n] = (f32x4){0.f, 0.f, 0.f, 0.f};
        cur = nxt; cB = nB; cA = nA; ++ui;
        if constexpr (Addr::LOADS) {
#pragma unroll
            for (int h = 0; h < 2; ++h)
#pragma unroll
                for (int i = 0; i < 2; ++i) oc[h][i] = on[h][i]; }
    }
    PG8_WAIT_V(0);
    if (wr == 0) PG8_BAR;
    PG8_BAR;
    if (TPROBE >= 40 && TPROBE < 50 && Epi::PID == TPGEMM && tid == 0) { gp_tot = GP_T() - gp_t0; atomicAdd((unsigned*)lds_ws_ctl + 512, gp_acc); atomicAdd((unsigned*)lds_ws_ctl + 513, gp_tot); }
#undef PG8_SA
#undef PG8_SB
#undef PG8_STAGE
#undef PG8_STAGE_A
#undef PG8_BSEL_B0
#undef PG8_BSEL_B1
#undef PG8_LDA
#undef PG8_LDB
#undef PG8_MMA
#undef PG8_WAIT_V
#undef PG8_WAIT_L
#undef PG8_BAR
#undef PG8_SCHED
}
}

#ifndef EN_HY
#define EN_HY 1
#endif
#ifndef EN_MA
#define EN_MA 1
#endif
#ifndef EN_AT
#define EN_AT 1
#endif
#ifndef EN_HG
#define EN_HG 1
#endif
#ifndef EN_MOE
#define EN_MOE 1
#endif
#ifndef MOE_F8
#define MOE_F8 1
#endif

DI void transpose_item(const float* W, int ld, int k0, int n0, bf16_t* dst, int drow0, float scale, LAS float* scr, int lane, const float* kw = nullptr) {
    {
        const int rs = lane >> 3, cq = (lane & 7) * 4;
        f32x4 v[8];
#pragma unroll
        for (int i = 0; i < 8; ++i) v[i] = __builtin_nontemporal_load((const f32x4*)(W + (size_t)(k0 + 8 * i + rs) * ld + n0 + cq));
#pragma unroll
        for (int i = 0; i < 8; ++i) { LAS float* d = scr + (8 * i + rs) * 33 + cq; d[0] = v[i].x; d[1] = v[i].y; d[2] = v[i].z; d[3] = v[i].w; }
    }
    LDS_WAIT();
    const int c = lane & 7;
    float sk[8];
#pragma unroll
    for (int i = 0; i < 8; ++i) sk[i] = kw ? scale * kw[k0 + 8 * c + i] : scale;
#pragma unroll
    for (int j = 0; j < 4; ++j) { const int n = (lane >> 3) + 8 * j; const LAS float* s = scr + (8 * c) * 33 + n;
        u32x4 o; o.x = pk2(s[0 * 33] * sk[0], s[1 * 33] * sk[1]); o.y = pk2(s[2 * 33] * sk[2], s[3 * 33] * sk[3]); o.z = pk2(s[4 * 33] * sk[4], s[5 * 33] * sk[5]); o.w = pk2(s[6 * 33] * sk[6], s[7 * 33] * sk[7]);
        *(u32x4*)(dst + (size_t)(drow0 + n) * 1024 + k0 + 8 * c) = o; }
    LDS_WAIT();
}

DI void transpose_item_f8(const float* W, int ld, int k0, int n0, unsigned char* dst, int drow0, float scale, LAS float* scr, int lane) {
    {   const int rs = lane >> 3, cq = (lane & 7) * 4;
        f32x4 v[8];
#pragma unroll
        for (int i = 0; i < 8; ++i) v[i] = __builtin_nontemporal_load((const f32x4*)(W + (size_t)(k0 + 8 * i + rs) * ld + n0 + cq));
#pragma unroll
        for (int i = 0; i < 8; ++i) { LAS float* d = scr + (8 * i + rs) * 33 + cq; d[0] = v[i].x; d[1] = v[i].y; d[2] = v[i].z; d[3] = v[i].w; }
    }
    LDS_WAIT();
    const int c = lane & 7;
#pragma unroll
    for (int j = 0; j < 4; ++j) { const int n = (lane >> 3) + 8 * j; const LAS float* s = scr + (8 * c) * 33 + n;
        u32x2 o; o.x = pk4_fp8(s[0 * 33] * scale, s[1 * 33] * scale, s[2 * 33] * scale, s[3 * 33] * scale); o.y = pk4_fp8(s[4 * 33] * scale, s[5 * 33] * scale, s[6 * 33] * scale, s[7 * 33] * scale);
        *(u32x2*)(dst + (size_t)(drow0 + n) * 1024 + k0 + 8 * c) = o; }
    LDS_WAIT();
}

#define RDL(x, i) __uint_as_float(__builtin_amdgcn_readlane(__float_as_uint(x), (i)))
DI void hyena_filter_pos(const Params& P, int l, int pos, int lane, bf16_t* kfilt) {
    const float TWO_PI = 6.283185307179586f;
    const float tpos = (float)pos * (1.0f / 2047.0f);
    float z = 0.f;
    if (lane == 0) z = tpos;
    else if (lane <= 32) { const int bnd = (lane - 1) & 15; const float f = 1e-4f + (float)bnd * ((15.0f - 1e-4f) / 15.0f);
        const float angp = TWO_PI * (float)pos / 2048.0f; const float ang = angp * f; z = (lane <= 16) ? cosf(ang) : -sinf(ang); }
    const float* w1 = P.hy_w1 + (size_t)l * 33 * 64; const float* w2 = P.hy_w2 + (size_t)l * 64 * 64; const float* w3 = P.hy_w3 + (size_t)l * 64 * 512;
    const float fr = P.hy_freq[l * 64 + lane];
    float a = P.hy_b1[l * 64 + lane];
#pragma unroll 11
    for (int i = 0; i < 33; ++i) a += RDL(z, i) * w1[i * 64 + lane];
    const float h1 = sinf(fr * a);
    float a2 = P.hy_b2[l * 64 + lane];
#pragma unroll 16
    for (int i = 0; i < 64; ++i) a2 += RDL(h1, i) * w2[i * 64 + lane];
    const float h2 = sinf(fr * a2);
    float h3[8];
#pragma unroll
    for (int k = 0; k < 8; ++k) h3[k] = 0.f;
#pragma unroll 8
    for (int i = 0; i < 64; ++i) { const float hv = RDL(h2, i);
#pragma unroll
        for (int k = 0; k < 8; ++k) h3[k] += hv * w3[i * 512 + k * 64 + lane]; }
    const float min_decay = -3.0701134573253944f, max_decay = -15.350567286626972f;
#pragma unroll
    for (int k = 0; k < 8; ++k) { const int cp = k * 64 + lane, c = cp & 255;
        const float delta = fabsf(min_decay + (float)c * ((max_decay - min_decay) / 255.0f));
        float v = h3[k] * expf(-tpos * delta);
        if (cp < 256) { if (pos == 0) { v += P.hy_fbias[l * 256 + c]; kfilt[(size_t)c * 4096 + 4095] = 0; } kfilt[(size_t)c * 4096 + 2047 - pos] = f2bf(v); }
        else if (pos >= 1) kfilt[(size_t)c * 4096 + 2047 + pos] = f2bf(v); }
}
#undef RDL

struct SelRows { int cnt; unsigned o0, o1, o2, o3; };
DI SelRows sel_compact(int sl, int b) {
    SelRows r; r.cnt = 0; r.o0 = r.o1 = r.o2 = r.o3 = 0u;
#pragma unroll
    for (int e = 0; e < 16; ++e) { const int s = __builtin_amdgcn_readlane(sl, e); const bool on = s >= 0; const unsigned v = (unsigned)((b * 16 + e) * 256 + s);
        r.o0 = (on && r.cnt == 0) ? v : r.o0; r.o1 = (on && r.cnt == 1) ? v : r.o1; r.o2 = (on && r.cnt == 2) ? v : r.o2; r.o3 = (on && r.cnt == 3) ? v : r.o3; r.cnt += on ? 1 : 0; }
    return r;
}
DI void ye_load(const bf16_t* YE, unsigned o, int lane, u32x2 (&t)[4]) { const u32x2* yr = (const u32x2*)(YE + (size_t)o * DM) + lane;
#pragma unroll
    for (int j = 0; j < 4; ++j) t[j] = yr[64 * j]; }
DI void ye_add(f32x4 (&v)[4], const u32x2 (&t)[4]) {
#pragma unroll
    for (int j = 0; j < 4; ++j) { v[j].x += bflo(t[j].x); v[j].y += bfhi(t[j].x); v[j].z += bflo(t[j].y); v[j].w += bfhi(t[j].y); } }
template <bool FINAL>
DI void pre_rows2(const Params& P, int l, const int (&m)[2], int lane, const LAS f32x4* dtw, const float* nw, const int (&slp)[2]) {
    unsigned char* ws = P.ws;
    bf16_t* XB = (bf16_t*)(ws + WS_XB);
    const bool first = (!FINAL && l == 0);
    f32x4 v[2][4];
    if (first) {
#pragma unroll
        for (int k = 0; k < 2; ++k) { const f32x4* xr = (const f32x4*)(P.x + (size_t)m[k] * DM) + lane;
#pragma unroll
            for (int j = 0; j < 4; ++j) v[k][j] = xr[64 * j]; }
    } else {
        u32x2 xh[2][4];
#pragma unroll
        for (int k = 0; k < 2; ++k) { const u32x2* xr = (const u32x2*)(XB + (size_t)m[k] * DM) + lane;
#pragma unroll
            for (int j = 0; j < 4; ++j) xh[k][j] = xr[64 * j]; }
#pragma unroll
        for (int k = 0; k < 2; ++k)
#pragma unroll
            for (int j = 0; j < 4; ++j) v[k][j] = (f32x4){bflo(xh[k][j].x), bfhi(xh[k][j].x), bflo(xh[k][j].y), bfhi(xh[k][j].y)};
    }
    if (!first && EN_MOE) {
        const bf16_t* YE = (const bf16_t*)(ws + WS_YE); const int* slot = (const int*)(ws + WS_SLOT);
        int sl[2]; SelRows sr[2]; (void)slot;
#pragma unroll
        for (int k = 0; k < 2; ++k) sl[k] = slp[k];
#pragma unroll
        for (int k = 0; k < 2; ++k) sr[k] = sel_compact(sl[k], m[k] >> 11);
        u32x2 t[2][4][4];
#pragma unroll
        for (int k = 0; k < 2; ++k) { if (sr[k].cnt > 0) ye_load(YE, sr[k].o0, lane, t[k][0]); if (sr[k].cnt > 1) ye_load(YE, sr[k].o1, lane, t[k][1]);
            if (sr[k].cnt > 2) ye_load(YE, sr[k].o2, lane, t[k][2]); if (sr[k].cnt > 3) ye_load(YE, sr[k].o3, lane, t[k][3]); }
#pragma unroll
        for (int k = 0; k < 2; ++k) { if (sr[k].cnt > 0) ye_add(v[k], t[k][0]); if (sr[k].cnt > 1) ye_add(v[k], t[k][1]); if (sr[k].cnt > 2) ye_add(v[k], t[k][2]); if (sr[k].cnt > 3) ye_add(v[k], t[k][3]);
            if (sr[k].cnt > 4) {
                int seen = 0; const int b = m[k] >> 11;
                for (int e = 0; e < 16; ++e) { const int s = __builtin_amdgcn_readlane(sl[k], e);
                    if (s >= 0) { if (seen >= 4) { u32x2 tt[4]; ye_load(YE, (unsigned)((b * 16 + e) * 256 + s), lane, tt); ye_add(v[k], tt); } ++seen; } } } }
    }
    float rr[2];
#pragma unroll
    for (int k = 0; k < 2; ++k) {
        float s = 0.f;
#pragma unroll
        for (int j = 0; j < 4; ++j) s += (v[k][j].x * v[k][j].x + v[k][j].y * v[k][j].y) + (v[k][j].z * v[k][j].z + v[k][j].w * v[k][j].w);
        rr[k] = __builtin_amdgcn_rsqf(wave_sum(s) * (1.0f / DM) + EPSN);
    }
    if (FINAL) {
#pragma unroll
        for (int k = 0; k < 2; ++k) { f32x4* o = (f32x4*)(P.out + (size_t)m[k] * DM) + lane;
#pragma unroll
            for (int j = 0; j < 4; ++j) { const f32x4 w = ((const f32x4*)nw)[64 * j + lane]; o[64 * j] = v[k][j] * rr[k] * w; } }
        return;
    }
    {
#pragma unroll
        for (int k = 0; k < 2; ++k) { u32x2* o = (u32x2*)(XB + (size_t)m[k] * DM) + lane;
#pragma unroll
            for (int j = 0; j < 4; ++j) o[64 * j] = (u32x2){pk2(v[k][j].x, v[k][j].y), pk2(v[k][j].z, v[k][j].w)}; } }
    float d[2][8];
#pragma unroll
    for (int k = 0; k < 2; ++k)
#pragma unroll
        for (int c = 0; c < 8; ++c) d[k][c] = 0.f;
#pragma unroll
    for (int j = 0; j < 4; ++j) {
#pragma unroll
        for (int q = 0; q < 4; ++q) { const f32x4 w0 = dtw[((j * 4 + q) * 2 + 0) * 64 + lane], w1 = dtw[((j * 4 + q) * 2 + 1) * 64 + lane];
#pragma unroll
            for (int k = 0; k < 2; ++k) { const float xv = q == 0 ? v[k][j].x : (q == 1 ? v[k][j].y : (q == 2 ? v[k][j].z : v[k][j].w));
                d[k][0] += xv * w0.x; d[k][1] += xv * w0.y; d[k][2] += xv * w0.z; d[k][3] += xv * w0.w; d[k][4] += xv * w1.x; d[k][5] += xv * w1.y; d[k][6] += xv * w1.z; d[k][7] += xv * w1.w; } }
    }
#pragma unroll
    for (int k = 0; k < 2; ++k) {
        float mine = 0.f;
#pragma unroll
        for (int c = 0; c < 8; ++c) { const float t2 = wave_sum(d[k][c]); mine = (lane == c) ? t2 : mine; }
        if (lane < 8) ((float*)(ws + WS_DT))[(size_t)m[k] * 8 + lane] = mine * rr[k];
        if (lane == 8) ((float*)(ws + WS_MSQ))[m[k]] = rr[k];
    }
    (void)nw;
}

DI void phase_pre(const Params& P, int l, LAS unsigned char* lds) {
    const int tid = tid_opaque(P.wv), lane = tid & 63, wave = tid >> 6;
    const int gw = blockIdx.x * 8 + wave, NGW = gridDim.x * 8;
    unsigned char* ws = P.ws;
    LAS float* dtwf = (LAS float*)lds;
    const float* win_ = P.w_in; asm volatile("" : "+s"(win_));
    for (int i = tid; i < 1024 * 8; i += 512) { const int k = i >> 3, c = i & 7; const int j = k >> 8, ln = (k & 255) >> 2, q = k & 3;
        dtwf[((((j * 4 + q) * 2 + (c >> 2)) * 64 + ln) << 2) + (c & 3)] = P.norm_mix_w[l * DM + k] * win_[((size_t)l * DM + k) * NIN_REF + 1536 + c]; }
    __syncthreads();
    if (EN_HY) for (int pos = gw; pos < SEQ; pos += NGW) hyena_filter_pos(P, l, pos, lane, (bf16_t*)(ws + WS_KFILT));
    {
        LAS float* scr = (LAS float*)(lds + 32768 + wave * 8448);
        constexpr int I_A = 16 * 48, I_B = 16 * 64, I_O = 16 * 32, I_E = 16 * 32 * 16;
        constexpr int NITEMS = I_A + I_B + I_O; (void)I_E;
        bf16_t* WinT = (bf16_t*)(ws + WS_WIN); bf16_t* WoutT = (bf16_t*)(ws + WS_WOUT); bf16_t* WguT = (bf16_t*)(ws + WS_WGU); bf16_t* WdT = (bf16_t*)(ws + WS_WD);
        for (int it = gw; it < NITEMS; it += NGW) {
            int r = it;
            if (r < I_A) { const int kb = r / 48, nb = r % 48; transpose_item(P.w_in + (size_t)l * DM * NIN_REF, NIN_REF, 64 * kb, 32 * nb, WinT, 32 * nb, 1.0f, scr, lane, P.norm_mix_w + l * DM); continue; } r -= I_A;
            if (r < I_B) { const int kb = r / 64, nb = r % 64; const int drow = 1536 + 32 * nb; transpose_item(P.w_in + (size_t)l * DM * NIN_REF, NIN_REF, 64 * kb, 1544 + 32 * nb, WinT, drow, drow < PC_AK ? 0.125f * 1.4426950408889634f : 1.0f  , scr, lane, P.norm_mix_w + l * DM); continue; } r -= I_B;
            { const int kb = r / 32, nb = r % 32; transpose_item(P.w_out + (size_t)l * DM * DM, DM, 64 * kb, 32 * nb, WoutT, 32 * nb, 1.0f, scr, lane); }
            (void)WguT; (void)WdT;
        }
    }
    const float* nw = P.norm_mix_w + l * DM;
    {
        const int* slotp = (const int*)(ws + WS_SLOT); const bool comb = (l != 0) && EN_MOE;
        int sln[2] = {0, 0};
        if (comb && gw < NTOK) { sln[0] = slotp[(size_t)gw * 16 + (lane & 15)]; sln[1] = slotp[(size_t)((gw + NGW < NTOK) ? gw + NGW : gw) * 16 + (lane & 15)]; }
        for (int m = gw; m < NTOK; m += 2 * NGW) { asm volatile("" ::: "memory"); const int mm[2] = {m, (m + NGW < NTOK) ? m + NGW : m};
            const int slc[2] = {sln[0], sln[1]}; const int mn = m + 2 * NGW;
            if (comb && mn < NTOK) { sln[0] = slotp[(size_t)mn * 16 + (lane & 15)]; sln[1] = slotp[(size_t)((mn + NGW < NTOK) ? mn + NGW : mn) * 16 + (lane & 15)]; }
            pre_rows2<false>(P, l, mm, lane, (const LAS f32x4*)dtwf, nw, slc); }
    }
}
DI void phase_final(const Params& P) {
    const int tid = tid_opaque(P.wv), lane = tid & 63, wave = tid >> 6;
    const int gw = blockIdx.x * 8 + wave, NGW = gridDim.x * 8;
    {
        const int* slotp = (const int*)(P.ws + WS_SLOT); const bool comb = EN_MOE;
        int sln[2] = {0, 0};
        if (comb && gw < NTOK) { sln[0] = slotp[(size_t)gw * 16 + (lane & 15)]; sln[1] = slotp[(size_t)((gw + NGW < NTOK) ? gw + NGW : gw) * 16 + (lane & 15)]; }
        for (int m = gw; m < NTOK; m += 2 * NGW) { const int mm[2] = {m, (m + NGW < NTOK) ? m + NGW : m};
            const int slc[2] = {sln[0], sln[1]}; const int mn = m + 2 * NGW;
            if (comb && mn < NTOK) { sln[0] = slotp[(size_t)mn * 16 + (lane & 15)]; sln[1] = slotp[(size_t)((mn + NGW < NTOK) ? mn + NGW : mn) * 16 + (lane & 15)]; }
            pre_rows2<true>(P, 1, mm, lane, nullptr, P.final_w, slc); }
    }
}

struct AddrPlain { static constexpr bool LOADS = false; int K; int nb_rows;
    DI unsigned arow(const pg8::Unit& u, int r) const { return (unsigned)(u.pm * 256 + r) * (unsigned)(K * 2); }
    DI size_t boff(const pg8::Unit& u) const { return (size_t)u.pn * 256 * K * 2; } };
DI int moe_panel(int r) { return (r & 31) * 16 + (r >> 5); }
struct AddrGateUp { static constexpr bool LOADS = true; const int* seli;
    DI unsigned arow(const pg8::Unit& u, int r) const { const int b = u.pm & 31; const int t = seli[moe_panel(u.pm) * 256 + r]; return (unsigned)(b * SEQ + t) * (unsigned)(DM * 2); }
    DI unsigned short arow_tok(const pg8::Unit& u, int r) const { return (unsigned short)seli[moe_panel(u.pm) * 256 + r]; }
    DI unsigned arow_lds(const LAS unsigned char* tab, int k, const pg8::Unit& u, int r) const { const int b = u.pm & 31; const int t = ((const LAS unsigned short*)tab)[k * 256 + r]; return (unsigned)(b * SEQ + t) * (unsigned)(DM * 2); }
    DI size_t boff(const pg8::Unit& u) const { return ((size_t)(u.pm >> 5) * 2048 + (size_t)u.pn * 256) * DM * 2; } };
struct AddrGateUp8 { static constexpr bool LOADS = true; static constexpr int SC_W = 0x79797979, SC_X = 0x7f7f7f7f; const int* seli;
    DI unsigned arow(const pg8::Unit& u, int r) const { const int b = u.pm & 31; const int t = seli[moe_panel(u.pm) * 256 + r]; return (unsigned)(b * SEQ + t) * (unsigned)DM; }
    DI unsigned short arow_tok(const pg8::Unit& u, int r) const { return (unsigned short)seli[moe_panel(u.pm) * 256 + r]; }
    DI unsigned arow_lds(const LAS unsigned char* tab, int k, const pg8::Unit& u, int r) const { const int b = u.pm & 31; const int t = ((const LAS unsigned short*)tab)[k * 256 + r]; return (unsigned)(b * SEQ + t) * (unsigned)DM; }
    DI size_t boff(const pg8::Unit& u) const { return ((size_t)(u.pm >> 5) * 2048 + (size_t)u.pn * 256) * DM; } };
struct AddrDown8 { static constexpr bool LOADS = false; static constexpr int SC_W = 0x79797979, SC_X = 0x7c7c7c7c;
    DI unsigned arow(const pg8::Unit& u, int r) const { return (unsigned)(moe_panel(u.pm) * 256 + r) * (unsigned)DM; }
    DI size_t boff(const pg8::Unit& u) const { return ((size_t)(u.pm >> 5) * 1024 + (size_t)u.pn * 256) * DM; } };
struct AddrDown { static constexpr bool LOADS = false;
    DI unsigned arow(const pg8::Unit& u, int r) const { return (unsigned)(moe_panel(u.pm) * 256 + r) * (unsigned)(DM * 2); }
    DI size_t boff(const pg8::Unit& u) const { return ((size_t)(u.pm >> 5) * 1024 + (size_t)u.pn * 256) * DM * 2; } };

struct EpiProj { static constexpr int PID = 1; static constexpr bool PERM = true, ROWTAB = true; bf16_t* O; const float* rsm;
    DI float rowscale(const pg8::Unit& u, int r) const { return rsm[u.pm * 256 + r]; }
    DI void operator()(const f32x4 (&acc)[2][2][4][2], const pg8::Unit& u, int wr, int wc, int fr, int fq, const LAS float* rtab) const {
        const int row0 = u.pm * 256 + wr * 64 + fr, col0 = u.pn * 256 + wc * 32 + 8 * fq;
#pragma unroll
        for (int ai = 0; ai < 2; ++ai)
#pragma unroll
            for (int m = 0; m < 4; ++m) { bf16_t* rowp = O + (size_t)(row0 + ai * 128 + m * 16) * NPROJ + col0; const float g = rtab[wr * 64 + fr + ai * 128 + m * 16];
#pragma unroll
                for (int bj = 0; bj < 2; ++bj) { const f32x4 v0 = acc[ai][bj][m][0] * g, v1 = acc[ai][bj][m][1] * g;
                    u32x4 w; w.x = pk2(v0[0], v0[1]); w.y = pk2(v0[2], v0[3]); w.z = pk2(v1[0], v1[1]); w.w = pk2(v1[2], v1[3]);
                    *(u32x4*)(rowp + bj * 128) = w; } }
    } };
struct EpiRes { static constexpr int PID = 5; static constexpr bool PERM = true, ROWTAB = false; const float* base32; const bf16_t* base16; bf16_t* out;
    DI void operator()(const f32x4 (&acc)[2][2][4][2], const pg8::Unit& u, int wr, int wc, int fr, int fq, const LAS float* rtab) const {
        const int row0 = u.pm * 256 + wr * 64 + fr, col0 = u.pn * 256 + wc * 32 + 8 * fq;
#pragma unroll
        for (int ai = 0; ai < 2; ++ai)
#pragma unroll
            for (int m = 0; m < 4; ++m) { const size_t off = (size_t)(row0 + ai * 128 + m * 16) * DM + col0;
#pragma unroll
                for (int bj = 0; bj < 2; ++bj) { f32x4 v0 = acc[ai][bj][m][0], v1 = acc[ai][bj][m][1];
                    if (base32) { v0 = v0 + *(const f32x4*)(base32 + off + bj * 128); v1 = v1 + *(const f32x4*)(base32 + off + bj * 128 + 4); }
                    else { const u32x4 bs = *(const u32x4*)(base16 + off + bj * 128);
                        v0 = v0 + (f32x4){bflo(bs.x), bfhi(bs.x), bflo(bs.y), bfhi(bs.y)}; v1 = v1 + (f32x4){bflo(bs.z), bfhi(bs.z), bflo(bs.w), bfhi(bs.w)}; }
                    u32x4 w; w.x = pk2(v0[0], v0[1]); w.y = pk2(v0[2], v0[3]); w.z = pk2(v1[0], v1[1]); w.w = pk2(v1[2], v1[3]);
                    *(u32x4*)(out + off + bj * 128) = w; } }
    } };
struct EpiGateUp { static constexpr int PID = 18; static constexpr bool PERM = true, ROWTAB = true; bf16_t* H; const float* selr;
    DI float rowscale(const pg8::Unit& u, int r) const { return selr[moe_panel(u.pm) * 256 + r]; }
    DI void operator()(const f32x4 (&acc)[2][2][4][2], const pg8::Unit& u, int wr, int wc, int fr, int fq, const LAS float* rtab) const {
        const int row0 = moe_panel(u.pm) * 256 + wr * 64 + fr, col0 = u.pn * 128 + wc * 32 + 8 * fq;
#pragma unroll
        for (int ai = 0; ai < 2; ++ai)
#pragma unroll
            for (int m = 0; m < 4; ++m) { bf16_t* rowp = H + (size_t)(row0 + ai * 128 + m * 16) * DM + col0; const float rr = rtab[wr * 64 + fr + ai * 128 + m * 16];
                float hv[8];
#pragma unroll
                for (int n = 0; n < 2; ++n)
#pragma unroll
                    for (int j = 0; j < 4; ++j) { const float g = acc[ai][0][m][n][j] * rr, up = acc[ai][1][m][n][j] * rr; hv[n * 4 + j] = silu_f(g) * up; }
                u32x4 w; w.x = pk2(hv[0], hv[1]); w.y = pk2(hv[2], hv[3]); w.z = pk2(hv[4], hv[5]); w.w = pk2(hv[6], hv[7]);
                *(u32x4*)rowp = w; }
    } };
struct EpiGateUp8 { static constexpr int PID = 8; static constexpr bool PERM = true, ROWTAB = true; unsigned char* H; const float* selr;
    DI float rowscale(const pg8::Unit& u, int r) const { return selr[moe_panel(u.pm) * 256 + r]; }
    DI void operator()(const f32x4 (&acc)[2][2][4][2], const pg8::Unit& u, int wr, int wc, int fr, int fq, const LAS float* rtab) const {
        const int row0 = moe_panel(u.pm) * 256 + wr * 64 + fr, col0 = u.pn * 128 + wc * 32 + 8 * fq;
#pragma unroll
        for (int ai = 0; ai < 2; ++ai)
#pragma unroll
            for (int m = 0; m < 4; ++m) { unsigned char* rowp = H + (size_t)(row0 + ai * 128 + m * 16) * DM + col0; const float rr = rtab[wr * 64 + fr + ai * 128 + m * 16];
                float hv[8];
#pragma unroll
                for (int n = 0; n < 2; ++n)
#pragma unroll
                    for (int j = 0; j < 4; ++j) { const float g = acc[ai][0][m][n][j] * rr, up = acc[ai][1][m][n][j] * rr; hv[n * 4 + j] = silu_f(g) * up * 8.0f; }
                *(u32x2*)rowp = (u32x2){pk4_fp8(hv[0], hv[1], hv[2], hv[3]), pk4_fp8(hv[4], hv[5], hv[6], hv[7])}; }
    } };
struct EpiDown { static constexpr int PID = 9; static constexpr bool PERM = true, ROWTAB = true; bf16_t* Y; const float* gate;
    DI float rowscale(const pg8::Unit& u, int r) const { return gate[moe_panel(u.pm) * 256 + r]; }
    DI void operator()(const f32x4 (&acc)[2][2][4][2], const pg8::Unit& u, int wr, int wc, int fr, int fq, const LAS float* rtab) const {
        const int row0 = moe_panel(u.pm) * 256 + wr * 64 + fr, col0 = u.pn * 256 + wc * 32 + 8 * fq;
#pragma unroll
        for (int ai = 0; ai < 2; ++ai)
#pragma unroll
            for (int m = 0; m < 4; ++m) { const int row = row0 + ai * 128 + m * 16; const float g = rtab[wr * 64 + fr + ai * 128 + m * 16]; bf16_t* rowp = Y + (size_t)row * DM + col0;
#pragma unroll
                for (int bj = 0; bj < 2; ++bj) { const f32x4 v0 = acc[ai][bj][m][0] * g, v1 = acc[ai][bj][m][1] * g;
                    u32x4 w; w.x = pk2(v0[0], v0[1]); w.y = pk2(v0[2], v0[3]); w.z = pk2(v1[0], v1[1]); w.w = pk2(v1[2], v1[3]);
                    *(u32x4*)(rowp + bj * 128) = w; } }
    } };

DI void phase_premix(const Params& P, int l, LAS unsigned char* lds) {
    const int tid = tid_opaque(P.wv), lane = tid & 63, wave = tid >> 6;
    const int gw = blockIdx.x * 8 + wave, NGW = gridDim.x * 8;
    unsigned char* ws = P.ws;
    const bf16_t* proj = (const bf16_t*)(ws + WS_PROJ);
    unsigned char* dsc = (unsigned char*)P.out;
    if (EN_HY) {
        bf16_t* HW = (bf16_t*)(dsc + DO_HW); bf16_t* HX0 = (bf16_t*)(dsc + DO_HX0);
        const float* cw = P.hy_conv_w + (size_t)l * 3 * 768;
        LAS unsigned char* tl = lds + wave * 15616;
        const int rsub = lane >> 3, cch = lane & 7;
        const int i16 = lane & 15, trq = i16 >> 2, trp = i16 & 3, g16 = lane >> 4;
        const unsigned troff = (unsigned)(trq * 144 + (16 * g16 + 4 * trp) * 2);
        u32x4 rin[5][3];
#define HYPM_LOAD(IT) do { const int ct_ = (IT) & 3, tt_ = ((IT) >> 2) & 63, b_ = (IT) >> 8; const int t0_ = tt_ * 32; \
            const bf16_t* pr_ = proj + ((size_t)b_ * SEQ) * NPROJ + ct_ * 64 + 8 * cch; \
            _Pragma("unroll") for (int i = 0; i < 5; ++i) { const int rr = rsub + 8 * i; const int t = t0_ - 1 + rr; const bool ok = (rr < 34) && (t >= 0) && (t < SEQ); \
                const bf16_t* q = pr_ + (size_t)(ok ? t : 0) * NPROJ; \
                _Pragma("unroll") for (int a = 0; a < 3; ++a) { rin[i][a] = *(const u32x4*)(q + 256 * a); if (!ok) rin[i][a] = (u32x4){0u, 0u, 0u, 0u}; } } } while (0)
        if (gw < NB * 64 * 4) HYPM_LOAD(gw);
        for (int it = gw; it < NB * 64 * 4; it += NGW) {
            const int ct = it & 3, tt = (it >> 2) & 63, b = it >> 8;
            const int c = ct * 64 + lane, t0 = tt * 32;
#pragma unroll
            for (int i = 0; i < 5; ++i) { const int rr = rsub + 8 * i;
#pragma unroll
                for (int a = 0; a < 3; ++a) if (rr < 36) *(LAS u32x4*)(tl + a * 5184 + rr * 144 + 16 * cch) = rin[i][a]; }
            if (it + NGW < NB * 64 * 4) HYPM_LOAD(it + NGW);
            float w0[3], w1[3], w2[3];
#pragma unroll
            for (int j = 0; j < 3; ++j) { w0[j] = cw[j * 768 + c]; w1[j] = cw[j * 768 + 256 + c]; w2[j] = cw[j * 768 + 512 + c]; }
            LDS_WAIT();
            float p0[4], p1[4], p2[4];
            unsigned hwv[16], hxv[16];
#pragma unroll
            for (int j = 0; j < 9; ++j) {
                const s16x4 r0 = __builtin_amdgcn_ds_read_tr16_b64_v4i16((LAS s16x4*)(tl + 0 * 5184 + troff + (4 * j) * 144));
                const s16x4 r1 = __builtin_amdgcn_ds_read_tr16_b64_v4i16((LAS s16x4*)(tl + 1 * 5184 + troff + (4 * j) * 144));
                const s16x4 r2 = __builtin_amdgcn_ds_read_tr16_b64_v4i16((LAS s16x4*)(tl + 2 * 5184 + troff + (4 * j) * 144));
                float c0[4], c1[4], c2[4];
#pragma unroll
                for (int k = 0; k < 4; ++k) { c0[k] = bf2f((unsigned short)r0[k]); c1[k] = bf2f((unsigned short)r1[k]); c2[k] = bf2f((unsigned short)r2[k]); }
                if (j > 0) {
                    float u0[4], hv[4];
#pragma unroll
                    for (int k = 0; k < 4; ++k) { const float a0 = p0[k], a1 = p1[k], a2 = p2[k];
                        const float b0 = (k < 3) ? p0[k + 1] : c0[0], b1 = (k < 3) ? p1[k + 1] : c1[0], b2 = (k < 3) ? p2[k + 1] : c2[0];
                        const float d0 = (k < 2) ? p0[k + 2] : c0[k - 2], d1 = (k < 2) ? p1[k + 2] : c1[k - 2], d2 = (k < 2) ? p2[k + 2] : c2[k - 2];
                        u0[k] = w0[0] * a0 + w0[1] * b0 + w0[2] * d0;
                        hv[k] = (w2[0] * a2 + w2[1] * b2 + w2[2] * d2) * (w1[0] * a1 + w1[1] * b1 + w1[2] * d1); }
                    hwv[2 * (j - 1)] = pk2(hv[0], hv[1]); hwv[2 * (j - 1) + 1] = pk2(hv[2], hv[3]); hxv[2 * (j - 1)] = pk2(u0[0], u0[1]); hxv[2 * (j - 1) + 1] = pk2(u0[2], u0[3]);
                }
#pragma unroll
                for (int k = 0; k < 4; ++k) { p0[k] = c0[k]; p1[k] = c1[k]; p2[k] = c2[k]; }
            }
            bf16_t* hwp = HW + ((size_t)c * NB + b) * SEQ + t0; bf16_t* hxp = HX0 + ((size_t)c * NB + b) * SEQ + t0;
#pragma unroll
            for (int k = 0; k < 4; ++k) { *(u32x4*)(hwp + 8 * k) = (u32x4){hwv[4 * k], hwv[4 * k + 1], hwv[4 * k + 2], hwv[4 * k + 3]}; *(u32x4*)(hxp + 8 * k) = (u32x4){hxv[4 * k], hxv[4 * k + 1], hxv[4 * k + 2], hxv[4 * k + 3]}; }
            LDS_WAIT();
        }
    }
    if (EN_MA) {
        bf16_t* MX = (bf16_t*)(dsc + DO_MXBC);
        const float* cw = P.m_conv_w + (size_t)l * 5 * 512; const float* cb = P.m_conv_b + (size_t)l * 512;
        const int gt = blockIdx.x * 512 + tid, NGT = gridDim.x * 512;
        for (int it = gt; it < (NTOK / 4) * 64; it += NGT) {
            const int ch = (it & 63) * 8, m0 = (it >> 6) * 4, t0 = m0 & (SEQ - 1);
            u32x4 rw[8];
#pragma unroll
            for (int j = 0; j < 8; ++j) { const int tt = t0 + j - 2; const bool ok = (tt >= 0) && (tt < SEQ);
                rw[j] = *(const u32x4*)(proj + (size_t)(ok ? m0 + j - 2 : m0) * NPROJ + PC_MX + ch); if (!ok) rw[j] = (u32x4){0u, 0u, 0u, 0u}; }
            f32x4 wa[5], wb[5];
#pragma unroll
            for (int j = 0; j < 5; ++j) { wa[j] = *(const f32x4*)(cw + j * 512 + ch); wb[j] = *(const f32x4*)(cw + j * 512 + ch + 4); }
            const f32x4 ba = *(const f32x4*)(cb + ch), bb = *(const f32x4*)(cb + ch + 4);
#pragma unroll
            for (int k = 0; k < 4; ++k) {
                float a[8] = {ba.x, ba.y, ba.z, ba.w, bb.x, bb.y, bb.z, bb.w};
#pragma unroll
                for (int j = 0; j < 5; ++j) { const u32x4 v = rw[k + j];
                    a[0] += wa[j].x * bflo(v.x); a[1] += wa[j].y * bfhi(v.x); a[2] += wa[j].z * bflo(v.y); a[3] += wa[j].w * bfhi(v.y);
                    a[4] += wb[j].x * bflo(v.z); a[5] += wb[j].y * bfhi(v.z); a[6] += wb[j].z * bflo(v.w); a[7] += wb[j].w * bfhi(v.w); }
                u32x4 o; o.x = pk2(silu_f(a[0]), silu_f(a[1])); o.y = pk2(silu_f(a[2]), silu_f(a[3])); o.z = pk2(silu_f(a[4]), silu_f(a[5])); o.w = pk2(silu_f(a[6]), silu_f(a[7]));
                *(u32x4*)(MX + (size_t)(m0 + k) * 512 + ch) = o;
            }
        }
    }
}

DI void phase_finalize(const Params& P, int l) {
    const int tid = tid_opaque(P.wv), lane = tid & 63, wave = tid >> 6;
    const int gw = blockIdx.x * 8 + wave, NGW = gridDim.x * 8;
    unsigned char* ws = P.ws; unsigned char* dsc = (unsigned char*)P.out;
    bf16_t* MIX = (bf16_t*)(ws + WS_HN);
    {
        const bf16_t* YAT = (const bf16_t*)(dsc + DO_YAT);
        for (int it = gw; it < NB * 32 * 4; it += NGW) {
            const int ct = it & 3, tt = (it >> 2) & 31, b = it >> 7;
            const int c = ct * 64 + lane, t0 = tt * 64;
            const bf16_t* src = YAT + ((size_t)c * NB + b) * SEQ + t0;
            bf16_t* dst = MIX + ((size_t)b * SEQ + t0) * DM + c;
#pragma unroll 2
            for (int t8 = 0; t8 < 64; t8 += 8) {
                u32x4 v = EN_HY ? *(const u32x4*)(src + t8) : (u32x4){0u, 0u, 0u, 0u};
                const unsigned w[4] = {v.x, v.y, v.z, v.w};
#pragma unroll
                for (int i = 0; i < 8; ++i) dst[(size_t)(t8 + i) * DM] = (bf16_t)((i & 1) ? (w[i >> 1] >> 16) : (w[i >> 1] & 0xffffu));
            }
        }
    }
    {
        const bf16_t* MYF = (const bf16_t*)(dsc + DO_MY); const bf16_t* MYB = (const bf16_t*)(ws + WS_MYB); const bf16_t* MX = (const bf16_t*)(dsc + DO_MXBC);
        const bf16_t* OB = (const bf16_t*)(ws + WS_OB); const bf16_t* proj = (const bf16_t*)(ws + WS_PROJ);
        const float* nwm = P.m_norm_w + l * 256; const float* nwh = P.hg_norm_w + l * 64;
        const int gt = blockIdx.x * 512 + tid, NGT = gridDim.x * 512;
        for (int it = gt; it < NTOK * 32; it += NGT) {
            const int ch = (it & 31) * 8, m = it >> 5;
            const u32x4 yf = *(const u32x4*)(MYF + (size_t)m * 256 + ch), yb = *(const u32x4*)(MYB + (size_t)m * 256 + ch), xv = *(const u32x4*)(MX + (size_t)m * 512 + ch), zv = *(const u32x4*)(proj + (size_t)m * NPROJ + PC_MZ + ch);
            const u32x4 of = *(const u32x4*)(MIX + (size_t)m * DM + 768 + ch), ob = *(const u32x4*)(OB + (size_t)m * 256 + ch), gv = *(const u32x4*)(proj + (size_t)m * NPROJ + PC_HG + ch);
            u32x4 o = {0u, 0u, 0u, 0u};
            if (EN_MA) {
                const float Dk = P.m_D[l * 4 + (ch >> 6)];
                const unsigned yfw[4] = {yf.x, yf.y, yf.z, yf.w}, ybw[4] = {yb.x, yb.y, yb.z, yb.w}, xw[4] = {xv.x, xv.y, xv.z, xv.w}, zw[4] = {zv.x, zv.y, zv.z, zv.w};
                float y[8]; float sq = 0.f;
#pragma unroll
                for (int j = 0; j < 4; ++j) { y[2 * j] = (bflo(yfw[j]) + bflo(ybw[j]) + Dk * bflo(xw[j])) * silu_f(bflo(zw[j])); y[2 * j + 1] = (bfhi(yfw[j]) + bfhi(ybw[j]) + Dk * bfhi(xw[j])) * silu_f(bfhi(zw[j]));
                    sq += y[2 * j] * y[2 * j] + y[2 * j + 1] * y[2 * j + 1]; }
#pragma unroll
                for (int of2 = 1; of2 < 32; of2 <<= 1) sq += __shfl_xor(sq, of2);
                const float r = __builtin_amdgcn_rsqf(sq * (1.0f / 256.0f) + EPSN);
                const f32x4 wa = *(const f32x4*)(nwm + ch), wb = *(const f32x4*)(nwm + ch + 4);
                o.x = pk2(y[0] * r * wa.x, y[1] * r * wa.y); o.y = pk2(y[2] * r * wa.z, y[3] * r * wa.w); o.z = pk2(y[4] * r * wb.x, y[5] * r * wb.y); o.w = pk2(y[6] * r * wb.z, y[7] * r * wb.w);
            }
            *(u32x4*)(MIX + (size_t)m * DM + 256 + ch) = o;
            if (EN_HG) {
                const unsigned ofw[4] = {of.x, of.y, of.z, of.w}, obw[4] = {ob.x, ob.y, ob.z, ob.w}, gw4[4] = {gv.x, gv.y, gv.z, gv.w};
                float y[8]; float sq = 0.f;
#pragma unroll
                for (int j = 0; j < 4; ++j) { y[2 * j] = bflo(ofw[j]) + bflo(obw[j]); y[2 * j + 1] = bfhi(ofw[j]) + bfhi(obw[j]); sq += y[2 * j] * y[2 * j] + y[2 * j + 1] * y[2 * j + 1]; }
#pragma unroll
                for (int o2 = 1; o2 < 8; o2 <<= 1) sq += __shfl_xor(sq, o2);
                const float r = __builtin_amdgcn_rsqf(sq * (1.0f / 64.0f) + EPSN);
                const f32x4 wa = *(const f32x4*)(nwh + (ch & 63)), wb = *(const f32x4*)(nwh + (ch & 63) + 4);
                u32x4 oh;
                oh.x = pk2(y[0] * r * wa.x * silu_f(bflo(gw4[0])), y[1] * r * wa.y * silu_f(bfhi(gw4[0]))); oh.y = pk2(y[2] * r * wa.z * silu_f(bflo(gw4[1])), y[3] * r * wa.w * silu_f(bfhi(gw4[1])));
                oh.z = pk2(y[4] * r * wb.x * silu_f(bflo(gw4[2])), y[5] * r * wb.y * silu_f(bfhi(gw4[2]))); oh.w = pk2(y[6] * r * wb.z * silu_f(bflo(gw4[3])), y[7] * r * wb.w * silu_f(bfhi(gw4[3])));
                *(u32x4*)(MIX + (size_t)m * DM + 768 + ch) = oh;
            }
        }
    }
#if !EN_AT || !EN_HG
    {
        const int gt = blockIdx.x * 512 + tid, NGT = gridDim.x * 512;
        for (int it = gt; it < NTOK * 32; it += NGT) { const int ch = (it & 31) * 8, m = it >> 5;
            if (!EN_AT) *(u32x4*)(MIX + (size_t)m * DM + 512 + ch) = (u32x4){0u, 0u, 0u, 0u};
            if (!EN_HG) *(u32x4*)(MIX + (size_t)m * DM + 768 + ch) = (u32x4){0u, 0u, 0u, 0u}; }
    }
#endif
}

DI void phase_ffnpre(const Params& P, int l, LAS unsigned char* lds) {
    const int tid = tid_opaque(P.wv), lane = tid & 63, wave = tid >> 6, r = lane & 15, q = lane >> 4;
    const int gw = blockIdx.x * 8 + wave, NGW = gridDim.x * 8;
    unsigned char* ws = P.ws;
    LAS u32x4* Wh = (LAS u32x4*)lds;
    LAS u32x4* Wl = Wh + 32 * 64;
    for (int i = tid; i < 32 * 64; i += 512) { const int s = i >> 6, ln = i & 63, e = ln & 15, qq = ln >> 4; float wv[8]; unsigned hi[4], lo[4];
#pragma unroll
        for (int j = 0; j < 8; ++j) { const int k = 32 * s + 8 * qq + j; wv[j] = P.norm_ffn_w[l * DM + k] * P.router_w[((size_t)l * DM + k) * 16 + e]; }
#pragma unroll
        for (int j = 0; j < 4; ++j) { hi[j] = pk2(wv[2 * j], wv[2 * j + 1]); lo[j] = pk2(wv[2 * j] - bflo(hi[j]), wv[2 * j + 1] - bfhi(hi[j])); }
        Wh[i] = (u32x4){hi[0], hi[1], hi[2], hi[3]}; Wl[i] = (u32x4){lo[0], lo[1], lo[2], lo[3]}; }
    __syncthreads();
    const bf16_t* XB = (const bf16_t*)(ws + WS_XB); const float* nw = P.norm_ffn_w + l * DM + 8 * q;
    float* aff = (float*)(ws + WS_AFF); float* rs = (float*)(ws + WS_RS);
    bf16_t* XN = (bf16_t*)(ws + WS_HN);
    for (int grp = gw; grp < NTOK / 16; grp += NGW) {
        const int m0 = grp * 16;
        const bf16_t* xrow = XB + (size_t)(m0 + r) * DM + 8 * q; bf16_t* orow = XN + (size_t)(m0 + r) * DM + 8 * q; unsigned char* orow8 = (unsigned char*)XN + (size_t)(m0 + r) * DM + 8 * q; (void)orow; (void)orow8;
        f32x4 acc = {0.f, 0.f, 0.f, 0.f}; float ss = 0.f;
#pragma unroll 8
        for (int s = 0; s < 32; ++s) {
            const u32x4 xv = *(const u32x4*)(xrow + 32 * s);
            const f32x4 a = {bflo(xv.x), bfhi(xv.x), bflo(xv.y), bfhi(xv.y)}, b = {bflo(xv.z), bfhi(xv.z), bflo(xv.w), bfhi(xv.w)};
            const f32x4 wa = *(const f32x4*)(nw + 32 * s), wb = *(const f32x4*)(nw + 32 * s + 4);
            ss += (a.x * a.x + a.y * a.y) + (a.z * a.z + a.w * a.w) + (b.x * b.x + b.y * b.y) + (b.z * b.z + b.w * b.w);
            const bf16x8 ah = __builtin_bit_cast(bf16x8, xv);
            const bf16x8 wh = __builtin_bit_cast(bf16x8, Wh[s * 64 + lane]), wl = __builtin_bit_cast(bf16x8, Wl[s * 64 + lane]);
            acc = __builtin_amdgcn_mfma_f32_16x16x32_bf16(ah, wh, acc, 0, 0, 0);
            acc = __builtin_amdgcn_mfma_f32_16x16x32_bf16(ah, wl, acc, 0, 0, 0);
#if MOE_F8
            *(u32x2*)(orow8 + 32 * s) = (u32x2){pk4_fp8(a.x * wa.x, a.y * wa.y, a.z * wa.z, a.w * wa.w), pk4_fp8(b.x * wb.x, b.y * wb.y, b.z * wb.z, b.w * wb.w)};
#else
            *(u32x4*)(orow + 32 * s) = (u32x4){pk2(a.x * wa.x, a.y * wa.y), pk2(a.z * wa.z, a.w * wa.w), pk2(b.x * wb.x, b.y * wb.y), pk2(b.z * wb.z, b.w * wb.w)};
#endif
        }
        ss += __shfl_xor(ss, 16); ss += __shfl_xor(ss, 32);
        const float rinv = __builtin_amdgcn_rsqf(ss * (1.0f / DM) + EPSN);
        if (q == 0) rs[m0 + r] = rinv;
#pragma unroll
        for (int i = 0; i < 4; ++i) {
            const float lg = acc[i] * __shfl(rinv, 4 * q + i);
            float mx = lg;
#pragma unroll
            for (int o = 1; o < 16; o <<= 1) mx = fmaxf(mx, __shfl_xor(mx, o));
            const float ex = expf(lg - mx); float se = ex;
#pragma unroll
            for (int o = 1; o < 16; o <<= 1) se += __shfl_xor(se, o);
            const int m = m0 + 4 * q + i;
            aff[((size_t)(m >> 11) * 16 + r) * SEQ + (m & (SEQ - 1))] = ex / se;
        }
    }
}

DI int wave_sum_i(int v) {
#pragma unroll
    for (int o = 1; o < 64; o <<= 1) v += __shfl_xor(v, o);
    return v;
}
DI int half_excl_scan(int c, int lane, int hw, LAS int* ws4, int* tot) {
    int inc = c;
#pragma unroll
    for (int o = 1; o < 64; o <<= 1) { const int t = __shfl_up(inc, o); if (lane >= o) inc += t; }
    if (lane == 63) ws4[hw] = inc;
    __syncthreads();
    int base = 0, total = 0;
#pragma unroll
    for (int w = 0; w < 4; ++w) { const int t = ws4[w]; base += (w < hw) ? t : 0; total += t; }
    *tot = total;
    return base + inc - c;
}
DI void phase_topk(const Params& P, int l, LAS unsigned char* lds) {
    const int tid = tid_opaque(P.wv), lane = tid & 63, wave = tid >> 6;
    unsigned char* ws = P.ws;
    const float* aff = (const float*)(ws + WS_AFF); const float* rs = (const float*)(ws + WS_RS);
    int* slot = (int*)(ws + WS_SLOT); int* seli = (int*)(ws + WS_SELI); float* selg = (float*)(ws + WS_SELG); float* selr = (float*)(ws + WS_SELR);
    const int half = wave >> 2, hw = wave & 3, ht = tid & 255;
    LAS int* wsum = (LAS int*)lds + half * 64;
    for (int u0 = blockIdx.x; u0 < NB * NEXP; u0 += 2 * gridDim.x) {
        const int u = u0 + half * gridDim.x; const bool live = u < NB * NEXP; const int uu = live ? u : u0;
        const int b = uu >> 4, e = uu & 15;
        __syncthreads();
        const u32x4 ka = *(const u32x4*)(aff + (size_t)uu * SEQ + 8 * ht), kb = *(const u32x4*)(aff + (size_t)uu * SEQ + 8 * ht + 4);
        const unsigned kk[8] = {ka.x, ka.y, ka.z, ka.w, kb.x, kb.y, kb.z, kb.w};
        const f32x4 ra = *(const f32x4*)(rs + (size_t)b * SEQ + 8 * ht), rb = *(const f32x4*)(rs + (size_t)b * SEQ + 8 * ht + 4);
        const float rsv[8] = {ra.x, ra.y, ra.z, ra.w, rb.x, rb.y, rb.z, rb.w};
        unsigned prefix = 0u;
#pragma unroll 1
        for (int bit = 30; bit >= 0; bit -= (bit == 30 ? 1 : 2)) {
            const unsigned hi = 1u << bit, lo = (bit == 30) ? 0u : (1u << (bit - 1));
            const unsigned c1 = prefix | hi, c0 = prefix | lo, c3 = prefix | hi | lo;
            int n1 = 0, n0 = 0, n3 = 0;
#pragma unroll
            for (int j = 0; j < 8; ++j) { n1 += __builtin_popcountll(__ballot(kk[j] >= c1)); n0 += __builtin_popcountll(__ballot(kk[j] >= c0)); n3 += __builtin_popcountll(__ballot(kk[j] >= c3)); }
            const int par = (bit & 2) ? 12 : 0;
            if (lane == 0) { wsum[par + hw * 3] = n1; wsum[par + hw * 3 + 1] = n0; wsum[par + hw * 3 + 2] = n3; }
            __syncthreads();
            int t1 = 0, t0 = 0, t3 = 0;
#pragma unroll
            for (int q = 0; q < 4; ++q) { t1 += wsum[par + q * 3]; t0 += wsum[par + q * 3 + 1]; t3 += wsum[par + q * 3 + 2]; }
            if (bit == 30) { if (t1 >= CAP) prefix = c1; }
            else if (t1 >= CAP) prefix = (t3 >= CAP) ? c3 : c1;
            else if (t0 >= CAP) prefix = c0;
        }
        const unsigned thr = prefix;
        int cgt = 0, ceq = 0;
#pragma unroll
        for (int j = 0; j < 8; ++j) { cgt += (kk[j] > thr) ? 1 : 0; ceq += (kk[j] == thr) ? 1 : 0; }
        int ngt; (void)half_excl_scan(cgt, lane, hw, wsum + 32, &ngt);
        const int need = CAP - ngt;
        int neq; int eqr = half_excl_scan(ceq, lane, hw, wsum + 36, &neq);
        bool sel[8]; int cs = 0;
#pragma unroll
        for (int j = 0; j < 8; ++j) { const bool eq = kk[j] == thr; sel[j] = (kk[j] > thr) || (eq && eqr < need); eqr += eq ? 1 : 0; cs += sel[j] ? 1 : 0; }
        int nsel; int sb = half_excl_scan(cs, lane, hw, wsum + 40, &nsel);
        if (live) {
#pragma unroll
            for (int j = 0; j < 8; ++j) { const int i = 8 * ht + j;
                slot[((size_t)b * SEQ + i) * 16 + e] = sel[j] ? sb : -1;
                if (sel[j]) { seli[u * CAP + sb] = i; selg[u * CAP + sb] = __uint_as_float(kk[j]); selr[u * CAP + sb] = rsv[j]; ++sb; } }
        }
    }
    __syncthreads();
    {
        const int gw = blockIdx.x * 8 + wave, NGW = gridDim.x * 8;
        LAS float* scr = (LAS float*)(lds + 4096 + wave * 8448);
        bf16_t* WguT = (bf16_t*)(ws + WS_WGU); bf16_t* WdT = (bf16_t*)(ws + WS_WD);
        constexpr int I_E = 16 * 32 * 16;
        for (int it = gw; it < 3 * I_E; it += NGW) {
            const int which = it / I_E; const int r = it - which * I_E;
            const int e = r / 512, kb = (r % 512) / 32, nb = r % 32;
            const size_t wofs = ((size_t)l * NEXP + e) * DM * DM;
#if MOE_F8
            if (which == 0)      transpose_item_f8(P.moe_wg + wofs, DM, 64 * kb, 32 * nb, (unsigned char*)WguT, e * 2048 + ((32 * nb) >> 7) * 256 + ((32 * nb) & 127), 64.0f, scr, lane);
            else if (which == 1) transpose_item_f8(P.moe_wu + wofs, DM, 64 * kb, 32 * nb, (unsigned char*)WguT, e * 2048 + ((32 * nb) >> 7) * 256 + 128 + ((32 * nb) & 127), 64.0f, scr, lane);
            else                 transpose_item_f8(P.moe_wd + wofs, DM, 64 * kb, 32 * nb, (unsigned char*)WdT, e * 1024 + 32 * nb, 64.0f, scr, lane);
#else
            if (which == 0)      transpose_item(P.moe_wg + wofs, DM, 64 * kb, 32 * nb, WguT, e * 2048 + ((32 * nb) >> 7) * 256 + ((32 * nb) & 127), 1.0f, scr, lane);
            else if (which == 1) transpose_item(P.moe_wu + wofs, DM, 64 * kb, 32 * nb, WguT, e * 2048 + ((32 * nb) >> 7) * 256 + 128 + ((32 * nb) & 127), 1.0f, scr, lane);
            else                 transpose_item(P.moe_wd + wofs, DM, 64 * kb, 32 * nb, WdT, e * 1024 + 32 * nb, 1.0f, scr, lane);
#endif
        }
    }
}

DI bf16x8 mk8(unsigned a, unsigned b, unsigned c, unsigned d) { u32x4 v = {a, b, c, d}; return __builtin_bit_cast(bf16x8, v); }
DI bf16x8 cat44(u32x2 lo, u32x2 hi) { u32x4 v = {lo.x, lo.y, hi.x, hi.y}; return __builtin_bit_cast(bf16x8, v); }
DI u32x4 ldg16(const void* ub, unsigned off) { return *(const u32x4*)((const char*)ub + off); }
DI u32x2 ldg8(const void* ub, unsigned off) { return *(const u32x2*)((const char*)ub + off); }
DI void stg2(void* ub, unsigned off, unsigned short v) { *(unsigned short*)((char*)ub + off) = v; }
DI int crow(int reg, int hh) { return (reg & 3) + 8 * (reg >> 2) + 4 * hh; }
#define PACK_STEP(x, s) mk8(pk2((x)[8 * (s)], (x)[8 * (s) + 1]), pk2((x)[8 * (s) + 2], (x)[8 * (s) + 3]), pk2((x)[8 * (s) + 4], (x)[8 * (s) + 5]), pk2((x)[8 * (s) + 6], (x)[8 * (s) + 7]))

#ifndef TPROBE
#define TPROBE 0
#endif
#ifndef TPWAVE
#define TPWAVE 0
#endif
#define TP_T() ({ asm volatile("" ::: "memory"); unsigned _t = (unsigned)__builtin_amdgcn_s_memrealtime(); asm volatile("" ::: "memory"); _t; })
#define TP_B(k) unsigned _tp##k = 0; if (TPROBE == (k) || ((k) == 1 && TPROBE)) _tp##k = TP_T();
#define TP_E(k) if ((k) == 1 && TPROBE) ttot += TP_T() - _tp##k; else if (TPROBE == (k)) tacc += TP_T() - _tp##k;
#ifndef HYD
#define HYD 4
#endif
DI void hyena_unit(const Params& P, int c, LAS unsigned char* lds) {
    const int tid = tid_opaque(P.wv), lane = tid & 63, w = __builtin_amdgcn_readfirstlane(tid >> 6), r = lane & 31, hh = lane >> 5;
    constexpr int CPS = 8224;
    unsigned char* ws = P.ws; unsigned char* dsc = (unsigned char*)P.out;
    const bf16_t* kf = (const bf16_t*)(ws + WS_KFILT) + (size_t)c * 4096;
    unsigned tacc = 0, ttot = 0;
    TP_B(1)
    __syncthreads();
    TP_B(81)
    {
        const u32x4 a = *(const u32x4*)(kf + 8 * tid), b = (tid < 511) ? *(const u32x4*)(kf + 8 * tid + 8) : (u32x4){0u, 0u, 0u, 0u};
        const unsigned d[9] = {a.x, a.y, a.z, a.w, b.x, b.y, b.z, b.w, 0u};
#pragma unroll
        for (int p = 0; p < 8; ++p) { const int m = p >> 1; u32x4 o;
            if (p & 1) { o.x = __builtin_amdgcn_alignbit(d[m + 1], d[m], 16); o.y = __builtin_amdgcn_alignbit(d[m + 2], d[m + 1], 16); o.z = __builtin_amdgcn_alignbit(d[m + 3], d[m + 2], 16); o.w = __builtin_amdgcn_alignbit(d[m + 4], d[m + 3], 16); }
            else { o.x = d[m]; o.y = d[m + 1]; o.z = d[m + 2]; o.w = d[m + 3]; }
            *(LAS u32x4*)(lds + p * CPS + tid * 16) = o; }
    }
    __syncthreads();
    TP_E(81)
    const bf16_t* hw = (const bf16_t*)(dsc + DO_HW) + ((size_t)c * NB + r) * SEQ + 8 * hh;
    f32x16 acc[8];
#pragma unroll
    for (int i = 0; i < 8; ++i)
#pragma unroll
        for (int q = 0; q < 16; ++q) acc[i][q] = 0.f;
    const int p = 7 - (r & 7);
    const LAS unsigned char* abase = lds + p * CPS + (2047 - 256 * w - r + 8 * hh - p) * 2;
    LAS unsigned char* Bt = lds + 8 * CPS;
    const bf16_t* hws = (const bf16_t*)(dsc + DO_HW) + ((size_t)c * NB + (tid >> 4)) * SEQ + 4 * (tid & 15);
    const unsigned bwo = (unsigned)((tid >> 4) * 144 + (tid & 15) * 8), bro = (unsigned)(r * 144 + 16 * hh);
    TP_B(82)
    u32x2 bpre[HYD];
#pragma unroll
    for (int d = 0; d < HYD; ++d) bpre[d] = *(const u32x2*)(hws + 64 * d);
    *(LAS u32x2*)(Bt + bwo) = bpre[0];
    __syncthreads();
#pragma unroll 1
    for (int s8 = 0; s8 < SEQ; s8 += 64 * HYD) {
#pragma unroll
        for (int d = 0; d < HYD; ++d) { const int sb = s8 + 64 * d;
            if (sb + 64 < SEQ) *(LAS u32x2*)(Bt + ((d + 1) & 1) * 4608 + bwo) = bpre[(d + 1) % HYD];
            if (sb + 64 * HYD < SEQ) bpre[d] = *(const u32x2*)(hws + sb + 64 * HYD);
#pragma unroll
            for (int j = 0; j < 4; ++j) { const int s0 = sb + 16 * j; const bf16x8 bfr = *(const LAS bf16x8*)(Bt + (d & 1) * 4608 + bro + 32 * j);
#pragma unroll
                for (int i = 0; i < 8; ++i) { const bf16x8 afr = *(const LAS bf16x8*)(abase + (s0 - 32 * i) * 2); acc[i] = MFMA32(afr, bfr, acc[i]); }
                __builtin_amdgcn_sched_barrier(0); }
            __syncthreads(); }
    }
    TP_E(82)
    TP_B(83)
    const bf16_t* hx = (const bf16_t*)(dsc + DO_HX0) + ((size_t)c * NB + r) * SEQ;
    bf16_t* ya = (bf16_t*)(dsc + DO_YAT) + ((size_t)c * NB + r) * SEQ;
#pragma unroll
    for (int i = 0; i < 8; ++i)
#pragma unroll
        for (int g = 0; g < 4; ++g) { const int t = 256 * w + 32 * i + 8 * g + 4 * hh;
            const u32x2 xv = *(const u32x2*)(hx + t);
            u32x2 o; o.x = pk2(acc[i][4 * g] * bflo(xv.x), acc[i][4 * g + 1] * bfhi(xv.x)); o.y = pk2(acc[i][4 * g + 2] * bflo(xv.y), acc[i][4 * g + 3] * bfhi(xv.y));
            *(u32x2*)(ya + t) = o; }
    TP_E(83)
    TP_E(1)
    if (TPROBE >= 80 && TPROBE < 90 && lane == 0 && w == (TPWAVE)) { atomicAdd((unsigned*)(ws + WS_CTL) + 512, tacc); atomicAdd((unsigned*)(ws + WS_CTL) + 513, ttot); }
}

DI int t5_bucket(int rel) {
    const int ret = rel > 0 ? 16 : 0; const int n = rel < 0 ? -rel : rel;
    if (n < 8) return ret + n;
    const float nf = (float)n;
    int large = 8 + (int)(logf(nf / 8.0f) / 4.852030263919617f * 8.0f);
    large = large < 15 ? large : 15;
    return ret + large;
}
#ifndef ATT_FAST
#define ATT_FAST 0
#endif
struct AttPass { int d, rho, uq0, nq; };
DI AttPass att_pass(int pp, int Q0, int w) {
    AttPass a;
    if (pp == 0) { a.d = 1; a.rho = 0; a.uq0 = Q0 + 32 * w; a.nq = 32; }
    else if (pp == 1) { a.d = 4; a.rho = w & 3; a.uq0 = (Q0 >> 2) + 32 * (w >> 2); a.nq = 32; }
    else { a.d = 16; a.rho = 2 * w + (pp - 2); a.uq0 = Q0 >> 4; a.nq = 16; }
    return a;
}
DI void attn_unit(const Params& P, int u, LAS unsigned char* lds, int& bias_h) {
    unsigned tacc = 0, ttot = 0;
    const int qb = u & 7, h = (u >> 3) & 3, b = u >> 5;
    const int tid = tid_opaque(P.wv), lane = tid & 63, w = __builtin_amdgcn_readfirstlane(tid >> 6), c = lane & 31, hh = lane >> 5;
    LAS float* Ost = (LAS float*)lds;
    LAS float* Mst = (LAS float*)(lds + 69632);
    LAS float* Lst = Mst + 256;
    LAS float* biasT = (LAS float*)(lds + 69632 + 2048);
    LAS unsigned char* Vr = lds + 69632 + 2048 + 12800 + w * 6144;
    unsigned char* ws = P.ws;
    TP_B(1)
    { TP_B(3) __syncthreads(); TP_E(3) }
    if (bias_h != h) {
        const float* relb = P.rel_bias; asm volatile("" : "+s"(relb));
        for (int i = tid; i < 4 * 768; i += 512) { const int s = i / 768, jx = i - 768 * s; const int pat = jx >> 8, rel = (jx & 255) - 128, dd = pat == 0 ? 1 : (pat == 1 ? 4 : 16);
            biasT[s * 784 + jx + s] = (rel >= -64 && rel <= 64) ? relb[t5_bucket(rel * dd) * 4 + h] * 1.4426950408889634f : -INFINITY; }
        __syncthreads();
        bias_h = h;
    }
    const bf16_t* pb = (const bf16_t*)(ws + WS_PROJ) + (size_t)b * SEQ * NPROJ;
    bf16_t* MIX = (bf16_t*)(ws + WS_HN);
    const int Q0 = qb * 256;
    const int i16 = lane & 15, trq = i16 >> 2, trp = i16 & 3;
    const unsigned troff = (unsigned)((4 * hh + trq) * 192 + (16 * ((lane >> 4) & 1) + 4 * trp) * 2);
    const int r8 = lane >> 3, j8 = lane & 7;
#define ATT_LOAD(KF, VR, KT, AP) do { const int nsub_ = SEQ / (AP).d, tlo_ = (AP).uq0 - 64 + 32 * (KT); \
        if (ATT_FAST && tlo_ >= 0 && tlo_ + 31 < nsub_) {                   \
            const unsigned lo_ = (unsigned)(r8 * (AP).d * NPROJ + 8 * j8) * 2u; \
            _Pragma("unroll") for (int i = 0; i < 4; ++i) { const bf16_t* b_ = pb + (size_t)(((tlo_ + 8 * i) * (AP).d + (AP).rho) * NPROJ + h * 64); \
                KF[i] = __builtin_bit_cast(bf16x8, ldg16(b_ + PC_AK, lo_)); VR[i] = ldg16(b_ + PC_AV, lo_); } \
        } else { \
            _Pragma("unroll") for (int i = 0; i < 4; ++i) { const int ukr_ = tlo_ + 8 * i + r8; const int ukc_ = ukr_ < 0 ? 0 : (ukr_ >= nsub_ ? nsub_ - 1 : ukr_); \
                const unsigned ko_ = (unsigned)((ukc_ * (AP).d + (AP).rho) * NPROJ + h * 64 + 8 * j8) * 2u; \
                KF[i] = __builtin_bit_cast(bf16x8, ldg16(pb + PC_AK, ko_)); VR[i] = ldg16(pb + PC_AV, ko_); } } } while (0)
#define ATT_TILE(KF, VR, KT, NEXTLOAD) do { const int kt = (KT); \
        bf16x8 kq_[4]; \
        f32x16 st;                                                          \
        _Pragma("unroll") for (int g = 0; g < 4; ++g) { const f32x4 bv_ = *(const LAS f32x4*)(tb4 + 32 * kt + 8 * g); st[4 * g] = bv_.x; st[4 * g + 1] = bv_.y; st[4 * g + 2] = bv_.z; st[4 * g + 3] = bv_.w; } \
        _Pragma("unroll") for (int i = 0; i < 4; ++i) *(LAS bf16x8*)(Vr + (8 * i + r8) * 144 + 16 * j8) = KF[i]; \
        _Pragma("unroll") for (int ks = 0; ks < 4; ++ks) kq_[ks] = *(const LAS bf16x8*)(Vr + c * 144 + 32 * ks + 16 * hh); \
        _Pragma("unroll") for (int i = 0; i < 4; ++i) *(LAS u32x4*)(Vr + (8 * i + r8) * 192 + 16 * j8) = VR[i]; \
        _Pragma("unroll") for (int ks = 0; ks < 4; ++ks) st = MFMA32(kq_[ks], qf[ks], st); \
        NEXTLOAD; \
        float tmax = -INFINITY; float lg[16]; \
        { const int tlo = uk0 + 32 * kt; \
          if (tlo >= 0 && tlo + 31 < nsub) { \
            _Pragma("unroll") for (int q = 0; q < 16; ++q) { lg[q] = st[q]; tmax = fmaxf(tmax, lg[q]); } \
          } else { \
            _Pragma("unroll") for (int q = 0; q < 16; ++q) { const int uk = tlo + crow(q, hh); lg[q] = (uk >= 0 && uk < nsub) ? st[q] : -INFINITY; tmax = fmaxf(tmax, lg[q]); } \
          } } \
        tmax = xhalf_max(tmax); \
        if (__any(tmax > mrun + 8.0f)) { const float mnew = fmaxf(mrun, tmax), alpha = __builtin_amdgcn_exp2f(mrun - mnew); lrun *= alpha; mrun = mnew; \
            _Pragma("unroll") for (int dt = 0; dt < 2; ++dt) _Pragma("unroll") for (int q = 0; q < 16; ++q) OT[dt][q] *= alpha; } \
        float psum = 0.f; \
        _Pragma("unroll") for (int q = 0; q < 16; ++q) { lg[q] = __builtin_amdgcn_exp2f(lg[q] - mrun); psum += lg[q]; } \
        lrun += xhalf_sum(psum); \
        LDS_WAIT(); \
        _Pragma("unroll") for (int s = 0; s < 2; ++s) { const bf16x8 pf = PACK_STEP(lg, s); \
            _Pragma("unroll") for (int dt = 0; dt < 2; ++dt) { \
                const s16x4 lo = __builtin_amdgcn_ds_read_tr16_b64_v4i16((LAS s16x4*)(Vr + troff + (16 * s) * 192 + 64 * dt)); \
                const s16x4 hi = __builtin_amdgcn_ds_read_tr16_b64_v4i16((LAS s16x4*)(Vr + troff + (16 * s + 8) * 192 + 64 * dt)); \
                OT[dt] = MFMA32(__builtin_shufflevector(lo, hi, 0, 1, 2, 3, 4, 5, 6, 7), pf, OT[dt]); } } \
        LDS_WAIT(); } while (0)
    bf16x8 kfA[4], kfB[4]; u32x4 vrA[4], vrB[4];
    bf16x8 qnext[4];
    { const AttPass a0 = att_pass(0, Q0, w);
      ATT_LOAD(kfA, vrA, 0, a0); ATT_LOAD(kfB, vrB, 1, a0);
      const int qpos0 = a0.uq0 + c;
#pragma unroll
      for (int ks = 0; ks < 4; ++ks) qnext[ks] = *(const bf16x8*)(pb + (size_t)qpos0 * NPROJ + PC_AQ + h * 64 + 16 * ks + 8 * hh); }
    auto pass = [&](const int pp, bf16x8 (&kf0)[4], u32x4 (&vr0)[4], bf16x8 (&kf1)[4], u32x4 (&vr1)[4]) __attribute__((always_inline)) {
        const int pat = pp < 2 ? pp : 2;
        const AttPass ap = att_pass(pp, Q0, w), an = att_pass(pp < 3 ? pp + 1 : 3, Q0, w);
        const int d = ap.d, rho = ap.rho, uq0 = ap.uq0, nq = ap.nq;
        const int uk0 = uq0 - 64, nsub = SEQ / d;
        const int cq = (c < nq) ? c : c - nq;
        const int qpos = (uq0 + cq) * d + rho, ql = qpos - Q0;
        const LAS float* tb4 = biasT + (cq & 3) * 784 + pat * 256 + (64 - cq + 4 * hh + (cq & 3));
        bf16x8 qf[4];
#pragma unroll
        for (int ks = 0; ks < 4; ++ks) qf[ks] = qnext[ks];
        if (pp < 3) {
            const int cq2 = (c < an.nq) ? c : c - an.nq; const int qpos2 = (an.uq0 + cq2) * an.d + an.rho;
#pragma unroll
            for (int ks = 0; ks < 4; ++ks) qnext[ks] = *(const bf16x8*)(pb + (size_t)qpos2 * NPROJ + PC_AQ + h * 64 + 16 * ks + 8 * hh); }
        float mrun = -1.0e30f, lrun = 0.f; f32x16 OT[2];
#pragma unroll
        for (int dt = 0; dt < 2; ++dt)
#pragma unroll
            for (int q = 0; q < 16; ++q) OT[dt][q] = 0.f;
        if (pat != 0) { mrun = Mst[ql]; lrun = Lst[ql];
#pragma unroll
            for (int dt = 0; dt < 2; ++dt)
#pragma unroll
                for (int g = 0; g < 4; ++g) { const f32x4 v = *(const LAS f32x4*)(Ost + ql * 68 + 32 * dt + 8 * g + 4 * hh);
                    OT[dt][4 * g] = v.x; OT[dt][4 * g + 1] = v.y; OT[dt][4 * g + 2] = v.z; OT[dt][4 * g + 3] = v.w; } }
        { TP_B(2)
        ATT_TILE(kf0, vr0, 0, ATT_LOAD(kf0, vr0, 2, ap)); ATT_TILE(kf1, vr1, 1, ATT_LOAD(kf1, vr1, 3, ap)); ATT_TILE(kf0, vr0, 2, ATT_LOAD(kf0, vr0, 4, ap));
        ATT_TILE(kf1, vr1, 3, if (pp < 3) { AttPass an_ = an; asm volatile("" : "+s"(an_.d), "+s"(an_.rho), "+s"(an_.uq0)); ATT_LOAD(kf1, vr1, 0, an_); });
        ATT_TILE(kf0, vr0, 4, if (pp < 3) { AttPass an_ = an; asm volatile("" : "+s"(an_.d), "+s"(an_.rho), "+s"(an_.uq0)); ATT_LOAD(kf0, vr0, 1, an_); });
        TP_E(2) }
        if (pat != 2) {
            if (hh == 0) { Mst[ql] = mrun; Lst[ql] = lrun; }
#pragma unroll
            for (int dt = 0; dt < 2; ++dt)
#pragma unroll
                for (int g = 0; g < 4; ++g) *(LAS f32x4*)(Ost + ql * 68 + 32 * dt + 8 * g + 4 * hh) = (f32x4){OT[dt][4 * g], OT[dt][4 * g + 1], OT[dt][4 * g + 2], OT[dt][4 * g + 3]};
        } else if (c < 16) {
            const float inv = __builtin_amdgcn_rcpf(lrun);
            bf16_t* orow = MIX + ((size_t)b * SEQ + qpos) * DM + 512 + h * 64;
#pragma unroll
            for (int dt = 0; dt < 2; ++dt)
#pragma unroll
                for (int g = 0; g < 4; ++g) { u32x2 o; o.x = pk2(OT[dt][4 * g] * inv, OT[dt][4 * g + 1] * inv); o.y = pk2(OT[dt][4 * g + 2] * inv, OT[dt][4 * g + 3] * inv);
                    *(u32x2*)(orow + 32 * dt + 8 * g + 4 * hh) = o; }
        }
        { TP_B(3) if (pp < 2) __syncthreads(); TP_E(3) }
    };
#pragma unroll 1
    for (int p2 = 0; p2 < 2; ++p2) { pass(2 * p2, kfA, vrA, kfB, vrB); pass(2 * p2 + 1, kfB, vrB, kfA, vrA); }
#undef ATT_LOAD
#undef ATT_TILE
    TP_E(1)
    if (TPROBE && TPROBE < 10 && (tid & 63) == 0 && w == (TPWAVE)) { atomicAdd((unsigned*)(ws + WS_CTL) + 512, tacc); atomicAdd((unsigned*)(ws + WS_CTL) + 513, ttot); }
}

DI float softplus_f(float x) { return x > 15.f ? x : __logf(1.0f + __expf(x)); }
DI unsigned short hsel(const u32x4& v, int c) { const unsigned w = (c >> 1) == 0 ? v.x : ((c >> 1) == 1 ? v.y : ((c >> 1) == 2 ? v.z : v.w)); return (unsigned short)((c & 1) ? (w >> 16) : (w & 0xffffu)); }
DI void mamba_unit(const Params& P, int l, int u, LAS unsigned char* lds) {
    const int dir = u & 1, h = (u >> 1) & 3, b = u >> 3, g = h >> 1;
    const int tid = tid_opaque(P.wv), lane_f = tid & 63, w = __builtin_amdgcn_readfirstlane(tid >> 6);
    LAS unsigned char* wl = lds + w * 15616;
    LAS unsigned short* xdT = (LAS unsigned short*)wl;
    LAS unsigned short* xwT = xdT + 64 * 40;
    LAS unsigned short* BT = xwT + 64 * 40;
    LAS float* dtv = (LAS float*)(wl + 15360);
    LAS float* acum = dtv + 32;
    LAS float* Atot = (LAS float*)(lds + 8 * 15616);
    unsigned char* ws = P.ws; unsigned char* dsc = (unsigned char*)P.out;
    const bf16_t* xbc = (const bf16_t*)(dsc + DO_MXBC) + (size_t)b * SEQ * 512;
    const float* dtr = (const float*)(ws + WS_DT) + (size_t)b * SEQ * 8 + dir * 4 + h;
    bf16_t* MYD = (bf16_t*)(dir ? (ws + WS_MYB) : (dsc + DO_MY)) + (size_t)b * SEQ * 256 + h * 64;
    float* stsc = (float*)(dsc + DO_MST) + (size_t)u * (8 * 4096);
    const float dtb = P.m_dt_bias[l * 8 + dir * 4 + h], Aneg = -expf(P.m_A_log[l * 8 + dir * 4 + h]);
    __syncthreads();
#define MTK(c0, j) (dir ? (c0) + 31 - (j) : (c0) + (j))
#define MCH(ci) (256 * w + 32 * (dir ? 7 - (ci) : (ci)))
#pragma unroll 1
    for (int pass = 0; pass < 2; ++pass) {
        int lane_p = lane_f; asm volatile("" : "+v"(lane_p));
        const int lane = lane_p, c32 = lane_p & 31, hh = lane_p >> 5, tg = lane_p >> 3, cg = lane_p & 7;
        f32x16 ST[2][2];
#pragma unroll
        for (int a = 0; a < 2; ++a)
#pragma unroll
            for (int q = 0; q < 2; ++q)
#pragma unroll
                for (int i = 0; i < 16; ++i) ST[a][q][i] = 0.f;
        if (pass == 1) {
            const int nv = dir ? 7 - w : w;
            for (int k = 0; k < nv; ++k) { const int v = dir ? 7 - k : k; const float dec = Atot[v];
                const f32x4* sp = (const f32x4*)(stsc + (size_t)v * 4096 + lane * 64);
#pragma unroll
                for (int a = 0; a < 2; ++a)
#pragma unroll
                    for (int q = 0; q < 2; ++q)
#pragma unroll
                        for (int i4 = 0; i4 < 4; ++i4) { const f32x4 t = sp[(a * 2 + q) * 4 + i4];
                            ST[a][q][4 * i4] = ST[a][q][4 * i4] * dec + t.x; ST[a][q][4 * i4 + 1] = ST[a][q][4 * i4 + 1] * dec + t.y; ST[a][q][4 * i4 + 2] = ST[a][q][4 * i4 + 2] * dec + t.z; ST[a][q][4 * i4 + 3] = ST[a][q][4 * i4 + 3] * dec + t.w; } }
        }
        float atot = 0.f;
        u32x4 rx[4], rB[4]; float rdt;
        { const int c0 = MCH(0);
#pragma unroll
          for (int i = 0; i < 4; ++i) { const unsigned ro = (unsigned)(MTK(c0, 4 * tg + i) * 512 + 8 * cg) * 2u; rx[i] = ldg16(xbc + h * 64, ro); rB[i] = ldg16(xbc + 256 + g * 64, ro); }
          rdt = *(const float*)((const char*)dtr + (unsigned)(MTK(c0, c32) * 32)); }
#pragma unroll 1
        for (int ci = 0; ci < 8; ++ci) {
            int lane_i = lane; asm volatile("" : "+v"(lane_i));
            const int c32 = lane_i & 31, hh = lane_i >> 5, tg = lane_i >> 3, cg = lane_i & 7;
            const int c0 = MCH(ci);
            {
                const float dt = softplus_f(rdt + dtb);
                float ac = dt * Aneg;
#pragma unroll
                for (int o = 1; o < 32; o <<= 1) { const float t = __shfl_up(ac, o, 32); if (c32 >= o) ac += t; }
                if (lane < 32) { dtv[c32] = dt; acum[c32] = ac; }
            }
            LDS_WAIT();
            const float aend = acum[31];
            {
                const f32x4 d4 = *(const LAS f32x4*)(dtv + 4 * tg), a4 = *(const LAS f32x4*)(acum + 4 * tg);
                const float dj[4] = {d4.x, d4.y, d4.z, d4.w};
                const float wj[4] = {__expf(aend - a4.x), __expf(aend - a4.y), __expf(aend - a4.z), __expf(aend - a4.w)};
#pragma unroll
                for (int c = 0; c < 8; ++c) {
                    float xd[4]; unsigned short bb[4];
#pragma unroll
                    for (int i = 0; i < 4; ++i) { xd[i] = bf2f(hsel(rx[i], c)) * dj[i]; bb[i] = hsel(rB[i], c); }
                    *(LAS u32x2*)(xdT + (8 * cg + c) * 40 + 4 * tg) = (u32x2){pk2(xd[0], xd[1]), pk2(xd[2], xd[3])};
                    *(LAS u32x2*)(xwT + (8 * cg + c) * 40 + 4 * tg) = (u32x2){pk2(xd[0] * wj[0], xd[1] * wj[1]), pk2(xd[2] * wj[2], xd[3] * wj[3])};
                    *(LAS u32x2*)(BT + (8 * cg + c) * 40 + 4 * tg) = (u32x2){(unsigned)bb[0] | ((unsigned)bb[1] << 16), (unsigned)bb[2] | ((unsigned)bb[3] << 16)};
                }
            }
            if (ci < 7) { const int c1 = MCH(ci + 1);
#pragma unroll
                for (int i = 0; i < 4; ++i) { const unsigned ro = (unsigned)(MTK(c1, 4 * tg + i) * 512 + 8 * cg) * 2u; rx[i] = ldg16(xbc + h * 64, ro); rB[i] = ldg16(xbc + 256 + g * 64, ro); }
                rdt = *(const float*)((const char*)dtr + (unsigned)(MTK(c1, c32) * 32)); }
            LDS_WAIT();
            if (pass == 1) {
                const unsigned bro = (unsigned)(MTK(c0, c32) * 512 + 8 * hh) * 2u;
                f32x16 GT;
#pragma unroll
                for (int i = 0; i < 16; ++i) GT[i] = 0.f;
#pragma unroll
                for (int ks = 0; ks < 4; ++ks) GT = MFMA32(__builtin_bit_cast(bf16x8, ldg16(xbc + 256 + g * 64 + 16 * ks, bro)), __builtin_bit_cast(bf16x8, ldg16(xbc + 384 + g * 64 + 16 * ks, bro)), GT);
                const float acl = acum[c32];
#pragma unroll
                for (int i = 0; i < 16; ++i) { const int s = crow(i, hh); GT[i] = (s <= c32) ? GT[i] * __expf(acl - acum[s]) : 0.f; }
                f32x16 Y[2];
#pragma unroll
                for (int pt = 0; pt < 2; ++pt)
#pragma unroll
                    for (int i = 0; i < 16; ++i) Y[pt][i] = 0.f;
#pragma unroll
                for (int s = 0; s < 2; ++s) { const bf16x8 pa = PACK_STEP(GT, s);
#pragma unroll
                    for (int pt = 0; pt < 2; ++pt) { const LAS unsigned short* xr = xdT + (32 * pt + c32) * 40 + 16 * s + 4 * hh;
                        Y[pt] = MFMA32(pa, cat44(*(const LAS u32x2*)xr, *(const LAS u32x2*)(xr + 8)), Y[pt]); } }
                const unsigned cro = (unsigned)(MTK(c0, c32) * 512 + 4 * hh) * 2u;
                const float el = __expf(acl);
#pragma unroll
                for (int nt = 0; nt < 2; ++nt)
#pragma unroll
                    for (int s = 0; s < 2; ++s) { const u32x2 clo = ldg8(xbc + 384 + g * 64 + 32 * nt + 16 * s, cro), chi = ldg8(xbc + 384 + g * 64 + 32 * nt + 16 * s + 8, cro);
                        const bf16x8 ca = mk8(pk2(bflo(clo.x) * el, bfhi(clo.x) * el), pk2(bflo(clo.y) * el, bfhi(clo.y) * el), pk2(bflo(chi.x) * el, bfhi(chi.x) * el), pk2(bflo(chi.y) * el, bfhi(chi.y) * el));
#pragma unroll
                        for (int pt = 0; pt < 2; ++pt) Y[pt] = MFMA32(ca, PACK_STEP(ST[nt][pt], s), Y[pt]); }
#pragma unroll
                for (int i = 0; i < 16; ++i) { const unsigned oo = (unsigned)(MTK(c0, crow(i, hh)) * 256 + c32) * 2u; stg2(MYD, oo, f2bf(Y[0][i])); stg2(MYD + 32, oo, f2bf(Y[1][i])); }
            }
            {
                const float de = __expf(aend);
#pragma unroll
                for (int nt = 0; nt < 2; ++nt)
#pragma unroll
                    for (int pt = 0; pt < 2; ++pt)
#pragma unroll
                        for (int i = 0; i < 16; ++i) ST[nt][pt][i] *= de;
#pragma unroll
                for (int s = 0; s < 2; ++s)
#pragma unroll
                    for (int nt = 0; nt < 2; ++nt) { const bf16x8 ba = *(const LAS bf16x8*)(BT + (32 * nt + c32) * 40 + 16 * s + 8 * hh);
#pragma unroll
                        for (int pt = 0; pt < 2; ++pt) ST[nt][pt] = MFMA32(ba, *(const LAS bf16x8*)(xwT + (32 * pt + c32) * 40 + 16 * s + 8 * hh), ST[nt][pt]); }
            }
            atot += aend;
            LDS_WAIT();
        }
        if (pass == 0) {
            f32x4* sp = (f32x4*)(stsc + (size_t)w * 4096 + lane * 64);
#pragma unroll
            for (int a = 0; a < 2; ++a)
#pragma unroll
                for (int q = 0; q < 2; ++q)
#pragma unroll
                    for (int i4 = 0; i4 < 4; ++i4) sp[(a * 2 + q) * 4 + i4] = (f32x4){ST[a][q][4 * i4], ST[a][q][4 * i4 + 1], ST[a][q][4 * i4 + 2], ST[a][q][4 * i4 + 3]};
            if (lane == 0) Atot[w] = __expf(atot);
            VM_WAIT(); __syncthreads();
        }
    }
#undef MTK
#undef MCH
    __syncthreads();
}

DI void hgrn_unit(const Params& P, int l, int u, LAS unsigned char* lds) {
    const int dir = u & 1, h = (u >> 1) & 3, b = u >> 3;
    const int tid = tid_opaque(P.wv), lane_f = tid & 63, w = __builtin_amdgcn_readfirstlane(tid >> 6);
    LAS unsigned char* wl = lds + w * 15104;
    LAS unsigned short* qd = (LAS unsigned short*)wl;
    LAS unsigned short* kd = qd + 32 * 72;
    LAS unsigned short* vT = kd + 32 * 72;
    LAS float* eref = (LAS float*)(wl + 14336);
    LAS float* eglr = eref + 64;
    LAS float* egl = eglr + 64;
    LAS float* lbt = (LAS float*)(lds + 8 * 15104 + 2048 + w * 512);
    LAS float* gsum = lbt + 64;
    LAS float* Atot = (LAS float*)(lds + 8 * 15104);
    unsigned char* ws = P.ws; unsigned char* dsc = (unsigned char*)P.out;
    const bf16_t* proj = (const bf16_t*)(ws + WS_PROJ) + (size_t)b * SEQ * NPROJ;
    bf16_t* OD = (dir ? (bf16_t*)(ws + WS_OB) + (size_t)b * SEQ * 256 + h * 64 : (bf16_t*)(ws + WS_HN) + (size_t)b * SEQ * DM + 768 + h * 64);
    const int ostride = dir ? 256 : DM;
    float* stsc = (float*)(dsc + DO_HST) + (size_t)u * (8 * 4096);
    __syncthreads();
    { float lb = 0.f;
      if (l == 1) { const float h0 = P.hg_lb[(0 * 2 + dir) * 256 + h * 64 + lane_f], h1 = P.hg_lb[(1 * 2 + dir) * 256 + h * 64 + lane_f]; lb = 1.0f / (1.0f + expf(h0 - h1)); }
      lbt[lane_f] = lb; }
    LDS_WAIT();
#define HTK(c0, j) (dir ? (c0) + 31 - (j) : (c0) + (j))
#define HCH(ci) (256 * w + 32 * (dir ? 7 - (ci) : (ci)))
#pragma unroll 1
    for (int pass = 0; pass < 2; ++pass) {
        int lane_p = lane_f; asm volatile("" : "+v"(lane_p));
        const int lane = lane_p, c32 = lane_p & 31, hh = lane_p >> 5, tg = lane_p >> 3, cg = lane_p & 7;
        f32x16 S[2][2];
#pragma unroll
        for (int a = 0; a < 2; ++a)
#pragma unroll
            for (int q = 0; q < 2; ++q)
#pragma unroll
                for (int i = 0; i < 16; ++i) S[a][q][i] = 0.f;
        if (pass == 1) {
            const int nv = dir ? 7 - w : w;
            for (int k = 0; k < nv; ++k) { const int v = dir ? 7 - k : k; const LAS float* at = Atot + v * 64;
                const f32x4* sp = (const f32x4*)(stsc + (size_t)v * 4096 + lane * 64);
#pragma unroll
                for (int a = 0; a < 2; ++a)
#pragma unroll
                    for (int i4 = 0; i4 < 4; ++i4) { const f32x4 dec = *(const LAS f32x4*)(at + 32 * a + 8 * i4 + 4 * hh);
#pragma unroll
                        for (int q = 0; q < 2; ++q) { const f32x4 t = sp[(a * 2 + q) * 4 + i4];
                            S[a][q][4 * i4] = S[a][q][4 * i4] * dec.x + t.x; S[a][q][4 * i4 + 1] = S[a][q][4 * i4 + 1] * dec.y + t.y; S[a][q][4 * i4 + 2] = S[a][q][4 * i4 + 2] * dec.z + t.z; S[a][q][4 * i4 + 3] = S[a][q][4 * i4 + 3] * dec.w + t.w; } } }
        }
        gsum[lane] = 1.0f;
        u32x4 rf[4], rq[4];
        { const int c0 = HCH(0);
#pragma unroll
          for (int i = 0; i < 4; ++i) { const unsigned ro = (unsigned)(HTK(c0, 4 * tg + i) * NPROJ + 8 * cg) * 2u;
              rf[i] = ldg16(proj + PC_HF + dir * 256 + h * 64, ro); rq[i] = (pass == 1) ? ldg16(proj + PC_HQ + h * 64, ro) : (u32x4){0u, 0u, 0u, 0u}; } }
#pragma unroll 1
        for (int ci = 0; ci < 8; ++ci) {
            int lane_i = lane; asm volatile("" : "+v"(lane_i));
            const int c32 = lane_i & 31, hh = lane_i >> 5, tg = lane_i >> 3, cg = lane_i & 7;
            const int c0 = HCH(ci);
            {
                float qprev[4], kprev[4];
                u32x4 rv[4];
#pragma unroll
                for (int i = 0; i < 4; ++i) { const unsigned ro = (unsigned)(HTK(c0, 4 * tg + i) * NPROJ + 8 * cg) * 2u; rv[i] = ldg16(proj + PC_HI + h * 64, ro); }
                const f32x4 lb0 = *(const LAS f32x4*)(lbt + 8 * cg), lb1 = *(const LAS f32x4*)(lbt + 8 * cg + 4);
                const float lbv[8] = {lb0.x, lb0.y, lb0.z, lb0.w, lb1.x, lb1.y, lb1.z, lb1.w};
#pragma unroll
                for (int c = 0; c < 8; ++c) {
                    const float lb = lbv[c], oml = 1.0f - lb;
                    float pl[4], kr[4];
#pragma unroll
                    for (int i = 0; i < 4; ++i) { const float fpre = bf2f(hsel(rf[i], c)); const float en = __expf(-fpre), sg = __builtin_amdgcn_rcpf(1.0f + en);
                        const float ff = lb + oml * sg; pl[i] = (i == 0) ? ff : pl[i - 1] * ff; kr[i] = oml * en * sg; }
                    float incl = pl[3];
#pragma unroll
                    for (int o = 8; o < 64; o <<= 1) { const float t = shfl_up_l(incl, o, lane); if (lane >= o) incl *= t; }
                    float excl = shfl_up_l(incl, 8, lane); if (lane < 8) excl = 1.0f;
                    const float pref = __shfl(incl, 24 + cg), plast = __shfl(incl, 56 + cg);
                    const float ipref = __builtin_amdgcn_rcpf(pref);
                    if (tg == 0) { eref[8 * cg + c] = pref; eglr[8 * cg + c] = plast * ipref; egl[8 * cg + c] = plast; gsum[8 * cg + c] *= plast; }
                    float kv[4], qv[4];
#pragma unroll
                    for (int i = 0; i < 4; ++i) { const float pj = excl * pl[i]; kv[i] = kr[i] * pref * __builtin_amdgcn_rcpf(pj);
                        if (pass == 1) { const float qr = bf2f(hsel(rq[i], c)); qv[i] = qr * __builtin_amdgcn_rcpf(1.0f + __expf(-qr)) * pj * ipref; } else qv[i] = 0.f; }
                    if (c & 1) {
#pragma unroll
                        for (int i = 0; i < 4; ++i) { *(LAS unsigned*)(kd + (4 * tg + i) * 72 + 8 * cg + c - 1) = pk2(kprev[i], kv[i]);
                            if (pass == 1) *(LAS unsigned*)(qd + (4 * tg + i) * 72 + 8 * cg + c - 1) = pk2(qprev[i], qv[i]); }
                    } else {
#pragma unroll
                        for (int i = 0; i < 4; ++i) { kprev[i] = kv[i]; qprev[i] = qv[i]; }
                    }
                }
#pragma unroll
                for (int c = 0; c < 8; ++c) { unsigned short vb[4];
#pragma unroll
                    for (int i = 0; i < 4; ++i) vb[i] = hsel(rv[i], c);
                    *(LAS u32x2*)(vT + (8 * cg + c) * 40 + 4 * tg) = (u32x2){(unsigned)vb[0] | ((unsigned)vb[1] << 16), (unsigned)vb[2] | ((unsigned)vb[3] << 16)}; }
            }
            if (ci < 7) { const int c1 = HCH(ci + 1);
#pragma unroll
                for (int i = 0; i < 4; ++i) { const unsigned ro = (unsigned)(HTK(c1, 4 * tg + i) * NPROJ + 8 * cg) * 2u;
                    rf[i] = ldg16(proj + PC_HF + dir * 256 + h * 64, ro); if (pass == 1) rq[i] = ldg16(proj + PC_HQ + h * 64, ro); } }
            LDS_WAIT(); __builtin_amdgcn_sched_barrier(0);
            bf16x8 vperm[2][2];
#pragma unroll
            for (int s = 0; s < 2; ++s)
#pragma unroll
                for (int pt = 0; pt < 2; ++pt) { const LAS unsigned short* vr = vT + (32 * pt + c32) * 40 + 16 * s + 4 * hh; vperm[s][pt] = cat44(*(const LAS u32x2*)vr, *(const LAS u32x2*)(vr + 8)); }
            if (pass == 1) {
                f32x16 SC;
#pragma unroll
                for (int i = 0; i < 16; ++i) SC[i] = 0.f;
#pragma unroll
                for (int ks = 0; ks < 4; ++ks) SC = MFMA32(*(const LAS bf16x8*)(kd + c32 * 72 + 16 * ks + 8 * hh), *(const LAS bf16x8*)(qd + c32 * 72 + 16 * ks + 8 * hh), SC);
#pragma unroll
                for (int i = 0; i < 16; ++i) SC[i] = (crow(i, hh) <= c32) ? SC[i] : 0.f;
                const bf16x8 pa0 = PACK_STEP(SC, 0), pa1 = PACK_STEP(SC, 1);
                bf16x8 qa[2][2];
#pragma unroll
                for (int et = 0; et < 2; ++et)
#pragma unroll
                    for (int s = 0; s < 2; ++s) { const LAS unsigned short* qr = qd + c32 * 72 + 32 * et + 16 * s + 4 * hh; qa[et][s] = cat44(*(const LAS u32x2*)qr, *(const LAS u32x2*)(qr + 8)); }
#pragma unroll
                for (int pt = 0; pt < 2; ++pt) {
                    f32x16 O;
#pragma unroll
                    for (int i = 0; i < 16; ++i) O[i] = 0.f;
                    O = MFMA32(pa0, vperm[0][pt], O); O = MFMA32(pa1, vperm[1][pt], O);
#pragma unroll
                    for (int et = 0; et < 2; ++et)
#pragma unroll
                        for (int s = 0; s < 2; ++s) { const f32x4 e0 = *(const LAS f32x4*)(eref + 32 * et + 16 * s + 4 * hh), e1 = *(const LAS f32x4*)(eref + 32 * et + 16 * s + 8 + 4 * hh);
                            const f32x16& sv = S[et][pt];
                            const bf16x8 sb = mk8(pk2(sv[8 * s] * e0.x, sv[8 * s + 1] * e0.y), pk2(sv[8 * s + 2] * e0.z, sv[8 * s + 3] * e0.w), pk2(sv[8 * s + 4] * e1.x, sv[8 * s + 5] * e1.y), pk2(sv[8 * s + 6] * e1.z, sv[8 * s + 7] * e1.w));
                            O = MFMA32(qa[et][s], sb, O); }
#pragma unroll
                    for (int i = 0; i < 16; ++i) { const unsigned oo = (unsigned)(HTK(c0, crow(i, hh)) * ostride + c32) * 2u; stg2(OD + 32 * pt, oo, f2bf(O[i])); }
                    __builtin_amdgcn_sched_barrier(0);
                }
            }
            __builtin_amdgcn_sched_barrier(0);
            {
#pragma unroll
                for (int et = 0; et < 2; ++et) {
                    f32x16 X;
#pragma unroll
                    for (int i = 0; i < 16; ++i) X[i] = 0.f;
#pragma unroll
                    for (int s = 0; s < 2; ++s) { unsigned idw[4];
#pragma unroll
                        for (int j = 0; j < 4; ++j) { const int k0 = 16 * s + 8 * hh + 2 * j; idw[j] = (k0 == c32 ? 0x3f80u : 0u) | (k0 + 1 == c32 ? 0x3f800000u : 0u); }
                        X = MFMA32(*(const LAS bf16x8*)(kd + c32 * 72 + 32 * et + 16 * s + 8 * hh), mk8(idw[0], idw[1], idw[2], idw[3]), X); }
                    const float sc = eglr[32 * et + c32];
#pragma unroll
                    for (int i = 0; i < 16; ++i) X[i] *= sc;
                    float dg[16];
#pragma unroll
                    for (int i = 0; i < 16; ++i) dg[i] = egl[32 * et + crow(i, hh)];
#pragma unroll
                    for (int pt = 0; pt < 2; ++pt) {
#pragma unroll
                        for (int i = 0; i < 16; ++i) S[et][pt][i] *= dg[i];
#pragma unroll
                        for (int s = 0; s < 2; ++s) S[et][pt] = MFMA32(PACK_STEP(X, s), vperm[s][pt], S[et][pt]); }
                }
            }
            LDS_WAIT();
        }
        if (pass == 0) {
            f32x4* sp = (f32x4*)(stsc + (size_t)w * 4096 + lane * 64);
#pragma unroll
            for (int a = 0; a < 2; ++a)
#pragma unroll
                for (int q = 0; q < 2; ++q)
#pragma unroll
                    for (int i4 = 0; i4 < 4; ++i4) sp[(a * 2 + q) * 4 + i4] = (f32x4){S[a][q][4 * i4], S[a][q][4 * i4 + 1], S[a][q][4 * i4 + 2], S[a][q][4 * i4 + 3]};
            LDS_WAIT(); Atot[w * 64 + lane] = gsum[lane];
            VM_WAIT(); __syncthreads();
        }
    }
#undef HTK
#undef HCH
    __syncthreads();
}

DI void phase_mixers(const Params& P, int l, LAS unsigned char* lds, int G, int bid) {
#ifndef REP_PHASE
#define REP_PHASE -1
#endif
#define MREPS(k) _Pragma("unroll 1") for (int _r = 0; _r < ((REP_PHASE == (k)) ? 2 : 1); ++_r)
    if (EN_HY) MREPS(30) for (int c = bid; c < 256; c += G) hyena_unit(P, c, lds);
    if (EN_AT) MREPS(31) { int bias_h = -1;
        if ((G & 7) == 0) { const int xcd = bid & 7, j = bid >> 3, per = G >> 3;
            for (int base = 0; base < NB * 4 * 8; base += G) { const int u = base + xcd * per + j; if (u < NB * 4 * 8) attn_unit(P, u, lds, bias_h); } }
        else for (int u = bid; u < NB * 4 * 8; u += G) attn_unit(P, u, lds, bias_h); }
    if (EN_MA) MREPS(32) for (int u = bid; u < 256; u += G) mamba_unit(P, l, u, lds);
    if (EN_HG) MREPS(33) for (int u = bid; u < 256; u += G) hgrn_unit(P, l, u, lds);
}

constexpr int N_PHASES = 21;
#if TPROBE >= 40 && TPROBE < 50
#define PCTL , (unsigned*)(ws + WS_CTL)
#else
#define PCTL
#endif
#ifndef REP_PHASE
#define REP_PHASE -1
#endif
#define REPS(k) for (int _rep = 0, _nrep = ((REP_PHASE == (k)) && ((k) != 0 && (k) != 5 || l == 0)) ? 2 : 1; _rep < _nrep; ++_rep)
__global__ void __launch_bounds__(512, 2) fwd_kernel(Params Pin) {
    Params P = Pin; P.wv = __builtin_amdgcn_readfirstlane((int)(threadIdx.x >> 6));
    extern __shared__ __attribute__((aligned(16))) unsigned char lds_raw[];
    LAS unsigned char* lds = (LAS unsigned char*)lds_raw;
    volatile LAS unsigned* MISC = (volatile LAS unsigned*)(lds + LDS_MISC);
    if (threadIdx.x < 64) MISC[threadIdx.x] = 0u;
    __syncthreads();
    unsigned char* ws = P.ws;
    const int lo = P.ph_lo, hi = P.ph_hi;
    XcdBarrier bar; bar.bar = (unsigned*)(ws + WS_CTL) + CW_BAR; bar.x = 0; bar.st = nullptr;
    if (hi - lo > 1) bar = xcd_barrier_post((unsigned*)(ws + WS_CTL) + CW_BAR, MISC + 8);
#define IN(k) (lo <= (k) && (k) < hi)
#ifndef TPSEAM
#define TPSEAM -1
#endif
#if TPROBE == 20
#define SEAM(k) do { if (IN(k) && IN((k) + 1)) { const unsigned _t0 = TP_T(); xcd_barrier(bar); if (TPSEAM < 0 || ((k) % 10) == TPSEAM) gb_wait += TP_T() - _t0; } } while (0)
#else
#define SEAM(k) do { if (IN(k) && IN((k) + 1)) xcd_barrier(bar); } while (0)
#endif
    unsigned gb_wait = 0; const unsigned gb_t0 = TPROBE == 20 ? TP_T() : 0u;
#pragma unroll 1
    for (int l = 0; l < 2; ++l) {
        int G = gridDim.x, bid = blockIdx.x; asm volatile("" : "+s"(G), "+s"(bid));
        const int p0 = 10 * l;
        if (IN(p0 + 0)) { _Pragma("unroll 1") REPS(0) phase_pre(P, l, lds); }
        SEAM(p0 + 0);
        if (IN(p0 + 1)) { _Pragma("unroll 1") REPS(1) {
            pg8::StaticOrder S; S.init(NTOK / 256, NPROJ / 256, G, bid); AddrPlain AD{DM, 0}; EpiProj E{(bf16_t*)(ws + WS_PROJ), (const float*)(ws + WS_MSQ)};
            pg8::gemm_phase(lds, (const char*)(ws + WS_XB), (const char*)(ws + WS_WIN), DM, S, AD, E, P.wv PCTL);
        } }
        SEAM(p0 + 1);
        if (IN(p0 + 2)) { _Pragma("unroll 1") REPS(2) phase_premix(P, l, lds); }
        SEAM(p0 + 2);
        if (IN(p0 + 3)) { _Pragma("unroll 1") REPS(3) phase_mixers(P, l, lds, G, bid); }
        SEAM(p0 + 3);
        if (IN(p0 + 4)) { _Pragma("unroll 1") REPS(4) phase_finalize(P, l); }
        SEAM(p0 + 4);
        if (IN(p0 + 5)) { _Pragma("unroll 1") REPS(5) {
            pg8::StaticOrder S; S.init(NTOK / 256, DM / 256, G, bid); AddrPlain AD{DM, 0}; EpiRes E{nullptr, (const bf16_t*)(ws + WS_XB), (bf16_t*)(ws + WS_XB)};
            pg8::gemm_phase(lds, (const char*)(ws + WS_HN), (const char*)(ws + WS_WOUT), DM, S, AD, E, P.wv PCTL);
        } }
        SEAM(p0 + 5);
        if (IN(p0 + 6)) { if (EN_MOE) { _Pragma("unroll 1") REPS(6) phase_ffnpre(P, l, lds); } }
        SEAM(p0 + 6);
        if (IN(p0 + 7)) { if (EN_MOE) { _Pragma("unroll 1") REPS(7) phase_topk(P, l, lds); } }
        SEAM(p0 + 7);
        if (IN(p0 + 8)) { if (EN_MOE) _Pragma("unroll 1") REPS(8) {
            pg8::StaticOrder S; S.init(NSLOT / 256, 2048 / 256, G, bid);
#if MOE_F8
            AddrGateUp8 AD{(const int*)(ws + WS_SELI)}; EpiGateUp8 E{(unsigned char*)P.out + DO_HDN, (const float*)(ws + WS_SELR)};
            pg8::gemm_phase<EpiGateUp8, pg8::StaticOrder, AddrGateUp8, true>(lds, (const char*)(ws + WS_HN), (const char*)(ws + WS_WGU), DM, S, AD, E, P.wv PCTL);
#else
            AddrGateUp AD{(const int*)(ws + WS_SELI)}; EpiGateUp E{(bf16_t*)((unsigned char*)P.out + DO_HDN), (const float*)(ws + WS_SELR)};
            pg8::gemm_phase(lds, (const char*)(ws + WS_HN), (const char*)(ws + WS_WGU), DM, S, AD, E, P.wv PCTL);
#endif
        } }
        SEAM(p0 + 8);
        if (IN(p0 + 9)) { if (EN_MOE) _Pragma("unroll 1") REPS(9) {
            pg8::StaticOrder S; S.init(NSLOT / 256, DM / 256, G, bid);
#if MOE_F8
            EpiDown E{(bf16_t*)(ws + WS_YE), (const float*)(ws + WS_SELG)};
            AddrDown8 AD{}; pg8::gemm_phase<EpiDown, pg8::StaticOrder, AddrDown8, true>(lds, (const char*)P.out + DO_HDN, (const char*)(ws + WS_WD), DM, S, AD, E, P.wv PCTL);
#else
            EpiDown E{(bf16_t*)(ws + WS_YE), (const float*)(ws + WS_SELG)};
            AddrDown AD{}; pg8::gemm_phase(lds, (const char*)P.out + DO_HDN, (const char*)(ws + WS_WD), DM, S, AD, E, P.wv PCTL);
#endif
        } }
        SEAM(p0 + 9);
    }
#ifdef PROBE_BARS
    if (hi - lo > 1) for (int i = 0; i < PROBE_BARS; ++i) xcd_barrier(bar);
#endif
    if (IN(20)) phase_final(P);
#ifndef TPOFF
#define TPOFF 0.5f
#endif
#if TPROBE == 20
    if (tid_opaque(P.wv) == 0) { atomicAdd((unsigned*)(ws + WS_CTL) + 512, gb_wait); atomicAdd((unsigned*)(ws + WS_CTL) + 513, (TP_T() - gb_t0) / 5u); }
    xcd_barrier(bar);
#endif
#if TPROBE
    __syncthreads();
    if (blockIdx.x == 0 && tid_opaque(P.wv) == 0) {
        const float a = (float)__hip_atomic_load((unsigned*)(ws + WS_CTL) + 512, __ATOMIC_RELAXED, __HIP_MEMORY_SCOPE_AGENT), t = (float)__hip_atomic_load((unsigned*)(ws + WS_CTL) + 513, __ATOMIC_RELAXED, __HIP_MEMORY_SCOPE_AGENT);
        P.out[0] = TPROBE == 99 ? 1.0e6f : (TPROBE == 20 && TPSEAM >= 0) ? (floorf(2.0f * log2f(a / t * 200.0f) + TPOFF) * 1.0e5f) : (floorf(a / t * 20.0f + TPOFF) * 1.0e5f); }
#endif
#undef IN
#undef SEAM
}

#ifndef N_LAUNCH_MODE
#define N_LAUNCH_MODE 1
#endif
extern "C" void kernel_launch(void* const* d_in, const int* in_sizes, int n_in, void* d_out, int out_size, void* d_ws, size_t ws_size, hipStream_t stream) {
    static int grid = 0;
    if (grid == 0) {
        if (n_in != 27 || in_sizes[0] != NTOK * DM || out_size != NTOK * DM || ws_size < WS_END) {
            fprintf(stderr, "kernel_launch: unexpected shapes (n_in %d, in0 %d, out %d, ws %zu, need %zu)\n", n_in, n_in > 0 ? in_sizes[0] : -1, out_size, ws_size, (size_t)WS_END); grid = -1; return; }
        int dev = 0, cus = 0, per_cu = 0;
        if (hipGetDevice(&dev) != hipSuccess || hipDeviceGetAttribute(&cus, hipDeviceAttributeMultiprocessorCount, dev) != hipSuccess) { grid = -1; return; }
        if (hipFuncSetAttribute((const void*)fwd_kernel, hipFuncAttributeMaxDynamicSharedMemorySize, LDS_BYTES) != hipSuccess) { fprintf(stderr, "kernel_launch: hipFuncSetAttribute failed\n"); grid = -1; return; }
        if (hipOccupancyMaxActiveBlocksPerMultiprocessor(&per_cu, (const void*)fwd_kernel, 512, LDS_BYTES) != hipSuccess || per_cu < 1) { fprintf(stderr, "kernel_launch: occupancy query says %d\n", per_cu); (void)hipGetLastError(); }
        grid = cus;
    }
    if (grid < 0) return;
    if (hipMemsetAsync((char*)d_ws + WS_CTL, 0, CTL_ZERO_BYTES, stream) != hipSuccess) return;
    Params p{};
    const float** pp = (const float**)&p;
    for (int i = 0; i < 27; ++i) pp[i] = (const float*)d_in[i];
    p.out = (float*)d_out; p.ws = (unsigned char*)d_ws;
    if (N_LAUNCH_MODE == 1) { p.ph_lo = 0; p.ph_hi = N_PHASES; hipLaunchKernelGGL(fwd_kernel, dim3(grid), dim3(512), LDS_BYTES, stream, p); }
    else for (int k = 0; k < N_PHASES; ++k) { p.ph_lo = k; p.ph_hi = k + 1; hipLaunchKernelGGL(fwd_kernel, dim3(grid), dim3(512), LDS_BYTES, stream, p); }
}
```

```cpp
#define N_LAUNCH_MODE 1
#include <hip/hip_runtime.h>
#include <cstdio>
#include <cstdint>

#define LAS __attribute__((address_space(3)))
#define DI __device__ __forceinline__
typedef unsigned short bf16_t;
typedef short bf16x8 __attribute__((ext_vector_type(8)));
typedef short s16x4 __attribute__((ext_vector_type(4)));
typedef float f32x2 __attribute__((ext_vector_type(2)));
typedef float f32x4 __attribute__((ext_vector_type(4)));
typedef float f32x16 __attribute__((ext_vector_type(16)));
typedef unsigned u32x2 __attribute__((ext_vector_type(2)));
typedef unsigned u32x4 __attribute__((ext_vector_type(4)));
typedef int i32x4 __attribute__((ext_vector_type(4)));
typedef __bf16 bfv2 __attribute__((ext_vector_type(2)));

DI unsigned pk2(float lo, float hi) { f32x2 v = {lo, hi}; return __builtin_bit_cast(unsigned, __builtin_convertvector(v, bfv2)); }
DI unsigned short f2bf(float f) { return (unsigned short)(pk2(f, 0.f) & 0xffffu); }
DI float bf2f(unsigned short b) { return __uint_as_float((unsigned)b << 16); }
DI float bflo(unsigned u) { return __uint_as_float(u << 16); }
DI float bfhi(unsigned u) { return __uint_as_float(u & 0xffff0000u); }
DI unsigned pk4_fp8(float a, float b, float c, float d) {
    a = __builtin_amdgcn_fmed3f(a, -440.f, 440.f); b = __builtin_amdgcn_fmed3f(b, -440.f, 440.f); c = __builtin_amdgcn_fmed3f(c, -440.f, 440.f); d = __builtin_amdgcn_fmed3f(d, -440.f, 440.f);
    int v = 0; v = __builtin_amdgcn_cvt_pk_fp8_f32(a, b, v, false); v = __builtin_amdgcn_cvt_pk_fp8_f32(c, d, v, true); return (unsigned)v; }
DI int lane_now() { int ln; asm volatile("v_mbcnt_lo_u32_b32 %0, -1, 0\n\tv_mbcnt_hi_u32_b32 %0, -1, %0" : "=v"(ln)); return ln; }
template <class T> DI T bperm_(int idx4, T v) { return __builtin_bit_cast(T, __builtin_amdgcn_ds_bpermute(idx4, __builtin_bit_cast(int, v))); }
template <class T> DI T shfl_xor_l(T v, int m, int self) { return bperm_(((self ^ m) & 63) << 2, v); }
template <class T> DI T shfl_up_l(T v, int o, int self, int width = 64) { int idx = self - o; if (idx < (self & ~(width - 1))) idx = self; return bperm_(idx << 2, v); }
template <class T> DI T shfl_xor_(T v, int m) { return shfl_xor_l(v, m, lane_now()); }
template <class T> DI T shfl_up_(T v, int o, int width = 64) { return shfl_up_l(v, o, lane_now(), width); }
template <class T> DI T shfl_(T v, int src) { return bperm_((src & 63) << 2, v); }
#ifndef HIP_SHFL
#define __shfl_xor shfl_xor_
#define __shfl_up shfl_up_
#define __shfl shfl_
#endif
DI float wave_sum(float v) {
#pragma unroll
    for (int o = 1; o < 64; o <<= 1) v += __shfl_xor(v, o);
    return v;
}
DI float silu_f(float x) { return x * __builtin_amdgcn_rcpf(1.0f + __expf(-x)); }
DI float sigmoid_f(float x) { return __builtin_amdgcn_rcpf(1.0f + __expf(-x)); }
#ifdef OLD_TID
DI int tid_opaque(int wv) { int t = wv * 64 + (int)__builtin_amdgcn_mbcnt_hi(~0u, __builtin_amdgcn_mbcnt_lo(~0u, 0u)); asm volatile("" : "+v"(t)); return t; }
#else
DI int tid_opaque(int wv) { int ln; asm volatile("v_mbcnt_lo_u32_b32 %0, -1, 0\n\tv_mbcnt_hi_u32_b32 %0, -1, %0" : "=v"(ln) :: "memory"); return wv * 64 + ln; }
#endif
DI float xhalf_max(float x) { const auto r = __builtin_amdgcn_permlane32_swap(__float_as_uint(x), __float_as_uint(x), false, false); return fmaxf(__uint_as_float(r[0]), __uint_as_float(r[1])); }
DI float xhalf_sum(float x) { const auto r = __builtin_amdgcn_permlane32_swap(__float_as_uint(x), __float_as_uint(x), false, false); return __uint_as_float(r[0]) + __uint_as_float(r[1]); }
DI bf16x8 mk8u(unsigned a, unsigned b, unsigned c, unsigned d) { u32x4 v = {a, b, c, d}; return __builtin_bit_cast(bf16x8, v); }
#define LDS_WAIT() asm volatile("s_waitcnt lgkmcnt(0)" ::: "memory")
#define VM_WAIT() asm volatile("s_waitcnt vmcnt(0)" ::: "memory")
#define MFMA32(a, b, c) __builtin_amdgcn_mfma_f32_32x32x16_bf16((a), (b), (c), 0, 0, 0)

constexpr int NB = 32, SEQ = 2048, DM = 1024, NTOK = NB * SEQ;
constexpr int NIN_REF = 3592, NPROJ = 3584;
constexpr int PC_HY = 0, PC_MZ = 768, PC_MX = 1024, PC_AQ = 1536, PC_AK = 1792, PC_AV = 2048, PC_HQ = 2304, PC_HF = 2560, PC_HI = 3072, PC_HG = 3328;
constexpr int NEXP = 16, CAP = 256, NSLOT = NB * NEXP * CAP;
constexpr float EPSN = 1e-6f;

constexpr size_t MiB = 1u << 20;
constexpr size_t WS_CTL = 0, CTL_ZERO_BYTES = 64 * 1024;
constexpr size_t WS_DT = 1 * MiB, WS_AFF = 3 * MiB, WS_SLOT = 7 * MiB, WS_SELI = 11 * MiB, WS_SELG = 11 * MiB + 512 * 1024, WS_KFILT = 12 * MiB, WS_MSQ = 14 * MiB, WS_RS = 15 * MiB, WS_SELR = 15 * MiB + 512 * 1024;
constexpr size_t WS_XB = 64 * MiB, WS_WIN = 320 * MiB, WS_WOUT = 327 * MiB, WS_WGU = 329 * MiB, WS_WD = 393 * MiB, WS_HN = 432 * MiB, WS_PROJ = 560 * MiB, WS_YE = WS_PROJ, WS_END = 1008 * MiB, WS_MYB = WS_WGU, WS_OB = WS_WGU + 32 * MiB;
constexpr size_t DO_HW = 0, DO_HX0 = 32 * MiB, DO_YAT = 64 * MiB, DO_MXBC = 96 * MiB, DO_MY = 160 * MiB, DO_MST = 192 * MiB, DO_HST = 224 * MiB, DO_HDN = 0;
constexpr int CW_BAR = 1024;

constexpr int LDS_MISC = 163840 - 256, LDS_BYTES = 163840;

struct Params {
    const float *x, *w_in, *w_out, *norm_mix_w, *norm_ffn_w, *hy_conv_w, *hy_w1, *hy_b1, *hy_w2, *hy_b2, *hy_freq, *hy_w3, *hy_fbias,
                *m_conv_w, *m_conv_b, *m_dt_bias, *m_A_log, *m_D, *m_norm_w, *rel_bias, *hg_lb, *hg_norm_w, *router_w, *moe_wg, *moe_wu, *moe_wd, *final_w;
    float* out; unsigned char* ws;
    int ph_lo, ph_hi, wv, pad;
};

#define XB_TMO      128
#define XB_XCNT(j)  (256  + 64 * (j))
#define XB_XSUB(j)  (1280 + 64 * (j))
#define XB_XGEN(j)  (2304 + 64 * (j))
#define XB_TOP      3328
#define XB_TOPGEN   3392
#define XCD_BAR_WORDS 3456
#define XB_SPIN_CAP (1u << 18)
__device__ __forceinline__ unsigned xb_ld(unsigned* p)              { return __hip_atomic_load(p, __ATOMIC_RELAXED, __HIP_MEMORY_SCOPE_AGENT); }
__device__ __forceinline__ unsigned xb_add(unsigned* p, unsigned v) { return __hip_atomic_fetch_add(p, v, __ATOMIC_RELAXED, __HIP_MEMORY_SCOPE_AGENT); }
__device__ __forceinline__ unsigned xb_xcc_id() { return (unsigned)__builtin_amdgcn_s_getreg((3 << 11) | 20) & 0xFu; }
#define XB_SPIN(cond, bar) do { unsigned _sp = 0; while (cond) { __builtin_amdgcn_s_sleep(1); \
    if ((++_sp & 255u) == 0u) { if (xb_ld(&(bar)[XB_TMO])) break; if (_sp > XB_SPIN_CAP) { atomicAdd(&(bar)[XB_TMO], 1u); break; } } } } while (0)
struct XcdBarrier { unsigned* bar; unsigned x; volatile LAS unsigned* st; };
__device__ __forceinline__ XcdBarrier xcd_barrier_post(unsigned* bar, volatile LAS unsigned* st) {
    XcdBarrier b; b.bar = bar; b.x = xb_xcc_id(); b.st = st;
    if (threadIdx.x == 0) (void)xb_add(&bar[XB_XCNT(b.x)], 1u);
    return b;
}
__device__ __forceinline__ void xcd_barrier_complete(unsigned* bar, unsigned x, unsigned& nloc, unsigned& nx) {
    const unsigned G = gridDim.x * gridDim.y * gridDim.z;
    unsigned sum, cnt, mine, sp = 0u;
    for (;;) {
        sum = 0u; cnt = 0u; mine = 0u;
#pragma unroll
        for (unsigned j = 0; j < 16; ++j) { const unsigned c = xb_ld(&bar[XB_XCNT(j)]); sum += c; cnt += (c > 0u) ? 1u : 0u; mine = (j == x) ? c : mine; }
        if (sum == G) break;
        __builtin_amdgcn_s_sleep(1);
        if ((++sp & 255u) == 0u) { if (xb_ld(&bar[XB_TMO])) break; if (sp > XB_SPIN_CAP) { atomicAdd(&bar[XB_TMO], 1u); break; } }
    }
    nloc = mine > 0u ? mine : 1u; nx = cnt > 0u ? cnt : 1u;
}
__device__ __forceinline__ void xcd_barrier(const XcdBarrier& b) {
    asm volatile("s_waitcnt vmcnt(0)" ::: "memory");
    __syncthreads();
    if (threadIdx.x == 0) {
        unsigned* bar = b.bar; asm volatile("" : "+s"(bar));
        __builtin_amdgcn_s_waitcnt(0);
        unsigned nloc = b.st[0], nx = b.st[1];
        if (nloc == 0u) { xcd_barrier_complete(bar, b.x, nloc, nx); b.st[0] = nloc; b.st[1] = nx; }
        const unsigned old = xb_add(&bar[XB_XSUB(b.x)], 1u);
        const unsigned gen = old / nloc;
        if (old + 1u == (gen + 1u) * nloc) {
            __builtin_amdgcn_fence(__ATOMIC_RELEASE, "agent");
            asm volatile("s_waitcnt vmcnt(0)" ::: "memory");
            const unsigned og = xb_add(&bar[XB_TOP], 1u);
            const unsigned tg = og / nx;
            if (og + 1u == (tg + 1u) * nx) xb_add(&bar[XB_TOPGEN], 1u);
            else XB_SPIN(xb_ld(&bar[XB_TOPGEN]) == tg, bar);
            __builtin_amdgcn_fence(__ATOMIC_ACQUIRE, "agent");
            xb_add(&bar[XB_XGEN(b.x)], 1u);
            asm volatile("s_waitcnt vmcnt(0)" ::: "memory");
        } else {
            XB_SPIN(xb_ld(&bar[XB_XGEN(b.x)]) == gen, bar);
            __builtin_amdgcn_fence(__ATOMIC_ACQUIRE, "agent");
            asm volatile("s_waitcnt vmcnt(0)" ::: "memory");
        }
    }
    __syncthreads();
}

namespace pg8 {
constexpr int BM = 256, BK = 64, HALF = 128, HTB = HALF * BK * 2, STAGE_BYTES = 8 * HTB, NXCD = 8, WGM = 8;
__host__ __device__ __forceinline__ int lds_byte(int r, int c) { const int st = (r >> 4) * 2 + (c >> 5), rr = r & 15, cc = c & 31, ob = rr * 64 + cc * 2; return st * 1024 + (ob ^ (((ob >> 9) & 1) << 5)); }
__host__ __device__ __forceinline__ void stage_rc(int b, int& R, int& C) { const int st = b / 1024, sb = b % 1024, swz = sb ^ (((sb >> 9) & 1) << 5); R = (st >> 1) * 16 + swz / 64; C = (st & 1) * 32 + (swz % 64) / 2; }
__host__ __device__ __forceinline__ int perm32(int rho) { const int n = rho >> 4, i = rho & 15; return 8 * (i >> 2) + 4 * n + (i & 3); }
struct Unit { int pm, pn; };
typedef int i32x8 __attribute__((ext_vector_type(8)));
typedef int i32x32 __attribute__((ext_vector_type(32)));
#define INS4(V, P, X) do { const i32x4 _x = (X); (V)[(P)] = _x.x; (V)[(P) + 1] = _x.y; (V)[(P) + 2] = _x.z; (V)[(P) + 3] = _x.w; } while (0)
#define EXT8(V, P) ((i32x8){(V)[(P)], (V)[(P) + 1], (V)[(P) + 2], (V)[(P) + 3], (V)[(P) + 4], (V)[(P) + 5], (V)[(P) + 6], (V)[(P) + 7]})
DI i32x8 cat88(bf16x8 lo, bf16x8 hi) { const i32x4 a = __builtin_bit_cast(i32x4, lo), b = __builtin_bit_cast(i32x4, hi); return (i32x8){a.x, a.y, a.z, a.w, b.x, b.y, b.z, b.w}; }
struct StaticOrder {
    int nM, nN, nwg, G, c;
    __device__ void init(int nM_, int nN_, int G_, int c_) { nM = nM_; nN = nN_; nwg = nM * nN; G = G_; c = c_; }
    __device__ bool next(int i, Unit& u) const {
        const long L = (long)i * G + c; if (L >= nwg) return false;
        int wgid = (int)L; { const int q = nwg / NXCD, r = nwg % NXCD, xcd = wgid % NXCD, off = wgid / NXCD; wgid = (xcd < r ? xcd * (q + 1) : r * (q + 1) + (xcd - r) * q) + off; }
        const int nig = WGM * nN, gid = wgid / nig, fm = gid * WGM, gsz = (nM - fm) < WGM ? (nM - fm) : WGM;
        u.pm = fm + ((wgid % nig) % gsz); u.pn = (wgid % nig) / gsz; return true;
    }
};
#ifndef TPROBE
#define TPROBE 0
#endif
#ifndef TPGEMM
#define TPGEMM 0
#endif
#define GP_T() ({ asm volatile("" ::: "memory"); unsigned _t = (unsigned)__builtin_amdgcn_s_memrealtime(); asm volatile("" ::: "memory"); _t; })
#define GP_ON(k) (TPROBE == (k) && Epi::PID == TPGEMM)
template <class Epi, class Sched, class Addr, bool F8 = false>
__device__ __forceinline__ void gemm_phase(LAS unsigned char* lds, const char* Abase, const char* Bbase, int K, const Sched& S, const Addr& AD, const Epi& E, int wv, unsigned* lds_ws_ctl = nullptr) {
    const int tid = tid_opaque(wv), wid = __builtin_amdgcn_readfirstlane(tid >> 6), lane = tid & 63, wr = wid >> 2, wc = wid & 3, fr = lane & 15, fq = lane >> 4;
    unsigned gp_acc = 0, gp_tot = 0, gp_t0 = 0, gp_t1 = 0; if (TPROBE >= 40 && TPROBE < 50 && Epi::PID == TPGEMM) gp_t0 = GP_T();
    const int KB = F8 ? K : 2 * K;
    const int nt = KB / 128;
    int Rr[2]; unsigned Cc[2], voffB[2], voffA[2];
#pragma unroll
    for (int i = 0; i < 2; ++i) { int R, C; stage_rc(tid * 16 + i * 8192, R, C); const int Rb = Epi::PERM ? ((R & ~31) + perm32(R & 31)) : R;
        Rr[i] = R; Cc[i] = (unsigned)C * 2u; voffA[i] = (unsigned)(R * KB + C * 2); voffB[i] = (unsigned)(Rb * KB + C * 2); }
    const size_t kstep = (size_t)(BK * 2);
    const size_t hstep = (size_t)HALF * KB;
    const unsigned ldsw = (unsigned)wid * 1024u;
    const int aoff = F8 ? lds_byte(wr * 64 + fr, fq * 16) : lds_byte(wr * 64 + fr, fq * 8), boff = F8 ? lds_byte(wc * 32 + fr, fq * 16) : lds_byte(wc * 32 + fr, fq * 8);
    const int aoff1 = F8 ? lds_byte(wr * 64 + fr, fq * 16 + 8) : aoff + 1024, boff1 = F8 ? lds_byte(wc * 32 + fr, fq * 16 + 8) : boff + 1024;
#define PG8_SA(b, h) (((b) * 2 + (h)) * HTB)
#define PG8_SB(b, h) ((4 + (b) * 2 + (h)) * HTB)
#define PG8_STAGE(bufoff, gbase, voff) do { _Pragma("unroll") for (int _i = 0; _i < 2; ++_i) \
        __builtin_amdgcn_global_load_lds((const unsigned*)((const char*)(gbase) + (voff)[_i]), (LAS unsigned*)(lds + (bufoff) + ldsw + _i * 8192), 16, 0, 0); } while (0)
#define PG8_STAGE_A(bufoff, kb, h, un) do { if constexpr (Addr::LOADS) { _Pragma("unroll") for (int _i = 0; _i < 2; ++_i) \
        __builtin_amdgcn_global_load_lds((const unsigned*)(Abase + (kb) + ((un) ? on[h][_i] : oc[h][_i])), (LAS unsigned*)(lds + (bufoff) + ldsw + _i * 8192), 16, 0, 0); } \
      else { const char* _ab = ((un) ? nA : cA) + (kb) + (size_t)(h) * hstep; _Pragma("unroll") for (int _i = 0; _i < 2; ++_i) \
        __builtin_amdgcn_global_load_lds((const unsigned*)(_ab + voffA[_i]), (LAS unsigned*)(lds + (bufoff) + ldsw + _i * 8192), 16, 0, 0); } } while (0)
#define PG8_BSEL_B0 0
#define PG8_BSEL_B1 16
#define PG8_LDA(dst, b, h) do { if constexpr (F8) { _Pragma("unroll") for (int m = 0; m < 4; ++m) { INS4(AA, 8 * m, *(const LAS i32x4*)(lds + PG8_SA(b, h) + aoff + m * 2048)); INS4(AA, 8 * m + 4, *(const LAS i32x4*)(lds + PG8_SA(b, h) + aoff + 16 + m * 2048)); } } \
      else { _Pragma("unroll") for (int m = 0; m < 4; ++m) _Pragma("unroll") for (int k = 0; k < 2; ++k) dst[m][k] = *(const LAS bf16x8*)(lds + PG8_SA(b, h) + (k ? aoff1 : aoff) + m * 2048); } } while (0)
#define PG8_LDB(dst, b, h) do { if constexpr (F8) { _Pragma("unroll") for (int n = 0; n < 2; ++n) { INS4(BB, PG8_BSEL_##dst + 8 * n, *(const LAS i32x4*)(lds + PG8_SB(b, h) + boff + n * 2048)); INS4(BB, PG8_BSEL_##dst + 8 * n + 4, *(const LAS i32x4*)(lds + PG8_SB(b, h) + boff + 16 + n * 2048)); } } \
      else { _Pragma("unroll") for (int n = 0; n < 2; ++n) _Pragma("unroll") for (int k = 0; k < 2; ++k) dst[n][k] = *(const LAS bf16x8*)(lds + PG8_SB(b, h) + (k ? boff1 : boff) + n * 2048); } } while (0)
#define PG8_MMA(ai, bj, At, Bt) do { __builtin_amdgcn_s_setprio(1); if constexpr (F8) { _Pragma("unroll") for (int m = 0; m < 4; ++m) _Pragma("unroll") for (int n = 0; n < 2; ++n) \
        { const i32x8 _b8 = EXT8(BB, PG8_BSEL_##Bt + 8 * n), _a8 = EXT8(AA, 8 * m); \
          asm volatile("s_nop 1\n\tv_mfma_scale_f32_16x16x128_f8f6f4 %0, %1, %2, %0, %3, %4 op_sel_hi:[0,0,0]" : "+v"(acc[ai][bj][m][n]) : "v"(_b8), "v"(_a8), "v"(scw), "v"(scx)); } } \
      else { _Pragma("unroll") for (int m = 0; m < 4; ++m) _Pragma("unroll") for (int n = 0; n < 2; ++n) _Pragma("unroll") for (int k = 0; k < 2; ++k) \
        acc[ai][bj][m][n] = __builtin_amdgcn_mfma_f32_16x16x32_bf16(Bt[n][k], At[m][k], acc[ai][bj][m][n], 0, 0, 0); } __builtin_amdgcn_s_setprio(0); } while (0)
#define PG8_WAIT_V(n) asm volatile("s_waitcnt vmcnt(" #n ")" ::: "memory")
#define PG8_WAIT_L(n) asm volatile("s_waitcnt lgkmcnt(" #n ")" ::: "memory")
#define PG8_BAR __builtin_amdgcn_s_barrier()
#define PG8_SCHED __builtin_amdgcn_sched_barrier(0)
    int scw = 0, scx = 0; if constexpr (F8) { scw = Addr::SC_W; scx = Addr::SC_X; } (void)scw; (void)scx;
    Unit cur, nxt; int ui = 0;
    if (!S.next(0, cur)) return;
#ifdef STAG_TICKS
    {
        const unsigned long long t0 = __builtin_amdgcn_s_memrealtime(); const unsigned long long dl = (unsigned long long)(((blockIdx.x >> 3) & 7) * STAG_TICKS);
        while (__builtin_amdgcn_s_memrealtime() - t0 < dl) __builtin_amdgcn_s_sleep(16);
    }
#endif
    f32x4 acc[2][2][4][2];
#pragma unroll
    for (int a = 0; a < 2; ++a)
#pragma unroll
        for (int b = 0; b < 2; ++b)
#pragma unroll
            for (int m = 0; m < 4; ++m)
#pragma unroll
                for (int n = 0; n < 2; ++n) acc[a][b][m][n] = (f32x4){0.f, 0.f, 0.f, 0.f};
    bf16x8 At[4][2], B0[2][2], B1[2][2]; i32x32 AA, BB; (void)At; (void)B0; (void)B1; (void)AA; (void)BB;
    unsigned oc[2][2], on[2][2];
    const char* cA = Abase; const char* nA = Abase;
    if constexpr (Epi::ROWTAB) {
        Unit tu;
        for (int k = 0; k < 16 && S.next(k, tu); ++k)
            for (int r = tid; r < 256; r += 512) ((LAS float*)(lds + STAGE_BYTES + 8192))[k * 256 + r] = E.rowscale(tu, r);
        if constexpr (!Addr::LOADS) __syncthreads();
    }
    if constexpr (Addr::LOADS) {
        {
            Unit tu;
            for (int k = 0; k < 16 && S.next(k, tu); ++k)
                for (int r = tid; r < 256; r += 512) ((LAS unsigned short*)(lds + STAGE_BYTES))[k * 256 + r] = AD.arow_tok(tu, r);
            __syncthreads();
        }
#pragma unroll
        for (int h = 0; h < 2; ++h)
#pragma unroll
            for (int i = 0; i < 2; ++i) { oc[h][i] = AD.arow_lds(lds + STAGE_BYTES, 0, cur, h * HALF + Rr[i]) + Cc[i]; on[h][i] = oc[h][i]; }
        PG8_WAIT_V(0);
    } else { cA = Abase + AD.arow(cur, 0); nA = cA; }
    const char* cB = Bbase + AD.boff(cur);
    PG8_STAGE(PG8_SB(0, 0), cB, voffB); PG8_STAGE_A(PG8_SA(0, 0), 0, 0, false); PG8_STAGE(PG8_SB(0, 1), cB + hstep, voffB); PG8_STAGE_A(PG8_SA(0, 1), 0, 1, false);
    if (wr == 1) PG8_BAR;
    PG8_WAIT_V(4); PG8_BAR;
    PG8_STAGE(PG8_SB(1, 0), cB + kstep, voffB); PG8_STAGE_A(PG8_SA(1, 0), kstep, 0, false); PG8_STAGE(PG8_SB(1, 1), cB + hstep + kstep, voffB);
    PG8_WAIT_V(6); PG8_BAR;
    for (;;) {
        const bool has_next = S.next(ui + 1, nxt);
        if (has_next) {
            if constexpr (Addr::LOADS) {
#pragma unroll
                for (int h = 0; h < 2; ++h)
#pragma unroll
                    for (int i = 0; i < 2; ++i) on[h][i] = AD.arow_lds(lds + STAGE_BYTES, ui + 1, nxt, h * HALF + Rr[i]) + Cc[i];
            } else nA = Abase + AD.arow(nxt, 0);
        } else nA = cA;
        const char* nB = has_next ? Bbase + AD.boff(nxt) : cB;
        if (GP_ON(41)) gp_t1 = GP_T();
#pragma unroll 1
        for (int t = 0; t < nt; t += 2) {
            if (GP_ON(43) && t == 0) gp_t1 = GP_T();
            if (GP_ON(44) && t == 2) gp_t1 = GP_T();
            const bool last = (t == nt - 2);
            const bool un = last && has_next;
            const size_t k1 = (size_t)(t + 1) * kstep;
            const size_t k2 = last ? 0 : (size_t)(t + 2) * kstep, k3 = k2 + kstep;
            const char* b2 = last ? nB : cB + (size_t)(t + 2) * kstep;
            const char* b3 = b2 + kstep;
            PG8_LDB(B0, 0, 0); PG8_SCHED; PG8_LDA(At, 0, 0); PG8_STAGE_A(PG8_SA(1, 1), k1, 1, false);
            PG8_WAIT_L(8); PG8_BAR; PG8_WAIT_L(0); PG8_MMA(0, 0, At, B0); PG8_BAR; PG8_SCHED;
            PG8_LDB(B1, 0, 1); PG8_STAGE(PG8_SB(0, 0), b2, voffB);
            PG8_BAR; PG8_WAIT_L(0); PG8_MMA(0, 1, At, B1); PG8_BAR;
            PG8_LDA(At, 0, 1); PG8_STAGE_A(PG8_SA(0, 0), k2, 0, un);
            PG8_BAR; PG8_WAIT_L(0); PG8_MMA(1, 0, At, B0); PG8_BAR; PG8_SCHED;
            PG8_STAGE(PG8_SB(0, 1), b2 + hstep, voffB);
            PG8_WAIT_V(6); PG8_BAR; PG8_MMA(1, 1, At, B1); PG8_BAR;
            PG8_LDB(B0, 1, 0); PG8_SCHED; PG8_LDA(At, 1, 0); PG8_STAGE_A(PG8_SA(0, 1), k2, 1, un);
            PG8_WAIT_L(8); PG8_BAR; PG8_WAIT_L(0); PG8_MMA(0, 0, At, B0); PG8_BAR; PG8_SCHED;
            PG8_LDB(B1, 1, 1); PG8_STAGE(PG8_SB(1, 0), b3, voffB);
            PG8_BAR; PG8_WAIT_L(0); PG8_MMA(0, 1, At, B1); PG8_BAR;
            PG8_LDA(At, 1, 1); PG8_STAGE_A(PG8_SA(1, 0), k3, 0, un);
            PG8_BAR; PG8_WAIT_L(0); PG8_MMA(1, 0, At, B0); PG8_BAR; PG8_SCHED;
            PG8_STAGE(PG8_SB(1, 1), b3 + hstep, voffB);
            PG8_WAIT_V(6); PG8_BAR; PG8_MMA(1, 1, At, B1); PG8_BAR;
            if (GP_ON(43) && t == 0) gp_acc += GP_T() - gp_t1;
            if (GP_ON(44) && t == 2) gp_acc += GP_T() - gp_t1;
        }
        if (GP_ON(41)) gp_acc += GP_T() - gp_t1;
        if (GP_ON(42)) gp_t1 = GP_T();
        if constexpr (F8) asm volatile("s_nop 15\n\ts_nop 15" ::: "memory");
        E(acc, cur, wr, wc, fr, fq, (const LAS float*)(lds + STAGE_BYTES + 8192) + ui * 256);
        if (GP_ON(42)) gp_acc += GP_T() - gp_t1;
        if (!has_next) break;
#pragma unroll
        for (int a = 0; a < 2; ++a)
#pragma unroll
            for (int b = 0; b < 2; ++b)
#pragma unroll
                for (int m = 0; m < 4; ++m)
#pragma unroll
                    for (int n = 0; n < 2; ++n) acc[a][b][m][n] = (f32x4){0.f, 0.f, 0.f, 0.f};
        cur = nxt; cB = nB; cA = nA; ++ui;
        if constexpr (Addr::LOADS) {
#pragma unroll
            for (int h = 0; h < 2; ++h)
#pragma unroll
                for (int i = 0; i < 2; ++i) oc[h][i] = on[h][i]; }
    }
    PG8_WAIT_V(0);
    if (wr == 0) PG8_BAR;
    PG8_BAR;
    if (TPROBE >= 40 && TPROBE < 50 && Epi::PID == TPGEMM && tid == 0) { gp_tot = GP_T() - gp_t0; atomicAdd((unsigned*)lds_ws_ctl + 512, gp_acc); atomicAdd((unsigned*)lds_ws_ctl + 513, gp_tot); }
#undef PG8_SA
#undef PG8_SB
#undef PG8_STAGE
#undef PG8_STAGE_A
#undef PG8_BSEL_B0
#undef PG8_BSEL_B1
#undef PG8_LDA
#undef PG8_LDB
#undef PG8_MMA
#undef PG8_WAIT_V
#undef PG8_WAIT_L
#undef PG8_BAR
#undef PG8_SCHED
}
}

#ifndef EN_HY
#define EN_HY 1
#endif
#ifndef EN_MA
#define EN_MA 1
#endif
#ifndef EN_AT
#define EN_AT 1
#endif
#ifndef EN_HG
#define EN_HG 1
#endif
#ifndef EN_MOE
#define EN_MOE 1
#endif
#ifndef MOE_F8
#define MOE_F8 1
#endif

DI void transpose_item(const float* W, int ld, int k0, int n0, bf16_t* dst, int drow0, float scale, LAS float* scr, int lane, const float* kw = nullptr) {
    {
        const int rs = lane >> 3, cq = (lane & 7) * 4;
        f32x4 v[8];
#pragma unroll
        for (int i = 0; i < 8; ++i) v[i] = __builtin_nontemporal_load((const f32x4*)(W + (size_t)(k0 + 8 * i + rs) * ld + n0 + cq));
#pragma unroll
        for (int i = 0; i < 8; ++i) { LAS float* d = scr + (8 * i + rs) * 33 + cq; d[0] = v[i].x; d[1] = v[i].y; d[2] = v[i].z; d[3] = v[i].w; }
    }
    LDS_WAIT();
    const int c = lane & 7;
    float sk[8];
#pragma unroll
    for (int i = 0; i < 8; ++i) sk[i] = kw ? scale * kw[k0 + 8 * c + i] : scale;
#pragma unroll
    for (int j = 0; j < 4; ++j) { const int n = (lane >> 3) + 8 * j; const LAS float* s = scr + (8 * c) * 33 + n;
        u32x4 o; o.x = pk2(s[0 * 33] * sk[0], s[1 * 33] * sk[1]); o.y = pk2(s[2 * 33] * sk[2], s[3 * 33] * sk[3]); o.z = pk2(s[4 * 33] * sk[4], s[5 * 33] * sk[5]); o.w = pk2(s[6 * 33] * sk[6], s[7 * 33] * sk[7]);
        *(u32x4*)(dst + (size_t)(drow0 + n) * 1024 + k0 + 8 * c) = o; }
    LDS_WAIT();
}

DI void transpose_item_f8(const float* W, int ld, int k0, int n0, unsigned char* dst, int drow0, float scale, LAS float* scr, int lane) {
    {   const int rs = lane >> 3, cq = (lane & 7) * 4;
        f32x4 v[8];
#pragma unroll
        for (int i = 0; i < 8; ++i) v[i] = __builtin_nontemporal_load((const f32x4*)(W + (size_t)(k0 + 8 * i + rs) * ld + n0 + cq));
#pragma unroll
        for (int i = 0; i < 8; ++i) { LAS float* d = scr + (8 * i + rs) * 33 + cq; d[0] = v[i].x; d[1] = v[i].y; d[2] = v[i].z; d[3] = v[i].w; }
    }
    LDS_WAIT();
    const int c = lane & 7;
#pragma unroll
    for (int j = 0; j < 4; ++j) { const int n = (lane >> 3) + 8 * j; const LAS float* s = scr + (8 * c) * 33 + n;
        u32x2 o; o.x = pk4_fp8(s[0 * 33] * scale, s[1 * 33] * scale, s[2 * 33] * scale, s[3 * 33] * scale); o.y = pk4_fp8(s[4 * 33] * scale, s[5 * 33] * scale, s[6 * 33] * scale, s[7 * 33] * scale);
        *(u32x2*)(dst + (size_t)(drow0 + n) * 1024 + k0 + 8 * c) = o; }
    LDS_WAIT();
}

#define RDL(x, i) __uint_as_float(__builtin_amdgcn_readlane(__float_as_uint(x), (i)))
DI void hyena_filter_pos(const Params& P, int l, int pos, int lane, bf16_t* kfilt) {
    const float TWO_PI = 6.283185307179586f;
    const float tpos = (float)pos * (1.0f / 2047.0f);
    float z = 0.f;
    if (lane == 0) z = tpos;
    else if (lane <= 32) { const int bnd = (lane - 1) & 15; const float f = 1e-4f + (float)bnd * ((15.0f - 1e-4f) / 15.0f);
        const float angp = TWO_PI * (float)pos / 2048.0f; const float ang = angp * f; z = (lane <= 16) ? cosf(ang) : -sinf(ang); }
    const float* w1 = P.hy_w1 + (size_t)l * 33 * 64; const float* w2 = P.hy_w2 + (size_t)l * 64 * 64; const float* w3 = P.hy_w3 + (size_t)l * 64 * 512;
    const float fr = P.hy_freq[l * 64 + lane];
    float a = P.hy_b1[l * 64 + lane];
#pragma unroll 11
    for (int i = 0; i < 33; ++i) a += RDL(z, i) * w1[i * 64 + lane];
    const float h1 = sinf(fr * a);
    float a2 = P.hy_b2[l * 64 + lane];
#pragma unroll 16
    for (int i = 0; i < 64; ++i) a2 += RDL(h1, i) * w2[i * 64 + lane];
    const float h2 = sinf(fr * a2);
    float h3[8];
#pragma unroll
    for (int k = 0; k < 8; ++k) h3[k] = 0.f;
#pragma unroll 8
    for (int i = 0; i < 64; ++i) { const float hv = RDL(h2, i);
#pragma unroll
        for (int k = 0; k < 8; ++k) h3[k] += hv * w3[i * 512 + k * 64 + lane]; }
    const float min_decay = -3.0701134573253944f, max_decay = -15.350567286626972f;
#pragma unroll
    for (int k = 0; k < 8; ++k) { const int cp = k * 64 + lane, c = cp & 255;
        const float delta = fabsf(min_decay + (float)c * ((max_decay - min_decay) / 255.0f));
        float v = h3[k] * expf(-tpos * delta);
        if (cp < 256) { if (pos == 0) { v += P.hy_fbias[l * 256 + c]; kfilt[(size_t)c * 4096 + 4095] = 0; } kfilt[(size_t)c * 4096 + 2047 - pos] = f2bf(v); }
        else if (pos >= 1) kfilt[(size_t)c * 4096 + 2047 + pos] = f2bf(v); }
}
#undef RDL

struct SelRows { int cnt; unsigned o0, o1, o2, o3; };
DI SelRows sel_compact(int sl, int b) {
    SelRows r; r.cnt = 0; r.o0 = r.o1 = r.o2 = r.o3 = 0u;
#pragma unroll
    for (int e = 0; e < 16; ++e) { const int s = __builtin_amdgcn_readlane(sl, e); const bool on = s >= 0; const unsigned v = (unsigned)((b * 16 + e) * 256 + s);
        r.o0 = (on && r.cnt == 0) ? v : r.o0; r.o1 = (on && r.cnt == 1) ? v : r.o1; r.o2 = (on && r.cnt == 2) ? v : r.o2; r.o3 = (on && r.cnt == 3) ? v : r.o3; r.cnt += on ? 1 : 0; }
    return r;
}
DI void ye_load(const bf16_t* YE, unsigned o, int lane, u32x2 (&t)[4]) { const u32x2* yr = (const u32x2*)(YE + (size_t)o * DM) + lane;
#pragma unroll
    for (int j = 0; j < 4; ++j) t[j] = yr[64 * j]; }
DI void ye_add(f32x4 (&v)[4], const u32x2 (&t)[4]) {
#pragma unroll
    for (int j = 0; j < 4; ++j) { v[j].x += bflo(t[j].x); v[j].y += bfhi(t[j].x); v[j].z += bflo(t[j].y); v[j].w += bfhi(t[j].y); } }
template <bool FINAL>
DI void pre_rows2(const Params& P, int l, const int (&m)[2], int lane, const LAS f32x4* dtw, const float* nw, const int (&slp)[2]) {
    unsigned char* ws = P.ws;
    bf16_t* XB = (bf16_t*)(ws + WS_XB);
    const bool first = (!FINAL && l == 0);
    f32x4 v[2][4];
    if (first) {
#pragma unroll
        for (int k = 0; k < 2; ++k) { const f32x4* xr = (const f32x4*)(P.x + (size_t)m[k] * DM) + lane;
#pragma unroll
            for (int j = 0; j < 4; ++j) v[k][j] = xr[64 * j]; }
    } else {
        u32x2 xh[2][4];
#pragma unroll
        for (int k = 0; k < 2; ++k) { const u32x2* xr = (const u32x2*)(XB + (size_t)m[k] * DM) + lane;
#pragma unroll
            for (int j = 0; j < 4; ++j) xh[k][j] = xr[64 * j]; }
#pragma unroll
        for (int k = 0; k < 2; ++k)
#pragma unroll
            for (int j = 0; j < 4; ++j) v[k][j] = (f32x4){bflo(xh[k][j].x), bfhi(xh[k][j].x), bflo(xh[k][j].y), bfhi(xh[k][j].y)};
    }
    if (!first && EN_MOE) {
        const bf16_t* YE = (const bf16_t*)(ws + WS_YE); const int* slot = (const int*)(ws + WS_SLOT);
        int sl[2]; SelRows sr[2]; (void)slot;
#pragma unroll
        for (int k = 0; k < 2; ++k) sl[k] = slp[k];
#pragma unroll
        for (int k = 0; k < 2; ++k) sr[k] = sel_compact(sl[k], m[k] >> 11);
        u32x2 t[2][4][4];
#pragma unroll
        for (int k = 0; k < 2; ++k) { if (sr[k].cnt > 0) ye_load(YE, sr[k].o0, lane, t[k][0]); if (sr[k].cnt > 1) ye_load(YE, sr[k].o1, lane, t[k][1]);
            if (sr[k].cnt > 2) ye_load(YE, sr[k].o2, lane, t[k][2]); if (sr[k].cnt > 3) ye_load(YE, sr[k].o3, lane, t[k][3]); }
#pragma unroll
        for (int k = 0; k < 2; ++k) { if (sr[k].cnt > 0) ye_add(v[k], t[k][0]); if (sr[k].cnt > 1) ye_add(v[k], t[k][1]); if (sr[k].cnt > 2) ye_add(v[k], t[k][2]); if (sr[k].cnt > 3) ye_add(v[k], t[k][3]);
            if (sr[k].cnt > 4) {
                int seen = 0; const int b = m[k] >> 11;
                for (int e = 0; e < 16; ++e) { const int s = __builtin_amdgcn_readlane(sl[k], e);
                    if (s >= 0) { if (seen >= 4) { u32x2 tt[4]; ye_load(YE, (unsigned)((b * 16 + e) * 256 + s), lane, tt); ye_add(v[k], tt); } ++seen; } } } }
    }
    float rr[2];
#pragma unroll
    for (int k = 0; k < 2; ++k) {
        float s = 0.f;
#pragma unroll
        for (int j = 0; j < 4; ++j) s += (v[k][j].x * v[k][j].x + v[k][j].y * v[k][j].y) + (v[k][j].z * v[k][j].z + v[k][j].w * v[k][j].w);
        rr[k] = __builtin_amdgcn_rsqf(wave_sum(s) * (1.0f / DM) + EPSN);
    }
    if (FINAL) {
#pragma unroll
        for (int k = 0; k < 2; ++k) { f32x4* o = (f32x4*)(P.out + (size_t)m[k] * DM) + lane;
#pragma unroll
            for (int j = 0; j < 4; ++j) { const f32x4 w = ((const f32x4*)nw)[64 * j + lane]; o[64 * j] = v[k][j] * rr[k] * w; } }
        return;
    }
    {
#pragma unroll
        for (int k = 0; k < 2; ++k) { u32x2* o = (u32x2*)(XB + (size_t)m[k] * DM) + lane;
#pragma unroll
            for (int j = 0; j < 4; ++j) o[64 * j] = (u32x2){pk2(v[k][j].x, v[k][j].y), pk2(v[k][j].z, v[k][j].w)}; } }
    float d[2][8];
#pragma unroll
    for (int k = 0; k < 2; ++k)
#pragma unroll
        for (int c = 0; c < 8; ++c) d[k][c] = 0.f;
#pragma unroll
    for (int j = 0; j < 4; ++j) {
#pragma unroll
        for (int q = 0; q < 4; ++q) { const f32x4 w0 = dtw[((j * 4 + q) * 2 + 0) * 64 + lane], w1 = dtw[((j * 4 + q) * 2 + 1) * 64 + lane];
#pragma unroll
            for (int k = 0; k < 2; ++k) { const float xv = q == 0 ? v[k][j].x : (q == 1 ? v[k][j].y : (q == 2 ? v[k][j].z : v[k][j].w));
                d[k][0] += xv * w0.x; d[k][1] += xv * w0.y; d[k][2] += xv * w0.z; d[k][3] += xv * w0.w; d[k][4] += xv * w1.x; d[k][5] += xv * w1.y; d[k][6] += xv * w1.z; d[k][7] += xv * w1.w; } }
    }
#pragma unroll
    for (int k = 0; k < 2; ++k) {
        float mine = 0.f;
#pragma unroll
        for (int c = 0; c < 8; ++c) { const float t2 = wave_sum(d[k][c]); mine = (lane == c) ? t2 : mine; }
        if (lane < 8) ((float*)(ws + WS_DT))[(size_t)m[k] * 8 + lane] = mine * rr[k];
        if (lane == 8) ((float*)(ws + WS_MSQ))[m[k]] = rr[k];
    }
    (void)nw;
}

DI void phase_pre(const Params& P, int l, LAS unsigned char* lds) {
    const int tid = tid_opaque(P.wv), lane = tid & 63, wave = tid >> 6;
    const int gw = blockIdx.x * 8 + wave, NGW = gridDim.x * 8;
    unsigned char* ws = P.ws;
    LAS float* dtwf = (LAS float*)lds;
    const float* win_ = P.w_in; asm volatile("" : "+s"(win_));
    for (int i = tid; i < 1024 * 8; i += 512) { const int k = i >> 3, c = i & 7; const int j = k >> 8, ln = (k & 255) >> 2, q = k & 3;
        dtwf[((((j * 4 + q) * 2 + (c >> 2)) * 64 + ln) << 2) + (c & 3)] = P.norm_mix_w[l * DM + k] * win_[((size_t)l * DM + k) * NIN_REF + 1536 + c]; }
    __syncthreads();
    if (EN_HY) for (int pos = gw; pos < SEQ; pos += NGW) hyena_filter_pos(P, l, pos, lane, (bf16_t*)(ws + WS_KFILT));
    {
        LAS float* scr = (LAS float*)(lds + 32768 + wave * 8448);
        constexpr int I_A = 16 * 48, I_B = 16 * 64, I_O = 16 * 32, I_E = 16 * 32 * 16;
        constexpr int NITEMS = I_A + I_B + I_O; (void)I_E;
        bf16_t* WinT = (bf16_t*)(ws + WS_WIN); bf16_t* WoutT = (bf16_t*)(ws + WS_WOUT); bf16_t* WguT = (bf16_t*)(ws + WS_WGU); bf16_t* WdT = (bf16_t*)(ws + WS_WD);
        for (int it = gw; it < NITEMS; it += NGW) {
            int r = it;
            if (r < I_A) { const int kb = r / 48, nb = r % 48; transpose_item(P.w_in + (size_t)l * DM * NIN_REF, NIN_REF, 64 * kb, 32 * nb, WinT, 32 * nb, 1.0f, scr, lane, P.norm_mix_w + l * DM); continue; } r -= I_A;
            if (r < I_B) { const int kb = r / 64, nb = r % 64; const int drow = 1536 + 32 * nb; transpose_item(P.w_in + (size_t)l * DM * NIN_REF, NIN_REF, 64 * kb, 1544 + 32 * nb, WinT, drow, drow < PC_AK ? 0.125f * 1.4426950408889634f : 1.0f  , scr, lane, P.norm_mix_w + l * DM); continue; } r -= I_B;
            { const int kb = r / 32, nb = r % 32; transpose_item(P.w_out + (size_t)l * DM * DM, DM, 64 * kb, 32 * nb, WoutT, 32 * nb, 1.0f, scr, lane); }
            (void)WguT; (void)WdT;
        }
    }
    const float* nw = P.norm_mix_w + l * DM;
    {
        const int* slotp = (const int*)(ws + WS_SLOT); const bool comb = (l != 0) && EN_MOE;
        int sln[2] = {0, 0};
        if (comb && gw < NTOK) { sln[0] = slotp[(size_t)gw * 16 + (lane & 15)]; sln[1] = slotp[(size_t)((gw + NGW < NTOK) ? gw + NGW : gw) * 16 + (lane & 15)]; }
        for (int m = gw; m < NTOK; m += 2 * NGW) { asm volatile("" ::: "memory"); const int mm[2] = {m, (m + NGW < NTOK) ? m + NGW : m};
            const int slc[2] = {sln[0], sln[1]}; const int mn = m + 2 * NGW;
            if (comb && mn < NTOK) { sln[0] = slotp[(size_t)mn * 16 + (lane & 15)]; sln[1] = slotp[(size_t)((mn + NGW < NTOK) ? mn + NGW : mn) * 16 + (lane & 15)]; }
            pre_rows2<false>(P, l, mm, lane, (const LAS f32x4*)dtwf, nw, slc); }
    }
}
DI void phase_final(const Params& P) {
    const int tid = tid_opaque(P.wv), lane = tid & 63, wave = tid >> 6;
    const int gw = blockIdx.x * 8 + wave, NGW = gridDim.x * 8;
    {
        const int* slotp = (const int*)(P.ws + WS_SLOT); const bool comb = EN_MOE;
        int sln[2] = {0, 0};
        if (comb && gw < NTOK) { sln[0] = slotp[(size_t)gw * 16 + (lane & 15)]; sln[1] = slotp[(size_t)((gw + NGW < NTOK) ? gw + NGW : gw) * 16 + (lane & 15)]; }
        for (int m = gw; m < NTOK; m += 2 * NGW) { const int mm[2] = {m, (m + NGW < NTOK) ? m + NGW : m};
            const int slc[2] = {sln[0], sln[1]}; const int mn = m + 2 * NGW;
            if (comb && mn < NTOK) { sln[0] = slotp[(size_t)mn * 16 + (lane & 15)]; sln[1] = slotp[(size_t)((mn + NGW < NTOK) ? mn + NGW : mn) * 16 + (lane & 15)]; }
            pre_rows2<true>(P, 1, mm, lane, nullptr, P.final_w, slc); }
    }
}

struct AddrPlain { static constexpr bool LOADS = false; int K; int nb_rows;
    DI unsigned arow(const pg8::Unit& u, int r) const { return (unsigned)(u.pm * 256 + r) * (unsigned)(K * 2); }
    DI size_t boff(const pg8::Unit& u) const { return (size_t)u.pn * 256 * K * 2; } };
DI int moe_panel(int r) { return (r & 31) * 16 + (r >> 5); }
struct AddrGateUp { static constexpr bool LOADS = true; const int* seli;
    DI unsigned arow(const pg8::Unit& u, int r) const { const int b = u.pm & 31; const int t = seli[moe_panel(u.pm) * 256 + r]; return (unsigned)(b * SEQ + t) * (unsigned)(DM * 2); }
    DI unsigned short arow_tok(const pg8::Unit& u, int r) const { return (unsigned short)seli[moe_panel(u.pm) * 256 + r]; }
    DI unsigned arow_lds(const LAS unsigned char* tab, int k, const pg8::Unit& u, int r) const { const int b = u.pm & 31; const int t = ((const LAS unsigned short*)tab)[k * 256 + r]; return (unsigned)(b * SEQ + t) * (unsigned)(DM * 2); }
    DI size_t boff(const pg8::Unit& u) const { return ((size_t)(u.pm >> 5) * 2048 + (size_t)u.pn * 256) * DM * 2; } };
struct AddrGateUp8 { static constexpr bool LOADS = true; static constexpr int SC_W = 0x79797979, SC_X = 0x7f7f7f7f; const int* seli;
    DI unsigned arow(const pg8::Unit& u, int r) const { const int b = u.pm & 31; const int t = seli[moe_panel(u.pm) * 256 + r]; return (unsigned)(b * SEQ + t) * (unsigned)DM; }
    DI unsigned short arow_tok(const pg8::Unit& u, int r) const { return (unsigned short)seli[moe_panel(u.pm) * 256 + r]; }
    DI unsigned arow_lds(const LAS unsigned char* tab, int k, const pg8::Unit& u, int r) const { const int b = u.pm & 31; const int t = ((const LAS unsigned short*)tab)[k * 256 + r]; return (unsigned)(b * SEQ + t) * (unsigned)DM; }
    DI size_t boff(const pg8::Unit& u) const { return ((size_t)(u.pm >> 5) * 2048 + (size_t)u.pn * 256) * DM; } };
struct AddrDown8 { static constexpr bool LOADS = false; static constexpr int SC_W = 0x79797979, SC_X = 0x7c7c7c7c;
    DI unsigned arow(const pg8::Unit& u, int r) const { return (unsigned)(moe_panel(u.pm) * 256 + r) * (unsigned)DM; }
    DI size_t boff(const pg8::Unit& u) const { return ((size_t)(u.pm >> 5) * 1024 + (size_t)u.pn * 256) * DM; } };
struct AddrDown { static constexpr bool LOADS = false;
    DI unsigned arow(const pg8::Unit& u, int r) const { return (unsigned)(moe_panel(u.pm) * 256 + r) * (unsigned)(DM * 2); }
    DI size_t boff(const pg8::Unit& u) const { return ((size_t)(u.pm >> 5) * 1024 + (size_t)u.pn * 256) * DM * 2; } };

struct EpiProj { static constexpr int PID = 1; static constexpr bool PERM = true, ROWTAB = true; bf16_t* O; const float* rsm;
    DI float rowscale(const pg8::Unit& u, int r) const { return rsm[u.pm * 256 + r]; }
    DI void operator()(const f32x4 (&acc)[2][2][4][2], const pg8::Unit& u, int wr, int wc, int fr, int fq, const LAS float* rtab) const {
        const int row0 = u.pm * 256 + wr * 64 + fr, col0 = u.pn * 256 + wc * 32 + 8 * fq;
#pragma unroll
        for (int ai = 0; ai < 2; ++ai)
#pragma unroll
            for (int m = 0; m < 4; ++m) { bf16_t* rowp = O + (size_t)(row0 + ai * 128 + m * 16) * NPROJ + col0; const float g = rtab[wr * 64 + fr + ai * 128 + m * 16];
#pragma unroll
                for (int bj = 0; bj < 2; ++bj) { const f32x4 v0 = acc[ai][bj][m][0] * g, v1 = acc[ai][bj][m][1] * g;
                    u32x4 w; w.x = pk2(v0[0], v0[1]); w.y = pk2(v0[2], v0[3]); w.z = pk2(v1[0], v1[1]); w.w = pk2(v1[2], v1[3]);
                    *(u32x4*)(rowp + bj * 128) = w; } }
    } };
struct EpiRes { static constexpr int PID = 5; static constexpr bool PERM = true, ROWTAB = false; const float* base32; const bf16_t* base16; bf16_t* out;
    DI void operator()(const f32x4 (&acc)[2][2][4][2], const pg8::Unit& u, int wr, int wc, int fr, int fq, const LAS float* rtab) const {
        const int row0 = u.pm * 256 + wr * 64 + fr, col0 = u.pn * 256 + wc * 32 + 8 * fq;
#pragma unroll
        for (int ai = 0; ai < 2; ++ai)
#pragma unroll
            for (int m = 0; m < 4; ++m) { const size_t off = (size_t)(row0 + ai * 128 + m * 16) * DM + col0;
#pragma unroll
                for (int bj = 0; bj < 2; ++bj) { f32x4 v0 = acc[ai][bj][m][0], v1 = acc[ai][bj][m][1];
                    if (base32) { v0 = v0 + *(const f32x4*)(base32 + off + bj * 128); v1 = v1 + *(const f32x4*)(base32 + off + bj * 128 + 4); }
                    else { const u32x4 bs = *(const u32x4*)(base16 + off + bj * 128);
                        v0 = v0 + (f32x4){bflo(bs.x), bfhi(bs.x), bflo(bs.y), bfhi(bs.y)}; v1 = v1 + (f32x4){bflo(bs.z), bfhi(bs.z), bflo(bs.w), bfhi(bs.w)}; }
                    u32x4 w; w.x = pk2(v0[0], v0[1]); w.y = pk2(v0[2], v0[3]); w.z = pk2(v1[0], v1[1]); w.w = pk2(v1[2], v1[3]);
                    *(u32x4*)(out + off + bj * 128) = w; } }
    } };
struct EpiGateUp { static constexpr int PID = 18; static constexpr bool PERM = true, ROWTAB = true; bf16_t* H; const float* selr;
    DI float rowscale(const pg8::Unit& u, int r) const { return selr[moe_panel(u.pm) * 256 + r]; }
    DI void operator()(const f32x4 (&acc)[2][2][4][2], const pg8::Unit& u, int wr, int wc, int fr, int fq, const LAS float* rtab) const {
        const int row0 = moe_panel(u.pm) * 256 + wr * 64 + fr, col0 = u.pn * 128 + wc * 32 + 8 * fq;
#pragma unroll
        for (int ai = 0; ai < 2; ++ai)
#pragma unroll
            for (int m = 0; m < 4; ++m) { bf16_t* rowp = H + (size_t)(row0 + ai * 128 + m * 16) * DM + col0; const float rr = rtab[wr * 64 + fr + ai * 128 + m * 16];
                float hv[8];
#pragma unroll
                for (int n = 0; n < 2; ++n)
#pragma unroll
                    for (int j = 0; j < 4; ++j) { const float g = acc[ai][0][m][n][j] * rr, up = acc[ai][1][m][n][j] * rr; hv[n * 4 + j] = silu_f(g) * up; }
                u32x4 w; w.x = pk2(hv[0], hv[1]); w.y = pk2(hv[2], hv[3]); w.z = pk2(hv[4], hv[5]); w.w = pk2(hv[6], hv[7]);
                *(u32x4*)rowp = w; }
    } };
struct EpiGateUp8 { static constexpr int PID = 8; static constexpr bool PERM = true, ROWTAB = true; unsigned char* H; const float* selr;
    DI float rowscale(const pg8::Unit& u, int r) const { return selr[moe_panel(u.pm) * 256 + r]; }
    DI void operator()(const f32x4 (&acc)[2][2][4][2], const pg8::Unit& u, int wr, int wc, int fr, int fq, const LAS float* rtab) const {
        const int row0 = moe_panel(u.pm) * 256 + wr * 64 + fr, col0 = u.pn * 128 + wc * 32 + 8 * fq;
#pragma unroll
        for (int ai = 0; ai < 2; ++ai)
#pragma unroll
            for (int m = 0; m < 4; ++m) { unsigned char* rowp = H + (size_t)(row0 + ai * 128 + m * 16) * DM + col0; const float rr = rtab[wr * 64 + fr + ai * 128 + m * 16]; const float c1 = -1.4426950408889634f * rr, k2 = 8.0f * rr * rr;
                float hv[8];
#pragma unroll
                for (int n = 0; n < 2; ++n)
#pragma unroll
                    for (int j = 0; j < 4; ++j) { const float g = acc[ai][0][m][n][j], up = acc[ai][1][m][n][j];
                        hv[n * 4 + j] = (g * up) * (k2 * __builtin_amdgcn_rcpf(1.0f + __builtin_amdgcn_exp2f(g * c1))); }
                *(u32x2*)rowp = (u32x2){pk4_fp8(hv[0], hv[1], hv[2], hv[3]), pk4_fp8(hv[4], hv[5], hv[6], hv[7])}; }
    } };
struct EpiDown { static constexpr int PID = 9; static constexpr bool PERM = true, ROWTAB = true; bf16_t* Y; const float* gate;
    DI float rowscale(const pg8::Unit& u, int r) const { return gate[moe_panel(u.pm) * 256 + r]; }
    DI void operator()(const f32x4 (&acc)[2][2][4][2], const pg8::Unit& u, int wr, int wc, int fr, int fq, const LAS float* rtab) const {
        const int row0 = moe_panel(u.pm) * 256 + wr * 64 + fr, col0 = u.pn * 256 + wc * 32 + 8 * fq;
#pragma unroll
        for (int ai = 0; ai < 2; ++ai)
#pragma unroll
            for (int m = 0; m < 4; ++m) { const int row = row0 + ai * 128 + m * 16; const float g = rtab[wr * 64 + fr + ai * 128 + m * 16]; bf16_t* rowp = Y + (size_t)row * DM + col0;
#pragma unroll
                for (int bj = 0; bj < 2; ++bj) { const f32x4 v0 = acc[ai][bj][m][0] * g, v1 = acc[ai][bj][m][1] * g;
                    u32x4 w; w.x = pk2(v0[0], v0[1]); w.y = pk2(v0[2], v0[3]); w.z = pk2(v1[0], v1[1]); w.w = pk2(v1[2], v1[3]);
                    *(u32x4*)(rowp + bj * 128) = w; } }
    } };

DI void phase_premix(const Params& P, int l, LAS unsigned char* lds) {
    const int tid = tid_opaque(P.wv), lane = tid & 63, wave = tid >> 6;
    const int gw = blockIdx.x * 8 + wave, NGW = gridDim.x * 8;
    unsigned char* ws = P.ws;
    const bf16_t* proj = (const bf16_t*)(ws + WS_PROJ);
    unsigned char* dsc = (unsigned char*)P.out;
    if (EN_HY) {
        bf16_t* HW = (bf16_t*)(dsc + DO_HW); bf16_t* HX0 = (bf16_t*)(dsc + DO_HX0);
        const float* cw = P.hy_conv_w + (size_t)l * 3 * 768;
        LAS unsigned char* tl = lds + wave * 15616;
        const int rsub = lane >> 3, cch = lane & 7;
        const int i16 = lane & 15, trq = i16 >> 2, trp = i16 & 3, g16 = lane >> 4;
        const unsigned troff = (unsigned)(trq * 144 + (16 * g16 + 4 * trp) * 2);
        u32x4 rin[5][3];
#define HYPM_LOAD(IT) do { const int ct_ = (IT) & 3, tt_ = ((IT) >> 2) & 63, b_ = (IT) >> 8; const int t0_ = tt_ * 32; \
            const bf16_t* pr_ = proj + ((size_t)b_ * SEQ) * NPROJ + ct_ * 64 + 8 * cch; \
            _Pragma("unroll") for (int i = 0; i < 5; ++i) { const int rr = rsub + 8 * i; const int t = t0_ - 1 + rr; const bool ok = (rr < 34) && (t >= 0) && (t < SEQ); \
                const bf16_t* q = pr_ + (size_t)(ok ? t : 0) * NPROJ; \
                _Pragma("unroll") for (int a = 0; a < 3; ++a) { rin[i][a] = *(const u32x4*)(q + 256 * a); if (!ok) rin[i][a] = (u32x4){0u, 0u, 0u, 0u}; } } } while (0)
        if (gw < NB * 64 * 4) HYPM_LOAD(gw);
        for (int it = gw; it < NB * 64 * 4; it += NGW) {
            const int ct = it & 3, tt = (it >> 2) & 63, b = it >> 8;
            const int c = ct * 64 + lane, t0 = tt * 32;
#pragma unroll
            for (int i = 0; i < 5; ++i) { const int rr = rsub + 8 * i;
#pragma unroll
                for (int a = 0; a < 3; ++a) if (rr < 36) *(LAS u32x4*)(tl + a * 5184 + rr * 144 + 16 * cch) = rin[i][a]; }
            if (it + NGW < NB * 64 * 4) HYPM_LOAD(it + NGW);
            float w0[3], w1[3], w2[3];
#pragma unroll
            for (int j = 0; j < 3; ++j) { w0[j] = cw[j * 768 + c]; w1[j] = cw[j * 768 + 256 + c]; w2[j] = cw[j * 768 + 512 + c]; }
            LDS_WAIT();
            float p0[4], p1[4], p2[4];
            unsigned hwv[16], hxv[16];
#pragma unroll
            for (int j = 0; j < 9; ++j) {
                const s16x4 r0 = __builtin_amdgcn_ds_read_tr16_b64_v4i16((LAS s16x4*)(tl + 0 * 5184 + troff + (4 * j) * 144));
                const s16x4 r1 = __builtin_amdgcn_ds_read_tr16_b64_v4i16((LAS s16x4*)(tl + 1 * 5184 + troff + (4 * j) * 144));
                const s16x4 r2 = __builtin_amdgcn_ds_read_tr16_b64_v4i16((LAS s16x4*)(tl + 2 * 5184 + troff + (4 * j) * 144));
                float c0[4], c1[4], c2[4];
#pragma unroll
                for (int k = 0; k < 4; ++k) { c0[k] = bf2f((unsigned short)r0[k]); c1[k] = bf2f((unsigned short)r1[k]); c2[k] = bf2f((unsigned short)r2[k]); }
                if (j > 0) {
                    float u0[4], hv[4];
#pragma unroll
                    for (int k = 0; k < 4; ++k) { const float a0 = p0[k], a1 = p1[k], a2 = p2[k];
                        const float b0 = (k < 3) ? p0[k + 1] : c0[0], b1 = (k < 3) ? p1[k + 1] : c1[0], b2 = (k < 3) ? p2[k + 1] : c2[0];
                        const float d0 = (k < 2) ? p0[k + 2] : c0[k - 2], d1 = (k < 2) ? p1[k + 2] : c1[k - 2], d2 = (k < 2) ? p2[k + 2] : c2[k - 2];
                        u0[k] = w0[0] * a0 + w0[1] * b0 + w0[2] * d0;
                        hv[k] = (w2[0] * a2 + w2[1] * b2 + w2[2] * d2) * (w1[0] * a1 + w1[1] * b1 + w1[2] * d1); }
                    hwv[2 * (j - 1)] = pk2(hv[0], hv[1]); hwv[2 * (j - 1) + 1] = pk2(hv[2], hv[3]); hxv[2 * (j - 1)] = pk2(u0[0], u0[1]); hxv[2 * (j - 1) + 1] = pk2(u0[2], u0[3]);
                }
#pragma unroll
                for (int k = 0; k < 4; ++k) { p0[k] = c0[k]; p1[k] = c1[k]; p2[k] = c2[k]; }
            }
            bf16_t* hwp = HW + ((size_t)c * NB + b) * SEQ + t0; bf16_t* hxp = HX0 + ((size_t)c * NB + b) * SEQ + t0;
#pragma unroll
            for (int k = 0; k < 4; ++k) { *(u32x4*)(hwp + 8 * k) = (u32x4){hwv[4 * k], hwv[4 * k + 1], hwv[4 * k + 2], hwv[4 * k + 3]}; *(u32x4*)(hxp + 8 * k) = (u32x4){hxv[4 * k], hxv[4 * k + 1], hxv[4 * k + 2], hxv[4 * k + 3]}; }
            LDS_WAIT();
        }
    }
    if (EN_MA) {
        bf16_t* MX = (bf16_t*)(dsc + DO_MXBC);
        const float* cw = P.m_conv_w + (size_t)l * 5 * 512; const float* cb = P.m_conv_b + (size_t)l * 512;
        const int gt = blockIdx.x * 512 + tid, NGT = gridDim.x * 512;
        for (int it = gt; it < (NTOK / 4) * 64; it += NGT) {
            const int ch = (it & 63) * 8, m0 = (it >> 6) * 4, t0 = m0 & (SEQ - 1);
            u32x4 rw[8];
#pragma unroll
            for (int j = 0; j < 8; ++j) { const int tt = t0 + j - 2; const bool ok = (tt >= 0) && (tt < SEQ);
                rw[j] = *(const u32x4*)(proj + (size_t)(ok ? m0 + j - 2 : m0) * NPROJ + PC_MX + ch); if (!ok) rw[j] = (u32x4){0u, 0u, 0u, 0u}; }
            f32x4 wa[5], wb[5];
#pragma unroll
            for (int j = 0; j < 5; ++j) { wa[j] = *(const f32x4*)(cw + j * 512 + ch); wb[j] = *(const f32x4*)(cw + j * 512 + ch + 4); }
            const f32x4 ba = *(const f32x4*)(cb + ch), bb = *(const f32x4*)(cb + ch + 4);
#pragma unroll
            for (int k = 0; k < 4; ++k) {
                float a[8] = {ba.x, ba.y, ba.z, ba.w, bb.x, bb.y, bb.z, bb.w};
#pragma unroll
                for (int j = 0; j < 5; ++j) { const u32x4 v = rw[k + j];
                    a[0] += wa[j].x * bflo(v.x); a[1] += wa[j].y * bfhi(v.x); a[2] += wa[j].z * bflo(v.y); a[3] += wa[j].w * bfhi(v.y);
                    a[4] += wb[j].x * bflo(v.z); a[5] += wb[j].y * bfhi(v.z); a[6] += wb[j].z * bflo(v.w); a[7] += wb[j].w * bfhi(v.w); }
                u32x4 o; o.x = pk2(silu_f(a[0]), silu_f(a[1])); o.y = pk2(silu_f(a[2]), silu_f(a[3])); o.z = pk2(silu_f(a[4]), silu_f(a[5])); o.w = pk2(silu_f(a[6]), silu_f(a[7]));
                *(u32x4*)(MX + (size_t)(m0 + k) * 512 + ch) = o;
            }
        }
    }
}

DI void phase_finalize(const Params& P, int l) {
    const int tid = tid_opaque(P.wv), lane = tid & 63, wave = tid >> 6;
    const int gw = blockIdx.x * 8 + wave, NGW = gridDim.x * 8;
    unsigned char* ws = P.ws; unsigned char* dsc = (unsigned char*)P.out;
    bf16_t* MIX = (bf16_t*)(ws + WS_HN);
    {
        const bf16_t* YAT = (const bf16_t*)(dsc + DO_YAT);
        for (int it = gw; it < NB * 32 * 4; it += NGW) {
            const int ct = it & 3, tt = (it >> 2) & 31, b = it >> 7;
            const int c = ct * 64 + lane, t0 = tt * 64;
            const bf16_t* src = YAT + ((size_t)c * NB + b) * SEQ + t0;
            bf16_t* dst = MIX + ((size_t)b * SEQ + t0) * DM + c;
#pragma unroll 2
            for (int t8 = 0; t8 < 64; t8 += 8) {
                u32x4 v = EN_HY ? *(const u32x4*)(src + t8) : (u32x4){0u, 0u, 0u, 0u};
                const unsigned w[4] = {v.x, v.y, v.z, v.w};
#pragma unroll
                for (int i = 0; i < 8; ++i) dst[(size_t)(t8 + i) * DM] = (bf16_t)((i & 1) ? (w[i >> 1] >> 16) : (w[i >> 1] & 0xffffu));
            }
        }
    }
    {
        const bf16_t* MYF = (const bf16_t*)(dsc + DO_MY); const bf16_t* MYB = (const bf16_t*)(ws + WS_MYB); const bf16_t* MX = (const bf16_t*)(dsc + DO_MXBC);
        const bf16_t* OB = (const bf16_t*)(ws + WS_OB); const bf16_t* proj = (const bf16_t*)(ws + WS_PROJ);
        const float* nwm = P.m_norm_w + l * 256; const float* nwh = P.hg_norm_w + l * 64;
        const int gt = blockIdx.x * 512 + tid, NGT = gridDim.x * 512;
        for (int it = gt; it < NTOK * 32; it += NGT) {
            const int ch = (it & 31) * 8, m = it >> 5;
            const u32x4 yf = *(const u32x4*)(MYF + (size_t)m * 256 + ch), yb = *(const u32x4*)(MYB + (size_t)m * 256 + ch), xv = *(const u32x4*)(MX + (size_t)m * 512 + ch), zv = *(const u32x4*)(proj + (size_t)m * NPROJ + PC_MZ + ch);
            const u32x4 of = *(const u32x4*)(MIX + (size_t)m * DM + 768 + ch), ob = *(const u32x4*)(OB + (size_t)m * 256 + ch), gv = *(const u32x4*)(proj + (size_t)m * NPROJ + PC_HG + ch);
            u32x4 o = {0u, 0u, 0u, 0u};
            if (EN_MA) {
                const float Dk = P.m_D[l * 4 + (ch >> 6)];
                const unsigned yfw[4] = {yf.x, yf.y, yf.z, yf.w}, ybw[4] = {yb.x, yb.y, yb.z, yb.w}, xw[4] = {xv.x, xv.y, xv.z, xv.w}, zw[4] = {zv.x, zv.y, zv.z, zv.w};
                float y[8]; float sq = 0.f;
#pragma unroll
                for (int j = 0; j < 4; ++j) { y[2 * j] = (bflo(yfw[j]) + bflo(ybw[j]) + Dk * bflo(xw[j])) * silu_f(bflo(zw[j])); y[2 * j + 1] = (bfhi(yfw[j]) + bfhi(ybw[j]) + Dk * bfhi(xw[j])) * silu_f(bfhi(zw[j]));
                    sq += y[2 * j] * y[2 * j] + y[2 * j + 1] * y[2 * j + 1]; }
#pragma unroll
                for (int of2 = 1; of2 < 32; of2 <<= 1) sq += __shfl_xor(sq, of2);
                const float r = __builtin_amdgcn_rsqf(sq * (1.0f / 256.0f) + EPSN);
                const f32x4 wa = *(const f32x4*)(nwm + ch), wb = *(const f32x4*)(nwm + ch + 4);
                o.x = pk2(y[0] * r * wa.x, y[1] * r * wa.y); o.y = pk2(y[2] * r * wa.z, y[3] * r * wa.w); o.z = pk2(y[4] * r * wb.x, y[5] * r * wb.y); o.w = pk2(y[6] * r * wb.z, y[7] * r * wb.w);
            }
            *(u32x4*)(MIX + (size_t)m * DM + 256 + ch) = o;
            if (EN_HG) {
                const unsigned ofw[4] = {of.x, of.y, of.z, of.w}, obw[4] = {ob.x, ob.y, ob.z, ob.w}, gw4[4] = {gv.x, gv.y, gv.z, gv.w};
                float y[8]; float sq = 0.f;
#pragma unroll
                for (int j = 0; j < 4; ++j) { y[2 * j] = bflo(ofw[j]) + bflo(obw[j]); y[2 * j + 1] = bfhi(ofw[j]) + bfhi(obw[j]); sq += y[2 * j] * y[2 * j] + y[2 * j + 1] * y[2 * j + 1]; }
#pragma unroll
                for (int o2 = 1; o2 < 8; o2 <<= 1) sq += __shfl_xor(sq, o2);
                const float r = __builtin_amdgcn_rsqf(sq * (1.0f / 64.0f) + EPSN);
                const f32x4 wa = *(const f32x4*)(nwh + (ch & 63)), wb = *(const f32x4*)(nwh + (ch & 63) + 4);
                u32x4 oh;
                oh.x = pk2(y[0] * r * wa.x * silu_f(bflo(gw4[0])), y[1] * r * wa.y * silu_f(bfhi(gw4[0]))); oh.y = pk2(y[2] * r * wa.z * silu_f(bflo(gw4[1])), y[3] * r * wa.w * silu_f(bfhi(gw4[1])));
                oh.z = pk2(y[4] * r * wb.x * silu_f(bflo(gw4[2])), y[5] * r * wb.y * silu_f(bfhi(gw4[2]))); oh.w = pk2(y[6] * r * wb.z * silu_f(bflo(gw4[3])), y[7] * r * wb.w * silu_f(bfhi(gw4[3])));
                *(u32x4*)(MIX + (size_t)m * DM + 768 + ch) = oh;
            }
        }
    }
#if !EN_AT || !EN_HG
    {
        const int gt = blockIdx.x * 512 + tid, NGT = gridDim.x * 512;
        for (int it = gt; it < NTOK * 32; it += NGT) { const int ch = (it & 31) * 8, m = it >> 5;
            if (!EN_AT) *(u32x4*)(MIX + (size_t)m * DM + 512 + ch) = (u32x4){0u, 0u, 0u, 0u};
            if (!EN_HG) *(u32x4*)(MIX + (size_t)m * DM + 768 + ch) = (u32x4){0u, 0u, 0u, 0u}; }
    }
#endif
}

DI void phase_ffnpre(const Params& P, int l, LAS unsigned char* lds) {
    const int tid = tid_opaque(P.wv), lane = tid & 63, wave = tid >> 6, r = lane & 15, q = lane >> 4;
    const int gw = blockIdx.x * 8 + wave, NGW = gridDim.x * 8;
    unsigned char* ws = P.ws;
    LAS u32x4* Wh = (LAS u32x4*)lds;
    LAS u32x4* Wl = Wh + 32 * 64;
    for (int i = tid; i < 32 * 64; i += 512) { const int s = i >> 6, ln = i & 63, e = ln & 15, qq = ln >> 4; float wv[8]; unsigned hi[4], lo[4];
#pragma unroll
        for (int j = 0; j < 8; ++j) { const int k = 32 * s + 8 * qq + j; wv[j] = P.norm_ffn_w[l * DM + k] * P.router_w[((size_t)l * DM + k) * 16 + e]; }
#pragma unroll
        for (int j = 0; j < 4; ++j) { hi[j] = pk2(wv[2 * j], wv[2 * j + 1]); lo[j] = pk2(wv[2 * j] - bflo(hi[j]), wv[2 * j + 1] - bfhi(hi[j])); }
        Wh[i] = (u32x4){hi[0], hi[1], hi[2], hi[3]}; Wl[i] = (u32x4){lo[0], lo[1], lo[2], lo[3]}; }
    __syncthreads();
    const bf16_t* XB = (const bf16_t*)(ws + WS_XB); const float* nw = P.norm_ffn_w + l * DM + 8 * q;
    float* aff = (float*)(ws + WS_AFF); float* rs = (float*)(ws + WS_RS);
    bf16_t* XN = (bf16_t*)(ws + WS_HN);
    for (int grp = gw; grp < NTOK / 16; grp += NGW) {
        const int m0 = grp * 16;
        const bf16_t* xrow = XB + (size_t)(m0 + r) * DM + 8 * q; bf16_t* orow = XN + (size_t)(m0 + r) * DM + 8 * q; unsigned char* orow8 = (unsigned char*)XN + (size_t)(m0 + r) * DM + 8 * q; (void)orow; (void)orow8;
        f32x4 acc = {0.f, 0.f, 0.f, 0.f}; float ss = 0.f;
#pragma unroll 8
        for (int s = 0; s < 32; ++s) {
            const u32x4 xv = *(const u32x4*)(xrow + 32 * s);
            const f32x4 a = {bflo(xv.x), bfhi(xv.x), bflo(xv.y), bfhi(xv.y)}, b = {bflo(xv.z), bfhi(xv.z), bflo(xv.w), bfhi(xv.w)};
            const f32x4 wa = *(const f32x4*)(nw + 32 * s), wb = *(const f32x4*)(nw + 32 * s + 4);
            ss += (a.x * a.x + a.y * a.y) + (a.z * a.z + a.w * a.w) + (b.x * b.x + b.y * b.y) + (b.z * b.z + b.w * b.w);
            const bf16x8 ah = __builtin_bit_cast(bf16x8, xv);
            const bf16x8 wh = __builtin_bit_cast(bf16x8, Wh[s * 64 + lane]), wl = __builtin_bit_cast(bf16x8, Wl[s * 64 + lane]);
            acc = __builtin_amdgcn_mfma_f32_16x16x32_bf16(ah, wh, acc, 0, 0, 0);
            acc = __builtin_amdgcn_mfma_f32_16x16x32_bf16(ah, wl, acc, 0, 0, 0);
#if MOE_F8
            *(u32x2*)(orow8 + 32 * s) = (u32x2){pk4_fp8(a.x * wa.x, a.y * wa.y, a.z * wa.z, a.w * wa.w), pk4_fp8(b.x * wb.x, b.y * wb.y, b.z * wb.z, b.w * wb.w)};
#else
            *(u32x4*)(orow + 32 * s) = (u32x4){pk2(a.x * wa.x, a.y * wa.y), pk2(a.z * wa.z, a.w * wa.w), pk2(b.x * wb.x, b.y * wb.y), pk2(b.z * wb.z, b.w * wb.w)};
#endif
        }
        ss += __shfl_xor(ss, 16); ss += __shfl_xor(ss, 32);
        const float rinv = __builtin_amdgcn_rsqf(ss * (1.0f / DM) + EPSN);
        if (q == 0) rs[m0 + r] = rinv;
#pragma unroll
        for (int i = 0; i < 4; ++i) {
            const float lg = acc[i] * __shfl(rinv, 4 * q + i);
            float mx = lg;
#pragma unroll
            for (int o = 1; o < 16; o <<= 1) mx = fmaxf(mx, __shfl_xor(mx, o));
            const float ex = expf(lg - mx); float se = ex;
#pragma unroll
            for (int o = 1; o < 16; o <<= 1) se += __shfl_xor(se, o);
            const int m = m0 + 4 * q + i;
            aff[((size_t)(m >> 11) * 16 + r) * SEQ + (m & (SEQ - 1))] = ex / se;
        }
    }
}

DI int wave_sum_i(int v) {
#pragma unroll
    for (int o = 1; o < 64; o <<= 1) v += __shfl_xor(v, o);
    return v;
}
DI int half_excl_scan(int c, int lane, int hw, LAS int* ws4, int* tot) {
    int inc = c;
#pragma unroll
    for (int o = 1; o < 64; o <<= 1) { const int t = __shfl_up(inc, o); if (lane >= o) inc += t; }
    if (lane == 63) ws4[hw] = inc;
    __syncthreads();
    int base = 0, total = 0;
#pragma unroll
    for (int w = 0; w < 4; ++w) { const int t = ws4[w]; base += (w < hw) ? t : 0; total += t; }
    *tot = total;
    return base + inc - c;
}
DI void phase_topk(const Params& P, int l, LAS unsigned char* lds) {
    const int tid = tid_opaque(P.wv), lane = tid & 63, wave = tid >> 6;
    unsigned char* ws = P.ws;
    const float* aff = (const float*)(ws + WS_AFF); const float* rs = (const float*)(ws + WS_RS);
    int* slot = (int*)(ws + WS_SLOT); int* seli = (int*)(ws + WS_SELI); float* selg = (float*)(ws + WS_SELG); float* selr = (float*)(ws + WS_SELR);
    const int half = wave >> 2, hw = wave & 3, ht = tid & 255;
    LAS int* wsum = (LAS int*)lds + half * 64;
    for (int u0 = blockIdx.x; u0 < NB * NEXP; u0 += 2 * gridDim.x) {
        const int u = u0 + half * gridDim.x; const bool live = u < NB * NEXP; const int uu = live ? u : u0;
        const int b = uu >> 4, e = uu & 15;
        __syncthreads();
        const u32x4 ka = *(const u32x4*)(aff + (size_t)uu * SEQ + 8 * ht), kb = *(const u32x4*)(aff + (size_t)uu * SEQ + 8 * ht + 4);
        const unsigned kk[8] = {ka.x, ka.y, ka.z, ka.w, kb.x, kb.y, kb.z, kb.w};
        const f32x4 ra = *(const f32x4*)(rs + (size_t)b * SEQ + 8 * ht), rb = *(const f32x4*)(rs + (size_t)b * SEQ + 8 * ht + 4);
        const float rsv[8] = {ra.x, ra.y, ra.z, ra.w, rb.x, rb.y, rb.z, rb.w};
        unsigned prefix = 0u;
#pragma unroll 1
        for (int bit = 30; bit >= 0; bit -= (bit == 30 ? 1 : 2)) {
            const unsigned hi = 1u << bit, lo = (bit == 30) ? 0u : (1u << (bit - 1));
            const unsigned c1 = prefix | hi, c0 = prefix | lo, c3 = prefix | hi | lo;
            int n1 = 0, n0 = 0, n3 = 0;
#pragma unroll
            for (int j = 0; j < 8; ++j) { n1 += __builtin_popcountll(__ballot(kk[j] >= c1)); n0 += __builtin_popcountll(__ballot(kk[j] >= c0)); n3 += __builtin_popcountll(__ballot(kk[j] >= c3)); }
            const int par = (bit & 2) ? 12 : 0;
            if (lane == 0) { wsum[par + hw * 3] = n1; wsum[par + hw * 3 + 1] = n0; wsum[par + hw * 3 + 2] = n3; }
            __syncthreads();
            int t1 = 0, t0 = 0, t3 = 0;
#pragma unroll
            for (int q = 0; q < 4; ++q) { t1 += wsum[par + q * 3]; t0 += wsum[par + q * 3 + 1]; t3 += wsum[par + q * 3 + 2]; }
            if (bit == 30) { if (t1 >= CAP) prefix = c1; }
            else if (t1 >= CAP) prefix = (t3 >= CAP) ? c3 : c1;
            else if (t0 >= CAP) prefix = c0;
        }
        const unsigned thr = prefix;
        int cgt = 0, ceq = 0;
#pragma unroll
        for (int j = 0; j < 8; ++j) { cgt += (kk[j] > thr) ? 1 : 0; ceq += (kk[j] == thr) ? 1 : 0; }
        int ngt; (void)half_excl_scan(cgt, lane, hw, wsum + 32, &ngt);
        const int need = CAP - ngt;
        int neq; int eqr = half_excl_scan(ceq, lane, hw, wsum + 36, &neq);
        bool sel[8]; int cs = 0;
#pragma unroll
        for (int j = 0; j < 8; ++j) { const bool eq = kk[j] == thr; sel[j] = (kk[j] > thr) || (eq && eqr < need); eqr += eq ? 1 : 0; cs += sel[j] ? 1 : 0; }
        int nsel; int sb = half_excl_scan(cs, lane, hw, wsum + 40, &nsel);
        if (live) {
#pragma unroll
            for (int j = 0; j < 8; ++j) { const int i = 8 * ht + j;
                slot[((size_t)b * SEQ + i) * 16 + e] = sel[j] ? sb : -1;
                if (sel[j]) { seli[u * CAP + sb] = i; selg[u * CAP + sb] = __uint_as_float(kk[j]); selr[u * CAP + sb] = rsv[j]; ++sb; } }
        }
    }
    __syncthreads();
    {
        const int gw = blockIdx.x * 8 + wave, NGW = gridDim.x * 8;
        LAS float* scr = (LAS float*)(lds + 4096 + wave * 8448);
        bf16_t* WguT = (bf16_t*)(ws + WS_WGU); bf16_t* WdT = (bf16_t*)(ws + WS_WD);
        constexpr int I_E = 16 * 32 * 16;
        for (int it = gw; it < 3 * I_E; it += NGW) {
            const int which = it / I_E; const int r = it - which * I_E;
            const int e = r / 512, kb = (r % 512) / 32, nb = r % 32;
            const size_t wofs = ((size_t)l * NEXP + e) * DM * DM;
#if MOE_F8
            if (which == 0)      transpose_item_f8(P.moe_wg + wofs, DM, 64 * kb, 32 * nb, (unsigned char*)WguT, e * 2048 + ((32 * nb) >> 7) * 256 + ((32 * nb) & 127), 64.0f, scr, lane);
            else if (which == 1) transpose_item_f8(P.moe_wu + wofs, DM, 64 * kb, 32 * nb, (unsigned char*)WguT, e * 2048 + ((32 * nb) >> 7) * 256 + 128 + ((32 * nb) & 127), 64.0f, scr, lane);
            else                 transpose_item_f8(P.moe_wd + wofs, DM, 64 * kb, 32 * nb, (unsigned char*)WdT, e * 1024 + 32 * nb, 64.0f, scr, lane);
#else
            if (which == 0)      transpose_item(P.moe_wg + wofs, DM, 64 * kb, 32 * nb, WguT, e * 2048 + ((32 * nb) >> 7) * 256 + ((32 * nb) & 127), 1.0f, scr, lane);
            else if (which == 1) transpose_item(P.moe_wu + wofs, DM, 64 * kb, 32 * nb, WguT, e * 2048 + ((32 * nb) >> 7) * 256 + 128 + ((32 * nb) & 127), 1.0f, scr, lane);
            else                 transpose_item(P.moe_wd + wofs, DM, 64 * kb, 32 * nb, WdT, e * 1024 + 32 * nb, 1.0f, scr, lane);
#endif
        }
    }
}

DI bf16x8 mk8(unsigned a, unsigned b, unsigned c, unsigned d) { u32x4 v = {a, b, c, d}; return __builtin_bit_cast(bf16x8, v); }
DI bf16x8 cat44(u32x2 lo, u32x2 hi) { u32x4 v = {lo.x, lo.y, hi.x, hi.y}; return __builtin_bit_cast(bf16x8, v); }
DI u32x4 ldg16(const void* ub, unsigned off) { return *(const u32x4*)((const char*)ub + off); }
DI u32x2 ldg8(const void* ub, unsigned off) { return *(const u32x2*)((const char*)ub + off); }
DI void stg2(void* ub, unsigned off, unsigned short v) { *(unsigned short*)((char*)ub + off) = v; }
DI int crow(int reg, int hh) { return (reg & 3) + 8 * (reg >> 2) + 4 * hh; }
#define PACK_STEP(x, s) mk8(pk2((x)[8 * (s)], (x)[8 * (s) + 1]), pk2((x)[8 * (s) + 2], (x)[8 * (s) + 3]), pk2((x)[8 * (s) + 4], (x)[8 * (s) + 5]), pk2((x)[8 * (s) + 6], (x)[8 * (s) + 7]))

#ifndef TPROBE
#define TPROBE 0
#endif
#ifndef TPWAVE
#define TPWAVE 0
#endif
#define TP_T() ({ asm volatile("" ::: "memory"); unsigned _t = (unsigned)__builtin_amdgcn_s_memrealtime(); asm volatile("" ::: "memory"); _t; })
#define TP_B(k) unsigned _tp##k = 0; if (TPROBE == (k) || ((k) == 1 && TPROBE)) _tp##k = TP_T();
#define TP_E(k) if ((k) == 1 && TPROBE) ttot += TP_T() - _tp##k; else if (TPROBE == (k)) tacc += TP_T() - _tp##k;
#ifndef HYD
#define HYD 4
#endif
DI void hyena_unit(const Params& P, int c, LAS unsigned char* lds) {
    const int tid = tid_opaque(P.wv), lane = tid & 63, w = __builtin_amdgcn_readfirstlane(tid >> 6), r = lane & 31, hh = lane >> 5;
    constexpr int CPS = 8224;
    unsigned char* ws = P.ws; unsigned char* dsc = (unsigned char*)P.out;
    const bf16_t* kf = (const bf16_t*)(ws + WS_KFILT) + (size_t)c * 4096;
    unsigned tacc = 0, ttot = 0;
    TP_B(1)
    __syncthreads();
    TP_B(81)
    {
        const u32x4 a = *(const u32x4*)(kf + 8 * tid), b = (tid < 511) ? *(const u32x4*)(kf + 8 * tid + 8) : (u32x4){0u, 0u, 0u, 0u};
        const unsigned d[9] = {a.x, a.y, a.z, a.w, b.x, b.y, b.z, b.w, 0u};
#pragma unroll
        for (int p = 0; p < 8; ++p) { const int m = p >> 1; u32x4 o;
            if (p & 1) { o.x = __builtin_amdgcn_alignbit(d[m + 1], d[m], 16); o.y = __builtin_amdgcn_alignbit(d[m + 2], d[m + 1], 16); o.z = __builtin_amdgcn_alignbit(d[m + 3], d[m + 2], 16); o.w = __builtin_amdgcn_alignbit(d[m + 4], d[m + 3], 16); }
            else { o.x = d[m]; o.y = d[m + 1]; o.z = d[m + 2]; o.w = d[m + 3]; }
            *(LAS u32x4*)(lds + p * CPS + tid * 16) = o; }
    }
    __syncthreads();
    TP_E(81)
    const bf16_t* hw = (const bf16_t*)(dsc + DO_HW) + ((size_t)c * NB + r) * SEQ + 8 * hh;
    f32x16 acc[8];
#pragma unroll
    for (int i = 0; i < 8; ++i)
#pragma unroll
        for (int q = 0; q < 16; ++q) acc[i][q] = 0.f;
    const int p = 7 - (r & 7);
    const LAS unsigned char* abase = lds + p * CPS + (2047 - 256 * w - r + 8 * hh - p) * 2;
    LAS unsigned char* Bt = lds + 8 * CPS;
    const bf16_t* hws = (const bf16_t*)(dsc + DO_HW) + ((size_t)c * NB + (tid >> 4)) * SEQ + 4 * (tid & 15);
    const unsigned bwo = (unsigned)((tid >> 4) * 144 + (tid & 15) * 8), bro = (unsigned)(r * 144 + 16 * hh);
    TP_B(82)
    u32x2 bpre[HYD];
#pragma unroll
    for (int d = 0; d < HYD; ++d) bpre[d] = *(const u32x2*)(hws + 64 * d);
    *(LAS u32x2*)(Bt + bwo) = bpre[0];
    __syncthreads();
#pragma unroll 1
    for (int s8 = 0; s8 < SEQ; s8 += 64 * HYD) {
#pragma unroll
        for (int d = 0; d < HYD; ++d) { const int sb = s8 + 64 * d;
            if (sb + 64 < SEQ) *(LAS u32x2*)(Bt + ((d + 1) & 1) * 4608 + bwo) = bpre[(d + 1) % HYD];
            if (sb + 64 * HYD < SEQ) bpre[d] = *(const u32x2*)(hws + sb + 64 * HYD);
#pragma unroll
            for (int j = 0; j < 4; ++j) { const int s0 = sb + 16 * j; const bf16x8 bfr = *(const LAS bf16x8*)(Bt + (d & 1) * 4608 + bro + 32 * j);
#pragma unroll
                for (int i = 0; i < 8; ++i) { const bf16x8 afr = *(const LAS bf16x8*)(abase + (s0 - 32 * i) * 2); acc[i] = MFMA32(afr, bfr, acc[i]); }
                __builtin_amdgcn_sched_barrier(0); }
            __syncthreads(); }
    }
    TP_E(82)
    TP_B(83)
    const bf16_t* hx = (const bf16_t*)(dsc + DO_HX0) + ((size_t)c * NB + r) * SEQ;
    bf16_t* ya = (bf16_t*)(dsc + DO_YAT) + ((size_t)c * NB + r) * SEQ;
#pragma unroll
    for (int i = 0; i < 8; ++i)
#pragma unroll
        for (int g = 0; g < 4; ++g) { const int t = 256 * w + 32 * i + 8 * g + 4 * hh;
            const u32x2 xv = *(const u32x2*)(hx + t);
            u32x2 o; o.x = pk2(acc[i][4 * g] * bflo(xv.x), acc[i][4 * g + 1] * bfhi(xv.x)); o.y = pk2(acc[i][4 * g + 2] * bflo(xv.y), acc[i][4 * g + 3] * bfhi(xv.y));
            *(u32x2*)(ya + t) = o; }
    TP_E(83)
    TP_E(1)
    if (TPROBE >= 80 && TPROBE < 90 && lane == 0 && w == (TPWAVE)) { atomicAdd((unsigned*)(ws + WS_CTL) + 512, tacc); atomicAdd((unsigned*)(ws + WS_CTL) + 513, ttot); }
}

DI int t5_bucket(int rel) {
    const int ret = rel > 0 ? 16 : 0; const int n = rel < 0 ? -rel : rel;
    if (n < 8) return ret + n;
    const float nf = (float)n;
    int large = 8 + (int)(logf(nf / 8.0f) / 4.852030263919617f * 8.0f);
    large = large < 15 ? large : 15;
    return ret + large;
}
#ifndef ATT_FAST
#define ATT_FAST 0
#endif
struct AttPass { int d, rho, uq0, nq; };
DI AttPass att_pass(int pp, int Q0, int w) {
    AttPass a;
    if (pp == 0) { a.d = 1; a.rho = 0; a.uq0 = Q0 + 32 * w; a.nq = 32; }
    else if (pp == 1) { a.d = 4; a.rho = w & 3; a.uq0 = (Q0 >> 2) + 32 * (w >> 2); a.nq = 32; }
    else { a.d = 16; a.rho = 2 * w + (pp - 2); a.uq0 = Q0 >> 4; a.nq = 16; }
    return a;
}
DI void attn_unit(const Params& P, int u, LAS unsigned char* lds, int& bias_h) {
    unsigned tacc = 0, ttot = 0;
    const int qb = u & 7, h = (u >> 3) & 3, b = u >> 5;
    const int tid = tid_opaque(P.wv), lane = tid & 63, w = __builtin_amdgcn_readfirstlane(tid >> 6), c = lane & 31, hh = lane >> 5;
    LAS float* Ost = (LAS float*)lds;
    LAS float* Mst = (LAS float*)(lds + 69632);
    LAS float* Lst = Mst + 256;
    LAS float* biasT = (LAS float*)(lds + 69632 + 2048);
    LAS unsigned char* Vr = lds + 69632 + 2048 + 12800 + w * 6144;
    unsigned char* ws = P.ws;
    TP_B(1)
    { TP_B(3) __syncthreads(); TP_E(3) }
    if (bias_h != h) {
        const float* relb = P.rel_bias; asm volatile("" : "+s"(relb));
        for (int i = tid; i < 4 * 768; i += 512) { const int s = i / 768, jx = i - 768 * s; const int pat = jx >> 8, rel = (jx & 255) - 128, dd = pat == 0 ? 1 : (pat == 1 ? 4 : 16);
            biasT[s * 784 + jx + s] = (rel >= -64 && rel <= 64) ? relb[t5_bucket(rel * dd) * 4 + h] * 1.4426950408889634f : -INFINITY; }
        __syncthreads();
        bias_h = h;
    }
    const bf16_t* pb = (const bf16_t*)(ws + WS_PROJ) + (size_t)b * SEQ * NPROJ;
    bf16_t* MIX = (bf16_t*)(ws + WS_HN);
    const int Q0 = qb * 256;
    const int i16 = lane & 15, trq = i16 >> 2, trp = i16 & 3;
    const unsigned troff = (unsigned)((4 * hh + trq) * 192 + (16 * ((lane >> 4) & 1) + 4 * trp) * 2);
    const int r8 = lane >> 3, j8 = lane & 7;
#define ATT_LOAD(KF, VR, KT, AP) do { const int nsub_ = SEQ / (AP).d, tlo_ = (AP).uq0 - 64 + 32 * (KT); \
        if (ATT_FAST && tlo_ >= 0 && tlo_ + 31 < nsub_) {                   \
            const unsigned lo_ = (unsigned)(r8 * (AP).d * NPROJ + 8 * j8) * 2u; \
            _Pragma("unroll") for (int i = 0; i < 4; ++i) { const bf16_t* b_ = pb + (size_t)(((tlo_ + 8 * i) * (AP).d + (AP).rho) * NPROJ + h * 64); \
                KF[i] = __builtin_bit_cast(bf16x8, ldg16(b_ + PC_AK, lo_)); VR[i] = ldg16(b_ + PC_AV, lo_); } \
        } else { \
            _Pragma("unroll") for (int i = 0; i < 4; ++i) { const int ukr_ = tlo_ + 8 * i + r8; const int ukc_ = ukr_ < 0 ? 0 : (ukr_ >= nsub_ ? nsub_ - 1 : ukr_); \
                const unsigned ko_ = (unsigned)((ukc_ * (AP).d + (AP).rho) * NPROJ + h * 64 + 8 * j8) * 2u; \
                KF[i] = __builtin_bit_cast(bf16x8, ldg16(pb + PC_AK, ko_)); VR[i] = ldg16(pb + PC_AV, ko_); } } } while (0)
#define ATT_TILE(KF, VR, KT, NEXTLOAD) do { const int kt = (KT); \
        bf16x8 kq_[4]; \
        f32x16 st;                                                          \
        _Pragma("unroll") for (int g = 0; g < 4; ++g) { const f32x4 bv_ = *(const LAS f32x4*)(tb4 + 32 * kt + 8 * g); st[4 * g] = bv_.x; st[4 * g + 1] = bv_.y; st[4 * g + 2] = bv_.z; st[4 * g + 3] = bv_.w; } \
        _Pragma("unroll") for (int i = 0; i < 4; ++i) *(LAS bf16x8*)(Vr + (8 * i + r8) * 144 + 16 * j8) = KF[i]; \
        _Pragma("unroll") for (int ks = 0; ks < 4; ++ks) kq_[ks] = *(const LAS bf16x8*)(Vr + c * 144 + 32 * ks + 16 * hh); \
        _Pragma("unroll") for (int i = 0; i < 4; ++i) *(LAS u32x4*)(Vr + (8 * i + r8) * 192 + 16 * j8) = VR[i]; \
        _Pragma("unroll") for (int ks = 0; ks < 4; ++ks) st = MFMA32(kq_[ks], qf[ks], st); \
        NEXTLOAD; \
        float tmax = -INFINITY; float lg[16]; \
        { const int tlo = uk0 + 32 * kt; \
          if (tlo >= 0 && tlo + 31 < nsub) { \
            _Pragma("unroll") for (int q = 0; q < 16; ++q) { lg[q] = st[q]; tmax = fmaxf(tmax, lg[q]); } \
          } else { \
            _Pragma("unroll") for (int q = 0; q < 16; ++q) { const int uk = tlo + crow(q, hh); lg[q] = (uk >= 0 && uk < nsub) ? st[q] : -INFINITY; tmax = fmaxf(tmax, lg[q]); } \
          } } \
        tmax = xhalf_max(tmax); \
        if (__any(tmax > mrun + 8.0f)) { const float mnew = fmaxf(mrun, tmax), alpha = __builtin_amdgcn_exp2f(mrun - mnew); lrun *= alpha; mrun = mnew; \
            _Pragma("unroll") for (int dt = 0; dt < 2; ++dt) _Pragma("unroll") for (int q = 0; q < 16; ++q) OT[dt][q] *= alpha; } \
        float psum = 0.f; \
        _Pragma("unroll") for (int q = 0; q < 16; ++q) { lg[q] = __builtin_amdgcn_exp2f(lg[q] - mrun); psum += lg[q]; } \
        lrun += xhalf_sum(psum); \
        LDS_WAIT(); \
        _Pragma("unroll") for (int s = 0; s < 2; ++s) { const bf16x8 pf = PACK_STEP(lg, s); \
            _Pragma("unroll") for (int dt = 0; dt < 2; ++dt) { \
                const s16x4 lo = __builtin_amdgcn_ds_read_tr16_b64_v4i16((LAS s16x4*)(Vr + troff + (16 * s) * 192 + 64 * dt)); \
                const s16x4 hi = __builtin_amdgcn_ds_read_tr16_b64_v4i16((LAS s16x4*)(Vr + troff + (16 * s + 8) * 192 + 64 * dt)); \
                OT[dt] = MFMA32(__builtin_shufflevector(lo, hi, 0, 1, 2, 3, 4, 5, 6, 7), pf, OT[dt]); } } \
        LDS_WAIT(); } while (0)
    bf16x8 kfA[4], kfB[4]; u32x4 vrA[4], vrB[4];
    bf16x8 qnext[4];
    { const AttPass a0 = att_pass(0, Q0, w);
      ATT_LOAD(kfA, vrA, 0, a0); ATT_LOAD(kfB, vrB, 1, a0);
      const int qpos0 = a0.uq0 + c;
#pragma unroll
      for (int ks = 0; ks < 4; ++ks) qnext[ks] = *(const bf16x8*)(pb + (size_t)qpos0 * NPROJ + PC_AQ + h * 64 + 16 * ks + 8 * hh); }
    auto pass = [&](const int pp, bf16x8 (&kf0)[4], u32x4 (&vr0)[4], bf16x8 (&kf1)[4], u32x4 (&vr1)[4]) __attribute__((always_inline)) {
        const int pat = pp < 2 ? pp : 2;
        const AttPass ap = att_pass(pp, Q0, w), an = att_pass(pp < 3 ? pp + 1 : 3, Q0, w);
        const int d = ap.d, rho = ap.rho, uq0 = ap.uq0, nq = ap.nq;
        const int uk0 = uq0 - 64, nsub = SEQ / d;
        const int cq = (c < nq) ? c : c - nq;
        const int qpos = (uq0 + cq) * d + rho, ql = qpos - Q0;
        const LAS float* tb4 = biasT + (cq & 3) * 784 + pat * 256 + (64 - cq + 4 * hh + (cq & 3));
        bf16x8 qf[4];
#pragma unroll
        for (int ks = 0; ks < 4; ++ks) qf[ks] = qnext[ks];
        if (pp < 3) {
            const int cq2 = (c < an.nq) ? c : c - an.nq; const int qpos2 = (an.uq0 + cq2) * an.d + an.rho;
#pragma unroll
            for (int ks = 0; ks < 4; ++ks) qnext[ks] = *(const bf16x8*)(pb + (size_t)qpos2 * NPROJ + PC_AQ + h * 64 + 16 * ks + 8 * hh); }
        float mrun = -1.0e30f, lrun = 0.f; f32x16 OT[2];
#pragma unroll
        for (int dt = 0; dt < 2; ++dt)
#pragma unroll
            for (int q = 0; q < 16; ++q) OT[dt][q] = 0.f;
        if (pat != 0) { mrun = Mst[ql]; lrun = Lst[ql];
#pragma unroll
            for (int dt = 0; dt < 2; ++dt)
#pragma unroll
                for (int g = 0; g < 4; ++g) { const f32x4 v = *(const LAS f32x4*)(Ost + ql * 68 + 32 * dt + 8 * g + 4 * hh);
                    OT[dt][4 * g] = v.x; OT[dt][4 * g + 1] = v.y; OT[dt][4 * g + 2] = v.z; OT[dt][4 * g + 3] = v.w; } }
        { TP_B(2)
        ATT_TILE(kf0, vr0, 0, ATT_LOAD(kf0, vr0, 2, ap)); ATT_TILE(kf1, vr1, 1, ATT_LOAD(kf1, vr1, 3, ap)); ATT_TILE(kf0, vr0, 2, ATT_LOAD(kf0, vr0, 4, ap));
        ATT_TILE(kf1, vr1, 3, if (pp < 3) { AttPass an_ = an; asm volatile("" : "+s"(an_.d), "+s"(an_.rho), "+s"(an_.uq0)); ATT_LOAD(kf1, vr1, 0, an_); });
        ATT_TILE(kf0, vr0, 4, if (pp < 3) { AttPass an_ = an; asm volatile("" : "+s"(an_.d), "+s"(an_.rho), "+s"(an_.uq0)); ATT_LOAD(kf0, vr0, 1, an_); });
        TP_E(2) }
        if (pat != 2) {
            if (hh == 0) { Mst[ql] = mrun; Lst[ql] = lrun; }
#pragma unroll
            for (int dt = 0; dt < 2; ++dt)
#pragma unroll
                for (int g = 0; g < 4; ++g) *(LAS f32x4*)(Ost + ql * 68 + 32 * dt + 8 * g + 4 * hh) = (f32x4){OT[dt][4 * g], OT[dt][4 * g + 1], OT[dt][4 * g + 2], OT[dt][4 * g + 3]};
        } else if (c < 16) {
            const float inv = __builtin_amdgcn_rcpf(lrun);
            bf16_t* orow = MIX + ((size_t)b * SEQ + qpos) * DM + 512 + h * 64;
#pragma unroll
            for (int dt = 0; dt < 2; ++dt)
#pragma unroll
                for (int g = 0; g < 4; ++g) { u32x2 o; o.x = pk2(OT[dt][4 * g] * inv, OT[dt][4 * g + 1] * inv); o.y = pk2(OT[dt][4 * g + 2] * inv, OT[dt][4 * g + 3] * inv);
                    *(u32x2*)(orow + 32 * dt + 8 * g + 4 * hh) = o; }
        }
        { TP_B(3) if (pp < 2) __syncthreads(); TP_E(3) }
    };
#pragma unroll 1
    for (int p2 = 0; p2 < 2; ++p2) { pass(2 * p2, kfA, vrA, kfB, vrB); pass(2 * p2 + 1, kfB, vrB, kfA, vrA); }
#undef ATT_LOAD
#undef ATT_TILE
    TP_E(1)
    if (TPROBE && TPROBE < 10 && (tid & 63) == 0 && w == (TPWAVE)) { atomicAdd((unsigned*)(ws + WS_CTL) + 512, tacc); atomicAdd((unsigned*)(ws + WS_CTL) + 513, ttot); }
}

DI float softplus_f(float x) { return x > 15.f ? x : __logf(1.0f + __expf(x)); }
DI unsigned short hsel(const u32x4& v, int c) { const unsigned w = (c >> 1) == 0 ? v.x : ((c >> 1) == 1 ? v.y : ((c >> 1) == 2 ? v.z : v.w)); return (unsigned short)((c & 1) ? (w >> 16) : (w & 0xffffu)); }
DI void mamba_unit(const Params& P, int l, int u, LAS unsigned char* lds) {
    const int dir = u & 1, h = (u >> 1) & 3, b = u >> 3, g = h >> 1;
    const int tid = tid_opaque(P.wv), lane_f = tid & 63, w = __builtin_amdgcn_readfirstlane(tid >> 6);
    LAS unsigned char* wl = lds + w * 15616;
    LAS unsigned short* xdT = (LAS unsigned short*)wl;
    LAS unsigned short* xwT = xdT + 64 * 40;
    LAS unsigned short* BT = xwT + 64 * 40;
    LAS float* dtv = (LAS float*)(wl + 15360);
    LAS float* acum = dtv + 32;
    LAS float* Atot = (LAS float*)(lds + 8 * 15616);
    unsigned char* ws = P.ws; unsigned char* dsc = (unsigned char*)P.out;
    const bf16_t* xbc = (const bf16_t*)(dsc + DO_MXBC) + (size_t)b * SEQ * 512;
    const float* dtr = (const float*)(ws + WS_DT) + (size_t)b * SEQ * 8 + dir * 4 + h;
    bf16_t* MYD = (bf16_t*)(dir ? (ws + WS_MYB) : (dsc + DO_MY)) + (size_t)b * SEQ * 256 + h * 64;
    float* stsc = (float*)(dsc + DO_MST) + (size_t)u * (8 * 4096);
    const float dtb = P.m_dt_bias[l * 8 + dir * 4 + h], Aneg = -expf(P.m_A_log[l * 8 + dir * 4 + h]);
    __syncthreads();
#define MTK(c0, j) (dir ? (c0) + 31 - (j) : (c0) + (j))
#define MCH(ci) (256 * w + 32 * (dir ? 7 - (ci) : (ci)))
#pragma unroll 1
    for (int pass = 0; pass < 2; ++pass) {
        int lane_p = lane_f; asm volatile("" : "+v"(lane_p));
        const int lane = lane_p, c32 = lane_p & 31, hh = lane_p >> 5, tg = lane_p >> 3, cg = lane_p & 7;
        f32x16 ST[2][2];
#pragma unroll
        for (int a = 0; a < 2; ++a)
#pragma unroll
            for (int q = 0; q < 2; ++q)
#pragma unroll
                for (int i = 0; i < 16; ++i) ST[a][q][i] = 0.f;
        if (pass == 1) {
            const int nv = dir ? 7 - w : w;
            for (int k = 0; k < nv; ++k) { const int v = dir ? 7 - k : k; const float dec = Atot[v];
                const f32x4* sp = (const f32x4*)(stsc + (size_t)v * 4096 + lane * 64);
#pragma unroll
                for (int a = 0; a < 2; ++a)
#pragma unroll
                    for (int q = 0; q < 2; ++q)
#pragma unroll
                        for (int i4 = 0; i4 < 4; ++i4) { const f32x4 t = sp[(a * 2 + q) * 4 + i4];
                            ST[a][q][4 * i4] = ST[a][q][4 * i4] * dec + t.x; ST[a][q][4 * i4 + 1] = ST[a][q][4 * i4 + 1] * dec + t.y; ST[a][q][4 * i4 + 2] = ST[a][q][4 * i4 + 2] * dec + t.z; ST[a][q][4 * i4 + 3] = ST[a][q][4 * i4 + 3] * dec + t.w; } }
        }
        float atot = 0.f;
        u32x4 rx[4], rB[4]; float rdt;
        { const int c0 = MCH(0);
#pragma unroll
          for (int i = 0; i < 4; ++i) { const unsigned ro = (unsigned)(MTK(c0, 4 * tg + i) * 512 + 8 * cg) * 2u; rx[i] = ldg16(xbc + h * 64, ro); rB[i] = ldg16(xbc + 256 + g * 64, ro); }
          rdt = *(const float*)((const char*)dtr + (unsigned)(MTK(c0, c32) * 32)); }
#pragma unroll 1
        for (int ci = 0; ci < 8; ++ci) {
            int lane_i = lane; asm volatile("" : "+v"(lane_i));
            const int c32 = lane_i & 31, hh = lane_i >> 5, tg = lane_i >> 3, cg = lane_i & 7;
            const int c0 = MCH(ci);
            {
                const float dt = softplus_f(rdt + dtb);
                float ac = dt * Aneg;
#pragma unroll
                for (int o = 1; o < 32; o <<= 1) { const float t = __shfl_up(ac, o, 32); if (c32 >= o) ac += t; }
                if (lane < 32) { dtv[c32] = dt; acum[c32] = ac; }
            }
            LDS_WAIT();
            const float aend = acum[31];
            {
                const f32x4 d4 = *(const LAS f32x4*)(dtv + 4 * tg), a4 = *(const LAS f32x4*)(acum + 4 * tg);
                const float dj[4] = {d4.x, d4.y, d4.z, d4.w};
                const float wj[4] = {__expf(aend - a4.x), __expf(aend - a4.y), __expf(aend - a4.z), __expf(aend - a4.w)};
#pragma unroll
                for (int c = 0; c < 8; ++c) {
                    float xd[4]; unsigned short bb[4];
#pragma unroll
                    for (int i = 0; i < 4; ++i) { xd[i] = bf2f(hsel(rx[i], c)) * dj[i]; bb[i] = hsel(rB[i], c); }
                    *(LAS u32x2*)(xdT + (8 * cg + c) * 40 + 4 * tg) = (u32x2){pk2(xd[0], xd[1]), pk2(xd[2], xd[3])};
                    *(LAS u32x2*)(xwT + (8 * cg + c) * 40 + 4 * tg) = (u32x2){pk2(xd[0] * wj[0], xd[1] * wj[1]), pk2(xd[2] * wj[2], xd[3] * wj[3])};
                    *(LAS u32x2*)(BT + (8 * cg + c) * 40 + 4 * tg) = (u32x2){(unsigned)bb[0] | ((unsigned)bb[1] << 16), (unsigned)bb[2] | ((unsigned)bb[3] << 16)};
                }
            }
            if (ci < 7) { const int c1 = MCH(ci + 1);
#pragma unroll
                for (int i = 0; i < 4; ++i) { const unsigned ro = (unsigned)(MTK(c1, 4 * tg + i) * 512 + 8 * cg) * 2u; rx[i] = ldg16(xbc + h * 64, ro); rB[i] = ldg16(xbc + 256 + g * 64, ro); }
                rdt = *(const float*)((const char*)dtr + (unsigned)(MTK(c1, c32) * 32)); }
            LDS_WAIT();
            if (pass == 1) {
                const unsigned bro = (unsigned)(MTK(c0, c32) * 512 + 8 * hh) * 2u;
                f32x16 GT;
#pragma unroll
                for (int i = 0; i < 16; ++i) GT[i] = 0.f;
#pragma unroll
                for (int ks = 0; ks < 4; ++ks) GT = MFMA32(__builtin_bit_cast(bf16x8, ldg16(xbc + 256 + g * 64 + 16 * ks, bro)), __builtin_bit_cast(bf16x8, ldg16(xbc + 384 + g * 64 + 16 * ks, bro)), GT);
                const float acl = acum[c32];
#pragma unroll
                for (int i = 0; i < 16; ++i) { const int s = crow(i, hh); GT[i] = (s <= c32) ? GT[i] * __expf(acl - acum[s]) : 0.f; }
                f32x16 Y[2];
#pragma unroll
                for (int pt = 0; pt < 2; ++pt)
#pragma unroll
                    for (int i = 0; i < 16; ++i) Y[pt][i] = 0.f;
#pragma unroll
                for (int s = 0; s < 2; ++s) { const bf16x8 pa = PACK_STEP(GT, s);
#pragma unroll
                    for (int pt = 0; pt < 2; ++pt) { const LAS unsigned short* xr = xdT + (32 * pt + c32) * 40 + 16 * s + 4 * hh;
                        Y[pt] = MFMA32(pa, cat44(*(const LAS u32x2*)xr, *(const LAS u32x2*)(xr + 8)), Y[pt]); } }
                const unsigned cro = (unsigned)(MTK(c0, c32) * 512 + 4 * hh) * 2u;
                const float el = __expf(acl);
#pragma unroll
                for (int nt = 0; nt < 2; ++nt)
#pragma unroll
                    for (int s = 0; s < 2; ++s) { const u32x2 clo = ldg8(xbc + 384 + g * 64 + 32 * nt + 16 * s, cro), chi = ldg8(xbc + 384 + g * 64 + 32 * nt + 16 * s + 8, cro);
                        const bf16x8 ca = mk8(pk2(bflo(clo.x) * el, bfhi(clo.x) * el), pk2(bflo(clo.y) * el, bfhi(clo.y) * el), pk2(bflo(chi.x) * el, bfhi(chi.x) * el), pk2(bflo(chi.y) * el, bfhi(chi.y) * el));
#pragma unroll
                        for (int pt = 0; pt < 2; ++pt) Y[pt] = MFMA32(ca, PACK_STEP(ST[nt][pt], s), Y[pt]); }
#pragma unroll
                for (int i = 0; i < 16; ++i) { const unsigned oo = (unsigned)(MTK(c0, crow(i, hh)) * 256 + c32) * 2u; stg2(MYD, oo, f2bf(Y[0][i])); stg2(MYD + 32, oo, f2bf(Y[1][i])); }
            }
            {
                const float de = __expf(aend);
#pragma unroll
                for (int nt = 0; nt < 2; ++nt)
#pragma unroll
                    for (int pt = 0; pt < 2; ++pt)
#pragma unroll
                        for (int i = 0; i < 16; ++i) ST[nt][pt][i] *= de;
#pragma unroll
                for (int s = 0; s < 2; ++s)
#pragma unroll
                    for (int nt = 0; nt < 2; ++nt) { const bf16x8 ba = *(const LAS bf16x8*)(BT + (32 * nt + c32) * 40 + 16 * s + 8 * hh);
#pragma unroll
                        for (int pt = 0; pt < 2; ++pt) ST[nt][pt] = MFMA32(ba, *(const LAS bf16x8*)(xwT + (32 * pt + c32) * 40 + 16 * s + 8 * hh), ST[nt][pt]); }
            }
            atot += aend;
            LDS_WAIT();
        }
        if (pass == 0) {
            f32x4* sp = (f32x4*)(stsc + (size_t)w * 4096 + lane * 64);
#pragma unroll
            for (int a = 0; a < 2; ++a)
#pragma unroll
                for (int q = 0; q < 2; ++q)
#pragma unroll
                    for (int i4 = 0; i4 < 4; ++i4) sp[(a * 2 + q) * 4 + i4] = (f32x4){ST[a][q][4 * i4], ST[a][q][4 * i4 + 1], ST[a][q][4 * i4 + 2], ST[a][q][4 * i4 + 3]};
            if (lane == 0) Atot[w] = __expf(atot);
            VM_WAIT(); __syncthreads();
        }
    }
#undef MTK
#undef MCH
    __syncthreads();
}

DI void hgrn_unit(const Params& P, int l, int u, LAS unsigned char* lds) {
    const int dir = u & 1, h = (u >> 1) & 3, b = u >> 3;
    const int tid = tid_opaque(P.wv), lane_f = tid & 63, w = __builtin_amdgcn_readfirstlane(tid >> 6);
    LAS unsigned char* wl = lds + w * 15104;
    LAS unsigned short* qd = (LAS unsigned short*)wl;
    LAS unsigned short* kd = qd + 32 * 72;
    LAS unsigned short* vT = kd + 32 * 72;
    LAS float* eref = (LAS float*)(wl + 14336);
    LAS float* eglr = eref + 64;
    LAS float* egl = eglr + 64;
    LAS float* lbt = (LAS float*)(lds + 8 * 15104 + 2048 + w * 512);
    LAS float* gsum = lbt + 64;
    LAS float* Atot = (LAS float*)(lds + 8 * 15104);
    unsigned char* ws = P.ws; unsigned char* dsc = (unsigned char*)P.out;
    const bf16_t* proj = (const bf16_t*)(ws + WS_PROJ) + (size_t)b * SEQ * NPROJ;
    bf16_t* OD = (dir ? (bf16_t*)(ws + WS_OB) + (size_t)b * SEQ * 256 + h * 64 : (bf16_t*)(ws + WS_HN) + (size_t)b * SEQ * DM + 768 + h * 64);
    const int ostride = dir ? 256 : DM;
    float* stsc = (float*)(dsc + DO_HST) + (size_t)u * (8 * 4096);
    __syncthreads();
    { float lb = 0.f;
      if (l == 1) { const float h0 = P.hg_lb[(0 * 2 + dir) * 256 + h * 64 + lane_f], h1 = P.hg_lb[(1 * 2 + dir) * 256 + h * 64 + lane_f]; lb = 1.0f / (1.0f + expf(h0 - h1)); }
      lbt[lane_f] = lb; }
    LDS_WAIT();
#define HTK(c0, j) (dir ? (c0) + 31 - (j) : (c0) + (j))
#define HCH(ci) (256 * w + 32 * (dir ? 7 - (ci) : (ci)))
#pragma unroll 1
    for (int pass = 0; pass < 2; ++pass) {
        int lane_p = lane_f; asm volatile("" : "+v"(lane_p));
        const int lane = lane_p, c32 = lane_p & 31, hh = lane_p >> 5, tg = lane_p >> 3, cg = lane_p & 7;
        f32x16 S[2][2];
#pragma unroll
        for (int a = 0; a < 2; ++a)
#pragma unroll
            for (int q = 0; q < 2; ++q)
#pragma unroll
                for (int i = 0; i < 16; ++i) S[a][q][i] = 0.f;
        if (pass == 1) {
            const int nv = dir ? 7 - w : w;
            for (int k = 0; k < nv; ++k) { const int v = dir ? 7 - k : k; const LAS float* at = Atot + v * 64;
                const f32x4* sp = (const f32x4*)(stsc + (size_t)v * 4096 + lane * 64);
#pragma unroll
                for (int a = 0; a < 2; ++a)
#pragma unroll
                    for (int i4 = 0; i4 < 4; ++i4) { const f32x4 dec = *(const LAS f32x4*)(at + 32 * a + 8 * i4 + 4 * hh);
#pragma unroll
                        for (int q = 0; q < 2; ++q) { const f32x4 t = sp[(a * 2 + q) * 4 + i4];
                            S[a][q][4 * i4] = S[a][q][4 * i4] * dec.x + t.x; S[a][q][4 * i4 + 1] = S[a][q][4 * i4 + 1] * dec.y + t.y; S[a][q][4 * i4 + 2] = S[a][q][4 * i4 + 2] * dec.z + t.z; S[a][q][4 * i4 + 3] = S[a][q][4 * i4 + 3] * dec.w + t.w; } } }
        }
        gsum[lane] = 1.0f;
        u32x4 rf[4], rq[4];
        { const int c0 = HCH(0);
#pragma unroll
          for (int i = 0; i < 4; ++i) { const unsigned ro = (unsigned)(HTK(c0, 4 * tg + i) * NPROJ + 8 * cg) * 2u;
              rf[i] = ldg16(proj + PC_HF + dir * 256 + h * 64, ro); rq[i] = (pass == 1) ? ldg16(proj + PC_HQ + h * 64, ro) : (u32x4){0u, 0u, 0u, 0u}; } }
#pragma unroll 1
        for (int ci = 0; ci < 8; ++ci) {
            int lane_i = lane; asm volatile("" : "+v"(lane_i));
            const int c32 = lane_i & 31, hh = lane_i >> 5, tg = lane_i >> 3, cg = lane_i & 7;
            const int c0 = HCH(ci);
            {
                float qprev[4], kprev[4];
                u32x4 rv[4];
#pragma unroll
                for (int i = 0; i < 4; ++i) { const unsigned ro = (unsigned)(HTK(c0, 4 * tg + i) * NPROJ + 8 * cg) * 2u; rv[i] = ldg16(proj + PC_HI + h * 64, ro); }
                const f32x4 lb0 = *(const LAS f32x4*)(lbt + 8 * cg), lb1 = *(const LAS f32x4*)(lbt + 8 * cg + 4);
                const float lbv[8] = {lb0.x, lb0.y, lb0.z, lb0.w, lb1.x, lb1.y, lb1.z, lb1.w};
#pragma unroll
                for (int c = 0; c < 8; ++c) {
                    const float lb = lbv[c], oml = 1.0f - lb;
                    float pl[4], kr[4];
#pragma unroll
                    for (int i = 0; i < 4; ++i) { const float fpre = bf2f(hsel(rf[i], c)); const float en = __expf(-fpre), sg = __builtin_amdgcn_rcpf(1.0f + en);
                        const float ff = lb + oml * sg; pl[i] = (i == 0) ? ff : pl[i - 1] * ff; kr[i] = oml * en * sg; }
                    float incl = pl[3];
#pragma unroll
                    for (int o = 8; o < 64; o <<= 1) { const float t = shfl_up_l(incl, o, lane); if (lane >= o) incl *= t; }
                    float excl = shfl_up_l(incl, 8, lane); if (lane < 8) excl = 1.0f;
                    const float pref = __shfl(incl, 24 + cg), plast = __shfl(incl, 56 + cg);
                    const float ipref = __builtin_amdgcn_rcpf(pref);
                    if (tg == 0) { eref[8 * cg + c] = pref; eglr[8 * cg + c] = plast * ipref; egl[8 * cg + c] = plast; gsum[8 * cg + c] *= plast; }
                    float kv[4], qv[4];
#pragma unroll
                    for (int i = 0; i < 4; ++i) { const float pj = excl * pl[i]; kv[i] = kr[i] * pref * __builtin_amdgcn_rcpf(pj);
                        if (pass == 1) { const float qr = bf2f(hsel(rq[i], c)); qv[i] = qr * __builtin_amdgcn_rcpf(1.0f + __expf(-qr)) * pj * ipref; } else qv[i] = 0.f; }
                    if (c & 1) {
#pragma unroll
                        for (int i = 0; i < 4; ++i) { *(LAS unsigned*)(kd + (4 * tg + i) * 72 + 8 * cg + c - 1) = pk2(kprev[i], kv[i]);
                            if (pass == 1) *(LAS unsigned*)(qd + (4 * tg + i) * 72 + 8 * cg + c - 1) = pk2(qprev[i], qv[i]); }
                    } else {
#pragma unroll
                        for (int i = 0; i < 4; ++i) { kprev[i] = kv[i]; qprev[i] = qv[i]; }
                    }
                }
#pragma unroll
                for (int c = 0; c < 8; ++c) { unsigned short vb[4];
#pragma unroll
                    for (int i = 0; i < 4; ++i) vb[i] = hsel(rv[i], c);
                    *(LAS u32x2*)(vT + (8 * cg + c) * 40 + 4 * tg) = (u32x2){(unsigned)vb[0] | ((unsigned)vb[1] << 16), (unsigned)vb[2] | ((unsigned)vb[3] << 16)}; }
            }
            if (ci < 7) { const int c1 = HCH(ci + 1);
#pragma unroll
                for (int i = 0; i < 4; ++i) { const unsigned ro = (unsigned)(HTK(c1, 4 * tg + i) * NPROJ + 8 * cg) * 2u;
                    rf[i] = ldg16(proj + PC_HF + dir * 256 + h * 64, ro); if (pass == 1) rq[i] = ldg16(proj + PC_HQ + h * 64, ro); } }
            LDS_WAIT(); __builtin_amdgcn_sched_barrier(0);
            bf16x8 vperm[2][2];
#pragma unroll
            for (int s = 0; s < 2; ++s)
#pragma unroll
                for (int pt = 0; pt < 2; ++pt) { const LAS unsigned short* vr = vT + (32 * pt + c32) * 40 + 16 * s + 4 * hh; vperm[s][pt] = cat44(*(const LAS u32x2*)vr, *(const LAS u32x2*)(vr + 8)); }
            if (pass == 1) {
                f32x16 SC;
#pragma unroll
                for (int i = 0; i < 16; ++i) SC[i] = 0.f;
#pragma unroll
                for (int ks = 0; ks < 4; ++ks) SC = MFMA32(*(const LAS bf16x8*)(kd + c32 * 72 + 16 * ks + 8 * hh), *(const LAS bf16x8*)(qd + c32 * 72 + 16 * ks + 8 * hh), SC);
#pragma unroll
                for (int i = 0; i < 16; ++i) SC[i] = (crow(i, hh) <= c32) ? SC[i] : 0.f;
                const bf16x8 pa0 = PACK_STEP(SC, 0), pa1 = PACK_STEP(SC, 1);
                bf16x8 qa[2][2];
#pragma unroll
                for (int et = 0; et < 2; ++et)
#pragma unroll
                    for (int s = 0; s < 2; ++s) { const LAS unsigned short* qr = qd + c32 * 72 + 32 * et + 16 * s + 4 * hh; qa[et][s] = cat44(*(const LAS u32x2*)qr, *(const LAS u32x2*)(qr + 8)); }
#pragma unroll
                for (int pt = 0; pt < 2; ++pt) {
                    f32x16 O;
#pragma unroll
                    for (int i = 0; i < 16; ++i) O[i] = 0.f;
                    O = MFMA32(pa0, vperm[0][pt], O); O = MFMA32(pa1, vperm[1][pt], O);
#pragma unroll
                    for (int et = 0; et < 2; ++et)
#pragma unroll
                        for (int s = 0; s < 2; ++s) { const f32x4 e0 = *(const LAS f32x4*)(eref + 32 * et + 16 * s + 4 * hh), e1 = *(const LAS f32x4*)(eref + 32 * et + 16 * s + 8 + 4 * hh);
                            const f32x16& sv = S[et][pt];
                            const bf16x8 sb = mk8(pk2(sv[8 * s] * e0.x, sv[8 * s + 1] * e0.y), pk2(sv[8 * s + 2] * e0.z, sv[8 * s + 3] * e0.w), pk2(sv[8 * s + 4] * e1.x, sv[8 * s + 5] * e1.y), pk2(sv[8 * s + 6] * e1.z, sv[8 * s + 7] * e1.w));
                            O = MFMA32(qa[et][s], sb, O); }
#pragma unroll
                    for (int i = 0; i < 16; ++i) { const unsigned oo = (unsigned)(HTK(c0, crow(i, hh)) * ostride + c32) * 2u; stg2(OD + 32 * pt, oo, f2bf(O[i])); }
                    __builtin_amdgcn_sched_barrier(0);
                }
            }
            __builtin_amdgcn_sched_barrier(0);
            {
#pragma unroll
                for (int et = 0; et < 2; ++et) {
                    f32x16 X;
#pragma unroll
                    for (int i = 0; i < 16; ++i) X[i] = 0.f;
#pragma unroll
                    for (int s = 0; s < 2; ++s) { unsigned idw[4];
#pragma unroll
                        for (int j = 0; j < 4; ++j) { const int k0 = 16 * s + 8 * hh + 2 * j; idw[j] = (k0 == c32 ? 0x3f80u : 0u) | (k0 + 1 == c32 ? 0x3f800000u : 0u); }
                        X = MFMA32(*(const LAS bf16x8*)(kd + c32 * 72 + 32 * et + 16 * s + 8 * hh), mk8(idw[0], idw[1], idw[2], idw[3]), X); }
                    const float sc = eglr[32 * et + c32];
#pragma unroll
                    for (int i = 0; i < 16; ++i) X[i] *= sc;
                    float dg[16];
#pragma unroll
                    for (int i = 0; i < 16; ++i) dg[i] = egl[32 * et + crow(i, hh)];
#pragma unroll
                    for (int pt = 0; pt < 2; ++pt) {
#pragma unroll
                        for (int i = 0; i < 16; ++i) S[et][pt][i] *= dg[i];
#pragma unroll
                        for (int s = 0; s < 2; ++s) S[et][pt] = MFMA32(PACK_STEP(X, s), vperm[s][pt], S[et][pt]); }
                }
            }
            LDS_WAIT();
        }
        if (pass == 0) {
            f32x4* sp = (f32x4*)(stsc + (size_t)w * 4096 + lane * 64);
#pragma unroll
            for (int a = 0; a < 2; ++a)
#pragma unroll
                for (int q = 0; q < 2; ++q)
#pragma unroll
                    for (int i4 = 0; i4 < 4; ++i4) sp[(a * 2 + q) * 4 + i4] = (f32x4){S[a][q][4 * i4], S[a][q][4 * i4 + 1], S[a][q][4 * i4 + 2], S[a][q][4 * i4 + 3]};
            LDS_WAIT(); Atot[w * 64 + lane] = gsum[lane];
            VM_WAIT(); __syncthreads();
        }
    }
#undef HTK
#undef HCH
    __syncthreads();
}

DI void phase_mixers(const Params& P, int l, LAS unsigned char* lds, int G, int bid) {
#ifndef REP_PHASE
#define REP_PHASE -1
#endif
#define MREPS(k) _Pragma("unroll 1") for (int _r = 0; _r < ((REP_PHASE == (k)) ? 2 : 1); ++_r)
    if (EN_HY) MREPS(30) for (int c = bid; c < 256; c += G) hyena_unit(P, c, lds);
    if (EN_AT) MREPS(31) { int bias_h = -1;
        if ((G & 7) == 0) { const int xcd = bid & 7, j = bid >> 3, per = G >> 3;
            for (int base = 0; base < NB * 4 * 8; base += G) { const int u = base + xcd * per + j; if (u < NB * 4 * 8) attn_unit(P, u, lds, bias_h); } }
        else for (int u = bid; u < NB * 4 * 8; u += G) attn_unit(P, u, lds, bias_h); }
    if (EN_MA) MREPS(32) for (int u = bid; u < 256; u += G) mamba_unit(P, l, u, lds);
    if (EN_HG) MREPS(33) for (int u = bid; u < 256; u += G) hgrn_unit(P, l, u, lds);
}

constexpr int N_PHASES = 21;
#if TPROBE >= 40 && TPROBE < 50
#define PCTL , (unsigned*)(ws + WS_CTL)
#else
#define PCTL
#endif
#ifndef REP_PHASE
#define REP_PHASE -1
#endif
#define REPS(k) for (int _rep = 0, _nrep = ((REP_PHASE == (k)) && ((k) != 0 && (k) != 5 || l == 0)) ? 2 : 1; _rep < _nrep; ++_rep)
__global__ void __launch_bounds__(512, 2) fwd_kernel(Params Pin) {
    Params P = Pin; P.wv = __builtin_amdgcn_readfirstlane((int)(threadIdx.x >> 6));
    extern __shared__ __attribute__((aligned(16))) unsigned char lds_raw[];
    LAS unsigned char* lds = (LAS unsigned char*)lds_raw;
    volatile LAS unsigned* MISC = (volatile LAS unsigned*)(lds + LDS_MISC);
    if (threadIdx.x < 64) MISC[threadIdx.x] = 0u;
    __syncthreads();
    unsigned char* ws = P.ws;
    const int lo = P.ph_lo, hi = P.ph_hi;
    XcdBarrier bar; bar.bar = (unsigned*)(ws + WS_CTL) + CW_BAR; bar.x = 0; bar.st = nullptr;
    if (hi - lo > 1) bar = xcd_barrier_post((unsigned*)(ws + WS_CTL) + CW_BAR, MISC + 8);
#define IN(k) (lo <= (k) && (k) < hi)
#ifndef TPSEAM
#define TPSEAM -1
#endif
#if TPROBE == 20
#define SEAM(k) do { if (IN(k) && IN((k) + 1)) { const unsigned _t0 = TP_T(); xcd_barrier(bar); if (TPSEAM < 0 || ((k) % 10) == TPSEAM) gb_wait += TP_T() - _t0; } } while (0)
#else
#define SEAM(k) do { if (IN(k) && IN((k) + 1)) xcd_barrier(bar); } while (0)
#endif
    unsigned gb_wait = 0; const unsigned gb_t0 = TPROBE == 20 ? TP_T() : 0u;
#pragma unroll 1
    for (int l = 0; l < 2; ++l) {
        int G = gridDim.x, bid = blockIdx.x; asm volatile("" : "+s"(G), "+s"(bid));
        const int p0 = 10 * l;
        if (IN(p0 + 0)) { _Pragma("unroll 1") REPS(0) phase_pre(P, l, lds); }
        SEAM(p0 + 0);
        if (IN(p0 + 1)) { _Pragma("unroll 1") REPS(1) {
            pg8::StaticOrder S; S.init(NTOK / 256, NPROJ / 256, G, bid); AddrPlain AD{DM, 0}; EpiProj E{(bf16_t*)(ws + WS_PROJ), (const float*)(ws + WS_MSQ)};
            pg8::gemm_phase(lds, (const char*)(ws + WS_XB), (const char*)(ws + WS_WIN), DM, S, AD, E, P.wv PCTL);
        } }
        SEAM(p0 + 1);
        if (IN(p0 + 2)) { _Pragma("unroll 1") REPS(2) phase_premix(P, l, lds); }
        SEAM(p0 + 2);
        if (IN(p0 + 3)) { _Pragma("unroll 1") REPS(3) phase_mixers(P, l, lds, G, bid); }
        SEAM(p0 + 3);
        if (IN(p0 + 4)) { _Pragma("unroll 1") REPS(4) phase_finalize(P, l); }
        SEAM(p0 + 4);
        if (IN(p0 + 5)) { _Pragma("unroll 1") REPS(5) {
            pg8::StaticOrder S; S.init(NTOK / 256, DM / 256, G, bid); AddrPlain AD{DM, 0}; EpiRes E{nullptr, (const bf16_t*)(ws + WS_XB), (bf16_t*)(ws + WS_XB)};
            pg8::gemm_phase(lds, (const char*)(ws + WS_HN), (const char*)(ws + WS_WOUT), DM, S, AD, E, P.wv PCTL);
        } }
        SEAM(p0 + 5);
        if (IN(p0 + 6)) { if (EN_MOE) { _Pragma("unroll 1") REPS(6) phase_ffnpre(P, l, lds); } }
        SEAM(p0 + 6);
        if (IN(p0 + 7)) { if (EN_MOE) { _Pragma("unroll 1") REPS(7) phase_topk(P, l, lds); } }
        SEAM(p0 + 7);
        if (IN(p0 + 8)) { if (EN_MOE) _Pragma("unroll 1") REPS(8) {
            pg8::StaticOrder S; S.init(NSLOT / 256, 2048 / 256, G, bid);
#if MOE_F8
            AddrGateUp8 AD{(const int*)(ws + WS_SELI)}; EpiGateUp8 E{(unsigned char*)P.out + DO_HDN, (const float*)(ws + WS_SELR)};
            pg8::gemm_phase<EpiGateUp8, pg8::StaticOrder, AddrGateUp8, true>(lds, (const char*)(ws + WS_HN), (const char*)(ws + WS_WGU), DM, S, AD, E, P.wv PCTL);
#else
            AddrGateUp AD{(const int*)(ws + WS_SELI)}; EpiGateUp E{(bf16_t*)((unsigned char*)P.out + DO_HDN), (const float*)(ws + WS_SELR)};
            pg8::gemm_phase(lds, (const char*)(ws + WS_HN), (const char*)(ws + WS_WGU), DM, S, AD, E, P.wv PCTL);
#endif
        } }
        SEAM(p0 + 8);
        if (IN(p0 + 9)) { if (EN_MOE) _Pragma("unroll 1") REPS(9) {
            pg8::StaticOrder S; S.init(NSLOT / 256, DM / 256, G, bid);
#if MOE_F8
            EpiDown E{(bf16_t*)(ws + WS_YE), (const float*)(ws + WS_SELG)};
            AddrDown8 AD{}; pg8::gemm_phase<EpiDown, pg8::StaticOrder, AddrDown8, true>(lds, (const char*)P.out + DO_HDN, (const char*)(ws + WS_WD), DM, S, AD, E, P.wv PCTL);
#else
            EpiDown E{(bf16_t*)(ws + WS_YE), (const float*)(ws + WS_SELG)};
            AddrDown AD{}; pg8::gemm_phase(lds, (const char*)P.out + DO_HDN, (const char*)(ws + WS_WD), DM, S, AD, E, P.wv PCTL);
#endif
        } }
        SEAM(p0 + 9);
    }
#ifdef PROBE_BARS
    if (hi - lo > 1) for (int i = 0; i < PROBE_BARS; ++i) xcd_barrier(bar);
#endif
    if (IN(20)) phase_final(P);
#ifndef TPOFF
#define TPOFF 0.5f
#endif
#if TPROBE == 20
    if (tid_opaque(P.wv) == 0) { atomicAdd((unsigned*)(ws + WS_CTL) + 512, gb_wait); atomicAdd((unsigned*)(ws + WS_CTL) + 513, (TP_T() - gb_t0) / 5u); }
    xcd_barrier(bar);
#endif
#if TPROBE
    __syncthreads();
    if (blockIdx.x == 0 && tid_opaque(P.wv) == 0) {
        const float a = (float)__hip_atomic_load((unsigned*)(ws + WS_CTL) + 512, __ATOMIC_RELAXED, __HIP_MEMORY_SCOPE_AGENT), t = (float)__hip_atomic_load((unsigned*)(ws + WS_CTL) + 513, __ATOMIC_RELAXED, __HIP_MEMORY_SCOPE_AGENT);
        P.out[0] = TPROBE == 99 ? 1.0e6f : (TPROBE == 20 && TPSEAM >= 0) ? (floorf(2.0f * log2f(a / t * 200.0f) + TPOFF) * 1.0e5f) : (floorf(a / t * 20.0f + TPOFF) * 1.0e5f); }
#endif
#undef IN
#undef SEAM
}

#ifndef N_LAUNCH_MODE
#define N_LAUNCH_MODE 1
#endif
extern "C" void kernel_launch(void* const* d_in, const int* in_sizes, int n_in, void* d_out, int out_size, void* d_ws, size_t ws_size, hipStream_t stream) {
    static int grid = 0;
    if (grid == 0) {
        if (n_in != 27 || in_sizes[0] != NTOK * DM || out_size != NTOK * DM || ws_size < WS_END) {
            fprintf(stderr, "kernel_launch: unexpected shapes (n_in %d, in0 %d, out %d, ws %zu, need %zu)\n", n_in, n_in > 0 ? in_sizes[0] : -1, out_size, ws_size, (size_t)WS_END); grid = -1; return; }
        int dev = 0, cus = 0, per_cu = 0;
        if (hipGetDevice(&dev) != hipSuccess || hipDeviceGetAttribute(&cus, hipDeviceAttributeMultiprocessorCount, dev) != hipSuccess) { grid = -1; return; }
        if (hipFuncSetAttribute((const void*)fwd_kernel, hipFuncAttributeMaxDynamicSharedMemorySize, LDS_BYTES) != hipSuccess) { fprintf(stderr, "kernel_launch: hipFuncSetAttribute failed\n"); grid = -1; return; }
        if (hipOccupancyMaxActiveBlocksPerMultiprocessor(&per_cu, (const void*)fwd_kernel, 512, LDS_BYTES) != hipSuccess || per_cu < 1) { fprintf(stderr, "kernel_launch: occupancy query says %d\n", per_cu); (void)hipGetLastError(); }
        grid = cus;
    }
    if (grid < 0) return;
    if (hipMemsetAsync((char*)d_ws + WS_CTL, 0, CTL_ZERO_BYTES, stream) != hipSuccess) return;
    Params p{};
    const float** pp = (const float**)&p;
    for (int i = 0; i < 27; ++i) pp[i] = (const float*)d_in[i];
    p.out = (float*)d_out; p.ws = (unsigned char*)d_ws;
    if (N_LAUNCH_MODE == 1) { p.ph_lo = 0; p.ph_hi = N_PHASES; hipLaunchKernelGGL(fwd_kernel, dim3(grid), dim3(512), LDS_BYTES, stream, p); }
    else for (int k = 0; k < N_PHASES; ++k) { p.ph_lo = k; p.ph_hi = k + 1; hipLaunchKernelGGL(fwd_kernel, dim3(grid), dim3(512), LDS_BYTES, stream, p); }
}
```

```cpp
#define N_LAUNCH_MODE 1
#include <hip/hip_runtime.h>
#include <cstdio>
#include <cstdint>

#define LAS __attribute__((address_space(3)))
#define DI __device__ __forceinline__
typedef unsigned short bf16_t;
typedef short bf16x8 __attribute__((ext_vector_type(8)));
typedef short s16x4 __attribute__((ext_vector_type(4)));
typedef float f32x2 __attribute__((ext_vector_type(2)));
typedef float f32x4 __attribute__((ext_vector_type(4)));
typedef float f32x16 __attribute__((ext_vector_type(16)));
typedef unsigned u32x2 __attribute__((ext_vector_type(2)));
typedef unsigned u32x4 __attribute__((ext_vector_type(4)));
typedef int i32x4 __attribute__((ext_vector_type(4)));
typedef __bf16 bfv2 __attribute__((ext_vector_type(2)));

DI unsigned pk2(float lo, float hi) { f32x2 v = {lo, hi}; return __builtin_bit_cast(unsigned, __builtin_convertvector(v, bfv2)); }
DI unsigned short f2bf(float f) { return (unsigned short)(pk2(f, 0.f) & 0xffffu); }
DI float bf2f(unsigned short b) { return __uint_as_float((unsigned)b << 16); }
DI float bflo(unsigned u) { return __uint_as_float(u << 16); }
DI float bfhi(unsigned u) { return __uint_as_float(u & 0xffff0000u); }
DI unsigned pk4_fp8(float a, float b, float c, float d) {
    a = __builtin_amdgcn_fmed3f(a, -440.f, 440.f); b = __builtin_amdgcn_fmed3f(b, -440.f, 440.f); c = __builtin_amdgcn_fmed3f(c, -440.f, 440.f); d = __builtin_amdgcn_fmed3f(d, -440.f, 440.f);
    int v = 0; v = __builtin_amdgcn_cvt_pk_fp8_f32(a, b, v, false); v = __builtin_amdgcn_cvt_pk_fp8_f32(c, d, v, true); return (unsigned)v; }
DI int lane_now() { int ln; asm volatile("v_mbcnt_lo_u32_b32 %0, -1, 0\n\tv_mbcnt_hi_u32_b32 %0, -1, %0" : "=v"(ln)); return ln; }
template <class T> DI T bperm_(int idx4, T v) { return __builtin_bit_cast(T, __builtin_amdgcn_ds_bpermute(idx4, __builtin_bit_cast(int, v))); }
template <class T> DI T shfl_xor_l(T v, int m, int self) { return bperm_(((self ^ m) & 63) << 2, v); }
template <class T> DI T shfl_up_l(T v, int o, int self, int width = 64) { int idx = self - o; if (idx < (self & ~(width - 1))) idx = self; return bperm_(idx << 2, v); }
template <class T> DI T shfl_xor_(T v, int m) { return shfl_xor_l(v, m, lane_now()); }
template <class T> DI T shfl_up_(T v, int o, int width = 64) { return shfl_up_l(v, o, lane_now(), width); }
template <class T> DI T shfl_(T v, int src) { return bperm_((src & 63) << 2, v); }
#ifndef HIP_SHFL
#define __shfl_xor shfl_xor_
#define __shfl_up shfl_up_
#define __shfl shfl_
#endif
DI float xhalf_max(float x) { const auto r = __builtin_amdgcn_permlane32_swap(__float_as_uint(x), __float_as_uint(x), false, false); return fmaxf(__uint_as_float(r[0]), __uint_as_float(r[1])); }
DI float xhalf_sum(float x) { const auto r = __builtin_amdgcn_permlane32_swap(__float_as_uint(x), __float_as_uint(x), false, false); return __uint_as_float(r[0]) + __uint_as_float(r[1]); }
template <int CTRL> DI float dpp_f(float x) { return __builtin_bit_cast(float, __builtin_amdgcn_update_dpp(0, __builtin_bit_cast(int, x), CTRL, 0xF, 0xF, true)); }
DI float x16_sum(float x) { const auto r = __builtin_amdgcn_permlane16_swap(__float_as_uint(x), __float_as_uint(x), false, false); return __uint_as_float(r[0]) + __uint_as_float(r[1]); }
DI float row_sum16(float x) { x += dpp_f<0x128>(x); x += dpp_f<0x124>(x); x += dpp_f<0x122>(x); x += dpp_f<0x121>(x); return x; }
DI float grp_sum8(float x) { x += dpp_f<0xB1>(x); x += dpp_f<0x4E>(x); x += dpp_f<0x141>(x); return x; }
DI float grp_max16(float x) { x = fmaxf(x, dpp_f<0xB1>(x)); x = fmaxf(x, dpp_f<0x4E>(x)); x = fmaxf(x, dpp_f<0x141>(x)); x = fmaxf(x, dpp_f<0x128>(x)); return x; }
DI float wave_sum(float v) { return xhalf_sum(x16_sum(row_sum16(v))); }
DI float silu_f(float x) { return x * __builtin_amdgcn_rcpf(1.0f + __expf(-x)); }
DI float sigmoid_f(float x) { return __builtin_amdgcn_rcpf(1.0f + __expf(-x)); }
#ifdef OLD_TID
DI int tid_opaque(int wv) { int t = wv * 64 + (int)__builtin_amdgcn_mbcnt_hi(~0u, __builtin_amdgcn_mbcnt_lo(~0u, 0u)); asm volatile("" : "+v"(t)); return t; }
#else
DI int tid_opaque(int wv) { int ln; asm volatile("v_mbcnt_lo_u32_b32 %0, -1, 0\n\tv_mbcnt_hi_u32_b32 %0, -1, %0" : "=v"(ln) :: "memory"); return wv * 64 + ln; }
#endif
DI bf16x8 mk8u(unsigned a, unsigned b, unsigned c, unsigned d) { u32x4 v = {a, b, c, d}; return __builtin_bit_cast(bf16x8, v); }
#define LDS_WAIT() asm volatile("s_waitcnt lgkmcnt(0)" ::: "memory")
#define VM_WAIT() asm volatile("s_waitcnt vmcnt(0)" ::: "memory")
#define MFMA32(a, b, c) __builtin_amdgcn_mfma_f32_32x32x16_bf16((a), (b), (c), 0, 0, 0)

constexpr int NB = 32, SEQ = 2048, DM = 1024, NTOK = NB * SEQ;
constexpr int NIN_REF = 3592, NPROJ = 3584;
constexpr int PC_HY = 0, PC_MZ = 768, PC_MX = 1024, PC_AQ = 1536, PC_AK = 1792, PC_AV = 2048, PC_HQ = 2304, PC_HF = 2560, PC_HI = 3072, PC_HG = 3328;
constexpr int NEXP = 16, CAP = 256, NSLOT = NB * NEXP * CAP;
constexpr float EPSN = 1e-6f;

constexpr size_t MiB = 1u << 20;
constexpr size_t WS_CTL = 0, CTL_ZERO_BYTES = 64 * 1024;
constexpr size_t WS_DT = 1 * MiB, WS_AFF = 3 * MiB, WS_SLOT = 7 * MiB, WS_SELI = 11 * MiB, WS_SELG = 11 * MiB + 512 * 1024, WS_KFILT = 12 * MiB, WS_MSQ = 14 * MiB, WS_RS = 15 * MiB, WS_SELR = 15 * MiB + 512 * 1024;
constexpr size_t WS_XB = 64 * MiB, WS_WIN = 320 * MiB, WS_WOUT = 327 * MiB, WS_WGU = 329 * MiB, WS_WD = 393 * MiB, WS_HN = 432 * MiB, WS_PROJ = 560 * MiB, WS_YE = WS_PROJ, WS_END = 1008 * MiB, WS_MYB = WS_WGU, WS_OB = WS_WGU + 32 * MiB;
constexpr size_t DO_HW = 0, DO_HX0 = 32 * MiB, DO_YAT = 64 * MiB, DO_MXBC = 96 * MiB, DO_MY = 160 * MiB, DO_MST = 192 * MiB, DO_HST = 224 * MiB, DO_HDN = 0;
constexpr int CW_BAR = 1024;

constexpr int LDS_MISC = 163840 - 256, LDS_BYTES = 163840;

struct Params {
    const float *x, *w_in, *w_out, *norm_mix_w, *norm_ffn_w, *hy_conv_w, *hy_w1, *hy_b1, *hy_w2, *hy_b2, *hy_freq, *hy_w3, *hy_fbias,
                *m_conv_w, *m_conv_b, *m_dt_bias, *m_A_log, *m_D, *m_norm_w, *rel_bias, *hg_lb, *hg_norm_w, *router_w, *moe_wg, *moe_wu, *moe_wd, *final_w;
    float* out; unsigned char* ws;
    int ph_lo, ph_hi, wv, pad;
};

#define XB_TMO      128
#define XB_XCNT(j)  (256  + 64 * (j))
#define XB_XSUB(j)  (1280 + 64 * (j))
#define XB_XGEN(j)  (2304 + 64 * (j))
#define XB_TOP      3328
#define XB_TOPGEN   3392
#define XCD_BAR_WORDS 3456
#define XB_SPIN_CAP (1u << 18)
__device__ __forceinline__ unsigned xb_ld(unsigned* p)              { return __hip_atomic_load(p, __ATOMIC_RELAXED, __HIP_MEMORY_SCOPE_AGENT); }
__device__ __forceinline__ unsigned xb_add(unsigned* p, unsigned v) { return __hip_atomic_fetch_add(p, v, __ATOMIC_RELAXED, __HIP_MEMORY_SCOPE_AGENT); }
__device__ __forceinline__ unsigned xb_xcc_id() { return (unsigned)__builtin_amdgcn_s_getreg((3 << 11) | 20) & 0xFu; }
#define XB_SPIN(cond, bar) do { unsigned _sp = 0; while (cond) { __builtin_amdgcn_s_sleep(1); \
    if ((++_sp & 255u) == 0u) { if (xb_ld(&(bar)[XB_TMO])) break; if (_sp > XB_SPIN_CAP) { atomicAdd(&(bar)[XB_TMO], 1u); break; } } } } while (0)
struct XcdBarrier { unsigned* bar; unsigned x; volatile LAS unsigned* st; };
__device__ __forceinline__ XcdBarrier xcd_barrier_post(unsigned* bar, volatile LAS unsigned* st) {
    XcdBarrier b; b.bar = bar; b.x = xb_xcc_id(); b.st = st;
    if (threadIdx.x == 0) (void)xb_add(&bar[XB_XCNT(b.x)], 1u);
    return b;
}
__device__ __forceinline__ void xcd_barrier_complete(unsigned* bar, unsigned x, unsigned& nloc, unsigned& nx) {
    const unsigned G = gridDim.x * gridDim.y * gridDim.z;
    unsigned sum, cnt, mine, sp = 0u;
    for (;;) {
        sum = 0u; cnt = 0u; mine = 0u;
#pragma unroll
        for (unsigned j = 0; j < 16; ++j) { const unsigned c = xb_ld(&bar[XB_XCNT(j)]); sum += c; cnt += (c > 0u) ? 1u : 0u; mine = (j == x) ? c : mine; }
        if (sum == G) break;
        __builtin_amdgcn_s_sleep(1);
        if ((++sp & 255u) == 0u) { if (xb_ld(&bar[XB_TMO])) break; if (sp > XB_SPIN_CAP) { atomicAdd(&bar[XB_TMO], 1u); break; } }
    }
    nloc = mine > 0u ? mine : 1u; nx = cnt > 0u ? cnt : 1u;
}
__device__ __forceinline__ void xcd_barrier(const XcdBarrier& b) {
    asm volatile("s_waitcnt vmcnt(0)" ::: "memory");
    __syncthreads();
    if (threadIdx.x == 0) {
        unsigned* bar = b.bar; asm volatile("" : "+s"(bar));
        __builtin_amdgcn_s_waitcnt(0);
        unsigned nloc = b.st[0], nx = b.st[1];
        if (nloc == 0u) { xcd_barrier_complete(bar, b.x, nloc, nx); b.st[0] = nloc; b.st[1] = nx; }
        const unsigned old = xb_add(&bar[XB_XSUB(b.x)], 1u);
        const unsigned gen = old / nloc;
        if (old + 1u == (gen + 1u) * nloc) {
            __builtin_amdgcn_fence(__ATOMIC_RELEASE, "agent");
            asm volatile("s_waitcnt vmcnt(0)" ::: "memory");
            const unsigned og = xb_add(&bar[XB_TOP], 1u);
            const unsigned tg = og / nx;
            if (og + 1u == (tg + 1u) * nx) xb_add(&bar[XB_TOPGEN], 1u);
            else XB_SPIN(xb_ld(&bar[XB_TOPGEN]) == tg, bar);
            __builtin_amdgcn_fence(__ATOMIC_ACQUIRE, "agent");
            xb_add(&bar[XB_XGEN(b.x)], 1u);
            asm volatile("s_waitcnt vmcnt(0)" ::: "memory");
        } else {
            XB_SPIN(xb_ld(&bar[XB_XGEN(b.x)]) == gen, bar);
            __builtin_amdgcn_fence(__ATOMIC_ACQUIRE, "agent");
            asm volatile("s_waitcnt vmcnt(0)" ::: "memory");
        }
    }
    __syncthreads();
}

namespace pg8 {
constexpr int BM = 256, BK = 64, HALF = 128, HTB = HALF * BK * 2, STAGE_BYTES = 8 * HTB, NXCD = 8, WGM = 8;
__host__ __device__ __forceinline__ int lds_byte(int r, int c) { const int st = (r >> 4) * 2 + (c >> 5), rr = r & 15, cc = c & 31, ob = rr * 64 + cc * 2; return st * 1024 + (ob ^ (((ob >> 9) & 1) << 5)); }
__host__ __device__ __forceinline__ void stage_rc(int b, int& R, int& C) { const int st = b / 1024, sb = b % 1024, swz = sb ^ (((sb >> 9) & 1) << 5); R = (st >> 1) * 16 + swz / 64; C = (st & 1) * 32 + (swz % 64) / 2; }
__host__ __device__ __forceinline__ int perm32(int rho) { const int n = rho >> 4, i = rho & 15; return 8 * (i >> 2) + 4 * n + (i & 3); }
struct Unit { int pm, pn; };
typedef int i32x8 __attribute__((ext_vector_type(8)));
typedef int i32x32 __attribute__((ext_vector_type(32)));
#define INS4(V, P, X) do { const i32x4 _x = (X); (V)[(P)] = _x.x; (V)[(P) + 1] = _x.y; (V)[(P) + 2] = _x.z; (V)[(P) + 3] = _x.w; } while (0)
#define EXT8(V, P) ((i32x8){(V)[(P)], (V)[(P) + 1], (V)[(P) + 2], (V)[(P) + 3], (V)[(P) + 4], (V)[(P) + 5], (V)[(P) + 6], (V)[(P) + 7]})
DI i32x8 cat88(bf16x8 lo, bf16x8 hi) { const i32x4 a = __builtin_bit_cast(i32x4, lo), b = __builtin_bit_cast(i32x4, hi); return (i32x8){a.x, a.y, a.z, a.w, b.x, b.y, b.z, b.w}; }
struct StaticOrder {
    int nM, nN, nwg, G, c;
    __device__ void init(int nM_, int nN_, int G_, int c_) { nM = nM_; nN = nN_; nwg = nM * nN; G = G_; c = c_; }
    __device__ bool next(int i, Unit& u) const {
        const long L = (long)i * G + c; if (L >= nwg) return false;
        int wgid = (int)L; { const int q = nwg / NXCD, r = nwg % NXCD, xcd = wgid % NXCD, off = wgid / NXCD; wgid = (xcd < r ? xcd * (q + 1) : r * (q + 1) + (xcd - r) * q) + off; }
        const int nig = WGM * nN, gid = wgid / nig, fm = gid * WGM, gsz = (nM - fm) < WGM ? (nM - fm) : WGM;
        u.pm = fm + ((wgid % nig) % gsz); u.pn = (wgid % nig) / gsz; return true;
    }
};
#ifndef TPROBE
#define TPROBE 0
#endif
#ifndef TPGEMM
#define TPGEMM 0
#endif
#define GP_T() ({ asm volatile("" ::: "memory"); unsigned _t = (unsigned)__builtin_amdgcn_s_memrealtime(); asm volatile("" ::: "memory"); _t; })
#define GP_ON(k) (TPROBE == (k) && Epi::PID == TPGEMM)
template <class Epi, class Sched, class Addr, bool F8 = false>
__device__ __forceinline__ void gemm_phase(LAS unsigned char* lds, const char* Abase, const char* Bbase, int K, const Sched& S, const Addr& AD, const Epi& E, int wv, unsigned* lds_ws_ctl = nullptr) {
    const int tid = tid_opaque(wv), wid = __builtin_amdgcn_readfirstlane(tid >> 6), lane = tid & 63, wr = wid >> 2, wc = wid & 3, fr = lane & 15, fq = lane >> 4;
    unsigned gp_acc = 0, gp_tot = 0, gp_t0 = 0, gp_t1 = 0; if (TPROBE >= 40 && TPROBE < 50 && Epi::PID == TPGEMM) gp_t0 = GP_T();
    const int KB = F8 ? K : 2 * K;
    const int nt = KB / 128;
    int Rr[2]; unsigned Cc[2], voffB[2], voffA[2];
#pragma unroll
    for (int i = 0; i < 2; ++i) { int R, C; stage_rc(tid * 16 + i * 8192, R, C); const int Rb = Epi::PERM ? ((R & ~31) + perm32(R & 31)) : R;
        Rr[i] = R; Cc[i] = (unsigned)C * 2u; voffA[i] = (unsigned)(R * KB + C * 2); voffB[i] = (unsigned)(Rb * KB + C * 2); }
    const size_t kstep = (size_t)(BK * 2);
    const size_t hstep = (size_t)HALF * KB;
    const unsigned ldsw = (unsigned)wid * 1024u;
    const int aoff = F8 ? lds_byte(wr * 64 + fr, fq * 16) : lds_byte(wr * 64 + fr, fq * 8), boff = F8 ? lds_byte(wc * 32 + fr, fq * 16) : lds_byte(wc * 32 + fr, fq * 8);
    const int aoff1 = F8 ? lds_byte(wr * 64 + fr, fq * 16 + 8) : aoff + 1024, boff1 = F8 ? lds_byte(wc * 32 + fr, fq * 16 + 8) : boff + 1024;
#define PG8_SA(b, h) (((b) * 2 + (h)) * HTB)
#define PG8_SB(b, h) ((4 + (b) * 2 + (h)) * HTB)
#define PG8_STAGE(bufoff, gbase, voff) do { _Pragma("unroll") for (int _i = 0; _i < 2; ++_i) \
        __builtin_amdgcn_global_load_lds((const unsigned*)((const char*)(gbase) + (voff)[_i]), (LAS unsigned*)(lds + (bufoff) + ldsw + _i * 8192), 16, 0, 0); } while (0)
#define PG8_STAGE_A(bufoff, kb, h, un) do { if constexpr (Addr::LOADS) { _Pragma("unroll") for (int _i = 0; _i < 2; ++_i) \
        __builtin_amdgcn_global_load_lds((const unsigned*)(Abase + (kb) + ((un) ? on[h][_i] : oc[h][_i])), (LAS unsigned*)(lds + (bufoff) + ldsw + _i * 8192), 16, 0, 0); } \
      else { const char* _ab = ((un) ? nA : cA) + (kb) + (size_t)(h) * hstep; _Pragma("unroll") for (int _i = 0; _i < 2; ++_i) \
        __builtin_amdgcn_global_load_lds((const unsigned*)(_ab + voffA[_i]), (LAS unsigned*)(lds + (bufoff) + ldsw + _i * 8192), 16, 0, 0); } } while (0)
#define PG8_BSEL_B0 0
#define PG8_BSEL_B1 16
#define PG8_LDA(dst, b, h) do { if constexpr (F8) { _Pragma("unroll") for (int m = 0; m < 4; ++m) { INS4(AA, 8 * m, *(const LAS i32x4*)(lds + PG8_SA(b, h) + aoff + m * 2048)); INS4(AA, 8 * m + 4, *(const LAS i32x4*)(lds + PG8_SA(b, h) + aoff + 16 + m * 2048)); } } \
      else { _Pragma("unroll") for (int m = 0; m < 4; ++m) _Pragma("unroll") for (int k = 0; k < 2; ++k) dst[m][k] = *(const LAS bf16x8*)(lds + PG8_SA(b, h) + (k ? aoff1 : aoff) + m * 2048); } } while (0)
#define PG8_LDB(dst, b, h) do { if constexpr (F8) { _Pragma("unroll") for (int n = 0; n < 2; ++n) { INS4(BB, PG8_BSEL_##dst + 8 * n, *(const LAS i32x4*)(lds + PG8_SB(b, h) + boff + n * 2048)); INS4(BB, PG8_BSEL_##dst + 8 * n + 4, *(const LAS i32x4*)(lds + PG8_SB(b, h) + boff + 16 + n * 2048)); } } \
      else { _Pragma("unroll") for (int n = 0; n < 2; ++n) _Pragma("unroll") for (int k = 0; k < 2; ++k) dst[n][k] = *(const LAS bf16x8*)(lds + PG8_SB(b, h) + (k ? boff1 : boff) + n * 2048); } } while (0)
#define PG8_MMA(ai, bj, At, Bt) do { __builtin_amdgcn_s_setprio(1); if constexpr (F8) { _Pragma("unroll") for (int m = 0; m < 4; ++m) _Pragma("unroll") for (int n = 0; n < 2; ++n) \
        { const i32x8 _b8 = EXT8(BB, PG8_BSEL_##Bt + 8 * n), _a8 = EXT8(AA, 8 * m); \
          asm volatile("s_nop 1\n\tv_mfma_scale_f32_16x16x128_f8f6f4 %0, %1, %2, %0, %3, %4 op_sel_hi:[0,0,0]" : "+v"(acc[ai][bj][m][n]) : "v"(_b8), "v"(_a8), "v"(scw), "v"(scx)); } } \
      else { _Pragma("unroll") for (int m = 0; m < 4; ++m) _Pragma("unroll") for (int n = 0; n < 2; ++n) _Pragma("unroll") for (int k = 0; k < 2; ++k) \
        acc[ai][bj][m][n] = __builtin_amdgcn_mfma_f32_16x16x32_bf16(Bt[n][k], At[m][k], acc[ai][bj][m][n], 0, 0, 0); } __builtin_amdgcn_s_setprio(0); } while (0)
#define PG8_WAIT_V(n) asm volatile("s_waitcnt vmcnt(" #n ")" ::: "memory")
#define PG8_WAIT_L(n) asm volatile("s_waitcnt lgkmcnt(" #n ")" ::: "memory")
#define PG8_BAR __builtin_amdgcn_s_barrier()
#define PG8_SCHED __builtin_amdgcn_sched_barrier(0)
    int scw = 0, scx = 0; if constexpr (F8) { scw = Addr::SC_W; scx = Addr::SC_X; } (void)scw; (void)scx;
    Unit cur, nxt; int ui = 0;
    if (!S.next(0, cur)) return;
#ifdef STAG_TICKS
    {
        const unsigned long long t0 = __builtin_amdgcn_s_memrealtime(); const unsigned long long dl = (unsigned long long)(((blockIdx.x >> 3) & 7) * STAG_TICKS);
        while (__builtin_amdgcn_s_memrealtime() - t0 < dl) __builtin_amdgcn_s_sleep(16);
    }
#endif
    f32x4 acc[2][2][4][2];
#pragma unroll
    for (int a = 0; a < 2; ++a)
#pragma unroll
        for (int b = 0; b < 2; ++b)
#pragma unroll
            for (int m = 0; m < 4; ++m)
#pragma unroll
                for (int n = 0; n < 2; ++n) acc[a][b][m][n] = (f32x4){0.f, 0.f, 0.f, 0.f};
    bf16x8 At[4][2], B0[2][2], B1[2][2]; i32x32 AA, BB; (void)At; (void)B0; (void)B1; (void)AA; (void)BB;
    unsigned oc[2][2], on[2][2];
    const char* cA = Abase; const char* nA = Abase;
    if constexpr (Epi::ROWTAB) {
        Unit tu;
        for (int k = 0; k < 16 && S.next(k, tu); ++k)
            for (int r = tid; r < 256; r += 512) ((LAS float*)(lds + STAGE_BYTES + 8192))[k * 256 + r] = E.rowscale(tu, r);
        if constexpr (!Addr::LOADS) __syncthreads();
    }
    if constexpr (Addr::LOADS) {
        {
            Unit tu;
            for (int k = 0; k < 16 && S.next(k, tu); ++k)
                for (int r = tid; r < 256; r += 512) ((LAS unsigned short*)(lds + STAGE_BYTES))[k * 256 + r] = AD.arow_tok(tu, r);
            __syncthreads();
        }
#pragma unroll
        for (int h = 0; h < 2; ++h)
#pragma unroll
            for (int i = 0; i < 2; ++i) { oc[h][i] = AD.arow_lds(lds + STAGE_BYTES, 0, cur, h * HALF + Rr[i]) + Cc[i]; on[h][i] = oc[h][i]; }
        PG8_WAIT_V(0);
    } else { cA = Abase + AD.arow(cur, 0); nA = cA; }
    const char* cB = Bbase + AD.boff(cur);
    PG8_STAGE(PG8_SB(0, 0), cB, voffB); PG8_STAGE_A(PG8_SA(0, 0), 0, 0, false); PG8_STAGE(PG8_SB(0, 1), cB + hstep, voffB); PG8_STAGE_A(PG8_SA(0, 1), 0, 1, false);
    if (wr == 1) PG8_BAR;
    PG8_WAIT_V(4); PG8_BAR;
    PG8_STAGE(PG8_SB(1, 0), cB + kstep, voffB); PG8_STAGE_A(PG8_SA(1, 0), kstep, 0, false); PG8_STAGE(PG8_SB(1, 1), cB + hstep + kstep, voffB);
    PG8_WAIT_V(6); PG8_BAR;
    for (;;) {
        const bool has_next = S.next(ui + 1, nxt);
        if (has_next) {
            if constexpr (Addr::LOADS) {
#pragma unroll
                for (int h = 0; h < 2; ++h)
#pragma unroll
                    for (int i = 0; i < 2; ++i) on[h][i] = AD.arow_lds(lds + STAGE_BYTES, ui + 1, nxt, h * HALF + Rr[i]) + Cc[i];
            } else nA = Abase + AD.arow(nxt, 0);
        } else nA = cA;
        const char* nB = has_next ? Bbase + AD.boff(nxt) : cB;
        if (GP_ON(41)) gp_t1 = GP_T();
#pragma unroll 1
        for (int t = 0; t < nt; t += 2) {
            if (GP_ON(43) && t == 0) gp_t1 = GP_T();
            if (GP_ON(44) && t == 2) gp_t1 = GP_T();
            const bool last = (t == nt - 2);
            const bool un = last && has_next;
            const size_t k1 = (size_t)(t + 1) * kstep;
            const size_t k2 = last ? 0 : (size_t)(t + 2) * kstep, k3 = k2 + kstep;
            const char* b2 = last ? nB : cB + (size_t)(t + 2) * kstep;
            const char* b3 = b2 + kstep;
            PG8_LDB(B0, 0, 0); PG8_SCHED; PG8_LDA(At, 0, 0); PG8_STAGE_A(PG8_SA(1, 1), k1, 1, false);
            PG8_WAIT_L(8); PG8_BAR; PG8_WAIT_L(0); PG8_MMA(0, 0, At, B0); PG8_BAR; PG8_SCHED;
            PG8_LDB(B1, 0, 1); PG8_STAGE(PG8_SB(0, 0), b2, voffB);
            PG8_BAR; PG8_WAIT_L(0); PG8_MMA(0, 1, At, B1); PG8_BAR;
            PG8_LDA(At, 0, 1); PG8_STAGE_A(PG8_SA(0, 0), k2, 0, un);
            PG8_BAR; PG8_WAIT_L(0); PG8_MMA(1, 0, At, B0); PG8_BAR; PG8_SCHED;
            PG8_STAGE(PG8_SB(0, 1), b2 + hstep, voffB);
            PG8_WAIT_V(6); PG8_BAR; PG8_MMA(1, 1, At, B1); PG8_BAR;
            PG8_LDB(B0, 1, 0); PG8_SCHED; PG8_LDA(At, 1, 0); PG8_STAGE_A(PG8_SA(0, 1), k2, 1, un);
            PG8_WAIT_L(8); PG8_BAR; PG8_WAIT_L(0); PG8_MMA(0, 0, At, B0); PG8_BAR; PG8_SCHED;
            PG8_LDB(B1, 1, 1); PG8_STAGE(PG8_SB(1, 0), b3, voffB);
            PG8_BAR; PG8_WAIT_L(0); PG8_MMA(0, 1, At, B1); PG8_BAR;
            PG8_LDA(At, 1, 1); PG8_STAGE_A(PG8_SA(1, 0), k3, 0, un);
            PG8_BAR; PG8_WAIT_L(0); PG8_MMA(1, 0, At, B0); PG8_BAR; PG8_SCHED;
            PG8_STAGE(PG8_SB(1, 1), b3 + hstep, voffB);
            PG8_WAIT_V(6); PG8_BAR; PG8_MMA(1, 1, At, B1); PG8_BAR;
            if (GP_ON(43) && t == 0) gp_acc += GP_T() - gp_t1;
            if (GP_ON(44) && t == 2) gp_acc += GP_T() - gp_t1;
        }
        if (GP_ON(41)) gp_acc += GP_T() - gp_t1;
        if (GP_ON(42)) gp_t1 = GP_T();
        if constexpr (F8) asm volatile("s_nop 15\n\ts_nop 15" ::: "memory");
        E(acc, cur, wr, wc, fr, fq, (const LAS float*)(lds + STAGE_BYTES + 8192) + ui * 256);
        if (GP_ON(42)) gp_acc += GP_T() - gp_t1;
        if (!has_next) break;
#pragma unroll
        for (int a = 0; a < 2; ++a)
#pragma unroll
            for (int b = 0; b < 2; ++b)
#pragma unroll
                for (int m = 0; m < 4; ++m)
#pragma unroll
                    for (int n = 0; n < 2; ++n) acc[a][b][m][n] = (f32x4){0.f, 0.f, 0.f, 0.f};
        cur = nxt; cB = nB; cA = nA; ++ui;
        if constexpr (Addr::LOADS) {
#pragma unroll
            for (int h = 0; h < 2; ++h)
#pragma unroll
                for (int i = 0; i < 2; ++i) oc[h][i] = on[h][i]; }
    }
    PG8_WAIT_V(0);
    if (wr == 0) PG8_BAR;
    PG8_BAR;
    if (TPROBE >= 40 && TPROBE < 50 && Epi::PID == TPGEMM && tid == 0) { gp_tot = GP_T() - gp_t0; atomicAdd((unsigned*)lds_ws_ctl + 512, gp_acc); atomicAdd((unsigned*)lds_ws_ctl + 513, gp_tot); }
#undef PG8_SA
#undef PG8_SB
#undef PG8_STAGE
#undef PG8_STAGE_A
#undef PG8_BSEL_B0
#undef PG8_BSEL_B1
#undef PG8_LDA
#undef PG8_LDB
#undef PG8_MMA
#undef PG8_WAIT_V
#undef PG8_WAIT_L
#undef PG8_BAR
#undef PG8_SCHED
}
}

#ifndef EN_HY
#define EN_HY 1
#endif
#ifndef EN_MA
#define EN_MA 1
#endif
#ifndef EN_AT
#define EN_AT 1
#endif
#ifndef EN_HG
#define EN_HG 1
#endif
#ifndef EN_MOE
#define EN_MOE 1
#endif
#ifndef MOE_F8
#define MOE_F8 1
#endif

DI void transpose_item(const float* W, int ld, int k0, int n0, bf16_t* dst, int drow0, float scale, LAS float* scr, int lane, const float* kw = nullptr) {
    {
        const int rs = lane >> 3, cq = (lane & 7) * 4;
        f32x4 v[8];
#pragma unroll
        for (int i = 0; i < 8; ++i) v[i] = __builtin_nontemporal_load((const f32x4*)(W + (size_t)(k0 + 8 * i + rs) * ld + n0 + cq));
#pragma unroll
        for (int i = 0; i < 8; ++i) { LAS float* d = scr + (8 * i + rs) * 33 + cq; d[0] = v[i].x; d[1] = v[i].y; d[2] = v[i].z; d[3] = v[i].w; }
    }
    LDS_WAIT();
    const int c = lane & 7;
    float sk[8];
#pragma unroll
    for (int i = 0; i < 8; ++i) sk[i] = kw ? scale * kw[k0 + 8 * c + i] : scale;
#pragma unroll
    for (int j = 0; j < 4; ++j) { const int n = (lane >> 3) + 8 * j; const LAS float* s = scr + (8 * c) * 33 + n;
        u32x4 o; o.x = pk2(s[0 * 33] * sk[0], s[1 * 33] * sk[1]); o.y = pk2(s[2 * 33] * sk[2], s[3 * 33] * sk[3]); o.z = pk2(s[4 * 33] * sk[4], s[5 * 33] * sk[5]); o.w = pk2(s[6 * 33] * sk[6], s[7 * 33] * sk[7]);
        *(u32x4*)(dst + (size_t)(drow0 + n) * 1024 + k0 + 8 * c) = o; }
    LDS_WAIT();
}

DI void transpose_item_f8(const float* W, int ld, int k0, int n0, unsigned char* dst, int drow0, float scale, LAS float* scr, int lane) {
    {   const int rs = lane >> 3, cq = (lane & 7) * 4;
        f32x4 v[8];
#pragma unroll
        for (int i = 0; i < 8; ++i) v[i] = __builtin_nontemporal_load((const f32x4*)(W + (size_t)(k0 + 8 * i + rs) * ld + n0 + cq));
#pragma unroll
        for (int i = 0; i < 8; ++i) { LAS float* d = scr + (8 * i + rs) * 33 + cq; d[0] = v[i].x; d[1] = v[i].y; d[2] = v[i].z; d[3] = v[i].w; }
    }
    LDS_WAIT();
    const int c = lane & 7;
#pragma unroll
    for (int j = 0; j < 4; ++j) { const int n = (lane >> 3) + 8 * j; const LAS float* s = scr + (8 * c) * 33 + n;
        u32x2 o; o.x = pk4_fp8(s[0 * 33] * scale, s[1 * 33] * scale, s[2 * 33] * scale, s[3 * 33] * scale); o.y = pk4_fp8(s[4 * 33] * scale, s[5 * 33] * scale, s[6 * 33] * scale, s[7 * 33] * scale);
        *(u32x2*)(dst + (size_t)(drow0 + n) * 1024 + k0 + 8 * c) = o; }
    LDS_WAIT();
}

#define RDL(x, i) __uint_as_float(__builtin_amdgcn_readlane(__float_as_uint(x), (i)))
DI void hyena_filter_pos(const Params& P, int l, int pos, int lane, bf16_t* kfilt) {
    const float TWO_PI = 6.283185307179586f;
    const float tpos = (float)pos * (1.0f / 2047.0f);
    float z = 0.f;
    if (lane == 0) z = tpos;
    else if (lane <= 32) { const int bnd = (lane - 1) & 15; const float f = 1e-4f + (float)bnd * ((15.0f - 1e-4f) / 15.0f);
        const float angp = TWO_PI * (float)pos / 2048.0f; const float ang = angp * f; z = (lane <= 16) ? cosf(ang) : -sinf(ang); }
    const float* w1 = P.hy_w1 + (size_t)l * 33 * 64; const float* w2 = P.hy_w2 + (size_t)l * 64 * 64; const float* w3 = P.hy_w3 + (size_t)l * 64 * 512;
    const float fr = P.hy_freq[l * 64 + lane];
    float a = P.hy_b1[l * 64 + lane];
#pragma unroll 11
    for (int i = 0; i < 33; ++i) a += RDL(z, i) * w1[i * 64 + lane];
    const float h1 = sinf(fr * a);
    float a2 = P.hy_b2[l * 64 + lane];
#pragma unroll 16
    for (int i = 0; i < 64; ++i) a2 += RDL(h1, i) * w2[i * 64 + lane];
    const float h2 = sinf(fr * a2);
    float h3[8];
#pragma unroll
    for (int k = 0; k < 8; ++k) h3[k] = 0.f;
#pragma unroll 8
    for (int i = 0; i < 64; ++i) { const float hv = RDL(h2, i);
#pragma unroll
        for (int k = 0; k < 8; ++k) h3[k] += hv * w3[i * 512 + k * 64 + lane]; }
    const float min_decay = -3.0701134573253944f, max_decay = -15.350567286626972f;
#pragma unroll
    for (int k = 0; k < 8; ++k) { const int cp = k * 64 + lane, c = cp & 255;
        const float delta = fabsf(min_decay + (float)c * ((max_decay - min_decay) / 255.0f));
        float v = h3[k] * expf(-tpos * delta);
        if (cp < 256) { if (pos == 0) { v += P.hy_fbias[l * 256 + c]; kfilt[(size_t)c * 4096 + 4095] = 0; } kfilt[(size_t)c * 4096 + 2047 - pos] = f2bf(v); }
        else if (pos >= 1) kfilt[(size_t)c * 4096 + 2047 + pos] = f2bf(v); }
}
#undef RDL

struct SelRows { int cnt; unsigned o0, o1, o2, o3; };
DI SelRows sel_compact(int sl, int b) {
    SelRows r; r.cnt = 0; r.o0 = r.o1 = r.o2 = r.o3 = 0u;
#pragma unroll
    for (int e = 0; e < 16; ++e) { const int s = __builtin_amdgcn_readlane(sl, e); const bool on = s >= 0; const unsigned v = (unsigned)((b * 16 + e) * 256 + s);
        r.o0 = (on && r.cnt == 0) ? v : r.o0; r.o1 = (on && r.cnt == 1) ? v : r.o1; r.o2 = (on && r.cnt == 2) ? v : r.o2; r.o3 = (on && r.cnt == 3) ? v : r.o3; r.cnt += on ? 1 : 0; }
    return r;
}
DI void ye_load(const bf16_t* YE, unsigned o, int lane, u32x2 (&t)[4]) { const u32x2* yr = (const u32x2*)(YE + (size_t)o * DM) + lane;
#pragma unroll
    for (int j = 0; j < 4; ++j) t[j] = yr[64 * j]; }
DI void ye_add(f32x4 (&v)[4], const u32x2 (&t)[4]) {
#pragma unroll
    for (int j = 0; j < 4; ++j) { v[j].x += bflo(t[j].x); v[j].y += bfhi(t[j].x); v[j].z += bflo(t[j].y); v[j].w += bfhi(t[j].y); } }
template <bool FINAL>
DI void pre_rows2(const Params& P, int l, const int (&m)[2], int lane, const LAS f32x4* dtw, const float* nw, const int (&slp)[2]) {
    unsigned char* ws = P.ws;
    bf16_t* XB = (bf16_t*)(ws + WS_XB);
    const bool first = (!FINAL && l == 0);
    f32x4 v[2][4];
    if (first) {
#pragma unroll
        for (int k = 0; k < 2; ++k) { const f32x4* xr = (const f32x4*)(P.x + (size_t)m[k] * DM) + lane;
#pragma unroll
            for (int j = 0; j < 4; ++j) v[k][j] = xr[64 * j]; }
    } else {
        u32x2 xh[2][4];
#pragma unroll
        for (int k = 0; k < 2; ++k) { const u32x2* xr = (const u32x2*)(XB + (size_t)m[k] * DM) + lane;
#pragma unroll
            for (int j = 0; j < 4; ++j) xh[k][j] = xr[64 * j]; }
#pragma unroll
        for (int k = 0; k < 2; ++k)
#pragma unroll
            for (int j = 0; j < 4; ++j) v[k][j] = (f32x4){bflo(xh[k][j].x), bfhi(xh[k][j].x), bflo(xh[k][j].y), bfhi(xh[k][j].y)};
    }
    if (!first && EN_MOE) {
        const bf16_t* YE = (const bf16_t*)(ws + WS_YE); const int* slot = (const int*)(ws + WS_SLOT);
        int sl[2]; SelRows sr[2]; (void)slot;
#pragma unroll
        for (int k = 0; k < 2; ++k) sl[k] = slp[k];
#pragma unroll
        for (int k = 0; k < 2; ++k) sr[k] = sel_compact(sl[k], m[k] >> 11);
        u32x2 t[2][4][4];
#pragma unroll
        for (int k = 0; k < 2; ++k) { if (sr[k].cnt > 0) ye_load(YE, sr[k].o0, lane, t[k][0]); if (sr[k].cnt > 1) ye_load(YE, sr[k].o1, lane, t[k][1]);
            if (sr[k].cnt > 2) ye_load(YE, sr[k].o2, lane, t[k][2]); if (sr[k].cnt > 3) ye_load(YE, sr[k].o3, lane, t[k][3]); }
#pragma unroll
        for (int k = 0; k < 2; ++k) { if (sr[k].cnt > 0) ye_add(v[k], t[k][0]); if (sr[k].cnt > 1) ye_add(v[k], t[k][1]); if (sr[k].cnt > 2) ye_add(v[k], t[k][2]); if (sr[k].cnt > 3) ye_add(v[k], t[k][3]);
            if (sr[k].cnt > 4) {
                int seen = 0; const int b = m[k] >> 11;
                for (int e = 0; e < 16; ++e) { const int s = __builtin_amdgcn_readlane(sl[k], e);
                    if (s >= 0) { if (seen >= 4) { u32x2 tt[4]; ye_load(YE, (unsigned)((b * 16 + e) * 256 + s), lane, tt); ye_add(v[k], tt); } ++seen; } } } }
    }
    float rr[2];
#pragma unroll
    for (int k = 0; k < 2; ++k) {
        float s = 0.f;
#pragma unroll
        for (int j = 0; j < 4; ++j) s += (v[k][j].x * v[k][j].x + v[k][j].y * v[k][j].y) + (v[k][j].z * v[k][j].z + v[k][j].w * v[k][j].w);
        rr[k] = __builtin_amdgcn_rsqf(wave_sum(s) * (1.0f / DM) + EPSN);
    }
    if (FINAL) {
#pragma unroll
        for (int k = 0; k < 2; ++k) { f32x4* o = (f32x4*)(P.out + (size_t)m[k] * DM) + lane;
#pragma unroll
            for (int j = 0; j < 4; ++j) { const f32x4 w = ((const f32x4*)nw)[64 * j + lane]; o[64 * j] = v[k][j] * rr[k] * w; } }
        return;
    }
    {
#pragma unroll
        for (int k = 0; k < 2; ++k) { u32x2* o = (u32x2*)(XB + (size_t)m[k] * DM) + lane;
#pragma unroll
            for (int j = 0; j < 4; ++j) o[64 * j] = (u32x2){pk2(v[k][j].x, v[k][j].y), pk2(v[k][j].z, v[k][j].w)}; } }
    float d[2][8];
#pragma unroll
    for (int k = 0; k < 2; ++k)
#pragma unroll
        for (int c = 0; c < 8; ++c) d[k][c] = 0.f;
#pragma unroll
    for (int j = 0; j < 4; ++j) {
#pragma unroll
        for (int q = 0; q < 4; ++q) { const f32x4 w0 = dtw[((j * 4 + q) * 2 + 0) * 64 + lane], w1 = dtw[((j * 4 + q) * 2 + 1) * 64 + lane];
#pragma unroll
            for (int k = 0; k < 2; ++k) { const float xv = q == 0 ? v[k][j].x : (q == 1 ? v[k][j].y : (q == 2 ? v[k][j].z : v[k][j].w));
                d[k][0] += xv * w0.x; d[k][1] += xv * w0.y; d[k][2] += xv * w0.z; d[k][3] += xv * w0.w; d[k][4] += xv * w1.x; d[k][5] += xv * w1.y; d[k][6] += xv * w1.z; d[k][7] += xv * w1.w; } }
    }
#pragma unroll
    for (int k = 0; k < 2; ++k) {
        float mine = 0.f;
#pragma unroll
        for (int c = 0; c < 8; ++c) { const float t2 = wave_sum(d[k][c]); mine = (lane == c) ? t2 : mine; }
        if (lane < 8) ((float*)(ws + WS_DT))[(size_t)m[k] * 8 + lane] = mine * rr[k];
        if (lane == 8) ((float*)(ws + WS_MSQ))[m[k]] = rr[k];
    }
    (void)nw;
}

DI void phase_pre(const Params& P, int l, LAS unsigned char* lds) {
    const int tid = tid_opaque(P.wv), lane = tid & 63, wave = tid >> 6;
    const int gw = blockIdx.x * 8 + wave, NGW = gridDim.x * 8;
    unsigned char* ws = P.ws;
    LAS float* dtwf = (LAS float*)lds;
    const float* win_ = P.w_in; asm volatile("" : "+s"(win_));
    for (int i = tid; i < 1024 * 8; i += 512) { const int k = i >> 3, c = i & 7; const int j = k >> 8, ln = (k & 255) >> 2, q = k & 3;
        dtwf[((((j * 4 + q) * 2 + (c >> 2)) * 64 + ln) << 2) + (c & 3)] = P.norm_mix_w[l * DM + k] * win_[((size_t)l * DM + k) * NIN_REF + 1536 + c]; }
    __syncthreads();
    if (EN_HY) for (int pos = gw; pos < SEQ; pos += NGW) hyena_filter_pos(P, l, pos, lane, (bf16_t*)(ws + WS_KFILT));
    {
        LAS float* scr = (LAS float*)(lds + 32768 + wave * 8448);
        constexpr int I_A = 16 * 48, I_B = 16 * 64, I_O = 16 * 32, I_E = 16 * 32 * 16;
        constexpr int NITEMS = I_A + I_B + I_O; (void)I_E;
        bf16_t* WinT = (bf16_t*)(ws + WS_WIN); bf16_t* WoutT = (bf16_t*)(ws + WS_WOUT); bf16_t* WguT = (bf16_t*)(ws + WS_WGU); bf16_t* WdT = (bf16_t*)(ws + WS_WD);
        for (int it = gw; it < NITEMS; it += NGW) {
            int r = it;
            if (r < I_A) { const int kb = r / 48, nb = r % 48; transpose_item(P.w_in + (size_t)l * DM * NIN_REF, NIN_REF, 64 * kb, 32 * nb, WinT, 32 * nb, 1.0f, scr, lane, P.norm_mix_w + l * DM); continue; } r -= I_A;
            if (r < I_B) { const int kb = r / 64, nb = r % 64; const int drow = 1536 + 32 * nb; transpose_item(P.w_in + (size_t)l * DM * NIN_REF, NIN_REF, 64 * kb, 1544 + 32 * nb, WinT, drow, drow < PC_AK ? 0.125f * 1.4426950408889634f : 1.0f  , scr, lane, P.norm_mix_w + l * DM); continue; } r -= I_B;
            { const int kb = r / 32, nb = r % 32; transpose_item(P.w_out + (size_t)l * DM * DM, DM, 64 * kb, 32 * nb, WoutT, 32 * nb, 1.0f, scr, lane); }
            (void)WguT; (void)WdT;
        }
    }
    const float* nw = P.norm_mix_w + l * DM;
    {
        const int* slotp = (const int*)(ws + WS_SLOT); const bool comb = (l != 0) && EN_MOE;
        int sln[2] = {0, 0};
        if (comb && gw < NTOK) { sln[0] = slotp[(size_t)gw * 16 + (lane & 15)]; sln[1] = slotp[(size_t)((gw + NGW < NTOK) ? gw + NGW : gw) * 16 + (lane & 15)]; }
        for (int m = gw; m < NTOK; m += 2 * NGW) { asm volatile("" ::: "memory"); const int mm[2] = {m, (m + NGW < NTOK) ? m + NGW : m};
            const int slc[2] = {sln[0], sln[1]}; const int mn = m + 2 * NGW;
            if (comb && mn < NTOK) { sln[0] = slotp[(size_t)mn * 16 + (lane & 15)]; sln[1] = slotp[(size_t)((mn + NGW < NTOK) ? mn + NGW : mn) * 16 + (lane & 15)]; }
            pre_rows2<false>(P, l, mm, lane, (const LAS f32x4*)dtwf, nw, slc); }
    }
}
DI void phase_final(const Params& P) {
    const int tid = tid_opaque(P.wv), lane = tid & 63, wave = tid >> 6;
    const int gw = blockIdx.x * 8 + wave, NGW = gridDim.x * 8;
    {
        const int* slotp = (const int*)(P.ws + WS_SLOT); const bool comb = EN_MOE;
        int sln[2] = {0, 0};
        if (comb && gw < NTOK) { sln[0] = slotp[(size_t)gw * 16 + (lane & 15)]; sln[1] = slotp[(size_t)((gw + NGW < NTOK) ? gw + NGW : gw) * 16 + (lane & 15)]; }
        for (int m = gw; m < NTOK; m += 2 * NGW) { const int mm[2] = {m, (m + NGW < NTOK) ? m + NGW : m};
            const int slc[2] = {sln[0], sln[1]}; const int mn = m + 2 * NGW;
            if (comb && mn < NTOK) { sln[0] = slotp[(size_t)mn * 16 + (lane & 15)]; sln[1] = slotp[(size_t)((mn + NGW < NTOK) ? mn + NGW : mn) * 16 + (lane & 15)]; }
            pre_rows2<true>(P, 1, mm, lane, nullptr, P.final_w, slc); }
    }
}

struct AddrPlain { static constexpr bool LOADS = false; int K; int nb_rows;
    DI unsigned arow(const pg8::Unit& u, int r) const { return (unsigned)(u.pm * 256 + r) * (unsigned)(K * 2); }
    DI size_t boff(const pg8::Unit& u) const { return (size_t)u.pn * 256 * K * 2; } };
DI int moe_panel(int r) { return (r & 31) * 16 + (r >> 5); }
struct AddrGateUp { static constexpr bool LOADS = true; const int* seli;
    DI unsigned arow(const pg8::Unit& u, int r) const { const int b = u.pm & 31; const int t = seli[moe_panel(u.pm) * 256 + r]; return (unsigned)(b * SEQ + t) * (unsigned)(DM * 2); }
    DI unsigned short arow_tok(const pg8::Unit& u, int r) const { return (unsigned short)seli[moe_panel(u.pm) * 256 + r]; }
    DI unsigned arow_lds(const LAS unsigned char* tab, int k, const pg8::Unit& u, int r) const { const int b = u.pm & 31; const int t = ((const LAS unsigned short*)tab)[k * 256 + r]; return (unsigned)(b * SEQ + t) * (unsigned)(DM * 2); }
    DI size_t boff(const pg8::Unit& u) const { return ((size_t)(u.pm >> 5) * 2048 + (size_t)u.pn * 256) * DM * 2; } };
struct AddrGateUp8 { static constexpr bool LOADS = true; static constexpr int SC_W = 0x79797979, SC_X = 0x7f7f7f7f; const int* seli;
    DI unsigned arow(const pg8::Unit& u, int r) const { const int b = u.pm & 31; const int t = seli[moe_panel(u.pm) * 256 + r]; return (unsigned)(b * SEQ + t) * (unsigned)DM; }
    DI unsigned short arow_tok(const pg8::Unit& u, int r) const { return (unsigned short)seli[moe_panel(u.pm) * 256 + r]; }
    DI unsigned arow_lds(const LAS unsigned char* tab, int k, const pg8::Unit& u, int r) const { const int b = u.pm & 31; const int t = ((const LAS unsigned short*)tab)[k * 256 + r]; return (unsigned)(b * SEQ + t) * (unsigned)DM; }
    DI size_t boff(const pg8::Unit& u) const { return ((size_t)(u.pm >> 5) * 2048 + (size_t)u.pn * 256) * DM; } };
struct AddrDown8 { static constexpr bool LOADS = false; static constexpr int SC_W = 0x79797979, SC_X = 0x7c7c7c7c;
    DI unsigned arow(const pg8::Unit& u, int r) const { return (unsigned)(moe_panel(u.pm) * 256 + r) * (unsigned)DM; }
    DI size_t boff(const pg8::Unit& u) const { return ((size_t)(u.pm >> 5) * 1024 + (size_t)u.pn * 256) * DM; } };
struct AddrDown { static constexpr bool LOADS = false;
    DI unsigned arow(const pg8::Unit& u, int r) const { return (unsigned)(moe_panel(u.pm) * 256 + r) * (unsigned)(DM * 2); }
    DI size_t boff(const pg8::Unit& u) const { return ((size_t)(u.pm >> 5) * 1024 + (size_t)u.pn * 256) * DM * 2; } };

struct EpiProj { static constexpr int PID = 1; static constexpr bool PERM = true, ROWTAB = true; bf16_t* O; const float* rsm;
    DI float rowscale(const pg8::Unit& u, int r) const { return rsm[u.pm * 256 + r]; }
    DI void operator()(const f32x4 (&acc)[2][2][4][2], const pg8::Unit& u, int wr, int wc, int fr, int fq, const LAS float* rtab) const {
        const int row0 = u.pm * 256 + wr * 64 + fr, col0 = u.pn * 256 + wc * 32 + 8 * fq;
#pragma unroll
        for (int ai = 0; ai < 2; ++ai)
#pragma unroll
            for (int m = 0; m < 4; ++m) { bf16_t* rowp = O + (size_t)(row0 + ai * 128 + m * 16) * NPROJ + col0; const float g = rtab[wr * 64 + fr + ai * 128 + m * 16];
#pragma unroll
                for (int bj = 0; bj < 2; ++bj) { const f32x4 v0 = acc[ai][bj][m][0] * g, v1 = acc[ai][bj][m][1] * g;
                    u32x4 w; w.x = pk2(v0[0], v0[1]); w.y = pk2(v0[2], v0[3]); w.z = pk2(v1[0], v1[1]); w.w = pk2(v1[2], v1[3]);
                    *(u32x4*)(rowp + bj * 128) = w; } }
    } };
struct EpiRes { static constexpr int PID = 5; static constexpr bool PERM = true, ROWTAB = false; const float* base32; const bf16_t* base16; bf16_t* out;
    DI void operator()(const f32x4 (&acc)[2][2][4][2], const pg8::Unit& u, int wr, int wc, int fr, int fq, const LAS float* rtab) const {
        const int row0 = u.pm * 256 + wr * 64 + fr, col0 = u.pn * 256 + wc * 32 + 8 * fq;
#pragma unroll
        for (int ai = 0; ai < 2; ++ai)
#pragma unroll
            for (int m = 0; m < 4; ++m) { const size_t off = (size_t)(row0 + ai * 128 + m * 16) * DM + col0;
#pragma unroll
                for (int bj = 0; bj < 2; ++bj) { f32x4 v0 = acc[ai][bj][m][0], v1 = acc[ai][bj][m][1];
                    if (base32) { v0 = v0 + *(const f32x4*)(base32 + off + bj * 128); v1 = v1 + *(const f32x4*)(base32 + off + bj * 128 + 4); }
                    else { const u32x4 bs = *(const u32x4*)(base16 + off + bj * 128);
                        v0 = v0 + (f32x4){bflo(bs.x), bfhi(bs.x), bflo(bs.y), bfhi(bs.y)}; v1 = v1 + (f32x4){bflo(bs.z), bfhi(bs.z), bflo(bs.w), bfhi(bs.w)}; }
                    u32x4 w; w.x = pk2(v0[0], v0[1]); w.y = pk2(v0[2], v0[3]); w.z = pk2(v1[0], v1[1]); w.w = pk2(v1[2], v1[3]);
                    *(u32x4*)(out + off + bj * 128) = w; } }
    } };
struct EpiGateUp { static constexpr int PID = 18; static constexpr bool PERM = true, ROWTAB = true; bf16_t* H; const float* selr;
    DI float rowscale(const pg8::Unit& u, int r) const { return selr[moe_panel(u.pm) * 256 + r]; }
    DI void operator()(const f32x4 (&acc)[2][2][4][2], const pg8::Unit& u, int wr, int wc, int fr, int fq, const LAS float* rtab) const {
        const int row0 = moe_panel(u.pm) * 256 + wr * 64 + fr, col0 = u.pn * 128 + wc * 32 + 8 * fq;
#pragma unroll
        for (int ai = 0; ai < 2; ++ai)
#pragma unroll
            for (int m = 0; m < 4; ++m) { bf16_t* rowp = H + (size_t)(row0 + ai * 128 + m * 16) * DM + col0; const float rr = rtab[wr * 64 + fr + ai * 128 + m * 16];
                float hv[8];
#pragma unroll
                for (int n = 0; n < 2; ++n)
#pragma unroll
                    for (int j = 0; j < 4; ++j) { const float g = acc[ai][0][m][n][j] * rr, up = acc[ai][1][m][n][j] * rr; hv[n * 4 + j] = silu_f(g) * up; }
                u32x4 w; w.x = pk2(hv[0], hv[1]); w.y = pk2(hv[2], hv[3]); w.z = pk2(hv[4], hv[5]); w.w = pk2(hv[6], hv[7]);
                *(u32x4*)rowp = w; }
    } };
struct EpiGateUp8 { static constexpr int PID = 8; static constexpr bool PERM = true, ROWTAB = true; unsigned char* H; const float* selr;
    DI float rowscale(const pg8::Unit& u, int r) const { return selr[moe_panel(u.pm) * 256 + r]; }
    DI void operator()(const f32x4 (&acc)[2][2][4][2], const pg8::Unit& u, int wr, int wc, int fr, int fq, const LAS float* rtab) const {
        const int row0 = moe_panel(u.pm) * 256 + wr * 64 + fr, col0 = u.pn * 128 + wc * 32 + 8 * fq;
#pragma unroll
        for (int ai = 0; ai < 2; ++ai)
#pragma unroll
            for (int m = 0; m < 4; ++m) { unsigned char* rowp = H + (size_t)(row0 + ai * 128 + m * 16) * DM + col0; const float rr = rtab[wr * 64 + fr + ai * 128 + m * 16]; const float c1 = -1.4426950408889634f * rr, k2 = 8.0f * rr * rr;
                float hv[8];
#pragma unroll
                for (int n = 0; n < 2; ++n)
#pragma unroll
                    for (int j = 0; j < 4; ++j) { const float g = acc[ai][0][m][n][j], up = acc[ai][1][m][n][j];
                        hv[n * 4 + j] = (g * up) * (k2 * __builtin_amdgcn_rcpf(1.0f + __builtin_amdgcn_exp2f(g * c1))); }
                *(u32x2*)rowp = (u32x2){pk4_fp8(hv[0], hv[1], hv[2], hv[3]), pk4_fp8(hv[4], hv[5], hv[6], hv[7])}; }
    } };
struct EpiDown { static constexpr int PID = 9; static constexpr bool PERM = true, ROWTAB = true; bf16_t* Y; const float* gate;
    DI float rowscale(const pg8::Unit& u, int r) const { return gate[moe_panel(u.pm) * 256 + r]; }
    DI void operator()(const f32x4 (&acc)[2][2][4][2], const pg8::Unit& u, int wr, int wc, int fr, int fq, const LAS float* rtab) const {
        const int row0 = moe_panel(u.pm) * 256 + wr * 64 + fr, col0 = u.pn * 256 + wc * 32 + 8 * fq;
#pragma unroll
        for (int ai = 0; ai < 2; ++ai)
#pragma unroll
            for (int m = 0; m < 4; ++m) { const int row = row0 + ai * 128 + m * 16; const float g = rtab[wr * 64 + fr + ai * 128 + m * 16]; bf16_t* rowp = Y + (size_t)row * DM + col0;
#pragma unroll
                for (int bj = 0; bj < 2; ++bj) { const f32x4 v0 = acc[ai][bj][m][0] * g, v1 = acc[ai][bj][m][1] * g;
                    u32x4 w; w.x = pk2(v0[0], v0[1]); w.y = pk2(v0[2], v0[3]); w.z = pk2(v1[0], v1[1]); w.w = pk2(v1[2], v1[3]);
                    *(u32x4*)(rowp + bj * 128) = w; } }
    } };

DI void phase_premix(const Params& P, int l, LAS unsigned char* lds) {
    const int tid = tid_opaque(P.wv), lane = tid & 63, wave = tid >> 6;
    const int gw = blockIdx.x * 8 + wave, NGW = gridDim.x * 8;
    unsigned char* ws = P.ws;
    const bf16_t* proj = (const bf16_t*)(ws + WS_PROJ);
    unsigned char* dsc = (unsigned char*)P.out;
    if (EN_HY) {
        bf16_t* HW = (bf16_t*)(dsc + DO_HW); bf16_t* HX0 = (bf16_t*)(dsc + DO_HX0);
        const float* cw = P.hy_conv_w + (size_t)l * 3 * 768;
        LAS unsigned char* tl = lds + wave * 15616;
        const int rsub = lane >> 3, cch = lane & 7;
        const int i16 = lane & 15, trq = i16 >> 2, trp = i16 & 3, g16 = lane >> 4;
        const unsigned troff = (unsigned)(trq * 144 + (16 * g16 + 4 * trp) * 2);
        u32x4 rin[5][3];
#define HYPM_LOAD(IT) do { const int ct_ = (IT) & 3, tt_ = ((IT) >> 2) & 63, b_ = (IT) >> 8; const int t0_ = tt_ * 32; \
            const bf16_t* pr_ = proj + ((size_t)b_ * SEQ) * NPROJ + ct_ * 64 + 8 * cch; \
            _Pragma("unroll") for (int i = 0; i < 5; ++i) { const int rr = rsub + 8 * i; const int t = t0_ - 1 + rr; const bool ok = (rr < 34) && (t >= 0) && (t < SEQ); \
                const bf16_t* q = pr_ + (size_t)(ok ? t : 0) * NPROJ; \
                _Pragma("unroll") for (int a = 0; a < 3; ++a) { rin[i][a] = *(const u32x4*)(q + 256 * a); if (!ok) rin[i][a] = (u32x4){0u, 0u, 0u, 0u}; } } } while (0)
        if (gw < NB * 64 * 4) HYPM_LOAD(gw);
        for (int it = gw; it < NB * 64 * 4; it += NGW) {
            const int ct = it & 3, tt = (it >> 2) & 63, b = it >> 8;
            const int c = ct * 64 + lane, t0 = tt * 32;
#pragma unroll
            for (int i = 0; i < 5; ++i) { const int rr = rsub + 8 * i;
#pragma unroll
                for (int a = 0; a < 3; ++a) if (rr < 36) *(LAS u32x4*)(tl + a * 5184 + rr * 144 + 16 * cch) = rin[i][a]; }
            if (it + NGW < NB * 64 * 4) HYPM_LOAD(it + NGW);
            float w0[3], w1[3], w2[3];
#pragma unroll
            for (int j = 0; j < 3; ++j) { w0[j] = cw[j * 768 + c]; w1[j] = cw[j * 768 + 256 + c]; w2[j] = cw[j * 768 + 512 + c]; }
            LDS_WAIT();
            float p0[4], p1[4], p2[4];
            unsigned hwv[16], hxv[16];
#pragma unroll
            for (int j = 0; j < 9; ++j) {
                const s16x4 r0 = __builtin_amdgcn_ds_read_tr16_b64_v4i16((LAS s16x4*)(tl + 0 * 5184 + troff + (4 * j) * 144));
                const s16x4 r1 = __builtin_amdgcn_ds_read_tr16_b64_v4i16((LAS s16x4*)(tl + 1 * 5184 + troff + (4 * j) * 144));
                const s16x4 r2 = __builtin_amdgcn_ds_read_tr16_b64_v4i16((LAS s16x4*)(tl + 2 * 5184 + troff + (4 * j) * 144));
                float c0[4], c1[4], c2[4];
#pragma unroll
                for (int k = 0; k < 4; ++k) { c0[k] = bf2f((unsigned short)r0[k]); c1[k] = bf2f((unsigned short)r1[k]); c2[k] = bf2f((unsigned short)r2[k]); }
                if (j > 0) {
                    float u0[4], hv[4];
#pragma unroll
                    for (int k = 0; k < 4; ++k) { const float a0 = p0[k], a1 = p1[k], a2 = p2[k];
                        const float b0 = (k < 3) ? p0[k + 1] : c0[0], b1 = (k < 3) ? p1[k + 1] : c1[0], b2 = (k < 3) ? p2[k + 1] : c2[0];
                        const float d0 = (k < 2) ? p0[k + 2] : c0[k - 2], d1 = (k < 2) ? p1[k + 2] : c1[k - 2], d2 = (k < 2) ? p2[k + 2] : c2[k - 2];
                        u0[k] = w0[0] * a0 + w0[1] * b0 + w0[2] * d0;
                        hv[k] = (w2[0] * a2 + w2[1] * b2 + w2[2] * d2) * (w1[0] * a1 + w1[1] * b1 + w1[2] * d1); }
                    hwv[2 * (j - 1)] = pk2(hv[0], hv[1]); hwv[2 * (j - 1) + 1] = pk2(hv[2], hv[3]); hxv[2 * (j - 1)] = pk2(u0[0], u0[1]); hxv[2 * (j - 1) + 1] = pk2(u0[2], u0[3]);
                }
#pragma unroll
                for (int k = 0; k < 4; ++k) { p0[k] = c0[k]; p1[k] = c1[k]; p2[k] = c2[k]; }
            }
            bf16_t* hwp = HW + ((size_t)c * NB + b) * SEQ + t0; bf16_t* hxp = HX0 + ((size_t)c * NB + b) * SEQ + t0;
#pragma unroll
            for (int k = 0; k < 4; ++k) { *(u32x4*)(hwp + 8 * k) = (u32x4){hwv[4 * k], hwv[4 * k + 1], hwv[4 * k + 2], hwv[4 * k + 3]}; *(u32x4*)(hxp + 8 * k) = (u32x4){hxv[4 * k], hxv[4 * k + 1], hxv[4 * k + 2], hxv[4 * k + 3]}; }
            LDS_WAIT();
        }
    }
    if (EN_MA) {
        bf16_t* MX = (bf16_t*)(dsc + DO_MXBC);
        const float* cw = P.m_conv_w + (size_t)l * 5 * 512; const float* cb = P.m_conv_b + (size_t)l * 512;
        const int gt = blockIdx.x * 512 + tid, NGT = gridDim.x * 512;
        for (int it = gt; it < (NTOK / 4) * 64; it += NGT) {
            const int ch = (it & 63) * 8, m0 = (it >> 6) * 4, t0 = m0 & (SEQ - 1);
            u32x4 rw[8];
#pragma unroll
            for (int j = 0; j < 8; ++j) { const int tt = t0 + j - 2; const bool ok = (tt >= 0) && (tt < SEQ);
                rw[j] = *(const u32x4*)(proj + (size_t)(ok ? m0 + j - 2 : m0) * NPROJ + PC_MX + ch); if (!ok) rw[j] = (u32x4){0u, 0u, 0u, 0u}; }
            f32x4 wa[5], wb[5];
#pragma unroll
            for (int j = 0; j < 5; ++j) { wa[j] = *(const f32x4*)(cw + j * 512 + ch); wb[j] = *(const f32x4*)(cw + j * 512 + ch + 4); }
            const f32x4 ba = *(const f32x4*)(cb + ch), bb = *(const f32x4*)(cb + ch + 4);
#pragma unroll
            for (int k = 0; k < 4; ++k) {
                float a[8] = {ba.x, ba.y, ba.z, ba.w, bb.x, bb.y, bb.z, bb.w};
#pragma unroll
                for (int j = 0; j < 5; ++j) { const u32x4 v = rw[k + j];
                    a[0] += wa[j].x * bflo(v.x); a[1] += wa[j].y * bfhi(v.x); a[2] += wa[j].z * bflo(v.y); a[3] += wa[j].w * bfhi(v.y);
                    a[4] += wb[j].x * bflo(v.z); a[5] += wb[j].y * bfhi(v.z); a[6] += wb[j].z * bflo(v.w); a[7] += wb[j].w * bfhi(v.w); }
                u32x4 o; o.x = pk2(silu_f(a[0]), silu_f(a[1])); o.y = pk2(silu_f(a[2]), silu_f(a[3])); o.z = pk2(silu_f(a[4]), silu_f(a[5])); o.w = pk2(silu_f(a[6]), silu_f(a[7]));
                *(u32x4*)(MX + (size_t)(m0 + k) * 512 + ch) = o;
            }
        }
    }
}

DI void phase_finalize(const Params& P, int l) {
    const int tid = tid_opaque(P.wv), lane = tid & 63, wave = tid >> 6;
    const int gw = blockIdx.x * 8 + wave, NGW = gridDim.x * 8;
    unsigned char* ws = P.ws; unsigned char* dsc = (unsigned char*)P.out;
    bf16_t* MIX = (bf16_t*)(ws + WS_HN);
    {
        const bf16_t* YAT = (const bf16_t*)(dsc + DO_YAT);
        for (int it = gw; it < NB * 32 * 4; it += NGW) {
            const int ct = it & 3, tt = (it >> 2) & 31, b = it >> 7;
            const int c = ct * 64 + lane, t0 = tt * 64;
            const bf16_t* src = YAT + ((size_t)c * NB + b) * SEQ + t0;
            bf16_t* dst = MIX + ((size_t)b * SEQ + t0) * DM + c;
#pragma unroll 2
            for (int t8 = 0; t8 < 64; t8 += 8) {
                u32x4 v = EN_HY ? *(const u32x4*)(src + t8) : (u32x4){0u, 0u, 0u, 0u};
                const unsigned w[4] = {v.x, v.y, v.z, v.w};
#pragma unroll
                for (int i = 0; i < 8; ++i) dst[(size_t)(t8 + i) * DM] = (bf16_t)((i & 1) ? (w[i >> 1] >> 16) : (w[i >> 1] & 0xffffu));
            }
        }
    }
    {
        const bf16_t* MYF = (const bf16_t*)(dsc + DO_MY); const bf16_t* MYB = (const bf16_t*)(ws + WS_MYB); const bf16_t* MX = (const bf16_t*)(dsc + DO_MXBC);
        const bf16_t* OB = (const bf16_t*)(ws + WS_OB); const bf16_t* proj = (const bf16_t*)(ws + WS_PROJ);
        const float* nwm = P.m_norm_w + l * 256; const float* nwh = P.hg_norm_w + l * 64;
        const int gt = blockIdx.x * 512 + tid, NGT = gridDim.x * 512;
        for (int it = gt; it < NTOK * 32; it += NGT) {
            const int ch = (it & 31) * 8, m = it >> 5;
            const u32x4 yf = *(const u32x4*)(MYF + (size_t)m * 256 + ch), yb = *(const u32x4*)(MYB + (size_t)m * 256 + ch), xv = *(const u32x4*)(MX + (size_t)m * 512 + ch), zv = *(const u32x4*)(proj + (size_t)m * NPROJ + PC_MZ + ch);
            const u32x4 of = *(const u32x4*)(MIX + (size_t)m * DM + 768 + ch), ob = *(const u32x4*)(OB + (size_t)m * 256 + ch), gv = *(const u32x4*)(proj + (size_t)m * NPROJ + PC_HG + ch);
            u32x4 o = {0u, 0u, 0u, 0u};
            if (EN_MA) {
                const float Dk = P.m_D[l * 4 + (ch >> 6)];
                const unsigned yfw[4] = {yf.x, yf.y, yf.z, yf.w}, ybw[4] = {yb.x, yb.y, yb.z, yb.w}, xw[4] = {xv.x, xv.y, xv.z, xv.w}, zw[4] = {zv.x, zv.y, zv.z, zv.w};
                float y[8]; float sq = 0.f;
#pragma unroll
                for (int j = 0; j < 4; ++j) { y[2 * j] = (bflo(yfw[j]) + bflo(ybw[j]) + Dk * bflo(xw[j])) * silu_f(bflo(zw[j])); y[2 * j + 1] = (bfhi(yfw[j]) + bfhi(ybw[j]) + Dk * bfhi(xw[j])) * silu_f(bfhi(zw[j]));
                    sq += y[2 * j] * y[2 * j] + y[2 * j + 1] * y[2 * j + 1]; }
                sq = x16_sum(row_sum16(sq));
                const float r = __builtin_amdgcn_rsqf(sq * (1.0f / 256.0f) + EPSN);
                const f32x4 wa = *(const f32x4*)(nwm + ch), wb = *(const f32x4*)(nwm + ch + 4);
                o.x = pk2(y[0] * r * wa.x, y[1] * r * wa.y); o.y = pk2(y[2] * r * wa.z, y[3] * r * wa.w); o.z = pk2(y[4] * r * wb.x, y[5] * r * wb.y); o.w = pk2(y[6] * r * wb.z, y[7] * r * wb.w);
            }
            *(u32x4*)(MIX + (size_t)m * DM + 256 + ch) = o;
            if (EN_HG) {
                const unsigned ofw[4] = {of.x, of.y, of.z, of.w}, obw[4] = {ob.x, ob.y, ob.z, ob.w}, gw4[4] = {gv.x, gv.y, gv.z, gv.w};
                float y[8]; float sq = 0.f;
#pragma unroll
                for (int j = 0; j < 4; ++j) { y[2 * j] = bflo(ofw[j]) + bflo(obw[j]); y[2 * j + 1] = bfhi(ofw[j]) + bfhi(obw[j]); sq += y[2 * j] * y[2 * j] + y[2 * j + 1] * y[2 * j + 1]; }
                sq = grp_sum8(sq);
                const float r = __builtin_amdgcn_rsqf(sq * (1.0f / 64.0f) + EPSN);
                const f32x4 wa = *(const f32x4*)(nwh + (ch & 63)), wb = *(const f32x4*)(nwh + (ch & 63) + 4);
                u32x4 oh;
                oh.x = pk2(y[0] * r * wa.x * silu_f(bflo(gw4[0])), y[1] * r * wa.y * silu_f(bfhi(gw4[0]))); oh.y = pk2(y[2] * r * wa.z * silu_f(bflo(gw4[1])), y[3] * r * wa.w * silu_f(bfhi(gw4[1])));
                oh.z = pk2(y[4] * r * wb.x * silu_f(bflo(gw4[2])), y[5] * r * wb.y * silu_f(bfhi(gw4[2]))); oh.w = pk2(y[6] * r * wb.z * silu_f(bflo(gw4[3])), y[7] * r * wb.w * silu_f(bfhi(gw4[3])));
                *(u32x4*)(MIX + (size_t)m * DM + 768 + ch) = oh;
            }
        }
    }
#if !EN_AT || !EN_HG
    {
        const int gt = blockIdx.x * 512 + tid, NGT = gridDim.x * 512;
        for (int it = gt; it < NTOK * 32; it += NGT) { const int ch = (it & 31) * 8, m = it >> 5;
            if (!EN_AT) *(u32x4*)(MIX + (size_t)m * DM + 512 + ch) = (u32x4){0u, 0u, 0u, 0u};
            if (!EN_HG) *(u32x4*)(MIX + (size_t)m * DM + 768 + ch) = (u32x4){0u, 0u, 0u, 0u}; }
    }
#endif
}

DI void phase_ffnpre(const Params& P, int l, LAS unsigned char* lds) {
    const int tid = tid_opaque(P.wv), lane = tid & 63, wave = tid >> 6, r = lane & 15, q = lane >> 4;
    const int gw = blockIdx.x * 8 + wave, NGW = gridDim.x * 8;
    unsigned char* ws = P.ws;
    LAS u32x4* Wh = (LAS u32x4*)lds;
    LAS u32x4* Wl = Wh + 32 * 64;
    for (int i = tid; i < 32 * 64; i += 512) { const int s = i >> 6, ln = i & 63, e = ln & 15, qq = ln >> 4; float wv[8]; unsigned hi[4], lo[4];
#pragma unroll
        for (int j = 0; j < 8; ++j) { const int k = 32 * s + 8 * qq + j; wv[j] = P.norm_ffn_w[l * DM + k] * P.router_w[((size_t)l * DM + k) * 16 + e]; }
#pragma unroll
        for (int j = 0; j < 4; ++j) { hi[j] = pk2(wv[2 * j], wv[2 * j + 1]); lo[j] = pk2(wv[2 * j] - bflo(hi[j]), wv[2 * j + 1] - bfhi(hi[j])); }
        Wh[i] = (u32x4){hi[0], hi[1], hi[2], hi[3]}; Wl[i] = (u32x4){lo[0], lo[1], lo[2], lo[3]}; }
    __syncthreads();
    const bf16_t* XB = (const bf16_t*)(ws + WS_XB); const float* nw = P.norm_ffn_w + l * DM + 8 * q;
    float* aff = (float*)(ws + WS_AFF); float* rs = (float*)(ws + WS_RS);
    bf16_t* XN = (bf16_t*)(ws + WS_HN);
    for (int grp = gw; grp < NTOK / 16; grp += NGW) {
        const int m0 = grp * 16;
        const bf16_t* xrow = XB + (size_t)(m0 + r) * DM + 8 * q; bf16_t* orow = XN + (size_t)(m0 + r) * DM + 8 * q; unsigned char* orow8 = (unsigned char*)XN + (size_t)(m0 + r) * DM + 8 * q; (void)orow; (void)orow8;
        f32x4 acc = {0.f, 0.f, 0.f, 0.f}; float ss = 0.f;
#pragma unroll 8
        for (int s = 0; s < 32; ++s) {
            const u32x4 xv = *(const u32x4*)(xrow + 32 * s);
            const f32x4 a = {bflo(xv.x), bfhi(xv.x), bflo(xv.y), bfhi(xv.y)}, b = {bflo(xv.z), bfhi(xv.z), bflo(xv.w), bfhi(xv.w)};
            const f32x4 wa = *(const f32x4*)(nw + 32 * s), wb = *(const f32x4*)(nw + 32 * s + 4);
            ss += (a.x * a.x + a.y * a.y) + (a.z * a.z + a.w * a.w) + (b.x * b.x + b.y * b.y) + (b.z * b.z + b.w * b.w);
            const bf16x8 ah = __builtin_bit_cast(bf16x8, xv);
            const bf16x8 wh = __builtin_bit_cast(bf16x8, Wh[s * 64 + lane]), wl = __builtin_bit_cast(bf16x8, Wl[s * 64 + lane]);
            acc = __builtin_amdgcn_mfma_f32_16x16x32_bf16(ah, wh, acc, 0, 0, 0);
            acc = __builtin_amdgcn_mfma_f32_16x16x32_bf16(ah, wl, acc, 0, 0, 0);
#if MOE_F8
            *(u32x2*)(orow8 + 32 * s) = (u32x2){pk4_fp8(a.x * wa.x, a.y * wa.y, a.z * wa.z, a.w * wa.w), pk4_fp8(b.x * wb.x, b.y * wb.y, b.z * wb.z, b.w * wb.w)};
#else
            *(u32x4*)(orow + 32 * s) = (u32x4){pk2(a.x * wa.x, a.y * wa.y), pk2(a.z * wa.z, a.w * wa.w), pk2(b.x * wb.x, b.y * wb.y), pk2(b.z * wb.z, b.w * wb.w)};
#endif
        }
        ss = xhalf_sum(x16_sum(ss));
        const float rinv = __builtin_amdgcn_rsqf(ss * (1.0f / DM) + EPSN);
        if (q == 0) rs[m0 + r] = rinv;
#pragma unroll
        for (int i = 0; i < 4; ++i) {
            const float lg = acc[i] * __shfl(rinv, 4 * q + i);
            const float mx = grp_max16(lg);
            const float ex = expf(lg - mx); const float se = row_sum16(ex);
            const int m = m0 + 4 * q + i;
            aff[((size_t)(m >> 11) * 16 + r) * SEQ + (m & (SEQ - 1))] = ex / se;
        }
    }
}

DI int wave_sum_i(int v) {
#pragma unroll
    for (int o = 1; o < 64; o <<= 1) v += __shfl_xor(v, o);
    return v;
}
DI int half_excl_scan(int c, int lane, int hw, LAS int* ws4, int* tot) {
    int inc = c;
#pragma unroll
    for (int o = 1; o < 64; o <<= 1) { const int t = __shfl_up(inc, o); if (lane >= o) inc += t; }
    if (lane == 63) ws4[hw] = inc;
    __syncthreads();
    int base = 0, total = 0;
#pragma unroll
    for (int w = 0; w < 4; ++w) { const int t = ws4[w]; base += (w < hw) ? t : 0; total += t; }
    *tot = total;
    return base + inc - c;
}
DI void phase_topk(const Params& P, int l, LAS unsigned char* lds) {
    const int tid = tid_opaque(P.wv), lane = tid & 63, wave = tid >> 6;
    unsigned char* ws = P.ws;
    const float* aff = (const float*)(ws + WS_AFF); const float* rs = (const float*)(ws + WS_RS);
    int* slot = (int*)(ws + WS_SLOT); int* seli = (int*)(ws + WS_SELI); float* selg = (float*)(ws + WS_SELG); float* selr = (float*)(ws + WS_SELR);
    const int half = wave >> 2, hw = wave & 3, ht = tid & 255;
    LAS int* wsum = (LAS int*)lds + half * 64;
    for (int u0 = blockIdx.x; u0 < NB * NEXP; u0 += 2 * gridDim.x) {
        const int u = u0 + half * gridDim.x; const bool live = u < NB * NEXP; const int uu = live ? u : u0;
        const int b = uu >> 4, e = uu & 15;
        __syncthreads();
        const u32x4 ka = *(const u32x4*)(aff + (size_t)uu * SEQ + 8 * ht), kb = *(const u32x4*)(aff + (size_t)uu * SEQ + 8 * ht + 4);
        const unsigned kk[8] = {ka.x, ka.y, ka.z, ka.w, kb.x, kb.y, kb.z, kb.w};
        const f32x4 ra = *(const f32x4*)(rs + (size_t)b * SEQ + 8 * ht), rb = *(const f32x4*)(rs + (size_t)b * SEQ + 8 * ht + 4);
        const float rsv[8] = {ra.x, ra.y, ra.z, ra.w, rb.x, rb.y, rb.z, rb.w};
        unsigned prefix = 0u;
#pragma unroll 1
        for (int bit = 30; bit >= 0; bit -= (bit == 30 ? 1 : 2)) {
            const unsigned hi = 1u << bit, lo = (bit == 30) ? 0u : (1u << (bit - 1));
            const unsigned c1 = prefix | hi, c0 = prefix | lo, c3 = prefix | hi | lo;
            int n1 = 0, n0 = 0, n3 = 0;
#pragma unroll
            for (int j = 0; j < 8; ++j) { n1 += __builtin_popcountll(__ballot(kk[j] >= c1)); n0 += __builtin_popcountll(__ballot(kk[j] >= c0)); n3 += __builtin_popcountll(__ballot(kk[j] >= c3)); }
            const int par = (bit & 2) ? 12 : 0;
            if (lane == 0) { wsum[par + hw * 3] = n1; wsum[par + hw * 3 + 1] = n0; wsum[par + hw * 3 + 2] = n3; }
            __syncthreads();
            int t1 = 0, t0 = 0, t3 = 0;
#pragma unroll
            for (int q = 0; q < 4; ++q) { t1 += wsum[par + q * 3]; t0 += wsum[par + q * 3 + 1]; t3 += wsum[par + q * 3 + 2]; }
            if (bit == 30) { if (t1 >= CAP) prefix = c1; }
            else if (t1 >= CAP) prefix = (t3 >= CAP) ? c3 : c1;
            else if (t0 >= CAP) prefix = c0;
        }
        const unsigned thr = prefix;
        int cgt = 0, ceq = 0;
#pragma unroll
        for (int j = 0; j < 8; ++j) { cgt += (kk[j] > thr) ? 1 : 0; ceq += (kk[j] == thr) ? 1 : 0; }
        int ngt; (void)half_excl_scan(cgt, lane, hw, wsum + 32, &ngt);
        const int need = CAP - ngt;
        int neq; int eqr = half_excl_scan(ceq, lane, hw, wsum + 36, &neq);
        bool sel[8]; int cs = 0;
#pragma unroll
        for (int j = 0; j < 8; ++j) { const bool eq = kk[j] == thr; sel[j] = (kk[j] > thr) || (eq && eqr < need); eqr += eq ? 1 : 0; cs += sel[j] ? 1 : 0; }
        int nsel; int sb = half_excl_scan(cs, lane, hw, wsum + 40, &nsel);
        if (live) {
#pragma unroll
            for (int j = 0; j < 8; ++j) { const int i = 8 * ht + j;
                slot[((size_t)b * SEQ + i) * 16 + e] = sel[j] ? sb : -1;
                if (sel[j]) { seli[u * CAP + sb] = i; selg[u * CAP + sb] = __uint_as_float(kk[j]); selr[u * CAP + sb] = rsv[j]; ++sb; } }
        }
    }
    __syncthreads();
    {
        const int gw = blockIdx.x * 8 + wave, NGW = gridDim.x * 8;
        LAS float* scr = (LAS float*)(lds + 4096 + wave * 8448);
        bf16_t* WguT = (bf16_t*)(ws + WS_WGU); bf16_t* WdT = (bf16_t*)(ws + WS_WD);
        constexpr int I_E = 16 * 32 * 16;
        for (int it = gw; it < 3 * I_E; it += NGW) {
            const int which = it / I_E; const int r = it - which * I_E;
            const int e = r / 512, kb = (r % 512) / 32, nb = r % 32;
            const size_t wofs = ((size_t)l * NEXP + e) * DM * DM;
#if MOE_F8
            if (which == 0)      transpose_item_f8(P.moe_wg + wofs, DM, 64 * kb, 32 * nb, (unsigned char*)WguT, e * 2048 + ((32 * nb) >> 7) * 256 + ((32 * nb) & 127), 64.0f, scr, lane);
            else if (which == 1) transpose_item_f8(P.moe_wu + wofs, DM, 64 * kb, 32 * nb, (unsigned char*)WguT, e * 2048 + ((32 * nb) >> 7) * 256 + 128 + ((32 * nb) & 127), 64.0f, scr, lane);
            else                 transpose_item_f8(P.moe_wd + wofs, DM, 64 * kb, 32 * nb, (unsigned char*)WdT, e * 1024 + 32 * nb, 64.0f, scr, lane);
#else
            if (which == 0)      transpose_item(P.moe_wg + wofs, DM, 64 * kb, 32 * nb, WguT, e * 2048 + ((32 * nb) >> 7) * 256 + ((32 * nb) & 127), 1.0f, scr, lane);
            else if (which == 1) transpose_item(P.moe_wu + wofs, DM, 64 * kb, 32 * nb, WguT, e * 2048 + ((32 * nb) >> 7) * 256 + 128 + ((32 * nb) & 127), 1.0f, scr, lane);
            else                 transpose_item(P.moe_wd + wofs, DM, 64 * kb, 32 * nb, WdT, e * 1024 + 32 * nb, 1.0f, scr, lane);
#endif
        }
    }
}

DI bf16x8 mk8(unsigned a, unsigned b, unsigned c, unsigned d) { u32x4 v = {a, b, c, d}; return __builtin_bit_cast(bf16x8, v); }
DI bf16x8 cat44(u32x2 lo, u32x2 hi) { u32x4 v = {lo.x, lo.y, hi.x, hi.y}; return __builtin_bit_cast(bf16x8, v); }
DI u32x4 ldg16(const void* ub, unsigned off) { return *(const u32x4*)((const char*)ub + off); }
DI u32x2 ldg8(const void* ub, unsigned off) { return *(const u32x2*)((const char*)ub + off); }
DI void stg2(void* ub, unsigned off, unsigned short v) { *(unsigned short*)((char*)ub + off) = v; }
DI int crow(int reg, int hh) { return (reg & 3) + 8 * (reg >> 2) + 4 * hh; }
#define PACK_STEP(x, s) mk8(pk2((x)[8 * (s)], (x)[8 * (s) + 1]), pk2((x)[8 * (s) + 2], (x)[8 * (s) + 3]), pk2((x)[8 * (s) + 4], (x)[8 * (s) + 5]), pk2((x)[8 * (s) + 6], (x)[8 * (s) + 7]))

#ifndef TPROBE
#define TPROBE 0
#endif
#ifndef TPWAVE
#define TPWAVE 0
#endif
#define TP_T() ({ asm volatile("" ::: "memory"); unsigned _t = (unsigned)__builtin_amdgcn_s_memrealtime(); asm volatile("" ::: "memory"); _t; })
#define TP_B(k) unsigned _tp##k = 0; if (TPROBE == (k) || ((k) == 1 && TPROBE)) _tp##k = TP_T();
#define TP_E(k) if ((k) == 1 && TPROBE) ttot += TP_T() - _tp##k; else if (TPROBE == (k)) tacc += TP_T() - _tp##k;
#ifndef HYD
#define HYD 4
#endif
DI void hyena_unit(const Params& P, int c, LAS unsigned char* lds) {
    const int tid = tid_opaque(P.wv), lane = tid & 63, w = __builtin_amdgcn_readfirstlane(tid >> 6), r = lane & 31, hh = lane >> 5;
    constexpr int CPS = 8224;
    unsigned char* ws = P.ws; unsigned char* dsc = (unsigned char*)P.out;
    const bf16_t* kf = (const bf16_t*)(ws + WS_KFILT) + (size_t)c * 4096;
    unsigned tacc = 0, ttot = 0;
    TP_B(1)
    __syncthreads();
    TP_B(81)
    {
        const u32x4 a = *(const u32x4*)(kf + 8 * tid), b = (tid < 511) ? *(const u32x4*)(kf + 8 * tid + 8) : (u32x4){0u, 0u, 0u, 0u};
        const unsigned d[9] = {a.x, a.y, a.z, a.w, b.x, b.y, b.z, b.w, 0u};
#pragma unroll
        for (int p = 0; p < 8; ++p) { const int m = p >> 1; u32x4 o;
            if (p & 1) { o.x = __builtin_amdgcn_alignbit(d[m + 1], d[m], 16); o.y = __builtin_amdgcn_alignbit(d[m + 2], d[m + 1], 16); o.z = __builtin_amdgcn_alignbit(d[m + 3], d[m + 2], 16); o.w = __builtin_amdgcn_alignbit(d[m + 4], d[m + 3], 16); }
            else { o.x = d[m]; o.y = d[m + 1]; o.z = d[m + 2]; o.w = d[m + 3]; }
            *(LAS u32x4*)(lds + p * CPS + tid * 16) = o; }
    }
    __syncthreads();
    TP_E(81)
    const bf16_t* hw = (const bf16_t*)(dsc + DO_HW) + ((size_t)c * NB + r) * SEQ + 8 * hh;
    f32x16 acc[8];
#pragma unroll
    for (int i = 0; i < 8; ++i)
#pragma unroll
        for (int q = 0; q < 16; ++q) acc[i][q] = 0.f;
    const int p = 7 - (r & 7);
    const LAS unsigned char* abase = lds + p * CPS + (2047 - 256 * w - r + 8 * hh - p) * 2;
    LAS unsigned char* Bt = lds + 8 * CPS;
    const bf16_t* hws = (const bf16_t*)(dsc + DO_HW) + ((size_t)c * NB + (tid >> 4)) * SEQ + 4 * (tid & 15);
    const unsigned bwo = (unsigned)((tid >> 4) * 144 + (tid & 15) * 8), bro = (unsigned)(r * 144 + 16 * hh);
    TP_B(82)
    u32x2 bpre[HYD];
#pragma unroll
    for (int d = 0; d < HYD; ++d) bpre[d] = *(const u32x2*)(hws + 64 * d);
    *(LAS u32x2*)(Bt + bwo) = bpre[0];
    __syncthreads();
#pragma unroll 1
    for (int s8 = 0; s8 < SEQ; s8 += 64 * HYD) {
#pragma unroll
        for (int d = 0; d < HYD; ++d) { const int sb = s8 + 64 * d;
            if (sb + 64 < SEQ) *(LAS u32x2*)(Bt + ((d + 1) & 1) * 4608 + bwo) = bpre[(d + 1) % HYD];
            if (sb + 64 * HYD < SEQ) bpre[d] = *(const u32x2*)(hws + sb + 64 * HYD);
#pragma unroll
            for (int j = 0; j < 4; ++j) { const int s0 = sb + 16 * j; const bf16x8 bfr = *(const LAS bf16x8*)(Bt + (d & 1) * 4608 + bro + 32 * j);
#pragma unroll
                for (int i = 0; i < 8; ++i) { const bf16x8 afr = *(const LAS bf16x8*)(abase + (s0 - 32 * i) * 2); acc[i] = MFMA32(afr, bfr, acc[i]); }
                __builtin_amdgcn_sched_barrier(0); }
            __syncthreads(); }
    }
    TP_E(82)
    TP_B(83)
    const bf16_t* hx = (const bf16_t*)(dsc + DO_HX0) + ((size_t)c * NB + r) * SEQ;
    bf16_t* ya = (bf16_t*)(dsc + DO_YAT) + ((size_t)c * NB + r) * SEQ;
#pragma unroll
    for (int i = 0; i < 8; ++i)
#pragma unroll
        for (int g = 0; g < 4; ++g) { const int t = 256 * w + 32 * i + 8 * g + 4 * hh;
            const u32x2 xv = *(const u32x2*)(hx + t);
            u32x2 o; o.x = pk2(acc[i][4 * g] * bflo(xv.x), acc[i][4 * g + 1] * bfhi(xv.x)); o.y = pk2(acc[i][4 * g + 2] * bflo(xv.y), acc[i][4 * g + 3] * bfhi(xv.y));
            *(u32x2*)(ya + t) = o; }
    TP_E(83)
    TP_E(1)
    if (TPROBE >= 80 && TPROBE < 90 && lane == 0 && w == (TPWAVE)) { atomicAdd((unsigned*)(ws + WS_CTL) + 512, tacc); atomicAdd((unsigned*)(ws + WS_CTL) + 513, ttot); }
}

DI int t5_bucket(int rel) {
    const int ret = rel > 0 ? 16 : 0; const int n = rel < 0 ? -rel : rel;
    if (n < 8) return ret + n;
    const float nf = (float)n;
    int large = 8 + (int)(logf(nf / 8.0f) / 4.852030263919617f * 8.0f);
    large = large < 15 ? large : 15;
    return ret + large;
}
#ifndef ATT_FAST
#define ATT_FAST 0
#endif
struct AttPass { int d, rho, uq0, nq; };
DI AttPass att_pass(int pp, int Q0, int w) {
    AttPass a;
    if (pp == 0) { a.d = 1; a.rho = 0; a.uq0 = Q0 + 32 * w; a.nq = 32; }
    else if (pp == 1) { a.d = 4; a.rho = w & 3; a.uq0 = (Q0 >> 2) + 32 * (w >> 2); a.nq = 32; }
    else { a.d = 16; a.rho = 2 * w + (pp - 2); a.uq0 = Q0 >> 4; a.nq = 16; }
    return a;
}
DI void attn_unit(const Params& P, int u, LAS unsigned char* lds, int& bias_h) {
    unsigned tacc = 0, ttot = 0;
    const int qb = u & 7, h = (u >> 3) & 3, b = u >> 5;
    const int tid = tid_opaque(P.wv), lane = tid & 63, w = __builtin_amdgcn_readfirstlane(tid >> 6), c = lane & 31, hh = lane >> 5;
    LAS float* Ost = (LAS float*)lds;
    LAS float* Mst = (LAS float*)(lds + 69632);
    LAS float* Lst = Mst + 256;
    LAS float* biasT = (LAS float*)(lds + 69632 + 2048);
    LAS unsigned char* Vr = lds + 69632 + 2048 + 12800 + w * 6144;
    unsigned char* ws = P.ws;
    TP_B(1)
    { TP_B(3) __syncthreads(); TP_E(3) }
    if (bias_h != h) {
        const float* relb = P.rel_bias; asm volatile("" : "+s"(relb));
        for (int i = tid; i < 4 * 768; i += 512) { const int s = i / 768, jx = i - 768 * s; const int pat = jx >> 8, rel = (jx & 255) - 128, dd = pat == 0 ? 1 : (pat == 1 ? 4 : 16);
            biasT[s * 784 + jx + s] = (rel >= -64 && rel <= 64) ? relb[t5_bucket(rel * dd) * 4 + h] * 1.4426950408889634f : -INFINITY; }
        __syncthreads();
        bias_h = h;
    }
    const bf16_t* pb = (const bf16_t*)(ws + WS_PROJ) + (size_t)b * SEQ * NPROJ;
    bf16_t* MIX = (bf16_t*)(ws + WS_HN);
    const int Q0 = qb * 256;
    const int i16 = lane & 15, trq = i16 >> 2, trp = i16 & 3;
    const unsigned troff = (unsigned)((4 * hh + trq) * 192 + (16 * ((lane >> 4) & 1) + 4 * trp) * 2);
    const int r8 = lane >> 3, j8 = lane & 7;
#define ATT_LOAD(KF, VR, KT, AP) do { const int nsub_ = SEQ / (AP).d, tlo_ = (AP).uq0 - 64 + 32 * (KT); \
        if (ATT_FAST && tlo_ >= 0 && tlo_ + 31 < nsub_) {                   \
            const unsigned lo_ = (unsigned)(r8 * (AP).d * NPROJ + 8 * j8) * 2u; \
            _Pragma("unroll") for (int i = 0; i < 4; ++i) { const bf16_t* b_ = pb + (size_t)(((tlo_ + 8 * i) * (AP).d + (AP).rho) * NPROJ + h * 64); \
                KF[i] = __builtin_bit_cast(bf16x8, ldg16(b_ + PC_AK, lo_)); VR[i] = ldg16(b_ + PC_AV, lo_); } \
        } else { \
            _Pragma("unroll") for (int i = 0; i < 4; ++i) { const int ukr_ = tlo_ + 8 * i + r8; const int ukc_ = ukr_ < 0 ? 0 : (ukr_ >= nsub_ ? nsub_ - 1 : ukr_); \
                const unsigned ko_ = (unsigned)((ukc_ * (AP).d + (AP).rho) * NPROJ + h * 64 + 8 * j8) * 2u; \
                KF[i] = __builtin_bit_cast(bf16x8, ldg16(pb + PC_AK, ko_)); VR[i] = ldg16(pb + PC_AV, ko_); } } } while (0)
#define ATT_TILE(KF, VR, KT, NEXTLOAD) do { const int kt = (KT); \
        bf16x8 kq_[4]; \
        f32x16 st;                                                          \
        _Pragma("unroll") for (int g = 0; g < 4; ++g) { const f32x4 bv_ = *(const LAS f32x4*)(tb4 + 32 * kt + 8 * g); st[4 * g] = bv_.x; st[4 * g + 1] = bv_.y; st[4 * g + 2] = bv_.z; st[4 * g + 3] = bv_.w; } \
        _Pragma("unroll") for (int i = 0; i < 4; ++i) *(LAS bf16x8*)(Vr + (8 * i + r8) * 144 + 16 * j8) = KF[i]; \
        _Pragma("unroll") for (int ks = 0; ks < 4; ++ks) kq_[ks] = *(const LAS bf16x8*)(Vr + c * 144 + 32 * ks + 16 * hh); \
        _Pragma("unroll") for (int i = 0; i < 4; ++i) *(LAS u32x4*)(Vr + (8 * i + r8) * 192 + 16 * j8) = VR[i]; \
        _Pragma("unroll") for (int ks = 0; ks < 4; ++ks) st = MFMA32(kq_[ks], qf[ks], st); \
        NEXTLOAD; \
        float tmax = -INFINITY; float lg[16]; \
        { const int tlo = uk0 + 32 * kt; \
          if (tlo >= 0 && tlo + 31 < nsub) { \
            _Pragma("unroll") for (int q = 0; q < 16; ++q) { lg[q] = st[q]; tmax = fmaxf(tmax, lg[q]); } \
          } else { \
            _Pragma("unroll") for (int q = 0; q < 16; ++q) { const int uk = tlo + crow(q, hh); lg[q] = (uk >= 0 && uk < nsub) ? st[q] : -INFINITY; tmax = fmaxf(tmax, lg[q]); } \
          } } \
        tmax = xhalf_max(tmax); \
        if (__any(tmax > mrun + 8.0f)) { const float mnew = fmaxf(mrun, tmax), alpha = __builtin_amdgcn_exp2f(mrun - mnew); lrun *= alpha; mrun = mnew; \
            _Pragma("unroll") for (int dt = 0; dt < 2; ++dt) _Pragma("unroll") for (int q = 0; q < 16; ++q) OT[dt][q] *= alpha; } \
        float psum = 0.f; \
        _Pragma("unroll") for (int q = 0; q < 16; ++q) { lg[q] = __builtin_amdgcn_exp2f(lg[q] - mrun); psum += lg[q]; } \
        lrun += xhalf_sum(psum); \
        LDS_WAIT(); \
        _Pragma("unroll") for (int s = 0; s < 2; ++s) { const bf16x8 pf = PACK_STEP(lg, s); \
            _Pragma("unroll") for (int dt = 0; dt < 2; ++dt) { \
                const s16x4 lo = __builtin_amdgcn_ds_read_tr16_b64_v4i16((LAS s16x4*)(Vr + troff + (16 * s) * 192 + 64 * dt)); \
                const s16x4 hi = __builtin_amdgcn_ds_read_tr16_b64_v4i16((LAS s16x4*)(Vr + troff + (16 * s + 8) * 192 + 64 * dt)); \
                OT[dt] = MFMA32(__builtin_shufflevector(lo, hi, 0, 1, 2, 3, 4, 5, 6, 7), pf, OT[dt]); } } \
        LDS_WAIT(); } while (0)
    bf16x8 kfA[4], kfB[4]; u32x4 vrA[4], vrB[4];
    bf16x8 qnext[4];
    { const AttPass a0 = att_pass(0, Q0, w);
      ATT_LOAD(kfA, vrA, 0, a0); ATT_LOAD(kfB, vrB, 1, a0);
      const int qpos0 = a0.uq0 + c;
#pragma unroll
      for (int ks = 0; ks < 4; ++ks) qnext[ks] = *(const bf16x8*)(pb + (size_t)qpos0 * NPROJ + PC_AQ + h * 64 + 16 * ks + 8 * hh); }
    auto pass = [&](const int pp, bf16x8 (&kf0)[4], u32x4 (&vr0)[4], bf16x8 (&kf1)[4], u32x4 (&vr1)[4]) __attribute__((always_inline)) {
        const int pat = pp < 2 ? pp : 2;
        const AttPass ap = att_pass(pp, Q0, w), an = att_pass(pp < 3 ? pp + 1 : 3, Q0, w);
        const int d = ap.d, rho = ap.rho, uq0 = ap.uq0, nq = ap.nq;
        const int uk0 = uq0 - 64, nsub = SEQ / d;
        const int cq = (c < nq) ? c : c - nq;
        const int qpos = (uq0 + cq) * d + rho, ql = qpos - Q0;
        const LAS float* tb4 = biasT + (cq & 3) * 784 + pat * 256 + (64 - cq + 4 * hh + (cq & 3));
        bf16x8 qf[4];
#pragma unroll
        for (int ks = 0; ks < 4; ++ks) qf[ks] = qnext[ks];
        if (pp < 3) {
            const int cq2 = (c < an.nq) ? c : c - an.nq; const int qpos2 = (an.uq0 + cq2) * an.d + an.rho;
#pragma unroll
            for (int ks = 0; ks < 4; ++ks) qnext[ks] = *(const bf16x8*)(pb + (size_t)qpos2 * NPROJ + PC_AQ + h * 64 + 16 * ks + 8 * hh); }
        float mrun = -1.0e30f, lrun = 0.f; f32x16 OT[2];
#pragma unroll
        for (int dt = 0; dt < 2; ++dt)
#pragma unroll
            for (int q = 0; q < 16; ++q) OT[dt][q] = 0.f;
        if (pat != 0) { mrun = Mst[ql]; lrun = Lst[ql];
#pragma unroll
            for (int dt = 0; dt < 2; ++dt)
#pragma unroll
                for (int g = 0; g < 4; ++g) { const f32x4 v = *(const LAS f32x4*)(Ost + ql * 68 + 32 * dt + 8 * g + 4 * hh);
                    OT[dt][4 * g] = v.x; OT[dt][4 * g + 1] = v.y; OT[dt][4 * g + 2] = v.z; OT[dt][4 * g + 3] = v.w; } }
        { TP_B(2)
        ATT_TILE(kf0, vr0, 0, ATT_LOAD(kf0, vr0, 2, ap)); ATT_TILE(kf1, vr1, 1, ATT_LOAD(kf1, vr1, 3, ap)); ATT_TILE(kf0, vr0, 2, ATT_LOAD(kf0, vr0, 4, ap));
        ATT_TILE(kf1, vr1, 3, if (pp < 3) { AttPass an_ = an; asm volatile("" : "+s"(an_.d), "+s"(an_.rho), "+s"(an_.uq0)); ATT_LOAD(kf1, vr1, 0, an_); });
        ATT_TILE(kf0, vr0, 4, if (pp < 3) { AttPass an_ = an; asm volatile("" : "+s"(an_.d), "+s"(an_.rho), "+s"(an_.uq0)); ATT_LOAD(kf0, vr0, 1, an_); });
        TP_E(2) }
        if (pat != 2) {
            if (hh == 0) { Mst[ql] = mrun; Lst[ql] = lrun; }
#pragma unroll
            for (int dt = 0; dt < 2; ++dt)
#pragma unroll
                for (int g = 0; g < 4; ++g) *(LAS f32x4*)(Ost + ql * 68 + 32 * dt + 8 * g + 4 * hh) = (f32x4){OT[dt][4 * g], OT[dt][4 * g + 1], OT[dt][4 * g + 2], OT[dt][4 * g + 3]};
        } else if (c < 16) {
            const float inv = __builtin_amdgcn_rcpf(lrun);
            bf16_t* orow = MIX + ((size_t)b * SEQ + qpos) * DM + 512 + h * 64;
#pragma unroll
            for (int dt = 0; dt < 2; ++dt)
#pragma unroll
                for (int g = 0; g < 4; ++g) { u32x2 o; o.x = pk2(OT[dt][4 * g] * inv, OT[dt][4 * g + 1] * inv); o.y = pk2(OT[dt][4 * g + 2] * inv, OT[dt][4 * g + 3] * inv);
                    *(u32x2*)(orow + 32 * dt + 8 * g + 4 * hh) = o; }
        }
        { TP_B(3) if (pp < 2) __syncthreads(); TP_E(3) }
    };
#pragma unroll 1
    for (int p2 = 0; p2 < 2; ++p2) { pass(2 * p2, kfA, vrA, kfB, vrB); pass(2 * p2 + 1, kfB, vrB, kfA, vrA); }
#undef ATT_LOAD
#undef ATT_TILE
    TP_E(1)
    if (TPROBE && TPROBE < 10 && (tid & 63) == 0 && w == (TPWAVE)) { atomicAdd((unsigned*)(ws + WS_CTL) + 512, tacc); atomicAdd((unsigned*)(ws + WS_CTL) + 513, ttot); }
}

DI float softplus_f(float x) { return x > 15.f ? x : __logf(1.0f + __expf(x)); }
DI unsigned short hsel(const u32x4& v, int c) { const unsigned w = (c >> 1) == 0 ? v.x : ((c >> 1) == 1 ? v.y : ((c >> 1) == 2 ? v.z : v.w)); return (unsigned short)((c & 1) ? (w >> 16) : (w & 0xffffu)); }
DI void mamba_unit(const Params& P, int l, int u, LAS unsigned char* lds) {
    const int dir = u & 1, h = (u >> 1) & 3, b = u >> 3, g = h >> 1;
    const int tid = tid_opaque(P.wv), lane_f = tid & 63, w = __builtin_amdgcn_readfirstlane(tid >> 6);
    LAS unsigned char* wl = lds + w * 15616;
    LAS unsigned short* xdT = (LAS unsigned short*)wl;
    LAS unsigned short* xwT = xdT + 64 * 40;
    LAS unsigned short* BT = xwT + 64 * 40;
    LAS float* dtv = (LAS float*)(wl + 15360);
    LAS float* acum = dtv + 32;
    LAS float* Atot = (LAS float*)(lds + 8 * 15616);
    unsigned char* ws = P.ws; unsigned char* dsc = (unsigned char*)P.out;
    const bf16_t* xbc = (const bf16_t*)(dsc + DO_MXBC) + (size_t)b * SEQ * 512;
    const float* dtr = (const float*)(ws + WS_DT) + (size_t)b * SEQ * 8 + dir * 4 + h;
    bf16_t* MYD = (bf16_t*)(dir ? (ws + WS_MYB) : (dsc + DO_MY)) + (size_t)b * SEQ * 256 + h * 64;
    float* stsc = (float*)(dsc + DO_MST) + (size_t)u * (8 * 4096);
    const float dtb = P.m_dt_bias[l * 8 + dir * 4 + h], Aneg = -expf(P.m_A_log[l * 8 + dir * 4 + h]);
    __syncthreads();
#define MTK(c0, j) (dir ? (c0) + 31 - (j) : (c0) + (j))
#define MCH(ci) (256 * w + 32 * (dir ? 7 - (ci) : (ci)))
#pragma unroll 1
    for (int pass = 0; pass < 2; ++pass) {
        int lane_p = lane_f; asm volatile("" : "+v"(lane_p));
        const int lane = lane_p, c32 = lane_p & 31, hh = lane_p >> 5, tg = lane_p >> 3, cg = lane_p & 7;
        f32x16 ST[2][2];
#pragma unroll
        for (int a = 0; a < 2; ++a)
#pragma unroll
            for (int q = 0; q < 2; ++q)
#pragma unroll
                for (int i = 0; i < 16; ++i) ST[a][q][i] = 0.f;
        if (pass == 1) {
            const int nv = dir ? 7 - w : w;
            for (int k = 0; k < nv; ++k) { const int v = dir ? 7 - k : k; const float dec = Atot[v];
                const f32x4* sp = (const f32x4*)(stsc + (size_t)v * 4096 + lane * 64);
#pragma unroll
                for (int a = 0; a < 2; ++a)
#pragma unroll
                    for (int q = 0; q < 2; ++q)
#pragma unroll
                        for (int i4 = 0; i4 < 4; ++i4) { const f32x4 t = sp[(a * 2 + q) * 4 + i4];
                            ST[a][q][4 * i4] = ST[a][q][4 * i4] * dec + t.x; ST[a][q][4 * i4 + 1] = ST[a][q][4 * i4 + 1] * dec + t.y; ST[a][q][4 * i4 + 2] = ST[a][q][4 * i4 + 2] * dec + t.z; ST[a][q][4 * i4 + 3] = ST[a][q][4 * i4 + 3] * dec + t.w; } }
        }
        float atot = 0.f;
        u32x4 rx[4], rB[4]; float rdt;
        { const int c0 = MCH(0);
#pragma unroll
          for (int i = 0; i < 4; ++i) { const unsigned ro = (unsigned)(MTK(c0, 4 * tg + i) * 512 + 8 * cg) * 2u; rx[i] = ldg16(xbc + h * 64, ro); rB[i] = ldg16(xbc + 256 + g * 64, ro); }
          rdt = *(const float*)((const char*)dtr + (unsigned)(MTK(c0, c32) * 32)); }
#pragma unroll 1
        for (int ci = 0; ci < 8; ++ci) {
            int lane_i = lane; asm volatile("" : "+v"(lane_i));
            const int c32 = lane_i & 31, hh = lane_i >> 5, tg = lane_i >> 3, cg = lane_i & 7;
            const int c0 = MCH(ci);
            {
                const float dt = softplus_f(rdt + dtb);
                float ac = dt * Aneg;
#pragma unroll
                for (int o = 1; o < 32; o <<= 1) { const float t = __shfl_up(ac, o, 32); if (c32 >= o) ac += t; }
                if (lane < 32) { dtv[c32] = dt; acum[c32] = ac; }
            }
            LDS_WAIT();
            const float aend = acum[31];
            {
                const f32x4 d4 = *(const LAS f32x4*)(dtv + 4 * tg), a4 = *(const LAS f32x4*)(acum + 4 * tg);
                const float dj[4] = {d4.x, d4.y, d4.z, d4.w};
                const float wj[4] = {__expf(aend - a4.x), __expf(aend - a4.y), __expf(aend - a4.z), __expf(aend - a4.w)};
#pragma unroll
                for (int c = 0; c < 8; ++c) {
                    float xd[4]; unsigned short bb[4];
#pragma unroll
                    for (int i = 0; i < 4; ++i) { xd[i] = bf2f(hsel(rx[i], c)) * dj[i]; bb[i] = hsel(rB[i], c); }
                    *(LAS u32x2*)(xdT + (8 * cg + c) * 40 + 4 * tg) = (u32x2){pk2(xd[0], xd[1]), pk2(xd[2], xd[3])};
                    *(LAS u32x2*)(xwT + (8 * cg + c) * 40 + 4 * tg) = (u32x2){pk2(xd[0] * wj[0], xd[1] * wj[1]), pk2(xd[2] * wj[2], xd[3] * wj[3])};
                    *(LAS u32x2*)(BT + (8 * cg + c) * 40 + 4 * tg) = (u32x2){(unsigned)bb[0] | ((unsigned)bb[1] << 16), (unsigned)bb[2] | ((unsigned)bb[3] << 16)};
                }
            }
            if (ci < 7) { const int c1 = MCH(ci + 1);
#pragma unroll
                for (int i = 0; i < 4; ++i) { const unsigned ro = (unsigned)(MTK(c1, 4 * tg + i) * 512 + 8 * cg) * 2u; rx[i] = ldg16(xbc + h * 64, ro); rB[i] = ldg16(xbc + 256 + g * 64, ro); }
                rdt = *(const float*)((const char*)dtr + (unsigned)(MTK(c1, c32) * 32)); }
            LDS_WAIT();
            if (pass == 1) {
                const unsigned bro = (unsigned)(MTK(c0, c32) * 512 + 8 * hh) * 2u;
                f32x16 GT;
#pragma unroll
                for (int i = 0; i < 16; ++i) GT[i] = 0.f;
#pragma unroll
                for (int ks = 0; ks < 4; ++ks) GT = MFMA32(__builtin_bit_cast(bf16x8, ldg16(xbc + 256 + g * 64 + 16 * ks, bro)), __builtin_bit_cast(bf16x8, ldg16(xbc + 384 + g * 64 + 16 * ks, bro)), GT);
                const float acl = acum[c32];
#pragma unroll
                for (int i = 0; i < 16; ++i) { const int s = crow(i, hh); GT[i] = (s <= c32) ? GT[i] * __expf(acl - acum[s]) : 0.f; }
                f32x16 Y[2];
#pragma unroll
                for (int pt = 0; pt < 2; ++pt)
#pragma unroll
                    for (int i = 0; i < 16; ++i) Y[pt][i] = 0.f;
#pragma unroll
                for (int s = 0; s < 2; ++s) { const bf16x8 pa = PACK_STEP(GT, s);
#pragma unroll
                    for (int pt = 0; pt < 2; ++pt) { const LAS unsigned short* xr = xdT + (32 * pt + c32) * 40 + 16 * s + 4 * hh;
                        Y[pt] = MFMA32(pa, cat44(*(const LAS u32x2*)xr, *(const LAS u32x2*)(xr + 8)), Y[pt]); } }
                const unsigned cro = (unsigned)(MTK(c0, c32) * 512 + 4 * hh) * 2u;
                const float el = __expf(acl);
#pragma unroll
                for (int nt = 0; nt < 2; ++nt)
#pragma unroll
                    for (int s = 0; s < 2; ++s) { const u32x2 clo = ldg8(xbc + 384 + g * 64 + 32 * nt + 16 * s, cro), chi = ldg8(xbc + 384 + g * 64 + 32 * nt + 16 * s + 8, cro);
                        const bf16x8 ca = mk8(pk2(bflo(clo.x) * el, bfhi(clo.x) * el), pk2(bflo(clo.y) * el, bfhi(clo.y) * el), pk2(bflo(chi.x) * el, bfhi(chi.x) * el), pk2(bflo(chi.y) * el, bfhi(chi.y) * el));
#pragma unroll
                        for (int pt = 0; pt < 2; ++pt) Y[pt] = MFMA32(ca, PACK_STEP(ST[nt][pt], s), Y[pt]); }
#pragma unroll
                for (int i = 0; i < 16; ++i) { const unsigned oo = (unsigned)(MTK(c0, crow(i, hh)) * 256 + c32) * 2u; stg2(MYD, oo, f2bf(Y[0][i])); stg2(MYD + 32, oo, f2bf(Y[1][i])); }
            }
            {
                const float de = __expf(aend);
#pragma unroll
                for (int nt = 0; nt < 2; ++nt)
#pragma unroll
                    for (int pt = 0; pt < 2; ++pt)
#pragma unroll
                        for (int i = 0; i < 16; ++i) ST[nt][pt][i] *= de;
#pragma unroll
                for (int s = 0; s < 2; ++s)
#pragma unroll
                    for (int nt = 0; nt < 2; ++nt) { const bf16x8 ba = *(const LAS bf16x8*)(BT + (32 * nt + c32) * 40 + 16 * s + 8 * hh);
#pragma unroll
                        for (int pt = 0; pt < 2; ++pt) ST[nt][pt] = MFMA32(ba, *(const LAS bf16x8*)(xwT + (32 * pt + c32) * 40 + 16 * s + 8 * hh), ST[nt][pt]); }
            }
            atot += aend;
            LDS_WAIT();
        }
        if (pass == 0) {
            f32x4* sp = (f32x4*)(stsc + (size_t)w * 4096 + lane * 64);
#pragma unroll
            for (int a = 0; a < 2; ++a)
#pragma unroll
                for (int q = 0; q < 2; ++q)
#pragma unroll
                    for (int i4 = 0; i4 < 4; ++i4) sp[(a * 2 + q) * 4 + i4] = (f32x4){ST[a][q][4 * i4], ST[a][q][4 * i4 + 1], ST[a][q][4 * i4 + 2], ST[a][q][4 * i4 + 3]};
            if (lane == 0) Atot[w] = __expf(atot);
            VM_WAIT(); __syncthreads();
        }
    }
#undef MTK
#undef MCH
    __syncthreads();
}

DI void hgrn_unit(const Params& P, int l, int u, LAS unsigned char* lds) {
    const int dir = u & 1, h = (u >> 1) & 3, b = u >> 3;
    const int tid = tid_opaque(P.wv), lane_f = tid & 63, w = __builtin_amdgcn_readfirstlane(tid >> 6);
    LAS unsigned char* wl = lds + w * 15104;
    LAS unsigned short* qd = (LAS unsigned short*)wl;
    LAS unsigned short* kd = qd + 32 * 72;
    LAS unsigned short* vT = kd + 32 * 72;
    LAS float* eref = (LAS float*)(wl + 14336);
    LAS float* eglr = eref + 64;
    LAS float* egl = eglr + 64;
    LAS float* lbt = (LAS float*)(lds + 8 * 15104 + 2048 + w * 512);
    LAS float* gsum = lbt + 64;
    LAS float* Atot = (LAS float*)(lds + 8 * 15104);
    unsigned char* ws = P.ws; unsigned char* dsc = (unsigned char*)P.out;
    const bf16_t* proj = (const bf16_t*)(ws + WS_PROJ) + (size_t)b * SEQ * NPROJ;
    bf16_t* OD = (dir ? (bf16_t*)(ws + WS_OB) + (size_t)b * SEQ * 256 + h * 64 : (bf16_t*)(ws + WS_HN) + (size_t)b * SEQ * DM + 768 + h * 64);
    const int ostride = dir ? 256 : DM;
    float* stsc = (float*)(dsc + DO_HST) + (size_t)u * (8 * 4096);
    __syncthreads();
    { float lb = 0.f;
      if (l == 1) { const float h0 = P.hg_lb[(0 * 2 + dir) * 256 + h * 64 + lane_f], h1 = P.hg_lb[(1 * 2 + dir) * 256 + h * 64 + lane_f]; lb = 1.0f / (1.0f + expf(h0 - h1)); }
      lbt[lane_f] = lb; }
    LDS_WAIT();
#define HTK(c0, j) (dir ? (c0) + 31 - (j) : (c0) + (j))
#define HCH(ci) (256 * w + 32 * (dir ? 7 - (ci) : (ci)))
#pragma unroll 1
    for (int pass = 0; pass < 2; ++pass) {
        int lane_p = lane_f; asm volatile("" : "+v"(lane_p));
        const int lane = lane_p, c32 = lane_p & 31, hh = lane_p >> 5, tg = lane_p >> 3, cg = lane_p & 7;
        f32x16 S[2][2];
#pragma unroll
        for (int a = 0; a < 2; ++a)
#pragma unroll
            for (int q = 0; q < 2; ++q)
#pragma unroll
                for (int i = 0; i < 16; ++i) S[a][q][i] = 0.f;
        if (pass == 1) {
            const int nv = dir ? 7 - w : w;
            for (int k = 0; k < nv; ++k) { const int v = dir ? 7 - k : k; const LAS float* at = Atot + v * 64;
                const f32x4* sp = (const f32x4*)(stsc + (size_t)v * 4096 + lane * 64);
#pragma unroll
                for (int a = 0; a < 2; ++a)
#pragma unroll
                    for (int i4 = 0; i4 < 4; ++i4) { const f32x4 dec = *(const LAS f32x4*)(at + 32 * a + 8 * i4 + 4 * hh);
#pragma unroll
                        for (int q = 0; q < 2; ++q) { const f32x4 t = sp[(a * 2 + q) * 4 + i4];
                            S[a][q][4 * i4] = S[a][q][4 * i4] * dec.x + t.x; S[a][q][4 * i4 + 1] = S[a][q][4 * i4 + 1] * dec.y + t.y; S[a][q][4 * i4 + 2] = S[a][q][4 * i4 + 2] * dec.z + t.z; S[a][q][4 * i4 + 3] = S[a][q][4 * i4 + 3] * dec.w + t.w; } } }
        }
        gsum[lane] = 1.0f;
        u32x4 rf[4], rq[4];
        { const int c0 = HCH(0);
#pragma unroll
          for (int i = 0; i < 4; ++i) { const unsigned ro = (unsigned)(HTK(c0, 4 * tg + i) * NPROJ + 8 * cg) * 2u;
              rf[i] = ldg16(proj + PC_HF + dir * 256 + h * 64, ro); rq[i] = (pass == 1) ? ldg16(proj + PC_HQ + h * 64, ro) : (u32x4){0u, 0u, 0u, 0u}; } }
#pragma unroll 1
        for (int ci = 0; ci < 8; ++ci) {
            int lane_i = lane; asm volatile("" : "+v"(lane_i));
            const int c32 = lane_i & 31, hh = lane_i >> 5, tg = lane_i >> 3, cg = lane_i & 7;
            const int c0 = HCH(ci);
            {
                float qprev[4], kprev[4];
                u32x4 rv[4];
#pragma unroll
                for (int i = 0; i < 4; ++i) { const unsigned ro = (unsigned)(HTK(c0, 4 * tg + i) * NPROJ + 8 * cg) * 2u; rv[i] = ldg16(proj + PC_HI + h * 64, ro); }
                const f32x4 lb0 = *(const LAS f32x4*)(lbt + 8 * cg), lb1 = *(const LAS f32x4*)(lbt + 8 * cg + 4);
                const float lbv[8] = {lb0.x, lb0.y, lb0.z, lb0.w, lb1.x, lb1.y, lb1.z, lb1.w};
#pragma unroll
                for (int c = 0; c < 8; ++c) {
                    const float lb = lbv[c], oml = 1.0f - lb;
                    float pl[4], kr[4];
#pragma unroll
                    for (int i = 0; i < 4; ++i) { const float fpre = bf2f(hsel(rf[i], c)); const float en = __expf(-fpre), sg = __builtin_amdgcn_rcpf(1.0f + en);
                        const float ff = lb + oml * sg; pl[i] = (i == 0) ? ff : pl[i - 1] * ff; kr[i] = oml * en * sg; }
                    float incl = pl[3];
#pragma unroll
                    for (int o = 8; o < 64; o <<= 1) { const float t = shfl_up_l(incl, o, lane); if (lane >= o) incl *= t; }
                    float excl = shfl_up_l(incl, 8, lane); if (lane < 8) excl = 1.0f;
                    const float pref = __shfl(incl, 24 + cg), plast = __shfl(incl, 56 + cg);
                    const float ipref = __builtin_amdgcn_rcpf(pref);
                    if (tg == 0) { eref[8 * cg + c] = pref; eglr[8 * cg + c] = plast * ipref; egl[8 * cg + c] = plast; gsum[8 * cg + c] *= plast; }
                    float kv[4], qv[4];
#pragma unroll
                    for (int i = 0; i < 4; ++i) { const float pj = excl * pl[i]; kv[i] = kr[i] * pref * __builtin_amdgcn_rcpf(pj);
                        if (pass == 1) { const float qr = bf2f(hsel(rq[i], c)); qv[i] = qr * __builtin_amdgcn_rcpf(1.0f + __expf(-qr)) * pj * ipref; } else qv[i] = 0.f; }
                    if (c & 1) {
#pragma unroll
                        for (int i = 0; i < 4; ++i) { *(LAS unsigned*)(kd + (4 * tg + i) * 72 + 8 * cg + c - 1) = pk2(kprev[i], kv[i]);
                            if (pass == 1) *(LAS unsigned*)(qd + (4 * tg + i) * 72 + 8 * cg + c - 1) = pk2(qprev[i], qv[i]); }
                    } else {
#pragma unroll
                        for (int i = 0; i < 4; ++i) { kprev[i] = kv[i]; qprev[i] = qv[i]; }
                    }
                }
#pragma unroll
                for (int c = 0; c < 8; ++c) { unsigned short vb[4];
#pragma unroll
                    for (int i = 0; i < 4; ++i) vb[i] = hsel(rv[i], c);
                    *(LAS u32x2*)(vT + (8 * cg + c) * 40 + 4 * tg) = (u32x2){(unsigned)vb[0] | ((unsigned)vb[1] << 16), (unsigned)vb[2] | ((unsigned)vb[3] << 16)}; }
            }
            if (ci < 7) { const int c1 = HCH(ci + 1);
#pragma unroll
                for (int i = 0; i < 4; ++i) { const unsigned ro = (unsigned)(HTK(c1, 4 * tg + i) * NPROJ + 8 * cg) * 2u;
                    rf[i] = ldg16(proj + PC_HF + dir * 256 + h * 64, ro); if (pass == 1) rq[i] = ldg16(proj + PC_HQ + h * 64, ro); } }
            LDS_WAIT(); __builtin_amdgcn_sched_barrier(0);
            bf16x8 vperm[2][2];
#pragma unroll
            for (int s = 0; s < 2; ++s)
#pragma unroll
                for (int pt = 0; pt < 2; ++pt) { const LAS unsigned short* vr = vT + (32 * pt + c32) * 40 + 16 * s + 4 * hh; vperm[s][pt] = cat44(*(const LAS u32x2*)vr, *(const LAS u32x2*)(vr + 8)); }
            if (pass == 1) {
                f32x16 SC;
#pragma unroll
                for (int i = 0; i < 16; ++i) SC[i] = 0.f;
#pragma unroll
                for (int ks = 0; ks < 4; ++ks) SC = MFMA32(*(const LAS bf16x8*)(kd + c32 * 72 + 16 * ks + 8 * hh), *(const LAS bf16x8*)(qd + c32 * 72 + 16 * ks + 8 * hh), SC);
#pragma unroll
                for (int i = 0; i < 16; ++i) SC[i] = (crow(i, hh) <= c32) ? SC[i] : 0.f;
                const bf16x8 pa0 = PACK_STEP(SC, 0), pa1 = PACK_STEP(SC, 1);
                bf16x8 qa[2][2];
#pragma unroll
                for (int et = 0; et < 2; ++et)
#pragma unroll
                    for (int s = 0; s < 2; ++s) { const LAS unsigned short* qr = qd + c32 * 72 + 32 * et + 16 * s + 4 * hh; qa[et][s] = cat44(*(const LAS u32x2*)qr, *(const LAS u32x2*)(qr + 8)); }
#pragma unroll
                for (int pt = 0; pt < 2; ++pt) {
                    f32x16 O;
#pragma unroll
                    for (int i = 0; i < 16; ++i) O[i] = 0.f;
                    O = MFMA32(pa0, vperm[0][pt], O); O = MFMA32(pa1, vperm[1][pt], O);
#pragma unroll
                    for (int et = 0; et < 2; ++et)
#pragma unroll
                        for (int s = 0; s < 2; ++s) { const f32x4 e0 = *(const LAS f32x4*)(eref + 32 * et + 16 * s + 4 * hh), e1 = *(const LAS f32x4*)(eref + 32 * et + 16 * s + 8 + 4 * hh);
                            const f32x16& sv = S[et][pt];
                            const bf16x8 sb = mk8(pk2(sv[8 * s] * e0.x, sv[8 * s + 1] * e0.y), pk2(sv[8 * s + 2] * e0.z, sv[8 * s + 3] * e0.w), pk2(sv[8 * s + 4] * e1.x, sv[8 * s + 5] * e1.y), pk2(sv[8 * s + 6] * e1.z, sv[8 * s + 7] * e1.w));
                            O = MFMA32(qa[et][s], sb, O); }
#pragma unroll
                    for (int i = 0; i < 16; ++i) { const unsigned oo = (unsigned)(HTK(c0, crow(i, hh)) * ostride + c32) * 2u; stg2(OD + 32 * pt, oo, f2bf(O[i])); }
                    __builtin_amdgcn_sched_barrier(0);
                }
            }
            __builtin_amdgcn_sched_barrier(0);
            {
#pragma unroll
                for (int et = 0; et < 2; ++et) {
                    f32x16 X;
#pragma unroll
                    for (int i = 0; i < 16; ++i) X[i] = 0.f;
#pragma unroll
                    for (int s = 0; s < 2; ++s) { unsigned idw[4];
#pragma unroll
                        for (int j = 0; j < 4; ++j) { const int k0 = 16 * s + 8 * hh + 2 * j; idw[j] = (k0 == c32 ? 0x3f80u : 0u) | (k0 + 1 == c32 ? 0x3f800000u : 0u); }
                        X = MFMA32(*(const LAS bf16x8*)(kd + c32 * 72 + 32 * et + 16 * s + 8 * hh), mk8(idw[0], idw[1], idw[2], idw[3]), X); }
                    const float sc = eglr[32 * et + c32];
#pragma unroll
                    for (int i = 0; i < 16; ++i) X[i] *= sc;
                    float dg[16];
#pragma unroll
                    for (int i = 0; i < 16; ++i) dg[i] = egl[32 * et + crow(i, hh)];
#pragma unroll
                    for (int pt = 0; pt < 2; ++pt) {
#pragma unroll
                        for (int i = 0; i < 16; ++i) S[et][pt][i] *= dg[i];
#pragma unroll
                        for (int s = 0; s < 2; ++s) S[et][pt] = MFMA32(PACK_STEP(X, s), vperm[s][pt], S[et][pt]); }
                }
            }
            LDS_WAIT();
        }
        if (pass == 0) {
            f32x4* sp = (f32x4*)(stsc + (size_t)w * 4096 + lane * 64);
#pragma unroll
            for (int a = 0; a < 2; ++a)
#pragma unroll
                for (int q = 0; q < 2; ++q)
#pragma unroll
                    for (int i4 = 0; i4 < 4; ++i4) sp[(a * 2 + q) * 4 + i4] = (f32x4){S[a][q][4 * i4], S[a][q][4 * i4 + 1], S[a][q][4 * i4 + 2], S[a][q][4 * i4 + 3]};
            LDS_WAIT(); Atot[w * 64 + lane] = gsum[lane];
            VM_WAIT(); __syncthreads();
        }
    }
#undef HTK
#undef HCH
    __syncthreads();
}

DI void phase_mixers(const Params& P, int l, LAS unsigned char* lds, int G, int bid) {
#ifndef REP_PHASE
#define REP_PHASE -1
#endif
#define MREPS(k) _Pragma("unroll 1") for (int _r = 0; _r < ((REP_PHASE == (k)) ? 2 : 1); ++_r)
    if (EN_HY) MREPS(30) for (int c = bid; c < 256; c += G) hyena_unit(P, c, lds);
    if (EN_AT) MREPS(31) { int bias_h = -1;
        if ((G & 7) == 0) { const int xcd = bid & 7, j = bid >> 3, per = G >> 3;
            for (int base = 0; base < NB * 4 * 8; base += G) { const int u = base + xcd * per + j; if (u < NB * 4 * 8) attn_unit(P, u, lds, bias_h); } }
        else for (int u = bid; u < NB * 4 * 8; u += G) attn_unit(P, u, lds, bias_h); }
    if (EN_MA) MREPS(32) for (int u = bid; u < 256; u += G) mamba_unit(P, l, u, lds);
    if (EN_HG) MREPS(33) for (int u = bid; u < 256; u += G) hgrn_unit(P, l, u, lds);
}

constexpr int N_PHASES = 21;
#if TPROBE >= 40 && TPROBE < 50
#define PCTL , (unsigned*)(ws + WS_CTL)
#else
#define PCTL
#endif
#ifndef REP_PHASE
#define REP_PHASE -1
#endif
#define REPS(k) for (int _rep = 0, _nrep = ((REP_PHASE == (k)) && ((k) != 0 && (k) != 5 || l == 0)) ? 2 : 1; _rep < _nrep; ++_rep)
__global__ void __launch_bounds__(512, 2) fwd_kernel(Params Pin) {
    Params P = Pin; P.wv = __builtin_amdgcn_readfirstlane((int)(threadIdx.x >> 6));
    extern __shared__ __attribute__((aligned(16))) unsigned char lds_raw[];
    LAS unsigned char* lds = (LAS unsigned char*)lds_raw;
    volatile LAS unsigned* MISC = (volatile LAS unsigned*)(lds + LDS_MISC);
    if (threadIdx.x < 64) MISC[threadIdx.x] = 0u;
    __syncthreads();
    unsigned char* ws = P.ws;
    const int lo = P.ph_lo, hi = P.ph_hi;
    XcdBarrier bar; bar.bar = (unsigned*)(ws + WS_CTL) + CW_BAR; bar.x = 0; bar.st = nullptr;
    if (hi - lo > 1) bar = xcd_barrier_post((unsigned*)(ws + WS_CTL) + CW_BAR, MISC + 8);
#define IN(k) (lo <= (k) && (k) < hi)
#ifndef TPSEAM
#define TPSEAM -1
#endif
#if TPROBE == 20
#define SEAM(k) do { if (IN(k) && IN((k) + 1)) { const unsigned _t0 = TP_T(); xcd_barrier(bar); if (TPSEAM < 0 || ((k) % 10) == TPSEAM) gb_wait += TP_T() - _t0; } } while (0)
#else
#define SEAM(k) do { if (IN(k) && IN((k) + 1)) xcd_barrier(bar); } while (0)
#endif
    unsigned gb_wait = 0; const unsigned gb_t0 = TPROBE == 20 ? TP_T() : 0u;
#pragma unroll 1
    for (int l = 0; l < 2; ++l) {
        int G = gridDim.x, bid = blockIdx.x; asm volatile("" : "+s"(G), "+s"(bid));
        const int p0 = 10 * l;
        if (IN(p0 + 0)) { _Pragma("unroll 1") REPS(0) phase_pre(P, l, lds); }
        SEAM(p0 + 0);
        if (IN(p0 + 1)) { _Pragma("unroll 1") REPS(1) {
            pg8::StaticOrder S; S.init(NTOK / 256, NPROJ / 256, G, bid); AddrPlain AD{DM, 0}; EpiProj E{(bf16_t*)(ws + WS_PROJ), (const float*)(ws + WS_MSQ)};
            pg8::gemm_phase(lds, (const char*)(ws + WS_XB), (const char*)(ws + WS_WIN), DM, S, AD, E, P.wv PCTL);
        } }
        SEAM(p0 + 1);
        if (IN(p0 + 2)) { _Pragma("unroll 1") REPS(2) phase_premix(P, l, lds); }
        SEAM(p0 + 2);
        if (IN(p0 + 3)) { _Pragma("unroll 1") REPS(3) phase_mixers(P, l, lds, G, bid); }
        SEAM(p0 + 3);
        if (IN(p0 + 4)) { _Pragma("unroll 1") REPS(4) phase_finalize(P, l); }
        SEAM(p0 + 4);
        if (IN(p0 + 5)) { _Pragma("unroll 1") REPS(5) {
            pg8::StaticOrder S; S.init(NTOK / 256, DM / 256, G, bid); AddrPlain AD{DM, 0}; EpiRes E{nullptr, (const bf16_t*)(ws + WS_XB), (bf16_t*)(ws + WS_XB)};
            pg8::gemm_phase(lds, (const char*)(ws + WS_HN), (const char*)(ws + WS_WOUT), DM, S, AD, E, P.wv PCTL);
        } }
        SEAM(p0 + 5);
        if (IN(p0 + 6)) { if (EN_MOE) { _Pragma("unroll 1") REPS(6) phase_ffnpre(P, l, lds); } }
        SEAM(p0 + 6);
        if (IN(p0 + 7)) { if (EN_MOE) { _Pragma("unroll 1") REPS(7) phase_topk(P, l, lds); } }
        SEAM(p0 + 7);
        if (IN(p0 + 8)) { if (EN_MOE) _Pragma("unroll 1") REPS(8) {
            pg8::StaticOrder S; S.init(NSLOT / 256, 2048 / 256, G, bid);
#if MOE_F8
            AddrGateUp8 AD{(const int*)(ws + WS_SELI)}; EpiGateUp8 E{(unsigned char*)P.out + DO_HDN, (const float*)(ws + WS_SELR)};
            pg8::gemm_phase<EpiGateUp8, pg8::StaticOrder, AddrGateUp8, true>(lds, (const char*)(ws + WS_HN), (const char*)(ws + WS_WGU), DM, S, AD, E, P.wv PCTL);
#else
            AddrGateUp AD{(const int*)(ws + WS_SELI)}; EpiGateUp E{(bf16_t*)((unsigned char*)P.out + DO_HDN), (const float*)(ws + WS_SELR)};
            pg8::gemm_phase(lds, (const char*)(ws + WS_HN), (const char*)(ws + WS_WGU), DM, S, AD, E, P.wv PCTL);
#endif
        } }
        SEAM(p0 + 8);
        if (IN(p0 + 9)) { if (EN_MOE) _Pragma("unroll 1") REPS(9) {
            pg8::StaticOrder S; S.init(NSLOT / 256, DM / 256, G, bid);
#if MOE_F8
            EpiDown E{(bf16_t*)(ws + WS_YE), (const float*)(ws + WS_SELG)};
            AddrDown8 AD{}; pg8::gemm_phase<EpiDown, pg8::StaticOrder, AddrDown8, true>(lds, (const char*)P.out + DO_HDN, (const char*)(ws + WS_WD), DM, S, AD, E, P.wv PCTL);
#else
            EpiDown E{(bf16_t*)(ws + WS_YE), (const float*)(ws + WS_SELG)};
            AddrDown AD{}; pg8::gemm_phase(lds, (const char*)P.out + DO_HDN, (const char*)(ws + WS_WD), DM, S, AD, E, P.wv PCTL);
#endif
        } }
        SEAM(p0 + 9);
    }
#ifdef PROBE_BARS
    if (hi - lo > 1) for (int i = 0; i < PROBE_BARS; ++i) xcd_barrier(bar);
#endif
    if (IN(20)) phase_final(P);
#ifndef TPOFF
#define TPOFF 0.5f
#endif
#if TPROBE == 20
    if (tid_opaque(P.wv) == 0) { atomicAdd((unsigned*)(ws + WS_CTL) + 512, gb_wait); atomicAdd((unsigned*)(ws + WS_CTL) + 513, (TP_T() - gb_t0) / 5u); }
    xcd_barrier(bar);
#endif
#if TPROBE
    __syncthreads();
    if (blockIdx.x == 0 && tid_opaque(P.wv) == 0) {
        const float a = (float)__hip_atomic_load((unsigned*)(ws + WS_CTL) + 512, __ATOMIC_RELAXED, __HIP_MEMORY_SCOPE_AGENT), t = (float)__hip_atomic_load((unsigned*)(ws + WS_CTL) + 513, __ATOMIC_RELAXED, __HIP_MEMORY_SCOPE_AGENT);
        P.out[0] = TPROBE == 99 ? 1.0e6f : (TPROBE == 20 && TPSEAM >= 0) ? (floorf(2.0f * log2f(a / t * 200.0f) + TPOFF) * 1.0e5f) : (floorf(a / t * 20.0f + TPOFF) * 1.0e5f); }
#endif
#undef IN
#undef SEAM
}

#ifndef N_LAUNCH_MODE
#define N_LAUNCH_MODE 1
#endif
extern "C" void kernel_launch(void* const* d_in, const int* in_sizes, int n_in, void* d_out, int out_size, void* d_ws, size_t ws_size, hipStream_t stream) {
    static int grid = 0;
    if (grid == 0) {
        if (n_in != 27 || in_sizes[0] != NTOK * DM || out_size != NTOK * DM || ws_size < WS_END) {
            fprintf(stderr, "kernel_launch: unexpected shapes (n_in %d, in0 %d, out %d, ws %zu, need %zu)\n", n_in, n_in > 0 ? in_sizes[0] : -1, out_size, ws_size, (size_t)WS_END); grid = -1; return; }
        int dev = 0, cus = 0, per_cu = 0;
        if (hipGetDevice(&dev) != hipSuccess || hipDeviceGetAttribute(&cus, hipDeviceAttributeMultiprocessorCount, dev) != hipSuccess) { grid = -1; return; }
        if (hipFuncSetAttribute((const void*)fwd_kernel, hipFuncAttributeMaxDynamicSharedMemorySize, LDS_BYTES) != hipSuccess) { fprintf(stderr, "kernel_launch: hipFuncSetAttribute failed\n"); grid = -1; return; }
        if (hipOccupancyMaxActiveBlocksPerMultiprocessor(&per_cu, (const void*)fwd_kernel, 512, LDS_BYTES) != hipSuccess || per_cu < 1) { fprintf(stderr, "kernel_launch: occupancy query says %d\n", per_cu); (void)hipGetLastError(); }
        grid = cus;
    }
    if (grid < 0) return;
    if (hipMemsetAsync((char*)d_ws + WS_CTL, 0, CTL_ZERO_BYTES, stream) != hipSuccess) return;
    Params p{};
    const float** pp = (const float**)&p;
    for (int i = 0; i < 27; ++i) pp[i] = (const float*)d_in[i];
    p.out = (float*)d_out; p.ws = (unsigned char*)d_ws;
    if (N_LAUNCH_MODE == 1) { p.ph_lo = 0; p.ph_hi = N_PHASES; hipLaunchKernelGGL(fwd_kernel, dim3(grid), dim3(512), LDS_BYTES, stream, p); }
    else for (int k = 0; k < N_PHASES; ++k) { p.ph_lo = k; p.ph_hi = k + 1; hipLaunchKernelGGL(fwd_kernel, dim3(grid), dim3(512), LDS_BYTES, stream, p); }
}
```

```cpp
#define N_LAUNCH_MODE 1
#include <hip/hip_runtime.h>
#include <cstdio>
#include <cstdint>

#define LAS __attribute__((address_space(3)))
#define DI __device__ __forceinline__
typedef unsigned short bf16_t;
typedef short bf16x8 __attribute__((ext_vector_type(8)));
typedef short s16x4 __attribute__((ext_vector_type(4)));
typedef float f32x2 __attribute__((ext_vector_type(2)));
typedef float f32x4 __attribute__((ext_vector_type(4)));
typedef float f32x16 __attribute__((ext_vector_type(16)));
typedef unsigned u32x2 __attribute__((ext_vector_type(2)));
typedef unsigned u32x4 __attribute__((ext_vector_type(4)));
typedef int i32x4 __attribute__((ext_vector_type(4)));
typedef __bf16 bfv2 __attribute__((ext_vector_type(2)));

DI unsigned pk2(float lo, float hi) { f32x2 v = {lo, hi}; return __builtin_bit_cast(unsigned, __builtin_convertvector(v, bfv2)); }
DI unsigned short f2bf(float f) { return (unsigned short)(pk2(f, 0.f) & 0xffffu); }
DI float bf2f(unsigned short b) { return __uint_as_float((unsigned)b << 16); }
DI float bflo(unsigned u) { return __uint_as_float(u << 16); }
DI float bfhi(unsigned u) { return __uint_as_float(u & 0xffff0000u); }
DI unsigned pk4_fp8(float a, float b, float c, float d) {
    a = __builtin_amdgcn_fmed3f(a, -440.f, 440.f); b = __builtin_amdgcn_fmed3f(b, -440.f, 440.f); c = __builtin_amdgcn_fmed3f(c, -440.f, 440.f); d = __builtin_amdgcn_fmed3f(d, -440.f, 440.f);
    int v = 0; v = __builtin_amdgcn_cvt_pk_fp8_f32(a, b, v, false); v = __builtin_amdgcn_cvt_pk_fp8_f32(c, d, v, true); return (unsigned)v; }
DI int lane_now() { int ln; asm volatile("v_mbcnt_lo_u32_b32 %0, -1, 0\n\tv_mbcnt_hi_u32_b32 %0, -1, %0" : "=v"(ln)); return ln; }
template <class T> DI T bperm_(int idx4, T v) { return __builtin_bit_cast(T, __builtin_amdgcn_ds_bpermute(idx4, __builtin_bit_cast(int, v))); }
template <class T> DI T shfl_xor_l(T v, int m, int self) { return bperm_(((self ^ m) & 63) << 2, v); }
template <class T> DI T shfl_up_l(T v, int o, int self, int width = 64) { int idx = self - o; if (idx < (self & ~(width - 1))) idx = self; return bperm_(idx << 2, v); }
template <class T> DI T shfl_xor_(T v, int m) { return shfl_xor_l(v, m, lane_now()); }
template <class T> DI T shfl_up_(T v, int o, int width = 64) { return shfl_up_l(v, o, lane_now(), width); }
template <class T> DI T shfl_(T v, int src) { return bperm_((src & 63) << 2, v); }
#ifndef HIP_SHFL
#define __shfl_xor shfl_xor_
#define __shfl_up shfl_up_
#define __shfl shfl_
#endif
DI float xhalf_max(float x) { const auto r = __builtin_amdgcn_permlane32_swap(__float_as_uint(x), __float_as_uint(x), false, false); return fmaxf(__uint_as_float(r[0]), __uint_as_float(r[1])); }
DI float xhalf_sum(float x) { const auto r = __builtin_amdgcn_permlane32_swap(__float_as_uint(x), __float_as_uint(x), false, false); return __uint_as_float(r[0]) + __uint_as_float(r[1]); }
template <int CTRL> DI float dpp_f(float x) { return __builtin_bit_cast(float, __builtin_amdgcn_update_dpp(0, __builtin_bit_cast(int, x), CTRL, 0xF, 0xF, true)); }
DI float x16_sum(float x) { const auto r = __builtin_amdgcn_permlane16_swap(__float_as_uint(x), __float_as_uint(x), false, false); return __uint_as_float(r[0]) + __uint_as_float(r[1]); }
DI float row_sum16(float x) { x += dpp_f<0x128>(x); x += dpp_f<0x124>(x); x += dpp_f<0x122>(x); x += dpp_f<0x121>(x); return x; }
DI float grp_sum8(float x) { x += dpp_f<0xB1>(x); x += dpp_f<0x4E>(x); x += dpp_f<0x141>(x); return x; }
DI float grp_max16(float x) { x = fmaxf(x, dpp_f<0xB1>(x)); x = fmaxf(x, dpp_f<0x4E>(x)); x = fmaxf(x, dpp_f<0x141>(x)); x = fmaxf(x, dpp_f<0x128>(x)); return x; }
DI float wave_sum(float v) { return xhalf_sum(x16_sum(row_sum16(v))); }
DI float silu_f(float x) { return x * __builtin_amdgcn_rcpf(1.0f + __expf(-x)); }
DI float sigmoid_f(float x) { return __builtin_amdgcn_rcpf(1.0f + __expf(-x)); }
#ifdef OLD_TID
DI int tid_opaque(int wv) { int t = wv * 64 + (int)__builtin_amdgcn_mbcnt_hi(~0u, __builtin_amdgcn_mbcnt_lo(~0u, 0u)); asm volatile("" : "+v"(t)); return t; }
#else
DI int tid_opaque(int wv) { int ln; asm volatile("v_mbcnt_lo_u32_b32 %0, -1, 0\n\tv_mbcnt_hi_u32_b32 %0, -1, %0" : "=v"(ln) :: "memory"); return wv * 64 + ln; }
#endif
DI bf16x8 mk8u(unsigned a, unsigned b, unsigned c, unsigned d) { u32x4 v = {a, b, c, d}; return __builtin_bit_cast(bf16x8, v); }
#define LDS_WAIT() asm volatile("s_waitcnt lgkmcnt(0)" ::: "memory")
#define VM_WAIT() asm volatile("s_waitcnt vmcnt(0)" ::: "memory")
#define MFMA32(a, b, c) __builtin_amdgcn_mfma_f32_32x32x16_bf16((a), (b), (c), 0, 0, 0)

constexpr int NB = 32, SEQ = 2048, DM = 1024, NTOK = NB * SEQ;
constexpr int NIN_REF = 3592, NPROJ = 3584;
constexpr int PC_HY = 0, PC_MZ = 768, PC_MX = 1024, PC_AQ = 1536, PC_AK = 1792, PC_AV = 2048, PC_HQ = 2304, PC_HF = 2560, PC_HI = 3072, PC_HG = 3328;
constexpr int NEXP = 16, CAP = 256, NSLOT = NB * NEXP * CAP;
constexpr float EPSN = 1e-6f;

constexpr size_t MiB = 1u << 20;
constexpr size_t WS_CTL = 0, CTL_ZERO_BYTES = 64 * 1024;
constexpr size_t WS_DT = 1 * MiB, WS_AFF = 3 * MiB, WS_SLOT = 7 * MiB, WS_SELI = 11 * MiB, WS_SELG = 11 * MiB + 512 * 1024, WS_KFILT = 12 * MiB, WS_MSQ = 14 * MiB, WS_RS = 15 * MiB, WS_SELR = 15 * MiB + 512 * 1024;
constexpr size_t WS_XB = 64 * MiB, WS_WIN = 320 * MiB, WS_WOUT = 327 * MiB, WS_WGU = 329 * MiB, WS_WD = 393 * MiB, WS_HN = 432 * MiB, WS_PROJ = 560 * MiB, WS_YE = WS_PROJ, WS_END = 1008 * MiB, WS_MYB = WS_WGU, WS_OB = WS_WGU + 32 * MiB;
constexpr size_t DO_HW = 0, DO_HX0 = 32 * MiB, DO_YAT = 64 * MiB, DO_MXBC = 96 * MiB, DO_MY = 160 * MiB, DO_MST = 192 * MiB, DO_HST = 224 * MiB, DO_HDN = 0;
constexpr int CW_BAR = 1024;

constexpr int LDS_MISC = 163840 - 256, LDS_BYTES = 163840;

struct Params {
    const float *x, *w_in, *w_out, *norm_mix_w, *norm_ffn_w, *hy_conv_w, *hy_w1, *hy_b1, *hy_w2, *hy_b2, *hy_freq, *hy_w3, *hy_fbias,
                *m_conv_w, *m_conv_b, *m_dt_bias, *m_A_log, *m_D, *m_norm_w, *rel_bias, *hg_lb, *hg_norm_w, *router_w, *moe_wg, *moe_wu, *moe_wd, *final_w;
    float* out; unsigned char* ws;
    int ph_lo, ph_hi, wv, pad;
};

#define XB_TMO      128
#define XB_XCNT(j)  (256  + 64 * (j))
#define XB_XSUB(j)  (1280 + 64 * (j))
#define XB_XGEN(j)  (2304 + 64 * (j))
#define XB_TOP      3328
#define XB_TOPGEN   3392
#define XCD_BAR_WORDS 3456
#define XB_SPIN_CAP (1u << 18)
__device__ __forceinline__ unsigned xb_ld(unsigned* p)              { return __hip_atomic_load(p, __ATOMIC_RELAXED, __HIP_MEMORY_SCOPE_AGENT); }
__device__ __forceinline__ unsigned xb_add(unsigned* p, unsigned v) { return __hip_atomic_fetch_add(p, v, __ATOMIC_RELAXED, __HIP_MEMORY_SCOPE_AGENT); }
__device__ __forceinline__ unsigned xb_xcc_id() { return (unsigned)__builtin_amdgcn_s_getreg((3 << 11) | 20) & 0xFu; }
#define XB_SPIN(cond, bar) do { unsigned _sp = 0; while (cond) { __builtin_amdgcn_s_sleep(1); \
    if ((++_sp & 255u) == 0u) { if (xb_ld(&(bar)[XB_TMO])) break; if (_sp > XB_SPIN_CAP) { atomicAdd(&(bar)[XB_TMO], 1u); break; } } } } while (0)
struct XcdBarrier { unsigned* bar; unsigned x; volatile LAS unsigned* st; };
__device__ __forceinline__ XcdBarrier xcd_barrier_post(unsigned* bar, volatile LAS unsigned* st) {
    XcdBarrier b; b.bar = bar; b.x = xb_xcc_id(); b.st = st;
    if (threadIdx.x == 0) (void)xb_add(&bar[XB_XCNT(b.x)], 1u);
    return b;
}
__device__ __forceinline__ void xcd_barrier_complete(unsigned* bar, unsigned x, unsigned& nloc, unsigned& nx) {
    const unsigned G = gridDim.x * gridDim.y * gridDim.z;
    unsigned sum, cnt, mine, sp = 0u;
    for (;;) {
        sum = 0u; cnt = 0u; mine = 0u;
#pragma unroll
        for (unsigned j = 0; j < 16; ++j) { const unsigned c = xb_ld(&bar[XB_XCNT(j)]); sum += c; cnt += (c > 0u) ? 1u : 0u; mine = (j == x) ? c : mine; }
        if (sum == G) break;
        __builtin_amdgcn_s_sleep(1);
        if ((++sp & 255u) == 0u) { if (xb_ld(&bar[XB_TMO])) break; if (sp > XB_SPIN_CAP) { atomicAdd(&bar[XB_TMO], 1u); break; } }
    }
    nloc = mine > 0u ? mine : 1u; nx = cnt > 0u ? cnt : 1u;
}
__device__ __forceinline__ void xcd_barrier(const XcdBarrier& b) {
    asm volatile("s_waitcnt vmcnt(0)" ::: "memory");
    __syncthreads();
    if (threadIdx.x == 0) {
        unsigned* bar = b.bar; asm volatile("" : "+s"(bar));
        __builtin_amdgcn_s_waitcnt(0);
        unsigned nloc = b.st[0], nx = b.st[1];
        if (nloc == 0u) { xcd_barrier_complete(bar, b.x, nloc, nx); b.st[0] = nloc; b.st[1] = nx; }
        const unsigned old = xb_add(&bar[XB_XSUB(b.x)], 1u);
        const unsigned gen = old / nloc;
        if (old + 1u == (gen + 1u) * nloc) {
            __builtin_amdgcn_fence(__ATOMIC_RELEASE, "agent");
            asm volatile("s_waitcnt vmcnt(0)" ::: "memory");
            const unsigned og = xb_add(&bar[XB_TOP], 1u);
            const unsigned tg = og / nx;
            if (og + 1u == (tg + 1u) * nx) xb_add(&bar[XB_TOPGEN], 1u);
            else XB_SPIN(xb_ld(&bar[XB_TOPGEN]) == tg, bar);
            __builtin_amdgcn_fence(__ATOMIC_ACQUIRE, "agent");
            xb_add(&bar[XB_XGEN(b.x)], 1u);
            asm volatile("s_waitcnt vmcnt(0)" ::: "memory");
        } else {
            XB_SPIN(xb_ld(&bar[XB_XGEN(b.x)]) == gen, bar);
            __builtin_amdgcn_fence(__ATOMIC_ACQUIRE, "agent");
            asm volatile("s_waitcnt vmcnt(0)" ::: "memory");
        }
    }
    __syncthreads();
}

namespace pg8 {
constexpr int BM = 256, BK = 64, HALF = 128, HTB = HALF * BK * 2, STAGE_BYTES = 8 * HTB, NXCD = 8, WGM = 8;
__host__ __device__ __forceinline__ int lds_byte(int r, int c) { const int st = (r >> 4) * 2 + (c >> 5), rr = r & 15, cc = c & 31, ob = rr * 64 + cc * 2; return st * 1024 + (ob ^ (((ob >> 9) & 1) << 5)); }
__host__ __device__ __forceinline__ void stage_rc(int b, int& R, int& C) { const int st = b / 1024, sb = b % 1024, swz = sb ^ (((sb >> 9) & 1) << 5); R = (st >> 1) * 16 + swz / 64; C = (st & 1) * 32 + (swz % 64) / 2; }
__host__ __device__ __forceinline__ int perm32(int rho) { const int n = rho >> 4, i = rho & 15; return 8 * (i >> 2) + 4 * n + (i & 3); }
struct Unit { int pm, pn; };
typedef int i32x8 __attribute__((ext_vector_type(8)));
typedef int i32x32 __attribute__((ext_vector_type(32)));
#define INS4(V, P, X) do { const i32x4 _x = (X); (V)[(P)] = _x.x; (V)[(P) + 1] = _x.y; (V)[(P) + 2] = _x.z; (V)[(P) + 3] = _x.w; } while (0)
#define EXT8(V, P) ((i32x8){(V)[(P)], (V)[(P) + 1], (V)[(P) + 2], (V)[(P) + 3], (V)[(P) + 4], (V)[(P) + 5], (V)[(P) + 6], (V)[(P) + 7]})
DI i32x8 cat88(bf16x8 lo, bf16x8 hi) { const i32x4 a = __builtin_bit_cast(i32x4, lo), b = __builtin_bit_cast(i32x4, hi); return (i32x8){a.x, a.y, a.z, a.w, b.x, b.y, b.z, b.w}; }
struct StaticOrder {
    int nM, nN, nwg, G, c;
    __device__ void init(int nM_, int nN_, int G_, int c_) { nM = nM_; nN = nN_; nwg = nM * nN; G = G_; c = c_; }
    __device__ bool next(int i, Unit& u) const {
        const long L = (long)i * G + c; if (L >= nwg) return false;
        int wgid = (int)L; { const int q = nwg / NXCD, r = nwg % NXCD, xcd = wgid % NXCD, off = wgid / NXCD; wgid = (xcd < r ? xcd * (q + 1) : r * (q + 1) + (xcd - r) * q) + off; }
        const int nig = WGM * nN, gid = wgid / nig, fm = gid * WGM, gsz = (nM - fm) < WGM ? (nM - fm) : WGM;
        u.pm = fm + ((wgid % nig) % gsz); u.pn = (wgid % nig) / gsz; return true;
    }
};
#ifndef TPROBE
#define TPROBE 0
#endif
#ifndef TPGEMM
#define TPGEMM 0
#endif
#define GP_T() ({ asm volatile("" ::: "memory"); unsigned _t = (unsigned)__builtin_amdgcn_s_memrealtime(); asm volatile("" ::: "memory"); _t; })
#define GP_ON(k) (TPROBE == (k) && Epi::PID == TPGEMM)
template <class Epi, class Sched, class Addr, bool F8 = false>
__device__ __forceinline__ void gemm_phase(LAS unsigned char* lds, const char* Abase, const char* Bbase, int K, const Sched& S, const Addr& AD, const Epi& E, int wv, unsigned* lds_ws_ctl = nullptr) {
    const int tid = tid_opaque(wv), wid = __builtin_amdgcn_readfirstlane(tid >> 6), lane = tid & 63, wr = wid >> 2, wc = wid & 3, fr = lane & 15, fq = lane >> 4;
    unsigned gp_acc = 0, gp_tot = 0, gp_t0 = 0, gp_t1 = 0; if (TPROBE >= 40 && TPROBE < 50 && Epi::PID == TPGEMM) gp_t0 = GP_T();
    const int KB = F8 ? K : 2 * K;
    const int nt = KB / 128;
    int Rr[2]; unsigned Cc[2], voffB[2], voffA[2];
#pragma unroll
    for (int i = 0; i < 2; ++i) { int R, C; stage_rc(tid * 16 + i * 8192, R, C); const int Rb = Epi::PERM ? ((R & ~31) + perm32(R & 31)) : R;
        Rr[i] = R; Cc[i] = (unsigned)C * 2u; voffA[i] = (unsigned)(R * KB + C * 2); voffB[i] = (unsigned)(Rb * KB + C * 2); }
    const size_t kstep = (size_t)(BK * 2);
    const size_t hstep = (size_t)HALF * KB;
    const unsigned ldsw = (unsigned)wid * 1024u;
    const int aoff = F8 ? lds_byte(wr * 64 + fr, fq * 16) : lds_byte(wr * 64 + fr, fq * 8), boff = F8 ? lds_byte(wc * 32 + fr, fq * 16) : lds_byte(wc * 32 + fr, fq * 8);
    const int aoff1 = F8 ? lds_byte(wr * 64 + fr, fq * 16 + 8) : aoff + 1024, boff1 = F8 ? lds_byte(wc * 32 + fr, fq * 16 + 8) : boff + 1024;
#define PG8_SA(b, h) (((b) * 2 + (h)) * HTB)
#define PG8_SB(b, h) ((4 + (b) * 2 + (h)) * HTB)
#define PG8_STAGE(bufoff, gbase, voff) do { _Pragma("unroll") for (int _i = 0; _i < 2; ++_i) \
        __builtin_amdgcn_global_load_lds((const unsigned*)((const char*)(gbase) + (voff)[_i]), (LAS unsigned*)(lds + (bufoff) + ldsw + _i * 8192), 16, 0, 0); } while (0)
#define PG8_STAGE_A(bufoff, kb, h, un) do { if constexpr (Addr::LOADS) { _Pragma("unroll") for (int _i = 0; _i < 2; ++_i) \
        __builtin_amdgcn_global_load_lds((const unsigned*)(Abase + (kb) + ((un) ? on[h][_i] : oc[h][_i])), (LAS unsigned*)(lds + (bufoff) + ldsw + _i * 8192), 16, 0, 0); } \
      else { const char* _ab = ((un) ? nA : cA) + (kb) + (size_t)(h) * hstep; _Pragma("unroll") for (int _i = 0; _i < 2; ++_i) \
        __builtin_amdgcn_global_load_lds((const unsigned*)(_ab + voffA[_i]), (LAS unsigned*)(lds + (bufoff) + ldsw + _i * 8192), 16, 0, 0); } } while (0)
#define PG8_BSEL_B0 0
#define PG8_BSEL_B1 16
#define PG8_LDA(dst, b, h) do { if constexpr (F8) { _Pragma("unroll") for (int m = 0; m < 4; ++m) { INS4(AA, 8 * m, *(const LAS i32x4*)(lds + PG8_SA(b, h) + aoff + m * 2048)); INS4(AA, 8 * m + 4, *(const LAS i32x4*)(lds + PG8_SA(b, h) + aoff + 16 + m * 2048)); } } \
      else { _Pragma("unroll") for (int m = 0; m < 4; ++m) _Pragma("unroll") for (int k = 0; k < 2; ++k) dst[m][k] = *(const LAS bf16x8*)(lds + PG8_SA(b, h) + (k ? aoff1 : aoff) + m * 2048); } } while (0)
#define PG8_LDB(dst, b, h) do { if constexpr (F8) { _Pragma("unroll") for (int n = 0; n < 2; ++n) { INS4(BB, PG8_BSEL_##dst + 8 * n, *(const LAS i32x4*)(lds + PG8_SB(b, h) + boff + n * 2048)); INS4(BB, PG8_BSEL_##dst + 8 * n + 4, *(const LAS i32x4*)(lds + PG8_SB(b, h) + boff + 16 + n * 2048)); } } \
      else { _Pragma("unroll") for (int n = 0; n < 2; ++n) _Pragma("unroll") for (int k = 0; k < 2; ++k) dst[n][k] = *(const LAS bf16x8*)(lds + PG8_SB(b, h) + (k ? boff1 : boff) + n * 2048); } } while (0)
#define PG8_MMA(ai, bj, At, Bt) do { __builtin_amdgcn_s_setprio(1); if constexpr (F8) { _Pragma("unroll") for (int m = 0; m < 4; ++m) _Pragma("unroll") for (int n = 0; n < 2; ++n) \
        { const i32x8 _b8 = EXT8(BB, PG8_BSEL_##Bt + 8 * n), _a8 = EXT8(AA, 8 * m); \
          asm volatile("s_nop 1\n\tv_mfma_scale_f32_16x16x128_f8f6f4 %0, %1, %2, %0, %3, %4 op_sel_hi:[0,0,0]" : "+v"(acc[ai][bj][m][n]) : "v"(_b8), "v"(_a8), "v"(scw), "v"(scx)); } } \
      else { _Pragma("unroll") for (int m = 0; m < 4; ++m) _Pragma("unroll") for (int n = 0; n < 2; ++n) _Pragma("unroll") for (int k = 0; k < 2; ++k) \
        acc[ai][bj][m][n] = __builtin_amdgcn_mfma_f32_16x16x32_bf16(Bt[n][k], At[m][k], acc[ai][bj][m][n], 0, 0, 0); } __builtin_amdgcn_s_setprio(0); } while (0)
#define PG8_WAIT_V(n) asm volatile("s_waitcnt vmcnt(" #n ")" ::: "memory")
#define PG8_WAIT_L(n) asm volatile("s_waitcnt lgkmcnt(" #n ")" ::: "memory")
#define PG8_BAR __builtin_amdgcn_s_barrier()
#define PG8_SCHED __builtin_amdgcn_sched_barrier(0)
    int scw = 0, scx = 0; if constexpr (F8) { scw = Addr::SC_W; scx = Addr::SC_X; } (void)scw; (void)scx;
    Unit cur, nxt; int ui = 0;
    if (!S.next(0, cur)) return;
#ifdef STAG_TICKS
    {
        const unsigned long long t0 = __builtin_amdgcn_s_memrealtime(); const unsigned long long dl = (unsigned long long)(((blockIdx.x >> 3) & 7) * STAG_TICKS);
        while (__builtin_amdgcn_s_memrealtime() - t0 < dl) __builtin_amdgcn_s_sleep(16);
    }
#endif
    f32x4 acc[2][2][4][2];
#pragma unroll
    for (int a = 0; a < 2; ++a)
#pragma unroll
        for (int b = 0; b < 2; ++b)
#pragma unroll
            for (int m = 0; m < 4; ++m)
#pragma unroll
                for (int n = 0; n < 2; ++n) acc[a][b][m][n] = (f32x4){0.f, 0.f, 0.f, 0.f};
    bf16x8 At[4][2], B0[2][2], B1[2][2]; i32x32 AA, BB; (void)At; (void)B0; (void)B1; (void)AA; (void)BB;
    unsigned oc[2][2], on[2][2];
    const char* cA = Abase; const char* nA = Abase;
    if constexpr (Epi::ROWTAB) {
        Unit tu;
        for (int k = 0; k < 16 && S.next(k, tu); ++k)
            for (int r = tid; r < 256; r += 512) ((LAS float*)(lds + STAGE_BYTES + 8192))[k * 256 + r] = E.rowscale(tu, r);
        if constexpr (!Addr::LOADS) __syncthreads();
    }
    if constexpr (Addr::LOADS) {
        {
            Unit tu;
            for (int k = 0; k < 16 && S.next(k, tu); ++k)
                for (int r = tid; r < 256; r += 512) ((LAS unsigned short*)(lds + STAGE_BYTES))[k * 256 + r] = AD.arow_tok(tu, r);
            __syncthreads();
        }
#pragma unroll
        for (int h = 0; h < 2; ++h)
#pragma unroll
            for (int i = 0; i < 2; ++i) { oc[h][i] = AD.arow_lds(lds + STAGE_BYTES, 0, cur, h * HALF + Rr[i]) + Cc[i]; on[h][i] = oc[h][i]; }
        PG8_WAIT_V(0);
    } else { cA = Abase + AD.arow(cur, 0); nA = cA; }
    const char* cB = Bbase + AD.boff(cur);
    PG8_STAGE(PG8_SB(0, 0), cB, voffB); PG8_STAGE_A(PG8_SA(0, 0), 0, 0, false); PG8_STAGE(PG8_SB(0, 1), cB + hstep, voffB); PG8_STAGE_A(PG8_SA(0, 1), 0, 1, false);
    if (wr == 1) PG8_BAR;
    PG8_WAIT_V(4); PG8_BAR;
    PG8_STAGE(PG8_SB(1, 0), cB + kstep, voffB); PG8_STAGE_A(PG8_SA(1, 0), kstep, 0, false); PG8_STAGE(PG8_SB(1, 1), cB + hstep + kstep, voffB);
    PG8_WAIT_V(6); PG8_BAR;
    for (;;) {
        const bool has_next = S.next(ui + 1, nxt);
        if (has_next) {
            if constexpr (Addr::LOADS) {
#pragma unroll
                for (int h = 0; h < 2; ++h)
#pragma unroll
                    for (int i = 0; i < 2; ++i) on[h][i] = AD.arow_lds(lds + STAGE_BYTES, ui + 1, nxt, h * HALF + Rr[i]) + Cc[i];
            } else nA = Abase + AD.arow(nxt, 0);
        } else nA = cA;
        const char* nB = has_next ? Bbase + AD.boff(nxt) : cB;
        if (GP_ON(41)) gp_t1 = GP_T();
#pragma unroll 1
        for (int t = 0; t < nt; t += 2) {
            if (GP_ON(43) && t == 0) gp_t1 = GP_T();
            if (GP_ON(44) && t == 2) gp_t1 = GP_T();
            const bool last = (t == nt - 2);
            const bool un = last && has_next;
            const size_t k1 = (size_t)(t + 1) * kstep;
            const size_t k2 = last ? 0 : (size_t)(t + 2) * kstep, k3 = k2 + kstep;
            const char* b2 = last ? nB : cB + (size_t)(t + 2) * kstep;
            const char* b3 = b2 + kstep;
            PG8_LDB(B0, 0, 0); PG8_SCHED; PG8_LDA(At, 0, 0); PG8_STAGE_A(PG8_SA(1, 1), k1, 1, false);
            PG8_WAIT_L(8); PG8_BAR; PG8_WAIT_L(0); PG8_MMA(0, 0, At, B0); PG8_BAR; PG8_SCHED;
            PG8_LDB(B1, 0, 1); PG8_STAGE(PG8_SB(0, 0), b2, voffB);
            PG8_BAR; PG8_WAIT_L(0); PG8_MMA(0, 1, At, B1); PG8_BAR;
            PG8_LDA(At, 0, 1); PG8_STAGE_A(PG8_SA(0, 0), k2, 0, un);
            PG8_BAR; PG8_WAIT_L(0); PG8_MMA(1, 0, At, B0); PG8_BAR; PG8_SCHED;
            PG8_STAGE(PG8_SB(0, 1), b2 + hstep, voffB);
            PG8_WAIT_V(6); PG8_BAR; PG8_MMA(1, 1, At, B1); PG8_BAR;
            PG8_LDB(B0, 1, 0); PG8_SCHED; PG8_LDA(At, 1, 0); PG8_STAGE_A(PG8_SA(0, 1), k2, 1, un);
            PG8_WAIT_L(8); PG8_BAR; PG8_WAIT_L(0); PG8_MMA(0, 0, At, B0); PG8_BAR; PG8_SCHED;
            PG8_LDB(B1, 1, 1); PG8_STAGE(PG8_SB(1, 0), b3, voffB);
            PG8_BAR; PG8_WAIT_L(0); PG8_MMA(0, 1, At, B1); PG8_BAR;
            PG8_LDA(At, 1, 1); PG8_STAGE_A(PG8_SA(1, 0), k3, 0, un);
            PG8_BAR; PG8_WAIT_L(0); PG8_MMA(1, 0, At, B0); PG8_BAR; PG8_SCHED;
            PG8_STAGE(PG8_SB(1, 1), b3 + hstep, voffB);
            PG8_WAIT_V(6); PG8_BAR; PG8_MMA(1, 1, At, B1); PG8_BAR;
            if (GP_ON(43) && t == 0) gp_acc += GP_T() - gp_t1;
            if (GP_ON(44) && t == 2) gp_acc += GP_T() - gp_t1;
        }
        if (GP_ON(41)) gp_acc += GP_T() - gp_t1;
        if (GP_ON(42)) gp_t1 = GP_T();
        if constexpr (F8) asm volatile("s_nop 15\n\ts_nop 15" ::: "memory");
        E(acc, cur, wr, wc, fr, fq, (const LAS float*)(lds + STAGE_BYTES + 8192) + ui * 256);
        if (GP_ON(42)) gp_acc += GP_T() - gp_t1;
        if (!has_next) break;
#pragma unroll
        for (int a = 0; a < 2; ++a)
#pragma unroll
            for (int b = 0; b < 2; ++b)
#pragma unroll
                for (int m = 0; m < 4; ++m)
#pragma unroll
                    for (int n = 0; n < 2; ++n) acc[a][b][m][n] = (f32x4){0.f, 0.f, 0.f, 0.f};
        cur = nxt; cB = nB; cA = nA; ++ui;
        if constexpr (Addr::LOADS) {
#pragma unroll
            for (int h = 0; h < 2; ++h)
#pragma unroll
                for (int i = 0; i < 2; ++i) oc[h][i] = on[h][i]; }
    }
    PG8_WAIT_V(0);
    if (wr == 0) PG8_BAR;
    PG8_BAR;
    if (TPROBE >= 40 && TPROBE < 50 && Epi::PID == TPGEMM && tid == 0) { gp_tot = GP_T() - gp_t0; atomicAdd((unsigned*)lds_ws_ctl + 512, gp_acc); atomicAdd((unsigned*)lds_ws_ctl + 513, gp_tot); }
#undef PG8_SA
#undef PG8_SB
#undef PG8_STAGE
#undef PG8_STAGE_A
#undef PG8_BSEL_B0
#undef PG8_BSEL_B1
#undef PG8_LDA
#undef PG8_LDB
#undef PG8_MMA
#undef PG8_WAIT_V
#undef PG8_WAIT_L
#undef PG8_BAR
#undef PG8_SCHED
}
}

#ifndef EN_HY
#define EN_HY 1
#endif
#ifndef EN_MA
#define EN_MA 1
#endif
#ifndef EN_AT
#define EN_AT 1
#endif
#ifndef EN_HG
#define EN_HG 1
#endif
#ifndef EN_MOE
#define EN_MOE 1
#endif
#ifndef MOE_F8
#define MOE_F8 1
#endif

DI void transpose_item(const float* W, int ld, int k0, int n0, bf16_t* dst, int drow0, float scale, LAS float* scr, int lane, const float* kw = nullptr) {
    {
        const int rs = lane >> 3, cq = (lane & 7) * 4;
        f32x4 v[8];
#pragma unroll
        for (int i = 0; i < 8; ++i) v[i] = __builtin_nontemporal_load((const f32x4*)(W + (size_t)(k0 + 8 * i + rs) * ld + n0 + cq));
#pragma unroll
        for (int i = 0; i < 8; ++i) { LAS float* d = scr + (8 * i + rs) * 33 + cq; d[0] = v[i].x; d[1] = v[i].y; d[2] = v[i].z; d[3] = v[i].w; }
    }
    LDS_WAIT();
    const int c = lane & 7;
    float sk[8];
#pragma unroll
    for (int i = 0; i < 8; ++i) sk[i] = kw ? scale * kw[k0 + 8 * c + i] : scale;
#pragma unroll
    for (int j = 0; j < 4; ++j) { const int n = (lane >> 3) + 8 * j; const LAS float* s = scr + (8 * c) * 33 + n;
        u32x4 o; o.x = pk2(s[0 * 33] * sk[0], s[1 * 33] * sk[1]); o.y = pk2(s[2 * 33] * sk[2], s[3 * 33] * sk[3]); o.z = pk2(s[4 * 33] * sk[4], s[5 * 33] * sk[5]); o.w = pk2(s[6 * 33] * sk[6], s[7 * 33] * sk[7]);
        *(u32x4*)(dst + (size_t)(drow0 + n) * 1024 + k0 + 8 * c) = o; }
    LDS_WAIT();
}

DI void transpose_item_f8(const float* W, int ld, int k0, int n0, unsigned char* dst, int drow0, float scale, LAS float* scr, int lane) {
    {   const int rs = lane >> 3, cq = (lane & 7) * 4;
        f32x4 v[8];
#pragma unroll
        for (int i = 0; i < 8; ++i) v[i] = __builtin_nontemporal_load((const f32x4*)(W + (size_t)(k0 + 8 * i + rs) * ld + n0 + cq));
#pragma unroll
        for (int i = 0; i < 8; ++i) { LAS float* d = scr + (8 * i + rs) * 33 + cq; d[0] = v[i].x; d[1] = v[i].y; d[2] = v[i].z; d[3] = v[i].w; }
    }
    LDS_WAIT();
    const int c = lane & 7;
#pragma unroll
    for (int j = 0; j < 4; ++j) { const int n = (lane >> 3) + 8 * j; const LAS float* s = scr + (8 * c) * 33 + n;
        u32x2 o; o.x = pk4_fp8(s[0 * 33] * scale, s[1 * 33] * scale, s[2 * 33] * scale, s[3 * 33] * scale); o.y = pk4_fp8(s[4 * 33] * scale, s[5 * 33] * scale, s[6 * 33] * scale, s[7 * 33] * scale);
        *(u32x2*)(dst + (size_t)(drow0 + n) * 1024 + k0 + 8 * c) = o; }
    LDS_WAIT();
}

#define RDL(x, i) __uint_as_float(__builtin_amdgcn_readlane(__float_as_uint(x), (i)))
DI void hyena_filter_pos(const Params& P, int l, int pos, int lane, bf16_t* kfilt) {
    const float TWO_PI = 6.283185307179586f;
    const float tpos = (float)pos * (1.0f / 2047.0f);
    float z = 0.f;
    if (lane == 0) z = tpos;
    else if (lane <= 32) { const int bnd = (lane - 1) & 15; const float f = 1e-4f + (float)bnd * ((15.0f - 1e-4f) / 15.0f);
        const float angp = TWO_PI * (float)pos / 2048.0f; const float ang = angp * f; z = (lane <= 16) ? cosf(ang) : -sinf(ang); }
    const float* w1 = P.hy_w1 + (size_t)l * 33 * 64; const float* w2 = P.hy_w2 + (size_t)l * 64 * 64; const float* w3 = P.hy_w3 + (size_t)l * 64 * 512;
    const float fr = P.hy_freq[l * 64 + lane];
    float a = P.hy_b1[l * 64 + lane];
#pragma unroll 11
    for (int i = 0; i < 33; ++i) a += RDL(z, i) * w1[i * 64 + lane];
    const float h1 = sinf(fr * a);
    float a2 = P.hy_b2[l * 64 + lane];
#pragma unroll 16
    for (int i = 0; i < 64; ++i) a2 += RDL(h1, i) * w2[i * 64 + lane];
    const float h2 = sinf(fr * a2);
    float h3[8];
#pragma unroll
    for (int k = 0; k < 8; ++k) h3[k] = 0.f;
#pragma unroll 8
    for (int i = 0; i < 64; ++i) { const float hv = RDL(h2, i);
#pragma unroll
        for (int k = 0; k < 8; ++k) h3[k] += hv * w3[i * 512 + k * 64 + lane]; }
    const float min_decay = -3.0701134573253944f, max_decay = -15.350567286626972f;
#pragma unroll
    for (int k = 0; k < 8; ++k) { const int cp = k * 64 + lane, c = cp & 255;
        const float delta = fabsf(min_decay + (float)c * ((max_decay - min_decay) / 255.0f));
        float v = h3[k] * expf(-tpos * delta);
        if (cp < 256) { if (pos == 0) { v += P.hy_fbias[l * 256 + c]; kfilt[(size_t)c * 4096 + 4095] = 0; } kfilt[(size_t)c * 4096 + 2047 - pos] = f2bf(v); }
        else if (pos >= 1) kfilt[(size_t)c * 4096 + 2047 + pos] = f2bf(v); }
}
#undef RDL

struct SelRows { int cnt; unsigned o0, o1, o2, o3; };
DI SelRows sel_compact(int sl, int b) {
    SelRows r; r.cnt = 0; r.o0 = r.o1 = r.o2 = r.o3 = 0u;
#pragma unroll
    for (int e = 0; e < 16; ++e) { const int s = __builtin_amdgcn_readlane(sl, e); const bool on = s >= 0; const unsigned v = (unsigned)((b * 16 + e) * 256 + s);
        r.o0 = (on && r.cnt == 0) ? v : r.o0; r.o1 = (on && r.cnt == 1) ? v : r.o1; r.o2 = (on && r.cnt == 2) ? v : r.o2; r.o3 = (on && r.cnt == 3) ? v : r.o3; r.cnt += on ? 1 : 0; }
    return r;
}
DI void ye_load(const bf16_t* YE, unsigned o, int lane, u32x2 (&t)[4]) { const u32x2* yr = (const u32x2*)(YE + (size_t)o * DM) + lane;
#pragma unroll
    for (int j = 0; j < 4; ++j) t[j] = yr[64 * j]; }
DI void ye_add(f32x4 (&v)[4], const u32x2 (&t)[4]) {
#pragma unroll
    for (int j = 0; j < 4; ++j) { v[j].x += bflo(t[j].x); v[j].y += bfhi(t[j].x); v[j].z += bflo(t[j].y); v[j].w += bfhi(t[j].y); } }
template <bool FINAL>
DI void pre_rows2(const Params& P, int l, const int (&m)[2], int lane, const LAS f32x4* dtw, const float* nw, const int (&slp)[2]) {
    unsigned char* ws = P.ws;
    bf16_t* XB = (bf16_t*)(ws + WS_XB);
    const bool first = (!FINAL && l == 0);
    f32x4 v[2][4];
    if (first) {
#pragma unroll
        for (int k = 0; k < 2; ++k) { const f32x4* xr = (const f32x4*)(P.x + (size_t)m[k] * DM) + lane;
#pragma unroll
            for (int j = 0; j < 4; ++j) v[k][j] = xr[64 * j]; }
    } else {
        u32x2 xh[2][4];
#pragma unroll
        for (int k = 0; k < 2; ++k) { const u32x2* xr = (const u32x2*)(XB + (size_t)m[k] * DM) + lane;
#pragma unroll
            for (int j = 0; j < 4; ++j) xh[k][j] = xr[64 * j]; }
#pragma unroll
        for (int k = 0; k < 2; ++k)
#pragma unroll
            for (int j = 0; j < 4; ++j) v[k][j] = (f32x4){bflo(xh[k][j].x), bfhi(xh[k][j].x), bflo(xh[k][j].y), bfhi(xh[k][j].y)};
    }
    if (!first && EN_MOE) {
        const bf16_t* YE = (const bf16_t*)(ws + WS_YE); const int* slot = (const int*)(ws + WS_SLOT);
        int sl[2]; SelRows sr[2]; (void)slot;
#pragma unroll
        for (int k = 0; k < 2; ++k) sl[k] = slp[k];
#pragma unroll
        for (int k = 0; k < 2; ++k) sr[k] = sel_compact(sl[k], m[k] >> 11);
        u32x2 t[2][4][4];
#pragma unroll
        for (int k = 0; k < 2; ++k) { if (sr[k].cnt > 0) ye_load(YE, sr[k].o0, lane, t[k][0]); if (sr[k].cnt > 1) ye_load(YE, sr[k].o1, lane, t[k][1]);
            if (sr[k].cnt > 2) ye_load(YE, sr[k].o2, lane, t[k][2]); if (sr[k].cnt > 3) ye_load(YE, sr[k].o3, lane, t[k][3]); }
#pragma unroll
        for (int k = 0; k < 2; ++k) { if (sr[k].cnt > 0) ye_add(v[k], t[k][0]); if (sr[k].cnt > 1) ye_add(v[k], t[k][1]); if (sr[k].cnt > 2) ye_add(v[k], t[k][2]); if (sr[k].cnt > 3) ye_add(v[k], t[k][3]);
            if (sr[k].cnt > 4) {
                int seen = 0; const int b = m[k] >> 11;
                for (int e = 0; e < 16; ++e) { const int s = __builtin_amdgcn_readlane(sl[k], e);
                    if (s >= 0) { if (seen >= 4) { u32x2 tt[4]; ye_load(YE, (unsigned)((b * 16 + e) * 256 + s), lane, tt); ye_add(v[k], tt); } ++seen; } } } }
    }
    float rr[2];
#pragma unroll
    for (int k = 0; k < 2; ++k) {
        float s = 0.f;
#pragma unroll
        for (int j = 0; j < 4; ++j) s += (v[k][j].x * v[k][j].x + v[k][j].y * v[k][j].y) + (v[k][j].z * v[k][j].z + v[k][j].w * v[k][j].w);
        rr[k] = __builtin_amdgcn_rsqf(wave_sum(s) * (1.0f / DM) + EPSN);
    }
    if (FINAL) {
#pragma unroll
        for (int k = 0; k < 2; ++k) { f32x4* o = (f32x4*)(P.out + (size_t)m[k] * DM) + lane;
#pragma unroll
            for (int j = 0; j < 4; ++j) { const f32x4 w = ((const f32x4*)nw)[64 * j + lane]; o[64 * j] = v[k][j] * rr[k] * w; } }
        return;
    }
    {
#pragma unroll
        for (int k = 0; k < 2; ++k) { u32x2* o = (u32x2*)(XB + (size_t)m[k] * DM) + lane;
#pragma unroll
            for (int j = 0; j < 4; ++j) o[64 * j] = (u32x2){pk2(v[k][j].x, v[k][j].y), pk2(v[k][j].z, v[k][j].w)}; } }
    float d[2][8];
#pragma unroll
    for (int k = 0; k < 2; ++k)
#pragma unroll
        for (int c = 0; c < 8; ++c) d[k][c] = 0.f;
#pragma unroll
    for (int j = 0; j < 4; ++j) {
#pragma unroll
        for (int q = 0; q < 4; ++q) { const f32x4 w0 = dtw[((j * 4 + q) * 2 + 0) * 64 + lane], w1 = dtw[((j * 4 + q) * 2 + 1) * 64 + lane];
#pragma unroll
            for (int k = 0; k < 2; ++k) { const float xv = q == 0 ? v[k][j].x : (q == 1 ? v[k][j].y : (q == 2 ? v[k][j].z : v[k][j].w));
                d[k][0] += xv * w0.x; d[k][1] += xv * w0.y; d[k][2] += xv * w0.z; d[k][3] += xv * w0.w; d[k][4] += xv * w1.x; d[k][5] += xv * w1.y; d[k][6] += xv * w1.z; d[k][7] += xv * w1.w; } }
    }
#pragma unroll
    for (int k = 0; k < 2; ++k) {
        float mine = 0.f;
#pragma unroll
        for (int c = 0; c < 8; ++c) { const float t2 = wave_sum(d[k][c]); mine = (lane == c) ? t2 : mine; }
        if (lane < 8) ((float*)(ws + WS_DT))[(size_t)m[k] * 8 + lane] = mine * rr[k];
        if (lane == 8) ((float*)(ws + WS_MSQ))[m[k]] = rr[k];
    }
    (void)nw;
}

DI void phase_pre(const Params& P, int l, LAS unsigned char* lds) {
    const int tid = tid_opaque(P.wv), lane = tid & 63, wave = tid >> 6;
    const int gw = blockIdx.x * 8 + wave, NGW = gridDim.x * 8;
    unsigned char* ws = P.ws;
    LAS float* dtwf = (LAS float*)lds;
    const float* win_ = P.w_in; asm volatile("" : "+s"(win_));
    for (int i = tid; i < 1024 * 8; i += 512) { const int k = i >> 3, c = i & 7; const int j = k >> 8, ln = (k & 255) >> 2, q = k & 3;
        dtwf[((((j * 4 + q) * 2 + (c >> 2)) * 64 + ln) << 2) + (c & 3)] = P.norm_mix_w[l * DM + k] * win_[((size_t)l * DM + k) * NIN_REF + 1536 + c]; }
    __syncthreads();
    if (EN_HY) for (int pos = gw; pos < SEQ; pos += NGW) hyena_filter_pos(P, l, pos, lane, (bf16_t*)(ws + WS_KFILT));
    {
        LAS float* scr = (LAS float*)(lds + 32768 + wave * 8448);
        constexpr int I_A = 16 * 48, I_B = 16 * 64, I_O = 16 * 32, I_E = 16 * 32 * 16;
        constexpr int NITEMS = I_A + I_B + I_O; (void)I_E;
        bf16_t* WinT = (bf16_t*)(ws + WS_WIN); bf16_t* WoutT = (bf16_t*)(ws + WS_WOUT); bf16_t* WguT = (bf16_t*)(ws + WS_WGU); bf16_t* WdT = (bf16_t*)(ws + WS_WD);
        for (int it = gw; it < NITEMS; it += NGW) {
            int r = it;
            if (r < I_A) { const int kb = r / 48, nb = r % 48; transpose_item(P.w_in + (size_t)l * DM * NIN_REF, NIN_REF, 64 * kb, 32 * nb, WinT, 32 * nb, 1.0f, scr, lane, P.norm_mix_w + l * DM); continue; } r -= I_A;
            if (r < I_B) { const int kb = r / 64, nb = r % 64; const int drow = 1536 + 32 * nb; transpose_item(P.w_in + (size_t)l * DM * NIN_REF, NIN_REF, 64 * kb, 1544 + 32 * nb, WinT, drow, drow < PC_AK ? 0.125f * 1.4426950408889634f : 1.0f  , scr, lane, P.norm_mix_w + l * DM); continue; } r -= I_B;
            { const int kb = r / 32, nb = r % 32; transpose_item(P.w_out + (size_t)l * DM * DM, DM, 64 * kb, 32 * nb, WoutT, 32 * nb, 1.0f, scr, lane); }
            (void)WguT; (void)WdT;
        }
    }
    const float* nw = P.norm_mix_w + l * DM;
    {
        const int* slotp = (const int*)(ws + WS_SLOT); const bool comb = (l != 0) && EN_MOE;
        int sln[2] = {0, 0};
        if (comb && gw < NTOK) { sln[0] = slotp[(size_t)gw * 16 + (lane & 15)]; sln[1] = slotp[(size_t)((gw + NGW < NTOK) ? gw + NGW : gw) * 16 + (lane & 15)]; }
        for (int m = gw; m < NTOK; m += 2 * NGW) { asm volatile("" ::: "memory"); const int mm[2] = {m, (m + NGW < NTOK) ? m + NGW : m};
            const int slc[2] = {sln[0], sln[1]}; const int mn = m + 2 * NGW;
            if (comb && mn < NTOK) { sln[0] = slotp[(size_t)mn * 16 + (lane & 15)]; sln[1] = slotp[(size_t)((mn + NGW < NTOK) ? mn + NGW : mn) * 16 + (lane & 15)]; }
            pre_rows2<false>(P, l, mm, lane, (const LAS f32x4*)dtwf, nw, slc); }
    }
}
DI void phase_final(const Params& P) {
    const int tid = tid_opaque(P.wv), lane = tid & 63, wave = tid >> 6;
    const int gw = blockIdx.x * 8 + wave, NGW = gridDim.x * 8;
    {
        const int* slotp = (const int*)(P.ws + WS_SLOT); const bool comb = EN_MOE;
        int sln[2] = {0, 0};
        if (comb && gw < NTOK) { sln[0] = slotp[(size_t)gw * 16 + (lane & 15)]; sln[1] = slotp[(size_t)((gw + NGW < NTOK) ? gw + NGW : gw) * 16 + (lane & 15)]; }
        for (int m = gw; m < NTOK; m += 2 * NGW) { const int mm[2] = {m, (m + NGW < NTOK) ? m + NGW : m};
            const int slc[2] = {sln[0], sln[1]}; const int mn = m + 2 * NGW;
            if (comb && mn < NTOK) { sln[0] = slotp[(size_t)mn * 16 + (lane & 15)]; sln[1] = slotp[(size_t)((mn + NGW < NTOK) ? mn + NGW : mn) * 16 + (lane & 15)]; }
            pre_rows2<true>(P, 1, mm, lane, nullptr, P.final_w, slc); }
    }
}

struct AddrPlain { static constexpr bool LOADS = false; int K; int nb_rows;
    DI unsigned arow(const pg8::Unit& u, int r) const { return (unsigned)(u.pm * 256 + r) * (unsigned)(K * 2); }
    DI size_t boff(const pg8::Unit& u) const { return (size_t)u.pn * 256 * K * 2; } };
DI int moe_panel(int r) { return (r & 31) * 16 + (r >> 5); }
struct AddrGateUp { static constexpr bool LOADS = true; const int* seli;
    DI unsigned arow(const pg8::Unit& u, int r) const { const int b = u.pm & 31; const int t = seli[moe_panel(u.pm) * 256 + r]; return (unsigned)(b * SEQ + t) * (unsigned)(DM * 2); }
    DI unsigned short arow_tok(const pg8::Unit& u, int r) const { return (unsigned short)seli[moe_panel(u.pm) * 256 + r]; }
    DI unsigned arow_lds(const LAS unsigned char* tab, int k, const pg8::Unit& u, int r) const { const int b = u.pm & 31; const int t = ((const LAS unsigned short*)tab)[k * 256 + r]; return (unsigned)(b * SEQ + t) * (unsigned)(DM * 2); }
    DI size_t boff(const pg8::Unit& u) const { return ((size_t)(u.pm >> 5) * 2048 + (size_t)u.pn * 256) * DM * 2; } };
struct AddrGateUp8 { static constexpr bool LOADS = true; static constexpr int SC_W = 0x79797979, SC_X = 0x7f7f7f7f; const int* seli;
    DI unsigned arow(const pg8::Unit& u, int r) const { const int b = u.pm & 31; const int t = seli[moe_panel(u.pm) * 256 + r]; return (unsigned)(b * SEQ + t) * (unsigned)DM; }
    DI unsigned short arow_tok(const pg8::Unit& u, int r) const { return (unsigned short)seli[moe_panel(u.pm) * 256 + r]; }
    DI unsigned arow_lds(const LAS unsigned char* tab, int k, const pg8::Unit& u, int r) const { const int b = u.pm & 31; const int t = ((const LAS unsigned short*)tab)[k * 256 + r]; return (unsigned)(b * SEQ + t) * (unsigned)DM; }
    DI size_t boff(const pg8::Unit& u) const { return ((size_t)(u.pm >> 5) * 2048 + (size_t)u.pn * 256) * DM; } };
struct AddrDown8 { static constexpr bool LOADS = false; static constexpr int SC_W = 0x79797979, SC_X = 0x7c7c7c7c;
    DI unsigned arow(const pg8::Unit& u, int r) const { return (unsigned)(moe_panel(u.pm) * 256 + r) * (unsigned)DM; }
    DI size_t boff(const pg8::Unit& u) const { return ((size_t)(u.pm >> 5) * 1024 + (size_t)u.pn * 256) * DM; } };
struct AddrDown { static constexpr bool LOADS = false;
    DI unsigned arow(const pg8::Unit& u, int r) const { return (unsigned)(moe_panel(u.pm) * 256 + r) * (unsigned)(DM * 2); }
    DI size_t boff(const pg8::Unit& u) const { return ((size_t)(u.pm >> 5) * 1024 + (size_t)u.pn * 256) * DM * 2; } };

struct EpiProj { static constexpr int PID = 1; static constexpr bool PERM = true, ROWTAB = true; bf16_t* O; const float* rsm;
    DI float rowscale(const pg8::Unit& u, int r) const { return rsm[u.pm * 256 + r]; }
    DI void operator()(const f32x4 (&acc)[2][2][4][2], const pg8::Unit& u, int wr, int wc, int fr, int fq, const LAS float* rtab) const {
        const int row0 = u.pm * 256 + wr * 64 + fr, col0 = u.pn * 256 + wc * 32 + 8 * fq;
#pragma unroll
        for (int ai = 0; ai < 2; ++ai)
#pragma unroll
            for (int m = 0; m < 4; ++m) { bf16_t* rowp = O + (size_t)(row0 + ai * 128 + m * 16) * NPROJ + col0; const float g = rtab[wr * 64 + fr + ai * 128 + m * 16];
#pragma unroll
                for (int bj = 0; bj < 2; ++bj) { const f32x4 v0 = acc[ai][bj][m][0] * g, v1 = acc[ai][bj][m][1] * g;
                    u32x4 w; w.x = pk2(v0[0], v0[1]); w.y = pk2(v0[2], v0[3]); w.z = pk2(v1[0], v1[1]); w.w = pk2(v1[2], v1[3]);
                    *(u32x4*)(rowp + bj * 128) = w; } }
    } };
struct EpiRes { static constexpr int PID = 5; static constexpr bool PERM = true, ROWTAB = false; const float* base32; const bf16_t* base16; bf16_t* out;
    DI void operator()(const f32x4 (&acc)[2][2][4][2], const pg8::Unit& u, int wr, int wc, int fr, int fq, const LAS float* rtab) const {
        const int row0 = u.pm * 256 + wr * 64 + fr, col0 = u.pn * 256 + wc * 32 + 8 * fq;
#pragma unroll
        for (int ai = 0; ai < 2; ++ai)
#pragma unroll
            for (int m = 0; m < 4; ++m) { const size_t off = (size_t)(row0 + ai * 128 + m * 16) * DM + col0;
#pragma unroll
                for (int bj = 0; bj < 2; ++bj) { f32x4 v0 = acc[ai][bj][m][0], v1 = acc[ai][bj][m][1];
                    if (base32) { v0 = v0 + *(const f32x4*)(base32 + off + bj * 128); v1 = v1 + *(const f32x4*)(base32 + off + bj * 128 + 4); }
                    else { const u32x4 bs = *(const u32x4*)(base16 + off + bj * 128);
                        v0 = v0 + (f32x4){bflo(bs.x), bfhi(bs.x), bflo(bs.y), bfhi(bs.y)}; v1 = v1 + (f32x4){bflo(bs.z), bfhi(bs.z), bflo(bs.w), bfhi(bs.w)}; }
                    u32x4 w; w.x = pk2(v0[0], v0[1]); w.y = pk2(v0[2], v0[3]); w.z = pk2(v1[0], v1[1]); w.w = pk2(v1[2], v1[3]);
                    *(u32x4*)(out + off + bj * 128) = w; } }
    } };
struct EpiGateUp { static constexpr int PID = 18; static constexpr bool PERM = true, ROWTAB = true; bf16_t* H; const float* selr;
    DI float rowscale(const pg8::Unit& u, int r) const { return selr[moe_panel(u.pm) * 256 + r]; }
    DI void operator()(const f32x4 (&acc)[2][2][4][2], const pg8::Unit& u, int wr, int wc, int fr, int fq, const LAS float* rtab) const {
        const int row0 = moe_panel(u.pm) * 256 + wr * 64 + fr, col0 = u.pn * 128 + wc * 32 + 8 * fq;
#pragma unroll
        for (int ai = 0; ai < 2; ++ai)
#pragma unroll
            for (int m = 0; m < 4; ++m) { bf16_t* rowp = H + (size_t)(row0 + ai * 128 + m * 16) * DM + col0; const float rr = rtab[wr * 64 + fr + ai * 128 + m * 16];
                float hv[8];
#pragma unroll
                for (int n = 0; n < 2; ++n)
#pragma unroll
                    for (int j = 0; j < 4; ++j) { const float g = acc[ai][0][m][n][j] * rr, up = acc[ai][1][m][n][j] * rr; hv[n * 4 + j] = silu_f(g) * up; }
                u32x4 w; w.x = pk2(hv[0], hv[1]); w.y = pk2(hv[2], hv[3]); w.z = pk2(hv[4], hv[5]); w.w = pk2(hv[6], hv[7]);
                *(u32x4*)rowp = w; }
    } };
struct EpiGateUp8 { static constexpr int PID = 8; static constexpr bool PERM = true, ROWTAB = true; unsigned char* H; const float* selr;
    DI float rowscale(const pg8::Unit& u, int r) const { return selr[moe_panel(u.pm) * 256 + r]; }
    DI void operator()(const f32x4 (&acc)[2][2][4][2], const pg8::Unit& u, int wr, int wc, int fr, int fq, const LAS float* rtab) const {
        const int row0 = moe_panel(u.pm) * 256 + wr * 64 + fr, col0 = u.pn * 128 + wc * 32 + 8 * fq;
#pragma unroll
        for (int ai = 0; ai < 2; ++ai)
#pragma unroll
            for (int m = 0; m < 4; ++m) { unsigned char* rowp = H + (size_t)(row0 + ai * 128 + m * 16) * DM + col0; const float rr = rtab[wr * 64 + fr + ai * 128 + m * 16]; const float c1 = -1.4426950408889634f * rr, k2 = 8.0f * rr * rr;
                float hv[8];
#pragma unroll
                for (int n = 0; n < 2; ++n)
#pragma unroll
                    for (int j = 0; j < 4; ++j) { const float g = acc[ai][0][m][n][j], up = acc[ai][1][m][n][j];
                        hv[n * 4 + j] = (g * up) * (k2 * __builtin_amdgcn_rcpf(1.0f + __builtin_amdgcn_exp2f(g * c1))); }
                *(u32x2*)rowp = (u32x2){pk4_fp8(hv[0], hv[1], hv[2], hv[3]), pk4_fp8(hv[4], hv[5], hv[6], hv[7])}; }
    } };
struct EpiDown { static constexpr int PID = 9; static constexpr bool PERM = true, ROWTAB = true; bf16_t* Y; const float* gate;
    DI float rowscale(const pg8::Unit& u, int r) const { return gate[moe_panel(u.pm) * 256 + r]; }
    DI void operator()(const f32x4 (&acc)[2][2][4][2], const pg8::Unit& u, int wr, int wc, int fr, int fq, const LAS float* rtab) const {
        const int row0 = moe_panel(u.pm) * 256 + wr * 64 + fr, col0 = u.pn * 256 + wc * 32 + 8 * fq;
#pragma unroll
        for (int ai = 0; ai < 2; ++ai)
#pragma unroll
            for (int m = 0; m < 4; ++m) { const int row = row0 + ai * 128 + m * 16; const float g = rtab[wr * 64 + fr + ai * 128 + m * 16]; bf16_t* rowp = Y + (size_t)row * DM + col0;
#pragma unroll
                for (int bj = 0; bj < 2; ++bj) { const f32x4 v0 = acc[ai][bj][m][0] * g, v1 = acc[ai][bj][m][1] * g;
                    u32x4 w; w.x = pk2(v0[0], v0[1]); w.y = pk2(v0[2], v0[3]); w.z = pk2(v1[0], v1[1]); w.w = pk2(v1[2], v1[3]);
                    *(u32x4*)(rowp + bj * 128) = w; } }
    } };

DI void phase_premix(const Params& P, int l, LAS unsigned char* lds) {
    const int tid = tid_opaque(P.wv), lane = tid & 63, wave = tid >> 6;
    const int gw = blockIdx.x * 8 + wave, NGW = gridDim.x * 8;
    unsigned char* ws = P.ws;
    const bf16_t* proj = (const bf16_t*)(ws + WS_PROJ);
    unsigned char* dsc = (unsigned char*)P.out;
    if (EN_HY) {
        bf16_t* HW = (bf16_t*)(dsc + DO_HW); bf16_t* HX0 = (bf16_t*)(dsc + DO_HX0);
        const float* cw = P.hy_conv_w + (size_t)l * 3 * 768;
        LAS unsigned char* tl = lds + wave * 15616;
        const int rsub = lane >> 3, cch = lane & 7;
        const int i16 = lane & 15, trq = i16 >> 2, trp = i16 & 3, g16 = lane >> 4;
        const unsigned troff = (unsigned)(trq * 144 + (16 * g16 + 4 * trp) * 2);
        u32x4 rin[5][3];
#define HYPM_LOAD(IT) do { const int ct_ = (IT) & 3, tt_ = ((IT) >> 2) & 63, b_ = (IT) >> 8; const int t0_ = tt_ * 32; \
            const bf16_t* pr_ = proj + ((size_t)b_ * SEQ) * NPROJ + ct_ * 64 + 8 * cch; \
            _Pragma("unroll") for (int i = 0; i < 5; ++i) { const int rr = rsub + 8 * i; const int t = t0_ - 1 + rr; const bool ok = (rr < 34) && (t >= 0) && (t < SEQ); \
                const bf16_t* q = pr_ + (size_t)(ok ? t : 0) * NPROJ; \
                _Pragma("unroll") for (int a = 0; a < 3; ++a) { rin[i][a] = *(const u32x4*)(q + 256 * a); if (!ok) rin[i][a] = (u32x4){0u, 0u, 0u, 0u}; } } } while (0)
        if (gw < NB * 64 * 4) HYPM_LOAD(gw);
        for (int it = gw; it < NB * 64 * 4; it += NGW) {
            const int ct = it & 3, tt = (it >> 2) & 63, b = it >> 8;
            const int c = ct * 64 + lane, t0 = tt * 32;
#pragma unroll
            for (int i = 0; i < 5; ++i) { const int rr = rsub + 8 * i;
#pragma unroll
                for (int a = 0; a < 3; ++a) if (rr < 36) *(LAS u32x4*)(tl + a * 5184 + rr * 144 + 16 * cch) = rin[i][a]; }
            if (it + NGW < NB * 64 * 4) HYPM_LOAD(it + NGW);
            float w0[3], w1[3], w2[3];
#pragma unroll
            for (int j = 0; j < 3; ++j) { w0[j] = cw[j * 768 + c]; w1[j] = cw[j * 768 + 256 + c]; w2[j] = cw[j * 768 + 512 + c]; }
            LDS_WAIT();
            float p0[4], p1[4], p2[4];
            unsigned hwv[16], hxv[16];
#pragma unroll
            for (int j = 0; j < 9; ++j) {
                const s16x4 r0 = __builtin_amdgcn_ds_read_tr16_b64_v4i16((LAS s16x4*)(tl + 0 * 5184 + troff + (4 * j) * 144));
                const s16x4 r1 = __builtin_amdgcn_ds_read_tr16_b64_v4i16((LAS s16x4*)(tl + 1 * 5184 + troff + (4 * j) * 144));
                const s16x4 r2 = __builtin_amdgcn_ds_read_tr16_b64_v4i16((LAS s16x4*)(tl + 2 * 5184 + troff + (4 * j) * 144));
                float c0[4], c1[4], c2[4];
#pragma unroll
                for (int k = 0; k < 4; ++k) { c0[k] = bf2f((unsigned short)r0[k]); c1[k] = bf2f((unsigned short)r1[k]); c2[k] = bf2f((unsigned short)r2[k]); }
                if (j > 0) {
                    float u0[4], hv[4];
#pragma unroll
                    for (int k = 0; k < 4; ++k) { const float a0 = p0[k], a1 = p1[k], a2 = p2[k];
                        const float b0 = (k < 3) ? p0[k + 1] : c0[0], b1 = (k < 3) ? p1[k + 1] : c1[0], b2 = (k < 3) ? p2[k + 1] : c2[0];
                        const float d0 = (k < 2) ? p0[k + 2] : c0[k - 2], d1 = (k < 2) ? p1[k + 2] : c1[k - 2], d2 = (k < 2) ? p2[k + 2] : c2[k - 2];
                        u0[k] = w0[0] * a0 + w0[1] * b0 + w0[2] * d0;
                        hv[k] = (w2[0] * a2 + w2[1] * b2 + w2[2] * d2) * (w1[0] * a1 + w1[1] * b1 + w1[2] * d1); }
                    hwv[2 * (j - 1)] = pk2(hv[0], hv[1]); hwv[2 * (j - 1) + 1] = pk2(hv[2], hv[3]); hxv[2 * (j - 1)] = pk2(u0[0], u0[1]); hxv[2 * (j - 1) + 1] = pk2(u0[2], u0[3]);
                }
#pragma unroll
                for (int k = 0; k < 4; ++k) { p0[k] = c0[k]; p1[k] = c1[k]; p2[k] = c2[k]; }
            }
            bf16_t* hwp = HW + ((size_t)c * NB + b) * SEQ + t0; bf16_t* hxp = HX0 + ((size_t)c * NB + b) * SEQ + t0;
#pragma unroll
            for (int k = 0; k < 4; ++k) { *(u32x4*)(hwp + 8 * k) = (u32x4){hwv[4 * k], hwv[4 * k + 1], hwv[4 * k + 2], hwv[4 * k + 3]}; *(u32x4*)(hxp + 8 * k) = (u32x4){hxv[4 * k], hxv[4 * k + 1], hxv[4 * k + 2], hxv[4 * k + 3]}; }
            LDS_WAIT();
        }
    }
    if (EN_MA) {
        bf16_t* MX = (bf16_t*)(dsc + DO_MXBC);
        const float* cw = P.m_conv_w + (size_t)l * 5 * 512; const float* cb = P.m_conv_b + (size_t)l * 512;
        const int gt = blockIdx.x * 512 + tid, NGT = gridDim.x * 512;
        for (int it = gt; it < (NTOK / 4) * 64; it += NGT) {
            const int ch = (it & 63) * 8, m0 = (it >> 6) * 4, t0 = m0 & (SEQ - 1);
            u32x4 rw[8];
#pragma unroll
            for (int j = 0; j < 8; ++j) { const int tt = t0 + j - 2; const bool ok = (tt >= 0) && (tt < SEQ);
                rw[j] = *(const u32x4*)(proj + (size_t)(ok ? m0 + j - 2 : m0) * NPROJ + PC_MX + ch); if (!ok) rw[j] = (u32x4){0u, 0u, 0u, 0u}; }
            f32x4 wa[5], wb[5];
#pragma unroll
            for (int j = 0; j < 5; ++j) { wa[j] = *(const f32x4*)(cw + j * 512 + ch); wb[j] = *(const f32x4*)(cw + j * 512 + ch + 4); }
            const f32x4 ba = *(const f32x4*)(cb + ch), bb = *(const f32x4*)(cb + ch + 4);
#pragma unroll
            for (int k = 0; k < 4; ++k) {
                float a[8] = {ba.x, ba.y, ba.z, ba.w, bb.x, bb.y, bb.z, bb.w};
#pragma unroll
                for (int j = 0; j < 5; ++j) { const u32x4 v = rw[k + j];
                    a[0] += wa[j].x * bflo(v.x); a[1] += wa[j].y * bfhi(v.x); a[2] += wa[j].z * bflo(v.y); a[3] += wa[j].w * bfhi(v.y);
                    a[4] += wb[j].x * bflo(v.z); a[5] += wb[j].y * bfhi(v.z); a[6] += wb[j].z * bflo(v.w); a[7] += wb[j].w * bfhi(v.w); }
                u32x4 o; o.x = pk2(silu_f(a[0]), silu_f(a[1])); o.y = pk2(silu_f(a[2]), silu_f(a[3])); o.z = pk2(silu_f(a[4]), silu_f(a[5])); o.w = pk2(silu_f(a[6]), silu_f(a[7]));
                *(u32x4*)(MX + (size_t)(m0 + k) * 512 + ch) = o;
            }
        }
    }
}

DI void phase_finalize(const Params& P, int l) {
    const int tid = tid_opaque(P.wv), lane = tid & 63, wave = tid >> 6;
    const int gw = blockIdx.x * 8 + wave, NGW = gridDim.x * 8;
    unsigned char* ws = P.ws; unsigned char* dsc = (unsigned char*)P.out;
    bf16_t* MIX = (bf16_t*)(ws + WS_HN);
    {
        const bf16_t* YAT = (const bf16_t*)(dsc + DO_YAT);
        for (int it = gw; it < NB * 32 * 4; it += NGW) {
            const int ct = it & 3, tt = (it >> 2) & 31, b = it >> 7;
            const int c = ct * 64 + lane, t0 = tt * 64;
            const bf16_t* src = YAT + ((size_t)c * NB + b) * SEQ + t0;
            bf16_t* dst = MIX + ((size_t)b * SEQ + t0) * DM + c;
#pragma unroll 2
            for (int t8 = 0; t8 < 64; t8 += 8) {
                u32x4 v = EN_HY ? *(const u32x4*)(src + t8) : (u32x4){0u, 0u, 0u, 0u};
                const unsigned w[4] = {v.x, v.y, v.z, v.w};
#pragma unroll
                for (int i = 0; i < 8; ++i) dst[(size_t)(t8 + i) * DM] = (bf16_t)((i & 1) ? (w[i >> 1] >> 16) : (w[i >> 1] & 0xffffu));
            }
        }
    }
    {
        const bf16_t* MYF = (const bf16_t*)(dsc + DO_MY); const bf16_t* MYB = (const bf16_t*)(ws + WS_MYB); const bf16_t* MX = (const bf16_t*)(dsc + DO_MXBC);
        const bf16_t* OB = (const bf16_t*)(ws + WS_OB); const bf16_t* proj = (const bf16_t*)(ws + WS_PROJ);
        const float* nwm = P.m_norm_w + l * 256; const float* nwh = P.hg_norm_w + l * 64;
        const int gt = blockIdx.x * 512 + tid, NGT = gridDim.x * 512;
        for (int it = gt; it < NTOK * 32; it += NGT) {
            const int ch = (it & 31) * 8, m = it >> 5;
            const u32x4 yf = *(const u32x4*)(MYF + (size_t)m * 256 + ch), yb = *(const u32x4*)(MYB + (size_t)m * 256 + ch), xv = *(const u32x4*)(MX + (size_t)m * 512 + ch), zv = *(const u32x4*)(proj + (size_t)m * NPROJ + PC_MZ + ch);
            const u32x4 of = *(const u32x4*)(MIX + (size_t)m * DM + 768 + ch), ob = *(const u32x4*)(OB + (size_t)m * 256 + ch), gv = *(const u32x4*)(proj + (size_t)m * NPROJ + PC_HG + ch);
            u32x4 o = {0u, 0u, 0u, 0u};
            if (EN_MA) {
                const float Dk = P.m_D[l * 4 + (ch >> 6)];
                const unsigned yfw[4] = {yf.x, yf.y, yf.z, yf.w}, ybw[4] = {yb.x, yb.y, yb.z, yb.w}, xw[4] = {xv.x, xv.y, xv.z, xv.w}, zw[4] = {zv.x, zv.y, zv.z, zv.w};
                float y[8]; float sq = 0.f;
#pragma unroll
                for (int j = 0; j < 4; ++j) { y[2 * j] = (bflo(yfw[j]) + bflo(ybw[j]) + Dk * bflo(xw[j])) * silu_f(bflo(zw[j])); y[2 * j + 1] = (bfhi(yfw[j]) + bfhi(ybw[j]) + Dk * bfhi(xw[j])) * silu_f(bfhi(zw[j]));
                    sq += y[2 * j] * y[2 * j] + y[2 * j + 1] * y[2 * j + 1]; }
                sq = x16_sum(row_sum16(sq));
                const float r = __builtin_amdgcn_rsqf(sq * (1.0f / 256.0f) + EPSN);
                const f32x4 wa = *(const f32x4*)(nwm + ch), wb = *(const f32x4*)(nwm + ch + 4);
                o.x = pk2(y[0] * r * wa.x, y[1] * r * wa.y); o.y = pk2(y[2] * r * wa.z, y[3] * r * wa.w); o.z = pk2(y[4] * r * wb.x, y[5] * r * wb.y); o.w = pk2(y[6] * r * wb.z, y[7] * r * wb.w);
            }
            *(u32x4*)(MIX + (size_t)m * DM + 256 + ch) = o;
            if (EN_HG) {
                const unsigned ofw[4] = {of.x, of.y, of.z, of.w}, obw[4] = {ob.x, ob.y, ob.z, ob.w}, gw4[4] = {gv.x, gv.y, gv.z, gv.w};
                float y[8]; float sq = 0.f;
#pragma unroll
                for (int j = 0; j < 4; ++j) { y[2 * j] = bflo(ofw[j]) + bflo(obw[j]); y[2 * j + 1] = bfhi(ofw[j]) + bfhi(obw[j]); sq += y[2 * j] * y[2 * j] + y[2 * j + 1] * y[2 * j + 1]; }
                sq = grp_sum8(sq);
                const float r = __builtin_amdgcn_rsqf(sq * (1.0f / 64.0f) + EPSN);
                const f32x4 wa = *(const f32x4*)(nwh + (ch & 63)), wb = *(const f32x4*)(nwh + (ch & 63) + 4);
                u32x4 oh;
                oh.x = pk2(y[0] * r * wa.x * silu_f(bflo(gw4[0])), y[1] * r * wa.y * silu_f(bfhi(gw4[0]))); oh.y = pk2(y[2] * r * wa.z * silu_f(bflo(gw4[1])), y[3] * r * wa.w * silu_f(bfhi(gw4[1])));
                oh.z = pk2(y[4] * r * wb.x * silu_f(bflo(gw4[2])), y[5] * r * wb.y * silu_f(bfhi(gw4[2]))); oh.w = pk2(y[6] * r * wb.z * silu_f(bflo(gw4[3])), y[7] * r * wb.w * silu_f(bfhi(gw4[3])));
                *(u32x4*)(MIX + (size_t)m * DM + 768 + ch) = oh;
            }
        }
    }
#if !EN_AT || !EN_HG
    {
        const int gt = blockIdx.x * 512 + tid, NGT = gridDim.x * 512;
        for (int it = gt; it < NTOK * 32; it += NGT) { const int ch = (it & 31) * 8, m = it >> 5;
            if (!EN_AT) *(u32x4*)(MIX + (size_t)m * DM + 512 + ch) = (u32x4){0u, 0u, 0u, 0u};
            if (!EN_HG) *(u32x4*)(MIX + (size_t)m * DM + 768 + ch) = (u32x4){0u, 0u, 0u, 0u}; }
    }
#endif
}

DI void phase_ffnpre(const Params& P, int l, LAS unsigned char* lds) {
    const int tid = tid_opaque(P.wv), lane = tid & 63, wave = tid >> 6, r = lane & 15, q = lane >> 4;
    const int gw = blockIdx.x * 8 + wave, NGW = gridDim.x * 8;
    unsigned char* ws = P.ws;
    LAS u32x4* Wh = (LAS u32x4*)lds;
    LAS u32x4* Wl = Wh + 32 * 64;
    for (int i = tid; i < 32 * 64; i += 512) { const int s = i >> 6, ln = i & 63, e = ln & 15, qq = ln >> 4; float wv[8]; unsigned hi[4], lo[4];
#pragma unroll
        for (int j = 0; j < 8; ++j) { const int k = 32 * s + 8 * qq + j; wv[j] = P.norm_ffn_w[l * DM + k] * P.router_w[((size_t)l * DM + k) * 16 + e]; }
#pragma unroll
        for (int j = 0; j < 4; ++j) { hi[j] = pk2(wv[2 * j], wv[2 * j + 1]); lo[j] = pk2(wv[2 * j] - bflo(hi[j]), wv[2 * j + 1] - bfhi(hi[j])); }
        Wh[i] = (u32x4){hi[0], hi[1], hi[2], hi[3]}; Wl[i] = (u32x4){lo[0], lo[1], lo[2], lo[3]}; }
    __syncthreads();
    const bf16_t* XB = (const bf16_t*)(ws + WS_XB); const float* nw = P.norm_ffn_w + l * DM + 8 * q;
    float* aff = (float*)(ws + WS_AFF); float* rs = (float*)(ws + WS_RS);
    bf16_t* XN = (bf16_t*)(ws + WS_HN);
    for (int grp = gw; grp < NTOK / 16; grp += NGW) {
        const int m0 = grp * 16;
        const bf16_t* xrow = XB + (size_t)(m0 + r) * DM + 8 * q; bf16_t* orow = XN + (size_t)(m0 + r) * DM + 8 * q; unsigned char* orow8 = (unsigned char*)XN + (size_t)(m0 + r) * DM + 8 * q; (void)orow; (void)orow8;
        f32x4 acc = {0.f, 0.f, 0.f, 0.f}; float ss = 0.f;
#pragma unroll 8
        for (int s = 0; s < 32; ++s) {
            const u32x4 xv = *(const u32x4*)(xrow + 32 * s);
            const f32x4 a = {bflo(xv.x), bfhi(xv.x), bflo(xv.y), bfhi(xv.y)}, b = {bflo(xv.z), bfhi(xv.z), bflo(xv.w), bfhi(xv.w)};
            const f32x4 wa = *(const f32x4*)(nw + 32 * s), wb = *(const f32x4*)(nw + 32 * s + 4);
            ss += (a.x * a.x + a.y * a.y) + (a.z * a.z + a.w * a.w) + (b.x * b.x + b.y * b.y) + (b.z * b.z + b.w * b.w);
            const bf16x8 ah = __builtin_bit_cast(bf16x8, xv);
            const bf16x8 wh = __builtin_bit_cast(bf16x8, Wh[s * 64 + lane]), wl = __builtin_bit_cast(bf16x8, Wl[s * 64 + lane]);
            acc = __builtin_amdgcn_mfma_f32_16x16x32_bf16(ah, wh, acc, 0, 0, 0);
            acc = __builtin_amdgcn_mfma_f32_16x16x32_bf16(ah, wl, acc, 0, 0, 0);
#if MOE_F8
            *(u32x2*)(orow8 + 32 * s) = (u32x2){pk4_fp8(a.x * wa.x, a.y * wa.y, a.z * wa.z, a.w * wa.w), pk4_fp8(b.x * wb.x, b.y * wb.y, b.z * wb.z, b.w * wb.w)};
#else
            *(u32x4*)(orow + 32 * s) = (u32x4){pk2(a.x * wa.x, a.y * wa.y), pk2(a.z * wa.z, a.w * wa.w), pk2(b.x * wb.x, b.y * wb.y), pk2(b.z * wb.z, b.w * wb.w)};
#endif
        }
        ss = xhalf_sum(x16_sum(ss));
        const float rinv = __builtin_amdgcn_rsqf(ss * (1.0f / DM) + EPSN);
        if (q == 0) rs[m0 + r] = rinv;
#pragma unroll
        for (int i = 0; i < 4; ++i) {
            const float lg = acc[i] * __shfl(rinv, 4 * q + i);
            const float mx = grp_max16(lg);
            const float ex = expf(lg - mx); const float se = row_sum16(ex);
            const int m = m0 + 4 * q + i;
            aff[((size_t)(m >> 11) * 16 + r) * SEQ + (m & (SEQ - 1))] = ex / se;
        }
    }
}

DI int wave_sum_i(int v) {
#pragma unroll
    for (int o = 1; o < 64; o <<= 1) v += __shfl_xor(v, o);
    return v;
}
DI int half_excl_scan(int c, int lane, int hw, LAS int* ws4, int* tot) {
    int inc = c;
#pragma unroll
    for (int o = 1; o < 64; o <<= 1) { const int t = __shfl_up(inc, o); if (lane >= o) inc += t; }
    if (lane == 63) ws4[hw] = inc;
    __syncthreads();
    int base = 0, total = 0;
#pragma unroll
    for (int w = 0; w < 4; ++w) { const int t = ws4[w]; base += (w < hw) ? t : 0; total += t; }
    *tot = total;
    return base + inc - c;
}
DI void phase_topk(const Params& P, int l, LAS unsigned char* lds) {
    const int tid = tid_opaque(P.wv), lane = tid & 63, wave = tid >> 6;
    unsigned char* ws = P.ws;
    const float* aff = (const float*)(ws + WS_AFF); const float* rs = (const float*)(ws + WS_RS);
    int* slot = (int*)(ws + WS_SLOT); int* seli = (int*)(ws + WS_SELI); float* selg = (float*)(ws + WS_SELG); float* selr = (float*)(ws + WS_SELR);
    const int half = wave >> 2, hw = wave & 3, ht = tid & 255;
    LAS int* wsum = (LAS int*)lds + half * 64;
    for (int u0 = blockIdx.x; u0 < NB * NEXP; u0 += 2 * gridDim.x) {
        const int u = u0 + half * gridDim.x; const bool live = u < NB * NEXP; const int uu = live ? u : u0;
        const int b = uu >> 4, e = uu & 15;
        __syncthreads();
        const u32x4 ka = *(const u32x4*)(aff + (size_t)uu * SEQ + 8 * ht), kb = *(const u32x4*)(aff + (size_t)uu * SEQ + 8 * ht + 4);
        const unsigned kk[8] = {ka.x, ka.y, ka.z, ka.w, kb.x, kb.y, kb.z, kb.w};
        const f32x4 ra = *(const f32x4*)(rs + (size_t)b * SEQ + 8 * ht), rb = *(const f32x4*)(rs + (size_t)b * SEQ + 8 * ht + 4);
        const float rsv[8] = {ra.x, ra.y, ra.z, ra.w, rb.x, rb.y, rb.z, rb.w};
        unsigned prefix = 0u;
#pragma unroll 1
        for (int bit = 30; bit >= 0; bit -= (bit == 30 ? 1 : 2)) {
            const unsigned hi = 1u << bit, lo = (bit == 30) ? 0u : (1u << (bit - 1));
            const unsigned c1 = prefix | hi, c0 = prefix | lo, c3 = prefix | hi | lo;
            int n1 = 0, n0 = 0, n3 = 0;
#pragma unroll
            for (int j = 0; j < 8; ++j) { n1 += __builtin_popcountll(__ballot(kk[j] >= c1)); n0 += __builtin_popcountll(__ballot(kk[j] >= c0)); n3 += __builtin_popcountll(__ballot(kk[j] >= c3)); }
            const int par = (bit & 2) ? 12 : 0;
            if (lane == 0) { wsum[par + hw * 3] = n1; wsum[par + hw * 3 + 1] = n0; wsum[par + hw * 3 + 2] = n3; }
            __syncthreads();
            int t1 = 0, t0 = 0, t3 = 0;
#pragma unroll
            for (int q = 0; q < 4; ++q) { t1 += wsum[par + q * 3]; t0 += wsum[par + q * 3 + 1]; t3 += wsum[par + q * 3 + 2]; }
            if (bit == 30) { if (t1 >= CAP) prefix = c1; }
            else if (t1 >= CAP) prefix = (t3 >= CAP) ? c3 : c1;
            else if (t0 >= CAP) prefix = c0;
        }
        const unsigned thr = prefix;
        int cgt = 0, ceq = 0;
#pragma unroll
        for (int j = 0; j < 8; ++j) { cgt += (kk[j] > thr) ? 1 : 0; ceq += (kk[j] == thr) ? 1 : 0; }
        int ngt; (void)half_excl_scan(cgt, lane, hw, wsum + 32, &ngt);
        const int need = CAP - ngt;
        int neq; int eqr = half_excl_scan(ceq, lane, hw, wsum + 36, &neq);
        bool sel[8]; int cs = 0;
#pragma unroll
        for (int j = 0; j < 8; ++j) { const bool eq = kk[j] == thr; sel[j] = (kk[j] > thr) || (eq && eqr < need); eqr += eq ? 1 : 0; cs += sel[j] ? 1 : 0; }
        int nsel; int sb = half_excl_scan(cs, lane, hw, wsum + 40, &nsel);
        if (live) {
#pragma unroll
            for (int j = 0; j < 8; ++j) { const int i = 8 * ht + j;
                slot[((size_t)b * SEQ + i) * 16 + e] = sel[j] ? sb : -1;
                if (sel[j]) { seli[u * CAP + sb] = i; selg[u * CAP + sb] = __uint_as_float(kk[j]); selr[u * CAP + sb] = rsv[j]; ++sb; } }
        }
    }
    __syncthreads();
    {
        const int gw = blockIdx.x * 8 + wave, NGW = gridDim.x * 8;
        LAS float* scr = (LAS float*)(lds + 4096 + wave * 8448);
        bf16_t* WguT = (bf16_t*)(ws + WS_WGU); bf16_t* WdT = (bf16_t*)(ws + WS_WD);
        constexpr int I_E = 16 * 32 * 16;
        for (int it = gw; it < 3 * I_E; it += NGW) {
            const int which = it / I_E; const int r = it - which * I_E;
            const int e = r / 512, kb = (r % 512) / 32, nb = r % 32;
            const size_t wofs = ((size_t)l * NEXP + e) * DM * DM;
#if MOE_F8
            if (which == 0)      transpose_item_f8(P.moe_wg + wofs, DM, 64 * kb, 32 * nb, (unsigned char*)WguT, e * 2048 + ((32 * nb) >> 7) * 256 + ((32 * nb) & 127), 64.0f, scr, lane);
            else if (which == 1) transpose_item_f8(P.moe_wu + wofs, DM, 64 * kb, 32 * nb, (unsigned char*)WguT, e * 2048 + ((32 * nb) >> 7) * 256 + 128 + ((32 * nb) & 127), 64.0f, scr, lane);
            else                 transpose_item_f8(P.moe_wd + wofs, DM, 64 * kb, 32 * nb, (unsigned char*)WdT, e * 1024 + 32 * nb, 64.0f, scr, lane);
#else
            if (which == 0)      transpose_item(P.moe_wg + wofs, DM, 64 * kb, 32 * nb, WguT, e * 2048 + ((32 * nb) >> 7) * 256 + ((32 * nb) & 127), 1.0f, scr, lane);
            else if (which == 1) transpose_item(P.moe_wu + wofs, DM, 64 * kb, 32 * nb, WguT, e * 2048 + ((32 * nb) >> 7) * 256 + 128 + ((32 * nb) & 127), 1.0f, scr, lane);
            else                 transpose_item(P.moe_wd + wofs, DM, 64 * kb, 32 * nb, WdT, e * 1024 + 32 * nb, 1.0f, scr, lane);
#endif
        }
    }
}

DI bf16x8 mk8(unsigned a, unsigned b, unsigned c, unsigned d) { u32x4 v = {a, b, c, d}; return __builtin_bit_cast(bf16x8, v); }
DI bf16x8 cat44(u32x2 lo, u32x2 hi) { u32x4 v = {lo.x, lo.y, hi.x, hi.y}; return __builtin_bit_cast(bf16x8, v); }
DI u32x4 ldg16(const void* ub, unsigned off) { return *(const u32x4*)((const char*)ub + off); }
DI u32x2 ldg8(const void* ub, unsigned off) { return *(const u32x2*)((const char*)ub + off); }
DI void stg2(void* ub, unsigned off, unsigned short v) { *(unsigned short*)((char*)ub + off) = v; }
DI int crow(int reg, int hh) { return (reg & 3) + 8 * (reg >> 2) + 4 * hh; }
#define PACK_STEP(x, s) mk8(pk2((x)[8 * (s)], (x)[8 * (s) + 1]), pk2((x)[8 * (s) + 2], (x)[8 * (s) + 3]), pk2((x)[8 * (s) + 4], (x)[8 * (s) + 5]), pk2((x)[8 * (s) + 6], (x)[8 * (s) + 7]))

#ifndef TPROBE
#define TPROBE 0
#endif
#ifndef TPWAVE
#define TPWAVE 0
#endif
#define TP_T() ({ asm volatile("" ::: "memory"); unsigned _t = (unsigned)__builtin_amdgcn_s_memrealtime(); asm volatile("" ::: "memory"); _t; })
#define TP_B(k) unsigned _tp##k = 0; if (TPROBE == (k) || ((k) == 1 && TPROBE)) _tp##k = TP_T();
#define TP_E(k) if ((k) == 1 && TPROBE) ttot += TP_T() - _tp##k; else if (TPROBE == (k)) tacc += TP_T() - _tp##k;
#ifndef HYD
#define HYD 4
#endif
DI void hyena_unit(const Params& P, int c, LAS unsigned char* lds) {
    const int tid = tid_opaque(P.wv), lane = tid & 63, w = __builtin_amdgcn_readfirstlane(tid >> 6), r = lane & 31, hh = lane >> 5;
    constexpr int CPS = 8224;
    unsigned char* ws = P.ws; unsigned char* dsc = (unsigned char*)P.out;
    const bf16_t* kf = (const bf16_t*)(ws + WS_KFILT) + (size_t)c * 4096;
    unsigned tacc = 0, ttot = 0;
    TP_B(1)
    __syncthreads();
    TP_B(81)
    {
        const u32x4 a = *(const u32x4*)(kf + 8 * tid), b = (tid < 511) ? *(const u32x4*)(kf + 8 * tid + 8) : (u32x4){0u, 0u, 0u, 0u};
        const unsigned d[9] = {a.x, a.y, a.z, a.w, b.x, b.y, b.z, b.w, 0u};
#pragma unroll
        for (int p = 0; p < 8; ++p) { const int m = p >> 1; u32x4 o;
            if (p & 1) { o.x = __builtin_amdgcn_alignbit(d[m + 1], d[m], 16); o.y = __builtin_amdgcn_alignbit(d[m + 2], d[m + 1], 16); o.z = __builtin_amdgcn_alignbit(d[m + 3], d[m + 2], 16); o.w = __builtin_amdgcn_alignbit(d[m + 4], d[m + 3], 16); }
            else { o.x = d[m]; o.y = d[m + 1]; o.z = d[m + 2]; o.w = d[m + 3]; }
            *(LAS u32x4*)(lds + p * CPS + tid * 16) = o; }
    }
    __syncthreads();
    TP_E(81)
    const bf16_t* hw = (const bf16_t*)(dsc + DO_HW) + ((size_t)c * NB + r) * SEQ + 8 * hh;
    f32x16 acc[8];
#pragma unroll
    for (int i = 0; i < 8; ++i)
#pragma unroll
        for (int q = 0; q < 16; ++q) acc[i][q] = 0.f;
    const int p = 7 - (r & 7);
    const LAS unsigned char* abase = lds + p * CPS + (2047 - 256 * w - r + 8 * hh - p) * 2;
    LAS unsigned char* Bt = lds + 8 * CPS;
    const bf16_t* hws = (const bf16_t*)(dsc + DO_HW) + ((size_t)c * NB + (tid >> 4)) * SEQ + 4 * (tid & 15);
    const unsigned bwo = (unsigned)((tid >> 4) * 144 + (tid & 15) * 8), bro = (unsigned)(r * 144 + 16 * hh);
    TP_B(82)
    u32x2 bpre[HYD];
#pragma unroll
    for (int d = 0; d < HYD; ++d) bpre[d] = *(const u32x2*)(hws + 64 * d);
    *(LAS u32x2*)(Bt + bwo) = bpre[0];
    __syncthreads();
#pragma unroll 1
    for (int s8 = 0; s8 < SEQ; s8 += 64 * HYD) {
#pragma unroll
        for (int d = 0; d < HYD; ++d) { const int sb = s8 + 64 * d;
            if (sb + 64 < SEQ) *(LAS u32x2*)(Bt + ((d + 1) & 1) * 4608 + bwo) = bpre[(d + 1) % HYD];
            if (sb + 64 * HYD < SEQ) bpre[d] = *(const u32x2*)(hws + sb + 64 * HYD);
#pragma unroll
            for (int j = 0; j < 4; ++j) { const int s0 = sb + 16 * j; const bf16x8 bfr = *(const LAS bf16x8*)(Bt + (d & 1) * 4608 + bro + 32 * j);
#pragma unroll
                for (int i = 0; i < 8; ++i) { const bf16x8 afr = *(const LAS bf16x8*)(abase + (s0 - 32 * i) * 2); acc[i] = MFMA32(afr, bfr, acc[i]); }
                __builtin_amdgcn_sched_barrier(0); }
            __syncthreads(); }
    }
    TP_E(82)
    TP_B(83)
    const bf16_t* hx = (const bf16_t*)(dsc + DO_HX0) + ((size_t)c * NB + r) * SEQ;
    bf16_t* ya = (bf16_t*)(dsc + DO_YAT) + ((size_t)c * NB + r) * SEQ;
#pragma unroll
    for (int i = 0; i < 8; ++i)
#pragma unroll
        for (int g = 0; g < 4; ++g) { const int t = 256 * w + 32 * i + 8 * g + 4 * hh;
            const u32x2 xv = *(const u32x2*)(hx + t);
            u32x2 o; o.x = pk2(acc[i][4 * g] * bflo(xv.x), acc[i][4 * g + 1] * bfhi(xv.x)); o.y = pk2(acc[i][4 * g + 2] * bflo(xv.y), acc[i][4 * g + 3] * bfhi(xv.y));
            *(u32x2*)(ya + t) = o; }
    TP_E(83)
    TP_E(1)
    if (TPROBE >= 80 && TPROBE < 90 && lane == 0 && w == (TPWAVE)) { atomicAdd((unsigned*)(ws + WS_CTL) + 512, tacc); atomicAdd((unsigned*)(ws + WS_CTL) + 513, ttot); }
}

DI int t5_bucket(int rel) {
    const int ret = rel > 0 ? 16 : 0; const int n = rel < 0 ? -rel : rel;
    if (n < 8) return ret + n;
    const float nf = (float)n;
    int large = 8 + (int)(logf(nf / 8.0f) / 4.852030263919617f * 8.0f);
    large = large < 15 ? large : 15;
    return ret + large;
}
#ifndef ATT_FAST
#define ATT_FAST 0
#endif
struct AttPass { int d, rho, uq0, nq; };
DI AttPass att_pass(int pp, int Q0, int w) {
    AttPass a;
    if (pp == 0) { a.d = 1; a.rho = 0; a.uq0 = Q0 + 32 * w; a.nq = 32; }
    else if (pp == 1) { a.d = 4; a.rho = w & 3; a.uq0 = (Q0 >> 2) + 32 * (w >> 2); a.nq = 32; }
    else { a.d = 16; a.rho = 2 * w + (pp - 2); a.uq0 = Q0 >> 4; a.nq = 16; }
    return a;
}
DI void attn_unit(const Params& P, int u, LAS unsigned char* lds, int& bias_h) {
    unsigned tacc = 0, ttot = 0;
    const int qb = u & 7, h = (u >> 3) & 3, b = u >> 5;
    const int tid = tid_opaque(P.wv), lane = tid & 63, w = __builtin_amdgcn_readfirstlane(tid >> 6), c = lane & 31, hh = lane >> 5;
    LAS float* Ost = (LAS float*)lds;
    LAS float* Mst = (LAS float*)(lds + 69632);
    LAS float* Lst = Mst + 256;
    LAS float* biasT = (LAS float*)(lds + 69632 + 2048);
    LAS unsigned char* Vr = lds + 69632 + 2048 + 12800 + w * 6144;
    unsigned char* ws = P.ws;
    TP_B(1)
    { TP_B(3) __syncthreads(); TP_E(3) }
    if (bias_h != h) {
        const float* relb = P.rel_bias; asm volatile("" : "+s"(relb));
        for (int i = tid; i < 4 * 768; i += 512) { const int s = i / 768, jx = i - 768 * s; const int pat = jx >> 8, rel = (jx & 255) - 128, dd = pat == 0 ? 1 : (pat == 1 ? 4 : 16);
            biasT[s * 784 + jx + s] = (rel >= -64 && rel <= 64) ? relb[t5_bucket(rel * dd) * 4 + h] * 1.4426950408889634f : -INFINITY; }
        __syncthreads();
        bias_h = h;
    }
    const bf16_t* pb = (const bf16_t*)(ws + WS_PROJ) + (size_t)b * SEQ * NPROJ;
    bf16_t* MIX = (bf16_t*)(ws + WS_HN);
    const int Q0 = qb * 256;
    const int i16 = lane & 15, trq = i16 >> 2, trp = i16 & 3;
    const unsigned troff = (unsigned)((4 * hh + trq) * 192 + (16 * ((lane >> 4) & 1) + 4 * trp) * 2);
    const int r8 = lane >> 3, j8 = lane & 7;
#define ATT_LOAD(KF, VR, KT, AP) do { const int nsub_ = SEQ / (AP).d, tlo_ = (AP).uq0 - 64 + 32 * (KT); \
        if (ATT_FAST && tlo_ >= 0 && tlo_ + 31 < nsub_) {                   \
            const unsigned lo_ = (unsigned)(r8 * (AP).d * NPROJ + 8 * j8) * 2u; \
            _Pragma("unroll") for (int i = 0; i < 4; ++i) { const bf16_t* b_ = pb + (size_t)(((tlo_ + 8 * i) * (AP).d + (AP).rho) * NPROJ + h * 64); \
                KF[i] = __builtin_bit_cast(bf16x8, ldg16(b_ + PC_AK, lo_)); VR[i] = ldg16(b_ + PC_AV, lo_); } \
        } else { \
            _Pragma("unroll") for (int i = 0; i < 4; ++i) { const int ukr_ = tlo_ + 8 * i + r8; const int ukc_ = ukr_ < 0 ? 0 : (ukr_ >= nsub_ ? nsub_ - 1 : ukr_); \
                const unsigned ko_ = (unsigned)((ukc_ * (AP).d + (AP).rho) * NPROJ + h * 64 + 8 * j8) * 2u; \
                KF[i] = __builtin_bit_cast(bf16x8, ldg16(pb + PC_AK, ko_)); VR[i] = ldg16(pb + PC_AV, ko_); } } } while (0)
#define ATT_TILE(KF, VR, KT, NEXTLOAD) do { const int kt = (KT); \
        bf16x8 kq_[4]; \
        f32x16 st;                                                          \
        _Pragma("unroll") for (int g = 0; g < 4; ++g) { const f32x4 bv_ = *(const LAS f32x4*)(tb4 + 32 * kt + 8 * g); st[4 * g] = bv_.x; st[4 * g + 1] = bv_.y; st[4 * g + 2] = bv_.z; st[4 * g + 3] = bv_.w; } \
        _Pragma("unroll") for (int i = 0; i < 4; ++i) *(LAS bf16x8*)(Vr + (8 * i + r8) * 144 + 16 * j8) = KF[i]; \
        _Pragma("unroll") for (int ks = 0; ks < 4; ++ks) kq_[ks] = *(const LAS bf16x8*)(Vr + c * 144 + 32 * ks + 16 * hh); \
        _Pragma("unroll") for (int i = 0; i < 4; ++i) *(LAS u32x4*)(Vr + (8 * i + r8) * 192 + 16 * j8) = VR[i]; \
        _Pragma("unroll") for (int ks = 0; ks < 4; ++ks) st = MFMA32(kq_[ks], qf[ks], st); \
        NEXTLOAD; \
        float tmax = -INFINITY; float lg[16]; \
        { const int tlo = uk0 + 32 * kt; \
          if (tlo >= 0 && tlo + 31 < nsub) { \
            _Pragma("unroll") for (int q = 0; q < 16; ++q) { lg[q] = st[q]; tmax = fmaxf(tmax, lg[q]); } \
          } else { \
            _Pragma("unroll") for (int q = 0; q < 16; ++q) { const int uk = tlo + crow(q, hh); lg[q] = (uk >= 0 && uk < nsub) ? st[q] : -INFINITY; tmax = fmaxf(tmax, lg[q]); } \
          } } \
        tmax = xhalf_max(tmax); \
        if (__any(tmax > mrun + 8.0f)) { const float mnew = fmaxf(mrun, tmax), alpha = __builtin_amdgcn_exp2f(mrun - mnew); lrun *= alpha; mrun = mnew; \
            _Pragma("unroll") for (int dt = 0; dt < 2; ++dt) _Pragma("unroll") for (int q = 0; q < 16; ++q) OT[dt][q] *= alpha; } \
        float psum = 0.f; \
        _Pragma("unroll") for (int q = 0; q < 16; ++q) { lg[q] = __builtin_amdgcn_exp2f(lg[q] - mrun); psum += lg[q]; } \
        lrun += xhalf_sum(psum); \
        LDS_WAIT(); \
        _Pragma("unroll") for (int s = 0; s < 2; ++s) { const bf16x8 pf = PACK_STEP(lg, s); \
            _Pragma("unroll") for (int dt = 0; dt < 2; ++dt) { \
                const s16x4 lo = __builtin_amdgcn_ds_read_tr16_b64_v4i16((LAS s16x4*)(Vr + troff + (16 * s) * 192 + 64 * dt)); \
                const s16x4 hi = __builtin_amdgcn_ds_read_tr16_b64_v4i16((LAS s16x4*)(Vr + troff + (16 * s + 8) * 192 + 64 * dt)); \
                OT[dt] = MFMA32(__builtin_shufflevector(lo, hi, 0, 1, 2, 3, 4, 5, 6, 7), pf, OT[dt]); } } \
        LDS_WAIT(); } while (0)
    bf16x8 kfA[4], kfB[4]; u32x4 vrA[4], vrB[4];
    bf16x8 qnext[4];
    { const AttPass a0 = att_pass(0, Q0, w);
      ATT_LOAD(kfA, vrA, 0, a0); ATT_LOAD(kfB, vrB, 1, a0);
      const int qpos0 = a0.uq0 + c;
#pragma unroll
      for (int ks = 0; ks < 4; ++ks) qnext[ks] = *(const bf16x8*)(pb + (size_t)qpos0 * NPROJ + PC_AQ + h * 64 + 16 * ks + 8 * hh); }
    auto pass = [&](const int pp, bf16x8 (&kf0)[4], u32x4 (&vr0)[4], bf16x8 (&kf1)[4], u32x4 (&vr1)[4]) __attribute__((always_inline)) {
        const int pat = pp < 2 ? pp : 2;
        const AttPass ap = att_pass(pp, Q0, w), an = att_pass(pp < 3 ? pp + 1 : 3, Q0, w);
        const int d = ap.d, rho = ap.rho, uq0 = ap.uq0, nq = ap.nq;
        const int uk0 = uq0 - 64, nsub = SEQ / d;
        const int cq = (c < nq) ? c : c - nq;
        const int qpos = (uq0 + cq) * d + rho, ql = qpos - Q0;
        const LAS float* tb4 = biasT + (cq & 3) * 784 + pat * 256 + (64 - cq + 4 * hh + (cq & 3));
        bf16x8 qf[4];
#pragma unroll
        for (int ks = 0; ks < 4; ++ks) qf[ks] = qnext[ks];
        if (pp < 3) {
            const int cq2 = (c < an.nq) ? c : c - an.nq; const int qpos2 = (an.uq0 + cq2) * an.d + an.rho;
#pragma unroll
            for (int ks = 0; ks < 4; ++ks) qnext[ks] = *(const bf16x8*)(pb + (size_t)qpos2 * NPROJ + PC_AQ + h * 64 + 16 * ks + 8 * hh); }
        float mrun = -1.0e30f, lrun = 0.f; f32x16 OT[2];
#pragma unroll
        for (int dt = 0; dt < 2; ++dt)
#pragma unroll
            for (int q = 0; q < 16; ++q) OT[dt][q] = 0.f;
        if (pat != 0) { mrun = Mst[ql]; lrun = Lst[ql];
#pragma unroll
            for (int dt = 0; dt < 2; ++dt)
#pragma unroll
                for (int g = 0; g < 4; ++g) { const f32x4 v = *(const LAS f32x4*)(Ost + ql * 68 + 32 * dt + 8 * g + 4 * hh);
                    OT[dt][4 * g] = v.x; OT[dt][4 * g + 1] = v.y; OT[dt][4 * g + 2] = v.z; OT[dt][4 * g + 3] = v.w; } }
        { TP_B(2)
        ATT_TILE(kf0, vr0, 0, ATT_LOAD(kf0, vr0, 2, ap)); ATT_TILE(kf1, vr1, 1, ATT_LOAD(kf1, vr1, 3, ap)); ATT_TILE(kf0, vr0, 2, ATT_LOAD(kf0, vr0, 4, ap));
        ATT_TILE(kf1, vr1, 3, if (pp < 3) { AttPass an_ = an; asm volatile("" : "+s"(an_.d), "+s"(an_.rho), "+s"(an_.uq0)); ATT_LOAD(kf1, vr1, 0, an_); });
        ATT_TILE(kf0, vr0, 4, if (pp < 3) { AttPass an_ = an; asm volatile("" : "+s"(an_.d), "+s"(an_.rho), "+s"(an_.uq0)); ATT_LOAD(kf0, vr0, 1, an_); });
        TP_E(2) }
        if (pat != 2) {
            if (hh == 0) { Mst[ql] = mrun; Lst[ql] = lrun; }
#pragma unroll
            for (int dt = 0; dt < 2; ++dt)
#pragma unroll
                for (int g = 0; g < 4; ++g) *(LAS f32x4*)(Ost + ql * 68 + 32 * dt + 8 * g + 4 * hh) = (f32x4){OT[dt][4 * g], OT[dt][4 * g + 1], OT[dt][4 * g + 2], OT[dt][4 * g + 3]};
        } else if (c < 16) {
            const float inv = __builtin_amdgcn_rcpf(lrun);
            bf16_t* orow = MIX + ((size_t)b * SEQ + qpos) * DM + 512 + h * 64;
#pragma unroll
            for (int dt = 0; dt < 2; ++dt)
#pragma unroll
                for (int g = 0; g < 4; ++g) { u32x2 o; o.x = pk2(OT[dt][4 * g] * inv, OT[dt][4 * g + 1] * inv); o.y = pk2(OT[dt][4 * g + 2] * inv, OT[dt][4 * g + 3] * inv);
                    *(u32x2*)(orow + 32 * dt + 8 * g + 4 * hh) = o; }
        }
        { TP_B(3) if (pp < 2) __syncthreads(); TP_E(3) }
    };
#pragma unroll 1
    for (int p2 = 0; p2 < 2; ++p2) { pass(2 * p2, kfA, vrA, kfB, vrB); pass(2 * p2 + 1, kfB, vrB, kfA, vrA); }
#undef ATT_LOAD
#undef ATT_TILE
    TP_E(1)
    if (TPROBE && TPROBE < 10 && (tid & 63) == 0 && w == (TPWAVE)) { atomicAdd((unsigned*)(ws + WS_CTL) + 512, tacc); atomicAdd((unsigned*)(ws + WS_CTL) + 513, ttot); }
}

DI float softplus_f(float x) { return x > 15.f ? x : __logf(1.0f + __expf(x)); }
DI unsigned short hsel(const u32x4& v, int c) { const unsigned w = (c >> 1) == 0 ? v.x : ((c >> 1) == 1 ? v.y : ((c >> 1) == 2 ? v.z : v.w)); return (unsigned short)((c & 1) ? (w >> 16) : (w & 0xffffu)); }
DI void mamba_unit(const Params& P, int l, int u, LAS unsigned char* lds) {
    const int dir = u & 1, h = (u >> 1) & 3, b = u >> 3, g = h >> 1;
    const int tid = tid_opaque(P.wv), lane_f = tid & 63, w = __builtin_amdgcn_readfirstlane(tid >> 6);
    LAS unsigned char* wl = lds + w * 15616;
    LAS unsigned short* xdT = (LAS unsigned short*)wl;
    LAS unsigned short* xwT = xdT + 64 * 40;
    LAS unsigned short* BT = xwT + 64 * 40;
    LAS float* dtv = (LAS float*)(wl + 15360);
    LAS float* acum = dtv + 32;
    LAS float* Atot = (LAS float*)(lds + 8 * 15616);
    unsigned char* ws = P.ws; unsigned char* dsc = (unsigned char*)P.out;
    const bf16_t* xbc = (const bf16_t*)(dsc + DO_MXBC) + (size_t)b * SEQ * 512;
    const float* dtr = (const float*)(ws + WS_DT) + (size_t)b * SEQ * 8 + dir * 4 + h;
    bf16_t* MYD = (bf16_t*)(dir ? (ws + WS_MYB) : (dsc + DO_MY)) + (size_t)b * SEQ * 256 + h * 64;
    float* stsc = (float*)(dsc + DO_MST) + (size_t)u * (8 * 4096);
    const float dtb = P.m_dt_bias[l * 8 + dir * 4 + h], Aneg = -expf(P.m_A_log[l * 8 + dir * 4 + h]);
    __syncthreads();
#define MTK(c0, j) (dir ? (c0) + 31 - (j) : (c0) + (j))
#define MCH(ci) (256 * w + 32 * (dir ? 7 - (ci) : (ci)))
#pragma unroll 1
    for (int pass = 0; pass < 2; ++pass) {
        int lane_p = lane_f; asm volatile("" : "+v"(lane_p));
        const int lane = lane_p, c32 = lane_p & 31, hh = lane_p >> 5, tg = lane_p >> 3, cg = lane_p & 7;
        f32x16 ST[2][2];
#pragma unroll
        for (int a = 0; a < 2; ++a)
#pragma unroll
            for (int q = 0; q < 2; ++q)
#pragma unroll
                for (int i = 0; i < 16; ++i) ST[a][q][i] = 0.f;
        if (pass == 1) {
            const int nv = dir ? 7 - w : w;
            for (int k = 0; k < nv; ++k) { const int v = dir ? 7 - k : k; const float dec = Atot[v];
                const f32x4* sp = (const f32x4*)(stsc + (size_t)v * 4096 + lane * 64);
#pragma unroll
                for (int a = 0; a < 2; ++a)
#pragma unroll
                    for (int q = 0; q < 2; ++q)
#pragma unroll
                        for (int i4 = 0; i4 < 4; ++i4) { const f32x4 t = sp[(a * 2 + q) * 4 + i4];
                            ST[a][q][4 * i4] = ST[a][q][4 * i4] * dec + t.x; ST[a][q][4 * i4 + 1] = ST[a][q][4 * i4 + 1] * dec + t.y; ST[a][q][4 * i4 + 2] = ST[a][q][4 * i4 + 2] * dec + t.z; ST[a][q][4 * i4 + 3] = ST[a][q][4 * i4 + 3] * dec + t.w; } }
        }
        float atot = 0.f;
        u32x4 rx[4], rB[4]; float rdt;
        { const int c0 = MCH(0);
#pragma unroll
          for (int i = 0; i < 4; ++i) { const unsigned ro = (unsigned)(MTK(c0, 4 * tg + i) * 512 + 8 * cg) * 2u; rx[i] = ldg16(xbc + h * 64, ro); rB[i] = ldg16(xbc + 256 + g * 64, ro); }
          rdt = *(const float*)((const char*)dtr + (unsigned)(MTK(c0, c32) * 32)); }
#pragma unroll 1
        for (int ci = 0; ci < 8; ++ci) {
            int lane_i = lane; asm volatile("" : "+v"(lane_i));
            const int c32 = lane_i & 31, hh = lane_i >> 5, tg = lane_i >> 3, cg = lane_i & 7;
            const int c0 = MCH(ci);
            {
                const float dt = softplus_f(rdt + dtb);
                float ac = dt * Aneg;
#pragma unroll
                for (int o = 1; o < 32; o <<= 1) { const float t = __shfl_up(ac, o, 32); if (c32 >= o) ac += t; }
                if (lane < 32) { dtv[c32] = dt; acum[c32] = ac; }
            }
            LDS_WAIT();
            const float aend = acum[31];
            {
                const f32x4 d4 = *(const LAS f32x4*)(dtv + 4 * tg), a4 = *(const LAS f32x4*)(acum + 4 * tg);
                const float dj[4] = {d4.x, d4.y, d4.z, d4.w};
                const float wj[4] = {__expf(aend - a4.x), __expf(aend - a4.y), __expf(aend - a4.z), __expf(aend - a4.w)};
#pragma unroll
                for (int c = 0; c < 8; ++c) {
                    float xd[4]; unsigned short bb[4];
#pragma unroll
                    for (int i = 0; i < 4; ++i) { xd[i] = bf2f(hsel(rx[i], c)) * dj[i]; bb[i] = hsel(rB[i], c); }
                    *(LAS u32x2*)(xdT + (8 * cg + c) * 40 + 4 * tg) = (u32x2){pk2(xd[0], xd[1]), pk2(xd[2], xd[3])};
                    *(LAS u32x2*)(xwT + (8 * cg + c) * 40 + 4 * tg) = (u32x2){pk2(xd[0] * wj[0], xd[1] * wj[1]), pk2(xd[2] * wj[2], xd[3] * wj[3])};
                    *(LAS u32x2*)(BT + (8 * cg + c) * 40 + 4 * tg) = (u32x2){(unsigned)bb[0] | ((unsigned)bb[1] << 16), (unsigned)bb[2] | ((unsigned)bb[3] << 16)};
                }
            }
            if (ci < 7) { const int c1 = MCH(ci + 1);
#pragma unroll
                for (int i = 0; i < 4; ++i) { const unsigned ro = (unsigned)(MTK(c1, 4 * tg + i) * 512 + 8 * cg) * 2u; rx[i] = ldg16(xbc + h * 64, ro); rB[i] = ldg16(xbc + 256 + g * 64, ro); }
                rdt = *(const float*)((const char*)dtr + (unsigned)(MTK(c1, c32) * 32)); }
            LDS_WAIT();
            if (pass == 1) {
                const unsigned bro = (unsigned)(MTK(c0, c32) * 512 + 8 * hh) * 2u;
                f32x16 GT;
#pragma unroll
                for (int i = 0; i < 16; ++i) GT[i] = 0.f;
#pragma unroll
                for (int ks = 0; ks < 4; ++ks) GT = MFMA32(__builtin_bit_cast(bf16x8, ldg16(xbc + 256 + g * 64 + 16 * ks, bro)), __builtin_bit_cast(bf16x8, ldg16(xbc + 384 + g * 64 + 16 * ks, bro)), GT);
                const float acl = acum[c32];
#pragma unroll
                for (int i = 0; i < 16; ++i) { const int s = crow(i, hh); GT[i] = (s <= c32) ? GT[i] * __expf(acl - acum[s]) : 0.f; }
                f32x16 Y[2];
#pragma unroll
                for (int pt = 0; pt < 2; ++pt)
#pragma unroll
                    for (int i = 0; i < 16; ++i) Y[pt][i] = 0.f;
#pragma unroll
                for (int s = 0; s < 2; ++s) { const bf16x8 pa = PACK_STEP(GT, s);
#pragma unroll
                    for (int pt = 0; pt < 2; ++pt) { const LAS unsigned short* xr = xdT + (32 * pt + c32) * 40 + 16 * s + 4 * hh;
                        Y[pt] = MFMA32(pa, cat44(*(const LAS u32x2*)xr, *(const LAS u32x2*)(xr + 8)), Y[pt]); } }
                const unsigned cro = (unsigned)(MTK(c0, c32) * 512 + 4 * hh) * 2u;
                const float el = __expf(acl);
#pragma unroll
                for (int nt = 0; nt < 2; ++nt)
#pragma unroll
                    for (int s = 0; s < 2; ++s) { const u32x2 clo = ldg8(xbc + 384 + g * 64 + 32 * nt + 16 * s, cro), chi = ldg8(xbc + 384 + g * 64 + 32 * nt + 16 * s + 8, cro);
                        const bf16x8 ca = mk8(pk2(bflo(clo.x) * el, bfhi(clo.x) * el), pk2(bflo(clo.y) * el, bfhi(clo.y) * el), pk2(bflo(chi.x) * el, bfhi(chi.x) * el), pk2(bflo(chi.y) * el, bfhi(chi.y) * el));
#pragma unroll
                        for (int pt = 0; pt < 2; ++pt) Y[pt] = MFMA32(ca, PACK_STEP(ST[nt][pt], s), Y[pt]); }
#pragma unroll
                for (int i = 0; i < 16; ++i) { const unsigned oo = (unsigned)(MTK(c0, crow(i, hh)) * 256 + c32) * 2u; stg2(MYD, oo, f2bf(Y[0][i])); stg2(MYD + 32, oo, f2bf(Y[1][i])); }
            }
            {
                const float de = __expf(aend);
#pragma unroll
                for (int nt = 0; nt < 2; ++nt)
#pragma unroll
                    for (int pt = 0; pt < 2; ++pt)
#pragma unroll
                        for (int i = 0; i < 16; ++i) ST[nt][pt][i] *= de;
#pragma unroll
                for (int s = 0; s < 2; ++s)
#pragma unroll
                    for (int nt = 0; nt < 2; ++nt) { const bf16x8 ba = *(const LAS bf16x8*)(BT + (32 * nt + c32) * 40 + 16 * s + 8 * hh);
#pragma unroll
                        for (int pt = 0; pt < 2; ++pt) ST[nt][pt] = MFMA32(ba, *(const LAS bf16x8*)(xwT + (32 * pt + c32) * 40 + 16 * s + 8 * hh), ST[nt][pt]); }
            }
            atot += aend;
            LDS_WAIT();
        }
        if (pass == 0) {
            f32x4* sp = (f32x4*)(stsc + (size_t)w * 4096 + lane * 64);
#pragma unroll
            for (int a = 0; a < 2; ++a)
#pragma unroll
                for (int q = 0; q < 2; ++q)
#pragma unroll
                    for (int i4 = 0; i4 < 4; ++i4) sp[(a * 2 + q) * 4 + i4] = (f32x4){ST[a][q][4 * i4], ST[a][q][4 * i4 + 1], ST[a][q][4 * i4 + 2], ST[a][q][4 * i4 + 3]};
            if (lane == 0) Atot[w] = __expf(atot);
            VM_WAIT(); __syncthreads();
        }
    }
#undef MTK
#undef MCH
    __syncthreads();
}

DI void hgrn_unit(const Params& P, int l, int u, LAS unsigned char* lds) {
    const int dir = u & 1, h = (u >> 1) & 3, b = u >> 3;
    const int tid = tid_opaque(P.wv), lane_f = tid & 63, w = __builtin_amdgcn_readfirstlane(tid >> 6);
    LAS unsigned char* wl = lds + w * 15104;
    LAS unsigned short* qd = (LAS unsigned short*)wl;
    LAS unsigned short* kd = qd + 32 * 72;
    LAS unsigned short* vT = kd + 32 * 72;
    LAS float* eref = (LAS float*)(wl + 14336);
    LAS float* eglr = eref + 64;
    LAS float* egl = eglr + 64;
    LAS float* lbt = (LAS float*)(lds + 8 * 15104 + 2048 + w * 512);
    LAS float* gsum = lbt + 64;
    LAS float* Atot = (LAS float*)(lds + 8 * 15104);
    unsigned char* ws = P.ws; unsigned char* dsc = (unsigned char*)P.out;
    const bf16_t* proj = (const bf16_t*)(ws + WS_PROJ) + (size_t)b * SEQ * NPROJ;
    bf16_t* OD = (dir ? (bf16_t*)(ws + WS_OB) + (size_t)b * SEQ * 256 + h * 64 : (bf16_t*)(ws + WS_HN) + (size_t)b * SEQ * DM + 768 + h * 64);
    const int ostride = dir ? 256 : DM;
    float* stsc = (float*)(dsc + DO_HST) + (size_t)u * (8 * 4096);
    __syncthreads();
    { float lb = 0.f;
      if (l == 1) { const float h0 = P.hg_lb[(0 * 2 + dir) * 256 + h * 64 + lane_f], h1 = P.hg_lb[(1 * 2 + dir) * 256 + h * 64 + lane_f]; lb = 1.0f / (1.0f + expf(h0 - h1)); }
      lbt[lane_f] = lb; }
    LDS_WAIT();
#define HTK(c0, j) (dir ? (c0) + 31 - (j) : (c0) + (j))
#define HCH(ci) (256 * w + 32 * (dir ? 7 - (ci) : (ci)))
#pragma unroll 1
    for (int pass = 0; pass < 2; ++pass) {
        int lane_p = lane_f; asm volatile("" : "+v"(lane_p));
        const int lane = lane_p, c32 = lane_p & 31, hh = lane_p >> 5, tg = lane_p >> 3, cg = lane_p & 7;
        f32x16 S[2][2];
#pragma unroll
        for (int a = 0; a < 2; ++a)
#pragma unroll
            for (int q = 0; q < 2; ++q)
#pragma unroll
                for (int i = 0; i < 16; ++i) S[a][q][i] = 0.f;
        if (pass == 1) {
            const int nv = dir ? 7 - w : w;
            for (int k = 0; k < nv; ++k) { const int v = dir ? 7 - k : k; const LAS float* at = Atot + v * 64;
                const f32x4* sp = (const f32x4*)(stsc + (size_t)v * 4096 + lane * 64);
#pragma unroll
                for (int a = 0; a < 2; ++a)
#pragma unroll
                    for (int i4 = 0; i4 < 4; ++i4) { const f32x4 dec = *(const LAS f32x4*)(at + 32 * a + 8 * i4 + 4 * hh);
#pragma unroll
                        for (int q = 0; q < 2; ++q) { const f32x4 t = sp[(a * 2 + q) * 4 + i4];
                            S[a][q][4 * i4] = S[a][q][4 * i4] * dec.x + t.x; S[a][q][4 * i4 + 1] = S[a][q][4 * i4 + 1] * dec.y + t.y; S[a][q][4 * i4 + 2] = S[a][q][4 * i4 + 2] * dec.z + t.z; S[a][q][4 * i4 + 3] = S[a][q][4 * i4 + 3] * dec.w + t.w; } } }
        }
        gsum[lane] = 1.0f;
        u32x4 rf[4], rq[4];
        { const int c0 = HCH(0);
#pragma unroll
          for (int i = 0; i < 4; ++i) { const unsigned ro = (unsigned)(HTK(c0, 4 * tg + i) * NPROJ + 8 * cg) * 2u;
              rf[i] = ldg16(proj + PC_HF + dir * 256 + h * 64, ro); rq[i] = (pass == 1) ? ldg16(proj + PC_HQ + h * 64, ro) : (u32x4){0u, 0u, 0u, 0u}; } }
#pragma unroll 1
        for (int ci = 0; ci < 8; ++ci) {
            int lane_i = lane; asm volatile("" : "+v"(lane_i));
            const int c32 = lane_i & 31, hh = lane_i >> 5, tg = lane_i >> 3, cg = lane_i & 7;
            const int c0 = HCH(ci);
            {
                float qprev[4], kprev[4];
                u32x4 rv[4];
#pragma unroll
                for (int i = 0; i < 4; ++i) { const unsigned ro = (unsigned)(HTK(c0, 4 * tg + i) * NPROJ + 8 * cg) * 2u; rv[i] = ldg16(proj + PC_HI + h * 64, ro); }
                const f32x4 lb0 = *(const LAS f32x4*)(lbt + 8 * cg), lb1 = *(const LAS f32x4*)(lbt + 8 * cg + 4);
                const float lbv[8] = {lb0.x, lb0.y, lb0.z, lb0.w, lb1.x, lb1.y, lb1.z, lb1.w};
#pragma unroll
                for (int c = 0; c < 8; ++c) {
                    const float lb = lbv[c], oml = 1.0f - lb;
                    float pl[4], kr[4];
#pragma unroll
                    for (int i = 0; i < 4; ++i) { const float fpre = bf2f(hsel(rf[i], c)); const float en = __expf(-fpre), sg = __builtin_amdgcn_rcpf(1.0f + en);
                        const float ff = lb + oml * sg; pl[i] = (i == 0) ? ff : pl[i - 1] * ff; kr[i] = oml * en * sg; }
                    const float own = pl[3];
                    float lsh = dpp_f<0x118>(own); asm volatile("" : "+v"(lsh));
                    const float lowv = (tg & 1) ? lsh : 1.0f;
                    const float rup = own * lowv;
                    float rro = dpp_f<0x128>(rup); asm volatile("" : "+v"(rro));
                    const float T = (tg & 1) ? rup : rro;
                    const auto s16 = __builtin_amdgcn_permlane16_swap(__float_as_uint(T), __float_as_uint(T), false, false);
                    const float Tp = ((lane >> 4) & 1) ? __uint_as_float(s16[0]) : __uint_as_float(s16[1]);
                    const float PT = T * Tp;
                    const auto s32 = __builtin_amdgcn_permlane32_swap(__float_as_uint(PT), __float_as_uint(PT), false, false);
                    const float pref = __uint_as_float(s32[0]), plast = pref * __uint_as_float(s32[1]);
                    const float excl = (((lane >> 4) & 1) ? Tp : 1.0f) * (((lane >> 5) & 1) ? pref : 1.0f) * ((tg & 1) ? lowv : 1.0f);
                    const float ipref = __builtin_amdgcn_rcpf(pref);
                    if (tg == 0) { eref[8 * cg + c] = pref; eglr[8 * cg + c] = plast * ipref; egl[8 * cg + c] = plast; gsum[8 * cg + c] *= plast; }
                    float kv[4], qv[4];
#pragma unroll
                    for (int i = 0; i < 4; ++i) { const float pj = excl * pl[i]; kv[i] = kr[i] * pref * __builtin_amdgcn_rcpf(pj);
                        if (pass == 1) { const float qr = bf2f(hsel(rq[i], c)); qv[i] = qr * __builtin_amdgcn_rcpf(1.0f + __expf(-qr)) * pj * ipref; } else qv[i] = 0.f; }
                    if (c & 1) {
#pragma unroll
                        for (int i = 0; i < 4; ++i) { *(LAS unsigned*)(kd + (4 * tg + i) * 72 + 8 * cg + c - 1) = pk2(kprev[i], kv[i]);
                            if (pass == 1) *(LAS unsigned*)(qd + (4 * tg + i) * 72 + 8 * cg + c - 1) = pk2(qprev[i], qv[i]); }
                    } else {
#pragma unroll
                        for (int i = 0; i < 4; ++i) { kprev[i] = kv[i]; qprev[i] = qv[i]; }
                    }
                }
#pragma unroll
                for (int c = 0; c < 8; ++c) { unsigned short vb[4];
#pragma unroll
                    for (int i = 0; i < 4; ++i) vb[i] = hsel(rv[i], c);
                    *(LAS u32x2*)(vT + (8 * cg + c) * 40 + 4 * tg) = (u32x2){(unsigned)vb[0] | ((unsigned)vb[1] << 16), (unsigned)vb[2] | ((unsigned)vb[3] << 16)}; }
            }
            if (ci < 7) { const int c1 = HCH(ci + 1);
#pragma unroll
                for (int i = 0; i < 4; ++i) { const unsigned ro = (unsigned)(HTK(c1, 4 * tg + i) * NPROJ + 8 * cg) * 2u;
                    rf[i] = ldg16(proj + PC_HF + dir * 256 + h * 64, ro); if (pass == 1) rq[i] = ldg16(proj + PC_HQ + h * 64, ro); } }
            LDS_WAIT(); __builtin_amdgcn_sched_barrier(0);
            bf16x8 vperm[2][2];
#pragma unroll
            for (int s = 0; s < 2; ++s)
#pragma unroll
                for (int pt = 0; pt < 2; ++pt) { const LAS unsigned short* vr = vT + (32 * pt + c32) * 40 + 16 * s + 4 * hh; vperm[s][pt] = cat44(*(const LAS u32x2*)vr, *(const LAS u32x2*)(vr + 8)); }
            if (pass == 1) {
                f32x16 SC;
#pragma unroll
                for (int i = 0; i < 16; ++i) SC[i] = 0.f;
#pragma unroll
                for (int ks = 0; ks < 4; ++ks) SC = MFMA32(*(const LAS bf16x8*)(kd + c32 * 72 + 16 * ks + 8 * hh), *(const LAS bf16x8*)(qd + c32 * 72 + 16 * ks + 8 * hh), SC);
#pragma unroll
                for (int i = 0; i < 16; ++i) SC[i] = (crow(i, hh) <= c32) ? SC[i] : 0.f;
                const bf16x8 pa0 = PACK_STEP(SC, 0), pa1 = PACK_STEP(SC, 1);
                bf16x8 qa[2][2];
#pragma unroll
                for (int et = 0; et < 2; ++et)
#pragma unroll
                    for (int s = 0; s < 2; ++s) { const LAS unsigned short* qr = qd + c32 * 72 + 32 * et + 16 * s + 4 * hh; qa[et][s] = cat44(*(const LAS u32x2*)qr, *(const LAS u32x2*)(qr + 8)); }
#pragma unroll
                for (int pt = 0; pt < 2; ++pt) {
                    f32x16 O;
#pragma unroll
                    for (int i = 0; i < 16; ++i) O[i] = 0.f;
                    O = MFMA32(pa0, vperm[0][pt], O); O = MFMA32(pa1, vperm[1][pt], O);
#pragma unroll
                    for (int et = 0; et < 2; ++et)
#pragma unroll
                        for (int s = 0; s < 2; ++s) { const f32x4 e0 = *(const LAS f32x4*)(eref + 32 * et + 16 * s + 4 * hh), e1 = *(const LAS f32x4*)(eref + 32 * et + 16 * s + 8 + 4 * hh);
                            const f32x16& sv = S[et][pt];
                            const bf16x8 sb = mk8(pk2(sv[8 * s] * e0.x, sv[8 * s + 1] * e0.y), pk2(sv[8 * s + 2] * e0.z, sv[8 * s + 3] * e0.w), pk2(sv[8 * s + 4] * e1.x, sv[8 * s + 5] * e1.y), pk2(sv[8 * s + 6] * e1.z, sv[8 * s + 7] * e1.w));
                            O = MFMA32(qa[et][s], sb, O); }
#pragma unroll
                    for (int i = 0; i < 16; ++i) { const unsigned oo = (unsigned)(HTK(c0, crow(i, hh)) * ostride + c32) * 2u; stg2(OD + 32 * pt, oo, f2bf(O[i])); }
                    __builtin_amdgcn_sched_barrier(0);
                }
            }
            __builtin_amdgcn_sched_barrier(0);
            {
#pragma unroll
                for (int et = 0; et < 2; ++et) {
                    f32x16 X;
#pragma unroll
                    for (int i = 0; i < 16; ++i) X[i] = 0.f;
#pragma unroll
                    for (int s = 0; s < 2; ++s) { unsigned idw[4];
#pragma unroll
                        for (int j = 0; j < 4; ++j) { const int k0 = 16 * s + 8 * hh + 2 * j; idw[j] = (k0 == c32 ? 0x3f80u : 0u) | (k0 + 1 == c32 ? 0x3f800000u : 0u); }
                        X = MFMA32(*(const LAS bf16x8*)(kd + c32 * 72 + 32 * et + 16 * s + 8 * hh), mk8(idw[0], idw[1], idw[2], idw[3]), X); }
                    const float sc = eglr[32 * et + c32];
#pragma unroll
                    for (int i = 0; i < 16; ++i) X[i] *= sc;
                    float dg[16];
#pragma unroll
                    for (int i = 0; i < 16; ++i) dg[i] = egl[32 * et + crow(i, hh)];
#pragma unroll
                    for (int pt = 0; pt < 2; ++pt) {
#pragma unroll
                        for (int i = 0; i < 16; ++i) S[et][pt][i] *= dg[i];
#pragma unroll
                        for (int s = 0; s < 2; ++s) S[et][pt] = MFMA32(PACK_STEP(X, s), vperm[s][pt], S[et][pt]); }
                }
            }
            LDS_WAIT();
        }
        if (pass == 0) {
            f32x4* sp = (f32x4*)(stsc + (size_t)w * 4096 + lane * 64);
#pragma unroll
            for (int a = 0; a < 2; ++a)
#pragma unroll
                for (int q = 0; q < 2; ++q)
#pragma unroll
                    for (int i4 = 0; i4 < 4; ++i4) sp[(a * 2 + q) * 4 + i4] = (f32x4){S[a][q][4 * i4], S[a][q][4 * i4 + 1], S[a][q][4 * i4 + 2], S[a][q][4 * i4 + 3]};
            LDS_WAIT(); Atot[w * 64 + lane] = gsum[lane];
            VM_WAIT(); __syncthreads();
        }
    }
#undef HTK
#undef HCH
    __syncthreads();
}

DI void phase_mixers(const Params& P, int l, LAS unsigned char* lds, int G, int bid) {
#ifndef REP_PHASE
#define REP_PHASE -1
#endif
#define MREPS(k) _Pragma("unroll 1") for (int _r = 0; _r < ((REP_PHASE == (k)) ? 2 : 1); ++_r)
    if (EN_HY) MREPS(30) for (int c = bid; c < 256; c += G) hyena_unit(P, c, lds);
    if (EN_AT) MREPS(31) { int bias_h = -1;
        if ((G & 7) == 0) { const int xcd = bid & 7, j = bid >> 3, per = G >> 3;
            for (int base = 0; base < NB * 4 * 8; base += G) { const int u = base + xcd * per + j; if (u < NB * 4 * 8) attn_unit(P, u, lds, bias_h); } }
        else for (int u = bid; u < NB * 4 * 8; u += G) attn_unit(P, u, lds, bias_h); }
    if (EN_MA) MREPS(32) for (int u = bid; u < 256; u += G) mamba_unit(P, l, u, lds);
    if (EN_HG) MREPS(33) for (int u = bid; u < 256; u += G) hgrn_unit(P, l, u, lds);
}

constexpr int N_PHASES = 21;
#if TPROBE >= 40 && TPROBE < 50
#define PCTL , (unsigned*)(ws + WS_CTL)
#else
#define PCTL
#endif
#ifndef REP_PHASE
#define REP_PHASE -1
#endif
#define REPS(k) for (int _rep = 0, _nrep = ((REP_PHASE == (k)) && ((k) != 0 && (k) != 5 || l == 0)) ? 2 : 1; _rep < _nrep; ++_rep)
__global__ void __launch_bounds__(512, 2) fwd_kernel(Params Pin) {
    Params P = Pin; P.wv = __builtin_amdgcn_readfirstlane((int)(threadIdx.x >> 6));
    extern __shared__ __attribute__((aligned(16))) unsigned char lds_raw[];
    LAS unsigned char* lds = (LAS unsigned char*)lds_raw;
    volatile LAS unsigned* MISC = (volatile LAS unsigned*)(lds + LDS_MISC);
    if (threadIdx.x < 64) MISC[threadIdx.x] = 0u;
    __syncthreads();
    unsigned char* ws = P.ws;
    const int lo = P.ph_lo, hi = P.ph_hi;
    XcdBarrier bar; bar.bar = (unsigned*)(ws + WS_CTL) + CW_BAR; bar.x = 0; bar.st = nullptr;
    if (hi - lo > 1) bar = xcd_barrier_post((unsigned*)(ws + WS_CTL) + CW_BAR, MISC + 8);
#define IN(k) (lo <= (k) && (k) < hi)
#ifndef TPSEAM
#define TPSEAM -1
#endif
#if TPROBE == 20
#define SEAM(k) do { if (IN(k) && IN((k) + 1)) { const unsigned _t0 = TP_T(); xcd_barrier(bar); if (TPSEAM < 0 || ((k) % 10) == TPSEAM) gb_wait += TP_T() - _t0; } } while (0)
#else
#define SEAM(k) do { if (IN(k) && IN((k) + 1)) xcd_barrier(bar); } while (0)
#endif
    unsigned gb_wait = 0; const unsigned gb_t0 = TPROBE == 20 ? TP_T() : 0u;
#pragma unroll 1
    for (int l = 0; l < 2; ++l) {
        int G = gridDim.x, bid = blockIdx.x; asm volatile("" : "+s"(G), "+s"(bid));
        const int p0 = 10 * l;
        if (IN(p0 + 0)) { _Pragma("unroll 1") REPS(0) phase_pre(P, l, lds); }
        SEAM(p0 + 0);
        if (IN(p0 + 1)) { _Pragma("unroll 1") REPS(1) {
            pg8::StaticOrder S; S.init(NTOK / 256, NPROJ / 256, G, bid); AddrPlain AD{DM, 0}; EpiProj E{(bf16_t*)(ws + WS_PROJ), (const float*)(ws + WS_MSQ)};
            pg8::gemm_phase(lds, (const char*)(ws + WS_XB), (const char*)(ws + WS_WIN), DM, S, AD, E, P.wv PCTL);
        } }
        SEAM(p0 + 1);
        if (IN(p0 + 2)) { _Pragma("unroll 1") REPS(2) phase_premix(P, l, lds); }
        SEAM(p0 + 2);
        if (IN(p0 + 3)) { _Pragma("unroll 1") REPS(3) phase_mixers(P, l, lds, G, bid); }
        SEAM(p0 + 3);
        if (IN(p0 + 4)) { _Pragma("unroll 1") REPS(4) phase_finalize(P, l); }
        SEAM(p0 + 4);
        if (IN(p0 + 5)) { _Pragma("unroll 1") REPS(5) {
            pg8::StaticOrder S; S.init(NTOK / 256, DM / 256, G, bid); AddrPlain AD{DM, 0}; EpiRes E{nullptr, (const bf16_t*)(ws + WS_XB), (bf16_t*)(ws + WS_XB)};
            pg8::gemm_phase(lds, (const char*)(ws + WS_HN), (const char*)(ws + WS_WOUT), DM, S, AD, E, P.wv PCTL);
        } }
        SEAM(p0 + 5);
        if (IN(p0 + 6)) { if (EN_MOE) { _Pragma("unroll 1") REPS(6) phase_ffnpre(P, l, lds); } }
        SEAM(p0 + 6);
        if (IN(p0 + 7)) { if (EN_MOE) { _Pragma("unroll 1") REPS(7) phase_topk(P, l, lds); } }
        SEAM(p0 + 7);
        if (IN(p0 + 8)) { if (EN_MOE) _Pragma("unroll 1") REPS(8) {
            pg8::StaticOrder S; S.init(NSLOT / 256, 2048 / 256, G, bid);
#if MOE_F8
            AddrGateUp8 AD{(const int*)(ws + WS_SELI)}; EpiGateUp8 E{(unsigned char*)P.out + DO_HDN, (const float*)(ws + WS_SELR)};
            pg8::gemm_phase<EpiGateUp8, pg8::StaticOrder, AddrGateUp8, true>(lds, (const char*)(ws + WS_HN), (const char*)(ws + WS_WGU), DM, S, AD, E, P.wv PCTL);
#else
            AddrGateUp AD{(const int*)(ws + WS_SELI)}; EpiGateUp E{(bf16_t*)((unsigned char*)P.out + DO_HDN), (const float*)(ws + WS_SELR)};
            pg8::gemm_phase(lds, (const char*)(ws + WS_HN), (const char*)(ws + WS_WGU), DM, S, AD, E, P.wv PCTL);
#endif
        } }
        SEAM(p0 + 8);
        if (IN(p0 + 9)) { if (EN_MOE) _Pragma("unroll 1") REPS(9) {
            pg8::StaticOrder S; S.init(NSLOT / 256, DM / 256, G, bid);
#if MOE_F8
            EpiDown E{(bf16_t*)(ws + WS_YE), (const float*)(ws + WS_SELG)};
            AddrDown8 AD{}; pg8::gemm_phase<EpiDown, pg8::StaticOrder, AddrDown8, true>(lds, (const char*)P.out + DO_HDN, (const char*)(ws + WS_WD), DM, S, AD, E, P.wv PCTL);
#else
            EpiDown E{(bf16_t*)(ws + WS_YE), (const float*)(ws + WS_SELG)};
            AddrDown AD{}; pg8::gemm_phase(lds, (const char*)P.out + DO_HDN, (const char*)(ws + WS_WD), DM, S, AD, E, P.wv PCTL);
#endif
        } }
        SEAM(p0 + 9);
    }
#ifdef PROBE_BARS
    if (hi - lo > 1) for (int i = 0; i < PROBE_BARS; ++i) xcd_barrier(bar);
#endif
    if (IN(20)) phase_final(P);
#ifndef TPOFF
#define TPOFF 0.5f
#endif
#if TPROBE == 20
    if (tid_opaque(P.wv) == 0) { atomicAdd((unsigned*)(ws + WS_CTL) + 512, gb_wait); atomicAdd((unsigned*)(ws + WS_CTL) + 513, (TP_T() - gb_t0) / 5u); }
    xcd_barrier(bar);
#endif
#if TPROBE
    __syncthreads();
    if (blockIdx.x == 0 && tid_opaque(P.wv) == 0) {
        const float a = (float)__hip_atomic_load((unsigned*)(ws + WS_CTL) + 512, __ATOMIC_RELAXED, __HIP_MEMORY_SCOPE_AGENT), t = (float)__hip_atomic_load((unsigned*)(ws + WS_CTL) + 513, __ATOMIC_RELAXED, __HIP_MEMORY_SCOPE_AGENT);
        P.out[0] = TPROBE == 99 ? 1.0e6f : (TPROBE == 20 && TPSEAM >= 0) ? (floorf(2.0f * log2f(a / t * 200.0f) + TPOFF) * 1.0e5f) : (floorf(a / t * 20.0f + TPOFF) * 1.0e5f); }
#endif
#undef IN
#undef SEAM
}

#ifndef N_LAUNCH_MODE
#define N_LAUNCH_MODE 1
#endif
extern "C" void kernel_launch(void* const* d_in, const int* in_sizes, int n_in, void* d_out, int out_size, void* d_ws, size_t ws_size, hipStream_t stream) {
    static int grid = 0;
    if (grid == 0) {
        if (n_in != 27 || in_sizes[0] != NTOK * DM || out_size != NTOK * DM || ws_size < WS_END) {
            fprintf(stderr, "kernel_launch: unexpected shapes (n_in %d, in0 %d, out %d, ws %zu, need %zu)\n", n_in, n_in > 0 ? in_sizes[0] : -1, out_size, ws_size, (size_t)WS_END); grid = -1; return; }
        int dev = 0, cus = 0, per_cu = 0;
        if (hipGetDevice(&dev) != hipSuccess || hipDeviceGetAttribute(&cus, hipDeviceAttributeMultiprocessorCount, dev) != hipSuccess) { grid = -1; return; }
        if (hipFuncSetAttribute((const void*)fwd_kernel, hipFuncAttributeMaxDynamicSharedMemorySize, LDS_BYTES) != hipSuccess) { fprintf(stderr, "kernel_launch: hipFuncSetAttribute failed\n"); grid = -1; return; }
        if (hipOccupancyMaxActiveBlocksPerMultiprocessor(&per_cu, (const void*)fwd_kernel, 512, LDS_BYTES) != hipSuccess || per_cu < 1) { fprintf(stderr, "kernel_launch: occupancy query says %d\n", per_cu); (void)hipGetLastError(); }
        grid = cus;
    }
    if (grid < 0) return;
    if (hipMemsetAsync((char*)d_ws + WS_CTL, 0, CTL_ZERO_BYTES, stream) != hipSuccess) return;
    Params p{};
    const float** pp = (const float**)&p;
    for (int i = 0; i < 27; ++i) pp[i] = (const float*)d_in[i];
    p.out = (float*)d_out; p.ws = (unsigned char*)d_ws;
    if (N_LAUNCH_MODE == 1) { p.ph_lo = 0; p.ph_hi = N_PHASES; hipLaunchKernelGGL(fwd_kernel, dim3(grid), dim3(512), LDS_BYTES, stream, p); }
    else for (int k = 0; k < N_PHASES; ++k) { p.ph_lo = k; p.ph_hi = k + 1; hipLaunchKernelGGL(fwd_kernel, dim3(grid), dim3(512), LDS_BYTES, stream, p); }
}
```

```cpp
#define N_LAUNCH_MODE 1
#include <hip/hip_runtime.h>
#include <cstdio>
#include <cstdint>

#define LAS __attribute__((address_space(3)))
#define DI __device__ __forceinline__
typedef unsigned short bf16_t;
typedef short bf16x8 __attribute__((ext_vector_type(8)));
typedef short s16x4 __attribute__((ext_vector_type(4)));
typedef float f32x2 __attribute__((ext_vector_type(2)));
typedef float f32x4 __attribute__((ext_vector_type(4)));
typedef float f32x16 __attribute__((ext_vector_type(16)));
typedef unsigned u32x2 __attribute__((ext_vector_type(2)));
typedef unsigned u32x4 __attribute__((ext_vector_type(4)));
typedef int i32x4 __attribute__((ext_vector_type(4)));
typedef __bf16 bfv2 __attribute__((ext_vector_type(2)));

DI unsigned pk2(float lo, float hi) { f32x2 v = {lo, hi}; return __builtin_bit_cast(unsigned, __builtin_convertvector(v, bfv2)); }
DI unsigned short f2bf(float f) { return (unsigned short)(pk2(f, 0.f) & 0xffffu); }
DI float bf2f(unsigned short b) { return __uint_as_float((unsigned)b << 16); }
DI float bflo(unsigned u) { return __uint_as_float(u << 16); }
DI float bfhi(unsigned u) { return __uint_as_float(u & 0xffff0000u); }
DI unsigned pk4_fp8(float a, float b, float c, float d) {
    a = __builtin_amdgcn_fmed3f(a, -440.f, 440.f); b = __builtin_amdgcn_fmed3f(b, -440.f, 440.f); c = __builtin_amdgcn_fmed3f(c, -440.f, 440.f); d = __builtin_amdgcn_fmed3f(d, -440.f, 440.f);
    int v = 0; v = __builtin_amdgcn_cvt_pk_fp8_f32(a, b, v, false); v = __builtin_amdgcn_cvt_pk_fp8_f32(c, d, v, true); return (unsigned)v; }
DI int lane_now() { int ln; asm volatile("v_mbcnt_lo_u32_b32 %0, -1, 0\n\tv_mbcnt_hi_u32_b32 %0, -1, %0" : "=v"(ln)); return ln; }
template <class T> DI T bperm_(int idx4, T v) { return __builtin_bit_cast(T, __builtin_amdgcn_ds_bpermute(idx4, __builtin_bit_cast(int, v))); }
template <class T> DI T shfl_xor_l(T v, int m, int self) { return bperm_(((self ^ m) & 63) << 2, v); }
template <class T> DI T shfl_up_l(T v, int o, int self, int width = 64) { int idx = self - o; if (idx < (self & ~(width - 1))) idx = self; return bperm_(idx << 2, v); }
template <class T> DI T shfl_xor_(T v, int m) { return shfl_xor_l(v, m, lane_now()); }
template <class T> DI T shfl_up_(T v, int o, int width = 64) { return shfl_up_l(v, o, lane_now(), width); }
template <class T> DI T shfl_(T v, int src) { return bperm_((src & 63) << 2, v); }
#ifndef HIP_SHFL
#define __shfl_xor shfl_xor_
#define __shfl_up shfl_up_
#define __shfl shfl_
#endif
DI float xhalf_max(float x) { const auto r = __builtin_amdgcn_permlane32_swap(__float_as_uint(x), __float_as_uint(x), false, false); return fmaxf(__uint_as_float(r[0]), __uint_as_float(r[1])); }
DI float xhalf_sum(float x) { const auto r = __builtin_amdgcn_permlane32_swap(__float_as_uint(x), __float_as_uint(x), false, false); return __uint_as_float(r[0]) + __uint_as_float(r[1]); }
template <int CTRL> DI float dpp_f(float x) { return __builtin_bit_cast(float, __builtin_amdgcn_update_dpp(0, __builtin_bit_cast(int, x), CTRL, 0xF, 0xF, true)); }
DI float x16_sum(float x) { const auto r = __builtin_amdgcn_permlane16_swap(__float_as_uint(x), __float_as_uint(x), false, false); return __uint_as_float(r[0]) + __uint_as_float(r[1]); }
DI float row_sum16(float x) { x += dpp_f<0x128>(x); x += dpp_f<0x124>(x); x += dpp_f<0x122>(x); x += dpp_f<0x121>(x); return x; }
DI float grp_sum8(float x) { x += dpp_f<0xB1>(x); x += dpp_f<0x4E>(x); x += dpp_f<0x141>(x); return x; }
DI float grp_max16(float x) { x = fmaxf(x, dpp_f<0xB1>(x)); x = fmaxf(x, dpp_f<0x4E>(x)); x = fmaxf(x, dpp_f<0x141>(x)); x = fmaxf(x, dpp_f<0x128>(x)); return x; }
DI float wave_sum(float v) { return xhalf_sum(x16_sum(row_sum16(v))); }
DI float silu_f(float x) { return x * __builtin_amdgcn_rcpf(1.0f + __expf(-x)); }
DI float sigmoid_f(float x) { return __builtin_amdgcn_rcpf(1.0f + __expf(-x)); }
#ifdef OLD_TID
DI int tid_opaque(int wv) { int t = wv * 64 + (int)__builtin_amdgcn_mbcnt_hi(~0u, __builtin_amdgcn_mbcnt_lo(~0u, 0u)); asm volatile("" : "+v"(t)); return t; }
#else
DI int tid_opaque(int wv) { int ln; asm volatile("v_mbcnt_lo_u32_b32 %0, -1, 0\n\tv_mbcnt_hi_u32_b32 %0, -1, %0" : "=v"(ln) :: "memory"); return wv * 64 + ln; }
#endif
DI bf16x8 mk8u(unsigned a, unsigned b, unsigned c, unsigned d) { u32x4 v = {a, b, c, d}; return __builtin_bit_cast(bf16x8, v); }
#define LDS_WAIT() asm volatile("s_waitcnt lgkmcnt(0)" ::: "memory")
#define VM_WAIT() asm volatile("s_waitcnt vmcnt(0)" ::: "memory")
#define MFMA32(a, b, c) __builtin_amdgcn_mfma_f32_32x32x16_bf16((a), (b), (c), 0, 0, 0)

constexpr int NB = 32, SEQ = 2048, DM = 1024, NTOK = NB * SEQ;
constexpr int NIN_REF = 3592, NPROJ = 3584;
constexpr int PC_HY = 0, PC_MZ = 768, PC_MX = 1024, PC_AQ = 1536, PC_AK = 1792, PC_AV = 2048, PC_HQ = 2304, PC_HF = 2560, PC_HI = 3072, PC_HG = 3328;
constexpr int NEXP = 16, CAP = 256, NSLOT = NB * NEXP * CAP;
constexpr float EPSN = 1e-6f;

constexpr size_t MiB = 1u << 20;
constexpr size_t WS_CTL = 0, CTL_ZERO_BYTES = 64 * 1024;
constexpr size_t WS_DT = 1 * MiB, WS_AFF = 3 * MiB, WS_SLOT = 7 * MiB, WS_SELI = 11 * MiB, WS_SELG = 11 * MiB + 512 * 1024, WS_KFILT = 12 * MiB, WS_MSQ = 14 * MiB, WS_RS = 15 * MiB, WS_SELR = 15 * MiB + 512 * 1024;
constexpr size_t WS_XB = 64 * MiB, WS_WIN = 320 * MiB, WS_WOUT = 327 * MiB, WS_WGU = 329 * MiB, WS_WD = 393 * MiB, WS_HN = 432 * MiB, WS_PROJ = 560 * MiB, WS_YE = WS_PROJ, WS_END = 1008 * MiB, WS_MYB = WS_WGU, WS_OB = WS_WGU + 32 * MiB;
constexpr size_t DO_HW = 0, DO_HX0 = 32 * MiB, DO_YAT = 64 * MiB, DO_MXBC = 96 * MiB, DO_MY = 160 * MiB, DO_MST = 192 * MiB, DO_HST = 224 * MiB, DO_HDN = 0;
constexpr int CW_BAR = 1024;

constexpr int LDS_MISC = 163840 - 256, LDS_BYTES = 163840;

struct Params {
    const float *x, *w_in, *w_out, *norm_mix_w, *norm_ffn_w, *hy_conv_w, *hy_w1, *hy_b1, *hy_w2, *hy_b2, *hy_freq, *hy_w3, *hy_fbias,
                *m_conv_w, *m_conv_b, *m_dt_bias, *m_A_log, *m_D, *m_norm_w, *rel_bias, *hg_lb, *hg_norm_w, *router_w, *moe_wg, *moe_wu, *moe_wd, *final_w;
    float* out; unsigned char* ws;
    int ph_lo, ph_hi, wv, pad;
};

#define XB_TMO      128
#define XB_XCNT(j)  (256  + 64 * (j))
#define XB_XSUB(j)  (1280 + 64 * (j))
#define XB_XGEN(j)  (2304 + 64 * (j))
#define XB_TOP      3328
#define XB_TOPGEN   3392
#define XCD_BAR_WORDS 3456
#define XB_SPIN_CAP (1u << 18)
__device__ __forceinline__ unsigned xb_ld(unsigned* p)              { return __hip_atomic_load(p, __ATOMIC_RELAXED, __HIP_MEMORY_SCOPE_AGENT); }
__device__ __forceinline__ unsigned xb_add(unsigned* p, unsigned v) { return __hip_atomic_fetch_add(p, v, __ATOMIC_RELAXED, __HIP_MEMORY_SCOPE_AGENT); }
__device__ __forceinline__ unsigned xb_xcc_id() { return (unsigned)__builtin_amdgcn_s_getreg((3 << 11) | 20) & 0xFu; }
#define XB_SPIN(cond, bar) do { unsigned _sp = 0; while (cond) { __builtin_amdgcn_s_sleep(1); \
    if ((++_sp & 255u) == 0u) { if (xb_ld(&(bar)[XB_TMO])) break; if (_sp > XB_SPIN_CAP) { atomicAdd(&(bar)[XB_TMO], 1u); break; } } } } while (0)
struct XcdBarrier { unsigned* bar; unsigned x; volatile LAS unsigned* st; };
__device__ __forceinline__ XcdBarrier xcd_barrier_post(unsigned* bar, volatile LAS unsigned* st) {
    XcdBarrier b; b.bar = bar; b.x = xb_xcc_id(); b.st = st;
    if (threadIdx.x == 0) (void)xb_add(&bar[XB_XCNT(b.x)], 1u);
    return b;
}
__device__ __forceinline__ void xcd_barrier_complete(unsigned* bar, unsigned x, unsigned& nloc, unsigned& nx) {
    const unsigned G = gridDim.x * gridDim.y * gridDim.z;
    unsigned sum, cnt, mine, sp = 0u;
    for (;;) {
        sum = 0u; cnt = 0u; mine = 0u;
#pragma unroll
        for (unsigned j = 0; j < 16; ++j) { const unsigned c = xb_ld(&bar[XB_XCNT(j)]); sum += c; cnt += (c > 0u) ? 1u : 0u; mine = (j == x) ? c : mine; }
        if (sum == G) break;
        __builtin_amdgcn_s_sleep(1);
        if ((++sp & 255u) == 0u) { if (xb_ld(&bar[XB_TMO])) break; if (sp > XB_SPIN_CAP) { atomicAdd(&bar[XB_TMO], 1u); break; } }
    }
    nloc = mine > 0u ? mine : 1u; nx = cnt > 0u ? cnt : 1u;
}
__device__ __forceinline__ void xcd_barrier(const XcdBarrier& b) {
    asm volatile("s_waitcnt vmcnt(0)" ::: "memory");
    __syncthreads();
    if (threadIdx.x == 0) {
        unsigned* bar = b.bar; asm volatile("" : "+s"(bar));
        __builtin_amdgcn_s_waitcnt(0);
        unsigned nloc = b.st[0], nx = b.st[1];
        if (nloc == 0u) { xcd_barrier_complete(bar, b.x, nloc, nx); b.st[0] = nloc; b.st[1] = nx; }
        const unsigned old = xb_add(&bar[XB_XSUB(b.x)], 1u);
        const unsigned gen = old / nloc;
        if (old + 1u == (gen + 1u) * nloc) {
            __builtin_amdgcn_fence(__ATOMIC_RELEASE, "agent");
            asm volatile("s_waitcnt vmcnt(0)" ::: "memory");
            const unsigned og = xb_add(&bar[XB_TOP], 1u);
            const unsigned tg = og / nx;
            if (og + 1u == (tg + 1u) * nx) xb_add(&bar[XB_TOPGEN], 1u);
            else XB_SPIN(xb_ld(&bar[XB_TOPGEN]) == tg, bar);
            __builtin_amdgcn_fence(__ATOMIC_ACQUIRE, "agent");
            xb_add(&bar[XB_XGEN(b.x)], 1u);
            asm volatile("s_waitcnt vmcnt(0)" ::: "memory");
        } else {
            XB_SPIN(xb_ld(&bar[XB_XGEN(b.x)]) == gen, bar);
            __builtin_amdgcn_fence(__ATOMIC_ACQUIRE, "agent");
            asm volatile("s_waitcnt vmcnt(0)" ::: "memory");
        }
    }
    __syncthreads();
}

namespace pg8 {
constexpr int BM = 256, BK = 64, HALF = 128, HTB = HALF * BK * 2, STAGE_BYTES = 8 * HTB, NXCD = 8, WGM = 8;
__host__ __device__ __forceinline__ int lds_byte(int r, int c) { const int st = (r >> 4) * 2 + (c >> 5), rr = r & 15, cc = c & 31, ob = rr * 64 + cc * 2; return st * 1024 + (ob ^ (((ob >> 9) & 1) << 5)); }
__host__ __device__ __forceinline__ void stage_rc(int b, int& R, int& C) { const int st = b / 1024, sb = b % 1024, swz = sb ^ (((sb >> 9) & 1) << 5); R = (st >> 1) * 16 + swz / 64; C = (st & 1) * 32 + (swz % 64) / 2; }
__host__ __device__ __forceinline__ int perm32(int rho) { const int n = rho >> 4, i = rho & 15; return 8 * (i >> 2) + 4 * n + (i & 3); }
struct Unit { int pm, pn; };
typedef int i32x8 __attribute__((ext_vector_type(8)));
typedef int i32x32 __attribute__((ext_vector_type(32)));
#define INS4(V, P, X) do { const i32x4 _x = (X); (V)[(P)] = _x.x; (V)[(P) + 1] = _x.y; (V)[(P) + 2] = _x.z; (V)[(P) + 3] = _x.w; } while (0)
#define EXT8(V, P) ((i32x8){(V)[(P)], (V)[(P) + 1], (V)[(P) + 2], (V)[(P) + 3], (V)[(P) + 4], (V)[(P) + 5], (V)[(P) + 6], (V)[(P) + 7]})
DI i32x8 cat88(bf16x8 lo, bf16x8 hi) { const i32x4 a = __builtin_bit_cast(i32x4, lo), b = __builtin_bit_cast(i32x4, hi); return (i32x8){a.x, a.y, a.z, a.w, b.x, b.y, b.z, b.w}; }
struct StaticOrder {
    int nM, nN, nwg, G, c;
    __device__ void init(int nM_, int nN_, int G_, int c_) { nM = nM_; nN = nN_; nwg = nM * nN; G = G_; c = c_; }
    __device__ bool next(int i, Unit& u) const {
        const long L = (long)i * G + c; if (L >= nwg) return false;
        int wgid = (int)L; { const int q = nwg / NXCD, r = nwg % NXCD, xcd = wgid % NXCD, off = wgid / NXCD; wgid = (xcd < r ? xcd * (q + 1) : r * (q + 1) + (xcd - r) * q) + off; }
        const int nig = WGM * nN, gid = wgid / nig, fm = gid * WGM, gsz = (nM - fm) < WGM ? (nM - fm) : WGM;
        u.pm = fm + ((wgid % nig) % gsz); u.pn = (wgid % nig) / gsz; return true;
    }
};
#ifndef TPROBE
#define TPROBE 0
#endif
#ifndef TPGEMM
#define TPGEMM 0
#endif
#define GP_T() ({ asm volatile("" ::: "memory"); unsigned _t = (unsigned)__builtin_amdgcn_s_memrealtime(); asm volatile("" ::: "memory"); _t; })
#define GP_ON(k) (TPROBE == (k) && Epi::PID == TPGEMM)
template <class Epi, class Sched, class Addr, bool F8 = false>
__device__ __forceinline__ void gemm_phase(LAS unsigned char* lds, const char* Abase, const char* Bbase, int K, const Sched& S, const Addr& AD, const Epi& E, int wv, unsigned* lds_ws_ctl = nullptr) {
    const int tid = tid_opaque(wv), wid = __builtin_amdgcn_readfirstlane(tid >> 6), lane = tid & 63, wr = wid >> 2, wc = wid & 3, fr = lane & 15, fq = lane >> 4;
    unsigned gp_acc = 0, gp_tot = 0, gp_t0 = 0, gp_t1 = 0; if (TPROBE >= 40 && TPROBE < 50 && Epi::PID == TPGEMM) gp_t0 = GP_T();
    const int KB = F8 ? K : 2 * K;
    const int nt = KB / 128;
    int Rr[2]; unsigned Cc[2], voffB[2], voffA[2];
#pragma unroll
    for (int i = 0; i < 2; ++i) { int R, C; stage_rc(tid * 16 + i * 8192, R, C); const int Rb = Epi::PERM ? ((R & ~31) + perm32(R & 31)) : R;
        Rr[i] = R; Cc[i] = (unsigned)C * 2u; voffA[i] = (unsigned)(R * KB + C * 2); voffB[i] = (unsigned)(Rb * KB + C * 2); }
    const size_t kstep = (size_t)(BK * 2);
    const size_t hstep = (size_t)HALF * KB;
    const unsigned ldsw = (unsigned)wid * 1024u;
    const int aoff = F8 ? lds_byte(wr * 64 + fr, fq * 16) : lds_byte(wr * 64 + fr, fq * 8), boff = F8 ? lds_byte(wc * 32 + fr, fq * 16) : lds_byte(wc * 32 + fr, fq * 8);
    const int aoff1 = F8 ? lds_byte(wr * 64 + fr, fq * 16 + 8) : aoff + 1024, boff1 = F8 ? lds_byte(wc * 32 + fr, fq * 16 + 8) : boff + 1024;
#define PG8_SA(b, h) (((b) * 2 + (h)) * HTB)
#define PG8_SB(b, h) ((4 + (b) * 2 + (h)) * HTB)
#define PG8_STAGE(bufoff, gbase, voff) do { _Pragma("unroll") for (int _i = 0; _i < 2; ++_i) \
        __builtin_amdgcn_global_load_lds((const unsigned*)((const char*)(gbase) + (voff)[_i]), (LAS unsigned*)(lds + (bufoff) + ldsw + _i * 8192), 16, 0, 0); } while (0)
#define PG8_STAGE_A(bufoff, kb, h, un) do { if constexpr (Addr::LOADS) { _Pragma("unroll") for (int _i = 0; _i < 2; ++_i) \
        __builtin_amdgcn_global_load_lds((const unsigned*)(Abase + (kb) + ((un) ? on[h][_i] : oc[h][_i])), (LAS unsigned*)(lds + (bufoff) + ldsw + _i * 8192), 16, 0, 0); } \
      else { const char* _ab = ((un) ? nA : cA) + (kb) + (size_t)(h) * hstep; _Pragma("unroll") for (int _i = 0; _i < 2; ++_i) \
        __builtin_amdgcn_global_load_lds((const unsigned*)(_ab + voffA[_i]), (LAS unsigned*)(lds + (bufoff) + ldsw + _i * 8192), 16, 0, 0); } } while (0)
#define PG8_BSEL_B0 0
#define PG8_BSEL_B1 16
#define PG8_LDA(dst, b, h) do { if constexpr (F8) { _Pragma("unroll") for (int m = 0; m < 4; ++m) { INS4(AA, 8 * m, *(const LAS i32x4*)(lds + PG8_SA(b, h) + aoff + m * 2048)); INS4(AA, 8 * m + 4, *(const LAS i32x4*)(lds + PG8_SA(b, h) + aoff + 16 + m * 2048)); } } \
      else { _Pragma("unroll") for (int m = 0; m < 4; ++m) _Pragma("unroll") for (int k = 0; k < 2; ++k) dst[m][k] = *(const LAS bf16x8*)(lds + PG8_SA(b, h) + (k ? aoff1 : aoff) + m * 2048); } } while (0)
#define PG8_LDB(dst, b, h) do { if constexpr (F8) { _Pragma("unroll") for (int n = 0; n < 2; ++n) { INS4(BB, PG8_BSEL_##dst + 8 * n, *(const LAS i32x4*)(lds + PG8_SB(b, h) + boff + n * 2048)); INS4(BB, PG8_BSEL_##dst + 8 * n + 4, *(const LAS i32x4*)(lds + PG8_SB(b, h) + boff + 16 + n * 2048)); } } \
      else { _Pragma("unroll") for (int n = 0; n < 2; ++n) _Pragma("unroll") for (int k = 0; k < 2; ++k) dst[n][k] = *(const LAS bf16x8*)(lds + PG8_SB(b, h) + (k ? boff1 : boff) + n * 2048); } } while (0)
#define PG8_MMA(ai, bj, At, Bt) do { __builtin_amdgcn_s_setprio(1); if constexpr (F8) { _Pragma("unroll") for (int m = 0; m < 4; ++m) _Pragma("unroll") for (int n = 0; n < 2; ++n) \
        { const i32x8 _b8 = EXT8(BB, PG8_BSEL_##Bt + 8 * n), _a8 = EXT8(AA, 8 * m); \
          asm volatile("s_nop 1\n\tv_mfma_scale_f32_16x16x128_f8f6f4 %0, %1, %2, %0, %3, %4 op_sel_hi:[0,0,0]" : "+v"(acc[ai][bj][m][n]) : "v"(_b8), "v"(_a8), "v"(scw), "v"(scx)); } } \
      else { _Pragma("unroll") for (int m = 0; m < 4; ++m) _Pragma("unroll") for (int n = 0; n < 2; ++n) _Pragma("unroll") for (int k = 0; k < 2; ++k) \
        acc[ai][bj][m][n] = __builtin_amdgcn_mfma_f32_16x16x32_bf16(Bt[n][k], At[m][k], acc[ai][bj][m][n], 0, 0, 0); } __builtin_amdgcn_s_setprio(0); } while (0)
#define PG8_WAIT_V(n) asm volatile("s_waitcnt vmcnt(" #n ")" ::: "memory")
#define PG8_WAIT_L(n) asm volatile("s_waitcnt lgkmcnt(" #n ")" ::: "memory")
#define PG8_BAR __builtin_amdgcn_s_barrier()
#define PG8_SCHED __builtin_amdgcn_sched_barrier(0)
    int scw = 0, scx = 0; if constexpr (F8) { scw = Addr::SC_W; scx = Addr::SC_X; } (void)scw; (void)scx;
    Unit cur, nxt; int ui = 0;
    if (!S.next(0, cur)) return;
#ifdef STAG_TICKS
    {
        const unsigned long long t0 = __builtin_amdgcn_s_memrealtime(); const unsigned long long dl = (unsigned long long)(((blockIdx.x >> 3) & 7) * STAG_TICKS);
        while (__builtin_amdgcn_s_memrealtime() - t0 < dl) __builtin_amdgcn_s_sleep(16);
    }
#endif
    f32x4 acc[2][2][4][2];
#pragma unroll
    for (int a = 0; a < 2; ++a)
#pragma unroll
        for (int b = 0; b < 2; ++b)
#pragma unroll
            for (int m = 0; m < 4; ++m)
#pragma unroll
                for (int n = 0; n < 2; ++n) acc[a][b][m][n] = (f32x4){0.f, 0.f, 0.f, 0.f};
    bf16x8 At[4][2], B0[2][2], B1[2][2]; i32x32 AA, BB; (void)At; (void)B0; (void)B1; (void)AA; (void)BB;
    unsigned oc[2][2], on[2][2];
    const char* cA = Abase; const char* nA = Abase;
    if constexpr (Epi::ROWTAB) {
        Unit tu;
        for (int k = 0; k < 16 && S.next(k, tu); ++k)
            for (int r = tid; r < 256; r += 512) ((LAS float*)(lds + STAGE_BYTES + 8192))[k * 256 + r] = E.rowscale(tu, r);
        if constexpr (!Addr::LOADS) __syncthreads();
    }
    if constexpr (Addr::LOADS) {
        {
            Unit tu;
            for (int k = 0; k < 16 && S.next(k, tu); ++k)
                for (int r = tid; r < 256; r += 512) ((LAS unsigned short*)(lds + STAGE_BYTES))[k * 256 + r] = AD.arow_tok(tu, r);
            __syncthreads();
        }
#pragma unroll
        for (int h = 0; h < 2; ++h)
#pragma unroll
            for (int i = 0; i < 2; ++i) { oc[h][i] = AD.arow_lds(lds + STAGE_BYTES, 0, cur, h * HALF + Rr[i]) + Cc[i]; on[h][i] = oc[h][i]; }
        PG8_WAIT_V(0);
    } else { cA = Abase + AD.arow(cur, 0); nA = cA; }
    const char* cB = Bbase + AD.boff(cur);
    PG8_STAGE(PG8_SB(0, 0), cB, voffB); PG8_STAGE_A(PG8_SA(0, 0), 0, 0, false); PG8_STAGE(PG8_SB(0, 1), cB + hstep, voffB); PG8_STAGE_A(PG8_SA(0, 1), 0, 1, false);
    if (wr == 1) PG8_BAR;
    PG8_WAIT_V(4); PG8_BAR;
    PG8_STAGE(PG8_SB(1, 0), cB + kstep, voffB); PG8_STAGE_A(PG8_SA(1, 0), kstep, 0, false); PG8_STAGE(PG8_SB(1, 1), cB + hstep + kstep, voffB);
    PG8_WAIT_V(6); PG8_BAR;
    for (;;) {
        const bool has_next = S.next(ui + 1, nxt);
        if (has_next) {
            if constexpr (Addr::LOADS) {
#pragma unroll
                for (int h = 0; h < 2; ++h)
#pragma unroll
                    for (int i = 0; i < 2; ++i) on[h][i] = AD.arow_lds(lds + STAGE_BYTES, ui + 1, nxt, h * HALF + Rr[i]) + Cc[i];
            } else nA = Abase + AD.arow(nxt, 0);
        } else nA = cA;
        const char* nB = has_next ? Bbase + AD.boff(nxt) : cB;
        if (GP_ON(41)) gp_t1 = GP_T();
#pragma unroll 1
        for (int t = 0; t < nt; t += 2) {
            if (GP_ON(43) && t == 0) gp_t1 = GP_T();
            if (GP_ON(44) && t == 2) gp_t1 = GP_T();
            const bool last = (t == nt - 2);
            const bool un = last && has_next;
            const size_t k1 = (size_t)(t + 1) * kstep;
            const size_t k2 = last ? 0 : (size_t)(t + 2) * kstep, k3 = k2 + kstep;
            const char* b2 = last ? nB : cB + (size_t)(t + 2) * kstep;
            const char* b3 = b2 + kstep;
            PG8_LDB(B0, 0, 0); PG8_SCHED; PG8_LDA(At, 0, 0); PG8_STAGE_A(PG8_SA(1, 1), k1, 1, false);
            PG8_WAIT_L(8); PG8_BAR; PG8_WAIT_L(0); PG8_MMA(0, 0, At, B0); PG8_BAR; PG8_SCHED;
            PG8_LDB(B1, 0, 1); PG8_STAGE(PG8_SB(0, 0), b2, voffB);
            PG8_BAR; PG8_WAIT_L(0); PG8_MMA(0, 1, At, B1); PG8_BAR;
            PG8_LDA(At, 0, 1); PG8_STAGE_A(PG8_SA(0, 0), k2, 0, un);
            PG8_BAR; PG8_WAIT_L(0); PG8_MMA(1, 0, At, B0); PG8_BAR; PG8_SCHED;
            PG8_STAGE(PG8_SB(0, 1), b2 + hstep, voffB);
            PG8_WAIT_V(6); PG8_BAR; PG8_MMA(1, 1, At, B1); PG8_BAR;
            PG8_LDB(B0, 1, 0); PG8_SCHED; PG8_LDA(At, 1, 0); PG8_STAGE_A(PG8_SA(0, 1), k2, 1, un);
            PG8_WAIT_L(8); PG8_BAR; PG8_WAIT_L(0); PG8_MMA(0, 0, At, B0); PG8_BAR; PG8_SCHED;
            PG8_LDB(B1, 1, 1); PG8_STAGE(PG8_SB(1, 0), b3, voffB);
            PG8_BAR; PG8_WAIT_L(0); PG8_MMA(0, 1, At, B1); PG8_BAR;
            PG8_LDA(At, 1, 1); PG8_STAGE_A(PG8_SA(1, 0), k3, 0, un);
            PG8_BAR; PG8_WAIT_L(0); PG8_MMA(1, 0, At, B0); PG8_BAR; PG8_SCHED;
            PG8_STAGE(PG8_SB(1, 1), b3 + hstep, voffB);
            PG8_WAIT_V(6); PG8_BAR; PG8_MMA(1, 1, At, B1); PG8_BAR;
            if (GP_ON(43) && t == 0) gp_acc += GP_T() - gp_t1;
            if (GP_ON(44) && t == 2) gp_acc += GP_T() - gp_t1;
        }
        if (GP_ON(41)) gp_acc += GP_T() - gp_t1;
        if (GP_ON(42)) gp_t1 = GP_T();
        if constexpr (F8) asm volatile("s_nop 15\n\ts_nop 15" ::: "memory");
        E(acc, cur, wr, wc, fr, fq, (const LAS float*)(lds + STAGE_BYTES + 8192) + ui * 256);
        if (GP_ON(42)) gp_acc += GP_T() - gp_t1;
        if (!has_next) break;
#pragma unroll
        for (int a = 0; a < 2; ++a)
#pragma unroll
            for (int b = 0; b < 2; ++b)
#pragma unroll
                for (int m = 0; m < 4; ++m)
#pragma unroll
                    for (int n = 0; n < 2; ++n) acc[a][b][m][n] = (f32x4){0.f, 0.f, 0.f, 0.f};
        cur = nxt; cB = nB; cA = nA; ++ui;
        if constexpr (Addr::LOADS) {
#pragma unroll
            for (int h = 0; h < 2; ++h)
#pragma unroll
                for (int i = 0; i < 2; ++i) oc[h][i] = on[h][i]; }
    }
    PG8_WAIT_V(0);
    if (wr == 0) PG8_BAR;
    PG8_BAR;
    if (TPROBE >= 40 && TPROBE < 50 && Epi::PID == TPGEMM && tid == 0) { gp_tot = GP_T() - gp_t0; atomicAdd((unsigned*)lds_ws_ctl + 512, gp_acc); atomicAdd((unsigned*)lds_ws_ctl + 513, gp_tot); }
#undef PG8_SA
#undef PG8_SB
#undef PG8_STAGE
#undef PG8_STAGE_A
#undef PG8_BSEL_B0
#undef PG8_BSEL_B1
#undef PG8_LDA
#undef PG8_LDB
#undef PG8_MMA
#undef PG8_WAIT_V
#undef PG8_WAIT_L
#undef PG8_BAR
#undef PG8_SCHED
}
}

#ifndef EN_HY
#define EN_HY 1
#endif
#ifndef EN_MA
#define EN_MA 1
#endif
#ifndef EN_AT
#define EN_AT 1
#endif
#ifndef EN_HG
#define EN_HG 1
#endif
#ifndef EN_MOE
#define EN_MOE 1
#endif
#ifndef MOE_F8
#define MOE_F8 1
#endif

DI void transpose_item(const float* W, int ld, int k0, int n0, bf16_t* dst, int drow0, float scale, LAS float* scr, int lane, const float* kw = nullptr) {
    {
        const int rs = lane >> 3, cq = (lane & 7) * 4;
        f32x4 v[8];
#pragma unroll
        for (int i = 0; i < 8; ++i) v[i] = __builtin_nontemporal_load((const f32x4*)(W + (size_t)(k0 + 8 * i + rs) * ld + n0 + cq));
#pragma unroll
        for (int i = 0; i < 8; ++i) { LAS float* d = scr + (8 * i + rs) * 33 + cq; d[0] = v[i].x; d[1] = v[i].y; d[2] = v[i].z; d[3] = v[i].w; }
    }
    LDS_WAIT();
    const int c = lane & 7;
    float sk[8];
#pragma unroll
    for (int i = 0; i < 8; ++i) sk[i] = kw ? scale * kw[k0 + 8 * c + i] : scale;
#pragma unroll
    for (int j = 0; j < 4; ++j) { const int n = (lane >> 3) + 8 * j; const LAS float* s = scr + (8 * c) * 33 + n;
        u32x4 o; o.x = pk2(s[0 * 33] * sk[0], s[1 * 33] * sk[1]); o.y = pk2(s[2 * 33] * sk[2], s[3 * 33] * sk[3]); o.z = pk2(s[4 * 33] * sk[4], s[5 * 33] * sk[5]); o.w = pk2(s[6 * 33] * sk[6], s[7 * 33] * sk[7]);
        *(u32x4*)(dst + (size_t)(drow0 + n) * 1024 + k0 + 8 * c) = o; }
    LDS_WAIT();
}

DI void transpose_item_f8(const float* W, int ld, int k0, int n0, unsigned char* dst, int drow0, float scale, LAS float* scr, int lane) {
    {   const int rs = lane >> 3, cq = (lane & 7) * 4;
        f32x4 v[8];
#pragma unroll
        for (int i = 0; i < 8; ++i) v[i] = __builtin_nontemporal_load((const f32x4*)(W + (size_t)(k0 + 8 * i + rs) * ld + n0 + cq));
#pragma unroll
        for (int i = 0; i < 8; ++i) { LAS float* d = scr + (8 * i + rs) * 33 + cq; d[0] = v[i].x; d[1] = v[i].y; d[2] = v[i].z; d[3] = v[i].w; }
    }
    LDS_WAIT();
    const int c = lane & 7;
#pragma unroll
    for (int j = 0; j < 4; ++j) { const int n = (lane >> 3) + 8 * j; const LAS float* s = scr + (8 * c) * 33 + n;
        u32x2 o; o.x = pk4_fp8(s[0 * 33] * scale, s[1 * 33] * scale, s[2 * 33] * scale, s[3 * 33] * scale); o.y = pk4_fp8(s[4 * 33] * scale, s[5 * 33] * scale, s[6 * 33] * scale, s[7 * 33] * scale);
        *(u32x2*)(dst + (size_t)(drow0 + n) * 1024 + k0 + 8 * c) = o; }
    LDS_WAIT();
}

#define RDL(x, i) __uint_as_float(__builtin_amdgcn_readlane(__float_as_uint(x), (i)))
DI void hyena_filter_pos(const Params& P, int l, int pos, int lane, bf16_t* kfilt) {
    const float TWO_PI = 6.283185307179586f;
    const float tpos = (float)pos * (1.0f / 2047.0f);
    float z = 0.f;
    if (lane == 0) z = tpos;
    else if (lane <= 32) { const int bnd = (lane - 1) & 15; const float f = 1e-4f + (float)bnd * ((15.0f - 1e-4f) / 15.0f);
        const float angp = TWO_PI * (float)pos / 2048.0f; const float ang = angp * f; z = (lane <= 16) ? cosf(ang) : -sinf(ang); }
    const float* w1 = P.hy_w1 + (size_t)l * 33 * 64; const float* w2 = P.hy_w2 + (size_t)l * 64 * 64; const float* w3 = P.hy_w3 + (size_t)l * 64 * 512;
    const float fr = P.hy_freq[l * 64 + lane];
    float a = P.hy_b1[l * 64 + lane];
#pragma unroll 11
    for (int i = 0; i < 33; ++i) a += RDL(z, i) * w1[i * 64 + lane];
    const float h1 = sinf(fr * a);
    float a2 = P.hy_b2[l * 64 + lane];
#pragma unroll 16
    for (int i = 0; i < 64; ++i) a2 += RDL(h1, i) * w2[i * 64 + lane];
    const float h2 = sinf(fr * a2);
    float h3[8];
#pragma unroll
    for (int k = 0; k < 8; ++k) h3[k] = 0.f;
#pragma unroll 8
    for (int i = 0; i < 64; ++i) { const float hv = RDL(h2, i);
#pragma unroll
        for (int k = 0; k < 8; ++k) h3[k] += hv * w3[i * 512 + k * 64 + lane]; }
    const float min_decay = -3.0701134573253944f, max_decay = -15.350567286626972f;
#pragma unroll
    for (int k = 0; k < 8; ++k) { const int cp = k * 64 + lane, c = cp & 255;
        const float delta = fabsf(min_decay + (float)c * ((max_decay - min_decay) / 255.0f));
        float v = h3[k] * expf(-tpos * delta);
        if (cp < 256) { if (pos == 0) { v += P.hy_fbias[l * 256 + c]; kfilt[(size_t)c * 4096 + 4095] = 0; } kfilt[(size_t)c * 4096 + 2047 - pos] = f2bf(v); }
        else if (pos >= 1) kfilt[(size_t)c * 4096 + 2047 + pos] = f2bf(v); }
}
#undef RDL

struct SelRows { int cnt; unsigned o0, o1, o2, o3; };
DI SelRows sel_compact(int sl, int b) {
    SelRows r; r.cnt = 0; r.o0 = r.o1 = r.o2 = r.o3 = 0u;
#pragma unroll
    for (int e = 0; e < 16; ++e) { const int s = __builtin_amdgcn_readlane(sl, e); const bool on = s >= 0; const unsigned v = (unsigned)((b * 16 + e) * 256 + s);
        r.o0 = (on && r.cnt == 0) ? v : r.o0; r.o1 = (on && r.cnt == 1) ? v : r.o1; r.o2 = (on && r.cnt == 2) ? v : r.o2; r.o3 = (on && r.cnt == 3) ? v : r.o3; r.cnt += on ? 1 : 0; }
    return r;
}
typedef float f32x2_ __attribute__((ext_vector_type(2)));
DI void ye_load(const unsigned char* YE, unsigned o, int lane, unsigned (&t)[4]) { const unsigned* yr = (const unsigned*)(YE + (size_t)o * DM) + lane;
#pragma unroll
    for (int j = 0; j < 4; ++j) t[j] = yr[64 * j]; }
DI void ye_add(f32x4 (&v)[4], const unsigned (&t)[4]) {
#pragma unroll
    for (int j = 0; j < 4; ++j) { const f32x2_ a = __builtin_amdgcn_cvt_pk_f32_fp8((int)t[j], false), b = __builtin_amdgcn_cvt_pk_f32_fp8((int)t[j], true);
        v[j].x += a.x * (1.0f / 64.0f); v[j].y += a.y * (1.0f / 64.0f); v[j].z += b.x * (1.0f / 64.0f); v[j].w += b.y * (1.0f / 64.0f); } }
template <bool FINAL>
DI void pre_rows2(const Params& P, int l, const int (&m)[2], int lane, const LAS f32x4* dtw, const float* nw, const int (&slp)[2]) {
    unsigned char* ws = P.ws;
    bf16_t* XB = (bf16_t*)(ws + WS_XB);
    const bool first = (!FINAL && l == 0);
    f32x4 v[2][4];
    if (first) {
#pragma unroll
        for (int k = 0; k < 2; ++k) { const f32x4* xr = (const f32x4*)(P.x + (size_t)m[k] * DM) + lane;
#pragma unroll
            for (int j = 0; j < 4; ++j) v[k][j] = xr[64 * j]; }
    } else {
        u32x2 xh[2][4];
#pragma unroll
        for (int k = 0; k < 2; ++k) { const u32x2* xr = (const u32x2*)(XB + (size_t)m[k] * DM) + lane;
#pragma unroll
            for (int j = 0; j < 4; ++j) xh[k][j] = xr[64 * j]; }
#pragma unroll
        for (int k = 0; k < 2; ++k)
#pragma unroll
            for (int j = 0; j < 4; ++j) v[k][j] = (f32x4){bflo(xh[k][j].x), bfhi(xh[k][j].x), bflo(xh[k][j].y), bfhi(xh[k][j].y)};
    }
    if (!first && EN_MOE) {
        const unsigned char* YE = (const unsigned char*)(ws + WS_YE); const int* slot = (const int*)(ws + WS_SLOT);
        int sl[2]; SelRows sr[2]; (void)slot;
#pragma unroll
        for (int k = 0; k < 2; ++k) sl[k] = slp[k];
#pragma unroll
        for (int k = 0; k < 2; ++k) sr[k] = sel_compact(sl[k], m[k] >> 11);
        unsigned t[2][4][4];
#pragma unroll
        for (int k = 0; k < 2; ++k) { if (sr[k].cnt > 0) ye_load(YE, sr[k].o0, lane, t[k][0]); if (sr[k].cnt > 1) ye_load(YE, sr[k].o1, lane, t[k][1]);
            if (sr[k].cnt > 2) ye_load(YE, sr[k].o2, lane, t[k][2]); if (sr[k].cnt > 3) ye_load(YE, sr[k].o3, lane, t[k][3]); }
#pragma unroll
        for (int k = 0; k < 2; ++k) { if (sr[k].cnt > 0) ye_add(v[k], t[k][0]); if (sr[k].cnt > 1) ye_add(v[k], t[k][1]); if (sr[k].cnt > 2) ye_add(v[k], t[k][2]); if (sr[k].cnt > 3) ye_add(v[k], t[k][3]);
            if (sr[k].cnt > 4) {
                int seen = 0; const int b = m[k] >> 11;
                for (int e = 0; e < 16; ++e) { const int s = __builtin_amdgcn_readlane(sl[k], e);
                    if (s >= 0) { if (seen >= 4) { unsigned tt[4]; ye_load(YE, (unsigned)((b * 16 + e) * 256 + s), lane, tt); ye_add(v[k], tt); } ++seen; } } } }
    }
    float rr[2];
#pragma unroll
    for (int k = 0; k < 2; ++k) {
        float s = 0.f;
#pragma unroll
        for (int j = 0; j < 4; ++j) s += (v[k][j].x * v[k][j].x + v[k][j].y * v[k][j].y) + (v[k][j].z * v[k][j].z + v[k][j].w * v[k][j].w);
        rr[k] = __builtin_amdgcn_rsqf(wave_sum(s) * (1.0f / DM) + EPSN);
    }
    if (FINAL) {
#pragma unroll
        for (int k = 0; k < 2; ++k) { f32x4* o = (f32x4*)(P.out + (size_t)m[k] * DM) + lane;
#pragma unroll
            for (int j = 0; j < 4; ++j) { const f32x4 w = ((const f32x4*)nw)[64 * j + lane]; o[64 * j] = v[k][j] * rr[k] * w; } }
        return;
    }
    {
#pragma unroll
        for (int k = 0; k < 2; ++k) { u32x2* o = (u32x2*)(XB + (size_t)m[k] * DM) + lane;
#pragma unroll
            for (int j = 0; j < 4; ++j) o[64 * j] = (u32x2){pk2(v[k][j].x, v[k][j].y), pk2(v[k][j].z, v[k][j].w)}; } }
    float d[2][8];
#pragma unroll
    for (int k = 0; k < 2; ++k)
#pragma unroll
        for (int c = 0; c < 8; ++c) d[k][c] = 0.f;
#pragma unroll
    for (int j = 0; j < 4; ++j) {
#pragma unroll
        for (int q = 0; q < 4; ++q) { const f32x4 w0 = dtw[((j * 4 + q) * 2 + 0) * 64 + lane], w1 = dtw[((j * 4 + q) * 2 + 1) * 64 + lane];
#pragma unroll
            for (int k = 0; k < 2; ++k) { const float xv = q == 0 ? v[k][j].x : (q == 1 ? v[k][j].y : (q == 2 ? v[k][j].z : v[k][j].w));
                d[k][0] += xv * w0.x; d[k][1] += xv * w0.y; d[k][2] += xv * w0.z; d[k][3] += xv * w0.w; d[k][4] += xv * w1.x; d[k][5] += xv * w1.y; d[k][6] += xv * w1.z; d[k][7] += xv * w1.w; } }
    }
#pragma unroll
    for (int k = 0; k < 2; ++k) {
        float mine = 0.f;
#pragma unroll
        for (int c = 0; c < 8; ++c) { const float t2 = wave_sum(d[k][c]); mine = (lane == c) ? t2 : mine; }
        if (lane < 8) ((float*)(ws + WS_DT))[(size_t)m[k] * 8 + lane] = mine * rr[k];
        if (lane == 8) ((float*)(ws + WS_MSQ))[m[k]] = rr[k];
    }
    (void)nw;
}

DI void phase_pre(const Params& P, int l, LAS unsigned char* lds) {
    const int tid = tid_opaque(P.wv), lane = tid & 63, wave = tid >> 6;
    const int gw = blockIdx.x * 8 + wave, NGW = gridDim.x * 8;
    unsigned char* ws = P.ws;
    LAS float* dtwf = (LAS float*)lds;
    const float* win_ = P.w_in; asm volatile("" : "+s"(win_));
    for (int i = tid; i < 1024 * 8; i += 512) { const int k = i >> 3, c = i & 7; const int j = k >> 8, ln = (k & 255) >> 2, q = k & 3;
        dtwf[((((j * 4 + q) * 2 + (c >> 2)) * 64 + ln) << 2) + (c & 3)] = P.norm_mix_w[l * DM + k] * win_[((size_t)l * DM + k) * NIN_REF + 1536 + c]; }
    __syncthreads();
    if (EN_HY) for (int pos = gw; pos < SEQ; pos += NGW) hyena_filter_pos(P, l, pos, lane, (bf16_t*)(ws + WS_KFILT));
    {
        LAS float* scr = (LAS float*)(lds + 32768 + wave * 8448);
        constexpr int I_A = 16 * 48, I_B = 16 * 64, I_O = 16 * 32, I_E = 16 * 32 * 16;
        constexpr int NITEMS = I_A + I_B + I_O; (void)I_E;
        bf16_t* WinT = (bf16_t*)(ws + WS_WIN); bf16_t* WoutT = (bf16_t*)(ws + WS_WOUT); bf16_t* WguT = (bf16_t*)(ws + WS_WGU); bf16_t* WdT = (bf16_t*)(ws + WS_WD);
        for (int it = gw; it < NITEMS; it += NGW) {
            int r = it;
            if (r < I_A) { const int kb = r / 48, nb = r % 48; transpose_item(P.w_in + (size_t)l * DM * NIN_REF, NIN_REF, 64 * kb, 32 * nb, WinT, 32 * nb, 1.0f, scr, lane, P.norm_mix_w + l * DM); continue; } r -= I_A;
            if (r < I_B) { const int kb = r / 64, nb = r % 64; const int drow = 1536 + 32 * nb; transpose_item(P.w_in + (size_t)l * DM * NIN_REF, NIN_REF, 64 * kb, 1544 + 32 * nb, WinT, drow, drow < PC_AK ? 0.125f * 1.4426950408889634f : 1.0f  , scr, lane, P.norm_mix_w + l * DM); continue; } r -= I_B;
            { const int kb = r / 32, nb = r % 32; transpose_item(P.w_out + (size_t)l * DM * DM, DM, 64 * kb, 32 * nb, WoutT, 32 * nb, 1.0f, scr, lane); }
            (void)WguT; (void)WdT;
        }
    }
    const float* nw = P.norm_mix_w + l * DM;
    {
        const int* slotp = (const int*)(ws + WS_SLOT); const bool comb = (l != 0) && EN_MOE;
        int sln[2] = {0, 0};
        if (comb && gw < NTOK) { sln[0] = slotp[(size_t)gw * 16 + (lane & 15)]; sln[1] = slotp[(size_t)((gw + NGW < NTOK) ? gw + NGW : gw) * 16 + (lane & 15)]; }
        for (int m = gw; m < NTOK; m += 2 * NGW) { asm volatile("" ::: "memory"); const int mm[2] = {m, (m + NGW < NTOK) ? m + NGW : m};
            const int slc[2] = {sln[0], sln[1]}; const int mn = m + 2 * NGW;
            if (comb && mn < NTOK) { sln[0] = slotp[(size_t)mn * 16 + (lane & 15)]; sln[1] = slotp[(size_t)((mn + NGW < NTOK) ? mn + NGW : mn) * 16 + (lane & 15)]; }
            pre_rows2<false>(P, l, mm, lane, (const LAS f32x4*)dtwf, nw, slc); }
    }
}
DI void phase_final(const Params& P) {
    const int tid = tid_opaque(P.wv), lane = tid & 63, wave = tid >> 6;
    const int gw = blockIdx.x * 8 + wave, NGW = gridDim.x * 8;
    {
        const int* slotp = (const int*)(P.ws + WS_SLOT); const bool comb = EN_MOE;
        int sln[2] = {0, 0};
        if (comb && gw < NTOK) { sln[0] = slotp[(size_t)gw * 16 + (lane & 15)]; sln[1] = slotp[(size_t)((gw + NGW < NTOK) ? gw + NGW : gw) * 16 + (lane & 15)]; }
        for (int m = gw; m < NTOK; m += 2 * NGW) { const int mm[2] = {m, (m + NGW < NTOK) ? m + NGW : m};
            const int slc[2] = {sln[0], sln[1]}; const int mn = m + 2 * NGW;
            if (comb && mn < NTOK) { sln[0] = slotp[(size_t)mn * 16 + (lane & 15)]; sln[1] = slotp[(size_t)((mn + NGW < NTOK) ? mn + NGW : mn) * 16 + (lane & 15)]; }
            pre_rows2<true>(P, 1, mm, lane, nullptr, P.final_w, slc); }
    }
}

struct AddrPlain { static constexpr bool LOADS = false; int K; int nb_rows;
    DI unsigned arow(const pg8::Unit& u, int r) const { return (unsigned)(u.pm * 256 + r) * (unsigned)(K * 2); }
    DI size_t boff(const pg8::Unit& u) const { return (size_t)u.pn * 256 * K * 2; } };
DI int moe_panel(int r) { return (r & 31) * 16 + (r >> 5); }
struct AddrGateUp { static constexpr bool LOADS = true; const int* seli;
    DI unsigned arow(const pg8::Unit& u, int r) const { const int b = u.pm & 31; const int t = seli[moe_panel(u.pm) * 256 + r]; return (unsigned)(b * SEQ + t) * (unsigned)(DM * 2); }
    DI unsigned short arow_tok(const pg8::Unit& u, int r) const { return (unsigned short)seli[moe_panel(u.pm) * 256 + r]; }
    DI unsigned arow_lds(const LAS unsigned char* tab, int k, const pg8::Unit& u, int r) const { const int b = u.pm & 31; const int t = ((const LAS unsigned short*)tab)[k * 256 + r]; return (unsigned)(b * SEQ + t) * (unsigned)(DM * 2); }
    DI size_t boff(const pg8::Unit& u) const { return ((size_t)(u.pm >> 5) * 2048 + (size_t)u.pn * 256) * DM * 2; } };
struct AddrGateUp8 { static constexpr bool LOADS = true; static constexpr int SC_W = 0x79797979, SC_X = 0x7f7f7f7f; const int* seli;
    DI unsigned arow(const pg8::Unit& u, int r) const { const int b = u.pm & 31; const int t = seli[moe_panel(u.pm) * 256 + r]; return (unsigned)(b * SEQ + t) * (unsigned)DM; }
    DI unsigned short arow_tok(const pg8::Unit& u, int r) const { return (unsigned short)seli[moe_panel(u.pm) * 256 + r]; }
    DI unsigned arow_lds(const LAS unsigned char* tab, int k, const pg8::Unit& u, int r) const { const int b = u.pm & 31; const int t = ((const LAS unsigned short*)tab)[k * 256 + r]; return (unsigned)(b * SEQ + t) * (unsigned)DM; }
    DI size_t boff(const pg8::Unit& u) const { return ((size_t)(u.pm >> 5) * 2048 + (size_t)u.pn * 256) * DM; } };
struct AddrDown8 { static constexpr bool LOADS = false; static constexpr int SC_W = 0x79797979, SC_X = 0x7c7c7c7c;
    DI unsigned arow(const pg8::Unit& u, int r) const { return (unsigned)(moe_panel(u.pm) * 256 + r) * (unsigned)DM; }
    DI size_t boff(const pg8::Unit& u) const { return ((size_t)(u.pm >> 5) * 1024 + (size_t)u.pn * 256) * DM; } };
struct AddrDown { static constexpr bool LOADS = false;
    DI unsigned arow(const pg8::Unit& u, int r) const { return (unsigned)(moe_panel(u.pm) * 256 + r) * (unsigned)(DM * 2); }
    DI size_t boff(const pg8::Unit& u) const { return ((size_t)(u.pm >> 5) * 1024 + (size_t)u.pn * 256) * DM * 2; } };

struct EpiProj { static constexpr int PID = 1; static constexpr bool PERM = true, ROWTAB = true; bf16_t* O; const float* rsm;
    DI float rowscale(const pg8::Unit& u, int r) const { return rsm[u.pm * 256 + r]; }
    DI void operator()(const f32x4 (&acc)[2][2][4][2], const pg8::Unit& u, int wr, int wc, int fr, int fq, const LAS float* rtab) const {
        const int row0 = u.pm * 256 + wr * 64 + fr, col0 = u.pn * 256 + wc * 32 + 8 * fq;
#pragma unroll
        for (int ai = 0; ai < 2; ++ai)
#pragma unroll
            for (int m = 0; m < 4; ++m) { bf16_t* rowp = O + (size_t)(row0 + ai * 128 + m * 16) * NPROJ + col0; const float g = rtab[wr * 64 + fr + ai * 128 + m * 16];
#pragma unroll
                for (int bj = 0; bj < 2; ++bj) { const f32x4 v0 = acc[ai][bj][m][0] * g, v1 = acc[ai][bj][m][1] * g;
                    u32x4 w; w.x = pk2(v0[0], v0[1]); w.y = pk2(v0[2], v0[3]); w.z = pk2(v1[0], v1[1]); w.w = pk2(v1[2], v1[3]);
                    *(u32x4*)(rowp + bj * 128) = w; } }
    } };
struct EpiRes { static constexpr int PID = 5; static constexpr bool PERM = true, ROWTAB = false; const float* base32; const bf16_t* base16; bf16_t* out;
    DI void operator()(const f32x4 (&acc)[2][2][4][2], const pg8::Unit& u, int wr, int wc, int fr, int fq, const LAS float* rtab) const {
        const int row0 = u.pm * 256 + wr * 64 + fr, col0 = u.pn * 256 + wc * 32 + 8 * fq;
#pragma unroll
        for (int ai = 0; ai < 2; ++ai)
#pragma unroll
            for (int m = 0; m < 4; ++m) { const size_t off = (size_t)(row0 + ai * 128 + m * 16) * DM + col0;
#pragma unroll
                for (int bj = 0; bj < 2; ++bj) { f32x4 v0 = acc[ai][bj][m][0], v1 = acc[ai][bj][m][1];
                    if (base32) { v0 = v0 + *(const f32x4*)(base32 + off + bj * 128); v1 = v1 + *(const f32x4*)(base32 + off + bj * 128 + 4); }
                    else { const u32x4 bs = *(const u32x4*)(base16 + off + bj * 128);
                        v0 = v0 + (f32x4){bflo(bs.x), bfhi(bs.x), bflo(bs.y), bfhi(bs.y)}; v1 = v1 + (f32x4){bflo(bs.z), bfhi(bs.z), bflo(bs.w), bfhi(bs.w)}; }
                    u32x4 w; w.x = pk2(v0[0], v0[1]); w.y = pk2(v0[2], v0[3]); w.z = pk2(v1[0], v1[1]); w.w = pk2(v1[2], v1[3]);
                    *(u32x4*)(out + off + bj * 128) = w; } }
    } };
struct EpiGateUp { static constexpr int PID = 18; static constexpr bool PERM = true, ROWTAB = true; bf16_t* H; const float* selr;
    DI float rowscale(const pg8::Unit& u, int r) const { return selr[moe_panel(u.pm) * 256 + r]; }
    DI void operator()(const f32x4 (&acc)[2][2][4][2], const pg8::Unit& u, int wr, int wc, int fr, int fq, const LAS float* rtab) const {
        const int row0 = moe_panel(u.pm) * 256 + wr * 64 + fr, col0 = u.pn * 128 + wc * 32 + 8 * fq;
#pragma unroll
        for (int ai = 0; ai < 2; ++ai)
#pragma unroll
            for (int m = 0; m < 4; ++m) { bf16_t* rowp = H + (size_t)(row0 + ai * 128 + m * 16) * DM + col0; const float rr = rtab[wr * 64 + fr + ai * 128 + m * 16];
                float hv[8];
#pragma unroll
                for (int n = 0; n < 2; ++n)
#pragma unroll
                    for (int j = 0; j < 4; ++j) { const float g = acc[ai][0][m][n][j] * rr, up = acc[ai][1][m][n][j] * rr; hv[n * 4 + j] = silu_f(g) * up; }
                u32x4 w; w.x = pk2(hv[0], hv[1]); w.y = pk2(hv[2], hv[3]); w.z = pk2(hv[4], hv[5]); w.w = pk2(hv[6], hv[7]);
                *(u32x4*)rowp = w; }
    } };
struct EpiGateUp8 { static constexpr int PID = 8; static constexpr bool PERM = true, ROWTAB = true; unsigned char* H; const float* selr;
    DI float rowscale(const pg8::Unit& u, int r) const { return selr[moe_panel(u.pm) * 256 + r]; }
    DI void operator()(const f32x4 (&acc)[2][2][4][2], const pg8::Unit& u, int wr, int wc, int fr, int fq, const LAS float* rtab) const {
        const int row0 = moe_panel(u.pm) * 256 + wr * 64 + fr, col0 = u.pn * 128 + wc * 32 + 8 * fq;
#pragma unroll
        for (int ai = 0; ai < 2; ++ai)
#pragma unroll
            for (int m = 0; m < 4; ++m) { unsigned char* rowp = H + (size_t)(row0 + ai * 128 + m * 16) * DM + col0; const float rr = rtab[wr * 64 + fr + ai * 128 + m * 16]; const float c1 = -1.4426950408889634f * rr, k2 = 8.0f * rr * rr;
                float hv[8];
#pragma unroll
                for (int n = 0; n < 2; ++n)
#pragma unroll
                    for (int j = 0; j < 4; ++j) { const float g = acc[ai][0][m][n][j], up = acc[ai][1][m][n][j];
                        hv[n * 4 + j] = (g * up) * (k2 * __builtin_amdgcn_rcpf(1.0f + __builtin_amdgcn_exp2f(g * c1))); }
                *(u32x2*)rowp = (u32x2){pk4_fp8(hv[0], hv[1], hv[2], hv[3]), pk4_fp8(hv[4], hv[5], hv[6], hv[7])}; }
    } };
struct EpiDown { static constexpr int PID = 9; static constexpr bool PERM = true, ROWTAB = true; unsigned char* Y; const float* gate;
    DI float rowscale(const pg8::Unit& u, int r) const { return gate[moe_panel(u.pm) * 256 + r]; }
    DI void operator()(const f32x4 (&acc)[2][2][4][2], const pg8::Unit& u, int wr, int wc, int fr, int fq, const LAS float* rtab) const {
        const int row0 = moe_panel(u.pm) * 256 + wr * 64 + fr, col0 = u.pn * 256 + wc * 32 + 8 * fq;
#pragma unroll
        for (int ai = 0; ai < 2; ++ai)
#pragma unroll
            for (int m = 0; m < 4; ++m) { const int row = row0 + ai * 128 + m * 16; const float g = rtab[wr * 64 + fr + ai * 128 + m * 16] * 64.0f; unsigned char* rowp = Y + (size_t)row * DM + col0;
#pragma unroll
                for (int bj = 0; bj < 2; ++bj) { const f32x4 v0 = acc[ai][bj][m][0] * g, v1 = acc[ai][bj][m][1] * g;
                    *(u32x2*)(rowp + bj * 128) = (u32x2){pk4_fp8(v0[0], v0[1], v0[2], v0[3]), pk4_fp8(v1[0], v1[1], v1[2], v1[3])}; } }
    } };

DI void phase_premix(const Params& P, int l, LAS unsigned char* lds) {
    const int tid = tid_opaque(P.wv), lane = tid & 63, wave = tid >> 6;
    const int gw = blockIdx.x * 8 + wave, NGW = gridDim.x * 8;
    unsigned char* ws = P.ws;
    const bf16_t* proj = (const bf16_t*)(ws + WS_PROJ);
    unsigned char* dsc = (unsigned char*)P.out;
    if (EN_HY) {
        bf16_t* HW = (bf16_t*)(dsc + DO_HW); bf16_t* HX0 = (bf16_t*)(dsc + DO_HX0);
        const float* cw = P.hy_conv_w + (size_t)l * 3 * 768;
        LAS unsigned char* tl = lds + wave * 15616;
        const int rsub = lane >> 3, cch = lane & 7;
        const int i16 = lane & 15, trq = i16 >> 2, trp = i16 & 3, g16 = lane >> 4;
        const unsigned troff = (unsigned)(trq * 144 + (16 * g16 + 4 * trp) * 2);
        u32x4 rin[5][3];
#define HYPM_LOAD(IT) do { const int ct_ = (IT) & 3, tt_ = ((IT) >> 2) & 63, b_ = (IT) >> 8; const int t0_ = tt_ * 32; \
            const bf16_t* pr_ = proj + ((size_t)b_ * SEQ) * NPROJ + ct_ * 64 + 8 * cch; \
            _Pragma("unroll") for (int i = 0; i < 5; ++i) { const int rr = rsub + 8 * i; const int t = t0_ - 1 + rr; const bool ok = (rr < 34) && (t >= 0) && (t < SEQ); \
                const bf16_t* q = pr_ + (size_t)(ok ? t : 0) * NPROJ; \
                _Pragma("unroll") for (int a = 0; a < 3; ++a) { rin[i][a] = *(const u32x4*)(q + 256 * a); if (!ok) rin[i][a] = (u32x4){0u, 0u, 0u, 0u}; } } } while (0)
        if (gw < NB * 64 * 4) HYPM_LOAD(gw);
        for (int it = gw; it < NB * 64 * 4; it += NGW) {
            const int ct = it & 3, tt = (it >> 2) & 63, b = it >> 8;
            const int c = ct * 64 + lane, t0 = tt * 32;
#pragma unroll
            for (int i = 0; i < 5; ++i) { const int rr = rsub + 8 * i;
#pragma unroll
                for (int a = 0; a < 3; ++a) if (rr < 36) *(LAS u32x4*)(tl + a * 5184 + rr * 144 + 16 * cch) = rin[i][a]; }
            if (it + NGW < NB * 64 * 4) HYPM_LOAD(it + NGW);
            float w0[3], w1[3], w2[3];
#pragma unroll
            for (int j = 0; j < 3; ++j) { w0[j] = cw[j * 768 + c]; w1[j] = cw[j * 768 + 256 + c]; w2[j] = cw[j * 768 + 512 + c]; }
            LDS_WAIT();
            float p0[4], p1[4], p2[4];
            unsigned hwv[16], hxv[16];
#pragma unroll
            for (int j = 0; j < 9; ++j) {
                const s16x4 r0 = __builtin_amdgcn_ds_read_tr16_b64_v4i16((LAS s16x4*)(tl + 0 * 5184 + troff + (4 * j) * 144));
                const s16x4 r1 = __builtin_amdgcn_ds_read_tr16_b64_v4i16((LAS s16x4*)(tl + 1 * 5184 + troff + (4 * j) * 144));
                const s16x4 r2 = __builtin_amdgcn_ds_read_tr16_b64_v4i16((LAS s16x4*)(tl + 2 * 5184 + troff + (4 * j) * 144));
                float c0[4], c1[4], c2[4];
#pragma unroll
                for (int k = 0; k < 4; ++k) { c0[k] = bf2f((unsigned short)r0[k]); c1[k] = bf2f((unsigned short)r1[k]); c2[k] = bf2f((unsigned short)r2[k]); }
                if (j > 0) {
                    float u0[4], hv[4];
#pragma unroll
                    for (int k = 0; k < 4; ++k) { const float a0 = p0[k], a1 = p1[k], a2 = p2[k];
                        const float b0 = (k < 3) ? p0[k + 1] : c0[0], b1 = (k < 3) ? p1[k + 1] : c1[0], b2 = (k < 3) ? p2[k + 1] : c2[0];
                        const float d0 = (k < 2) ? p0[k + 2] : c0[k - 2], d1 = (k < 2) ? p1[k + 2] : c1[k - 2], d2 = (k < 2) ? p2[k + 2] : c2[k - 2];
                        u0[k] = w0[0] * a0 + w0[1] * b0 + w0[2] * d0;
                        hv[k] = (w2[0] * a2 + w2[1] * b2 + w2[2] * d2) * (w1[0] * a1 + w1[1] * b1 + w1[2] * d1); }
                    hwv[2 * (j - 1)] = pk2(hv[0], hv[1]); hwv[2 * (j - 1) + 1] = pk2(hv[2], hv[3]); hxv[2 * (j - 1)] = pk2(u0[0], u0[1]); hxv[2 * (j - 1) + 1] = pk2(u0[2], u0[3]);
                }
#pragma unroll
                for (int k = 0; k < 4; ++k) { p0[k] = c0[k]; p1[k] = c1[k]; p2[k] = c2[k]; }
            }
            bf16_t* hwp = HW + ((size_t)c * NB + b) * SEQ + t0; bf16_t* hxp = HX0 + ((size_t)c * NB + b) * SEQ + t0;
#pragma unroll
            for (int k = 0; k < 4; ++k) { *(u32x4*)(hwp + 8 * k) = (u32x4){hwv[4 * k], hwv[4 * k + 1], hwv[4 * k + 2], hwv[4 * k + 3]}; *(u32x4*)(hxp + 8 * k) = (u32x4){hxv[4 * k], hxv[4 * k + 1], hxv[4 * k + 2], hxv[4 * k + 3]}; }
            LDS_WAIT();
        }
    }
    if (EN_MA) {
        bf16_t* MX = (bf16_t*)(dsc + DO_MXBC);
        const float* cw = P.m_conv_w + (size_t)l * 5 * 512; const float* cb = P.m_conv_b + (size_t)l * 512;
        const int gt = blockIdx.x * 512 + tid, NGT = gridDim.x * 512;
        for (int it = gt; it < (NTOK / 4) * 64; it += NGT) {
            const int ch = (it & 63) * 8, m0 = (it >> 6) * 4, t0 = m0 & (SEQ - 1);
            u32x4 rw[8];
#pragma unroll
            for (int j = 0; j < 8; ++j) { const int tt = t0 + j - 2; const bool ok = (tt >= 0) && (tt < SEQ);
                rw[j] = *(const u32x4*)(proj + (size_t)(ok ? m0 + j - 2 : m0) * NPROJ + PC_MX + ch); if (!ok) rw[j] = (u32x4){0u, 0u, 0u, 0u}; }
            f32x4 wa[5], wb[5];
#pragma unroll
            for (int j = 0; j < 5; ++j) { wa[j] = *(const f32x4*)(cw + j * 512 + ch); wb[j] = *(const f32x4*)(cw + j * 512 + ch + 4); }
            const f32x4 ba = *(const f32x4*)(cb + ch), bb = *(const f32x4*)(cb + ch + 4);
#pragma unroll
            for (int k = 0; k < 4; ++k) {
                float a[8] = {ba.x, ba.y, ba.z, ba.w, bb.x, bb.y, bb.z, bb.w};
#pragma unroll
                for (int j = 0; j < 5; ++j) { const u32x4 v = rw[k + j];
                    a[0] += wa[j].x * bflo(v.x); a[1] += wa[j].y * bfhi(v.x); a[2] += wa[j].z * bflo(v.y); a[3] += wa[j].w * bfhi(v.y);
                    a[4] += wb[j].x * bflo(v.z); a[5] += wb[j].y * bfhi(v.z); a[6] += wb[j].z * bflo(v.w); a[7] += wb[j].w * bfhi(v.w); }
                u32x4 o; o.x = pk2(silu_f(a[0]), silu_f(a[1])); o.y = pk2(silu_f(a[2]), silu_f(a[3])); o.z = pk2(silu_f(a[4]), silu_f(a[5])); o.w = pk2(silu_f(a[6]), silu_f(a[7]));
                *(u32x4*)(MX + (size_t)(m0 + k) * 512 + ch) = o;
            }
        }
    }
}

DI void phase_finalize(const Params& P, int l) {
    const int tid = tid_opaque(P.wv), lane = tid & 63, wave = tid >> 6;
    const int gw = blockIdx.x * 8 + wave, NGW = gridDim.x * 8;
    unsigned char* ws = P.ws; unsigned char* dsc = (unsigned char*)P.out;
    bf16_t* MIX = (bf16_t*)(ws + WS_HN);
    {
        const bf16_t* YAT = (const bf16_t*)(dsc + DO_YAT);
        for (int it = gw; it < NB * 32 * 4; it += NGW) {
            const int ct = it & 3, tt = (it >> 2) & 31, b = it >> 7;
            const int c = ct * 64 + lane, t0 = tt * 64;
            const bf16_t* src = YAT + ((size_t)c * NB + b) * SEQ + t0;
            bf16_t* dst = MIX + ((size_t)b * SEQ + t0) * DM + c;
#pragma unroll 2
            for (int t8 = 0; t8 < 64; t8 += 8) {
                u32x4 v = EN_HY ? *(const u32x4*)(src + t8) : (u32x4){0u, 0u, 0u, 0u};
                const unsigned w[4] = {v.x, v.y, v.z, v.w};
#pragma unroll
                for (int i = 0; i < 8; ++i) dst[(size_t)(t8 + i) * DM] = (bf16_t)((i & 1) ? (w[i >> 1] >> 16) : (w[i >> 1] & 0xffffu));
            }
        }
    }
    {
        const bf16_t* MYF = (const bf16_t*)(dsc + DO_MY); const bf16_t* MYB = (const bf16_t*)(ws + WS_MYB); const bf16_t* MX = (const bf16_t*)(dsc + DO_MXBC);
        const bf16_t* OB = (const bf16_t*)(ws + WS_OB); const bf16_t* proj = (const bf16_t*)(ws + WS_PROJ);
        const float* nwm = P.m_norm_w + l * 256; const float* nwh = P.hg_norm_w + l * 64;
        const int gt = blockIdx.x * 512 + tid, NGT = gridDim.x * 512;
        for (int it = gt; it < NTOK * 32; it += NGT) {
            const int ch = (it & 31) * 8, m = it >> 5;
            const u32x4 yf = *(const u32x4*)(MYF + (size_t)m * 256 + ch), yb = *(const u32x4*)(MYB + (size_t)m * 256 + ch), xv = *(const u32x4*)(MX + (size_t)m * 512 + ch), zv = *(const u32x4*)(proj + (size_t)m * NPROJ + PC_MZ + ch);
            const u32x4 of = *(const u32x4*)(MIX + (size_t)m * DM + 768 + ch), ob = *(const u32x4*)(OB + (size_t)m * 256 + ch), gv = *(const u32x4*)(proj + (size_t)m * NPROJ + PC_HG + ch);
            u32x4 o = {0u, 0u, 0u, 0u};
            if (EN_MA) {
                const float Dk = P.m_D[l * 4 + (ch >> 6)];
                const unsigned yfw[4] = {yf.x, yf.y, yf.z, yf.w}, ybw[4] = {yb.x, yb.y, yb.z, yb.w}, xw[4] = {xv.x, xv.y, xv.z, xv.w}, zw[4] = {zv.x, zv.y, zv.z, zv.w};
                float y[8]; float sq = 0.f;
#pragma unroll
                for (int j = 0; j < 4; ++j) { y[2 * j] = (bflo(yfw[j]) + bflo(ybw[j]) + Dk * bflo(xw[j])) * silu_f(bflo(zw[j])); y[2 * j + 1] = (bfhi(yfw[j]) + bfhi(ybw[j]) + Dk * bfhi(xw[j])) * silu_f(bfhi(zw[j]));
                    sq += y[2 * j] * y[2 * j] + y[2 * j + 1] * y[2 * j + 1]; }
                sq = x16_sum(row_sum16(sq));
                const float r = __builtin_amdgcn_rsqf(sq * (1.0f / 256.0f) + EPSN);
                const f32x4 wa = *(const f32x4*)(nwm + ch), wb = *(const f32x4*)(nwm + ch + 4);
                o.x = pk2(y[0] * r * wa.x, y[1] * r * wa.y); o.y = pk2(y[2] * r * wa.z, y[3] * r * wa.w); o.z = pk2(y[4] * r * wb.x, y[5] * r * wb.y); o.w = pk2(y[6] * r * wb.z, y[7] * r * wb.w);
            }
            *(u32x4*)(MIX + (size_t)m * DM + 256 + ch) = o;
            if (EN_HG) {
                const unsigned ofw[4] = {of.x, of.y, of.z, of.w}, obw[4] = {ob.x, ob.y, ob.z, ob.w}, gw4[4] = {gv.x, gv.y, gv.z, gv.w};
                float y[8]; float sq = 0.f;
#pragma unroll
                for (int j = 0; j < 4; ++j) { y[2 * j] = bflo(ofw[j]) + bflo(obw[j]); y[2 * j + 1] = bfhi(ofw[j]) + bfhi(obw[j]); sq += y[2 * j] * y[2 * j] + y[2 * j + 1] * y[2 * j + 1]; }
                sq = grp_sum8(sq);
                const float r = __builtin_amdgcn_rsqf(sq * (1.0f / 64.0f) + EPSN);
                const f32x4 wa = *(const f32x4*)(nwh + (ch & 63)), wb = *(const f32x4*)(nwh + (ch & 63) + 4);
                u32x4 oh;
                oh.x = pk2(y[0] * r * wa.x * silu_f(bflo(gw4[0])), y[1] * r * wa.y * silu_f(bfhi(gw4[0]))); oh.y = pk2(y[2] * r * wa.z * silu_f(bflo(gw4[1])), y[3] * r * wa.w * silu_f(bfhi(gw4[1])));
                oh.z = pk2(y[4] * r * wb.x * silu_f(bflo(gw4[2])), y[5] * r * wb.y * silu_f(bfhi(gw4[2]))); oh.w = pk2(y[6] * r * wb.z * silu_f(bflo(gw4[3])), y[7] * r * wb.w * silu_f(bfhi(gw4[3])));
                *(u32x4*)(MIX + (size_t)m * DM + 768 + ch) = oh;
            }
        }
    }
#if !EN_AT || !EN_HG
    {
        const int gt = blockIdx.x * 512 + tid, NGT = gridDim.x * 512;
        for (int it = gt; it < NTOK * 32; it += NGT) { const int ch = (it & 31) * 8, m = it >> 5;
            if (!EN_AT) *(u32x4*)(MIX + (size_t)m * DM + 512 + ch) = (u32x4){0u, 0u, 0u, 0u};
            if (!EN_HG) *(u32x4*)(MIX + (size_t)m * DM + 768 + ch) = (u32x4){0u, 0u, 0u, 0u}; }
    }
#endif
}

DI void phase_ffnpre(const Params& P, int l, LAS unsigned char* lds) {
    const int tid = tid_opaque(P.wv), lane = tid & 63, wave = tid >> 6, r = lane & 15, q = lane >> 4;
    const int gw = blockIdx.x * 8 + wave, NGW = gridDim.x * 8;
    unsigned char* ws = P.ws;
    LAS u32x4* Wh = (LAS u32x4*)lds;
    LAS u32x4* Wl = Wh + 32 * 64;
    for (int i = tid; i < 32 * 64; i += 512) { const int s = i >> 6, ln = i & 63, e = ln & 15, qq = ln >> 4; float wv[8]; unsigned hi[4], lo[4];
#pragma unroll
        for (int j = 0; j < 8; ++j) { const int k = 32 * s + 8 * qq + j; wv[j] = P.norm_ffn_w[l * DM + k] * P.router_w[((size_t)l * DM + k) * 16 + e]; }
#pragma unroll
        for (int j = 0; j < 4; ++j) { hi[j] = pk2(wv[2 * j], wv[2 * j + 1]); lo[j] = pk2(wv[2 * j] - bflo(hi[j]), wv[2 * j + 1] - bfhi(hi[j])); }
        Wh[i] = (u32x4){hi[0], hi[1], hi[2], hi[3]}; Wl[i] = (u32x4){lo[0], lo[1], lo[2], lo[3]}; }
    __syncthreads();
    const bf16_t* XB = (const bf16_t*)(ws + WS_XB); const float* nw = P.norm_ffn_w + l * DM + 8 * q;
    float* aff = (float*)(ws + WS_AFF); float* rs = (float*)(ws + WS_RS);
    bf16_t* XN = (bf16_t*)(ws + WS_HN);
    for (int grp = gw; grp < NTOK / 16; grp += NGW) {
        const int m0 = grp * 16;
        const bf16_t* xrow = XB + (size_t)(m0 + r) * DM + 8 * q; bf16_t* orow = XN + (size_t)(m0 + r) * DM + 8 * q; unsigned char* orow8 = (unsigned char*)XN + (size_t)(m0 + r) * DM + 8 * q; (void)orow; (void)orow8;
        f32x4 acc = {0.f, 0.f, 0.f, 0.f}; float ss = 0.f;
#pragma unroll 8
        for (int s = 0; s < 32; ++s) {
            const u32x4 xv = *(const u32x4*)(xrow + 32 * s);
            const f32x4 a = {bflo(xv.x), bfhi(xv.x), bflo(xv.y), bfhi(xv.y)}, b = {bflo(xv.z), bfhi(xv.z), bflo(xv.w), bfhi(xv.w)};
            const f32x4 wa = *(const f32x4*)(nw + 32 * s), wb = *(const f32x4*)(nw + 32 * s + 4);
            ss += (a.x * a.x + a.y * a.y) + (a.z * a.z + a.w * a.w) + (b.x * b.x + b.y * b.y) + (b.z * b.z + b.w * b.w);
            const bf16x8 ah = __builtin_bit_cast(bf16x8, xv);
            const bf16x8 wh = __builtin_bit_cast(bf16x8, Wh[s * 64 + lane]), wl = __builtin_bit_cast(bf16x8, Wl[s * 64 + lane]);
            acc = __builtin_amdgcn_mfma_f32_16x16x32_bf16(ah, wh, acc, 0, 0, 0);
            acc = __builtin_amdgcn_mfma_f32_16x16x32_bf16(ah, wl, acc, 0, 0, 0);
#if MOE_F8
            *(u32x2*)(orow8 + 32 * s) = (u32x2){pk4_fp8(a.x * wa.x, a.y * wa.y, a.z * wa.z, a.w * wa.w), pk4_fp8(b.x * wb.x, b.y * wb.y, b.z * wb.z, b.w * wb.w)};
#else
            *(u32x4*)(orow + 32 * s) = (u32x4){pk2(a.x * wa.x, a.y * wa.y), pk2(a.z * wa.z, a.w * wa.w), pk2(b.x * wb.x, b.y * wb.y), pk2(b.z * wb.z, b.w * wb.w)};
#endif
        }
        ss = xhalf_sum(x16_sum(ss));
        const float rinv = __builtin_amdgcn_rsqf(ss * (1.0f / DM) + EPSN);
        if (q == 0) rs[m0 + r] = rinv;
#pragma unroll
        for (int i = 0; i < 4; ++i) {
            const float lg = acc[i] * __shfl(rinv, 4 * q + i);
            const float mx = grp_max16(lg);
            const float ex = expf(lg - mx); const float se = row_sum16(ex);
            const int m = m0 + 4 * q + i;
            aff[((size_t)(m >> 11) * 16 + r) * SEQ + (m & (SEQ - 1))] = ex / se;
        }
    }
}

DI int wave_sum_i(int v) {
#pragma unroll
    for (int o = 1; o < 64; o <<= 1) v += __shfl_xor(v, o);
    return v;
}
DI int half_excl_scan(int c, int lane, int hw, LAS int* ws4, int* tot) {
    int inc = c;
#pragma unroll
    for (int o = 1; o < 64; o <<= 1) { const int t = __shfl_up(inc, o); if (lane >= o) inc += t; }
    if (lane == 63) ws4[hw] = inc;
    __syncthreads();
    int base = 0, total = 0;
#pragma unroll
    for (int w = 0; w < 4; ++w) { const int t = ws4[w]; base += (w < hw) ? t : 0; total += t; }
    *tot = total;
    return base + inc - c;
}
DI void phase_topk(const Params& P, int l, LAS unsigned char* lds) {
    const int tid = tid_opaque(P.wv), lane = tid & 63, wave = tid >> 6;
    unsigned char* ws = P.ws;
    const float* aff = (const float*)(ws + WS_AFF); const float* rs = (const float*)(ws + WS_RS);
    int* slot = (int*)(ws + WS_SLOT); int* seli = (int*)(ws + WS_SELI); float* selg = (float*)(ws + WS_SELG); float* selr = (float*)(ws + WS_SELR);
    const int half = wave >> 2, hw = wave & 3, ht = tid & 255;
    LAS int* wsum = (LAS int*)lds + half * 64;
    for (int u0 = blockIdx.x; u0 < NB * NEXP; u0 += 2 * gridDim.x) {
        const int u = u0 + half * gridDim.x; const bool live = u < NB * NEXP; const int uu = live ? u : u0;
        const int b = uu >> 4, e = uu & 15;
        __syncthreads();
        const u32x4 ka = *(const u32x4*)(aff + (size_t)uu * SEQ + 8 * ht), kb = *(const u32x4*)(aff + (size_t)uu * SEQ + 8 * ht + 4);
        const unsigned kk[8] = {ka.x, ka.y, ka.z, ka.w, kb.x, kb.y, kb.z, kb.w};
        const f32x4 ra = *(const f32x4*)(rs + (size_t)b * SEQ + 8 * ht), rb = *(const f32x4*)(rs + (size_t)b * SEQ + 8 * ht + 4);
        const float rsv[8] = {ra.x, ra.y, ra.z, ra.w, rb.x, rb.y, rb.z, rb.w};
        unsigned prefix = 0u;
#pragma unroll 1
        for (int bit = 30; bit >= 0; bit -= (bit == 30 ? 1 : 2)) {
            const unsigned hi = 1u << bit, lo = (bit == 30) ? 0u : (1u << (bit - 1));
            const unsigned c1 = prefix | hi, c0 = prefix | lo, c3 = prefix | hi | lo;
            int n1 = 0, n0 = 0, n3 = 0;
#pragma unroll
            for (int j = 0; j < 8; ++j) { n1 += __builtin_popcountll(__ballot(kk[j] >= c1)); n0 += __builtin_popcountll(__ballot(kk[j] >= c0)); n3 += __builtin_popcountll(__ballot(kk[j] >= c3)); }
            const int par = (bit & 2) ? 12 : 0;
            if (lane == 0) { wsum[par + hw * 3] = n1; wsum[par + hw * 3 + 1] = n0; wsum[par + hw * 3 + 2] = n3; }
            __syncthreads();
            int t1 = 0, t0 = 0, t3 = 0;
#pragma unroll
            for (int q = 0; q < 4; ++q) { t1 += wsum[par + q * 3]; t0 += wsum[par + q * 3 + 1]; t3 += wsum[par + q * 3 + 2]; }
            if (bit == 30) { if (t1 >= CAP) prefix = c1; }
            else if (t1 >= CAP) prefix = (t3 >= CAP) ? c3 : c1;
            else if (t0 >= CAP) prefix = c0;
        }
        const unsigned thr = prefix;
        int cgt = 0, ceq = 0;
#pragma unroll
        for (int j = 0; j < 8; ++j) { cgt += (kk[j] > thr) ? 1 : 0; ceq += (kk[j] == thr) ? 1 : 0; }
        int ngt; (void)half_excl_scan(cgt, lane, hw, wsum + 32, &ngt);
        const int need = CAP - ngt;
        int neq; int eqr = half_excl_scan(ceq, lane, hw, wsum + 36, &neq);
        bool sel[8]; int cs = 0;
#pragma unroll
        for (int j = 0; j < 8; ++j) { const bool eq = kk[j] == thr; sel[j] = (kk[j] > thr) || (eq && eqr < need); eqr += eq ? 1 : 0; cs += sel[j] ? 1 : 0; }
        int nsel; int sb = half_excl_scan(cs, lane, hw, wsum + 40, &nsel);
        if (live) {
#pragma unroll
            for (int j = 0; j < 8; ++j) { const int i = 8 * ht + j;
                slot[((size_t)b * SEQ + i) * 16 + e] = sel[j] ? sb : -1;
                if (sel[j]) { seli[u * CAP + sb] = i; selg[u * CAP + sb] = __uint_as_float(kk[j]); selr[u * CAP + sb] = rsv[j]; ++sb; } }
        }
    }
    __syncthreads();
    {
        const int gw = blockIdx.x * 8 + wave, NGW = gridDim.x * 8;
        LAS float* scr = (LAS float*)(lds + 4096 + wave * 8448);
        bf16_t* WguT = (bf16_t*)(ws + WS_WGU); bf16_t* WdT = (bf16_t*)(ws + WS_WD);
        constexpr int I_E = 16 * 32 * 16;
        for (int it = gw; it < 3 * I_E; it += NGW) {
            const int which = it / I_E; const int r = it - which * I_E;
            const int e = r / 512, kb = (r % 512) / 32, nb = r % 32;
            const size_t wofs = ((size_t)l * NEXP + e) * DM * DM;
#if MOE_F8
            if (which == 0)      transpose_item_f8(P.moe_wg + wofs, DM, 64 * kb, 32 * nb, (unsigned char*)WguT, e * 2048 + ((32 * nb) >> 7) * 256 + ((32 * nb) & 127), 64.0f, scr, lane);
            else if (which == 1) transpose_item_f8(P.moe_wu + wofs, DM, 64 * kb, 32 * nb, (unsigned char*)WguT, e * 2048 + ((32 * nb) >> 7) * 256 + 128 + ((32 * nb) & 127), 64.0f, scr, lane);
            else                 transpose_item_f8(P.moe_wd + wofs, DM, 64 * kb, 32 * nb, (unsigned char*)WdT, e * 1024 + 32 * nb, 64.0f, scr, lane);
#else
            if (which == 0)      transpose_item(P.moe_wg + wofs, DM, 64 * kb, 32 * nb, WguT, e * 2048 + ((32 * nb) >> 7) * 256 + ((32 * nb) & 127), 1.0f, scr, lane);
            else if (which == 1) transpose_item(P.moe_wu + wofs, DM, 64 * kb, 32 * nb, WguT, e * 2048 + ((32 * nb) >> 7) * 256 + 128 + ((32 * nb) & 127), 1.0f, scr, lane);
            else                 transpose_item(P.moe_wd + wofs, DM, 64 * kb, 32 * nb, WdT, e * 1024 + 32 * nb, 1.0f, scr, lane);
#endif
        }
    }
}

DI bf16x8 mk8(unsigned a, unsigned b, unsigned c, unsigned d) { u32x4 v = {a, b, c, d}; return __builtin_bit_cast(bf16x8, v); }
DI bf16x8 cat44(u32x2 lo, u32x2 hi) { u32x4 v = {lo.x, lo.y, hi.x, hi.y}; return __builtin_bit_cast(bf16x8, v); }
DI u32x4 ldg16(const void* ub, unsigned off) { return *(const u32x4*)((const char*)ub + off); }
DI u32x2 ldg8(const void* ub, unsigned off) { return *(const u32x2*)((const char*)ub + off); }
DI void stg2(void* ub, unsigned off, unsigned short v) { *(unsigned short*)((char*)ub + off) = v; }
DI int crow(int reg, int hh) { return (reg & 3) + 8 * (reg >> 2) + 4 * hh; }
#define PACK_STEP(x, s) mk8(pk2((x)[8 * (s)], (x)[8 * (s) + 1]), pk2((x)[8 * (s) + 2], (x)[8 * (s) + 3]), pk2((x)[8 * (s) + 4], (x)[8 * (s) + 5]), pk2((x)[8 * (s) + 6], (x)[8 * (s) + 7]))

#ifndef TPROBE
#define TPROBE 0
#endif
#ifndef TPWAVE
#define TPWAVE 0
#endif
#define TP_T() ({ asm volatile("" ::: "memory"); unsigned _t = (unsigned)__builtin_amdgcn_s_memrealtime(); asm volatile("" ::: "memory"); _t; })
#define TP_B(k) unsigned _tp##k = 0; if (TPROBE == (k) || ((k) == 1 && TPROBE)) _tp##k = TP_T();
#define TP_E(k) if ((k) == 1 && TPROBE) ttot += TP_T() - _tp##k; else if (TPROBE == (k)) tacc += TP_T() - _tp##k;
#ifndef HYD
#define HYD 4
#endif
DI void hyena_unit(const Params& P, int c, LAS unsigned char* lds) {
    const int tid = tid_opaque(P.wv), lane = tid & 63, w = __builtin_amdgcn_readfirstlane(tid >> 6), r = lane & 31, hh = lane >> 5;
    constexpr int CPS = 8224;
    unsigned char* ws = P.ws; unsigned char* dsc = (unsigned char*)P.out;
    const bf16_t* kf = (const bf16_t*)(ws + WS_KFILT) + (size_t)c * 4096;
    unsigned tacc = 0, ttot = 0;
    TP_B(1)
    __syncthreads();
    TP_B(81)
    {
        const u32x4 a = *(const u32x4*)(kf + 8 * tid), b = (tid < 511) ? *(const u32x4*)(kf + 8 * tid + 8) : (u32x4){0u, 0u, 0u, 0u};
        const unsigned d[9] = {a.x, a.y, a.z, a.w, b.x, b.y, b.z, b.w, 0u};
#pragma unroll
        for (int p = 0; p < 8; ++p) { const int m = p >> 1; u32x4 o;
            if (p & 1) { o.x = __builtin_amdgcn_alignbit(d[m + 1], d[m], 16); o.y = __builtin_amdgcn_alignbit(d[m + 2], d[m + 1], 16); o.z = __builtin_amdgcn_alignbit(d[m + 3], d[m + 2], 16); o.w = __builtin_amdgcn_alignbit(d[m + 4], d[m + 3], 16); }
            else { o.x = d[m]; o.y = d[m + 1]; o.z = d[m + 2]; o.w = d[m + 3]; }
            *(LAS u32x4*)(lds + p * CPS + tid * 16) = o; }
    }
    __syncthreads();
    TP_E(81)
    const bf16_t* hw = (const bf16_t*)(dsc + DO_HW) + ((size_t)c * NB + r) * SEQ + 8 * hh;
    f32x16 acc[8];
#pragma unroll
    for (int i = 0; i < 8; ++i)
#pragma unroll
        for (int q = 0; q < 16; ++q) acc[i][q] = 0.f;
    const int p = 7 - (r & 7);
    const LAS unsigned char* abase = lds + p * CPS + (2047 - 256 * w - r + 8 * hh - p) * 2;
    LAS unsigned char* Bt = lds + 8 * CPS;
    const bf16_t* hws = (const bf16_t*)(dsc + DO_HW) + ((size_t)c * NB + (tid >> 4)) * SEQ + 4 * (tid & 15);
    const unsigned bwo = (unsigned)((tid >> 4) * 144 + (tid & 15) * 8), bro = (unsigned)(r * 144 + 16 * hh);
    TP_B(82)
    u32x2 bpre[HYD];
#pragma unroll
    for (int d = 0; d < HYD; ++d) bpre[d] = *(const u32x2*)(hws + 64 * d);
    *(LAS u32x2*)(Bt + bwo) = bpre[0];
    __syncthreads();
#pragma unroll 1
    for (int s8 = 0; s8 < SEQ; s8 += 64 * HYD) {
#pragma unroll
        for (int d = 0; d < HYD; ++d) { const int sb = s8 + 64 * d;
            if (sb + 64 < SEQ) *(LAS u32x2*)(Bt + ((d + 1) & 1) * 4608 + bwo) = bpre[(d + 1) % HYD];
            if (sb + 64 * HYD < SEQ) bpre[d] = *(const u32x2*)(hws + sb + 64 * HYD);
#pragma unroll
            for (int j = 0; j < 4; ++j) { const int s0 = sb + 16 * j; const bf16x8 bfr = *(const LAS bf16x8*)(Bt + (d & 1) * 4608 + bro + 32 * j);
#pragma unroll
                for (int i = 0; i < 8; ++i) { const bf16x8 afr = *(const LAS bf16x8*)(abase + (s0 - 32 * i) * 2); acc[i] = MFMA32(afr, bfr, acc[i]); }
                __builtin_amdgcn_sched_barrier(0); }
            __syncthreads(); }
    }
    TP_E(82)
    TP_B(83)
    const bf16_t* hx = (const bf16_t*)(dsc + DO_HX0) + ((size_t)c * NB + r) * SEQ;
    bf16_t* ya = (bf16_t*)(dsc + DO_YAT) + ((size_t)c * NB + r) * SEQ;
#pragma unroll
    for (int i = 0; i < 8; ++i)
#pragma unroll
        for (int g = 0; g < 4; ++g) { const int t = 256 * w + 32 * i + 8 * g + 4 * hh;
            const u32x2 xv = *(const u32x2*)(hx + t);
            u32x2 o; o.x = pk2(acc[i][4 * g] * bflo(xv.x), acc[i][4 * g + 1] * bfhi(xv.x)); o.y = pk2(acc[i][4 * g + 2] * bflo(xv.y), acc[i][4 * g + 3] * bfhi(xv.y));
            *(u32x2*)(ya + t) = o; }
    TP_E(83)
    TP_E(1)
    if (TPROBE >= 80 && TPROBE < 90 && lane == 0 && w == (TPWAVE)) { atomicAdd((unsigned*)(ws + WS_CTL) + 512, tacc); atomicAdd((unsigned*)(ws + WS_CTL) + 513, ttot); }
}

DI int t5_bucket(int rel) {
    const int ret = rel > 0 ? 16 : 0; const int n = rel < 0 ? -rel : rel;
    if (n < 8) return ret + n;
    const float nf = (float)n;
    int large = 8 + (int)(logf(nf / 8.0f) / 4.852030263919617f * 8.0f);
    large = large < 15 ? large : 15;
    return ret + large;
}
#ifndef ATT_FAST
#define ATT_FAST 0
#endif
struct AttPass { int d, rho, uq0, nq; };
DI AttPass att_pass(int pp, int Q0, int w) {
    AttPass a;
    if (pp == 0) { a.d = 1; a.rho = 0; a.uq0 = Q0 + 32 * w; a.nq = 32; }
    else if (pp == 1) { a.d = 4; a.rho = w & 3; a.uq0 = (Q0 >> 2) + 32 * (w >> 2); a.nq = 32; }
    else { a.d = 16; a.rho = 2 * w + (pp - 2); a.uq0 = Q0 >> 4; a.nq = 16; }
    return a;
}
DI void attn_unit(const Params& P, int u, LAS unsigned char* lds, int& bias_h) {
    unsigned tacc = 0, ttot = 0;
    const int qb = u & 7, h = (u >> 3) & 3, b = u >> 5;
    const int tid = tid_opaque(P.wv), lane = tid & 63, w = __builtin_amdgcn_readfirstlane(tid >> 6), c = lane & 31, hh = lane >> 5;
    LAS float* Ost = (LAS float*)lds;
    LAS float* Mst = (LAS float*)(lds + 69632);
    LAS float* Lst = Mst + 256;
    LAS float* biasT = (LAS float*)(lds + 69632 + 2048);
    LAS unsigned char* Vr = lds + 69632 + 2048 + 12800 + w * 6144;
    unsigned char* ws = P.ws;
    TP_B(1)
    { TP_B(3) __syncthreads(); TP_E(3) }
    if (bias_h != h) {
        const float* relb = P.rel_bias; asm volatile("" : "+s"(relb));
        for (int i = tid; i < 4 * 768; i += 512) { const int s = i / 768, jx = i - 768 * s; const int pat = jx >> 8, rel = (jx & 255) - 128, dd = pat == 0 ? 1 : (pat == 1 ? 4 : 16);
            biasT[s * 784 + jx + s] = (rel >= -64 && rel <= 64) ? relb[t5_bucket(rel * dd) * 4 + h] * 1.4426950408889634f : -INFINITY; }
        __syncthreads();
        bias_h = h;
    }
    const bf16_t* pb = (const bf16_t*)(ws + WS_PROJ) + (size_t)b * SEQ * NPROJ;
    bf16_t* MIX = (bf16_t*)(ws + WS_HN);
    const int Q0 = qb * 256;
    const int i16 = lane & 15, trq = i16 >> 2, trp = i16 & 3;
    const unsigned troff = (unsigned)((4 * hh + trq) * 192 + (16 * ((lane >> 4) & 1) + 4 * trp) * 2);
    const int r8 = lane >> 3, j8 = lane & 7;
#define ATT_LOAD(KF, VR, KT, AP) do { const int nsub_ = SEQ / (AP).d, tlo_ = (AP).uq0 - 64 + 32 * (KT); \
        if (ATT_FAST && tlo_ >= 0 && tlo_ + 31 < nsub_) {                   \
            const unsigned lo_ = (unsigned)(r8 * (AP).d * NPROJ + 8 * j8) * 2u; \
            _Pragma("unroll") for (int i = 0; i < 4; ++i) { const bf16_t* b_ = pb + (size_t)(((tlo_ + 8 * i) * (AP).d + (AP).rho) * NPROJ + h * 64); \
                KF[i] = __builtin_bit_cast(bf16x8, ldg16(b_ + PC_AK, lo_)); VR[i] = ldg16(b_ + PC_AV, lo_); } \
        } else { \
            _Pragma("unroll") for (int i = 0; i < 4; ++i) { const int ukr_ = tlo_ + 8 * i + r8; const int ukc_ = ukr_ < 0 ? 0 : (ukr_ >= nsub_ ? nsub_ - 1 : ukr_); \
                const unsigned ko_ = (unsigned)((ukc_ * (AP).d + (AP).rho) * NPROJ + h * 64 + 8 * j8) * 2u; \
                KF[i] = __builtin_bit_cast(bf16x8, ldg16(pb + PC_AK, ko_)); VR[i] = ldg16(pb + PC_AV, ko_); } } } while (0)
#define ATT_TILE(KF, VR, KT, NEXTLOAD) do { const int kt = (KT); \
        bf16x8 kq_[4]; \
        f32x16 st;                                                          \
        _Pragma("unroll") for (int g = 0; g < 4; ++g) { const f32x4 bv_ = *(const LAS f32x4*)(tb4 + 32 * kt + 8 * g); st[4 * g] = bv_.x; st[4 * g + 1] = bv_.y; st[4 * g + 2] = bv_.z; st[4 * g + 3] = bv_.w; } \
        _Pragma("unroll") for (int i = 0; i < 4; ++i) *(LAS bf16x8*)(Vr + (8 * i + r8) * 144 + 16 * j8) = KF[i]; \
        _Pragma("unroll") for (int ks = 0; ks < 4; ++ks) kq_[ks] = *(const LAS bf16x8*)(Vr + c * 144 + 32 * ks + 16 * hh); \
        _Pragma("unroll") for (int i = 0; i < 4; ++i) *(LAS u32x4*)(Vr + (8 * i + r8) * 192 + 16 * j8) = VR[i]; \
        _Pragma("unroll") for (int ks = 0; ks < 4; ++ks) st = MFMA32(kq_[ks], qf[ks], st); \
        NEXTLOAD; \
        float tmax = -INFINITY; float lg[16]; \
        { const int tlo = uk0 + 32 * kt; \
          if (tlo >= 0 && tlo + 31 < nsub) { \
            _Pragma("unroll") for (int q = 0; q < 16; ++q) { lg[q] = st[q]; tmax = fmaxf(tmax, lg[q]); } \
          } else { \
            _Pragma("unroll") for (int q = 0; q < 16; ++q) { const int uk = tlo + crow(q, hh); lg[q] = (uk >= 0 && uk < nsub) ? st[q] : -INFINITY; tmax = fmaxf(tmax, lg[q]); } \
          } } \
        tmax = xhalf_max(tmax); \
        if (__any(tmax > mrun + 8.0f)) { const float mnew = fmaxf(mrun, tmax), alpha = __builtin_amdgcn_exp2f(mrun - mnew); lrun *= alpha; mrun = mnew; \
            _Pragma("unroll") for (int dt = 0; dt < 2; ++dt) _Pragma("unroll") for (int q = 0; q < 16; ++q) OT[dt][q] *= alpha; } \
        float psum = 0.f; \
        _Pragma("unroll") for (int q = 0; q < 16; ++q) { lg[q] = __builtin_amdgcn_exp2f(lg[q] - mrun); psum += lg[q]; } \
        lrun += xhalf_sum(psum); \
        LDS_WAIT(); \
        _Pragma("unroll") for (int s = 0; s < 2; ++s) { const bf16x8 pf = PACK_STEP(lg, s); \
            _Pragma("unroll") for (int dt = 0; dt < 2; ++dt) { \
                const s16x4 lo = __builtin_amdgcn_ds_read_tr16_b64_v4i16((LAS s16x4*)(Vr + troff + (16 * s) * 192 + 64 * dt)); \
                const s16x4 hi = __builtin_amdgcn_ds_read_tr16_b64_v4i16((LAS s16x4*)(Vr + troff + (16 * s + 8) * 192 + 64 * dt)); \
                OT[dt] = MFMA32(__builtin_shufflevector(lo, hi, 0, 1, 2, 3, 4, 5, 6, 7), pf, OT[dt]); } } \
        LDS_WAIT(); } while (0)
    bf16x8 kfA[4], kfB[4]; u32x4 vrA[4], vrB[4];
    bf16x8 qnext[4];
    { const AttPass a0 = att_pass(0, Q0, w);
      ATT_LOAD(kfA, vrA, 0, a0); ATT_LOAD(kfB, vrB, 1, a0);
      const int qpos0 = a0.uq0 + c;
#pragma unroll
      for (int ks = 0; ks < 4; ++ks) qnext[ks] = *(const bf16x8*)(pb + (size_t)qpos0 * NPROJ + PC_AQ + h * 64 + 16 * ks + 8 * hh); }
    auto pass = [&](const int pp, bf16x8 (&kf0)[4], u32x4 (&vr0)[4], bf16x8 (&kf1)[4], u32x4 (&vr1)[4]) __attribute__((always_inline)) {
        const int pat = pp < 2 ? pp : 2;
        const AttPass ap = att_pass(pp, Q0, w), an = att_pass(pp < 3 ? pp + 1 : 3, Q0, w);
        const int d = ap.d, rho = ap.rho, uq0 = ap.uq0, nq = ap.nq;
        const int uk0 = uq0 - 64, nsub = SEQ / d;
        const int cq = (c < nq) ? c : c - nq;
        const int qpos = (uq0 + cq) * d + rho, ql = qpos - Q0;
        const LAS float* tb4 = biasT + (cq & 3) * 784 + pat * 256 + (64 - cq + 4 * hh + (cq & 3));
        bf16x8 qf[4];
#pragma unroll
        for (int ks = 0; ks < 4; ++ks) qf[ks] = qnext[ks];
        if (pp < 3) {
            const int cq2 = (c < an.nq) ? c : c - an.nq; const int qpos2 = (an.uq0 + cq2) * an.d + an.rho;
#pragma unroll
            for (int ks = 0; ks < 4; ++ks) qnext[ks] = *(const bf16x8*)(pb + (size_t)qpos2 * NPROJ + PC_AQ + h * 64 + 16 * ks + 8 * hh); }
        float mrun = -1.0e30f, lrun = 0.f; f32x16 OT[2];
#pragma unroll
        for (int dt = 0; dt < 2; ++dt)
#pragma unroll
            for (int q = 0; q < 16; ++q) OT[dt][q] = 0.f;
        if (pat != 0) { mrun = Mst[ql]; lrun = Lst[ql];
#pragma unroll
            for (int dt = 0; dt < 2; ++dt)
#pragma unroll
                for (int g = 0; g < 4; ++g) { const f32x4 v = *(const LAS f32x4*)(Ost + ql * 68 + 32 * dt + 8 * g + 4 * hh);
                    OT[dt][4 * g] = v.x; OT[dt][4 * g + 1] = v.y; OT[dt][4 * g + 2] = v.z; OT[dt][4 * g + 3] = v.w; } }
        { TP_B(2)
        ATT_TILE(kf0, vr0, 0, ATT_LOAD(kf0, vr0, 2, ap)); ATT_TILE(kf1, vr1, 1, ATT_LOAD(kf1, vr1, 3, ap)); ATT_TILE(kf0, vr0, 2, ATT_LOAD(kf0, vr0, 4, ap));
        ATT_TILE(kf1, vr1, 3, if (pp < 3) { AttPass an_ = an; asm volatile("" : "+s"(an_.d), "+s"(an_.rho), "+s"(an_.uq0)); ATT_LOAD(kf1, vr1, 0, an_); });
        ATT_TILE(kf0, vr0, 4, if (pp < 3) { AttPass an_ = an; asm volatile("" : "+s"(an_.d), "+s"(an_.rho), "+s"(an_.uq0)); ATT_LOAD(kf0, vr0, 1, an_); });
        TP_E(2) }
        if (pat != 2) {
            if (hh == 0) { Mst[ql] = mrun; Lst[ql] = lrun; }
#pragma unroll
            for (int dt = 0; dt < 2; ++dt)
#pragma unroll
                for (int g = 0; g < 4; ++g) *(LAS f32x4*)(Ost + ql * 68 + 32 * dt + 8 * g + 4 * hh) = (f32x4){OT[dt][4 * g], OT[dt][4 * g + 1], OT[dt][4 * g + 2], OT[dt][4 * g + 3]};
        } else if (c < 16) {
            const float inv = __builtin_amdgcn_rcpf(lrun);
            bf16_t* orow = MIX + ((size_t)b * SEQ + qpos) * DM + 512 + h * 64;
#pragma unroll
            for (int dt = 0; dt < 2; ++dt)
#pragma unroll
                for (int g = 0; g < 4; ++g) { u32x2 o; o.x = pk2(OT[dt][4 * g] * inv, OT[dt][4 * g + 1] * inv); o.y = pk2(OT[dt][4 * g + 2] * inv, OT[dt][4 * g + 3] * inv);
                    *(u32x2*)(orow + 32 * dt + 8 * g + 4 * hh) = o; }
        }
        { TP_B(3) if (pp < 2) __syncthreads(); TP_E(3) }
    };
#pragma unroll 1
    for (int p2 = 0; p2 < 2; ++p2) { pass(2 * p2, kfA, vrA, kfB, vrB); pass(2 * p2 + 1, kfB, vrB, kfA, vrA); }
#undef ATT_LOAD
#undef ATT_TILE
    TP_E(1)
    if (TPROBE && TPROBE < 10 && (tid & 63) == 0 && w == (TPWAVE)) { atomicAdd((unsigned*)(ws + WS_CTL) + 512, tacc); atomicAdd((unsigned*)(ws + WS_CTL) + 513, ttot); }
}

DI float softplus_f(float x) { return x > 15.f ? x : __logf(1.0f + __expf(x)); }
DI unsigned short hsel(const u32x4& v, int c) { const unsigned w = (c >> 1) == 0 ? v.x : ((c >> 1) == 1 ? v.y : ((c >> 1) == 2 ? v.z : v.w)); return (unsigned short)((c & 1) ? (w >> 16) : (w & 0xffffu)); }
DI void mamba_unit(const Params& P, int l, int u, LAS unsigned char* lds) {
    const int dir = u & 1, h = (u >> 1) & 3, b = u >> 3, g = h >> 1;
    const int tid = tid_opaque(P.wv), lane_f = tid & 63, w = __builtin_amdgcn_readfirstlane(tid >> 6);
    LAS unsigned char* wl = lds + w * 15616;
    LAS unsigned short* xdT = (LAS unsigned short*)wl;
    LAS unsigned short* xwT = xdT + 64 * 40;
    LAS unsigned short* BT = xwT + 64 * 40;
    LAS float* dtv = (LAS float*)(wl + 15360);
    LAS float* acum = dtv + 32;
    LAS float* Atot = (LAS float*)(lds + 8 * 15616);
    unsigned char* ws = P.ws; unsigned char* dsc = (unsigned char*)P.out;
    const bf16_t* xbc = (const bf16_t*)(dsc + DO_MXBC) + (size_t)b * SEQ * 512;
    const float* dtr = (const float*)(ws + WS_DT) + (size_t)b * SEQ * 8 + dir * 4 + h;
    bf16_t* MYD = (bf16_t*)(dir ? (ws + WS_MYB) : (dsc + DO_MY)) + (size_t)b * SEQ * 256 + h * 64;
    float* stsc = (float*)(dsc + DO_MST) + (size_t)u * (8 * 4096);
    const float dtb = P.m_dt_bias[l * 8 + dir * 4 + h], Aneg = -expf(P.m_A_log[l * 8 + dir * 4 + h]);
    __syncthreads();
#define MTK(c0, j) (dir ? (c0) + 31 - (j) : (c0) + (j))
#define MCH(ci) (256 * w + 32 * (dir ? 7 - (ci) : (ci)))
#pragma unroll 1
    for (int pass = 0; pass < 2; ++pass) {
        int lane_p = lane_f; asm volatile("" : "+v"(lane_p));
        const int lane = lane_p, c32 = lane_p & 31, hh = lane_p >> 5, tg = lane_p >> 3, cg = lane_p & 7;
        f32x16 ST[2][2];
#pragma unroll
        for (int a = 0; a < 2; ++a)
#pragma unroll
            for (int q = 0; q < 2; ++q)
#pragma unroll
                for (int i = 0; i < 16; ++i) ST[a][q][i] = 0.f;
        if (pass == 1) {
            const int nv = dir ? 7 - w : w;
            for (int k = 0; k < nv; ++k) { const int v = dir ? 7 - k : k; const float dec = Atot[v];
                const f32x4* sp = (const f32x4*)(stsc + (size_t)v * 4096 + lane * 64);
#pragma unroll
                for (int a = 0; a < 2; ++a)
#pragma unroll
                    for (int q = 0; q < 2; ++q)
#pragma unroll
                        for (int i4 = 0; i4 < 4; ++i4) { const f32x4 t = sp[(a * 2 + q) * 4 + i4];
                            ST[a][q][4 * i4] = ST[a][q][4 * i4] * dec + t.x; ST[a][q][4 * i4 + 1] = ST[a][q][4 * i4 + 1] * dec + t.y; ST[a][q][4 * i4 + 2] = ST[a][q][4 * i4 + 2] * dec + t.z; ST[a][q][4 * i4 + 3] = ST[a][q][4 * i4 + 3] * dec + t.w; } }
        }
        float atot = 0.f;
        u32x4 rx[4], rB[4]; float rdt;
        { const int c0 = MCH(0);
#pragma unroll
          for (int i = 0; i < 4; ++i) { const unsigned ro = (unsigned)(MTK(c0, 4 * tg + i) * 512 + 8 * cg) * 2u; rx[i] = ldg16(xbc + h * 64, ro); rB[i] = ldg16(xbc + 256 + g * 64, ro); }
          rdt = *(const float*)((const char*)dtr + (unsigned)(MTK(c0, c32) * 32)); }
#pragma unroll 1
        for (int ci = 0; ci < 8; ++ci) {
            int lane_i = lane; asm volatile("" : "+v"(lane_i));
            const int c32 = lane_i & 31, hh = lane_i >> 5, tg = lane_i >> 3, cg = lane_i & 7;
            const int c0 = MCH(ci);
            {
                const float dt = softplus_f(rdt + dtb);
                float ac = dt * Aneg;
#pragma unroll
                for (int o = 1; o < 32; o <<= 1) { const float t = __shfl_up(ac, o, 32); if (c32 >= o) ac += t; }
                if (lane < 32) { dtv[c32] = dt; acum[c32] = ac; }
            }
            LDS_WAIT();
            const float aend = acum[31];
            {
                const f32x4 d4 = *(const LAS f32x4*)(dtv + 4 * tg), a4 = *(const LAS f32x4*)(acum + 4 * tg);
                const float dj[4] = {d4.x, d4.y, d4.z, d4.w};
                const float wj[4] = {__expf(aend - a4.x), __expf(aend - a4.y), __expf(aend - a4.z), __expf(aend - a4.w)};
#pragma unroll
                for (int c = 0; c < 8; ++c) {
                    float xd[4]; unsigned short bb[4];
#pragma unroll
                    for (int i = 0; i < 4; ++i) { xd[i] = bf2f(hsel(rx[i], c)) * dj[i]; bb[i] = hsel(rB[i], c); }
                    *(LAS u32x2*)(xdT + (8 * cg + c) * 40 + 4 * tg) = (u32x2){pk2(xd[0], xd[1]), pk2(xd[2], xd[3])};
                    *(LAS u32x2*)(xwT + (8 * cg + c) * 40 + 4 * tg) = (u32x2){pk2(xd[0] * wj[0], xd[1] * wj[1]), pk2(xd[2] * wj[2], xd[3] * wj[3])};
                    *(LAS u32x2*)(BT + (8 * cg + c) * 40 + 4 * tg) = (u32x2){(unsigned)bb[0] | ((unsigned)bb[1] << 16), (unsigned)bb[2] | ((unsigned)bb[3] << 16)};
                }
            }
            if (ci < 7) { const int c1 = MCH(ci + 1);
#pragma unroll
                for (int i = 0; i < 4; ++i) { const unsigned ro = (unsigned)(MTK(c1, 4 * tg + i) * 512 + 8 * cg) * 2u; rx[i] = ldg16(xbc + h * 64, ro); rB[i] = ldg16(xbc + 256 + g * 64, ro); }
                rdt = *(const float*)((const char*)dtr + (unsigned)(MTK(c1, c32) * 32)); }
            LDS_WAIT();
            if (pass == 1) {
                const unsigned bro = (unsigned)(MTK(c0, c32) * 512 + 8 * hh) * 2u;
                f32x16 GT;
#pragma unroll
                for (int i = 0; i < 16; ++i) GT[i] = 0.f;
#pragma unroll
                for (int ks = 0; ks < 4; ++ks) GT = MFMA32(__builtin_bit_cast(bf16x8, ldg16(xbc + 256 + g * 64 + 16 * ks, bro)), __builtin_bit_cast(bf16x8, ldg16(xbc + 384 + g * 64 + 16 * ks, bro)), GT);
                const float acl = acum[c32];
#pragma unroll
                for (int i = 0; i < 16; ++i) { const int s = crow(i, hh); GT[i] = (s <= c32) ? GT[i] * __expf(acl - acum[s]) : 0.f; }
                f32x16 Y[2];
#pragma unroll
                for (int pt = 0; pt < 2; ++pt)
#pragma unroll
                    for (int i = 0; i < 16; ++i) Y[pt][i] = 0.f;
#pragma unroll
                for (int s = 0; s < 2; ++s) { const bf16x8 pa = PACK_STEP(GT, s);
#pragma unroll
                    for (int pt = 0; pt < 2; ++pt) { const LAS unsigned short* xr = xdT + (32 * pt + c32) * 40 + 16 * s + 4 * hh;
                        Y[pt] = MFMA32(pa, cat44(*(const LAS u32x2*)xr, *(const LAS u32x2*)(xr + 8)), Y[pt]); } }
                const unsigned cro = (unsigned)(MTK(c0, c32) * 512 + 4 * hh) * 2u;
                const float el = __expf(acl);
#pragma unroll
                for (int nt = 0; nt < 2; ++nt)
#pragma unroll
                    for (int s = 0; s < 2; ++s) { const u32x2 clo = ldg8(xbc + 384 + g * 64 + 32 * nt + 16 * s, cro), chi = ldg8(xbc + 384 + g * 64 + 32 * nt + 16 * s + 8, cro);
                        const bf16x8 ca = mk8(pk2(bflo(clo.x) * el, bfhi(clo.x) * el), pk2(bflo(clo.y) * el, bfhi(clo.y) * el), pk2(bflo(chi.x) * el, bfhi(chi.x) * el), pk2(bflo(chi.y) * el, bfhi(chi.y) * el));
#pragma unroll
                        for (int pt = 0; pt < 2; ++pt) Y[pt] = MFMA32(ca, PACK_STEP(ST[nt][pt], s), Y[pt]); }
#pragma unroll
                for (int i = 0; i < 16; ++i) { const unsigned oo = (unsigned)(MTK(c0, crow(i, hh)) * 256 + c32) * 2u; stg2(MYD, oo, f2bf(Y[0][i])); stg2(MYD + 32, oo, f2bf(Y[1][i])); }
            }
            {
                const float de = __expf(aend);
#pragma unroll
                for (int nt = 0; nt < 2; ++nt)
#pragma unroll
                    for (int pt = 0; pt < 2; ++pt)
#pragma unroll
                        for (int i = 0; i < 16; ++i) ST[nt][pt][i] *= de;
#pragma unroll
                for (int s = 0; s < 2; ++s)
#pragma unroll
                    for (int nt = 0; nt < 2; ++nt) { const bf16x8 ba = *(const LAS bf16x8*)(BT + (32 * nt + c32) * 40 + 16 * s + 8 * hh);
#pragma unroll
                        for (int pt = 0; pt < 2; ++pt) ST[nt][pt] = MFMA32(ba, *(const LAS bf16x8*)(xwT + (32 * pt + c32) * 40 + 16 * s + 8 * hh), ST[nt][pt]); }
            }
            atot += aend;
            LDS_WAIT();
        }
        if (pass == 0) {
            f32x4* sp = (f32x4*)(stsc + (size_t)w * 4096 + lane * 64);
#pragma unroll
            for (int a = 0; a < 2; ++a)
#pragma unroll
                for (int q = 0; q < 2; ++q)
#pragma unroll
                    for (int i4 = 0; i4 < 4; ++i4) sp[(a * 2 + q) * 4 + i4] = (f32x4){ST[a][q][4 * i4], ST[a][q][4 * i4 + 1], ST[a][q][4 * i4 + 2], ST[a][q][4 * i4 + 3]};
            if (lane == 0) Atot[w] = __expf(atot);
            VM_WAIT(); __syncthreads();
        }
    }
#undef MTK
#undef MCH
    __syncthreads();
}

DI void hgrn_unit(const Params& P, int l, int u, LAS unsigned char* lds) {
    const int dir = u & 1, h = (u >> 1) & 3, b = u >> 3;
    const int tid = tid_opaque(P.wv), lane_f = tid & 63, w = __builtin_amdgcn_readfirstlane(tid >> 6);
    LAS unsigned char* wl = lds + w * 15104;
    LAS unsigned short* qd = (LAS unsigned short*)wl;
    LAS unsigned short* kd = qd + 32 * 72;
    LAS unsigned short* vT = kd + 32 * 72;
    LAS float* eref = (LAS float*)(wl + 14336);
    LAS float* eglr = eref + 64;
    LAS float* egl = eglr + 64;
    LAS float* lbt = (LAS float*)(lds + 8 * 15104 + 2048 + w * 512);
    LAS float* gsum = lbt + 64;
    LAS float* Atot = (LAS float*)(lds + 8 * 15104);
    unsigned char* ws = P.ws; unsigned char* dsc = (unsigned char*)P.out;
    const bf16_t* proj = (const bf16_t*)(ws + WS_PROJ) + (size_t)b * SEQ * NPROJ;
    bf16_t* OD = (dir ? (bf16_t*)(ws + WS_OB) + (size_t)b * SEQ * 256 + h * 64 : (bf16_t*)(ws + WS_HN) + (size_t)b * SEQ * DM + 768 + h * 64);
    const int ostride = dir ? 256 : DM;
    float* stsc = (float*)(dsc + DO_HST) + (size_t)u * (8 * 4096);
    __syncthreads();
    { float lb = 0.f;
      if (l == 1) { const float h0 = P.hg_lb[(0 * 2 + dir) * 256 + h * 64 + lane_f], h1 = P.hg_lb[(1 * 2 + dir) * 256 + h * 64 + lane_f]; lb = 1.0f / (1.0f + expf(h0 - h1)); }
      lbt[lane_f] = lb; }
    LDS_WAIT();
#define HTK(c0, j) (dir ? (c0) + 31 - (j) : (c0) + (j))
#define HCH(ci) (256 * w + 32 * (dir ? 7 - (ci) : (ci)))
#pragma unroll 1
    for (int pass = 0; pass < 2; ++pass) {
        int lane_p = lane_f; asm volatile("" : "+v"(lane_p));
        const int lane = lane_p, c32 = lane_p & 31, hh = lane_p >> 5, tg = lane_p >> 3, cg = lane_p & 7;
        f32x16 S[2][2];
#pragma unroll
        for (int a = 0; a < 2; ++a)
#pragma unroll
            for (int q = 0; q < 2; ++q)
#pragma unroll
                for (int i = 0; i < 16; ++i) S[a][q][i] = 0.f;
        if (pass == 1) {
            const int nv = dir ? 7 - w : w;
            for (int k = 0; k < nv; ++k) { const int v = dir ? 7 - k : k; const LAS float* at = Atot + v * 64;
                const f32x4* sp = (const f32x4*)(stsc + (size_t)v * 4096 + lane * 64);
#pragma unroll
                for (int a = 0; a < 2; ++a)
#pragma unroll
                    for (int i4 = 0; i4 < 4; ++i4) { const f32x4 dec = *(const LAS f32x4*)(at + 32 * a + 8 * i4 + 4 * hh);
#pragma unroll
                        for (int q = 0; q < 2; ++q) { const f32x4 t = sp[(a * 2 + q) * 4 + i4];
                            S[a][q][4 * i4] = S[a][q][4 * i4] * dec.x + t.x; S[a][q][4 * i4 + 1] = S[a][q][4 * i4 + 1] * dec.y + t.y; S[a][q][4 * i4 + 2] = S[a][q][4 * i4 + 2] * dec.z + t.z; S[a][q][4 * i4 + 3] = S[a][q][4 * i4 + 3] * dec.w + t.w; } } }
        }
        gsum[lane] = 1.0f;
        u32x4 rf[4], rq[4];
        { const int c0 = HCH(0);
#pragma unroll
          for (int i = 0; i < 4; ++i) { const unsigned ro = (unsigned)(HTK(c0, 4 * tg + i) * NPROJ + 8 * cg) * 2u;
              rf[i] = ldg16(proj + PC_HF + dir * 256 + h * 64, ro); rq[i] = (pass == 1) ? ldg16(proj + PC_HQ + h * 64, ro) : (u32x4){0u, 0u, 0u, 0u}; } }
#pragma unroll 1
        for (int ci = 0; ci < 8; ++ci) {
            int lane_i = lane; asm volatile("" : "+v"(lane_i));
            const int c32 = lane_i & 31, hh = lane_i >> 5, tg = lane_i >> 3, cg = lane_i & 7;
            const int c0 = HCH(ci);
            {
                float qprev[4], kprev[4];
                u32x4 rv[4];
#pragma unroll
                for (int i = 0; i < 4; ++i) { const unsigned ro = (unsigned)(HTK(c0, 4 * tg + i) * NPROJ + 8 * cg) * 2u; rv[i] = ldg16(proj + PC_HI + h * 64, ro); }
                const f32x4 lb0 = *(const LAS f32x4*)(lbt + 8 * cg), lb1 = *(const LAS f32x4*)(lbt + 8 * cg + 4);
                const float lbv[8] = {lb0.x, lb0.y, lb0.z, lb0.w, lb1.x, lb1.y, lb1.z, lb1.w};
#pragma unroll
                for (int c = 0; c < 8; ++c) {
                    const float lb = lbv[c], oml = 1.0f - lb;
                    float pl[4], kr[4];
#pragma unroll
                    for (int i = 0; i < 4; ++i) { const float fpre = bf2f(hsel(rf[i], c)); const float en = __expf(-fpre), sg = __builtin_amdgcn_rcpf(1.0f + en);
                        const float ff = lb + oml * sg; pl[i] = (i == 0) ? ff : pl[i - 1] * ff; kr[i] = oml * en * sg; }
                    const float own = pl[3];
                    float lsh = dpp_f<0x118>(own); asm volatile("" : "+v"(lsh));
                    const float lowv = (tg & 1) ? lsh : 1.0f;
                    const float rup = own * lowv;
                    float rro = dpp_f<0x128>(rup); asm volatile("" : "+v"(rro));
                    const float T = (tg & 1) ? rup : rro;
                    const auto s16 = __builtin_amdgcn_permlane16_swap(__float_as_uint(T), __float_as_uint(T), false, false);
                    const float Tp = ((lane >> 4) & 1) ? __uint_as_float(s16[0]) : __uint_as_float(s16[1]);
                    const float PT = T * Tp;
                    const auto s32 = __builtin_amdgcn_permlane32_swap(__float_as_uint(PT), __float_as_uint(PT), false, false);
                    const float pref = __uint_as_float(s32[0]), plast = pref * __uint_as_float(s32[1]);
                    const float excl = (((lane >> 4) & 1) ? Tp : 1.0f) * (((lane >> 5) & 1) ? pref : 1.0f) * ((tg & 1) ? lowv : 1.0f);
                    const float ipref = __builtin_amdgcn_rcpf(pref);
                    if (tg == 0) { eref[8 * cg + c] = pref; eglr[8 * cg + c] = plast * ipref; egl[8 * cg + c] = plast; gsum[8 * cg + c] *= plast; }
                    float kv[4], qv[4];
#pragma unroll
                    for (int i = 0; i < 4; ++i) { const float pj = excl * pl[i]; kv[i] = kr[i] * pref * __builtin_amdgcn_rcpf(pj);
                        if (pass == 1) { const float qr = bf2f(hsel(rq[i], c)); qv[i] = qr * __builtin_amdgcn_rcpf(1.0f + __expf(-qr)) * pj * ipref; } else qv[i] = 0.f; }
                    if (c & 1) {
#pragma unroll
                        for (int i = 0; i < 4; ++i) { *(LAS unsigned*)(kd + (4 * tg + i) * 72 + 8 * cg + c - 1) = pk2(kprev[i], kv[i]);
                            if (pass == 1) *(LAS unsigned*)(qd + (4 * tg + i) * 72 + 8 * cg + c - 1) = pk2(qprev[i], qv[i]); }
                    } else {
#pragma unroll
                        for (int i = 0; i < 4; ++i) { kprev[i] = kv[i]; qprev[i] = qv[i]; }
                    }
                }
#pragma unroll
                for (int c = 0; c < 8; ++c) { unsigned short vb[4];
#pragma unroll
                    for (int i = 0; i < 4; ++i) vb[i] = hsel(rv[i], c);
                    *(LAS u32x2*)(vT + (8 * cg + c) * 40 + 4 * tg) = (u32x2){(unsigned)vb[0] | ((unsigned)vb[1] << 16), (unsigned)vb[2] | ((unsigned)vb[3] << 16)}; }
            }
            if (ci < 7) { const int c1 = HCH(ci + 1);
#pragma unroll
                for (int i = 0; i < 4; ++i) { const unsigned ro = (unsigned)(HTK(c1, 4 * tg + i) * NPROJ + 8 * cg) * 2u;
                    rf[i] = ldg16(proj + PC_HF + dir * 256 + h * 64, ro); if (pass == 1) rq[i] = ldg16(proj + PC_HQ + h * 64, ro); } }
            LDS_WAIT(); __builtin_amdgcn_sched_barrier(0);
            bf16x8 vperm[2][2];
#pragma unroll
            for (int s = 0; s < 2; ++s)
#pragma unroll
                for (int pt = 0; pt < 2; ++pt) { const LAS unsigned short* vr = vT + (32 * pt + c32) * 40 + 16 * s + 4 * hh; vperm[s][pt] = cat44(*(const LAS u32x2*)vr, *(const LAS u32x2*)(vr + 8)); }
            if (pass == 1) {
                f32x16 SC;
#pragma unroll
                for (int i = 0; i < 16; ++i) SC[i] = 0.f;
#pragma unroll
                for (int ks = 0; ks < 4; ++ks) SC = MFMA32(*(const LAS bf16x8*)(kd + c32 * 72 + 16 * ks + 8 * hh), *(const LAS bf16x8*)(qd + c32 * 72 + 16 * ks + 8 * hh), SC);
#pragma unroll
                for (int i = 0; i < 16; ++i) SC[i] = (crow(i, hh) <= c32) ? SC[i] : 0.f;
                const bf16x8 pa0 = PACK_STEP(SC, 0), pa1 = PACK_STEP(SC, 1);
                bf16x8 qa[2][2];
#pragma unroll
                for (int et = 0; et < 2; ++et)
#pragma unroll
                    for (int s = 0; s < 2; ++s) { const LAS unsigned short* qr = qd + c32 * 72 + 32 * et + 16 * s + 4 * hh; qa[et][s] = cat44(*(const LAS u32x2*)qr, *(const LAS u32x2*)(qr + 8)); }
#pragma unroll
                for (int pt = 0; pt < 2; ++pt) {
                    f32x16 O;
#pragma unroll
                    for (int i = 0; i < 16; ++i) O[i] = 0.f;
                    O = MFMA32(pa0, vperm[0][pt], O); O = MFMA32(pa1, vperm[1][pt], O);
#pragma unroll
                    for (int et = 0; et < 2; ++et)
#pragma unroll
                        for (int s = 0; s < 2; ++s) { const f32x4 e0 = *(const LAS f32x4*)(eref + 32 * et + 16 * s + 4 * hh), e1 = *(const LAS f32x4*)(eref + 32 * et + 16 * s + 8 + 4 * hh);
                            const f32x16& sv = S[et][pt];
                            const bf16x8 sb = mk8(pk2(sv[8 * s] * e0.x, sv[8 * s + 1] * e0.y), pk2(sv[8 * s + 2] * e0.z, sv[8 * s + 3] * e0.w), pk2(sv[8 * s + 4] * e1.x, sv[8 * s + 5] * e1.y), pk2(sv[8 * s + 6] * e1.z, sv[8 * s + 7] * e1.w));
                            O = MFMA32(qa[et][s], sb, O); }
#pragma unroll
                    for (int i = 0; i < 16; ++i) { const unsigned oo = (unsigned)(HTK(c0, crow(i, hh)) * ostride + c32) * 2u; stg2(OD + 32 * pt, oo, f2bf(O[i])); }
                    __builtin_amdgcn_sched_barrier(0);
                }
            }
            __builtin_amdgcn_sched_barrier(0);
            {
#pragma unroll
                for (int et = 0; et < 2; ++et) {
                    f32x16 X;
#pragma unroll
                    for (int i = 0; i < 16; ++i) X[i] = 0.f;
#pragma unroll
                    for (int s = 0; s < 2; ++s) { unsigned idw[4];
#pragma unroll
                        for (int j = 0; j < 4; ++j) { const int k0 = 16 * s + 8 * hh + 2 * j; idw[j] = (k0 == c32 ? 0x3f80u : 0u) | (k0 + 1 == c32 ? 0x3f800000u : 0u); }
                        X = MFMA32(*(const LAS bf16x8*)(kd + c32 * 72 + 32 * et + 16 * s + 8 * hh), mk8(idw[0], idw[1], idw[2], idw[3]), X); }
                    const float sc = eglr[32 * et + c32];
#pragma unroll
                    for (int i = 0; i < 16; ++i) X[i] *= sc;
                    float dg[16];
#pragma unroll
                    for (int i = 0; i < 16; ++i) dg[i] = egl[32 * et + crow(i, hh)];
#pragma unroll
                    for (int pt = 0; pt < 2; ++pt) {
#pragma unroll
                        for (int i = 0; i < 16; ++i) S[et][pt][i] *= dg[i];
#pragma unroll
                        for (int s = 0; s < 2; ++s) S[et][pt] = MFMA32(PACK_STEP(X, s), vperm[s][pt], S[et][pt]); }
                }
            }
            LDS_WAIT();
        }
        if (pass == 0) {
            f32x4* sp = (f32x4*)(stsc + (size_t)w * 4096 + lane * 64);
#pragma unroll
            for (int a = 0; a < 2; ++a)
#pragma unroll
                for (int q = 0; q < 2; ++q)
#pragma unroll
                    for (int i4 = 0; i4 < 4; ++i4) sp[(a * 2 + q) * 4 + i4] = (f32x4){S[a][q][4 * i4], S[a][q][4 * i4 + 1], S[a][q][4 * i4 + 2], S[a][q][4 * i4 + 3]};
            LDS_WAIT(); Atot[w * 64 + lane] = gsum[lane];
            VM_WAIT(); __syncthreads();
        }
    }
#undef HTK
#undef HCH
    __syncthreads();
}

DI void phase_mixers(const Params& P, int l, LAS unsigned char* lds, int G, int bid) {
#ifndef REP_PHASE
#define REP_PHASE -1
#endif
#define MREPS(k) _Pragma("unroll 1") for (int _r = 0; _r < ((REP_PHASE == (k)) ? 2 : 1); ++_r)
    if (EN_HY) MREPS(30) for (int c = bid; c < 256; c += G) hyena_unit(P, c, lds);
    if (EN_AT) MREPS(31) { int bias_h = -1;
        if ((G & 7) == 0) { const int xcd = bid & 7, j = bid >> 3, per = G >> 3;
            for (int base = 0; base < NB * 4 * 8; base += G) { const int u = base + xcd * per + j; if (u < NB * 4 * 8) attn_unit(P, u, lds, bias_h); } }
        else for (int u = bid; u < NB * 4 * 8; u += G) attn_unit(P, u, lds, bias_h); }
    if (EN_MA) MREPS(32) for (int u = bid; u < 256; u += G) mamba_unit(P, l, u, lds);
    if (EN_HG) MREPS(33) for (int u = bid; u < 256; u += G) hgrn_unit(P, l, u, lds);
}

constexpr int N_PHASES = 21;
#if TPROBE >= 40 && TPROBE < 50
#define PCTL , (unsigned*)(ws + WS_CTL)
#else
#define PCTL
#endif
#ifndef REP_PHASE
#define REP_PHASE -1
#endif
#define REPS(k) for (int _rep = 0, _nrep = ((REP_PHASE == (k)) && ((k) != 0 && (k) != 5 || l == 0)) ? 2 : 1; _rep < _nrep; ++_rep)
__global__ void __launch_bounds__(512, 2) fwd_kernel(Params Pin) {
    Params P = Pin; P.wv = __builtin_amdgcn_readfirstlane((int)(threadIdx.x >> 6));
    extern __shared__ __attribute__((aligned(16))) unsigned char lds_raw[];
    LAS unsigned char* lds = (LAS unsigned char*)lds_raw;
    volatile LAS unsigned* MISC = (volatile LAS unsigned*)(lds + LDS_MISC);
    if (threadIdx.x < 64) MISC[threadIdx.x] = 0u;
    __syncthreads();
    unsigned char* ws = P.ws;
    const int lo = P.ph_lo, hi = P.ph_hi;
    XcdBarrier bar; bar.bar = (unsigned*)(ws + WS_CTL) + CW_BAR; bar.x = 0; bar.st = nullptr;
    if (hi - lo > 1) bar = xcd_barrier_post((unsigned*)(ws + WS_CTL) + CW_BAR, MISC + 8);
#define IN(k) (lo <= (k) && (k) < hi)
#ifndef TPSEAM
#define TPSEAM -1
#endif
#if TPROBE == 20
#define SEAM(k) do { if (IN(k) && IN((k) + 1)) { const unsigned _t0 = TP_T(); xcd_barrier(bar); if (TPSEAM < 0 || ((k) % 10) == TPSEAM) gb_wait += TP_T() - _t0; } } while (0)
#else
#define SEAM(k) do { if (IN(k) && IN((k) + 1)) xcd_barrier(bar); } while (0)
#endif
    unsigned gb_wait = 0; const unsigned gb_t0 = TPROBE == 20 ? TP_T() : 0u;
#pragma unroll 1
    for (int l = 0; l < 2; ++l) {
        int G = gridDim.x, bid = blockIdx.x; asm volatile("" : "+s"(G), "+s"(bid));
        const int p0 = 10 * l;
        if (IN(p0 + 0)) { _Pragma("unroll 1") REPS(0) phase_pre(P, l, lds); }
        SEAM(p0 + 0);
        if (IN(p0 + 1)) { _Pragma("unroll 1") REPS(1) {
            pg8::StaticOrder S; S.init(NTOK / 256, NPROJ / 256, G, bid); AddrPlain AD{DM, 0}; EpiProj E{(bf16_t*)(ws + WS_PROJ), (const float*)(ws + WS_MSQ)};
            pg8::gemm_phase(lds, (const char*)(ws + WS_XB), (const char*)(ws + WS_WIN), DM, S, AD, E, P.wv PCTL);
        } }
        SEAM(p0 + 1);
        if (IN(p0 + 2)) { _Pragma("unroll 1") REPS(2) phase_premix(P, l, lds); }
        SEAM(p0 + 2);
        if (IN(p0 + 3)) { _Pragma("unroll 1") REPS(3) phase_mixers(P, l, lds, G, bid); }
        SEAM(p0 + 3);
        if (IN(p0 + 4)) { _Pragma("unroll 1") REPS(4) phase_finalize(P, l); }
        SEAM(p0 + 4);
        if (IN(p0 + 5)) { _Pragma("unroll 1") REPS(5) {
            pg8::StaticOrder S; S.init(NTOK / 256, DM / 256, G, bid); AddrPlain AD{DM, 0}; EpiRes E{nullptr, (const bf16_t*)(ws + WS_XB), (bf16_t*)(ws + WS_XB)};
            pg8::gemm_phase(lds, (const char*)(ws + WS_HN), (const char*)(ws + WS_WOUT), DM, S, AD, E, P.wv PCTL);
        } }
        SEAM(p0 + 5);
        if (IN(p0 + 6)) { if (EN_MOE) { _Pragma("unroll 1") REPS(6) phase_ffnpre(P, l, lds); } }
        SEAM(p0 + 6);
        if (IN(p0 + 7)) { if (EN_MOE) { _Pragma("unroll 1") REPS(7) phase_topk(P, l, lds); } }
        SEAM(p0 + 7);
        if (IN(p0 + 8)) { if (EN_MOE) _Pragma("unroll 1") REPS(8) {
            pg8::StaticOrder S; S.init(NSLOT / 256, 2048 / 256, G, bid);
#if MOE_F8
            AddrGateUp8 AD{(const int*)(ws + WS_SELI)}; EpiGateUp8 E{(unsigned char*)P.out + DO_HDN, (const float*)(ws + WS_SELR)};
            pg8::gemm_phase<EpiGateUp8, pg8::StaticOrder, AddrGateUp8, true>(lds, (const char*)(ws + WS_HN), (const char*)(ws + WS_WGU), DM, S, AD, E, P.wv PCTL);
#else
            AddrGateUp AD{(const int*)(ws + WS_SELI)}; EpiGateUp E{(bf16_t*)((unsigned char*)P.out + DO_HDN), (const float*)(ws + WS_SELR)};
            pg8::gemm_phase(lds, (const char*)(ws + WS_HN), (const char*)(ws + WS_WGU), DM, S, AD, E, P.wv PCTL);
#endif
        } }
        SEAM(p0 + 8);
        if (IN(p0 + 9)) { if (EN_MOE) _Pragma("unroll 1") REPS(9) {
            pg8::StaticOrder S; S.init(NSLOT / 256, DM / 256, G, bid);
#if MOE_F8
            EpiDown E{(unsigned char*)(ws + WS_YE), (const float*)(ws + WS_SELG)};
            AddrDown8 AD{}; pg8::gemm_phase<EpiDown, pg8::StaticOrder, AddrDown8, true>(lds, (const char*)P.out + DO_HDN, (const char*)(ws + WS_WD), DM, S, AD, E, P.wv PCTL);
#else
            EpiDown E{(unsigned char*)(ws + WS_YE), (const float*)(ws + WS_SELG)};
            AddrDown AD{}; pg8::gemm_phase(lds, (const char*)P.out + DO_HDN, (const char*)(ws + WS_WD), DM, S, AD, E, P.wv PCTL);
#endif
        } }
        SEAM(p0 + 9);
    }
#ifdef PROBE_BARS
    if (hi - lo > 1) for (int i = 0; i < PROBE_BARS; ++i) xcd_barrier(bar);
#endif
    if (IN(20)) phase_final(P);
#ifndef TPOFF
#define TPOFF 0.5f
#endif
#if TPROBE == 20
    if (tid_opaque(P.wv) == 0) { atomicAdd((unsigned*)(ws + WS_CTL) + 512, gb_wait); atomicAdd((unsigned*)(ws + WS_CTL) + 513, (TP_T() - gb_t0) / 5u); }
    xcd_barrier(bar);
#endif
#if TPROBE
    __syncthreads();
    if (blockIdx.x == 0 && tid_opaque(P.wv) == 0) {
        const float a = (float)__hip_atomic_load((unsigned*)(ws + WS_CTL) + 512, __ATOMIC_RELAXED, __HIP_MEMORY_SCOPE_AGENT), t = (float)__hip_atomic_load((unsigned*)(ws + WS_CTL) + 513, __ATOMIC_RELAXED, __HIP_MEMORY_SCOPE_AGENT);
        P.out[0] = TPROBE == 99 ? 1.0e6f : (TPROBE == 20 && TPSEAM >= 0) ? (floorf(2.0f * log2f(a / t * 200.0f) + TPOFF) * 1.0e5f) : (floorf(a / t * 20.0f + TPOFF) * 1.0e5f); }
#endif
#undef IN
#undef SEAM
}

#ifndef N_LAUNCH_MODE
#define N_LAUNCH_MODE 1
#endif
extern "C" void kernel_launch(void* const* d_in, const int* in_sizes, int n_in, void* d_out, int out_size, void* d_ws, size_t ws_size, hipStream_t stream) {
    static int grid = 0;
    if (grid == 0) {
        if (n_in != 27 || in_sizes[0] != NTOK * DM || out_size != NTOK * DM || ws_size < WS_END) {
            fprintf(stderr, "kernel_launch: unexpected shapes (n_in %d, in0 %d, out %d, ws %zu, need %zu)\n", n_in, n_in > 0 ? in_sizes[0] : -1, out_size, ws_size, (size_t)WS_END); grid = -1; return; }
        int dev = 0, cus = 0, per_cu = 0;
        if (hipGetDevice(&dev) != hipSuccess || hipDeviceGetAttribute(&cus, hipDeviceAttributeMultiprocessorCount, dev) != hipSuccess) { grid = -1; return; }
        if (hipFuncSetAttribute((const void*)fwd_kernel, hipFuncAttributeMaxDynamicSharedMemorySize, LDS_BYTES) != hipSuccess) { fprintf(stderr, "kernel_launch: hipFuncSetAttribute failed\n"); grid = -1; return; }
        if (hipOccupancyMaxActiveBlocksPerMultiprocessor(&per_cu, (const void*)fwd_kernel, 512, LDS_BYTES) != hipSuccess || per_cu < 1) { fprintf(stderr, "kernel_launch: occupancy query says %d\n", per_cu); (void)hipGetLastError(); }
        grid = cus;
    }
    if (grid < 0) return;
    if (hipMemsetAsync((char*)d_ws + WS_CTL, 0, CTL_ZERO_BYTES, stream) != hipSuccess) return;
    Params p{};
    const float** pp = (const float**)&p;
    for (int i = 0; i < 27; ++i) pp[i] = (const float*)d_in[i];
    p.out = (float*)d_out; p.ws = (unsigned char*)d_ws;
    if (N_LAUNCH_MODE == 1) { p.ph_lo = 0; p.ph_hi = N_PHASES; hipLaunchKernelGGL(fwd_kernel, dim3(grid), dim3(512), LDS_BYTES, stream, p); }
    else for (int k = 0; k < N_PHASES; ++k) { p.ph_lo = k; p.ph_hi = k + 1; hipLaunchKernelGGL(fwd_kernel, dim3(grid), dim3(512), LDS_BYTES, stream, p); }
}
```

```cpp
#define N_LAUNCH_MODE 1
#include <hip/hip_runtime.h>
#include <cstdio>
#include <cstdint>

#define LAS __attribute__((address_space(3)))
#define DI __device__ __forceinline__
typedef unsigned short bf16_t;
typedef short bf16x8 __attribute__((ext_vector_type(8)));
typedef short s16x4 __attribute__((ext_vector_type(4)));
typedef float f32x2 __attribute__((ext_vector_type(2)));
typedef float f32x4 __attribute__((ext_vector_type(4)));
typedef float f32x16 __attribute__((ext_vector_type(16)));
typedef unsigned u32x2 __attribute__((ext_vector_type(2)));
typedef unsigned u32x4 __attribute__((ext_vector_type(4)));
typedef int i32x4 __attribute__((ext_vector_type(4)));
typedef __bf16 bfv2 __attribute__((ext_vector_type(2)));

DI unsigned pk2(float lo, float hi) { f32x2 v = {lo, hi}; return __builtin_bit_cast(unsigned, __builtin_convertvector(v, bfv2)); }
DI unsigned short f2bf(float f) { return (unsigned short)(pk2(f, 0.f) & 0xffffu); }
DI float bf2f(unsigned short b) { return __uint_as_float((unsigned)b << 16); }
DI float bflo(unsigned u) { return __uint_as_float(u << 16); }
DI float bfhi(unsigned u) { return __uint_as_float(u & 0xffff0000u); }
DI unsigned pk4_fp8(float a, float b, float c, float d) {
    a = __builtin_amdgcn_fmed3f(a, -440.f, 440.f); b = __builtin_amdgcn_fmed3f(b, -440.f, 440.f); c = __builtin_amdgcn_fmed3f(c, -440.f, 440.f); d = __builtin_amdgcn_fmed3f(d, -440.f, 440.f);
    int v = 0; v = __builtin_amdgcn_cvt_pk_fp8_f32(a, b, v, false); v = __builtin_amdgcn_cvt_pk_fp8_f32(c, d, v, true); return (unsigned)v; }
DI int lane_now() { int ln; asm volatile("v_mbcnt_lo_u32_b32 %0, -1, 0\n\tv_mbcnt_hi_u32_b32 %0, -1, %0" : "=v"(ln)); return ln; }
template <class T> DI T bperm_(int idx4, T v) { return __builtin_bit_cast(T, __builtin_amdgcn_ds_bpermute(idx4, __builtin_bit_cast(int, v))); }
template <class T> DI T shfl_xor_l(T v, int m, int self) { return bperm_(((self ^ m) & 63) << 2, v); }
template <class T> DI T shfl_up_l(T v, int o, int self, int width = 64) { int idx = self - o; if (idx < (self & ~(width - 1))) idx = self; return bperm_(idx << 2, v); }
template <class T> DI T shfl_xor_(T v, int m) { return shfl_xor_l(v, m, lane_now()); }
template <class T> DI T shfl_up_(T v, int o, int width = 64) { return shfl_up_l(v, o, lane_now(), width); }
template <class T> DI T shfl_(T v, int src) { return bperm_((src & 63) << 2, v); }
#ifndef HIP_SHFL
#define __shfl_xor shfl_xor_
#define __shfl_up shfl_up_
#define __shfl shfl_
#endif
DI float xhalf_max(float x) { const auto r = __builtin_amdgcn_permlane32_swap(__float_as_uint(x), __float_as_uint(x), false, false); return fmaxf(__uint_as_float(r[0]), __uint_as_float(r[1])); }
DI float xhalf_sum(float x) { const auto r = __builtin_amdgcn_permlane32_swap(__float_as_uint(x), __float_as_uint(x), false, false); return __uint_as_float(r[0]) + __uint_as_float(r[1]); }
template <int CTRL> DI float dpp_f(float x) { return __builtin_bit_cast(float, __builtin_amdgcn_update_dpp(0, __builtin_bit_cast(int, x), CTRL, 0xF, 0xF, true)); }
DI float x16_sum(float x) { const auto r = __builtin_amdgcn_permlane16_swap(__float_as_uint(x), __float_as_uint(x), false, false); return __uint_as_float(r[0]) + __uint_as_float(r[1]); }
DI float row_sum16(float x) { x += dpp_f<0x128>(x); x += dpp_f<0x124>(x); x += dpp_f<0x122>(x); x += dpp_f<0x121>(x); return x; }
DI float grp_sum8(float x) { x += dpp_f<0xB1>(x); x += dpp_f<0x4E>(x); x += dpp_f<0x141>(x); return x; }
DI float grp_max16(float x) { x = fmaxf(x, dpp_f<0xB1>(x)); x = fmaxf(x, dpp_f<0x4E>(x)); x = fmaxf(x, dpp_f<0x141>(x)); x = fmaxf(x, dpp_f<0x128>(x)); return x; }
DI float wave_sum(float v) { return xhalf_sum(x16_sum(row_sum16(v))); }
DI float silu_f(float x) { return x * __builtin_amdgcn_rcpf(1.0f + __expf(-x)); }
DI float sigmoid_f(float x) { return __builtin_amdgcn_rcpf(1.0f + __expf(-x)); }
#ifdef OLD_TID
DI int tid_opaque(int wv) { int t = wv * 64 + (int)__builtin_amdgcn_mbcnt_hi(~0u, __builtin_amdgcn_mbcnt_lo(~0u, 0u)); asm volatile("" : "+v"(t)); return t; }
#else
DI int tid_opaque(int wv) { int ln; asm volatile("v_mbcnt_lo_u32_b32 %0, -1, 0\n\tv_mbcnt_hi_u32_b32 %0, -1, %0" : "=v"(ln) :: "memory"); return wv * 64 + ln; }
#endif
DI bf16x8 mk8u(unsigned a, unsigned b, unsigned c, unsigned d) { u32x4 v = {a, b, c, d}; return __builtin_bit_cast(bf16x8, v); }
#define LDS_WAIT() asm volatile("s_waitcnt lgkmcnt(0)" ::: "memory")
#define VM_WAIT() asm volatile("s_waitcnt vmcnt(0)" ::: "memory")
#define MFMA32(a, b, c) __builtin_amdgcn_mfma_f32_32x32x16_bf16((a), (b), (c), 0, 0, 0)

constexpr int NB = 32, SEQ = 2048, DM = 1024, NTOK = NB * SEQ;
constexpr int NIN_REF = 3592, NPROJ = 3584;
constexpr int PC_HY = 0, PC_MZ = 768, PC_MX = 1024, PC_AQ = 1536, PC_AK = 1792, PC_AV = 2048, PC_HQ = 2304, PC_HF = 2560, PC_HI = 3072, PC_HG = 3328;
constexpr int NEXP = 16, CAP = 256, NSLOT = NB * NEXP * CAP;
constexpr float EPSN = 1e-6f;

constexpr size_t MiB = 1u << 20;
constexpr size_t WS_CTL = 0, CTL_ZERO_BYTES = 64 * 1024;
constexpr size_t WS_DT = 1 * MiB, WS_AFF = 3 * MiB, WS_SLOT = 7 * MiB, WS_SELI = 11 * MiB, WS_SELG = 11 * MiB + 512 * 1024, WS_KFILT = 12 * MiB, WS_MSQ = 14 * MiB, WS_RS = 15 * MiB, WS_SELR = 15 * MiB + 512 * 1024;
constexpr size_t WS_XB = 64 * MiB, WS_WIN = 320 * MiB, WS_WOUT = 327 * MiB, WS_WGU = 329 * MiB, WS_WD = 393 * MiB, WS_HN = 432 * MiB, WS_PROJ = 560 * MiB, WS_YE = WS_PROJ, WS_END = 1008 * MiB, WS_MYB = WS_WGU, WS_OB = WS_WGU + 32 * MiB;
constexpr size_t DO_HW = 0, DO_HX0 = 32 * MiB, DO_YAT = 64 * MiB, DO_MXBC = 96 * MiB, DO_MY = 160 * MiB, DO_MST = 192 * MiB, DO_HST = 224 * MiB, DO_HDN = 0;
constexpr int CW_BAR = 1024;

constexpr int LDS_MISC = 163840 - 256, LDS_BYTES = 163840;

struct Params {
    const float *x, *w_in, *w_out, *norm_mix_w, *norm_ffn_w, *hy_conv_w, *hy_w1, *hy_b1, *hy_w2, *hy_b2, *hy_freq, *hy_w3, *hy_fbias,
                *m_conv_w, *m_conv_b, *m_dt_bias, *m_A_log, *m_D, *m_norm_w, *rel_bias, *hg_lb, *hg_norm_w, *router_w, *moe_wg, *moe_wu, *moe_wd, *final_w;
    float* out; unsigned char* ws;
    int ph_lo, ph_hi, wv, pad;
};

#define XB_TMO      128
#define XB_XCNT(j)  (256  + 64 * (j))
#define XB_XSUB(j)  (1280 + 64 * (j))
#define XB_XGEN(j)  (2304 + 64 * (j))
#define XB_TOP      3328
#define XB_TOPGEN   3392
#define XCD_BAR_WORDS 3456
#define XB_SPIN_CAP (1u << 18)
__device__ __forceinline__ unsigned xb_ld(unsigned* p)              { return __hip_atomic_load(p, __ATOMIC_RELAXED, __HIP_MEMORY_SCOPE_AGENT); }
__device__ __forceinline__ unsigned xb_add(unsigned* p, unsigned v) { return __hip_atomic_fetch_add(p, v, __ATOMIC_RELAXED, __HIP_MEMORY_SCOPE_AGENT); }
__device__ __forceinline__ unsigned xb_xcc_id() { return (unsigned)__builtin_amdgcn_s_getreg((3 << 11) | 20) & 0xFu; }
#define XB_SPIN(cond, bar) do { unsigned _sp = 0; while (cond) { __builtin_amdgcn_s_sleep(1); \
    if ((++_sp & 255u) == 0u) { if (xb_ld(&(bar)[XB_TMO])) break; if (_sp > XB_SPIN_CAP) { atomicAdd(&(bar)[XB_TMO], 1u); break; } } } } while (0)
struct XcdBarrier { unsigned* bar; unsigned x; volatile LAS unsigned* st; };
__device__ __forceinline__ XcdBarrier xcd_barrier_post(unsigned* bar, volatile LAS unsigned* st) {
    XcdBarrier b; b.bar = bar; b.x = xb_xcc_id(); b.st = st;
    if (threadIdx.x == 0) (void)xb_add(&bar[XB_XCNT(b.x)], 1u);
    return b;
}
__device__ __forceinline__ void xcd_barrier_complete(unsigned* bar, unsigned x, unsigned& nloc, unsigned& nx) {
    const unsigned G = gridDim.x * gridDim.y * gridDim.z;
    unsigned sum, cnt, mine, sp = 0u;
    for (;;) {
        sum = 0u; cnt = 0u; mine = 0u;
#pragma unroll
        for (unsigned j = 0; j < 16; ++j) { const unsigned c = xb_ld(&bar[XB_XCNT(j)]); sum += c; cnt += (c > 0u) ? 1u : 0u; mine = (j == x) ? c : mine; }
        if (sum == G) break;
        __builtin_amdgcn_s_sleep(1);
        if ((++sp & 255u) == 0u) { if (xb_ld(&bar[XB_TMO])) break; if (sp > XB_SPIN_CAP) { atomicAdd(&bar[XB_TMO], 1u); break; } }
    }
    nloc = mine > 0u ? mine : 1u; nx = cnt > 0u ? cnt : 1u;
}
__device__ __forceinline__ void xcd_barrier(const XcdBarrier& b) {
    asm volatile("s_waitcnt vmcnt(0)" ::: "memory");
    __syncthreads();
    if (threadIdx.x == 0) {
        unsigned* bar = b.bar; asm volatile("" : "+s"(bar));
        __builtin_amdgcn_s_waitcnt(0);
        unsigned nloc = b.st[0], nx = b.st[1];
        if (nloc == 0u) { xcd_barrier_complete(bar, b.x, nloc, nx); b.st[0] = nloc; b.st[1] = nx; }
        const unsigned old = xb_add(&bar[XB_XSUB(b.x)], 1u);
        const unsigned gen = old / nloc;
        if (old + 1u == (gen + 1u) * nloc) {
            __builtin_amdgcn_fence(__ATOMIC_RELEASE, "agent");
            asm volatile("s_waitcnt vmcnt(0)" ::: "memory");
            const unsigned og = xb_add(&bar[XB_TOP], 1u);
            const unsigned tg = og / nx;
            if (og + 1u == (tg + 1u) * nx) xb_add(&bar[XB_TOPGEN], 1u);
            else XB_SPIN(xb_ld(&bar[XB_TOPGEN]) == tg, bar);
            __builtin_amdgcn_fence(__ATOMIC_ACQUIRE, "agent");
            xb_add(&bar[XB_XGEN(b.x)], 1u);
            asm volatile("s_waitcnt vmcnt(0)" ::: "memory");
        } else {
            XB_SPIN(xb_ld(&bar[XB_XGEN(b.x)]) == gen, bar);
            __builtin_amdgcn_fence(__ATOMIC_ACQUIRE, "agent");
            asm volatile("s_waitcnt vmcnt(0)" ::: "memory");
        }
    }
    __syncthreads();
}

namespace pg8 {
constexpr int BM = 256, BK = 64, HALF = 128, HTB = HALF * BK * 2, STAGE_BYTES = 8 * HTB, NXCD = 8, WGM = 8;
__host__ __device__ __forceinline__ int lds_byte(int r, int c) { const int st = (r >> 4) * 2 + (c >> 5), rr = r & 15, cc = c & 31, ob = rr * 64 + cc * 2; return st * 1024 + (ob ^ (((ob >> 9) & 1) << 5)); }
__host__ __device__ __forceinline__ void stage_rc(int b, int& R, int& C) { const int st = b / 1024, sb = b % 1024, swz = sb ^ (((sb >> 9) & 1) << 5); R = (st >> 1) * 16 + swz / 64; C = (st & 1) * 32 + (swz % 64) / 2; }
__host__ __device__ __forceinline__ int perm32(int rho) { const int n = rho >> 4, i = rho & 15; return 8 * (i >> 2) + 4 * n + (i & 3); }
struct Unit { int pm, pn; };
typedef int i32x8 __attribute__((ext_vector_type(8)));
typedef int i32x32 __attribute__((ext_vector_type(32)));
#define INS4(V, P, X) do { const i32x4 _x = (X); (V)[(P)] = _x.x; (V)[(P) + 1] = _x.y; (V)[(P) + 2] = _x.z; (V)[(P) + 3] = _x.w; } while (0)
#define EXT8(V, P) ((i32x8){(V)[(P)], (V)[(P) + 1], (V)[(P) + 2], (V)[(P) + 3], (V)[(P) + 4], (V)[(P) + 5], (V)[(P) + 6], (V)[(P) + 7]})
DI i32x8 cat88(bf16x8 lo, bf16x8 hi) { const i32x4 a = __builtin_bit_cast(i32x4, lo), b = __builtin_bit_cast(i32x4, hi); return (i32x8){a.x, a.y, a.z, a.w, b.x, b.y, b.z, b.w}; }
struct StaticOrder {
    int nM, nN, nwg, G, c;
    __device__ void init(int nM_, int nN_, int G_, int c_) { nM = nM_; nN = nN_; nwg = nM * nN; G = G_; c = c_; }
    __device__ bool next(int i, Unit& u) const {
        const long L = (long)i * G + c; if (L >= nwg) return false;
        int wgid = (int)L; { const int q = nwg / NXCD, r = nwg % NXCD, xcd = wgid % NXCD, off = wgid / NXCD; wgid = (xcd < r ? xcd * (q + 1) : r * (q + 1) + (xcd - r) * q) + off; }
        const int nig = WGM * nN, gid = wgid / nig, fm = gid * WGM, gsz = (nM - fm) < WGM ? (nM - fm) : WGM;
        u.pm = fm + ((wgid % nig) % gsz); u.pn = (wgid % nig) / gsz; return true;
    }
};
#ifndef TPROBE
#define TPROBE 0
#endif
#ifndef TPGEMM
#define TPGEMM 0
#endif
#define GP_T() ({ asm volatile("" ::: "memory"); unsigned _t = (unsigned)__builtin_amdgcn_s_memrealtime(); asm volatile("" ::: "memory"); _t; })
#define GP_ON(k) (TPROBE == (k) && Epi::PID == TPGEMM)
template <class Epi, class Sched, class Addr, bool F8 = false>
__device__ __forceinline__ void gemm_phase(LAS unsigned char* lds, const char* Abase, const char* Bbase, int K, const Sched& S, const Addr& AD, const Epi& E, int wv, unsigned* lds_ws_ctl = nullptr) {
    const int tid = tid_opaque(wv), wid = __builtin_amdgcn_readfirstlane(tid >> 6), lane = tid & 63, wr = wid >> 2, wc = wid & 3, fr = lane & 15, fq = lane >> 4;
    unsigned gp_acc = 0, gp_tot = 0, gp_t0 = 0, gp_t1 = 0; if (TPROBE >= 40 && TPROBE < 50 && Epi::PID == TPGEMM) gp_t0 = GP_T();
    const int KB = F8 ? K : 2 * K;
    const int nt = KB / 128;
    int Rr[2]; unsigned Cc[2], voffB[2], voffA[2];
#pragma unroll
    for (int i = 0; i < 2; ++i) { int R, C; stage_rc(tid * 16 + i * 8192, R, C); const int Rb = Epi::PERM ? ((R & ~31) + perm32(R & 31)) : R;
        Rr[i] = R; Cc[i] = (unsigned)C * 2u; voffA[i] = (unsigned)(R * KB + C * 2); voffB[i] = (unsigned)(Rb * KB + C * 2); }
    const size_t kstep = (size_t)(BK * 2);
    const size_t hstep = (size_t)HALF * KB;
    const unsigned ldsw = (unsigned)wid * 1024u;
    const int aoff = F8 ? lds_byte(wr * 64 + fr, fq * 16) : lds_byte(wr * 64 + fr, fq * 8), boff = F8 ? lds_byte(wc * 32 + fr, fq * 16) : lds_byte(wc * 32 + fr, fq * 8);
    const int aoff1 = F8 ? lds_byte(wr * 64 + fr, fq * 16 + 8) : aoff + 1024, boff1 = F8 ? lds_byte(wc * 32 + fr, fq * 16 + 8) : boff + 1024;
#define PG8_SA(b, h) (((b) * 2 + (h)) * HTB)
#define PG8_SB(b, h) ((4 + (b) * 2 + (h)) * HTB)
#define PG8_STAGE(bufoff, gbase, voff) do { _Pragma("unroll") for (int _i = 0; _i < 2; ++_i) \
        __builtin_amdgcn_global_load_lds((const unsigned*)((const char*)(gbase) + (voff)[_i]), (LAS unsigned*)(lds + (bufoff) + ldsw + _i * 8192), 16, 0, 0); } while (0)
#define PG8_STAGE_A(bufoff, kb, h, un) do { if constexpr (Addr::LOADS) { _Pragma("unroll") for (int _i = 0; _i < 2; ++_i) \
        __builtin_amdgcn_global_load_lds((const unsigned*)(Abase + (kb) + ((un) ? on[h][_i] : oc[h][_i])), (LAS unsigned*)(lds + (bufoff) + ldsw + _i * 8192), 16, 0, 0); } \
      else { const char* _ab = ((un) ? nA : cA) + (kb) + (size_t)(h) * hstep; _Pragma("unroll") for (int _i = 0; _i < 2; ++_i) \
        __builtin_amdgcn_global_load_lds((const unsigned*)(_ab + voffA[_i]), (LAS unsigned*)(lds + (bufoff) + ldsw + _i * 8192), 16, 0, 0); } } while (0)
#define PG8_BSEL_B0 0
#define PG8_BSEL_B1 16
#define PG8_LDA(dst, b, h) do { if constexpr (F8) { _Pragma("unroll") for (int m = 0; m < 4; ++m) { INS4(AA, 8 * m, *(const LAS i32x4*)(lds + PG8_SA(b, h) + aoff + m * 2048)); INS4(AA, 8 * m + 4, *(const LAS i32x4*)(lds + PG8_SA(b, h) + aoff + 16 + m * 2048)); } } \
      else { _Pragma("unroll") for (int m = 0; m < 4; ++m) _Pragma("unroll") for (int k = 0; k < 2; ++k) dst[m][k] = *(const LAS bf16x8*)(lds + PG8_SA(b, h) + (k ? aoff1 : aoff) + m * 2048); } } while (0)
#define PG8_LDB(dst, b, h) do { if constexpr (F8) { _Pragma("unroll") for (int n = 0; n < 2; ++n) { INS4(BB, PG8_BSEL_##dst + 8 * n, *(const LAS i32x4*)(lds + PG8_SB(b, h) + boff + n * 2048)); INS4(BB, PG8_BSEL_##dst + 8 * n + 4, *(const LAS i32x4*)(lds + PG8_SB(b, h) + boff + 16 + n * 2048)); } } \
      else { _Pragma("unroll") for (int n = 0; n < 2; ++n) _Pragma("unroll") for (int k = 0; k < 2; ++k) dst[n][k] = *(const LAS bf16x8*)(lds + PG8_SB(b, h) + (k ? boff1 : boff) + n * 2048); } } while (0)
#define PG8_MMA(ai, bj, At, Bt) do { __builtin_amdgcn_s_setprio(1); if constexpr (F8) { _Pragma("unroll") for (int m = 0; m < 4; ++m) _Pragma("unroll") for (int n = 0; n < 2; ++n) \
        { const i32x8 _b8 = EXT8(BB, PG8_BSEL_##Bt + 8 * n), _a8 = EXT8(AA, 8 * m); \
          asm volatile("s_nop 1\n\tv_mfma_scale_f32_16x16x128_f8f6f4 %0, %1, %2, %0, %3, %4 op_sel_hi:[0,0,0]" : "+v"(acc[ai][bj][m][n]) : "v"(_b8), "v"(_a8), "v"(scw), "v"(scx)); } } \
      else { _Pragma("unroll") for (int m = 0; m < 4; ++m) _Pragma("unroll") for (int n = 0; n < 2; ++n) _Pragma("unroll") for (int k = 0; k < 2; ++k) \
        acc[ai][bj][m][n] = __builtin_amdgcn_mfma_f32_16x16x32_bf16(Bt[n][k], At[m][k], acc[ai][bj][m][n], 0, 0, 0); } __builtin_amdgcn_s_setprio(0); } while (0)
#define PG8_WAIT_V(n) asm volatile("s_waitcnt vmcnt(" #n ")" ::: "memory")
#define PG8_WAIT_L(n) asm volatile("s_waitcnt lgkmcnt(" #n ")" ::: "memory")
#define PG8_BAR __builtin_amdgcn_s_barrier()
#define PG8_SCHED __builtin_amdgcn_sched_barrier(0)
    int scw = 0, scx = 0; if constexpr (F8) { scw = Addr::SC_W; scx = Addr::SC_X; } (void)scw; (void)scx;
    Unit cur, nxt; int ui = 0;
    if (!S.next(0, cur)) return;
#ifdef STAG_TICKS
    {
        const unsigned long long t0 = __builtin_amdgcn_s_memrealtime(); const unsigned long long dl = (unsigned long long)(((blockIdx.x >> 3) & 7) * STAG_TICKS);
        while (__builtin_amdgcn_s_memrealtime() - t0 < dl) __builtin_amdgcn_s_sleep(16);
    }
#endif
    f32x4 acc[2][2][4][2];
#pragma unroll
    for (int a = 0; a < 2; ++a)
#pragma unroll
        for (int b = 0; b < 2; ++b)
#pragma unroll
            for (int m = 0; m < 4; ++m)
#pragma unroll
                for (int n = 0; n < 2; ++n) acc[a][b][m][n] = (f32x4){0.f, 0.f, 0.f, 0.f};
    bf16x8 At[4][2], B0[2][2], B1[2][2]; i32x32 AA, BB; (void)At; (void)B0; (void)B1; (void)AA; (void)BB;
    unsigned oc[2][2], on[2][2];
    const char* cA = Abase; const char* nA = Abase;
    if constexpr (Epi::ROWTAB) {
        Unit tu;
        for (int k = 0; k < 16 && S.next(k, tu); ++k)
            for (int r = tid; r < 256; r += 512) ((LAS float*)(lds + STAGE_BYTES + 8192))[k * 256 + r] = E.rowscale(tu, r);
        if constexpr (!Addr::LOADS) __syncthreads();
    }
    if constexpr (Addr::LOADS) {
        {
            Unit tu;
            for (int k = 0; k < 16 && S.next(k, tu); ++k)
                for (int r = tid; r < 256; r += 512) ((LAS unsigned short*)(lds + STAGE_BYTES))[k * 256 + r] = AD.arow_tok(tu, r);
            __syncthreads();
        }
#pragma unroll
        for (int h = 0; h < 2; ++h)
#pragma unroll
            for (int i = 0; i < 2; ++i) { oc[h][i] = AD.arow_lds(lds + STAGE_BYTES, 0, cur, h * HALF + Rr[i]) + Cc[i]; on[h][i] = oc[h][i]; }
        PG8_WAIT_V(0);
    } else { cA = Abase + AD.arow(cur, 0); nA = cA; }
    const char* cB = Bbase + AD.boff(cur);
    PG8_STAGE(PG8_SB(0, 0), cB, voffB); PG8_STAGE_A(PG8_SA(0, 0), 0, 0, false); PG8_STAGE(PG8_SB(0, 1), cB + hstep, voffB); PG8_STAGE_A(PG8_SA(0, 1), 0, 1, false);
    if (wr == 1) PG8_BAR;
    PG8_WAIT_V(4); PG8_BAR;
    PG8_STAGE(PG8_SB(1, 0), cB + kstep, voffB); PG8_STAGE_A(PG8_SA(1, 0), kstep, 0, false); PG8_STAGE(PG8_SB(1, 1), cB + hstep + kstep, voffB);
    PG8_WAIT_V(6); PG8_BAR;
    for (;;) {
        const bool has_next = S.next(ui + 1, nxt);
        if (has_next) {
            if constexpr (Addr::LOADS) {
#pragma unroll
                for (int h = 0; h < 2; ++h)
#pragma unroll
                    for (int i = 0; i < 2; ++i) on[h][i] = AD.arow_lds(lds + STAGE_BYTES, ui + 1, nxt, h * HALF + Rr[i]) + Cc[i];
            } else nA = Abase + AD.arow(nxt, 0);
        } else nA = cA;
        const char* nB = has_next ? Bbase + AD.boff(nxt) : cB;
        if (GP_ON(41)) gp_t1 = GP_T();
#pragma unroll 1
        for (int t = 0; t < nt; t += 2) {
            if (GP_ON(43) && t == 0) gp_t1 = GP_T();
            if (GP_ON(44) && t == 2) gp_t1 = GP_T();
            const bool last = (t == nt - 2);
            const bool un = last && has_next;
            const size_t k1 = (size_t)(t + 1) * kstep;
            const size_t k2 = last ? 0 : (size_t)(t + 2) * kstep, k3 = k2 + kstep;
            const char* b2 = last ? nB : cB + (size_t)(t + 2) * kstep;
            const char* b3 = b2 + kstep;
            PG8_LDB(B0, 0, 0); PG8_SCHED; PG8_LDA(At, 0, 0); PG8_STAGE_A(PG8_SA(1, 1), k1, 1, false);
            PG8_WAIT_L(8); PG8_BAR; PG8_WAIT_L(0); PG8_MMA(0, 0, At, B0); PG8_BAR; PG8_SCHED;
            PG8_LDB(B1, 0, 1); PG8_STAGE(PG8_SB(0, 0), b2, voffB);
            PG8_BAR; PG8_WAIT_L(0); PG8_MMA(0, 1, At, B1); PG8_BAR;
            PG8_LDA(At, 0, 1); PG8_STAGE_A(PG8_SA(0, 0), k2, 0, un);
            PG8_BAR; PG8_WAIT_L(0); PG8_MMA(1, 0, At, B0); PG8_BAR; PG8_SCHED;
            PG8_STAGE(PG8_SB(0, 1), b2 + hstep, voffB);
            PG8_WAIT_V(6); PG8_BAR; PG8_MMA(1, 1, At, B1); PG8_BAR;
            PG8_LDB(B0, 1, 0); PG8_SCHED; PG8_LDA(At, 1, 0); PG8_STAGE_A(PG8_SA(0, 1), k2, 1, un);
            PG8_WAIT_L(8); PG8_BAR; PG8_WAIT_L(0); PG8_MMA(0, 0, At, B0); PG8_BAR; PG8_SCHED;
            PG8_LDB(B1, 1, 1); PG8_STAGE(PG8_SB(1, 0), b3, voffB);
            PG8_BAR; PG8_WAIT_L(0); PG8_MMA(0, 1, At, B1); PG8_BAR;
            PG8_LDA(At, 1, 1); PG8_STAGE_A(PG8_SA(1, 0), k3, 0, un);
            PG8_BAR; PG8_WAIT_L(0); PG8_MMA(1, 0, At, B0); PG8_BAR; PG8_SCHED;
            PG8_STAGE(PG8_SB(1, 1), b3 + hstep, voffB);
            PG8_WAIT_V(6); PG8_BAR; PG8_MMA(1, 1, At, B1); PG8_BAR;
            if (GP_ON(43) && t == 0) gp_acc += GP_T() - gp_t1;
            if (GP_ON(44) && t == 2) gp_acc += GP_T() - gp_t1;
        }
        if (GP_ON(41)) gp_acc += GP_T() - gp_t1;
        if (GP_ON(42)) gp_t1 = GP_T();
        if constexpr (F8) asm volatile("s_nop 15\n\ts_nop 15" ::: "memory");
        E(acc, cur, wr, wc, fr, fq, (const LAS float*)(lds + STAGE_BYTES + 8192) + ui * 256);
        if (GP_ON(42)) gp_acc += GP_T() - gp_t1;
        if (!has_next) break;
#pragma unroll
        for (int a = 0; a < 2; ++a)
#pragma unroll
            for (int b = 0; b < 2; ++b)
#pragma unroll
                for (int m = 0; m < 4; ++m)
#pragma unroll
                    for (int n = 0; n < 2; ++n) acc[a][b][m][n] = (f32x4){0.f, 0.f, 0.f, 0.f};
        cur = nxt; cB = nB; cA = nA; ++ui;
        if constexpr (Addr::LOADS) {
#pragma unroll
            for (int h = 0; h < 2; ++h)
#pragma unroll
                for (int i = 0; i < 2; ++i) oc[h][i] = on[h][i]; }
    }
    PG8_WAIT_V(0);
    if (wr == 0) PG8_BAR;
    PG8_BAR;
    if (TPROBE >= 40 && TPROBE < 50 && Epi::PID == TPGEMM && tid == 0) { gp_tot = GP_T() - gp_t0; atomicAdd((unsigned*)lds_ws_ctl + 512, gp_acc); atomicAdd((unsigned*)lds_ws_ctl + 513, gp_tot); }
#undef PG8_SA
#undef PG8_SB
#undef PG8_STAGE
#undef PG8_STAGE_A
#undef PG8_BSEL_B0
#undef PG8_BSEL_B1
#undef PG8_LDA
#undef PG8_LDB
#undef PG8_MMA
#undef PG8_WAIT_V
#undef PG8_WAIT_L
#undef PG8_BAR
#undef PG8_SCHED
}
}

#ifndef EN_HY
#define EN_HY 1
#endif
#ifndef EN_MA
#define EN_MA 1
#endif
#ifndef EN_AT
#define EN_AT 1
#endif
#ifndef EN_HG
#define EN_HG 1
#endif
#ifndef EN_MOE
#define EN_MOE 1
#endif
#ifndef MOE_F8
#define MOE_F8 1
#endif

DI void transpose_item(const float* W, int ld, int k0, int n0, bf16_t* dst, int drow0, float scale, LAS float* scr, int lane, const float* kw = nullptr) {
    {
        const int rs = lane >> 3, cq = (lane & 7) * 4;
        f32x4 v[8];
#pragma unroll
        for (int i = 0; i < 8; ++i) v[i] = __builtin_nontemporal_load((const f32x4*)(W + (size_t)(k0 + 8 * i + rs) * ld + n0 + cq));
#pragma unroll
        for (int i = 0; i < 8; ++i) { LAS float* d = scr + (8 * i + rs) * 33 + cq; d[0] = v[i].x; d[1] = v[i].y; d[2] = v[i].z; d[3] = v[i].w; }
    }
    LDS_WAIT();
    const int c = lane & 7;
    float sk[8];
#pragma unroll
    for (int i = 0; i < 8; ++i) sk[i] = kw ? scale * kw[k0 + 8 * c + i] : scale;
#pragma unroll
    for (int j = 0; j < 4; ++j) { const int n = (lane >> 3) + 8 * j; const LAS float* s = scr + (8 * c) * 33 + n;
        u32x4 o; o.x = pk2(s[0 * 33] * sk[0], s[1 * 33] * sk[1]); o.y = pk2(s[2 * 33] * sk[2], s[3 * 33] * sk[3]); o.z = pk2(s[4 * 33] * sk[4], s[5 * 33] * sk[5]); o.w = pk2(s[6 * 33] * sk[6], s[7 * 33] * sk[7]);
        *(u32x4*)(dst + (size_t)(drow0 + n) * 1024 + k0 + 8 * c) = o; }
    LDS_WAIT();
}

DI void transpose_item_f8(const float* W, int ld, int k0, int n0, unsigned char* dst, int drow0, float scale, LAS float* scr, int lane) {
    {   const int rs = lane >> 3, cq = (lane & 7) * 4;
        f32x4 v[8];
#pragma unroll
        for (int i = 0; i < 8; ++i) v[i] = __builtin_nontemporal_load((const f32x4*)(W + (size_t)(k0 + 8 * i + rs) * ld + n0 + cq));
#pragma unroll
        for (int i = 0; i < 8; ++i) { LAS float* d = scr + (8 * i + rs) * 33 + cq; d[0] = v[i].x; d[1] = v[i].y; d[2] = v[i].z; d[3] = v[i].w; }
    }
    LDS_WAIT();
    const int c = lane & 7;
#pragma unroll
    for (int j = 0; j < 4; ++j) { const int n = (lane >> 3) + 8 * j; const LAS float* s = scr + (8 * c) * 33 + n;
        u32x2 o; o.x = pk4_fp8(s[0 * 33] * scale, s[1 * 33] * scale, s[2 * 33] * scale, s[3 * 33] * scale); o.y = pk4_fp8(s[4 * 33] * scale, s[5 * 33] * scale, s[6 * 33] * scale, s[7 * 33] * scale);
        *(u32x2*)(dst + (size_t)(drow0 + n) * 1024 + k0 + 8 * c) = o; }
    LDS_WAIT();
}

#define RDL(x, i) __uint_as_float(__builtin_amdgcn_readlane(__float_as_uint(x), (i)))
DI void hyena_filter_pos(const Params& P, int l, int pos, int lane, bf16_t* kfilt) {
    const float TWO_PI = 6.283185307179586f;
    const float tpos = (float)pos * (1.0f / 2047.0f);
    float z = 0.f;
    if (lane == 0) z = tpos;
    else if (lane <= 32) { const int bnd = (lane - 1) & 15; const float f = 1e-4f + (float)bnd * ((15.0f - 1e-4f) / 15.0f);
        const float angp = TWO_PI * (float)pos / 2048.0f; const float ang = angp * f; z = (lane <= 16) ? cosf(ang) : -sinf(ang); }
    const float* w1 = P.hy_w1 + (size_t)l * 33 * 64; const float* w2 = P.hy_w2 + (size_t)l * 64 * 64; const float* w3 = P.hy_w3 + (size_t)l * 64 * 512;
    const float fr = P.hy_freq[l * 64 + lane];
    float a = P.hy_b1[l * 64 + lane];
#pragma unroll 11
    for (int i = 0; i < 33; ++i) a += RDL(z, i) * w1[i * 64 + lane];
    const float h1 = sinf(fr * a);
    float a2 = P.hy_b2[l * 64 + lane];
#pragma unroll 16
    for (int i = 0; i < 64; ++i) a2 += RDL(h1, i) * w2[i * 64 + lane];
    const float h2 = sinf(fr * a2);
    float h3[8];
#pragma unroll
    for (int k = 0; k < 8; ++k) h3[k] = 0.f;
#pragma unroll 8
    for (int i = 0; i < 64; ++i) { const float hv = RDL(h2, i);
#pragma unroll
        for (int k = 0; k < 8; ++k) h3[k] += hv * w3[i * 512 + k * 64 + lane]; }
    const float min_decay = -3.0701134573253944f, max_decay = -15.350567286626972f;
#pragma unroll
    for (int k = 0; k < 8; ++k) { const int cp = k * 64 + lane, c = cp & 255;
        const float delta = fabsf(min_decay + (float)c * ((max_decay - min_decay) / 255.0f));
        float v = h3[k] * expf(-tpos * delta);
        if (cp < 256) { if (pos == 0) { v += P.hy_fbias[l * 256 + c]; kfilt[(size_t)c * 4096 + 4095] = 0; } kfilt[(size_t)c * 4096 + 2047 - pos] = f2bf(v); }
        else if (pos >= 1) kfilt[(size_t)c * 4096 + 2047 + pos] = f2bf(v); }
}
#undef RDL

struct SelRows { int cnt; unsigned o0, o1, o2, o3; };
DI SelRows sel_compact(int sl, int b) {
    SelRows r; r.cnt = 0; r.o0 = r.o1 = r.o2 = r.o3 = 0u;
#pragma unroll
    for (int e = 0; e < 16; ++e) { const int s = __builtin_amdgcn_readlane(sl, e); const bool on = s >= 0; const unsigned v = (unsigned)((b * 16 + e) * 256 + s);
        r.o0 = (on && r.cnt == 0) ? v : r.o0; r.o1 = (on && r.cnt == 1) ? v : r.o1; r.o2 = (on && r.cnt == 2) ? v : r.o2; r.o3 = (on && r.cnt == 3) ? v : r.o3; r.cnt += on ? 1 : 0; }
    return r;
}
typedef float f32x2_ __attribute__((ext_vector_type(2)));
DI void ye_load(const unsigned char* YE, unsigned o, int lane, unsigned (&t)[4]) { const unsigned* yr = (const unsigned*)(YE + (size_t)o * DM) + lane;
#pragma unroll
    for (int j = 0; j < 4; ++j) t[j] = yr[64 * j]; }
DI void ye_add(f32x4 (&v)[4], const unsigned (&t)[4]) {
#pragma unroll
    for (int j = 0; j < 4; ++j) { const f32x2_ a = __builtin_amdgcn_cvt_pk_f32_fp8((int)t[j], false), b = __builtin_amdgcn_cvt_pk_f32_fp8((int)t[j], true);
        v[j].x += a.x * (1.0f / 64.0f); v[j].y += a.y * (1.0f / 64.0f); v[j].z += b.x * (1.0f / 64.0f); v[j].w += b.y * (1.0f / 64.0f); } }
template <bool FINAL>
DI void pre_rows2(const Params& P, int l, const int (&m)[2], int lane, const LAS f32x4* dtw, const float* nw, const int (&slp)[2]) {
    unsigned char* ws = P.ws;
    bf16_t* XB = (bf16_t*)(ws + WS_XB);
    const bool first = (!FINAL && l == 0);
    f32x4 v[2][4];
    if (first) {
#pragma unroll
        for (int k = 0; k < 2; ++k) { const f32x4* xr = (const f32x4*)(P.x + (size_t)m[k] * DM) + lane;
#pragma unroll
            for (int j = 0; j < 4; ++j) v[k][j] = xr[64 * j]; }
    } else {
        u32x2 xh[2][4];
#pragma unroll
        for (int k = 0; k < 2; ++k) { const u32x2* xr = (const u32x2*)(XB + (size_t)m[k] * DM) + lane;
#pragma unroll
            for (int j = 0; j < 4; ++j) xh[k][j] = xr[64 * j]; }
#pragma unroll
        for (int k = 0; k < 2; ++k)
#pragma unroll
            for (int j = 0; j < 4; ++j) v[k][j] = (f32x4){bflo(xh[k][j].x), bfhi(xh[k][j].x), bflo(xh[k][j].y), bfhi(xh[k][j].y)};
    }
    if (!first && EN_MOE) {
        const unsigned char* YE = (const unsigned char*)(ws + WS_YE); const int* slot = (const int*)(ws + WS_SLOT);
        int sl[2]; SelRows sr[2]; (void)slot;
#pragma unroll
        for (int k = 0; k < 2; ++k) sl[k] = slp[k];
#pragma unroll
        for (int k = 0; k < 2; ++k) sr[k] = sel_compact(sl[k], m[k] >> 11);
        unsigned t[2][4][4];
#pragma unroll
        for (int k = 0; k < 2; ++k) { if (sr[k].cnt > 0) ye_load(YE, sr[k].o0, lane, t[k][0]); if (sr[k].cnt > 1) ye_load(YE, sr[k].o1, lane, t[k][1]);
            if (sr[k].cnt > 2) ye_load(YE, sr[k].o2, lane, t[k][2]); if (sr[k].cnt > 3) ye_load(YE, sr[k].o3, lane, t[k][3]); }
#pragma unroll
        for (int k = 0; k < 2; ++k) { if (sr[k].cnt > 0) ye_add(v[k], t[k][0]); if (sr[k].cnt > 1) ye_add(v[k], t[k][1]); if (sr[k].cnt > 2) ye_add(v[k], t[k][2]); if (sr[k].cnt > 3) ye_add(v[k], t[k][3]);
            if (sr[k].cnt > 4) {
                int seen = 0; const int b = m[k] >> 11;
                for (int e = 0; e < 16; ++e) { const int s = __builtin_amdgcn_readlane(sl[k], e);
                    if (s >= 0) { if (seen >= 4) { unsigned tt[4]; ye_load(YE, (unsigned)((b * 16 + e) * 256 + s), lane, tt); ye_add(v[k], tt); } ++seen; } } } }
    }
    float rr[2];
#pragma unroll
    for (int k = 0; k < 2; ++k) {
        float s = 0.f;
#pragma unroll
        for (int j = 0; j < 4; ++j) s += (v[k][j].x * v[k][j].x + v[k][j].y * v[k][j].y) + (v[k][j].z * v[k][j].z + v[k][j].w * v[k][j].w);
        rr[k] = __builtin_amdgcn_rsqf(wave_sum(s) * (1.0f / DM) + EPSN);
    }
    if (FINAL) {
#pragma unroll
        for (int k = 0; k < 2; ++k) { f32x4* o = (f32x4*)(P.out + (size_t)m[k] * DM) + lane;
#pragma unroll
            for (int j = 0; j < 4; ++j) { const f32x4 w = ((const f32x4*)nw)[64 * j + lane]; o[64 * j] = v[k][j] * rr[k] * w; } }
        return;
    }
    {
#pragma unroll
        for (int k = 0; k < 2; ++k) { u32x2* o = (u32x2*)(XB + (size_t)m[k] * DM) + lane;
#pragma unroll
            for (int j = 0; j < 4; ++j) o[64 * j] = (u32x2){pk2(v[k][j].x, v[k][j].y), pk2(v[k][j].z, v[k][j].w)}; } }
    float d[2][8];
#pragma unroll
    for (int k = 0; k < 2; ++k)
#pragma unroll
        for (int c = 0; c < 8; ++c) d[k][c] = 0.f;
#pragma unroll
    for (int j = 0; j < 4; ++j) {
#pragma unroll
        for (int q = 0; q < 4; ++q) { const f32x4 w0 = dtw[((j * 4 + q) * 2 + 0) * 64 + lane], w1 = dtw[((j * 4 + q) * 2 + 1) * 64 + lane];
#pragma unroll
            for (int k = 0; k < 2; ++k) { const float xv = q == 0 ? v[k][j].x : (q == 1 ? v[k][j].y : (q == 2 ? v[k][j].z : v[k][j].w));
                d[k][0] += xv * w0.x; d[k][1] += xv * w0.y; d[k][2] += xv * w0.z; d[k][3] += xv * w0.w; d[k][4] += xv * w1.x; d[k][5] += xv * w1.y; d[k][6] += xv * w1.z; d[k][7] += xv * w1.w; } }
    }
#pragma unroll
    for (int k = 0; k < 2; ++k) {
        float mine = 0.f;
#pragma unroll
        for (int c = 0; c < 8; ++c) { const float t2 = wave_sum(d[k][c]); mine = (lane == c) ? t2 : mine; }
        if (lane < 8) ((float*)(ws + WS_DT))[(size_t)m[k] * 8 + lane] = mine * rr[k];
        if (lane == 8) ((float*)(ws + WS_MSQ))[m[k]] = rr[k];
    }
    (void)nw;
}

DI void phase_pre(const Params& P, int l, LAS unsigned char* lds) {
    const int tid = tid_opaque(P.wv), lane = tid & 63, wave = tid >> 6;
    const int gw = blockIdx.x * 8 + wave, NGW = gridDim.x * 8;
    unsigned char* ws = P.ws;
    LAS float* dtwf = (LAS float*)lds;
    const float* win_ = P.w_in; asm volatile("" : "+s"(win_));
    for (int i = tid; i < 1024 * 8; i += 512) { const int k = i >> 3, c = i & 7; const int j = k >> 8, ln = (k & 255) >> 2, q = k & 3;
        dtwf[((((j * 4 + q) * 2 + (c >> 2)) * 64 + ln) << 2) + (c & 3)] = P.norm_mix_w[l * DM + k] * win_[((size_t)l * DM + k) * NIN_REF + 1536 + c]; }
    __syncthreads();
    if (EN_HY) for (int pos = gw; pos < SEQ; pos += NGW) hyena_filter_pos(P, l, pos, lane, (bf16_t*)(ws + WS_KFILT));
    {
        LAS float* scr = (LAS float*)(lds + 32768 + wave * 8448);
        constexpr int I_A = 16 * 48, I_B = 16 * 64, I_O = 16 * 32, I_E = 16 * 32 * 16;
        constexpr int NITEMS = I_A + I_B + I_O; (void)I_E;
        bf16_t* WinT = (bf16_t*)(ws + WS_WIN); bf16_t* WoutT = (bf16_t*)(ws + WS_WOUT); bf16_t* WguT = (bf16_t*)(ws + WS_WGU); bf16_t* WdT = (bf16_t*)(ws + WS_WD);
        for (int it = gw; it < NITEMS; it += NGW) {
            int r = it;
            if (r < I_A) { const int kb = r / 48, nb = r % 48; transpose_item(P.w_in + (size_t)l * DM * NIN_REF, NIN_REF, 64 * kb, 32 * nb, WinT, 32 * nb, 1.0f, scr, lane, P.norm_mix_w + l * DM); continue; } r -= I_A;
            if (r < I_B) { const int kb = r / 64, nb = r % 64; const int drow = 1536 + 32 * nb; transpose_item(P.w_in + (size_t)l * DM * NIN_REF, NIN_REF, 64 * kb, 1544 + 32 * nb, WinT, drow, drow < PC_AK ? 0.125f * 1.4426950408889634f : 1.0f  , scr, lane, P.norm_mix_w + l * DM); continue; } r -= I_B;
            { const int kb = r / 32, nb = r % 32; transpose_item(P.w_out + (size_t)l * DM * DM, DM, 64 * kb, 32 * nb, WoutT, 32 * nb, 1.0f, scr, lane); }
            (void)WguT; (void)WdT;
        }
    }
    const float* nw = P.norm_mix_w + l * DM;
    {
        const int* slotp = (const int*)(ws + WS_SLOT); const bool comb = (l != 0) && EN_MOE;
        int sln[2] = {0, 0};
        if (comb && gw < NTOK) { sln[0] = slotp[(size_t)gw * 16 + (lane & 15)]; sln[1] = slotp[(size_t)((gw + NGW < NTOK) ? gw + NGW : gw) * 16 + (lane & 15)]; }
        for (int m = gw; m < NTOK; m += 2 * NGW) { asm volatile("" ::: "memory"); const int mm[2] = {m, (m + NGW < NTOK) ? m + NGW : m};
            const int slc[2] = {sln[0], sln[1]}; const int mn = m + 2 * NGW;
            if (comb && mn < NTOK) { sln[0] = slotp[(size_t)mn * 16 + (lane & 15)]; sln[1] = slotp[(size_t)((mn + NGW < NTOK) ? mn + NGW : mn) * 16 + (lane & 15)]; }
            pre_rows2<false>(P, l, mm, lane, (const LAS f32x4*)dtwf, nw, slc); }
    }
}
DI void phase_final(const Params& P) {
    const int tid = tid_opaque(P.wv), lane = tid & 63, wave = tid >> 6;
    const int gw = blockIdx.x * 8 + wave, NGW = gridDim.x * 8;
    {
        const int* slotp = (const int*)(P.ws + WS_SLOT); const bool comb = EN_MOE;
        int sln[2] = {0, 0};
        if (comb && gw < NTOK) { sln[0] = slotp[(size_t)gw * 16 + (lane & 15)]; sln[1] = slotp[(size_t)((gw + NGW < NTOK) ? gw + NGW : gw) * 16 + (lane & 15)]; }
        for (int m = gw; m < NTOK; m += 2 * NGW) { const int mm[2] = {m, (m + NGW < NTOK) ? m + NGW : m};
            const int slc[2] = {sln[0], sln[1]}; const int mn = m + 2 * NGW;
            if (comb && mn < NTOK) { sln[0] = slotp[(size_t)mn * 16 + (lane & 15)]; sln[1] = slotp[(size_t)((mn + NGW < NTOK) ? mn + NGW : mn) * 16 + (lane & 15)]; }
            pre_rows2<true>(P, 1, mm, lane, nullptr, P.final_w, slc); }
    }
}

struct AddrPlain { static constexpr bool LOADS = false; int K; int nb_rows;
    DI unsigned arow(const pg8::Unit& u, int r) const { return (unsigned)(u.pm * 256 + r) * (unsigned)(K * 2); }
    DI size_t boff(const pg8::Unit& u) const { return (size_t)u.pn * 256 * K * 2; } };
DI int moe_panel(int r) { return (r & 31) * 16 + (r >> 5); }
struct AddrGateUp { static constexpr bool LOADS = true; const int* seli;
    DI unsigned arow(const pg8::Unit& u, int r) const { const int b = u.pm & 31; const int t = seli[moe_panel(u.pm) * 256 + r]; return (unsigned)(b * SEQ + t) * (unsigned)(DM * 2); }
    DI unsigned short arow_tok(const pg8::Unit& u, int r) const { return (unsigned short)seli[moe_panel(u.pm) * 256 + r]; }
    DI unsigned arow_lds(const LAS unsigned char* tab, int k, const pg8::Unit& u, int r) const { const int b = u.pm & 31; const int t = ((const LAS unsigned short*)tab)[k * 256 + r]; return (unsigned)(b * SEQ + t) * (unsigned)(DM * 2); }
    DI size_t boff(const pg8::Unit& u) const { return ((size_t)(u.pm >> 5) * 2048 + (size_t)u.pn * 256) * DM * 2; } };
struct AddrGateUp8 { static constexpr bool LOADS = true; static constexpr int SC_W = 0x79797979, SC_X = 0x7f7f7f7f; const int* seli;
    DI unsigned arow(const pg8::Unit& u, int r) const { const int b = u.pm & 31; const int t = seli[moe_panel(u.pm) * 256 + r]; return (unsigned)(b * SEQ + t) * (unsigned)DM; }
    DI unsigned short arow_tok(const pg8::Unit& u, int r) const { return (unsigned short)seli[moe_panel(u.pm) * 256 + r]; }
    DI unsigned arow_lds(const LAS unsigned char* tab, int k, const pg8::Unit& u, int r) const { const int b = u.pm & 31; const int t = ((const LAS unsigned short*)tab)[k * 256 + r]; return (unsigned)(b * SEQ + t) * (unsigned)DM; }
    DI size_t boff(const pg8::Unit& u) const { return ((size_t)(u.pm >> 5) * 2048 + (size_t)u.pn * 256) * DM; } };
struct AddrDown8 { static constexpr bool LOADS = false; static constexpr int SC_W = 0x79797979, SC_X = 0x7c7c7c7c;
    DI unsigned arow(const pg8::Unit& u, int r) const { return (unsigned)(moe_panel(u.pm) * 256 + r) * (unsigned)DM; }
    DI size_t boff(const pg8::Unit& u) const { return ((size_t)(u.pm >> 5) * 1024 + (size_t)u.pn * 256) * DM; } };
struct AddrDown { static constexpr bool LOADS = false;
    DI unsigned arow(const pg8::Unit& u, int r) const { return (unsigned)(moe_panel(u.pm) * 256 + r) * (unsigned)(DM * 2); }
    DI size_t boff(const pg8::Unit& u) const { return ((size_t)(u.pm >> 5) * 1024 + (size_t)u.pn * 256) * DM * 2; } };

struct EpiProj { static constexpr int PID = 1; static constexpr bool PERM = true, ROWTAB = true; bf16_t* O; const float* rsm;
    DI float rowscale(const pg8::Unit& u, int r) const { return rsm[u.pm * 256 + r]; }
    DI void operator()(const f32x4 (&acc)[2][2][4][2], const pg8::Unit& u, int wr, int wc, int fr, int fq, const LAS float* rtab) const {
        const int row0 = u.pm * 256 + wr * 64 + fr, col0 = u.pn * 256 + wc * 32 + 8 * fq;
#pragma unroll
        for (int ai = 0; ai < 2; ++ai)
#pragma unroll
            for (int m = 0; m < 4; ++m) { bf16_t* rowp = O + (size_t)(row0 + ai * 128 + m * 16) * NPROJ + col0; const float g = rtab[wr * 64 + fr + ai * 128 + m * 16];
#pragma unroll
                for (int bj = 0; bj < 2; ++bj) { const f32x4 v0 = acc[ai][bj][m][0] * g, v1 = acc[ai][bj][m][1] * g;
                    u32x4 w; w.x = pk2(v0[0], v0[1]); w.y = pk2(v0[2], v0[3]); w.z = pk2(v1[0], v1[1]); w.w = pk2(v1[2], v1[3]);
                    *(u32x4*)(rowp + bj * 128) = w; } }
    } };
struct EpiRes { static constexpr int PID = 5; static constexpr bool PERM = true, ROWTAB = false; const float* base32; const bf16_t* base16; bf16_t* out;
    DI void operator()(const f32x4 (&acc)[2][2][4][2], const pg8::Unit& u, int wr, int wc, int fr, int fq, const LAS float* rtab) const {
        const int row0 = u.pm * 256 + wr * 64 + fr, col0 = u.pn * 256 + wc * 32 + 8 * fq;
#pragma unroll
        for (int ai = 0; ai < 2; ++ai)
#pragma unroll
            for (int m = 0; m < 4; ++m) { const size_t off = (size_t)(row0 + ai * 128 + m * 16) * DM + col0;
#pragma unroll
                for (int bj = 0; bj < 2; ++bj) { f32x4 v0 = acc[ai][bj][m][0], v1 = acc[ai][bj][m][1];
                    if (base32) { v0 = v0 + *(const f32x4*)(base32 + off + bj * 128); v1 = v1 + *(const f32x4*)(base32 + off + bj * 128 + 4); }
                    else { const u32x4 bs = *(const u32x4*)(base16 + off + bj * 128);
                        v0 = v0 + (f32x4){bflo(bs.x), bfhi(bs.x), bflo(bs.y), bfhi(bs.y)}; v1 = v1 + (f32x4){bflo(bs.z), bfhi(bs.z), bflo(bs.w), bfhi(bs.w)}; }
                    u32x4 w; w.x = pk2(v0[0], v0[1]); w.y = pk2(v0[2], v0[3]); w.z = pk2(v1[0], v1[1]); w.w = pk2(v1[2], v1[3]);
                    *(u32x4*)(out + off + bj * 128) = w; } }
    } };
struct EpiGateUp { static constexpr int PID = 18; static constexpr bool PERM = true, ROWTAB = true; bf16_t* H; const float* selr;
    DI float rowscale(const pg8::Unit& u, int r) const { return selr[moe_panel(u.pm) * 256 + r]; }
    DI void operator()(const f32x4 (&acc)[2][2][4][2], const pg8::Unit& u, int wr, int wc, int fr, int fq, const LAS float* rtab) const {
        const int row0 = moe_panel(u.pm) * 256 + wr * 64 + fr, col0 = u.pn * 128 + wc * 32 + 8 * fq;
#pragma unroll
        for (int ai = 0; ai < 2; ++ai)
#pragma unroll
            for (int m = 0; m < 4; ++m) { bf16_t* rowp = H + (size_t)(row0 + ai * 128 + m * 16) * DM + col0; const float rr = rtab[wr * 64 + fr + ai * 128 + m * 16];
                float hv[8];
#pragma unroll
                for (int n = 0; n < 2; ++n)
#pragma unroll
                    for (int j = 0; j < 4; ++j) { const float g = acc[ai][0][m][n][j] * rr, up = acc[ai][1][m][n][j] * rr; hv[n * 4 + j] = silu_f(g) * up; }
                u32x4 w; w.x = pk2(hv[0], hv[1]); w.y = pk2(hv[2], hv[3]); w.z = pk2(hv[4], hv[5]); w.w = pk2(hv[6], hv[7]);
                *(u32x4*)rowp = w; }
    } };
struct EpiGateUp8 { static constexpr int PID = 8; static constexpr bool PERM = true, ROWTAB = true; unsigned char* H; const float* selr;
    DI float rowscale(const pg8::Unit& u, int r) const { return selr[moe_panel(u.pm) * 256 + r]; }
    DI void operator()(const f32x4 (&acc)[2][2][4][2], const pg8::Unit& u, int wr, int wc, int fr, int fq, const LAS float* rtab) const {
        const int row0 = moe_panel(u.pm) * 256 + wr * 64 + fr, col0 = u.pn * 128 + wc * 32 + 8 * fq;
#pragma unroll
        for (int ai = 0; ai < 2; ++ai)
#pragma unroll
            for (int m = 0; m < 4; ++m) { unsigned char* rowp = H + (size_t)(row0 + ai * 128 + m * 16) * DM + col0; const float rr = rtab[wr * 64 + fr + ai * 128 + m * 16]; const float c1 = -1.4426950408889634f * rr, k2 = 8.0f * rr * rr;
                float hv[8];
#pragma unroll
                for (int n = 0; n < 2; ++n)
#pragma unroll
                    for (int j = 0; j < 4; ++j) { const float g = acc[ai][0][m][n][j], up = acc[ai][1][m][n][j];
                        hv[n * 4 + j] = (g * up) * (k2 * __builtin_amdgcn_rcpf(1.0f + __builtin_amdgcn_exp2f(g * c1))); }
                *(u32x2*)rowp = (u32x2){pk4_fp8(hv[0], hv[1], hv[2], hv[3]), pk4_fp8(hv[4], hv[5], hv[6], hv[7])}; }
    } };
struct EpiDown { static constexpr int PID = 9; static constexpr bool PERM = true, ROWTAB = true; unsigned char* Y; const float* gate;
    DI float rowscale(const pg8::Unit& u, int r) const { return gate[moe_panel(u.pm) * 256 + r]; }
    DI void operator()(const f32x4 (&acc)[2][2][4][2], const pg8::Unit& u, int wr, int wc, int fr, int fq, const LAS float* rtab) const {
        const int row0 = moe_panel(u.pm) * 256 + wr * 64 + fr, col0 = u.pn * 256 + wc * 32 + 8 * fq;
#pragma unroll
        for (int ai = 0; ai < 2; ++ai)
#pragma unroll
            for (int m = 0; m < 4; ++m) { const int row = row0 + ai * 128 + m * 16; const float g = rtab[wr * 64 + fr + ai * 128 + m * 16] * 64.0f; unsigned char* rowp = Y + (size_t)row * DM + col0;
#pragma unroll
                for (int bj = 0; bj < 2; ++bj) { const f32x4 v0 = acc[ai][bj][m][0] * g, v1 = acc[ai][bj][m][1] * g;
                    *(u32x2*)(rowp + bj * 128) = (u32x2){pk4_fp8(v0[0], v0[1], v0[2], v0[3]), pk4_fp8(v1[0], v1[1], v1[2], v1[3])}; } }
    } };

DI void phase_premix(const Params& P, int l, LAS unsigned char* lds) {
    const int tid = tid_opaque(P.wv), lane = tid & 63, wave = tid >> 6;
    const int gw = blockIdx.x * 8 + wave, NGW = gridDim.x * 8;
    unsigned char* ws = P.ws;
    const bf16_t* proj = (const bf16_t*)(ws + WS_PROJ);
    unsigned char* dsc = (unsigned char*)P.out;
    if (EN_HY) {
        bf16_t* HW = (bf16_t*)(dsc + DO_HW); bf16_t* HX0 = (bf16_t*)(dsc + DO_HX0);
        const float* cw = P.hy_conv_w + (size_t)l * 3 * 768;
        LAS unsigned char* tl = lds + wave * 15616;
        const int rsub = lane >> 3, cch = lane & 7;
        const int i16 = lane & 15, trq = i16 >> 2, trp = i16 & 3, g16 = lane >> 4;
        const unsigned troff = (unsigned)(trq * 144 + (16 * g16 + 4 * trp) * 2);
        u32x4 rin[5][3];
#define HYPM_LOAD(IT) do { const int ct_ = (IT) & 3, tt_ = ((IT) >> 2) & 63, b_ = (IT) >> 8; const int t0_ = tt_ * 32; \
            const bf16_t* pr_ = proj + ((size_t)b_ * SEQ) * NPROJ + ct_ * 64 + 8 * cch; \
            _Pragma("unroll") for (int i = 0; i < 5; ++i) { const int rr = rsub + 8 * i; const int t = t0_ - 1 + rr; const bool ok = (rr < 34) && (t >= 0) && (t < SEQ); \
                const bf16_t* q = pr_ + (size_t)(ok ? t : 0) * NPROJ; \
                _Pragma("unroll") for (int a = 0; a < 3; ++a) { rin[i][a] = *(const u32x4*)(q + 256 * a); if (!ok) rin[i][a] = (u32x4){0u, 0u, 0u, 0u}; } } } while (0)
        if (gw < NB * 64 * 4) HYPM_LOAD(gw);
        for (int it = gw; it < NB * 64 * 4; it += NGW) {
            const int ct = it & 3, tt = (it >> 2) & 63, b = it >> 8;
            const int c = ct * 64 + lane, t0 = tt * 32;
#pragma unroll
            for (int i = 0; i < 5; ++i) { const int rr = rsub + 8 * i;
#pragma unroll
                for (int a = 0; a < 3; ++a) if (rr < 36) *(LAS u32x4*)(tl + a * 5184 + rr * 144 + 16 * cch) = rin[i][a]; }
            if (it + NGW < NB * 64 * 4) HYPM_LOAD(it + NGW);
            float w0[3], w1[3], w2[3];
#pragma unroll
            for (int j = 0; j < 3; ++j) { w0[j] = cw[j * 768 + c]; w1[j] = cw[j * 768 + 256 + c]; w2[j] = cw[j * 768 + 512 + c]; }
            LDS_WAIT();
            float p0[4], p1[4], p2[4];
            unsigned hwv[16], hxv[16];
#pragma unroll
            for (int j = 0; j < 9; ++j) {
                const s16x4 r0 = __builtin_amdgcn_ds_read_tr16_b64_v4i16((LAS s16x4*)(tl + 0 * 5184 + troff + (4 * j) * 144));
                const s16x4 r1 = __builtin_amdgcn_ds_read_tr16_b64_v4i16((LAS s16x4*)(tl + 1 * 5184 + troff + (4 * j) * 144));
                const s16x4 r2 = __builtin_amdgcn_ds_read_tr16_b64_v4i16((LAS s16x4*)(tl + 2 * 5184 + troff + (4 * j) * 144));
                float c0[4], c1[4], c2[4];
#pragma unroll
                for (int k = 0; k < 4; ++k) { c0[k] = bf2f((unsigned short)r0[k]); c1[k] = bf2f((unsigned short)r1[k]); c2[k] = bf2f((unsigned short)r2[k]); }
                if (j > 0) {
                    float u0[4], hv[4];
#pragma unroll
                    for (int k = 0; k < 4; ++k) { const float a0 = p0[k], a1 = p1[k], a2 = p2[k];
                        const float b0 = (k < 3) ? p0[k + 1] : c0[0], b1 = (k < 3) ? p1[k + 1] : c1[0], b2 = (k < 3) ? p2[k + 1] : c2[0];
                        const float d0 = (k < 2) ? p0[k + 2] : c0[k - 2], d1 = (k < 2) ? p1[k + 2] : c1[k - 2], d2 = (k < 2) ? p2[k + 2] : c2[k - 2];
                        u0[k] = w0[0] * a0 + w0[1] * b0 + w0[2] * d0;
                        hv[k] = (w2[0] * a2 + w2[1] * b2 + w2[2] * d2) * (w1[0] * a1 + w1[1] * b1 + w1[2] * d1); }
                    hwv[2 * (j - 1)] = pk2(hv[0], hv[1]); hwv[2 * (j - 1) + 1] = pk2(hv[2], hv[3]); hxv[2 * (j - 1)] = pk2(u0[0], u0[1]); hxv[2 * (j - 1) + 1] = pk2(u0[2], u0[3]);
                }
#pragma unroll
                for (int k = 0; k < 4; ++k) { p0[k] = c0[k]; p1[k] = c1[k]; p2[k] = c2[k]; }
            }
            bf16_t* hwp = HW + ((size_t)c * NB + b) * SEQ + t0; bf16_t* hxp = HX0 + ((size_t)c * NB + b) * SEQ + t0;
#pragma unroll
            for (int k = 0; k < 4; ++k) { *(u32x4*)(hwp + 8 * k) = (u32x4){hwv[4 * k], hwv[4 * k + 1], hwv[4 * k + 2], hwv[4 * k + 3]}; *(u32x4*)(hxp + 8 * k) = (u32x4){hxv[4 * k], hxv[4 * k + 1], hxv[4 * k + 2], hxv[4 * k + 3]}; }
            LDS_WAIT();
        }
    }
    if (EN_MA) {
        bf16_t* MX = (bf16_t*)(dsc + DO_MXBC);
        const float* cw = P.m_conv_w + (size_t)l * 5 * 512; const float* cb = P.m_conv_b + (size_t)l * 512;
        const int gt = blockIdx.x * 512 + tid, NGT = gridDim.x * 512;
        for (int it = gt; it < (NTOK / 4) * 64; it += NGT) {
            const int ch = (it & 63) * 8, m0 = (it >> 6) * 4, t0 = m0 & (SEQ - 1);
            u32x4 rw[8];
#pragma unroll
            for (int j = 0; j < 8; ++j) { const int tt = t0 + j - 2; const bool ok = (tt >= 0) && (tt < SEQ);
                rw[j] = *(const u32x4*)(proj + (size_t)(ok ? m0 + j - 2 : m0) * NPROJ + PC_MX + ch); if (!ok) rw[j] = (u32x4){0u, 0u, 0u, 0u}; }
            f32x4 wa[5], wb[5];
#pragma unroll
            for (int j = 0; j < 5; ++j) { wa[j] = *(const f32x4*)(cw + j * 512 + ch); wb[j] = *(const f32x4*)(cw + j * 512 + ch + 4); }
            const f32x4 ba = *(const f32x4*)(cb + ch), bb = *(const f32x4*)(cb + ch + 4);
#pragma unroll
            for (int k = 0; k < 4; ++k) {
                float a[8] = {ba.x, ba.y, ba.z, ba.w, bb.x, bb.y, bb.z, bb.w};
#pragma unroll
                for (int j = 0; j < 5; ++j) { const u32x4 v = rw[k + j];
                    a[0] += wa[j].x * bflo(v.x); a[1] += wa[j].y * bfhi(v.x); a[2] += wa[j].z * bflo(v.y); a[3] += wa[j].w * bfhi(v.y);
                    a[4] += wb[j].x * bflo(v.z); a[5] += wb[j].y * bfhi(v.z); a[6] += wb[j].z * bflo(v.w); a[7] += wb[j].w * bfhi(v.w); }
                u32x4 o; o.x = pk2(silu_f(a[0]), silu_f(a[1])); o.y = pk2(silu_f(a[2]), silu_f(a[3])); o.z = pk2(silu_f(a[4]), silu_f(a[5])); o.w = pk2(silu_f(a[6]), silu_f(a[7]));
                *(u32x4*)(MX + (size_t)(m0 + k) * 512 + ch) = o;
            }
        }
    }
}

DI void phase_finalize(const Params& P, int l) {
    const int tid = tid_opaque(P.wv), lane = tid & 63, wave = tid >> 6;
    const int gw = blockIdx.x * 8 + wave, NGW = gridDim.x * 8;
    unsigned char* ws = P.ws; unsigned char* dsc = (unsigned char*)P.out;
    bf16_t* MIX = (bf16_t*)(ws + WS_HN);
    {
        const bf16_t* YAT = (const bf16_t*)(dsc + DO_YAT);
        for (int it = gw; it < NB * 32 * 4; it += NGW) {
            const int ct = it & 3, tt = (it >> 2) & 31, b = it >> 7;
            const int c = ct * 64 + lane, t0 = tt * 64;
            const bf16_t* src = YAT + ((size_t)c * NB + b) * SEQ + t0;
            bf16_t* dst = MIX + ((size_t)b * SEQ + t0) * DM + c;
#pragma unroll 2
            for (int t8 = 0; t8 < 64; t8 += 8) {
                u32x4 v = EN_HY ? *(const u32x4*)(src + t8) : (u32x4){0u, 0u, 0u, 0u};
                const unsigned w[4] = {v.x, v.y, v.z, v.w};
#pragma unroll
                for (int i = 0; i < 8; ++i) dst[(size_t)(t8 + i) * DM] = (bf16_t)((i & 1) ? (w[i >> 1] >> 16) : (w[i >> 1] & 0xffffu));
            }
        }
    }
    {
        const bf16_t* MYF = (const bf16_t*)(dsc + DO_MY); const bf16_t* MYB = (const bf16_t*)(ws + WS_MYB); const bf16_t* MX = (const bf16_t*)(dsc + DO_MXBC);
        const bf16_t* OB = (const bf16_t*)(ws + WS_OB); const bf16_t* proj = (const bf16_t*)(ws + WS_PROJ);
        const float* nwm = P.m_norm_w + l * 256; const float* nwh = P.hg_norm_w + l * 64;
        const int gt = blockIdx.x * 512 + tid, NGT = gridDim.x * 512;
        for (int it = gt; it < NTOK * 32; it += NGT) {
            const int ch = (it & 31) * 8, m = it >> 5;
            const u32x4 yf = *(const u32x4*)(MYF + (size_t)m * 256 + ch), yb = *(const u32x4*)(MYB + (size_t)m * 256 + ch), xv = *(const u32x4*)(MX + (size_t)m * 512 + ch), zv = *(const u32x4*)(proj + (size_t)m * NPROJ + PC_MZ + ch);
            const u32x4 of = *(const u32x4*)(MIX + (size_t)m * DM + 768 + ch), ob = *(const u32x4*)(OB + (size_t)m * 256 + ch), gv = *(const u32x4*)(proj + (size_t)m * NPROJ + PC_HG + ch);
            u32x4 o = {0u, 0u, 0u, 0u};
            if (EN_MA) {
                const float Dk = P.m_D[l * 4 + (ch >> 6)];
                const unsigned yfw[4] = {yf.x, yf.y, yf.z, yf.w}, ybw[4] = {yb.x, yb.y, yb.z, yb.w}, xw[4] = {xv.x, xv.y, xv.z, xv.w}, zw[4] = {zv.x, zv.y, zv.z, zv.w};
                float y[8]; float sq = 0.f;
#pragma unroll
                for (int j = 0; j < 4; ++j) { y[2 * j] = (bflo(yfw[j]) + bflo(ybw[j]) + Dk * bflo(xw[j])) * silu_f(bflo(zw[j])); y[2 * j + 1] = (bfhi(yfw[j]) + bfhi(ybw[j]) + Dk * bfhi(xw[j])) * silu_f(bfhi(zw[j]));
                    sq += y[2 * j] * y[2 * j] + y[2 * j + 1] * y[2 * j + 1]; }
                sq = x16_sum(row_sum16(sq));
                const float r = __builtin_amdgcn_rsqf(sq * (1.0f / 256.0f) + EPSN);
                const f32x4 wa = *(const f32x4*)(nwm + ch), wb = *(const f32x4*)(nwm + ch + 4);
                o.x = pk2(y[0] * r * wa.x, y[1] * r * wa.y); o.y = pk2(y[2] * r * wa.z, y[3] * r * wa.w); o.z = pk2(y[4] * r * wb.x, y[5] * r * wb.y); o.w = pk2(y[6] * r * wb.z, y[7] * r * wb.w);
            }
            *(u32x4*)(MIX + (size_t)m * DM + 256 + ch) = o;
            if (EN_HG) {
                const unsigned ofw[4] = {of.x, of.y, of.z, of.w}, obw[4] = {ob.x, ob.y, ob.z, ob.w}, gw4[4] = {gv.x, gv.y, gv.z, gv.w};
                float y[8]; float sq = 0.f;
#pragma unroll
                for (int j = 0; j < 4; ++j) { y[2 * j] = bflo(ofw[j]) + bflo(obw[j]); y[2 * j + 1] = bfhi(ofw[j]) + bfhi(obw[j]); sq += y[2 * j] * y[2 * j] + y[2 * j + 1] * y[2 * j + 1]; }
                sq = grp_sum8(sq);
                const float r = __builtin_amdgcn_rsqf(sq * (1.0f / 64.0f) + EPSN);
                const f32x4 wa = *(const f32x4*)(nwh + (ch & 63)), wb = *(const f32x4*)(nwh + (ch & 63) + 4);
                u32x4 oh;
                oh.x = pk2(y[0] * r * wa.x * silu_f(bflo(gw4[0])), y[1] * r * wa.y * silu_f(bfhi(gw4[0]))); oh.y = pk2(y[2] * r * wa.z * silu_f(bflo(gw4[1])), y[3] * r * wa.w * silu_f(bfhi(gw4[1])));
                oh.z = pk2(y[4] * r * wb.x * silu_f(bflo(gw4[2])), y[5] * r * wb.y * silu_f(bfhi(gw4[2]))); oh.w = pk2(y[6] * r * wb.z * silu_f(bflo(gw4[3])), y[7] * r * wb.w * silu_f(bfhi(gw4[3])));
                *(u32x4*)(MIX + (size_t)m * DM + 768 + ch) = oh;
            }
        }
    }
#if !EN_AT || !EN_HG
    {
        const int gt = blockIdx.x * 512 + tid, NGT = gridDim.x * 512;
        for (int it = gt; it < NTOK * 32; it += NGT) { const int ch = (it & 31) * 8, m = it >> 5;
            if (!EN_AT) *(u32x4*)(MIX + (size_t)m * DM + 512 + ch) = (u32x4){0u, 0u, 0u, 0u};
            if (!EN_HG) *(u32x4*)(MIX + (size_t)m * DM + 768 + ch) = (u32x4){0u, 0u, 0u, 0u}; }
    }
#endif
}

DI void phase_ffnpre(const Params& P, int l, LAS unsigned char* lds) {
    const int tid = tid_opaque(P.wv), lane = tid & 63, wave = tid >> 6, r = lane & 15, q = lane >> 4;
    const int gw = blockIdx.x * 8 + wave, NGW = gridDim.x * 8;
    unsigned char* ws = P.ws;
    LAS u32x4* Wh = (LAS u32x4*)lds;
    LAS u32x4* Wl = Wh + 32 * 64;
    for (int i = tid; i < 32 * 64; i += 512) { const int s = i >> 6, ln = i & 63, e = ln & 15, qq = ln >> 4; float wv[8]; unsigned hi[4], lo[4];
#pragma unroll
        for (int j = 0; j < 8; ++j) { const int k = 32 * s + 8 * qq + j; wv[j] = P.norm_ffn_w[l * DM + k] * P.router_w[((size_t)l * DM + k) * 16 + e]; }
#pragma unroll
        for (int j = 0; j < 4; ++j) { hi[j] = pk2(wv[2 * j], wv[2 * j + 1]); lo[j] = pk2(wv[2 * j] - bflo(hi[j]), wv[2 * j + 1] - bfhi(hi[j])); }
        Wh[i] = (u32x4){hi[0], hi[1], hi[2], hi[3]}; Wl[i] = (u32x4){lo[0], lo[1], lo[2], lo[3]}; }
    __syncthreads();
    const bf16_t* XB = (const bf16_t*)(ws + WS_XB); const float* nw = P.norm_ffn_w + l * DM + 8 * q;
    float* aff = (float*)(ws + WS_AFF); float* rs = (float*)(ws + WS_RS);
    bf16_t* XN = (bf16_t*)(ws + WS_HN);
    for (int grp = gw; grp < NTOK / 16; grp += NGW) {
        const int m0 = grp * 16;
        const bf16_t* xrow = XB + (size_t)(m0 + r) * DM + 8 * q; bf16_t* orow = XN + (size_t)(m0 + r) * DM + 8 * q; unsigned char* orow8 = (unsigned char*)XN + (size_t)(m0 + r) * DM + 8 * q; (void)orow; (void)orow8;
        f32x4 acc = {0.f, 0.f, 0.f, 0.f}; float ss = 0.f;
#pragma unroll 8
        for (int s = 0; s < 32; ++s) {
            const u32x4 xv = *(const u32x4*)(xrow + 32 * s);
            const f32x4 a = {bflo(xv.x), bfhi(xv.x), bflo(xv.y), bfhi(xv.y)}, b = {bflo(xv.z), bfhi(xv.z), bflo(xv.w), bfhi(xv.w)};
            const f32x4 wa = *(const f32x4*)(nw + 32 * s), wb = *(const f32x4*)(nw + 32 * s + 4);
            ss += (a.x * a.x + a.y * a.y) + (a.z * a.z + a.w * a.w) + (b.x * b.x + b.y * b.y) + (b.z * b.z + b.w * b.w);
            const bf16x8 ah = __builtin_bit_cast(bf16x8, xv);
            const bf16x8 wh = __builtin_bit_cast(bf16x8, Wh[s * 64 + lane]), wl = __builtin_bit_cast(bf16x8, Wl[s * 64 + lane]);
            acc = __builtin_amdgcn_mfma_f32_16x16x32_bf16(ah, wh, acc, 0, 0, 0);
            acc = __builtin_amdgcn_mfma_f32_16x16x32_bf16(ah, wl, acc, 0, 0, 0);
#if MOE_F8
            *(u32x2*)(orow8 + 32 * s) = (u32x2){pk4_fp8(a.x * wa.x, a.y * wa.y, a.z * wa.z, a.w * wa.w), pk4_fp8(b.x * wb.x, b.y * wb.y, b.z * wb.z, b.w * wb.w)};
#else
            *(u32x4*)(orow + 32 * s) = (u32x4){pk2(a.x * wa.x, a.y * wa.y), pk2(a.z * wa.z, a.w * wa.w), pk2(b.x * wb.x, b.y * wb.y), pk2(b.z * wb.z, b.w * wb.w)};
#endif
        }
        ss = xhalf_sum(x16_sum(ss));
        const float rinv = __builtin_amdgcn_rsqf(ss * (1.0f / DM) + EPSN);
        if (q == 0) rs[m0 + r] = rinv;
#pragma unroll
        for (int i = 0; i < 4; ++i) {
            const float lg = acc[i] * __shfl(rinv, 4 * q + i);
            const float mx = grp_max16(lg);
            const float ex = expf(lg - mx); const float se = row_sum16(ex);
            const int m = m0 + 4 * q + i;
            aff[((size_t)(m >> 11) * 16 + r) * SEQ + (m & (SEQ - 1))] = ex / se;
        }
    }
}

DI int wave_sum_i(int v) {
#pragma unroll
    for (int o = 1; o < 64; o <<= 1) v += __shfl_xor(v, o);
    return v;
}
DI int half_excl_scan(int c, int lane, int hw, LAS int* ws4, int* tot) {
    int inc = c;
#pragma unroll
    for (int o = 1; o < 64; o <<= 1) { const int t = __shfl_up(inc, o); if (lane >= o) inc += t; }
    if (lane == 63) ws4[hw] = inc;
    __syncthreads();
    int base = 0, total = 0;
#pragma unroll
    for (int w = 0; w < 4; ++w) { const int t = ws4[w]; base += (w < hw) ? t : 0; total += t; }
    *tot = total;
    return base + inc - c;
}
DI void phase_topk(const Params& P, int l, LAS unsigned char* lds) {
    const int tid = tid_opaque(P.wv), lane = tid & 63, wave = tid >> 6;
    unsigned char* ws = P.ws;
    const float* aff = (const float*)(ws + WS_AFF); const float* rs = (const float*)(ws + WS_RS);
    int* slot = (int*)(ws + WS_SLOT); int* seli = (int*)(ws + WS_SELI); float* selg = (float*)(ws + WS_SELG); float* selr = (float*)(ws + WS_SELR);
    const int half = wave >> 2, hw = wave & 3, ht = tid & 255;
    LAS int* wsum = (LAS int*)lds + half * 64;
    for (int u0 = blockIdx.x; u0 < NB * NEXP; u0 += 2 * gridDim.x) {
        const int u = u0 + half * gridDim.x; const bool live = u < NB * NEXP; const int uu = live ? u : u0;
        const int b = uu >> 4, e = uu & 15;
        __syncthreads();
        const u32x4 ka = *(const u32x4*)(aff + (size_t)uu * SEQ + 8 * ht), kb = *(const u32x4*)(aff + (size_t)uu * SEQ + 8 * ht + 4);
        const unsigned kk[8] = {ka.x, ka.y, ka.z, ka.w, kb.x, kb.y, kb.z, kb.w};
        const f32x4 ra = *(const f32x4*)(rs + (size_t)b * SEQ + 8 * ht), rb = *(const f32x4*)(rs + (size_t)b * SEQ + 8 * ht + 4);
        const float rsv[8] = {ra.x, ra.y, ra.z, ra.w, rb.x, rb.y, rb.z, rb.w};
        unsigned prefix = 0u;
#pragma unroll 1
        for (int bit = 30; bit >= 0; bit -= (bit == 30 ? 1 : 2)) {
            const unsigned hi = 1u << bit, lo = (bit == 30) ? 0u : (1u << (bit - 1));
            const unsigned c1 = prefix | hi, c0 = prefix | lo, c3 = prefix | hi | lo;
            int n1 = 0, n0 = 0, n3 = 0;
#pragma unroll
            for (int j = 0; j < 8; ++j) { n1 += __builtin_popcountll(__ballot(kk[j] >= c1)); n0 += __builtin_popcountll(__ballot(kk[j] >= c0)); n3 += __builtin_popcountll(__ballot(kk[j] >= c3)); }
            const int par = (bit & 2) ? 12 : 0;
            if (lane == 0) { wsum[par + hw * 3] = n1; wsum[par + hw * 3 + 1] = n0; wsum[par + hw * 3 + 2] = n3; }
            __syncthreads();
            int t1 = 0, t0 = 0, t3 = 0;
#pragma unroll
            for (int q = 0; q < 4; ++q) { t1 += wsum[par + q * 3]; t0 += wsum[par + q * 3 + 1]; t3 += wsum[par + q * 3 + 2]; }
            if (bit == 30) { if (t1 >= CAP) prefix = c1; }
            else if (t1 >= CAP) prefix = (t3 >= CAP) ? c3 : c1;
            else if (t0 >= CAP) prefix = c0;
        }
        const unsigned thr = prefix;
        int cgt = 0, ceq = 0;
#pragma unroll
        for (int j = 0; j < 8; ++j) { cgt += (kk[j] > thr) ? 1 : 0; ceq += (kk[j] == thr) ? 1 : 0; }
        int ngt; (void)half_excl_scan(cgt, lane, hw, wsum + 32, &ngt);
        const int need = CAP - ngt;
        int neq; int eqr = half_excl_scan(ceq, lane, hw, wsum + 36, &neq);
        bool sel[8]; int cs = 0;
#pragma unroll
        for (int j = 0; j < 8; ++j) { const bool eq = kk[j] == thr; sel[j] = (kk[j] > thr) || (eq && eqr < need); eqr += eq ? 1 : 0; cs += sel[j] ? 1 : 0; }
        int nsel; int sb = half_excl_scan(cs, lane, hw, wsum + 40, &nsel);
        if (live) {
#pragma unroll
            for (int j = 0; j < 8; ++j) { const int i = 8 * ht + j;
                slot[((size_t)b * SEQ + i) * 16 + e] = sel[j] ? sb : -1;
                if (sel[j]) { seli[u * CAP + sb] = i; selg[u * CAP + sb] = __uint_as_float(kk[j]); selr[u * CAP + sb] = rsv[j]; ++sb; } }
        }
    }
    __syncthreads();
    {
        const int gw = blockIdx.x * 8 + wave, NGW = gridDim.x * 8;
        LAS float* scr = (LAS float*)(lds + 4096 + wave * 8448);
        bf16_t* WguT = (bf16_t*)(ws + WS_WGU); bf16_t* WdT = (bf16_t*)(ws + WS_WD);
        constexpr int I_E = 16 * 32 * 16;
        for (int it = gw; it < 3 * I_E; it += NGW) {
            const int which = it / I_E; const int r = it - which * I_E;
            const int e = r / 512, kb = (r % 512) / 32, nb = r % 32;
            const size_t wofs = ((size_t)l * NEXP + e) * DM * DM;
#if MOE_F8
            if (which == 0)      transpose_item_f8(P.moe_wg + wofs, DM, 64 * kb, 32 * nb, (unsigned char*)WguT, e * 2048 + ((32 * nb) >> 7) * 256 + ((32 * nb) & 127), 64.0f, scr, lane);
            else if (which == 1) transpose_item_f8(P.moe_wu + wofs, DM, 64 * kb, 32 * nb, (unsigned char*)WguT, e * 2048 + ((32 * nb) >> 7) * 256 + 128 + ((32 * nb) & 127), 64.0f, scr, lane);
            else                 transpose_item_f8(P.moe_wd + wofs, DM, 64 * kb, 32 * nb, (unsigned char*)WdT, e * 1024 + 32 * nb, 64.0f, scr, lane);
#else
            if (which == 0)      transpose_item(P.moe_wg + wofs, DM, 64 * kb, 32 * nb, WguT, e * 2048 + ((32 * nb) >> 7) * 256 + ((32 * nb) & 127), 1.0f, scr, lane);
            else if (which == 1) transpose_item(P.moe_wu + wofs, DM, 64 * kb, 32 * nb, WguT, e * 2048 + ((32 * nb) >> 7) * 256 + 128 + ((32 * nb) & 127), 1.0f, scr, lane);
            else                 transpose_item(P.moe_wd + wofs, DM, 64 * kb, 32 * nb, WdT, e * 1024 + 32 * nb, 1.0f, scr, lane);
#endif
        }
    }
}

DI bf16x8 mk8(unsigned a, unsigned b, unsigned c, unsigned d) { u32x4 v = {a, b, c, d}; return __builtin_bit_cast(bf16x8, v); }
DI bf16x8 cat44(u32x2 lo, u32x2 hi) { u32x4 v = {lo.x, lo.y, hi.x, hi.y}; return __builtin_bit_cast(bf16x8, v); }
DI u32x4 ldg16(const void* ub, unsigned off) { return *(const u32x4*)((const char*)ub + off); }
DI u32x2 ldg8(const void* ub, unsigned off) { return *(const u32x2*)((const char*)ub + off); }
DI void stg2(void* ub, unsigned off, unsigned short v) { *(unsigned short*)((char*)ub + off) = v; }
DI int crow(int reg, int hh) { return (reg & 3) + 8 * (reg >> 2) + 4 * hh; }
#define PACK_STEP(x, s) mk8(pk2((x)[8 * (s)], (x)[8 * (s) + 1]), pk2((x)[8 * (s) + 2], (x)[8 * (s) + 3]), pk2((x)[8 * (s) + 4], (x)[8 * (s) + 5]), pk2((x)[8 * (s) + 6], (x)[8 * (s) + 7]))

#ifndef TPROBE
#define TPROBE 0
#endif
#ifndef TPWAVE
#define TPWAVE 0
#endif
#define TP_T() ({ asm volatile("" ::: "memory"); unsigned _t = (unsigned)__builtin_amdgcn_s_memrealtime(); asm volatile("" ::: "memory"); _t; })
#define TP_B(k) unsigned _tp##k = 0; if (TPROBE == (k) || ((k) == 1 && TPROBE)) _tp##k = TP_T();
#define TP_E(k) if ((k) == 1 && TPROBE) ttot += TP_T() - _tp##k; else if (TPROBE == (k)) tacc += TP_T() - _tp##k;
#ifndef HYD
#define HYD 4
#endif
DI void hyena_unit(const Params& P, int c, LAS unsigned char* lds) {
    const int tid = tid_opaque(P.wv), lane = tid & 63, w = __builtin_amdgcn_readfirstlane(tid >> 6), r = lane & 31, hh = lane >> 5;
    constexpr int CPS = 8224;
    unsigned char* ws = P.ws; unsigned char* dsc = (unsigned char*)P.out;
    const bf16_t* kf = (const bf16_t*)(ws + WS_KFILT) + (size_t)c * 4096;
    unsigned tacc = 0, ttot = 0;
    TP_B(1)
    __syncthreads();
    TP_B(81)
    {
        const u32x4 a = *(const u32x4*)(kf + 8 * tid), b = (tid < 511) ? *(const u32x4*)(kf + 8 * tid + 8) : (u32x4){0u, 0u, 0u, 0u};
        const unsigned d[9] = {a.x, a.y, a.z, a.w, b.x, b.y, b.z, b.w, 0u};
#pragma unroll
        for (int p = 0; p < 8; ++p) { const int m = p >> 1; u32x4 o;
            if (p & 1) { o.x = __builtin_amdgcn_alignbit(d[m + 1], d[m], 16); o.y = __builtin_amdgcn_alignbit(d[m + 2], d[m + 1], 16); o.z = __builtin_amdgcn_alignbit(d[m + 3], d[m + 2], 16); o.w = __builtin_amdgcn_alignbit(d[m + 4], d[m + 3], 16); }
            else { o.x = d[m]; o.y = d[m + 1]; o.z = d[m + 2]; o.w = d[m + 3]; }
            *(LAS u32x4*)(lds + p * CPS + tid * 16) = o; }
    }
    __syncthreads();
    TP_E(81)
    const bf16_t* hw = (const bf16_t*)(dsc + DO_HW) + ((size_t)c * NB + r) * SEQ + 8 * hh;
    f32x16 acc[8];
#pragma unroll
    for (int i = 0; i < 8; ++i)
#pragma unroll
        for (int q = 0; q < 16; ++q) acc[i][q] = 0.f;
    const int p = 7 - (r & 7);
    const LAS unsigned char* abase = lds + p * CPS + (2047 - 256 * w - r + 8 * hh - p) * 2;
    LAS unsigned char* Bt = lds + 8 * CPS;
    const bf16_t* hws = (const bf16_t*)(dsc + DO_HW) + ((size_t)c * NB + (tid >> 4)) * SEQ + 4 * (tid & 15);
    const unsigned bwo = (unsigned)((tid >> 4) * 144 + (tid & 15) * 8), bro = (unsigned)(r * 144 + 16 * hh);
    TP_B(82)
    u32x2 bpre[HYD];
#pragma unroll
    for (int d = 0; d < HYD; ++d) bpre[d] = *(const u32x2*)(hws + 64 * d);
    *(LAS u32x2*)(Bt + bwo) = bpre[0];
    __syncthreads();
#pragma unroll 1
    for (int s8 = 0; s8 < SEQ; s8 += 64 * HYD) {
#pragma unroll
        for (int d = 0; d < HYD; ++d) { const int sb = s8 + 64 * d;
            if (sb + 64 < SEQ) *(LAS u32x2*)(Bt + ((d + 1) & 1) * 4608 + bwo) = bpre[(d + 1) % HYD];
            if (sb + 64 * HYD < SEQ) bpre[d] = *(const u32x2*)(hws + sb + 64 * HYD);
#pragma unroll
            for (int j = 0; j < 4; ++j) { const int s0 = sb + 16 * j; const bf16x8 bfr = *(const LAS bf16x8*)(Bt + (d & 1) * 4608 + bro + 32 * j);
#pragma unroll
                for (int i = 0; i < 8; ++i) { const bf16x8 afr = *(const LAS bf16x8*)(abase + (s0 - 32 * i) * 2); acc[i] = MFMA32(afr, bfr, acc[i]); }
                __builtin_amdgcn_sched_barrier(0); }
            __syncthreads(); }
    }
    TP_E(82)
    TP_B(83)
    const bf16_t* hx = (const bf16_t*)(dsc + DO_HX0) + ((size_t)c * NB + r) * SEQ;
    bf16_t* ya = (bf16_t*)(dsc + DO_YAT) + ((size_t)c * NB + r) * SEQ;
#pragma unroll
    for (int i = 0; i < 8; ++i)
#pragma unroll
        for (int g = 0; g < 4; ++g) { const int t = 256 * w + 32 * i + 8 * g + 4 * hh;
            const u32x2 xv = *(const u32x2*)(hx + t);
            u32x2 o; o.x = pk2(acc[i][4 * g] * bflo(xv.x), acc[i][4 * g + 1] * bfhi(xv.x)); o.y = pk2(acc[i][4 * g + 2] * bflo(xv.y), acc[i][4 * g + 3] * bfhi(xv.y));
            *(u32x2*)(ya + t) = o; }
    TP_E(83)
    TP_E(1)
    if (TPROBE >= 80 && TPROBE < 90 && lane == 0 && w == (TPWAVE)) { atomicAdd((unsigned*)(ws + WS_CTL) + 512, tacc); atomicAdd((unsigned*)(ws + WS_CTL) + 513, ttot); }
}

DI int t5_bucket(int rel) {
    const int ret = rel > 0 ? 16 : 0; const int n = rel < 0 ? -rel : rel;
    if (n < 8) return ret + n;
    const float nf = (float)n;
    int large = 8 + (int)(logf(nf / 8.0f) / 4.852030263919617f * 8.0f);
    large = large < 15 ? large : 15;
    return ret + large;
}
#ifndef ATT_FAST
#define ATT_FAST 0
#endif
struct AttPass { int d, rho, uq0, nq; };
DI AttPass att_pass(int pp, int Q0, int w) {
    AttPass a;
    if (pp == 0) { a.d = 1; a.rho = 0; a.uq0 = Q0 + 32 * w; a.nq = 32; }
    else if (pp == 1) { a.d = 4; a.rho = w & 3; a.uq0 = (Q0 >> 2) + 32 * (w >> 2); a.nq = 32; }
    else { a.d = 16; a.rho = 2 * w + (pp - 2); a.uq0 = Q0 >> 4; a.nq = 16; }
    return a;
}
DI void attn_unit(const Params& P, int u, LAS unsigned char* lds, int& bias_h) {
    unsigned tacc = 0, ttot = 0;
    const int qb = u & 7, h = (u >> 3) & 3, b = u >> 5;
    const int tid = tid_opaque(P.wv), lane = tid & 63, w = __builtin_amdgcn_readfirstlane(tid >> 6), c = lane & 31, hh = lane >> 5;
    LAS float* Ost = (LAS float*)lds;
    LAS float* Mst = (LAS float*)(lds + 69632);
    LAS float* Lst = Mst + 256;
    LAS float* biasT = (LAS float*)(lds + 69632 + 2048);
    LAS unsigned char* Vr = lds + 69632 + 2048 + 12800 + w * 6144;
    unsigned char* ws = P.ws;
    TP_B(1)
    { TP_B(3) __syncthreads(); TP_E(3) }
    if (bias_h != h) {
        const float* relb = P.rel_bias; asm volatile("" : "+s"(relb));
        for (int i = tid; i < 4 * 768; i += 512) { const int s = i / 768, jx = i - 768 * s; const int pat = jx >> 8, rel = (jx & 255) - 128, dd = pat == 0 ? 1 : (pat == 1 ? 4 : 16);
            biasT[s * 784 + jx + s] = (rel >= -64 && rel <= 64) ? relb[t5_bucket(rel * dd) * 4 + h] * 1.4426950408889634f : -INFINITY; }
        __syncthreads();
        bias_h = h;
    }
    const bf16_t* pb = (const bf16_t*)(ws + WS_PROJ) + (size_t)b * SEQ * NPROJ;
    bf16_t* MIX = (bf16_t*)(ws + WS_HN);
    const int Q0 = qb * 256;
    const int i16 = lane & 15, trq = i16 >> 2, trp = i16 & 3;
    const unsigned troff = (unsigned)((4 * hh + trq) * 192 + (16 * ((lane >> 4) & 1) + 4 * trp) * 2);
    const int r8 = lane >> 3, j8 = lane & 7;
#define ATT_LOAD(KF, VR, KT, AP) do { const int nsub_ = SEQ / (AP).d, tlo_ = (AP).uq0 - 64 + 32 * (KT); \
        if (ATT_FAST && tlo_ >= 0 && tlo_ + 31 < nsub_) {                   \
            const unsigned lo_ = (unsigned)(r8 * (AP).d * NPROJ + 8 * j8) * 2u; \
            _Pragma("unroll") for (int i = 0; i < 4; ++i) { const bf16_t* b_ = pb + (size_t)(((tlo_ + 8 * i) * (AP).d + (AP).rho) * NPROJ + h * 64); \
                KF[i] = __builtin_bit_cast(bf16x8, ldg16(b_ + PC_AK, lo_)); VR[i] = ldg16(b_ + PC_AV, lo_); } \
        } else { \
            _Pragma("unroll") for (int i = 0; i < 4; ++i) { const int ukr_ = tlo_ + 8 * i + r8; const int ukc_ = ukr_ < 0 ? 0 : (ukr_ >= nsub_ ? nsub_ - 1 : ukr_); \
                const unsigned ko_ = (unsigned)((ukc_ * (AP).d + (AP).rho) * NPROJ + h * 64 + 8 * j8) * 2u; \
                KF[i] = __builtin_bit_cast(bf16x8, ldg16(pb + PC_AK, ko_)); VR[i] = ldg16(pb + PC_AV, ko_); } } } while (0)
#define ATT_TILE(KF, VR, KT, NEXTLOAD) do { const int kt = (KT); \
        bf16x8 kq_[4]; \
        f32x16 st;                                                          \
        _Pragma("unroll") for (int g = 0; g < 4; ++g) { const f32x4 bv_ = *(const LAS f32x4*)(tb4 + 32 * kt + 8 * g); st[4 * g] = bv_.x; st[4 * g + 1] = bv_.y; st[4 * g + 2] = bv_.z; st[4 * g + 3] = bv_.w; } \
        _Pragma("unroll") for (int i = 0; i < 4; ++i) *(LAS bf16x8*)(Vr + (8 * i + r8) * 144 + 16 * j8) = KF[i]; \
        _Pragma("unroll") for (int ks = 0; ks < 4; ++ks) kq_[ks] = *(const LAS bf16x8*)(Vr + c * 144 + 32 * ks + 16 * hh); \
        _Pragma("unroll") for (int i = 0; i < 4; ++i) *(LAS u32x4*)(Vr + (8 * i + r8) * 192 + 16 * j8) = VR[i]; \
        _Pragma("unroll") for (int ks = 0; ks < 4; ++ks) st = MFMA32(kq_[ks], qf[ks], st); \
        NEXTLOAD; \
        float tmax = -INFINITY; float lg[16]; \
        { const int tlo = uk0 + 32 * kt; \
          if (tlo >= 0 && tlo + 31 < nsub) { \
            _Pragma("unroll") for (int q = 0; q < 16; ++q) { lg[q] = st[q]; tmax = fmaxf(tmax, lg[q]); } \
          } else { \
            _Pragma("unroll") for (int q = 0; q < 16; ++q) { const int uk = tlo + crow(q, hh); lg[q] = (uk >= 0 && uk < nsub) ? st[q] : -INFINITY; tmax = fmaxf(tmax, lg[q]); } \
          } } \
        tmax = xhalf_max(tmax); \
        if (__any(tmax > mrun + 8.0f)) { const float mnew = fmaxf(mrun, tmax), alpha = __builtin_amdgcn_exp2f(mrun - mnew); lrun *= alpha; mrun = mnew; \
            _Pragma("unroll") for (int dt = 0; dt < 2; ++dt) _Pragma("unroll") for (int q = 0; q < 16; ++q) OT[dt][q] *= alpha; } \
        float psum = 0.f; \
        _Pragma("unroll") for (int q = 0; q < 16; ++q) { lg[q] = __builtin_amdgcn_exp2f(lg[q] - mrun); psum += lg[q]; } \
        lrun += xhalf_sum(psum); \
        LDS_WAIT(); \
        _Pragma("unroll") for (int s = 0; s < 2; ++s) { const bf16x8 pf = PACK_STEP(lg, s); \
            _Pragma("unroll") for (int dt = 0; dt < 2; ++dt) { \
                const s16x4 lo = __builtin_amdgcn_ds_read_tr16_b64_v4i16((LAS s16x4*)(Vr + troff + (16 * s) * 192 + 64 * dt)); \
                const s16x4 hi = __builtin_amdgcn_ds_read_tr16_b64_v4i16((LAS s16x4*)(Vr + troff + (16 * s + 8) * 192 + 64 * dt)); \
                OT[dt] = MFMA32(__builtin_shufflevector(lo, hi, 0, 1, 2, 3, 4, 5, 6, 7), pf, OT[dt]); } } \
        LDS_WAIT(); } while (0)
    bf16x8 kfA[4], kfB[4]; u32x4 vrA[4], vrB[4];
    bf16x8 qnext[4];
    { const AttPass a0 = att_pass(0, Q0, w);
      ATT_LOAD(kfA, vrA, 0, a0); ATT_LOAD(kfB, vrB, 1, a0);
      const int qpos0 = a0.uq0 + c;
#pragma unroll
      for (int ks = 0; ks < 4; ++ks) qnext[ks] = *(const bf16x8*)(pb + (size_t)qpos0 * NPROJ + PC_AQ + h * 64 + 16 * ks + 8 * hh); }
    auto pass = [&](const int pp, bf16x8 (&kf0)[4], u32x4 (&vr0)[4], bf16x8 (&kf1)[4], u32x4 (&vr1)[4]) __attribute__((always_inline)) {
        const int pat = pp < 2 ? pp : 2;
        const AttPass ap = att_pass(pp, Q0, w), an = att_pass(pp < 3 ? pp + 1 : 3, Q0, w);
        const int d = ap.d, rho = ap.rho, uq0 = ap.uq0, nq = ap.nq;
        const int uk0 = uq0 - 64, nsub = SEQ / d;
        const int cq = (c < nq) ? c : c - nq;
        const int qpos = (uq0 + cq) * d + rho, ql = qpos - Q0;
        const LAS float* tb4 = biasT + (cq & 3) * 784 + pat * 256 + (64 - cq + 4 * hh + (cq & 3));
        bf16x8 qf[4];
#pragma unroll
        for (int ks = 0; ks < 4; ++ks) qf[ks] = qnext[ks];
        if (pp < 3) {
            const int cq2 = (c < an.nq) ? c : c - an.nq; const int qpos2 = (an.uq0 + cq2) * an.d + an.rho;
#pragma unroll
            for (int ks = 0; ks < 4; ++ks) qnext[ks] = *(const bf16x8*)(pb + (size_t)qpos2 * NPROJ + PC_AQ + h * 64 + 16 * ks + 8 * hh); }
        float mrun = -1.0e30f, lrun = 0.f; f32x16 OT[2];
#pragma unroll
        for (int dt = 0; dt < 2; ++dt)
#pragma unroll
            for (int q = 0; q < 16; ++q) OT[dt][q] = 0.f;
        if (pat != 0) { mrun = Mst[ql]; lrun = Lst[ql];
#pragma unroll
            for (int dt = 0; dt < 2; ++dt)
#pragma unroll
                for (int g = 0; g < 4; ++g) { const f32x4 v = *(const LAS f32x4*)(Ost + ql * 68 + 32 * dt + 8 * g + 4 * hh);
                    OT[dt][4 * g] = v.x; OT[dt][4 * g + 1] = v.y; OT[dt][4 * g + 2] = v.z; OT[dt][4 * g + 3] = v.w; } }
        { TP_B(2)
        ATT_TILE(kf0, vr0, 0, ATT_LOAD(kf0, vr0, 2, ap)); ATT_TILE(kf1, vr1, 1, ATT_LOAD(kf1, vr1, 3, ap)); ATT_TILE(kf0, vr0, 2, ATT_LOAD(kf0, vr0, 4, ap));
        ATT_TILE(kf1, vr1, 3, if (pp < 3) { AttPass an_ = an; asm volatile("" : "+s"(an_.d), "+s"(an_.rho), "+s"(an_.uq0)); ATT_LOAD(kf1, vr1, 0, an_); });
        ATT_TILE(kf0, vr0, 4, if (pp < 3) { AttPass an_ = an; asm volatile("" : "+s"(an_.d), "+s"(an_.rho), "+s"(an_.uq0)); ATT_LOAD(kf0, vr0, 1, an_); });
        TP_E(2) }
        if (pat != 2) {
            if (hh == 0) { Mst[ql] = mrun; Lst[ql] = lrun; }
#pragma unroll
            for (int dt = 0; dt < 2; ++dt)
#pragma unroll
                for (int g = 0; g < 4; ++g) *(LAS f32x4*)(Ost + ql * 68 + 32 * dt + 8 * g + 4 * hh) = (f32x4){OT[dt][4 * g], OT[dt][4 * g + 1], OT[dt][4 * g + 2], OT[dt][4 * g + 3]};
        } else if (c < 16) {
            const float inv = __builtin_amdgcn_rcpf(lrun);
            bf16_t* orow = MIX + ((size_t)b * SEQ + qpos) * DM + 512 + h * 64;
#pragma unroll
            for (int dt = 0; dt < 2; ++dt)
#pragma unroll
                for (int g = 0; g < 4; ++g) { u32x2 o; o.x = pk2(OT[dt][4 * g] * inv, OT[dt][4 * g + 1] * inv); o.y = pk2(OT[dt][4 * g + 2] * inv, OT[dt][4 * g + 3] * inv);
                    *(u32x2*)(orow + 32 * dt + 8 * g + 4 * hh) = o; }
        }
        { TP_B(3) if (pp < 2) __syncthreads(); TP_E(3) }
    };
#pragma unroll 1
    for (int p2 = 0; p2 < 2; ++p2) { pass(2 * p2, kfA, vrA, kfB, vrB); pass(2 * p2 + 1, kfB, vrB, kfA, vrA); }
#undef ATT_LOAD
#undef ATT_TILE
    TP_E(1)
    if (TPROBE && TPROBE < 10 && (tid & 63) == 0 && w == (TPWAVE)) { atomicAdd((unsigned*)(ws + WS_CTL) + 512, tacc); atomicAdd((unsigned*)(ws + WS_CTL) + 513, ttot); }
}

DI float softplus_f(float x) { return x > 15.f ? x : __logf(1.0f + __expf(x)); }
DI unsigned short hsel(const u32x4& v, int c) { const unsigned w = (c >> 1) == 0 ? v.x : ((c >> 1) == 1 ? v.y : ((c >> 1) == 2 ? v.z : v.w)); return (unsigned short)((c & 1) ? (w >> 16) : (w & 0xffffu)); }
DI void mamba_unit(const Params& P, int l, int u, LAS unsigned char* lds) {
    const int dir = u & 1, h = (u >> 1) & 3, b = u >> 3, g = h >> 1;
    const int tid = tid_opaque(P.wv), lane_f = tid & 63, w = __builtin_amdgcn_readfirstlane(tid >> 6);
    LAS unsigned char* wl = lds + w * 15616;
    LAS unsigned short* xdT = (LAS unsigned short*)wl;
    LAS unsigned short* xwT = xdT + 64 * 40;
    LAS unsigned short* BT = xwT + 64 * 40;
    LAS float* dtv = (LAS float*)(wl + 15360);
    LAS float* acum = dtv + 32;
    LAS float* Atot = (LAS float*)(lds + 8 * 15616);
    unsigned char* ws = P.ws; unsigned char* dsc = (unsigned char*)P.out;
    const bf16_t* xbc = (const bf16_t*)(dsc + DO_MXBC) + (size_t)b * SEQ * 512;
    const float* dtr = (const float*)(ws + WS_DT) + (size_t)b * SEQ * 8 + dir * 4 + h;
    bf16_t* MYD = (bf16_t*)(dir ? (ws + WS_MYB) : (dsc + DO_MY)) + (size_t)b * SEQ * 256 + h * 64;
    float* stsc = (float*)(dsc + DO_MST) + (size_t)u * (8 * 4096);
    const float dtb = P.m_dt_bias[l * 8 + dir * 4 + h], Aneg = -expf(P.m_A_log[l * 8 + dir * 4 + h]);
    __syncthreads();
#define MTK(c0, j) (dir ? (c0) + 31 - (j) : (c0) + (j))
#define MCH(ci) (256 * w + 32 * (dir ? 7 - (ci) : (ci)))
#pragma unroll 1
    for (int pass = 0; pass < 2; ++pass) {
        int lane_p = lane_f; asm volatile("" : "+v"(lane_p));
        const int lane = lane_p, c32 = lane_p & 31, hh = lane_p >> 5, tg = lane_p >> 3, cg = lane_p & 7;
        f32x16 ST[2][2];
#pragma unroll
        for (int a = 0; a < 2; ++a)
#pragma unroll
            for (int q = 0; q < 2; ++q)
#pragma unroll
                for (int i = 0; i < 16; ++i) ST[a][q][i] = 0.f;
        if (pass == 1) {
            const int nv = dir ? 7 - w : w;
            for (int k = 0; k < nv; ++k) { const int v = dir ? 7 - k : k; const float dec = Atot[v];
                const f32x4* sp = (const f32x4*)(stsc + (size_t)v * 4096 + lane * 64);
#pragma unroll
                for (int a = 0; a < 2; ++a)
#pragma unroll
                    for (int q = 0; q < 2; ++q)
#pragma unroll
                        for (int i4 = 0; i4 < 4; ++i4) { const f32x4 t = sp[(a * 2 + q) * 4 + i4];
                            ST[a][q][4 * i4] = ST[a][q][4 * i4] * dec + t.x; ST[a][q][4 * i4 + 1] = ST[a][q][4 * i4 + 1] * dec + t.y; ST[a][q][4 * i4 + 2] = ST[a][q][4 * i4 + 2] * dec + t.z; ST[a][q][4 * i4 + 3] = ST[a][q][4 * i4 + 3] * dec + t.w; } }
        }
        float atot = 0.f;
        u32x4 rx[4], rB[4]; float rdt;
        { const int c0 = MCH(0);
#pragma unroll
          for (int i = 0; i < 4; ++i) { const unsigned ro = (unsigned)(MTK(c0, 4 * tg + i) * 512 + 8 * cg) * 2u; rx[i] = ldg16(xbc + h * 64, ro); rB[i] = ldg16(xbc + 256 + g * 64, ro); }
          rdt = *(const float*)((const char*)dtr + (unsigned)(MTK(c0, c32) * 32)); }
#pragma unroll 1
        for (int ci = 0; ci < 8; ++ci) {
            int lane_i = lane; asm volatile("" : "+v"(lane_i));
            const int c32 = lane_i & 31, hh = lane_i >> 5, tg = lane_i >> 3, cg = lane_i & 7;
            const int c0 = MCH(ci);
            {
                const float dt = softplus_f(rdt + dtb);
                float ac = dt * Aneg;
#pragma unroll
                for (int o = 1; o < 32; o <<= 1) { const float t = __shfl_up(ac, o, 32); if (c32 >= o) ac += t; }
                if (lane < 32) { dtv[c32] = dt; acum[c32] = ac; }
            }
            LDS_WAIT();
            const float aend = acum[31];
            {
                const f32x4 d4 = *(const LAS f32x4*)(dtv + 4 * tg), a4 = *(const LAS f32x4*)(acum + 4 * tg);
                const float dj[4] = {d4.x, d4.y, d4.z, d4.w};
                const float wj[4] = {__expf(aend - a4.x), __expf(aend - a4.y), __expf(aend - a4.z), __expf(aend - a4.w)};
#pragma unroll
                for (int c = 0; c < 8; ++c) {
                    float xd[4]; unsigned short bb[4];
#pragma unroll
                    for (int i = 0; i < 4; ++i) { xd[i] = bf2f(hsel(rx[i], c)) * dj[i]; bb[i] = hsel(rB[i], c); }
                    *(LAS u32x2*)(xdT + (8 * cg + c) * 40 + 4 * tg) = (u32x2){pk2(xd[0], xd[1]), pk2(xd[2], xd[3])};
                    *(LAS u32x2*)(xwT + (8 * cg + c) * 40 + 4 * tg) = (u32x2){pk2(xd[0] * wj[0], xd[1] * wj[1]), pk2(xd[2] * wj[2], xd[3] * wj[3])};
                    *(LAS u32x2*)(BT + (8 * cg + c) * 40 + 4 * tg) = (u32x2){(unsigned)bb[0] | ((unsigned)bb[1] << 16), (unsigned)bb[2] | ((unsigned)bb[3] << 16)};
                }
            }
            if (ci < 7) { const int c1 = MCH(ci + 1);
#pragma unroll
                for (int i = 0; i < 4; ++i) { const unsigned ro = (unsigned)(MTK(c1, 4 * tg + i) * 512 + 8 * cg) * 2u; rx[i] = ldg16(xbc + h * 64, ro); rB[i] = ldg16(xbc + 256 + g * 64, ro); }
                rdt = *(const float*)((const char*)dtr + (unsigned)(MTK(c1, c32) * 32)); }
            LDS_WAIT();
            if (pass == 1) {
                const unsigned bro = (unsigned)(MTK(c0, c32) * 512 + 8 * hh) * 2u;
                f32x16 GT;
#pragma unroll
                for (int i = 0; i < 16; ++i) GT[i] = 0.f;
#pragma unroll
                for (int ks = 0; ks < 4; ++ks) GT = MFMA32(__builtin_bit_cast(bf16x8, ldg16(xbc + 256 + g * 64 + 16 * ks, bro)), __builtin_bit_cast(bf16x8, ldg16(xbc + 384 + g * 64 + 16 * ks, bro)), GT);
                const float acl = acum[c32];
#pragma unroll
                for (int i = 0; i < 16; ++i) { const int s = crow(i, hh); GT[i] = (s <= c32) ? GT[i] * __expf(acl - acum[s]) : 0.f; }
                f32x16 Y[2];
#pragma unroll
                for (int pt = 0; pt < 2; ++pt)
#pragma unroll
                    for (int i = 0; i < 16; ++i) Y[pt][i] = 0.f;
#pragma unroll
                for (int s = 0; s < 2; ++s) { const bf16x8 pa = PACK_STEP(GT, s);
#pragma unroll
                    for (int pt = 0; pt < 2; ++pt) { const LAS unsigned short* xr = xdT + (32 * pt + c32) * 40 + 16 * s + 4 * hh;
                        Y[pt] = MFMA32(pa, cat44(*(const LAS u32x2*)xr, *(const LAS u32x2*)(xr + 8)), Y[pt]); } }
                const unsigned cro = (unsigned)(MTK(c0, c32) * 512 + 4 * hh) * 2u;
                const float el = __expf(acl);
#pragma unroll
                for (int nt = 0; nt < 2; ++nt)
#pragma unroll
                    for (int s = 0; s < 2; ++s) { const u32x2 clo = ldg8(xbc + 384 + g * 64 + 32 * nt + 16 * s, cro), chi = ldg8(xbc + 384 + g * 64 + 32 * nt + 16 * s + 8, cro);
                        const bf16x8 ca = mk8(pk2(bflo(clo.x) * el, bfhi(clo.x) * el), pk2(bflo(clo.y) * el, bfhi(clo.y) * el), pk2(bflo(chi.x) * el, bfhi(chi.x) * el), pk2(bflo(chi.y) * el, bfhi(chi.y) * el));
#pragma unroll
                        for (int pt = 0; pt < 2; ++pt) Y[pt] = MFMA32(ca, PACK_STEP(ST[nt][pt], s), Y[pt]); }
#pragma unroll
                for (int i = 0; i < 16; ++i) { const unsigned oo = (unsigned)(MTK(c0, crow(i, hh)) * 256 + c32) * 2u; stg2(MYD, oo, f2bf(Y[0][i])); stg2(MYD + 32, oo, f2bf(Y[1][i])); }
            }
            {
                const float de = __expf(aend);
#pragma unroll
                for (int nt = 0; nt < 2; ++nt)
#pragma unroll
                    for (int pt = 0; pt < 2; ++pt)
#pragma unroll
                        for (int i = 0; i < 16; ++i) ST[nt][pt][i] *= de;
#pragma unroll
                for (int s = 0; s < 2; ++s)
#pragma unroll
                    for (int nt = 0; nt < 2; ++nt) { const bf16x8 ba = *(const LAS bf16x8*)(BT + (32 * nt + c32) * 40 + 16 * s + 8 * hh);
#pragma unroll
                        for (int pt = 0; pt < 2; ++pt) ST[nt][pt] = MFMA32(ba, *(const LAS bf16x8*)(xwT + (32 * pt + c32) * 40 + 16 * s + 8 * hh), ST[nt][pt]); }
            }
            atot += aend;
            LDS_WAIT();
        }
        if (pass == 0) {
            f32x4* sp = (f32x4*)(stsc + (size_t)w * 4096 + lane * 64);
#pragma unroll
            for (int a = 0; a < 2; ++a)
#pragma unroll
                for (int q = 0; q < 2; ++q)
#pragma unroll
                    for (int i4 = 0; i4 < 4; ++i4) sp[(a * 2 + q) * 4 + i4] = (f32x4){ST[a][q][4 * i4], ST[a][q][4 * i4 + 1], ST[a][q][4 * i4 + 2], ST[a][q][4 * i4 + 3]};
            if (lane == 0) Atot[w] = __expf(atot);
            VM_WAIT(); __syncthreads();
        }
    }
#undef MTK
#undef MCH
    __syncthreads();
}

DI void hgrn_unit(const Params& P, int l, int u, LAS unsigned char* lds) {
    const int dir = u & 1, h = (u >> 1) & 3, b = u >> 3;
    const int tid = tid_opaque(P.wv), lane_f = tid & 63, w = __builtin_amdgcn_readfirstlane(tid >> 6);
    LAS unsigned char* wl = lds + w * 15104;
    LAS unsigned short* qd = (LAS unsigned short*)wl;
    LAS unsigned short* kd = qd + 32 * 72;
    LAS unsigned short* vT = kd + 32 * 72;
    LAS float* eref = (LAS float*)(wl + 14336);
    LAS float* eglr = eref + 64;
    LAS float* egl = eglr + 64;
    LAS float* lbt = (LAS float*)(lds + 8 * 15104 + 2048 + w * 512);
    LAS float* gsum = lbt + 64;
    LAS float* Atot = (LAS float*)(lds + 8 * 15104);
    unsigned char* ws = P.ws; unsigned char* dsc = (unsigned char*)P.out;
    const bf16_t* proj = (const bf16_t*)(ws + WS_PROJ) + (size_t)b * SEQ * NPROJ;
    bf16_t* OD = (dir ? (bf16_t*)(ws + WS_OB) + (size_t)b * SEQ * 256 + h * 64 : (bf16_t*)(ws + WS_HN) + (size_t)b * SEQ * DM + 768 + h * 64);
    const int ostride = dir ? 256 : DM;
    float* stsc = (float*)(dsc + DO_HST) + (size_t)u * (8 * 4096);
    __syncthreads();
    { float lb = 0.f;
      if (l == 1) { const float h0 = P.hg_lb[(0 * 2 + dir) * 256 + h * 64 + lane_f], h1 = P.hg_lb[(1 * 2 + dir) * 256 + h * 64 + lane_f]; lb = 1.0f / (1.0f + expf(h0 - h1)); }
      lbt[lane_f] = lb; }
    LDS_WAIT();
#define HTK(c0, j) (dir ? (c0) + 31 - (j) : (c0) + (j))
#define HCH(ci) (256 * w + 32 * (dir ? 7 - (ci) : (ci)))
#pragma unroll 1
    for (int pass = 0; pass < 2; ++pass) {
        int lane_p = lane_f; asm volatile("" : "+v"(lane_p));
        const int lane = lane_p, c32 = lane_p & 31, hh = lane_p >> 5, tg = lane_p >> 3, cg = lane_p & 7;
        f32x16 S[2][2];
#pragma unroll
        for (int a = 0; a < 2; ++a)
#pragma unroll
            for (int q = 0; q < 2; ++q)
#pragma unroll
                for (int i = 0; i < 16; ++i) S[a][q][i] = 0.f;
        if (pass == 1) {
            const int nv = dir ? 7 - w : w;
            for (int k = 0; k < nv; ++k) { const int v = dir ? 7 - k : k; const LAS float* at = Atot + v * 64;
                const f32x4* sp = (const f32x4*)(stsc + (size_t)v * 4096 + lane * 64);
#pragma unroll
                for (int a = 0; a < 2; ++a)
#pragma unroll
                    for (int i4 = 0; i4 < 4; ++i4) { const f32x4 dec = *(const LAS f32x4*)(at + 32 * a + 8 * i4 + 4 * hh);
#pragma unroll
                        for (int q = 0; q < 2; ++q) { const f32x4 t = sp[(a * 2 + q) * 4 + i4];
                            S[a][q][4 * i4] = S[a][q][4 * i4] * dec.x + t.x; S[a][q][4 * i4 + 1] = S[a][q][4 * i4 + 1] * dec.y + t.y; S[a][q][4 * i4 + 2] = S[a][q][4 * i4 + 2] * dec.z + t.z; S[a][q][4 * i4 + 3] = S[a][q][4 * i4 + 3] * dec.w + t.w; } } }
        }
        gsum[lane] = 1.0f;
        u32x4 rf[4], rq[4];
        { const int c0 = HCH(0);
#pragma unroll
          for (int i = 0; i < 4; ++i) { const unsigned ro = (unsigned)(HTK(c0, 4 * tg + i) * NPROJ + 8 * cg) * 2u;
              rf[i] = ldg16(proj + PC_HF + dir * 256 + h * 64, ro); rq[i] = (pass == 1) ? ldg16(proj + PC_HQ + h * 64, ro) : (u32x4){0u, 0u, 0u, 0u}; } }
#pragma unroll 1
        for (int ci = 0; ci < 8; ++ci) {
            int lane_i = lane; asm volatile("" : "+v"(lane_i));
            const int c32 = lane_i & 31, hh = lane_i >> 5, tg = lane_i >> 3, cg = lane_i & 7;
            const int c0 = HCH(ci);
            {
                float qprev[4], kprev[4];
                u32x4 rv[4];
#pragma unroll
                for (int i = 0; i < 4; ++i) { const unsigned ro = (unsigned)(HTK(c0, 4 * tg + i) * NPROJ + 8 * cg) * 2u; rv[i] = ldg16(proj + PC_HI + h * 64, ro); }
                const f32x4 lb0 = *(const LAS f32x4*)(lbt + 8 * cg), lb1 = *(const LAS f32x4*)(lbt + 8 * cg + 4);
                const float lbv[8] = {lb0.x, lb0.y, lb0.z, lb0.w, lb1.x, lb1.y, lb1.z, lb1.w};
#pragma unroll
                for (int c = 0; c < 8; ++c) {
                    const float lb = lbv[c], oml = 1.0f - lb;
                    float en[4], cD[4], cN[4];
#pragma unroll
                    for (int i = 0; i < 4; ++i) { const float fpre = bf2f(hsel(rf[i], c)); const float e_ = fminf(__expf(-fpre), 1.0e9f); en[i] = e_;
                        const float dd = 1.0f + e_, nn = 1.0f + lb * e_; cD[i] = (i == 0) ? dd : cD[i - 1] * dd; cN[i] = (i == 0) ? nn : cN[i - 1] * nn; }
                    float iD[4], iN[4]; iD[3] = __builtin_amdgcn_rcpf(cD[3]); iN[3] = __builtin_amdgcn_rcpf(cN[3]);
#pragma unroll
                    for (int i = 3; i > 0; --i) { iD[i - 1] = iD[i] * (1.0f + en[i]); iN[i - 1] = iN[i] * (1.0f + lb * en[i]); }
                    const float own = cN[3] * iD[3];
                    float lsh = dpp_f<0x118>(own); asm volatile("" : "+v"(lsh));
                    const float lowv = (tg & 1) ? lsh : 1.0f;
                    const float rup = own * lowv;
                    float rro = dpp_f<0x128>(rup); asm volatile("" : "+v"(rro));
                    const float T = (tg & 1) ? rup : rro;
                    const auto s16 = __builtin_amdgcn_permlane16_swap(__float_as_uint(T), __float_as_uint(T), false, false);
                    const float Tp = ((lane >> 4) & 1) ? __uint_as_float(s16[0]) : __uint_as_float(s16[1]);
                    const float PT = T * Tp;
                    const auto s32 = __builtin_amdgcn_permlane32_swap(__float_as_uint(PT), __float_as_uint(PT), false, false);
                    const float pref = __uint_as_float(s32[0]), plast = pref * __uint_as_float(s32[1]);
                    const float excl = (((lane >> 4) & 1) ? Tp : 1.0f) * (((lane >> 5) & 1) ? pref : 1.0f) * ((tg & 1) ? lowv : 1.0f);
                    const float ipref = __builtin_amdgcn_rcpf(pref);
                    if (tg == 0) { eref[8 * cg + c] = pref; eglr[8 * cg + c] = plast * ipref; egl[8 * cg + c] = plast; gsum[8 * cg + c] *= plast; }
                    float kv[4], qv[4];
                    const float Kc = oml * pref * __builtin_amdgcn_rcpf(excl), Qc = excl * ipref;
#pragma unroll
                    for (int i = 0; i < 4; ++i) { kv[i] = Kc * (en[i] * ((i == 0) ? 1.0f : cD[i - 1])) * iN[i];
                        if (pass == 1) { const float qr = bf2f(hsel(rq[i], c)); qv[i] = qr * __builtin_amdgcn_rcpf(1.0f + __expf(-qr)) * (Qc * (cN[i] * iD[i])); } else qv[i] = 0.f; }
                    if (c & 1) {
#pragma unroll
                        for (int i = 0; i < 4; ++i) { *(LAS unsigned*)(kd + (4 * tg + i) * 72 + 8 * cg + c - 1) = pk2(kprev[i], kv[i]);
                            if (pass == 1) *(LAS unsigned*)(qd + (4 * tg + i) * 72 + 8 * cg + c - 1) = pk2(qprev[i], qv[i]); }
                    } else {
#pragma unroll
                        for (int i = 0; i < 4; ++i) { kprev[i] = kv[i]; qprev[i] = qv[i]; }
                    }
                }
#pragma unroll
                for (int c = 0; c < 8; ++c) { unsigned short vb[4];
#pragma unroll
                    for (int i = 0; i < 4; ++i) vb[i] = hsel(rv[i], c);
                    *(LAS u32x2*)(vT + (8 * cg + c) * 40 + 4 * tg) = (u32x2){(unsigned)vb[0] | ((unsigned)vb[1] << 16), (unsigned)vb[2] | ((unsigned)vb[3] << 16)}; }
            }
            if (ci < 7) { const int c1 = HCH(ci + 1);
#pragma unroll
                for (int i = 0; i < 4; ++i) { const unsigned ro = (unsigned)(HTK(c1, 4 * tg + i) * NPROJ + 8 * cg) * 2u;
                    rf[i] = ldg16(proj + PC_HF + dir * 256 + h * 64, ro); if (pass == 1) rq[i] = ldg16(proj + PC_HQ + h * 64, ro); } }
            LDS_WAIT(); __builtin_amdgcn_sched_barrier(0);
            bf16x8 vperm[2][2];
#pragma unroll
            for (int s = 0; s < 2; ++s)
#pragma unroll
                for (int pt = 0; pt < 2; ++pt) { const LAS unsigned short* vr = vT + (32 * pt + c32) * 40 + 16 * s + 4 * hh; vperm[s][pt] = cat44(*(const LAS u32x2*)vr, *(const LAS u32x2*)(vr + 8)); }
            if (pass == 1) {
                f32x16 SC;
#pragma unroll
                for (int i = 0; i < 16; ++i) SC[i] = 0.f;
#pragma unroll
                for (int ks = 0; ks < 4; ++ks) SC = MFMA32(*(const LAS bf16x8*)(kd + c32 * 72 + 16 * ks + 8 * hh), *(const LAS bf16x8*)(qd + c32 * 72 + 16 * ks + 8 * hh), SC);
#pragma unroll
                for (int i = 0; i < 16; ++i) SC[i] = (crow(i, hh) <= c32) ? SC[i] : 0.f;
                const bf16x8 pa0 = PACK_STEP(SC, 0), pa1 = PACK_STEP(SC, 1);
                bf16x8 qa[2][2];
#pragma unroll
                for (int et = 0; et < 2; ++et)
#pragma unroll
                    for (int s = 0; s < 2; ++s) { const LAS unsigned short* qr = qd + c32 * 72 + 32 * et + 16 * s + 4 * hh; qa[et][s] = cat44(*(const LAS u32x2*)qr, *(const LAS u32x2*)(qr + 8)); }
#pragma unroll
                for (int pt = 0; pt < 2; ++pt) {
                    f32x16 O;
#pragma unroll
                    for (int i = 0; i < 16; ++i) O[i] = 0.f;
                    O = MFMA32(pa0, vperm[0][pt], O); O = MFMA32(pa1, vperm[1][pt], O);
#pragma unroll
                    for (int et = 0; et < 2; ++et)
#pragma unroll
                        for (int s = 0; s < 2; ++s) { const f32x4 e0 = *(const LAS f32x4*)(eref + 32 * et + 16 * s + 4 * hh), e1 = *(const LAS f32x4*)(eref + 32 * et + 16 * s + 8 + 4 * hh);
                            const f32x16& sv = S[et][pt];
                            const bf16x8 sb = mk8(pk2(sv[8 * s] * e0.x, sv[8 * s + 1] * e0.y), pk2(sv[8 * s + 2] * e0.z, sv[8 * s + 3] * e0.w), pk2(sv[8 * s + 4] * e1.x, sv[8 * s + 5] * e1.y), pk2(sv[8 * s + 6] * e1.z, sv[8 * s + 7] * e1.w));
                            O = MFMA32(qa[et][s], sb, O); }
#pragma unroll
                    for (int i = 0; i < 16; ++i) { const unsigned oo = (unsigned)(HTK(c0, crow(i, hh)) * ostride + c32) * 2u; stg2(OD + 32 * pt, oo, f2bf(O[i])); }
                    __builtin_amdgcn_sched_barrier(0);
                }
            }
            __builtin_amdgcn_sched_barrier(0);
            {
#pragma unroll
                for (int et = 0; et < 2; ++et) {
                    f32x16 X;
#pragma unroll
                    for (int i = 0; i < 16; ++i) X[i] = 0.f;
#pragma unroll
                    for (int s = 0; s < 2; ++s) { unsigned idw[4];
#pragma unroll
                        for (int j = 0; j < 4; ++j) { const int k0 = 16 * s + 8 * hh + 2 * j; idw[j] = (k0 == c32 ? 0x3f80u : 0u) | (k0 + 1 == c32 ? 0x3f800000u : 0u); }
                        X = MFMA32(*(const LAS bf16x8*)(kd + c32 * 72 + 32 * et + 16 * s + 8 * hh), mk8(idw[0], idw[1], idw[2], idw[3]), X); }
                    const float sc = eglr[32 * et + c32];
#pragma unroll
                    for (int i = 0; i < 16; ++i) X[i] *= sc;
                    float dg[16];
#pragma unroll
                    for (int i = 0; i < 16; ++i) dg[i] = egl[32 * et + crow(i, hh)];
#pragma unroll
                    for (int pt = 0; pt < 2; ++pt) {
#pragma unroll
                        for (int i = 0; i < 16; ++i) S[et][pt][i] *= dg[i];
#pragma unroll
                        for (int s = 0; s < 2; ++s) S[et][pt] = MFMA32(PACK_STEP(X, s), vperm[s][pt], S[et][pt]); }
                }
            }
            LDS_WAIT();
        }
        if (pass == 0) {
            f32x4* sp = (f32x4*)(stsc + (size_t)w * 4096 + lane * 64);
#pragma unroll
            for (int a = 0; a < 2; ++a)
#pragma unroll
                for (int q = 0; q < 2; ++q)
#pragma unroll
                    for (int i4 = 0; i4 < 4; ++i4) sp[(a * 2 + q) * 4 + i4] = (f32x4){S[a][q][4 * i4], S[a][q][4 * i4 + 1], S[a][q][4 * i4 + 2], S[a][q][4 * i4 + 3]};
            LDS_WAIT(); Atot[w * 64 + lane] = gsum[lane];
            VM_WAIT(); __syncthreads();
        }
    }
#undef HTK
#undef HCH
    __syncthreads();
}

DI void phase_mixers(const Params& P, int l, LAS unsigned char* lds, int G, int bid) {
#ifndef REP_PHASE
#define REP_PHASE -1
#endif
#define MREPS(k) _Pragma("unroll 1") for (int _r = 0; _r < ((REP_PHASE == (k)) ? 2 : 1); ++_r)
    if (EN_HY) MREPS(30) for (int c = bid; c < 256; c += G) hyena_unit(P, c, lds);
    if (EN_AT) MREPS(31) { int bias_h = -1;
        if ((G & 7) == 0) { const int xcd = bid & 7, j = bid >> 3, per = G >> 3;
            for (int base = 0; base < NB * 4 * 8; base += G) { const int u = base + xcd * per + j; if (u < NB * 4 * 8) attn_unit(P, u, lds, bias_h); } }
        else for (int u = bid; u < NB * 4 * 8; u += G) attn_unit(P, u, lds, bias_h); }
    if (EN_MA) MREPS(32) for (int u = bid; u < 256; u += G) mamba_unit(P, l, u, lds);
    if (EN_HG) MREPS(33) for (int u = bid; u < 256; u += G) hgrn_unit(P, l, u, lds);
}

constexpr int N_PHASES = 21;
#if TPROBE >= 40 && TPROBE < 50
#define PCTL , (unsigned*)(ws + WS_CTL)
#else
#define PCTL
#endif
#ifndef REP_PHASE
#define REP_PHASE -1
#endif
#define REPS(k) for (int _rep = 0, _nrep = ((REP_PHASE == (k)) && ((k) != 0 && (k) != 5 || l == 0)) ? 2 : 1; _rep < _nrep; ++_rep)
__global__ void __launch_bounds__(512, 2) fwd_kernel(Params Pin) {
    Params P = Pin; P.wv = __builtin_amdgcn_readfirstlane((int)(threadIdx.x >> 6));
    extern __shared__ __attribute__((aligned(16))) unsigned char lds_raw[];
    LAS unsigned char* lds = (LAS unsigned char*)lds_raw;
    volatile LAS unsigned* MISC = (volatile LAS unsigned*)(lds + LDS_MISC);
    if (threadIdx.x < 64) MISC[threadIdx.x] = 0u;
    __syncthreads();
    unsigned char* ws = P.ws;
    const int lo = P.ph_lo, hi = P.ph_hi;
    XcdBarrier bar; bar.bar = (unsigned*)(ws + WS_CTL) + CW_BAR; bar.x = 0; bar.st = nullptr;
    if (hi - lo > 1) bar = xcd_barrier_post((unsigned*)(ws + WS_CTL) + CW_BAR, MISC + 8);
#define IN(k) (lo <= (k) && (k) < hi)
#ifndef TPSEAM
#define TPSEAM -1
#endif
#if TPROBE == 20
#define SEAM(k) do { if (IN(k) && IN((k) + 1)) { const unsigned _t0 = TP_T(); xcd_barrier(bar); if (TPSEAM < 0 || ((k) % 10) == TPSEAM) gb_wait += TP_T() - _t0; } } while (0)
#else
#define SEAM(k) do { if (IN(k) && IN((k) + 1)) xcd_barrier(bar); } while (0)
#endif
    unsigned gb_wait = 0; const unsigned gb_t0 = TPROBE == 20 ? TP_T() : 0u;
#pragma unroll 1
    for (int l = 0; l < 2; ++l) {
        int G = gridDim.x, bid = blockIdx.x; asm volatile("" : "+s"(G), "+s"(bid));
        const int p0 = 10 * l;
        if (IN(p0 + 0)) { _Pragma("unroll 1") REPS(0) phase_pre(P, l, lds); }
        SEAM(p0 + 0);
        if (IN(p0 + 1)) { _Pragma("unroll 1") REPS(1) {
            pg8::StaticOrder S; S.init(NTOK / 256, NPROJ / 256, G, bid); AddrPlain AD{DM, 0}; EpiProj E{(bf16_t*)(ws + WS_PROJ), (const float*)(ws + WS_MSQ)};
            pg8::gemm_phase(lds, (const char*)(ws + WS_XB), (const char*)(ws + WS_WIN), DM, S, AD, E, P.wv PCTL);
        } }
        SEAM(p0 + 1);
        if (IN(p0 + 2)) { _Pragma("unroll 1") REPS(2) phase_premix(P, l, lds); }
        SEAM(p0 + 2);
        if (IN(p0 + 3)) { _Pragma("unroll 1") REPS(3) phase_mixers(P, l, lds, G, bid); }
        SEAM(p0 + 3);
        if (IN(p0 + 4)) { _Pragma("unroll 1") REPS(4) phase_finalize(P, l); }
        SEAM(p0 + 4);
        if (IN(p0 + 5)) { _Pragma("unroll 1") REPS(5) {
            pg8::StaticOrder S; S.init(NTOK / 256, DM / 256, G, bid); AddrPlain AD{DM, 0}; EpiRes E{nullptr, (const bf16_t*)(ws + WS_XB), (bf16_t*)(ws + WS_XB)};
            pg8::gemm_phase(lds, (const char*)(ws + WS_HN), (const char*)(ws + WS_WOUT), DM, S, AD, E, P.wv PCTL);
        } }
        SEAM(p0 + 5);
        if (IN(p0 + 6)) { if (EN_MOE) { _Pragma("unroll 1") REPS(6) phase_ffnpre(P, l, lds); } }
        SEAM(p0 + 6);
        if (IN(p0 + 7)) { if (EN_MOE) { _Pragma("unroll 1") REPS(7) phase_topk(P, l, lds); } }
        SEAM(p0 + 7);
        if (IN(p0 + 8)) { if (EN_MOE) _Pragma("unroll 1") REPS(8) {
            pg8::StaticOrder S; S.init(NSLOT / 256, 2048 / 256, G, bid);
#if MOE_F8
            AddrGateUp8 AD{(const int*)(ws + WS_SELI)}; EpiGateUp8 E{(unsigned char*)P.out + DO_HDN, (const float*)(ws + WS_SELR)};
            pg8::gemm_phase<EpiGateUp8, pg8::StaticOrder, AddrGateUp8, true>(lds, (const char*)(ws + WS_HN), (const char*)(ws + WS_WGU), DM, S, AD, E, P.wv PCTL);
#else
            AddrGateUp AD{(const int*)(ws + WS_SELI)}; EpiGateUp E{(bf16_t*)((unsigned char*)P.out + DO_HDN), (const float*)(ws + WS_SELR)};
            pg8::gemm_phase(lds, (const char*)(ws + WS_HN), (const char*)(ws + WS_WGU), DM, S, AD, E, P.wv PCTL);
#endif
        } }
        SEAM(p0 + 8);
        if (IN(p0 + 9)) { if (EN_MOE) _Pragma("unroll 1") REPS(9) {
            pg8::StaticOrder S; S.init(NSLOT / 256, DM / 256, G, bid);
#if MOE_F8
            EpiDown E{(unsigned char*)(ws + WS_YE), (const float*)(ws + WS_SELG)};
            AddrDown8 AD{}; pg8::gemm_phase<EpiDown, pg8::StaticOrder, AddrDown8, true>(lds, (const char*)P.out + DO_HDN, (const char*)(ws + WS_WD), DM, S, AD, E, P.wv PCTL);
#else
            EpiDown E{(unsigned char*)(ws + WS_YE), (const float*)(ws + WS_SELG)};
            AddrDown AD{}; pg8::gemm_phase(lds, (const char*)P.out + DO_HDN, (const char*)(ws + WS_WD), DM, S, AD, E, P.wv PCTL);
#endif
        } }
        SEAM(p0 + 9);
    }
#ifdef PROBE_BARS
    if (hi - lo > 1) for (int i = 0; i < PROBE_BARS; ++i) xcd_barrier(bar);
#endif
    if (IN(20)) phase_final(P);
#ifndef TPOFF
#define TPOFF 0.5f
#endif
#if TPROBE == 20
    if (tid_opaque(P.wv) == 0) { atomicAdd((unsigned*)(ws + WS_CTL) + 512, gb_wait); atomicAdd((unsigned*)(ws + WS_CTL) + 513, (TP_T() - gb_t0) / 5u); }
    xcd_barrier(bar);
#endif
#if TPROBE
    __syncthreads();
    if (blockIdx.x == 0 && tid_opaque(P.wv) == 0) {
        const float a = (float)__hip_atomic_load((unsigned*)(ws + WS_CTL) + 512, __ATOMIC_RELAXED, __HIP_MEMORY_SCOPE_AGENT), t = (float)__hip_atomic_load((unsigned*)(ws + WS_CTL) + 513, __ATOMIC_RELAXED, __HIP_MEMORY_SCOPE_AGENT);
        P.out[0] = TPROBE == 99 ? 1.0e6f : (TPROBE == 20 && TPSEAM >= 0) ? (floorf(2.0f * log2f(a / t * 200.0f) + TPOFF) * 1.0e5f) : (floorf(a / t * 20.0f + TPOFF) * 1.0e5f); }
#endif
#undef IN
#undef SEAM
}

#ifndef N_LAUNCH_MODE
#define N_LAUNCH_MODE 1
#endif
extern "C" void kernel_launch(void* const* d_in, const int* in_sizes, int n_in, void* d_out, int out_size, void* d_ws, size_t ws_size, hipStream_t stream) {
    static int grid = 0;
    if (grid == 0) {
        if (n_in != 27 || in_sizes[0] != NTOK * DM || out_size != NTOK * DM || ws_size < WS_END) {
            fprintf(stderr, "kernel_launch: unexpected shapes (n_in %d, in0 %d, out %d, ws %zu, need %zu)\n", n_in, n_in > 0 ? in_sizes[0] : -1, out_size, ws_size, (size_t)WS_END); grid = -1; return; }
        int dev = 0, cus = 0, per_cu = 0;
        if (hipGetDevice(&dev) != hipSuccess || hipDeviceGetAttribute(&cus, hipDeviceAttributeMultiprocessorCount, dev) != hipSuccess) { grid = -1; return; }
        if (hipFuncSetAttribute((const void*)fwd_kernel, hipFuncAttributeMaxDynamicSharedMemorySize, LDS_BYTES) != hipSuccess) { fprintf(stderr, "kernel_launch: hipFuncSetAttribute failed\n"); grid = -1; return; }
        if (hipOccupancyMaxActiveBlocksPerMultiprocessor(&per_cu, (const void*)fwd_kernel, 512, LDS_BYTES) != hipSuccess || per_cu < 1) { fprintf(stderr, "kernel_launch: occupancy query says %d\n", per_cu); (void)hipGetLastError(); }
        grid = cus;
    }
    if (grid < 0) return;
    if (hipMemsetAsync((char*)d_ws + WS_CTL, 0, CTL_ZERO_BYTES, stream) != hipSuccess) return;
    Params p{};
    const float** pp = (const float**)&p;
    for (int i = 0; i < 27; ++i) pp[i] = (const float*)d_in[i];
    p.out = (float*)d_out; p.ws = (unsigned char*)d_ws;
    if (N_LAUNCH_MODE == 1) { p.ph_lo = 0; p.ph_hi = N_PHASES; hipLaunchKernelGGL(fwd_kernel, dim3(grid), dim3(512), LDS_BYTES, stream, p); }
    else for (int k = 0; k < N_PHASES; ++k) { p.ph_lo = k; p.ph_hi = k + 1; hipLaunchKernelGGL(fwd_kernel, dim3(grid), dim3(512), LDS_BYTES, stream, p); }
}
```

```cpp
#define N_LAUNCH_MODE 1
#include <hip/hip_runtime.h>
#include <cstdio>
#include <cstdint>

#define LAS __attribute__((address_space(3)))
#define DI __device__ __forceinline__
typedef unsigned short bf16_t;
typedef short bf16x8 __attribute__((ext_vector_type(8)));
typedef short s16x4 __attribute__((ext_vector_type(4)));
typedef float f32x2 __attribute__((ext_vector_type(2)));
typedef float f32x4 __attribute__((ext_vector_type(4)));
typedef float f32x16 __attribute__((ext_vector_type(16)));
typedef unsigned u32x2 __attribute__((ext_vector_type(2)));
typedef unsigned u32x4 __attribute__((ext_vector_type(4)));
typedef int i32x4 __attribute__((ext_vector_type(4)));
typedef __bf16 bfv2 __attribute__((ext_vector_type(2)));

DI unsigned pk2(float lo, float hi) { f32x2 v = {lo, hi}; return __builtin_bit_cast(unsigned, __builtin_convertvector(v, bfv2)); }
DI unsigned short f2bf(float f) { return (unsigned short)(pk2(f, 0.f) & 0xffffu); }
DI float bf2f(unsigned short b) { return __uint_as_float((unsigned)b << 16); }
DI float bflo(unsigned u) { return __uint_as_float(u << 16); }
DI float bfhi(unsigned u) { return __uint_as_float(u & 0xffff0000u); }
DI unsigned pk4_fp8(float a, float b, float c, float d) {
    a = __builtin_amdgcn_fmed3f(a, -440.f, 440.f); b = __builtin_amdgcn_fmed3f(b, -440.f, 440.f); c = __builtin_amdgcn_fmed3f(c, -440.f, 440.f); d = __builtin_amdgcn_fmed3f(d, -440.f, 440.f);
    int v = 0; v = __builtin_amdgcn_cvt_pk_fp8_f32(a, b, v, false); v = __builtin_amdgcn_cvt_pk_fp8_f32(c, d, v, true); return (unsigned)v; }
DI int lane_now() { int ln; asm volatile("v_mbcnt_lo_u32_b32 %0, -1, 0\n\tv_mbcnt_hi_u32_b32 %0, -1, %0" : "=v"(ln)); return ln; }
template <class T> DI T bperm_(int idx4, T v) { return __builtin_bit_cast(T, __builtin_amdgcn_ds_bpermute(idx4, __builtin_bit_cast(int, v))); }
template <class T> DI T shfl_xor_l(T v, int m, int self) { return bperm_(((self ^ m) & 63) << 2, v); }
template <class T> DI T shfl_up_l(T v, int o, int self, int width = 64) { int idx = self - o; if (idx < (self & ~(width - 1))) idx = self; return bperm_(idx << 2, v); }
template <class T> DI T shfl_xor_(T v, int m) { return shfl_xor_l(v, m, lane_now()); }
template <class T> DI T shfl_up_(T v, int o, int width = 64) { return shfl_up_l(v, o, lane_now(), width); }
template <class T> DI T shfl_(T v, int src) { return bperm_((src & 63) << 2, v); }
#ifndef HIP_SHFL
#define __shfl_xor shfl_xor_
#define __shfl_up shfl_up_
#define __shfl shfl_
#endif
DI float xhalf_max(float x) { const auto r = __builtin_amdgcn_permlane32_swap(__float_as_uint(x), __float_as_uint(x), false, false); return fmaxf(__uint_as_float(r[0]), __uint_as_float(r[1])); }
DI float xhalf_sum(float x) { const auto r = __builtin_amdgcn_permlane32_swap(__float_as_uint(x), __float_as_uint(x), false, false); return __uint_as_float(r[0]) + __uint_as_float(r[1]); }
template <int CTRL> DI float dpp_f(float x) { return __builtin_bit_cast(float, __builtin_amdgcn_update_dpp(0, __builtin_bit_cast(int, x), CTRL, 0xF, 0xF, true)); }
DI float x16_sum(float x) { const auto r = __builtin_amdgcn_permlane16_swap(__float_as_uint(x), __float_as_uint(x), false, false); return __uint_as_float(r[0]) + __uint_as_float(r[1]); }
DI float row_sum16(float x) { x += dpp_f<0x128>(x); x += dpp_f<0x124>(x); x += dpp_f<0x122>(x); x += dpp_f<0x121>(x); return x; }
DI float grp_sum8(float x) { x += dpp_f<0xB1>(x); x += dpp_f<0x4E>(x); x += dpp_f<0x141>(x); return x; }
DI float grp_max16(float x) { x = fmaxf(x, dpp_f<0xB1>(x)); x = fmaxf(x, dpp_f<0x4E>(x)); x = fmaxf(x, dpp_f<0x141>(x)); x = fmaxf(x, dpp_f<0x128>(x)); return x; }
DI float wave_sum(float v) { return xhalf_sum(x16_sum(row_sum16(v))); }
DI float silu_f(float x) { return x * __builtin_amdgcn_rcpf(1.0f + __expf(-x)); }
DI float sigmoid_f(float x) { return __builtin_amdgcn_rcpf(1.0f + __expf(-x)); }
#ifdef OLD_TID
DI int tid_opaque(int wv) { int t = wv * 64 + (int)__builtin_amdgcn_mbcnt_hi(~0u, __builtin_amdgcn_mbcnt_lo(~0u, 0u)); asm volatile("" : "+v"(t)); return t; }
#else
DI int tid_opaque(int wv) { int ln; asm volatile("v_mbcnt_lo_u32_b32 %0, -1, 0\n\tv_mbcnt_hi_u32_b32 %0, -1, %0" : "=v"(ln) :: "memory"); return wv * 64 + ln; }
#endif
DI bf16x8 mk8u(unsigned a, unsigned b, unsigned c, unsigned d) { u32x4 v = {a, b, c, d}; return __builtin_bit_cast(bf16x8, v); }
#define LDS_WAIT() asm volatile("s_waitcnt lgkmcnt(0)" ::: "memory")
#define VM_WAIT() asm volatile("s_waitcnt vmcnt(0)" ::: "memory")
#define MFMA32(a, b, c) __builtin_amdgcn_mfma_f32_32x32x16_bf16((a), (b), (c), 0, 0, 0)

constexpr int NB = 32, SEQ = 2048, DM = 1024, NTOK = NB * SEQ;
constexpr int NIN_REF = 3592, NPROJ = 3584;
constexpr int PC_HY = 0, PC_MZ = 768, PC_MX = 1024, PC_AQ = 1536, PC_AK = 1792, PC_AV = 2048, PC_HQ = 2304, PC_HF = 2560, PC_HI = 3072, PC_HG = 3328;
constexpr int NEXP = 16, CAP = 256, NSLOT = NB * NEXP * CAP;
constexpr float EPSN = 1e-6f;

constexpr size_t MiB = 1u << 20;
constexpr size_t WS_CTL = 0, CTL_ZERO_BYTES = 64 * 1024;
constexpr size_t WS_DT = 1 * MiB, WS_AFF = 3 * MiB, WS_SLOT = 7 * MiB, WS_SELI = 11 * MiB, WS_SELG = 11 * MiB + 512 * 1024, WS_KFILT = 12 * MiB, WS_MSQ = 14 * MiB, WS_RS = 15 * MiB, WS_SELR = 15 * MiB + 512 * 1024;
constexpr size_t WS_XB = 64 * MiB, WS_WIN = 320 * MiB, WS_WOUT = 327 * MiB, WS_WGU = 329 * MiB, WS_WD = 393 * MiB, WS_HN = 432 * MiB, WS_PROJ = 560 * MiB, WS_YE = WS_PROJ, WS_END = 1008 * MiB, WS_MYB = WS_WGU, WS_OB = WS_WGU + 32 * MiB;
constexpr size_t DO_HW = 0, DO_HX0 = 32 * MiB, DO_YAT = 64 * MiB, DO_MXBC = 96 * MiB, DO_MY = 160 * MiB, DO_MST = 192 * MiB, DO_HST = 224 * MiB, DO_HDN = 0;
constexpr int CW_BAR = 1024;

constexpr int LDS_MISC = 163840 - 256, LDS_BYTES = 163840;

struct Params {
    const float *x, *w_in, *w_out, *norm_mix_w, *norm_ffn_w, *hy_conv_w, *hy_w1, *hy_b1, *hy_w2, *hy_b2, *hy_freq, *hy_w3, *hy_fbias,
                *m_conv_w, *m_conv_b, *m_dt_bias, *m_A_log, *m_D, *m_norm_w, *rel_bias, *hg_lb, *hg_norm_w, *router_w, *moe_wg, *moe_wu, *moe_wd, *final_w;
    float* out; unsigned char* ws;
    int ph_lo, ph_hi, wv, pad;
};

#define XB_TMO      128
#define XB_XCNT(j)  (256  + 64 * (j))
#define XB_XSUB(j)  (1280 + 64 * (j))
#define XB_XGEN(j)  (2304 + 64 * (j))
#define XB_TOP      3328
#define XB_TOPGEN   3392
#define XCD_BAR_WORDS 3456
#define XB_SPIN_CAP (1u << 18)
__device__ __forceinline__ unsigned xb_ld(unsigned* p)              { return __hip_atomic_load(p, __ATOMIC_RELAXED, __HIP_MEMORY_SCOPE_AGENT); }
__device__ __forceinline__ unsigned xb_add(unsigned* p, unsigned v) { return __hip_atomic_fetch_add(p, v, __ATOMIC_RELAXED, __HIP_MEMORY_SCOPE_AGENT); }
__device__ __forceinline__ unsigned xb_xcc_id() { return (unsigned)__builtin_amdgcn_s_getreg((3 << 11) | 20) & 0xFu; }
#define XB_SPIN(cond, bar) do { unsigned _sp = 0; while (cond) { __builtin_amdgcn_s_sleep(1); \
    if ((++_sp & 255u) == 0u) { if (xb_ld(&(bar)[XB_TMO])) break; if (_sp > XB_SPIN_CAP) { atomicAdd(&(bar)[XB_TMO], 1u); break; } } } } while (0)
struct XcdBarrier { unsigned* bar; unsigned x; volatile LAS unsigned* st; };
__device__ __forceinline__ XcdBarrier xcd_barrier_post(unsigned* bar, volatile LAS unsigned* st) {
    XcdBarrier b; b.bar = bar; b.x = xb_xcc_id(); b.st = st;
    if (threadIdx.x == 0) (void)xb_add(&bar[XB_XCNT(b.x)], 1u);
    return b;
}
__device__ __forceinline__ void xcd_barrier_complete(unsigned* bar, unsigned x, unsigned& nloc, unsigned& nx) {
    const unsigned G = gridDim.x * gridDim.y * gridDim.z;
    unsigned sum, cnt, mine, sp = 0u;
    for (;;) {
        sum = 0u; cnt = 0u; mine = 0u;
#pragma unroll
        for (unsigned j = 0; j < 16; ++j) { const unsigned c = xb_ld(&bar[XB_XCNT(j)]); sum += c; cnt += (c > 0u) ? 1u : 0u; mine = (j == x) ? c : mine; }
        if (sum == G) break;
        __builtin_amdgcn_s_sleep(1);
        if ((++sp & 255u) == 0u) { if (xb_ld(&bar[XB_TMO])) break; if (sp > XB_SPIN_CAP) { atomicAdd(&bar[XB_TMO], 1u); break; } }
    }
    nloc = mine > 0u ? mine : 1u; nx = cnt > 0u ? cnt : 1u;
}
__device__ __forceinline__ void xcd_barrier(const XcdBarrier& b) {
    asm volatile("s_waitcnt vmcnt(0)" ::: "memory");
    __syncthreads();
    if (threadIdx.x == 0) {
        unsigned* bar = b.bar; asm volatile("" : "+s"(bar));
        __builtin_amdgcn_s_waitcnt(0);
        unsigned nloc = b.st[0], nx = b.st[1];
        if (nloc == 0u) { xcd_barrier_complete(bar, b.x, nloc, nx); b.st[0] = nloc; b.st[1] = nx; }
        const unsigned old = xb_add(&bar[XB_XSUB(b.x)], 1u);
        const unsigned gen = old / nloc;
        if (old + 1u == (gen + 1u) * nloc) {
            __builtin_amdgcn_fence(__ATOMIC_RELEASE, "agent");
            asm volatile("s_waitcnt vmcnt(0)" ::: "memory");
            const unsigned og = xb_add(&bar[XB_TOP], 1u);
            const unsigned tg = og / nx;
            if (og + 1u == (tg + 1u) * nx) xb_add(&bar[XB_TOPGEN], 1u);
            else XB_SPIN(xb_ld(&bar[XB_TOPGEN]) == tg, bar);
            __builtin_amdgcn_fence(__ATOMIC_ACQUIRE, "agent");
            xb_add(&bar[XB_XGEN(b.x)], 1u);
            asm volatile("s_waitcnt vmcnt(0)" ::: "memory");
        } else {
            XB_SPIN(xb_ld(&bar[XB_XGEN(b.x)]) == gen, bar);
            __builtin_amdgcn_fence(__ATOMIC_ACQUIRE, "agent");
            asm volatile("s_waitcnt vmcnt(0)" ::: "memory");
        }
    }
    __syncthreads();
}

namespace pg8 {
constexpr int BM = 256, BK = 64, HALF = 128, HTB = HALF * BK * 2, STAGE_BYTES = 8 * HTB, NXCD = 8, WGM = 8;
__host__ __device__ __forceinline__ int lds_byte(int r, int c) { const int st = (r >> 4) * 2 + (c >> 5), rr = r & 15, cc = c & 31, ob = rr * 64 + cc * 2; return st * 1024 + (ob ^ (((ob >> 9) & 1) << 5)); }
__host__ __device__ __forceinline__ void stage_rc(int b, int& R, int& C) { const int st = b / 1024, sb = b % 1024, swz = sb ^ (((sb >> 9) & 1) << 5); R = (st >> 1) * 16 + swz / 64; C = (st & 1) * 32 + (swz % 64) / 2; }
__host__ __device__ __forceinline__ int perm32(int rho) { const int n = rho >> 4, i = rho & 15; return 8 * (i >> 2) + 4 * n + (i & 3); }
struct Unit { int pm, pn; };
typedef int i32x8 __attribute__((ext_vector_type(8)));
typedef int i32x32 __attribute__((ext_vector_type(32)));
#define INS4(V, P, X) do { const i32x4 _x = (X); (V)[(P)] = _x.x; (V)[(P) + 1] = _x.y; (V)[(P) + 2] = _x.z; (V)[(P) + 3] = _x.w; } while (0)
#define EXT8(V, P) ((i32x8){(V)[(P)], (V)[(P) + 1], (V)[(P) + 2], (V)[(P) + 3], (V)[(P) + 4], (V)[(P) + 5], (V)[(P) + 6], (V)[(P) + 7]})
DI i32x8 cat88(bf16x8 lo, bf16x8 hi) { const i32x4 a = __builtin_bit_cast(i32x4, lo), b = __builtin_bit_cast(i32x4, hi); return (i32x8){a.x, a.y, a.z, a.w, b.x, b.y, b.z, b.w}; }
struct StaticOrder {
    int nM, nN, nwg, G, c;
    __device__ void init(int nM_, int nN_, int G_, int c_) { nM = nM_; nN = nN_; nwg = nM * nN; G = G_; c = c_; }
    __device__ bool next(int i, Unit& u) const {
        const long L = (long)i * G + c; if (L >= nwg) return false;
        int wgid = (int)L; { const int q = nwg / NXCD, r = nwg % NXCD, xcd = wgid % NXCD, off = wgid / NXCD; wgid = (xcd < r ? xcd * (q + 1) : r * (q + 1) + (xcd - r) * q) + off; }
        const int nig = WGM * nN, gid = wgid / nig, fm = gid * WGM, gsz = (nM - fm) < WGM ? (nM - fm) : WGM;
        u.pm = fm + ((wgid % nig) % gsz); u.pn = (wgid % nig) / gsz; return true;
    }
};
#ifndef TPROBE
#define TPROBE 0
#endif
#ifndef TPGEMM
#define TPGEMM 0
#endif
#define GP_T() ({ asm volatile("" ::: "memory"); unsigned _t = (unsigned)__builtin_amdgcn_s_memrealtime(); asm volatile("" ::: "memory"); _t; })
#define GP_ON(k) (TPROBE == (k) && Epi::PID == TPGEMM)
template <class Epi, class Sched, class Addr, bool F8 = false>
__device__ __forceinline__ void gemm_phase(LAS unsigned char* lds, const char* Abase, const char* Bbase, int K, const Sched& S, const Addr& AD, const Epi& E, int wv, unsigned* lds_ws_ctl = nullptr) {
    const int tid = tid_opaque(wv), wid = __builtin_amdgcn_readfirstlane(tid >> 6), lane = tid & 63, wr = wid >> 2, wc = wid & 3, fr = lane & 15, fq = lane >> 4;
    unsigned gp_acc = 0, gp_tot = 0, gp_t0 = 0, gp_t1 = 0; if (TPROBE >= 40 && TPROBE < 50 && Epi::PID == TPGEMM) gp_t0 = GP_T();
    const int KB = F8 ? K : 2 * K;
    const int nt = KB / 128;
    int Rr[2]; unsigned Cc[2], voffB[2], voffA[2];
#pragma unroll
    for (int i = 0; i < 2; ++i) { int R, C; stage_rc(tid * 16 + i * 8192, R, C); const int Rb = Epi::PERM ? ((R & ~31) + perm32(R & 31)) : R;
        Rr[i] = R; Cc[i] = (unsigned)C * 2u; voffA[i] = (unsigned)(R * KB + C * 2); voffB[i] = (unsigned)(Rb * KB + C * 2); }
    const size_t kstep = (size_t)(BK * 2);
    const size_t hstep = (size_t)HALF * KB;
    const unsigned ldsw = (unsigned)wid * 1024u;
    const int aoff = F8 ? lds_byte(wr * 64 + fr, fq * 16) : lds_byte(wr * 64 + fr, fq * 8), boff = F8 ? lds_byte(wc * 32 + fr, fq * 16) : lds_byte(wc * 32 + fr, fq * 8);
    const int aoff1 = F8 ? lds_byte(wr * 64 + fr, fq * 16 + 8) : aoff + 1024, boff1 = F8 ? lds_byte(wc * 32 + fr, fq * 16 + 8) : boff + 1024;
#define PG8_SA(b, h) (((b) * 2 + (h)) * HTB)
#define PG8_SB(b, h) ((4 + (b) * 2 + (h)) * HTB)
#define PG8_STAGE(bufoff, gbase, voff) do { _Pragma("unroll") for (int _i = 0; _i < 2; ++_i) \
        __builtin_amdgcn_global_load_lds((const unsigned*)((const char*)(gbase) + (voff)[_i]), (LAS unsigned*)(lds + (bufoff) + ldsw + _i * 8192), 16, 0, 0); } while (0)
#define PG8_STAGE_A(bufoff, kb, h, un) do { if constexpr (Addr::LOADS) { _Pragma("unroll") for (int _i = 0; _i < 2; ++_i) \
        __builtin_amdgcn_global_load_lds((const unsigned*)(Abase + (kb) + ((un) ? on[h][_i] : oc[h][_i])), (LAS unsigned*)(lds + (bufoff) + ldsw + _i * 8192), 16, 0, 0); } \
      else { const char* _ab = ((un) ? nA : cA) + (kb) + (size_t)(h) * hstep; _Pragma("unroll") for (int _i = 0; _i < 2; ++_i) \
        __builtin_amdgcn_global_load_lds((const unsigned*)(_ab + voffA[_i]), (LAS unsigned*)(lds + (bufoff) + ldsw + _i * 8192), 16, 0, 0); } } while (0)
#define PG8_BSEL_B0 0
#define PG8_BSEL_B1 16
#define PG8_LDA(dst, b, h) do { if constexpr (F8) { _Pragma("unroll") for (int m = 0; m < 4; ++m) { INS4(AA, 8 * m, *(const LAS i32x4*)(lds + PG8_SA(b, h) + aoff + m * 2048)); INS4(AA, 8 * m + 4, *(const LAS i32x4*)(lds + PG8_SA(b, h) + aoff + 16 + m * 2048)); } } \
      else { _Pragma("unroll") for (int m = 0; m < 4; ++m) _Pragma("unroll") for (int k = 0; k < 2; ++k) dst[m][k] = *(const LAS bf16x8*)(lds + PG8_SA(b, h) + (k ? aoff1 : aoff) + m * 2048); } } while (0)
#define PG8_LDB(dst, b, h) do { if constexpr (F8) { _Pragma("unroll") for (int n = 0; n < 2; ++n) { INS4(BB, PG8_BSEL_##dst + 8 * n, *(const LAS i32x4*)(lds + PG8_SB(b, h) + boff + n * 2048)); INS4(BB, PG8_BSEL_##dst + 8 * n + 4, *(const LAS i32x4*)(lds + PG8_SB(b, h) + boff + 16 + n * 2048)); } } \
      else { _Pragma("unroll") for (int n = 0; n < 2; ++n) _Pragma("unroll") for (int k = 0; k < 2; ++k) dst[n][k] = *(const LAS bf16x8*)(lds + PG8_SB(b, h) + (k ? boff1 : boff) + n * 2048); } } while (0)
#define PG8_MMA(ai, bj, At, Bt) do { __builtin_amdgcn_s_setprio(1); if constexpr (F8) { _Pragma("unroll") for (int m = 0; m < 4; ++m) _Pragma("unroll") for (int n = 0; n < 2; ++n) \
        { const i32x8 _b8 = EXT8(BB, PG8_BSEL_##Bt + 8 * n), _a8 = EXT8(AA, 8 * m); \
          asm volatile("s_nop 1\n\tv_mfma_scale_f32_16x16x128_f8f6f4 %0, %1, %2, %0, %3, %4 op_sel_hi:[0,0,0]" : "+v"(acc[ai][bj][m][n]) : "v"(_b8), "v"(_a8), "v"(scw), "v"(scx)); } } \
      else { _Pragma("unroll") for (int m = 0; m < 4; ++m) _Pragma("unroll") for (int n = 0; n < 2; ++n) _Pragma("unroll") for (int k = 0; k < 2; ++k) \
        acc[ai][bj][m][n] = __builtin_amdgcn_mfma_f32_16x16x32_bf16(Bt[n][k], At[m][k], acc[ai][bj][m][n], 0, 0, 0); } __builtin_amdgcn_s_setprio(0); } while (0)
#define PG8_WAIT_V(n) asm volatile("s_waitcnt vmcnt(" #n ")" ::: "memory")
#define PG8_WAIT_L(n) asm volatile("s_waitcnt lgkmcnt(" #n ")" ::: "memory")
#define PG8_BAR __builtin_amdgcn_s_barrier()
#define PG8_SCHED __builtin_amdgcn_sched_barrier(0)
    int scw = 0, scx = 0; if constexpr (F8) { scw = Addr::SC_W; scx = Addr::SC_X; } (void)scw; (void)scx;
    Unit cur, nxt; int ui = 0;
    if (!S.next(0, cur)) return;
#ifdef STAG_TICKS
    {
        const unsigned long long t0 = __builtin_amdgcn_s_memrealtime(); const unsigned long long dl = (unsigned long long)(((blockIdx.x >> 3) & 7) * STAG_TICKS);
        while (__builtin_amdgcn_s_memrealtime() - t0 < dl) __builtin_amdgcn_s_sleep(16);
    }
#endif
    f32x4 acc[2][2][4][2];
#pragma unroll
    for (int a = 0; a < 2; ++a)
#pragma unroll
        for (int b = 0; b < 2; ++b)
#pragma unroll
            for (int m = 0; m < 4; ++m)
#pragma unroll
                for (int n = 0; n < 2; ++n) acc[a][b][m][n] = (f32x4){0.f, 0.f, 0.f, 0.f};
    bf16x8 At[4][2], B0[2][2], B1[2][2]; i32x32 AA, BB; (void)At; (void)B0; (void)B1; (void)AA; (void)BB;
    unsigned oc[2][2], on[2][2];
    const char* cA = Abase; const char* nA = Abase;
    if constexpr (Epi::ROWTAB) {
        Unit tu;
        for (int k = 0; k < 16 && S.next(k, tu); ++k)
            for (int r = tid; r < 256; r += 512) ((LAS float*)(lds + STAGE_BYTES + 8192))[k * 256 + r] = E.rowscale(tu, r);
        if constexpr (!Addr::LOADS) __syncthreads();
    }
    if constexpr (Addr::LOADS) {
        {
            Unit tu;
            for (int k = 0; k < 16 && S.next(k, tu); ++k)
                for (int r = tid; r < 256; r += 512) ((LAS unsigned short*)(lds + STAGE_BYTES))[k * 256 + r] = AD.arow_tok(tu, r);
            __syncthreads();
        }
#pragma unroll
        for (int h = 0; h < 2; ++h)
#pragma unroll
            for (int i = 0; i < 2; ++i) { oc[h][i] = AD.arow_lds(lds + STAGE_BYTES, 0, cur, h * HALF + Rr[i]) + Cc[i]; on[h][i] = oc[h][i]; }
        PG8_WAIT_V(0);
    } else { cA = Abase + AD.arow(cur, 0); nA = cA; }
    const char* cB = Bbase + AD.boff(cur);
    PG8_STAGE(PG8_SB(0, 0), cB, voffB); PG8_STAGE_A(PG8_SA(0, 0), 0, 0, false); PG8_STAGE(PG8_SB(0, 1), cB + hstep, voffB); PG8_STAGE_A(PG8_SA(0, 1), 0, 1, false);
    if (wr == 1) PG8_BAR;
    PG8_WAIT_V(4); PG8_BAR;
    PG8_STAGE(PG8_SB(1, 0), cB + kstep, voffB); PG8_STAGE_A(PG8_SA(1, 0), kstep, 0, false); PG8_STAGE(PG8_SB(1, 1), cB + hstep + kstep, voffB);
    PG8_WAIT_V(6); PG8_BAR;
    for (;;) {
        const bool has_next = S.next(ui + 1, nxt);
        if (has_next) {
            if constexpr (Addr::LOADS) {
#pragma unroll
                for (int h = 0; h < 2; ++h)
#pragma unroll
                    for (int i = 0; i < 2; ++i) on[h][i] = AD.arow_lds(lds + STAGE_BYTES, ui + 1, nxt, h * HALF + Rr[i]) + Cc[i];
            } else nA = Abase + AD.arow(nxt, 0);
        } else nA = cA;
        const char* nB = has_next ? Bbase + AD.boff(nxt) : cB;
        if (GP_ON(41)) gp_t1 = GP_T();
#pragma unroll 1
        for (int t = 0; t < nt; t += 2) {
            if (GP_ON(43) && t == 0) gp_t1 = GP_T();
            if (GP_ON(44) && t == 2) gp_t1 = GP_T();
            const bool last = (t == nt - 2);
            const bool un = last && has_next;
            const size_t k1 = (size_t)(t + 1) * kstep;
            const size_t k2 = last ? 0 : (size_t)(t + 2) * kstep, k3 = k2 + kstep;
            const char* b2 = last ? nB : cB + (size_t)(t + 2) * kstep;
            const char* b3 = b2 + kstep;
            PG8_LDB(B0, 0, 0); PG8_SCHED; PG8_LDA(At, 0, 0); PG8_STAGE_A(PG8_SA(1, 1), k1, 1, false);
            PG8_WAIT_L(8); PG8_BAR; PG8_WAIT_L(0); PG8_MMA(0, 0, At, B0); PG8_BAR; PG8_SCHED;
            PG8_LDB(B1, 0, 1); PG8_STAGE(PG8_SB(0, 0), b2, voffB);
            PG8_BAR; PG8_WAIT_L(0); PG8_MMA(0, 1, At, B1); PG8_BAR;
            PG8_LDA(At, 0, 1); PG8_STAGE_A(PG8_SA(0, 0), k2, 0, un);
            PG8_BAR; PG8_WAIT_L(0); PG8_MMA(1, 0, At, B0); PG8_BAR; PG8_SCHED;
            PG8_STAGE(PG8_SB(0, 1), b2 + hstep, voffB);
            PG8_WAIT_V(6); PG8_BAR; PG8_MMA(1, 1, At, B1); PG8_BAR;
            PG8_LDB(B0, 1, 0); PG8_SCHED; PG8_LDA(At, 1, 0); PG8_STAGE_A(PG8_SA(0, 1), k2, 1, un);
            PG8_WAIT_L(8); PG8_BAR; PG8_WAIT_L(0); PG8_MMA(0, 0, At, B0); PG8_BAR; PG8_SCHED;
            PG8_LDB(B1, 1, 1); PG8_STAGE(PG8_SB(1, 0), b3, voffB);
            PG8_BAR; PG8_WAIT_L(0); PG8_MMA(0, 1, At, B1); PG8_BAR;
            PG8_LDA(At, 1, 1); PG8_STAGE_A(PG8_SA(1, 0), k3, 0, un);
            PG8_BAR; PG8_WAIT_L(0); PG8_MMA(1, 0, At, B0); PG8_BAR; PG8_SCHED;
            PG8_STAGE(PG8_SB(1, 1), b3 + hstep, voffB);
            PG8_WAIT_V(6); PG8_BAR; PG8_MMA(1, 1, At, B1); PG8_BAR;
            if (GP_ON(43) && t == 0) gp_acc += GP_T() - gp_t1;
            if (GP_ON(44) && t == 2) gp_acc += GP_T() - gp_t1;
        }
        if (GP_ON(41)) gp_acc += GP_T() - gp_t1;
        if (GP_ON(42)) gp_t1 = GP_T();
        if constexpr (F8) asm volatile("s_nop 15\n\ts_nop 15" ::: "memory");
        E(acc, cur, wr, wc, fr, fq, (const LAS float*)(lds + STAGE_BYTES + 8192) + ui * 256);
        if (GP_ON(42)) gp_acc += GP_T() - gp_t1;
        if (!has_next) break;
#pragma unroll
        for (int a = 0; a < 2; ++a)
#pragma unroll
            for (int b = 0; b < 2; ++b)
#pragma unroll
                for (int m = 0; m < 4; ++m)
#pragma unroll
                    for (int n = 0; n < 2; ++n) acc[a][b][m][n] = (f32x4){0.f, 0.f, 0.f, 0.f};
        cur = nxt; cB = nB; cA = nA; ++ui;
        if constexpr (Addr::LOADS) {
#pragma unroll
            for (int h = 0; h < 2; ++h)
#pragma unroll
                for (int i = 0; i < 2; ++i) oc[h][i] = on[h][i]; }
    }
    PG8_WAIT_V(0);
    if (wr == 0) PG8_BAR;
    PG8_BAR;
    if (TPROBE >= 40 && TPROBE < 50 && Epi::PID == TPGEMM && tid == 0) { gp_tot = GP_T() - gp_t0; atomicAdd((unsigned*)lds_ws_ctl + 512, gp_acc); atomicAdd((unsigned*)lds_ws_ctl + 513, gp_tot); }
#undef PG8_SA
#undef PG8_SB
#undef PG8_STAGE
#undef PG8_STAGE_A
#undef PG8_BSEL_B0
#undef PG8_BSEL_B1
#undef PG8_LDA
#undef PG8_LDB
#undef PG8_MMA
#undef PG8_WAIT_V
#undef PG8_WAIT_L
#undef PG8_BAR
#undef PG8_SCHED
}
}

#ifndef EN_HY
#define EN_HY 1
#endif
#ifndef EN_MA
#define EN_MA 1
#endif
#ifndef EN_AT
#define EN_AT 1
#endif
#ifndef EN_HG
#define EN_HG 1
#endif
#ifndef EN_MOE
#define EN_MOE 1
#endif
#ifndef MOE_F8
#define MOE_F8 1
#endif

DI void transpose_item(const float* W, int ld, int k0, int n0, bf16_t* dst, int drow0, float scale, LAS float* scr, int lane, const float* kw = nullptr) {
    {
        const int rs = lane >> 3, cq = (lane & 7) * 4;
        f32x4 v[8];
#pragma unroll
        for (int i = 0; i < 8; ++i) v[i] = __builtin_nontemporal_load((const f32x4*)(W + (size_t)(k0 + 8 * i + rs) * ld + n0 + cq));
#pragma unroll
        for (int i = 0; i < 8; ++i) { LAS float* d = scr + (8 * i + rs) * 33 + cq; d[0] = v[i].x; d[1] = v[i].y; d[2] = v[i].z; d[3] = v[i].w; }
    }
    LDS_WAIT();
    const int c = lane & 7;
    float sk[8];
#pragma unroll
    for (int i = 0; i < 8; ++i) sk[i] = kw ? scale * kw[k0 + 8 * c + i] : scale;
#pragma unroll
    for (int j = 0; j < 4; ++j) { const int n = (lane >> 3) + 8 * j; const LAS float* s = scr + (8 * c) * 33 + n;
        u32x4 o; o.x = pk2(s[0 * 33] * sk[0], s[1 * 33] * sk[1]); o.y = pk2(s[2 * 33] * sk[2], s[3 * 33] * sk[3]); o.z = pk2(s[4 * 33] * sk[4], s[5 * 33] * sk[5]); o.w = pk2(s[6 * 33] * sk[6], s[7 * 33] * sk[7]);
        *(u32x4*)(dst + (size_t)(drow0 + n) * 1024 + k0 + 8 * c) = o; }
    LDS_WAIT();
}

DI void transpose_item_f8(const float* W, int ld, int k0, int n0, unsigned char* dst, int drow0, float scale, LAS float* scr, int lane) {
    {   const int rs = lane >> 3, cq = (lane & 7) * 4;
        f32x4 v[8];
#pragma unroll
        for (int i = 0; i < 8; ++i) v[i] = __builtin_nontemporal_load((const f32x4*)(W + (size_t)(k0 + 8 * i + rs) * ld + n0 + cq));
#pragma unroll
        for (int i = 0; i < 8; ++i) { LAS float* d = scr + (8 * i + rs) * 33 + cq; d[0] = v[i].x; d[1] = v[i].y; d[2] = v[i].z; d[3] = v[i].w; }
    }
    LDS_WAIT();
    const int c = lane & 7;
#pragma unroll
    for (int j = 0; j < 4; ++j) { const int n = (lane >> 3) + 8 * j; const LAS float* s = scr + (8 * c) * 33 + n;
        u32x2 o; o.x = pk4_fp8(s[0 * 33] * scale, s[1 * 33] * scale, s[2 * 33] * scale, s[3 * 33] * scale); o.y = pk4_fp8(s[4 * 33] * scale, s[5 * 33] * scale, s[6 * 33] * scale, s[7 * 33] * scale);
        *(u32x2*)(dst + (size_t)(drow0 + n) * 1024 + k0 + 8 * c) = o; }
    LDS_WAIT();
}

#define RDL(x, i) __uint_as_float(__builtin_amdgcn_readlane(__float_as_uint(x), (i)))
DI void hyena_filter_pos(const Params& P, int l, int pos, int lane, bf16_t* kfilt) {
    const float TWO_PI = 6.283185307179586f;
    const float tpos = (float)pos * (1.0f / 2047.0f);
    float z = 0.f;
    if (lane == 0) z = tpos;
    else if (lane <= 32) { const int bnd = (lane - 1) & 15; const float f = 1e-4f + (float)bnd * ((15.0f - 1e-4f) / 15.0f);
        const float angp = TWO_PI * (float)pos / 2048.0f; const float ang = angp * f; z = (lane <= 16) ? cosf(ang) : -sinf(ang); }
    const float* w1 = P.hy_w1 + (size_t)l * 33 * 64; const float* w2 = P.hy_w2 + (size_t)l * 64 * 64; const float* w3 = P.hy_w3 + (size_t)l * 64 * 512;
    const float fr = P.hy_freq[l * 64 + lane];
    float a = P.hy_b1[l * 64 + lane];
#pragma unroll 11
    for (int i = 0; i < 33; ++i) a += RDL(z, i) * w1[i * 64 + lane];
    const float h1 = sinf(fr * a);
    float a2 = P.hy_b2[l * 64 + lane];
#pragma unroll 16
    for (int i = 0; i < 64; ++i) a2 += RDL(h1, i) * w2[i * 64 + lane];
    const float h2 = sinf(fr * a2);
    float h3[8];
#pragma unroll
    for (int k = 0; k < 8; ++k) h3[k] = 0.f;
#pragma unroll 8
    for (int i = 0; i < 64; ++i) { const float hv = RDL(h2, i);
#pragma unroll
        for (int k = 0; k < 8; ++k) h3[k] += hv * w3[i * 512 + k * 64 + lane]; }
    const float min_decay = -3.0701134573253944f, max_decay = -15.350567286626972f;
#pragma unroll
    for (int k = 0; k < 8; ++k) { const int cp = k * 64 + lane, c = cp & 255;
        const float delta = fabsf(min_decay + (float)c * ((max_decay - min_decay) / 255.0f));
        float v = h3[k] * expf(-tpos * delta);
        if (cp < 256) { if (pos == 0) { v += P.hy_fbias[l * 256 + c]; kfilt[(size_t)c * 4096 + 4095] = 0; } kfilt[(size_t)c * 4096 + 2047 - pos] = f2bf(v); }
        else if (pos >= 1) kfilt[(size_t)c * 4096 + 2047 + pos] = f2bf(v); }
}
#undef RDL

struct SelRows { int cnt; unsigned o0, o1, o2, o3; };
DI SelRows sel_compact(int sl, int b) {
    SelRows r; r.cnt = 0; r.o0 = r.o1 = r.o2 = r.o3 = 0u;
#pragma unroll
    for (int e = 0; e < 16; ++e) { const int s = __builtin_amdgcn_readlane(sl, e); const bool on = s >= 0; const unsigned v = (unsigned)((b * 16 + e) * 256 + s);
        r.o0 = (on && r.cnt == 0) ? v : r.o0; r.o1 = (on && r.cnt == 1) ? v : r.o1; r.o2 = (on && r.cnt == 2) ? v : r.o2; r.o3 = (on && r.cnt == 3) ? v : r.o3; r.cnt += on ? 1 : 0; }
    return r;
}
typedef float f32x2_ __attribute__((ext_vector_type(2)));
DI void ye_load(const unsigned char* YE, unsigned o, int lane, unsigned (&t)[4]) { const unsigned* yr = (const unsigned*)(YE + (size_t)o * DM) + lane;
#pragma unroll
    for (int j = 0; j < 4; ++j) t[j] = yr[64 * j]; }
DI void ye_add(f32x4 (&v)[4], const unsigned (&t)[4]) {
#pragma unroll
    for (int j = 0; j < 4; ++j) { const f32x2_ a = __builtin_amdgcn_cvt_pk_f32_fp8((int)t[j], false), b = __builtin_amdgcn_cvt_pk_f32_fp8((int)t[j], true);
        v[j].x += a.x * (1.0f / 64.0f); v[j].y += a.y * (1.0f / 64.0f); v[j].z += b.x * (1.0f / 64.0f); v[j].w += b.y * (1.0f / 64.0f); } }
template <bool FINAL>
DI void pre_rows2(const Params& P, int l, const int (&m)[2], int lane, const LAS f32x4* dtw, const float* nw, const int (&slp)[2]) {
    unsigned char* ws = P.ws;
    bf16_t* XB = (bf16_t*)(ws + WS_XB);
    const bool first = (!FINAL && l == 0);
    f32x4 v[2][4];
    if (first) {
#pragma unroll
        for (int k = 0; k < 2; ++k) { const f32x4* xr = (const f32x4*)(P.x + (size_t)m[k] * DM) + lane;
#pragma unroll
            for (int j = 0; j < 4; ++j) v[k][j] = xr[64 * j]; }
    } else {
        u32x2 xh[2][4];
#pragma unroll
        for (int k = 0; k < 2; ++k) { const u32x2* xr = (const u32x2*)(XB + (size_t)m[k] * DM) + lane;
#pragma unroll
            for (int j = 0; j < 4; ++j) xh[k][j] = xr[64 * j]; }
#pragma unroll
        for (int k = 0; k < 2; ++k)
#pragma unroll
            for (int j = 0; j < 4; ++j) v[k][j] = (f32x4){bflo(xh[k][j].x), bfhi(xh[k][j].x), bflo(xh[k][j].y), bfhi(xh[k][j].y)};
    }
    if (!first && EN_MOE) {
        const unsigned char* YE = (const unsigned char*)(ws + WS_YE); const int* slot = (const int*)(ws + WS_SLOT);
        int sl[2]; SelRows sr[2]; (void)slot;
#pragma unroll
        for (int k = 0; k < 2; ++k) sl[k] = slp[k];
#pragma unroll
        for (int k = 0; k < 2; ++k) sr[k] = sel_compact(sl[k], m[k] >> 11);
        unsigned t[2][4][4];
#pragma unroll
        for (int k = 0; k < 2; ++k) { if (sr[k].cnt > 0) ye_load(YE, sr[k].o0, lane, t[k][0]); if (sr[k].cnt > 1) ye_load(YE, sr[k].o1, lane, t[k][1]);
            if (sr[k].cnt > 2) ye_load(YE, sr[k].o2, lane, t[k][2]); if (sr[k].cnt > 3) ye_load(YE, sr[k].o3, lane, t[k][3]); }
#pragma unroll
        for (int k = 0; k < 2; ++k) { if (sr[k].cnt > 0) ye_add(v[k], t[k][0]); if (sr[k].cnt > 1) ye_add(v[k], t[k][1]); if (sr[k].cnt > 2) ye_add(v[k], t[k][2]); if (sr[k].cnt > 3) ye_add(v[k], t[k][3]);
            if (sr[k].cnt > 4) {
                int seen = 0; const int b = m[k] >> 11;
                for (int e = 0; e < 16; ++e) { const int s = __builtin_amdgcn_readlane(sl[k], e);
                    if (s >= 0) { if (seen >= 4) { unsigned tt[4]; ye_load(YE, (unsigned)((b * 16 + e) * 256 + s), lane, tt); ye_add(v[k], tt); } ++seen; } } } }
    }
    float rr[2];
#pragma unroll
    for (int k = 0; k < 2; ++k) {
        float s = 0.f;
#pragma unroll
        for (int j = 0; j < 4; ++j) s += (v[k][j].x * v[k][j].x + v[k][j].y * v[k][j].y) + (v[k][j].z * v[k][j].z + v[k][j].w * v[k][j].w);
        rr[k] = __builtin_amdgcn_rsqf(wave_sum(s) * (1.0f / DM) + EPSN);
    }
    if (FINAL) {
#pragma unroll
        for (int k = 0; k < 2; ++k) { f32x4* o = (f32x4*)(P.out + (size_t)m[k] * DM) + lane;
#pragma unroll
            for (int j = 0; j < 4; ++j) { const f32x4 w = ((const f32x4*)nw)[64 * j + lane]; o[64 * j] = v[k][j] * rr[k] * w; } }
        return;
    }
    {
#pragma unroll
        for (int k = 0; k < 2; ++k) { u32x2* o = (u32x2*)(XB + (size_t)m[k] * DM) + lane;
#pragma unroll
            for (int j = 0; j < 4; ++j) o[64 * j] = (u32x2){pk2(v[k][j].x, v[k][j].y), pk2(v[k][j].z, v[k][j].w)}; } }
    float d[2][8];
#pragma unroll
    for (int k = 0; k < 2; ++k)
#pragma unroll
        for (int c = 0; c < 8; ++c) d[k][c] = 0.f;
#pragma unroll
    for (int j = 0; j < 4; ++j) {
#pragma unroll
        for (int q = 0; q < 4; ++q) { const f32x4 w0 = dtw[((j * 4 + q) * 2 + 0) * 64 + lane], w1 = dtw[((j * 4 + q) * 2 + 1) * 64 + lane];
#pragma unroll
            for (int k = 0; k < 2; ++k) { const float xv = q == 0 ? v[k][j].x : (q == 1 ? v[k][j].y : (q == 2 ? v[k][j].z : v[k][j].w));
                d[k][0] += xv * w0.x; d[k][1] += xv * w0.y; d[k][2] += xv * w0.z; d[k][3] += xv * w0.w; d[k][4] += xv * w1.x; d[k][5] += xv * w1.y; d[k][6] += xv * w1.z; d[k][7] += xv * w1.w; } }
    }
#pragma unroll
    for (int k = 0; k < 2; ++k) {
        float mine = 0.f;
#pragma unroll
        for (int c = 0; c < 8; ++c) { const float t2 = wave_sum(d[k][c]); mine = (lane == c) ? t2 : mine; }
        if (lane < 8) ((float*)(ws + WS_DT))[(size_t)m[k] * 8 + lane] = mine * rr[k];
        if (lane == 8) ((float*)(ws + WS_MSQ))[m[k]] = rr[k];
    }
    (void)nw;
}

DI void phase_pre(const Params& P, int l, LAS unsigned char* lds) {
    const int tid = tid_opaque(P.wv), lane = tid & 63, wave = tid >> 6;
    const int gw = blockIdx.x * 8 + wave, NGW = gridDim.x * 8;
    unsigned char* ws = P.ws;
    LAS float* dtwf = (LAS float*)lds;
    const float* win_ = P.w_in; asm volatile("" : "+s"(win_));
    for (int i = tid; i < 1024 * 8; i += 512) { const int k = i >> 3, c = i & 7; const int j = k >> 8, ln = (k & 255) >> 2, q = k & 3;
        dtwf[((((j * 4 + q) * 2 + (c >> 2)) * 64 + ln) << 2) + (c & 3)] = P.norm_mix_w[l * DM + k] * win_[((size_t)l * DM + k) * NIN_REF + 1536 + c]; }
    __syncthreads();
    if (EN_HY) for (int pos = gw; pos < SEQ; pos += NGW) hyena_filter_pos(P, l, pos, lane, (bf16_t*)(ws + WS_KFILT));
    {
        LAS float* scr = (LAS float*)(lds + 32768 + wave * 8448);
        constexpr int I_A = 16 * 48, I_B = 16 * 64, I_O = 16 * 32, I_E = 16 * 32 * 16;
        constexpr int NITEMS = I_A + I_B + I_O; (void)I_E;
        bf16_t* WinT = (bf16_t*)(ws + WS_WIN); bf16_t* WoutT = (bf16_t*)(ws + WS_WOUT); bf16_t* WguT = (bf16_t*)(ws + WS_WGU); bf16_t* WdT = (bf16_t*)(ws + WS_WD);
        for (int it = gw; it < NITEMS; it += NGW) {
            int r = it;
            if (r < I_A) { const int kb = r / 48, nb = r % 48; transpose_item(P.w_in + (size_t)l * DM * NIN_REF, NIN_REF, 64 * kb, 32 * nb, WinT, 32 * nb, 1.0f, scr, lane, P.norm_mix_w + l * DM); continue; } r -= I_A;
            if (r < I_B) { const int kb = r / 64, nb = r % 64; const int drow = 1536 + 32 * nb; transpose_item(P.w_in + (size_t)l * DM * NIN_REF, NIN_REF, 64 * kb, 1544 + 32 * nb, WinT, drow, drow < PC_AK ? 0.125f * 1.4426950408889634f : 1.0f  , scr, lane, P.norm_mix_w + l * DM); continue; } r -= I_B;
            { const int kb = r / 32, nb = r % 32; transpose_item(P.w_out + (size_t)l * DM * DM, DM, 64 * kb, 32 * nb, WoutT, 32 * nb, 1.0f, scr, lane); }
            (void)WguT; (void)WdT;
        }
    }
    const float* nw = P.norm_mix_w + l * DM;
    {
        const int* slotp = (const int*)(ws + WS_SLOT); const bool comb = (l != 0) && EN_MOE;
        int sln[2] = {0, 0};
        if (comb && gw < NTOK) { sln[0] = slotp[(size_t)gw * 16 + (lane & 15)]; sln[1] = slotp[(size_t)((gw + NGW < NTOK) ? gw + NGW : gw) * 16 + (lane & 15)]; }
        for (int m = gw; m < NTOK; m += 2 * NGW) { asm volatile("" ::: "memory"); const int mm[2] = {m, (m + NGW < NTOK) ? m + NGW : m};
            const int slc[2] = {sln[0], sln[1]}; const int mn = m + 2 * NGW;
            if (comb && mn < NTOK) { sln[0] = slotp[(size_t)mn * 16 + (lane & 15)]; sln[1] = slotp[(size_t)((mn + NGW < NTOK) ? mn + NGW : mn) * 16 + (lane & 15)]; }
            pre_rows2<false>(P, l, mm, lane, (const LAS f32x4*)dtwf, nw, slc); }
    }
}
DI void phase_final(const Params& P) {
    const int tid = tid_opaque(P.wv), lane = tid & 63, wave = tid >> 6;
    const int gw = blockIdx.x * 8 + wave, NGW = gridDim.x * 8;
    {
        const int* slotp = (const int*)(P.ws + WS_SLOT); const bool comb = EN_MOE;
        int sln[2] = {0, 0};
        if (comb && gw < NTOK) { sln[0] = slotp[(size_t)gw * 16 + (lane & 15)]; sln[1] = slotp[(size_t)((gw + NGW < NTOK) ? gw + NGW : gw) * 16 + (lane & 15)]; }
        for (int m = gw; m < NTOK; m += 2 * NGW) { const int mm[2] = {m, (m + NGW < NTOK) ? m + NGW : m};
            const int slc[2] = {sln[0], sln[1]}; const int mn = m + 2 * NGW;
            if (comb && mn < NTOK) { sln[0] = slotp[(size_t)mn * 16 + (lane & 15)]; sln[1] = slotp[(size_t)((mn + NGW < NTOK) ? mn + NGW : mn) * 16 + (lane & 15)]; }
            pre_rows2<true>(P, 1, mm, lane, nullptr, P.final_w, slc); }
    }
}

struct AddrPlain { static constexpr bool LOADS = false; int K; int nb_rows;
    DI unsigned arow(const pg8::Unit& u, int r) const { return (unsigned)(u.pm * 256 + r) * (unsigned)(K * 2); }
    DI size_t boff(const pg8::Unit& u) const { return (size_t)u.pn * 256 * K * 2; } };
DI int moe_panel(int r) { return (r & 31) * 16 + (r >> 5); }
struct AddrGateUp { static constexpr bool LOADS = true; const int* seli;
    DI unsigned arow(const pg8::Unit& u, int r) const { const int b = u.pm & 31; const int t = seli[moe_panel(u.pm) * 256 + r]; return (unsigned)(b * SEQ + t) * (unsigned)(DM * 2); }
    DI unsigned short arow_tok(const pg8::Unit& u, int r) const { return (unsigned short)seli[moe_panel(u.pm) * 256 + r]; }
    DI unsigned arow_lds(const LAS unsigned char* tab, int k, const pg8::Unit& u, int r) const { const int b = u.pm & 31; const int t = ((const LAS unsigned short*)tab)[k * 256 + r]; return (unsigned)(b * SEQ + t) * (unsigned)(DM * 2); }
    DI size_t boff(const pg8::Unit& u) const { return ((size_t)(u.pm >> 5) * 2048 + (size_t)u.pn * 256) * DM * 2; } };
struct AddrGateUp8 { static constexpr bool LOADS = true; static constexpr int SC_W = 0x79797979, SC_X = 0x7f7f7f7f; const int* seli;
    DI unsigned arow(const pg8::Unit& u, int r) const { const int b = u.pm & 31; const int t = seli[moe_panel(u.pm) * 256 + r]; return (unsigned)(b * SEQ + t) * (unsigned)DM; }
    DI unsigned short arow_tok(const pg8::Unit& u, int r) const { return (unsigned short)seli[moe_panel(u.pm) * 256 + r]; }
    DI unsigned arow_lds(const LAS unsigned char* tab, int k, const pg8::Unit& u, int r) const { const int b = u.pm & 31; const int t = ((const LAS unsigned short*)tab)[k * 256 + r]; return (unsigned)(b * SEQ + t) * (unsigned)DM; }
    DI size_t boff(const pg8::Unit& u) const { return ((size_t)(u.pm >> 5) * 2048 + (size_t)u.pn * 256) * DM; } };
struct AddrDown8 { static constexpr bool LOADS = false; static constexpr int SC_W = 0x79797979, SC_X = 0x7c7c7c7c;
    DI unsigned arow(const pg8::Unit& u, int r) const { return (unsigned)(moe_panel(u.pm) * 256 + r) * (unsigned)DM; }
    DI size_t boff(const pg8::Unit& u) const { return ((size_t)(u.pm >> 5) * 1024 + (size_t)u.pn * 256) * DM; } };
struct AddrDown { static constexpr bool LOADS = false;
    DI unsigned arow(const pg8::Unit& u, int r) const { return (unsigned)(moe_panel(u.pm) * 256 + r) * (unsigned)(DM * 2); }
    DI size_t boff(const pg8::Unit& u) const { return ((size_t)(u.pm >> 5) * 1024 + (size_t)u.pn * 256) * DM * 2; } };

struct EpiProj { static constexpr int PID = 1; static constexpr bool PERM = true, ROWTAB = true; bf16_t* O; const float* rsm;
    DI float rowscale(const pg8::Unit& u, int r) const { return rsm[u.pm * 256 + r]; }
    DI void operator()(const f32x4 (&acc)[2][2][4][2], const pg8::Unit& u, int wr, int wc, int fr, int fq, const LAS float* rtab) const {
        const int row0 = u.pm * 256 + wr * 64 + fr, col0 = u.pn * 256 + wc * 32 + 8 * fq;
#pragma unroll
        for (int ai = 0; ai < 2; ++ai)
#pragma unroll
            for (int m = 0; m < 4; ++m) { bf16_t* rowp = O + (size_t)(row0 + ai * 128 + m * 16) * NPROJ + col0; const float g = rtab[wr * 64 + fr + ai * 128 + m * 16];
#pragma unroll
                for (int bj = 0; bj < 2; ++bj) { const f32x4 v0 = acc[ai][bj][m][0] * g, v1 = acc[ai][bj][m][1] * g;
                    u32x4 w; w.x = pk2(v0[0], v0[1]); w.y = pk2(v0[2], v0[3]); w.z = pk2(v1[0], v1[1]); w.w = pk2(v1[2], v1[3]);
                    *(u32x4*)(rowp + bj * 128) = w; } }
    } };
struct EpiRes { static constexpr int PID = 5; static constexpr bool PERM = true, ROWTAB = false; const float* base32; const bf16_t* base16; bf16_t* out;
    DI void operator()(const f32x4 (&acc)[2][2][4][2], const pg8::Unit& u, int wr, int wc, int fr, int fq, const LAS float* rtab) const {
        const int row0 = u.pm * 256 + wr * 64 + fr, col0 = u.pn * 256 + wc * 32 + 8 * fq;
#pragma unroll
        for (int ai = 0; ai < 2; ++ai)
#pragma unroll
            for (int m = 0; m < 4; ++m) { const size_t off = (size_t)(row0 + ai * 128 + m * 16) * DM + col0;
#pragma unroll
                for (int bj = 0; bj < 2; ++bj) { f32x4 v0 = acc[ai][bj][m][0], v1 = acc[ai][bj][m][1];
                    if (base32) { v0 = v0 + *(const f32x4*)(base32 + off + bj * 128); v1 = v1 + *(const f32x4*)(base32 + off + bj * 128 + 4); }
                    else { const u32x4 bs = *(const u32x4*)(base16 + off + bj * 128);
                        v0 = v0 + (f32x4){bflo(bs.x), bfhi(bs.x), bflo(bs.y), bfhi(bs.y)}; v1 = v1 + (f32x4){bflo(bs.z), bfhi(bs.z), bflo(bs.w), bfhi(bs.w)}; }
                    u32x4 w; w.x = pk2(v0[0], v0[1]); w.y = pk2(v0[2], v0[3]); w.z = pk2(v1[0], v1[1]); w.w = pk2(v1[2], v1[3]);
                    *(u32x4*)(out + off + bj * 128) = w; } }
    } };
struct EpiGateUp { static constexpr int PID = 18; static constexpr bool PERM = true, ROWTAB = true; bf16_t* H; const float* selr;
    DI float rowscale(const pg8::Unit& u, int r) const { return selr[moe_panel(u.pm) * 256 + r]; }
    DI void operator()(const f32x4 (&acc)[2][2][4][2], const pg8::Unit& u, int wr, int wc, int fr, int fq, const LAS float* rtab) const {
        const int row0 = moe_panel(u.pm) * 256 + wr * 64 + fr, col0 = u.pn * 128 + wc * 32 + 8 * fq;
#pragma unroll
        for (int ai = 0; ai < 2; ++ai)
#pragma unroll
            for (int m = 0; m < 4; ++m) { bf16_t* rowp = H + (size_t)(row0 + ai * 128 + m * 16) * DM + col0; const float rr = rtab[wr * 64 + fr + ai * 128 + m * 16];
                float hv[8];
#pragma unroll
                for (int n = 0; n < 2; ++n)
#pragma unroll
                    for (int j = 0; j < 4; ++j) { const float g = acc[ai][0][m][n][j] * rr, up = acc[ai][1][m][n][j] * rr; hv[n * 4 + j] = silu_f(g) * up; }
                u32x4 w; w.x = pk2(hv[0], hv[1]); w.y = pk2(hv[2], hv[3]); w.z = pk2(hv[4], hv[5]); w.w = pk2(hv[6], hv[7]);
                *(u32x4*)rowp = w; }
    } };
struct EpiGateUp8 { static constexpr int PID = 8; static constexpr bool PERM = true, ROWTAB = true; unsigned char* H; const float* selr;
    DI float rowscale(const pg8::Unit& u, int r) const { return selr[moe_panel(u.pm) * 256 + r]; }
    DI void operator()(const f32x4 (&acc)[2][2][4][2], const pg8::Unit& u, int wr, int wc, int fr, int fq, const LAS float* rtab) const {
        const int row0 = moe_panel(u.pm) * 256 + wr * 64 + fr, col0 = u.pn * 128 + wc * 32 + 8 * fq;
#pragma unroll
        for (int ai = 0; ai < 2; ++ai)
#pragma unroll
            for (int m = 0; m < 4; ++m) { unsigned char* rowp = H + (size_t)(row0 + ai * 128 + m * 16) * DM + col0; const float rr = rtab[wr * 64 + fr + ai * 128 + m * 16]; const float c1 = -1.4426950408889634f * rr, k2 = 8.0f * rr * rr;
                float hv[8];
#pragma unroll
                for (int n = 0; n < 2; ++n)
#pragma unroll
                    for (int j = 0; j < 4; ++j) { const float g = acc[ai][0][m][n][j], up = acc[ai][1][m][n][j];
                        hv[n * 4 + j] = (g * up) * (k2 * __builtin_amdgcn_rcpf(1.0f + __builtin_amdgcn_exp2f(g * c1))); }
                *(u32x2*)rowp = (u32x2){pk4_fp8(hv[0], hv[1], hv[2], hv[3]), pk4_fp8(hv[4], hv[5], hv[6], hv[7])}; }
    } };
struct EpiDown { static constexpr int PID = 9; static constexpr bool PERM = true, ROWTAB = true; unsigned char* Y; const float* gate;
    DI float rowscale(const pg8::Unit& u, int r) const { return gate[moe_panel(u.pm) * 256 + r]; }
    DI void operator()(const f32x4 (&acc)[2][2][4][2], const pg8::Unit& u, int wr, int wc, int fr, int fq, const LAS float* rtab) const {
        const int row0 = moe_panel(u.pm) * 256 + wr * 64 + fr, col0 = u.pn * 256 + wc * 32 + 8 * fq;
#pragma unroll
        for (int ai = 0; ai < 2; ++ai)
#pragma unroll
            for (int m = 0; m < 4; ++m) { const int row = row0 + ai * 128 + m * 16; const float g = rtab[wr * 64 + fr + ai * 128 + m * 16] * 64.0f; unsigned char* rowp = Y + (size_t)row * DM + col0;
#pragma unroll
                for (int bj = 0; bj < 2; ++bj) { const f32x4 v0 = acc[ai][bj][m][0] * g, v1 = acc[ai][bj][m][1] * g;
                    *(u32x2*)(rowp + bj * 128) = (u32x2){pk4_fp8(v0[0], v0[1], v0[2], v0[3]), pk4_fp8(v1[0], v1[1], v1[2], v1[3])}; } }
    } };

DI void phase_premix(const Params& P, int l, LAS unsigned char* lds) {
    const int tid = tid_opaque(P.wv), lane = tid & 63, wave = tid >> 6;
    const int gw = blockIdx.x * 8 + wave, NGW = gridDim.x * 8;
    unsigned char* ws = P.ws;
    const bf16_t* proj = (const bf16_t*)(ws + WS_PROJ);
    unsigned char* dsc = (unsigned char*)P.out;
    if (EN_HY) {
        bf16_t* HW = (bf16_t*)(dsc + DO_HW); bf16_t* HX0 = (bf16_t*)(dsc + DO_HX0);
        const float* cw = P.hy_conv_w + (size_t)l * 3 * 768;
        LAS unsigned char* tl = lds + wave * 15616;
        const int rsub = lane >> 3, cch = lane & 7;
        const int i16 = lane & 15, trq = i16 >> 2, trp = i16 & 3, g16 = lane >> 4;
        const unsigned troff = (unsigned)(trq * 144 + (16 * g16 + 4 * trp) * 2);
        u32x4 rin[5][3];
#define HYPM_LOAD(IT) do { const int ct_ = (IT) & 3, tt_ = ((IT) >> 2) & 63, b_ = (IT) >> 8; const int t0_ = tt_ * 32; \
            const bf16_t* pr_ = proj + ((size_t)b_ * SEQ) * NPROJ + ct_ * 64 + 8 * cch; \
            _Pragma("unroll") for (int i = 0; i < 5; ++i) { const int rr = rsub + 8 * i; const int t = t0_ - 1 + rr; const bool ok = (rr < 34) && (t >= 0) && (t < SEQ); \
                const bf16_t* q = pr_ + (size_t)(ok ? t : 0) * NPROJ; \
                _Pragma("unroll") for (int a = 0; a < 3; ++a) { rin[i][a] = *(const u32x4*)(q + 256 * a); if (!ok) rin[i][a] = (u32x4){0u, 0u, 0u, 0u}; } } } while (0)
        if (gw < NB * 64 * 4) HYPM_LOAD(gw);
        for (int it = gw; it < NB * 64 * 4; it += NGW) {
            const int ct = it & 3, tt = (it >> 2) & 63, b = it >> 8;
            const int c = ct * 64 + lane, t0 = tt * 32;
#pragma unroll
            for (int i = 0; i < 5; ++i) { const int rr = rsub + 8 * i;
#pragma unroll
                for (int a = 0; a < 3; ++a) if (rr < 36) *(LAS u32x4*)(tl + a * 5184 + rr * 144 + 16 * cch) = rin[i][a]; }
            if (it + NGW < NB * 64 * 4) HYPM_LOAD(it + NGW);
            float w0[3], w1[3], w2[3];
#pragma unroll
            for (int j = 0; j < 3; ++j) { w0[j] = cw[j * 768 + c]; w1[j] = cw[j * 768 + 256 + c]; w2[j] = cw[j * 768 + 512 + c]; }
            LDS_WAIT();
            float p0[4], p1[4], p2[4];
            unsigned hwv[16], hxv[16];
#pragma unroll
            for (int j = 0; j < 9; ++j) {
                const s16x4 r0 = __builtin_amdgcn_ds_read_tr16_b64_v4i16((LAS s16x4*)(tl + 0 * 5184 + troff + (4 * j) * 144));
                const s16x4 r1 = __builtin_amdgcn_ds_read_tr16_b64_v4i16((LAS s16x4*)(tl + 1 * 5184 + troff + (4 * j) * 144));
                const s16x4 r2 = __builtin_amdgcn_ds_read_tr16_b64_v4i16((LAS s16x4*)(tl + 2 * 5184 + troff + (4 * j) * 144));
                float c0[4], c1[4], c2[4];
#pragma unroll
                for (int k = 0; k < 4; ++k) { c0[k] = bf2f((unsigned short)r0[k]); c1[k] = bf2f((unsigned short)r1[k]); c2[k] = bf2f((unsigned short)r2[k]); }
                if (j > 0) {
                    float u0[4], hv[4];
#pragma unroll
                    for (int k = 0; k < 4; ++k) { const float a0 = p0[k], a1 = p1[k], a2 = p2[k];
                        const float b0 = (k < 3) ? p0[k + 1] : c0[0], b1 = (k < 3) ? p1[k + 1] : c1[0], b2 = (k < 3) ? p2[k + 1] : c2[0];
                        const float d0 = (k < 2) ? p0[k + 2] : c0[k - 2], d1 = (k < 2) ? p1[k + 2] : c1[k - 2], d2 = (k < 2) ? p2[k + 2] : c2[k - 2];
                        u0[k] = w0[0] * a0 + w0[1] * b0 + w0[2] * d0;
                        hv[k] = (w2[0] * a2 + w2[1] * b2 + w2[2] * d2) * (w1[0] * a1 + w1[1] * b1 + w1[2] * d1); }
                    hwv[2 * (j - 1)] = pk2(hv[0], hv[1]); hwv[2 * (j - 1) + 1] = pk2(hv[2], hv[3]); hxv[2 * (j - 1)] = pk2(u0[0], u0[1]); hxv[2 * (j - 1) + 1] = pk2(u0[2], u0[3]);
                }
#pragma unroll
                for (int k = 0; k < 4; ++k) { p0[k] = c0[k]; p1[k] = c1[k]; p2[k] = c2[k]; }
            }
            bf16_t* hwp = HW + ((size_t)c * NB + b) * SEQ + t0; bf16_t* hxp = HX0 + ((size_t)c * NB + b) * SEQ + t0;
#pragma unroll
            for (int k = 0; k < 4; ++k) { *(u32x4*)(hwp + 8 * k) = (u32x4){hwv[4 * k], hwv[4 * k + 1], hwv[4 * k + 2], hwv[4 * k + 3]}; *(u32x4*)(hxp + 8 * k) = (u32x4){hxv[4 * k], hxv[4 * k + 1], hxv[4 * k + 2], hxv[4 * k + 3]}; }
            LDS_WAIT();
        }
    }
    if (EN_MA) {
        bf16_t* MX = (bf16_t*)(dsc + DO_MXBC);
        const float* cw = P.m_conv_w + (size_t)l * 5 * 512; const float* cb = P.m_conv_b + (size_t)l * 512;
        const int gt = blockIdx.x * 512 + tid, NGT = gridDim.x * 512;
        u32x4 rn[8];
#define MCV_LOAD(IT) do { const int ch_ = ((IT) & 63) * 8, m0_ = ((IT) >> 6) * 4, t0_ = m0_ & (SEQ - 1); \
            _Pragma("unroll") for (int j = 0; j < 8; ++j) { const int tt = t0_ + j - 2; const bool ok = (tt >= 0) && (tt < SEQ); \
                rn[j] = *(const u32x4*)(proj + (size_t)(ok ? m0_ + j - 2 : m0_) * NPROJ + PC_MX + ch_); if (!ok) rn[j] = (u32x4){0u, 0u, 0u, 0u}; } } while (0)
        if (gt < (NTOK / 4) * 64) MCV_LOAD(gt);
        for (int it = gt; it < (NTOK / 4) * 64; it += NGT) {
            const int ch = (it & 63) * 8, m0 = (it >> 6) * 4;
            u32x4 rw[8];
#pragma unroll
            for (int j = 0; j < 8; ++j) rw[j] = rn[j];
            if (it + NGT < (NTOK / 4) * 64) MCV_LOAD(it + NGT);
            f32x4 wa[5], wb[5];
#pragma unroll
            for (int j = 0; j < 5; ++j) { wa[j] = *(const f32x4*)(cw + j * 512 + ch); wb[j] = *(const f32x4*)(cw + j * 512 + ch + 4); }
            const f32x4 ba = *(const f32x4*)(cb + ch), bb = *(const f32x4*)(cb + ch + 4);
#pragma unroll
            for (int k = 0; k < 4; ++k) {
                float a[8] = {ba.x, ba.y, ba.z, ba.w, bb.x, bb.y, bb.z, bb.w};
#pragma unroll
                for (int j = 0; j < 5; ++j) { const u32x4 v = rw[k + j];
                    a[0] += wa[j].x * bflo(v.x); a[1] += wa[j].y * bfhi(v.x); a[2] += wa[j].z * bflo(v.y); a[3] += wa[j].w * bfhi(v.y);
                    a[4] += wb[j].x * bflo(v.z); a[5] += wb[j].y * bfhi(v.z); a[6] += wb[j].z * bflo(v.w); a[7] += wb[j].w * bfhi(v.w); }
                u32x4 o; o.x = pk2(silu_f(a[0]), silu_f(a[1])); o.y = pk2(silu_f(a[2]), silu_f(a[3])); o.z = pk2(silu_f(a[4]), silu_f(a[5])); o.w = pk2(silu_f(a[6]), silu_f(a[7]));
                *(u32x4*)(MX + (size_t)(m0 + k) * 512 + ch) = o;
            }
        }
#undef MCV_LOAD
    }
}

DI void phase_finalize(const Params& P, int l) {
    const int tid = tid_opaque(P.wv), lane = tid & 63, wave = tid >> 6;
    const int gw = blockIdx.x * 8 + wave, NGW = gridDim.x * 8;
    unsigned char* ws = P.ws; unsigned char* dsc = (unsigned char*)P.out;
    bf16_t* MIX = (bf16_t*)(ws + WS_HN);
    {
        const bf16_t* YAT = (const bf16_t*)(dsc + DO_YAT);
        for (int it = gw; it < NB * 32 * 4; it += NGW) {
            const int ct = it & 3, tt = (it >> 2) & 31, b = it >> 7;
            const int c = ct * 64 + lane, t0 = tt * 64;
            const bf16_t* src = YAT + ((size_t)c * NB + b) * SEQ + t0;
            bf16_t* dst = MIX + ((size_t)b * SEQ + t0) * DM + c;
#pragma unroll 2
            for (int t8 = 0; t8 < 64; t8 += 8) {
                u32x4 v = EN_HY ? *(const u32x4*)(src + t8) : (u32x4){0u, 0u, 0u, 0u};
                const unsigned w[4] = {v.x, v.y, v.z, v.w};
#pragma unroll
                for (int i = 0; i < 8; ++i) dst[(size_t)(t8 + i) * DM] = (bf16_t)((i & 1) ? (w[i >> 1] >> 16) : (w[i >> 1] & 0xffffu));
            }
        }
    }
    {
        const bf16_t* MYF = (const bf16_t*)(dsc + DO_MY); const bf16_t* MYB = (const bf16_t*)(ws + WS_MYB); const bf16_t* MX = (const bf16_t*)(dsc + DO_MXBC);
        const bf16_t* OB = (const bf16_t*)(ws + WS_OB); const bf16_t* proj = (const bf16_t*)(ws + WS_PROJ);
        const float* nwm = P.m_norm_w + l * 256; const float* nwh = P.hg_norm_w + l * 64;
        const int gt = blockIdx.x * 512 + tid, NGT = gridDim.x * 512;
        for (int it = gt; it < NTOK * 32; it += NGT) {
            const int ch = (it & 31) * 8, m = it >> 5;
            const u32x4 yf = *(const u32x4*)(MYF + (size_t)m * 256 + ch), yb = *(const u32x4*)(MYB + (size_t)m * 256 + ch), xv = *(const u32x4*)(MX + (size_t)m * 512 + ch), zv = *(const u32x4*)(proj + (size_t)m * NPROJ + PC_MZ + ch);
            const u32x4 of = *(const u32x4*)(MIX + (size_t)m * DM + 768 + ch), ob = *(const u32x4*)(OB + (size_t)m * 256 + ch), gv = *(const u32x4*)(proj + (size_t)m * NPROJ + PC_HG + ch);
            u32x4 o = {0u, 0u, 0u, 0u};
            if (EN_MA) {
                const float Dk = P.m_D[l * 4 + (ch >> 6)];
                const unsigned yfw[4] = {yf.x, yf.y, yf.z, yf.w}, ybw[4] = {yb.x, yb.y, yb.z, yb.w}, xw[4] = {xv.x, xv.y, xv.z, xv.w}, zw[4] = {zv.x, zv.y, zv.z, zv.w};
                float y[8]; float sq = 0.f;
#pragma unroll
                for (int j = 0; j < 4; ++j) { y[2 * j] = (bflo(yfw[j]) + bflo(ybw[j]) + Dk * bflo(xw[j])) * silu_f(bflo(zw[j])); y[2 * j + 1] = (bfhi(yfw[j]) + bfhi(ybw[j]) + Dk * bfhi(xw[j])) * silu_f(bfhi(zw[j]));
                    sq += y[2 * j] * y[2 * j] + y[2 * j + 1] * y[2 * j + 1]; }
                sq = x16_sum(row_sum16(sq));
                const float r = __builtin_amdgcn_rsqf(sq * (1.0f / 256.0f) + EPSN);
                const f32x4 wa = *(const f32x4*)(nwm + ch), wb = *(const f32x4*)(nwm + ch + 4);
                o.x = pk2(y[0] * r * wa.x, y[1] * r * wa.y); o.y = pk2(y[2] * r * wa.z, y[3] * r * wa.w); o.z = pk2(y[4] * r * wb.x, y[5] * r * wb.y); o.w = pk2(y[6] * r * wb.z, y[7] * r * wb.w);
            }
            *(u32x4*)(MIX + (size_t)m * DM + 256 + ch) = o;
            if (EN_HG) {
                const unsigned ofw[4] = {of.x, of.y, of.z, of.w}, obw[4] = {ob.x, ob.y, ob.z, ob.w}, gw4[4] = {gv.x, gv.y, gv.z, gv.w};
                float y[8]; float sq = 0.f;
#pragma unroll
                for (int j = 0; j < 4; ++j) { y[2 * j] = bflo(ofw[j]) + bflo(obw[j]); y[2 * j + 1] = bfhi(ofw[j]) + bfhi(obw[j]); sq += y[2 * j] * y[2 * j] + y[2 * j + 1] * y[2 * j + 1]; }
                sq = grp_sum8(sq);
                const float r = __builtin_amdgcn_rsqf(sq * (1.0f / 64.0f) + EPSN);
                const f32x4 wa = *(const f32x4*)(nwh + (ch & 63)), wb = *(const f32x4*)(nwh + (ch & 63) + 4);
                u32x4 oh;
                oh.x = pk2(y[0] * r * wa.x * silu_f(bflo(gw4[0])), y[1] * r * wa.y * silu_f(bfhi(gw4[0]))); oh.y = pk2(y[2] * r * wa.z * silu_f(bflo(gw4[1])), y[3] * r * wa.w * silu_f(bfhi(gw4[1])));
                oh.z = pk2(y[4] * r * wb.x * silu_f(bflo(gw4[2])), y[5] * r * wb.y * silu_f(bfhi(gw4[2]))); oh.w = pk2(y[6] * r * wb.z * silu_f(bflo(gw4[3])), y[7] * r * wb.w * silu_f(bfhi(gw4[3])));
                *(u32x4*)(MIX + (size_t)m * DM + 768 + ch) = oh;
            }
        }
    }
#if !EN_AT || !EN_HG
    {
        const int gt = blockIdx.x * 512 + tid, NGT = gridDim.x * 512;
        for (int it = gt; it < NTOK * 32; it += NGT) { const int ch = (it & 31) * 8, m = it >> 5;
            if (!EN_AT) *(u32x4*)(MIX + (size_t)m * DM + 512 + ch) = (u32x4){0u, 0u, 0u, 0u};
            if (!EN_HG) *(u32x4*)(MIX + (size_t)m * DM + 768 + ch) = (u32x4){0u, 0u, 0u, 0u}; }
    }
#endif
}

DI void phase_ffnpre(const Params& P, int l, LAS unsigned char* lds) {
    const int tid = tid_opaque(P.wv), lane = tid & 63, wave = tid >> 6, r = lane & 15, q = lane >> 4;
    const int gw = blockIdx.x * 8 + wave, NGW = gridDim.x * 8;
    unsigned char* ws = P.ws;
    LAS u32x4* Wh = (LAS u32x4*)lds;
    LAS u32x4* Wl = Wh + 32 * 64;
    for (int i = tid; i < 32 * 64; i += 512) { const int s = i >> 6, ln = i & 63, e = ln & 15, qq = ln >> 4; float wv[8]; unsigned hi[4], lo[4];
#pragma unroll
        for (int j = 0; j < 8; ++j) { const int k = 32 * s + 8 * qq + j; wv[j] = P.norm_ffn_w[l * DM + k] * P.router_w[((size_t)l * DM + k) * 16 + e]; }
#pragma unroll
        for (int j = 0; j < 4; ++j) { hi[j] = pk2(wv[2 * j], wv[2 * j + 1]); lo[j] = pk2(wv[2 * j] - bflo(hi[j]), wv[2 * j + 1] - bfhi(hi[j])); }
        Wh[i] = (u32x4){hi[0], hi[1], hi[2], hi[3]}; Wl[i] = (u32x4){lo[0], lo[1], lo[2], lo[3]}; }
    __syncthreads();
    const bf16_t* XB = (const bf16_t*)(ws + WS_XB); const float* nw = P.norm_ffn_w + l * DM + 8 * q;
    float* aff = (float*)(ws + WS_AFF); float* rs = (float*)(ws + WS_RS);
    bf16_t* XN = (bf16_t*)(ws + WS_HN);
    for (int grp = gw; grp < NTOK / 16; grp += NGW) {
        const int m0 = grp * 16;
        const bf16_t* xrow = XB + (size_t)(m0 + r) * DM + 8 * q; bf16_t* orow = XN + (size_t)(m0 + r) * DM + 8 * q; unsigned char* orow8 = (unsigned char*)XN + (size_t)(m0 + r) * DM + 8 * q; (void)orow; (void)orow8;
        f32x4 acc = {0.f, 0.f, 0.f, 0.f}; float ss = 0.f;
#pragma unroll 8
        for (int s = 0; s < 32; ++s) {
            const u32x4 xv = *(const u32x4*)(xrow + 32 * s);
            const f32x4 a = {bflo(xv.x), bfhi(xv.x), bflo(xv.y), bfhi(xv.y)}, b = {bflo(xv.z), bfhi(xv.z), bflo(xv.w), bfhi(xv.w)};
            const f32x4 wa = *(const f32x4*)(nw + 32 * s), wb = *(const f32x4*)(nw + 32 * s + 4);
            ss += (a.x * a.x + a.y * a.y) + (a.z * a.z + a.w * a.w) + (b.x * b.x + b.y * b.y) + (b.z * b.z + b.w * b.w);
            const bf16x8 ah = __builtin_bit_cast(bf16x8, xv);
            const bf16x8 wh = __builtin_bit_cast(bf16x8, Wh[s * 64 + lane]), wl = __builtin_bit_cast(bf16x8, Wl[s * 64 + lane]);
            acc = __builtin_amdgcn_mfma_f32_16x16x32_bf16(ah, wh, acc, 0, 0, 0);
            acc = __builtin_amdgcn_mfma_f32_16x16x32_bf16(ah, wl, acc, 0, 0, 0);
#if MOE_F8
            *(u32x2*)(orow8 + 32 * s) = (u32x2){pk4_fp8(a.x * wa.x, a.y * wa.y, a.z * wa.z, a.w * wa.w), pk4_fp8(b.x * wb.x, b.y * wb.y, b.z * wb.z, b.w * wb.w)};
#else
            *(u32x4*)(orow + 32 * s) = (u32x4){pk2(a.x * wa.x, a.y * wa.y), pk2(a.z * wa.z, a.w * wa.w), pk2(b.x * wb.x, b.y * wb.y), pk2(b.z * wb.z, b.w * wb.w)};
#endif
        }
        ss = xhalf_sum(x16_sum(ss));
        const float rinv = __builtin_amdgcn_rsqf(ss * (1.0f / DM) + EPSN);
        if (q == 0) rs[m0 + r] = rinv;
#pragma unroll
        for (int i = 0; i < 4; ++i) {
            const float lg = acc[i] * __shfl(rinv, 4 * q + i);
            const float mx = grp_max16(lg);
            const float ex = expf(lg - mx); const float se = row_sum16(ex);
            const int m = m0 + 4 * q + i;
            aff[((size_t)(m >> 11) * 16 + r) * SEQ + (m & (SEQ - 1))] = ex / se;
        }
    }
}

DI int wave_sum_i(int v) {
#pragma unroll
    for (int o = 1; o < 64; o <<= 1) v += __shfl_xor(v, o);
    return v;
}
DI int half_excl_scan(int c, int lane, int hw, LAS int* ws4, int* tot) {
    int inc = c;
#pragma unroll
    for (int o = 1; o < 64; o <<= 1) { const int t = __shfl_up(inc, o); if (lane >= o) inc += t; }
    if (lane == 63) ws4[hw] = inc;
    __syncthreads();
    int base = 0, total = 0;
#pragma unroll
    for (int w = 0; w < 4; ++w) { const int t = ws4[w]; base += (w < hw) ? t : 0; total += t; }
    *tot = total;
    return base + inc - c;
}
DI void phase_topk(const Params& P, int l, LAS unsigned char* lds) {
    const int tid = tid_opaque(P.wv), lane = tid & 63, wave = tid >> 6;
    unsigned char* ws = P.ws;
    const float* aff = (const float*)(ws + WS_AFF); const float* rs = (const float*)(ws + WS_RS);
    int* slot = (int*)(ws + WS_SLOT); int* seli = (int*)(ws + WS_SELI); float* selg = (float*)(ws + WS_SELG); float* selr = (float*)(ws + WS_SELR);
    const int half = wave >> 2, hw = wave & 3, ht = tid & 255;
    LAS int* wsum = (LAS int*)lds + half * 64;
    for (int u0 = blockIdx.x; u0 < NB * NEXP; u0 += 2 * gridDim.x) {
        const int u = u0 + half * gridDim.x; const bool live = u < NB * NEXP; const int uu = live ? u : u0;
        const int b = uu >> 4, e = uu & 15;
        __syncthreads();
        const u32x4 ka = *(const u32x4*)(aff + (size_t)uu * SEQ + 8 * ht), kb = *(const u32x4*)(aff + (size_t)uu * SEQ + 8 * ht + 4);
        const unsigned kk[8] = {ka.x, ka.y, ka.z, ka.w, kb.x, kb.y, kb.z, kb.w};
        const f32x4 ra = *(const f32x4*)(rs + (size_t)b * SEQ + 8 * ht), rb = *(const f32x4*)(rs + (size_t)b * SEQ + 8 * ht + 4);
        const float rsv[8] = {ra.x, ra.y, ra.z, ra.w, rb.x, rb.y, rb.z, rb.w};
        unsigned prefix = 0u;
#pragma unroll 1
        for (int bit = 30; bit >= 0; bit -= (bit == 30 ? 1 : 2)) {
            const unsigned hi = 1u << bit, lo = (bit == 30) ? 0u : (1u << (bit - 1));
            const unsigned c1 = prefix | hi, c0 = prefix | lo, c3 = prefix | hi | lo;
            int n1 = 0, n0 = 0, n3 = 0;
#pragma unroll
            for (int j = 0; j < 8; ++j) { n1 += __builtin_popcountll(__ballot(kk[j] >= c1)); n0 += __builtin_popcountll(__ballot(kk[j] >= c0)); n3 += __builtin_popcountll(__ballot(kk[j] >= c3)); }
            const int par = (bit & 2) ? 12 : 0;
            if (lane == 0) { wsum[par + hw * 3] = n1; wsum[par + hw * 3 + 1] = n0; wsum[par + hw * 3 + 2] = n3; }
            __syncthreads();
            int t1 = 0, t0 = 0, t3 = 0;
#pragma unroll
            for (int q = 0; q < 4; ++q) { t1 += wsum[par + q * 3]; t0 += wsum[par + q * 3 + 1]; t3 += wsum[par + q * 3 + 2]; }
            if (bit == 30) { if (t1 >= CAP) prefix = c1; }
            else if (t1 >= CAP) prefix = (t3 >= CAP) ? c3 : c1;
            else if (t0 >= CAP) prefix = c0;
        }
        const unsigned thr = prefix;
        int cgt = 0, ceq = 0;
#pragma unroll
        for (int j = 0; j < 8; ++j) { cgt += (kk[j] > thr) ? 1 : 0; ceq += (kk[j] == thr) ? 1 : 0; }
        int ngt; (void)half_excl_scan(cgt, lane, hw, wsum + 32, &ngt);
        const int need = CAP - ngt;
        int neq; int eqr = half_excl_scan(ceq, lane, hw, wsum + 36, &neq);
        bool sel[8]; int cs = 0;
#pragma unroll
        for (int j = 0; j < 8; ++j) { const bool eq = kk[j] == thr; sel[j] = (kk[j] > thr) || (eq && eqr < need); eqr += eq ? 1 : 0; cs += sel[j] ? 1 : 0; }
        int nsel; int sb = half_excl_scan(cs, lane, hw, wsum + 40, &nsel);
        if (live) {
#pragma unroll
            for (int j = 0; j < 8; ++j) { const int i = 8 * ht + j;
                slot[((size_t)b * SEQ + i) * 16 + e] = sel[j] ? sb : -1;
                if (sel[j]) { seli[u * CAP + sb] = i; selg[u * CAP + sb] = __uint_as_float(kk[j]); selr[u * CAP + sb] = rsv[j]; ++sb; } }
        }
    }
    __syncthreads();
    {
        const int gw = blockIdx.x * 8 + wave, NGW = gridDim.x * 8;
        LAS float* scr = (LAS float*)(lds + 4096 + wave * 8448);
        bf16_t* WguT = (bf16_t*)(ws + WS_WGU); bf16_t* WdT = (bf16_t*)(ws + WS_WD);
        constexpr int I_E = 16 * 32 * 16;
        for (int it = gw; it < 3 * I_E; it += NGW) {
            const int which = it / I_E; const int r = it - which * I_E;
            const int e = r / 512, kb = (r % 512) / 32, nb = r % 32;
            const size_t wofs = ((size_t)l * NEXP + e) * DM * DM;
#if MOE_F8
            if (which == 0)      transpose_item_f8(P.moe_wg + wofs, DM, 64 * kb, 32 * nb, (unsigned char*)WguT, e * 2048 + ((32 * nb) >> 7) * 256 + ((32 * nb) & 127), 64.0f, scr, lane);
            else if (which == 1) transpose_item_f8(P.moe_wu + wofs, DM, 64 * kb, 32 * nb, (unsigned char*)WguT, e * 2048 + ((32 * nb) >> 7) * 256 + 128 + ((32 * nb) & 127), 64.0f, scr, lane);
            else                 transpose_item_f8(P.moe_wd + wofs, DM, 64 * kb, 32 * nb, (unsigned char*)WdT, e * 1024 + 32 * nb, 64.0f, scr, lane);
#else
            if (which == 0)      transpose_item(P.moe_wg + wofs, DM, 64 * kb, 32 * nb, WguT, e * 2048 + ((32 * nb) >> 7) * 256 + ((32 * nb) & 127), 1.0f, scr, lane);
            else if (which == 1) transpose_item(P.moe_wu + wofs, DM, 64 * kb, 32 * nb, WguT, e * 2048 + ((32 * nb) >> 7) * 256 + 128 + ((32 * nb) & 127), 1.0f, scr, lane);
            else                 transpose_item(P.moe_wd + wofs, DM, 64 * kb, 32 * nb, WdT, e * 1024 + 32 * nb, 1.0f, scr, lane);
#endif
        }
    }
}

DI bf16x8 mk8(unsigned a, unsigned b, unsigned c, unsigned d) { u32x4 v = {a, b, c, d}; return __builtin_bit_cast(bf16x8, v); }
DI bf16x8 cat44(u32x2 lo, u32x2 hi) { u32x4 v = {lo.x, lo.y, hi.x, hi.y}; return __builtin_bit_cast(bf16x8, v); }
DI u32x4 ldg16(const void* ub, unsigned off) { return *(const u32x4*)((const char*)ub + off); }
DI u32x2 ldg8(const void* ub, unsigned off) { return *(const u32x2*)((const char*)ub + off); }
DI void stg2(void* ub, unsigned off, unsigned short v) { *(unsigned short*)((char*)ub + off) = v; }
DI int crow(int reg, int hh) { return (reg & 3) + 8 * (reg >> 2) + 4 * hh; }
#define PACK_STEP(x, s) mk8(pk2((x)[8 * (s)], (x)[8 * (s) + 1]), pk2((x)[8 * (s) + 2], (x)[8 * (s) + 3]), pk2((x)[8 * (s) + 4], (x)[8 * (s) + 5]), pk2((x)[8 * (s) + 6], (x)[8 * (s) + 7]))

#ifndef TPROBE
#define TPROBE 0
#endif
#ifndef TPWAVE
#define TPWAVE 0
#endif
#define TP_T() ({ asm volatile("" ::: "memory"); unsigned _t = (unsigned)__builtin_amdgcn_s_memrealtime(); asm volatile("" ::: "memory"); _t; })
#define TP_B(k) unsigned _tp##k = 0; if (TPROBE == (k) || ((k) == 1 && TPROBE)) _tp##k = TP_T();
#define TP_E(k) if ((k) == 1 && TPROBE) ttot += TP_T() - _tp##k; else if (TPROBE == (k)) tacc += TP_T() - _tp##k;
#ifndef HYD
#define HYD 4
#endif
DI void hyena_unit(const Params& P, int c, LAS unsigned char* lds) {
    const int tid = tid_opaque(P.wv), lane = tid & 63, w = __builtin_amdgcn_readfirstlane(tid >> 6), r = lane & 31, hh = lane >> 5;
    constexpr int CPS = 8224;
    unsigned char* ws = P.ws; unsigned char* dsc = (unsigned char*)P.out;
    const bf16_t* kf = (const bf16_t*)(ws + WS_KFILT) + (size_t)c * 4096;
    unsigned tacc = 0, ttot = 0;
    TP_B(1)
    __syncthreads();
    TP_B(81)
    {
        const u32x4 a = *(const u32x4*)(kf + 8 * tid), b = (tid < 511) ? *(const u32x4*)(kf + 8 * tid + 8) : (u32x4){0u, 0u, 0u, 0u};
        const unsigned d[9] = {a.x, a.y, a.z, a.w, b.x, b.y, b.z, b.w, 0u};
#pragma unroll
        for (int p = 0; p < 8; ++p) { const int m = p >> 1; u32x4 o;
            if (p & 1) { o.x = __builtin_amdgcn_alignbit(d[m + 1], d[m], 16); o.y = __builtin_amdgcn_alignbit(d[m + 2], d[m + 1], 16); o.z = __builtin_amdgcn_alignbit(d[m + 3], d[m + 2], 16); o.w = __builtin_amdgcn_alignbit(d[m + 4], d[m + 3], 16); }
            else { o.x = d[m]; o.y = d[m + 1]; o.z = d[m + 2]; o.w = d[m + 3]; }
            *(LAS u32x4*)(lds + p * CPS + tid * 16) = o; }
    }
    __syncthreads();
    TP_E(81)
    const bf16_t* hw = (const bf16_t*)(dsc + DO_HW) + ((size_t)c * NB + r) * SEQ + 8 * hh;
    f32x16 acc[8];
#pragma unroll
    for (int i = 0; i < 8; ++i)
#pragma unroll
        for (int q = 0; q < 16; ++q) acc[i][q] = 0.f;
    const int p = 7 - (r & 7);
    const LAS unsigned char* abase = lds + p * CPS + (2047 - 256 * w - r + 8 * hh - p) * 2;
    LAS unsigned char* Bt = lds + 8 * CPS;
    const bf16_t* hws = (const bf16_t*)(dsc + DO_HW) + ((size_t)c * NB + (tid >> 4)) * SEQ + 4 * (tid & 15);
    const unsigned bwo = (unsigned)((tid >> 4) * 144 + (tid & 15) * 8), bro = (unsigned)(r * 144 + 16 * hh);
    TP_B(82)
    u32x2 bpre[HYD];
#pragma unroll
    for (int d = 0; d < HYD; ++d) bpre[d] = *(const u32x2*)(hws + 64 * d);
    *(LAS u32x2*)(Bt + bwo) = bpre[0];
    __syncthreads();
#pragma unroll 1
    for (int s8 = 0; s8 < SEQ; s8 += 64 * HYD) {
#pragma unroll
        for (int d = 0; d < HYD; ++d) { const int sb = s8 + 64 * d;
            if (sb + 64 < SEQ) *(LAS u32x2*)(Bt + ((d + 1) & 1) * 4608 + bwo) = bpre[(d + 1) % HYD];
            if (sb + 64 * HYD < SEQ) bpre[d] = *(const u32x2*)(hws + sb + 64 * HYD);
#pragma unroll
            for (int j = 0; j < 4; ++j) { const int s0 = sb + 16 * j; const bf16x8 bfr = *(const LAS bf16x8*)(Bt + (d & 1) * 4608 + bro + 32 * j);
#pragma unroll
                for (int i = 0; i < 8; ++i) { const bf16x8 afr = *(const LAS bf16x8*)(abase + (s0 - 32 * i) * 2); acc[i] = MFMA32(afr, bfr, acc[i]); }
                __builtin_amdgcn_sched_barrier(0); }
            __syncthreads(); }
    }
    TP_E(82)
    TP_B(83)
    const bf16_t* hx = (const bf16_t*)(dsc + DO_HX0) + ((size_t)c * NB + r) * SEQ;
    bf16_t* ya = (bf16_t*)(dsc + DO_YAT) + ((size_t)c * NB + r) * SEQ;
#pragma unroll
    for (int i = 0; i < 8; ++i)
#pragma unroll
        for (int g = 0; g < 4; ++g) { const int t = 256 * w + 32 * i + 8 * g + 4 * hh;
            const u32x2 xv = *(const u32x2*)(hx + t);
            u32x2 o; o.x = pk2(acc[i][4 * g] * bflo(xv.x), acc[i][4 * g + 1] * bfhi(xv.x)); o.y = pk2(acc[i][4 * g + 2] * bflo(xv.y), acc[i][4 * g + 3] * bfhi(xv.y));
            *(u32x2*)(ya + t) = o; }
    TP_E(83)
    TP_E(1)
    if (TPROBE >= 80 && TPROBE < 90 && lane == 0 && w == (TPWAVE)) { atomicAdd((unsigned*)(ws + WS_CTL) + 512, tacc); atomicAdd((unsigned*)(ws + WS_CTL) + 513, ttot); }
}

DI int t5_bucket(int rel) {
    const int ret = rel > 0 ? 16 : 0; const int n = rel < 0 ? -rel : rel;
    if (n < 8) return ret + n;
    const float nf = (float)n;
    int large = 8 + (int)(logf(nf / 8.0f) / 4.852030263919617f * 8.0f);
    large = large < 15 ? large : 15;
    return ret + large;
}
#ifndef ATT_FAST
#define ATT_FAST 0
#endif
struct AttPass { int d, rho, uq0, nq; };
DI AttPass att_pass(int pp, int Q0, int w) {
    AttPass a;
    if (pp == 0) { a.d = 1; a.rho = 0; a.uq0 = Q0 + 32 * w; a.nq = 32; }
    else if (pp == 1) { a.d = 4; a.rho = w & 3; a.uq0 = (Q0 >> 2) + 32 * (w >> 2); a.nq = 32; }
    else { a.d = 16; a.rho = 2 * w + (pp - 2); a.uq0 = Q0 >> 4; a.nq = 16; }
    return a;
}
DI void attn_unit(const Params& P, int u, LAS unsigned char* lds, int& bias_h) {
    unsigned tacc = 0, ttot = 0;
    const int qb = u & 7, h = (u >> 3) & 3, b = u >> 5;
    const int tid = tid_opaque(P.wv), lane = tid & 63, w = __builtin_amdgcn_readfirstlane(tid >> 6), c = lane & 31, hh = lane >> 5;
    LAS float* Ost = (LAS float*)lds;
    LAS float* Mst = (LAS float*)(lds + 69632);
    LAS float* Lst = Mst + 256;
    LAS float* biasT = (LAS float*)(lds + 69632 + 2048);
    LAS unsigned char* Vr = lds + 69632 + 2048 + 12800 + w * 6144;
    unsigned char* ws = P.ws;
    TP_B(1)
    { TP_B(3) __syncthreads(); TP_E(3) }
    if (bias_h != h) {
        const float* relb = P.rel_bias; asm volatile("" : "+s"(relb));
        for (int i = tid; i < 4 * 768; i += 512) { const int s = i / 768, jx = i - 768 * s; const int pat = jx >> 8, rel = (jx & 255) - 128, dd = pat == 0 ? 1 : (pat == 1 ? 4 : 16);
            biasT[s * 784 + jx + s] = (rel >= -64 && rel <= 64) ? relb[t5_bucket(rel * dd) * 4 + h] * 1.4426950408889634f : -INFINITY; }
        __syncthreads();
        bias_h = h;
    }
    const bf16_t* pb = (const bf16_t*)(ws + WS_PROJ) + (size_t)b * SEQ * NPROJ;
    bf16_t* MIX = (bf16_t*)(ws + WS_HN);
    const int Q0 = qb * 256;
    const int i16 = lane & 15, trq = i16 >> 2, trp = i16 & 3;
    const unsigned troff = (unsigned)((4 * hh + trq) * 192 + (16 * ((lane >> 4) & 1) + 4 * trp) * 2);
    const int r8 = lane >> 3, j8 = lane & 7;
#define ATT_LOAD(KF, VR, KT, AP) do { const int nsub_ = SEQ / (AP).d, tlo_ = (AP).uq0 - 64 + 32 * (KT); \
        if (ATT_FAST && tlo_ >= 0 && tlo_ + 31 < nsub_) {                   \
            const unsigned lo_ = (unsigned)(r8 * (AP).d * NPROJ + 8 * j8) * 2u; \
            _Pragma("unroll") for (int i = 0; i < 4; ++i) { const bf16_t* b_ = pb + (size_t)(((tlo_ + 8 * i) * (AP).d + (AP).rho) * NPROJ + h * 64); \
                KF[i] = __builtin_bit_cast(bf16x8, ldg16(b_ + PC_AK, lo_)); VR[i] = ldg16(b_ + PC_AV, lo_); } \
        } else { \
            _Pragma("unroll") for (int i = 0; i < 4; ++i) { const int ukr_ = tlo_ + 8 * i + r8; const int ukc_ = ukr_ < 0 ? 0 : (ukr_ >= nsub_ ? nsub_ - 1 : ukr_); \
                const unsigned ko_ = (unsigned)((ukc_ * (AP).d + (AP).rho) * NPROJ + h * 64 + 8 * j8) * 2u; \
                KF[i] = __builtin_bit_cast(bf16x8, ldg16(pb + PC_AK, ko_)); VR[i] = ldg16(pb + PC_AV, ko_); } } } while (0)
#define ATT_TILE(KF, VR, KT, NEXTLOAD) do { const int kt = (KT); \
        bf16x8 kq_[4]; \
        f32x16 st;                                                          \
        _Pragma("unroll") for (int g = 0; g < 4; ++g) { const f32x4 bv_ = *(const LAS f32x4*)(tb4 + 32 * kt + 8 * g); st[4 * g] = bv_.x; st[4 * g + 1] = bv_.y; st[4 * g + 2] = bv_.z; st[4 * g + 3] = bv_.w; } \
        _Pragma("unroll") for (int i = 0; i < 4; ++i) *(LAS bf16x8*)(Vr + (8 * i + r8) * 144 + 16 * j8) = KF[i]; \
        _Pragma("unroll") for (int ks = 0; ks < 4; ++ks) kq_[ks] = *(const LAS bf16x8*)(Vr + c * 144 + 32 * ks + 16 * hh); \
        _Pragma("unroll") for (int i = 0; i < 4; ++i) *(LAS u32x4*)(Vr + (8 * i + r8) * 192 + 16 * j8) = VR[i]; \
        _Pragma("unroll") for (int ks = 0; ks < 4; ++ks) st = MFMA32(kq_[ks], qf[ks], st); \
        NEXTLOAD; \
        float tmax = -INFINITY; float lg[16]; \
        { const int tlo = uk0 + 32 * kt; \
          if (tlo >= 0 && tlo + 31 < nsub) { \
            _Pragma("unroll") for (int q = 0; q < 16; ++q) { lg[q] = st[q]; tmax = fmaxf(tmax, lg[q]); } \
          } else { \
            _Pragma("unroll") for (int q = 0; q < 16; ++q) { const int uk = tlo + crow(q, hh); lg[q] = (uk >= 0 && uk < nsub) ? st[q] : -INFINITY; tmax = fmaxf(tmax, lg[q]); } \
          } } \
        tmax = xhalf_max(tmax); \
        if (__any(tmax > mrun + 8.0f)) { const float mnew = fmaxf(mrun, tmax), alpha = __builtin_amdgcn_exp2f(mrun - mnew); lrun *= alpha; mrun = mnew; \
            _Pragma("unroll") for (int dt = 0; dt < 2; ++dt) _Pragma("unroll") for (int q = 0; q < 16; ++q) OT[dt][q] *= alpha; } \
        float psum = 0.f; \
        _Pragma("unroll") for (int q = 0; q < 16; ++q) { lg[q] = __builtin_amdgcn_exp2f(lg[q] - mrun); psum += lg[q]; } \
        lrun += xhalf_sum(psum); \
        LDS_WAIT(); \
        _Pragma("unroll") for (int s = 0; s < 2; ++s) { const bf16x8 pf = PACK_STEP(lg, s); \
            _Pragma("unroll") for (int dt = 0; dt < 2; ++dt) { \
                const s16x4 lo = __builtin_amdgcn_ds_read_tr16_b64_v4i16((LAS s16x4*)(Vr + troff + (16 * s) * 192 + 64 * dt)); \
                const s16x4 hi = __builtin_amdgcn_ds_read_tr16_b64_v4i16((LAS s16x4*)(Vr + troff + (16 * s + 8) * 192 + 64 * dt)); \
                OT[dt] = MFMA32(__builtin_shufflevector(lo, hi, 0, 1, 2, 3, 4, 5, 6, 7), pf, OT[dt]); } } \
        LDS_WAIT(); } while (0)
    bf16x8 kfA[4], kfB[4]; u32x4 vrA[4], vrB[4];
    bf16x8 qnext[4];
    { const AttPass a0 = att_pass(0, Q0, w);
      ATT_LOAD(kfA, vrA, 0, a0); ATT_LOAD(kfB, vrB, 1, a0);
      const int qpos0 = a0.uq0 + c;
#pragma unroll
      for (int ks = 0; ks < 4; ++ks) qnext[ks] = *(const bf16x8*)(pb + (size_t)qpos0 * NPROJ + PC_AQ + h * 64 + 16 * ks + 8 * hh); }
    auto pass = [&](const int pp, bf16x8 (&kf0)[4], u32x4 (&vr0)[4], bf16x8 (&kf1)[4], u32x4 (&vr1)[4]) __attribute__((always_inline)) {
        const int pat = pp < 2 ? pp : 2;
        const AttPass ap = att_pass(pp, Q0, w), an = att_pass(pp < 3 ? pp + 1 : 3, Q0, w);
        const int d = ap.d, rho = ap.rho, uq0 = ap.uq0, nq = ap.nq;
        const int uk0 = uq0 - 64, nsub = SEQ / d;
        const int cq = (c < nq) ? c : c - nq;
        const int qpos = (uq0 + cq) * d + rho, ql = qpos - Q0;
        const LAS float* tb4 = biasT + (cq & 3) * 784 + pat * 256 + (64 - cq + 4 * hh + (cq & 3));
        bf16x8 qf[4];
#pragma unroll
        for (int ks = 0; ks < 4; ++ks) qf[ks] = qnext[ks];
        if (pp < 3) {
            const int cq2 = (c < an.nq) ? c : c - an.nq; const int qpos2 = (an.uq0 + cq2) * an.d + an.rho;
#pragma unroll
            for (int ks = 0; ks < 4; ++ks) qnext[ks] = *(const bf16x8*)(pb + (size_t)qpos2 * NPROJ + PC_AQ + h * 64 + 16 * ks + 8 * hh); }
        float mrun = -1.0e30f, lrun = 0.f; f32x16 OT[2];
#pragma unroll
        for (int dt = 0; dt < 2; ++dt)
#pragma unroll
            for (int q = 0; q < 16; ++q) OT[dt][q] = 0.f;
        if (pat != 0) { mrun = Mst[ql]; lrun = Lst[ql];
#pragma unroll
            for (int dt = 0; dt < 2; ++dt)
#pragma unroll
                for (int g = 0; g < 4; ++g) { const f32x4 v = *(const LAS f32x4*)(Ost + ql * 68 + 32 * dt + 8 * g + 4 * hh);
                    OT[dt][4 * g] = v.x; OT[dt][4 * g + 1] = v.y; OT[dt][4 * g + 2] = v.z; OT[dt][4 * g + 3] = v.w; } }
        { TP_B(2)
        ATT_TILE(kf0, vr0, 0, ATT_LOAD(kf0, vr0, 2, ap)); ATT_TILE(kf1, vr1, 1, ATT_LOAD(kf1, vr1, 3, ap)); ATT_TILE(kf0, vr0, 2, ATT_LOAD(kf0, vr0, 4, ap));
        ATT_TILE(kf1, vr1, 3, if (pp < 3) { AttPass an_ = an; asm volatile("" : "+s"(an_.d), "+s"(an_.rho), "+s"(an_.uq0)); ATT_LOAD(kf1, vr1, 0, an_); });
        ATT_TILE(kf0, vr0, 4, if (pp < 3) { AttPass an_ = an; asm volatile("" : "+s"(an_.d), "+s"(an_.rho), "+s"(an_.uq0)); ATT_LOAD(kf0, vr0, 1, an_); });
        TP_E(2) }
        if (pat != 2) {
            if (hh == 0) { Mst[ql] = mrun; Lst[ql] = lrun; }
#pragma unroll
            for (int dt = 0; dt < 2; ++dt)
#pragma unroll
                for (int g = 0; g < 4; ++g) *(LAS f32x4*)(Ost + ql * 68 + 32 * dt + 8 * g + 4 * hh) = (f32x4){OT[dt][4 * g], OT[dt][4 * g + 1], OT[dt][4 * g + 2], OT[dt][4 * g + 3]};
        } else if (c < 16) {
            const float inv = __builtin_amdgcn_rcpf(lrun);
            bf16_t* orow = MIX + ((size_t)b * SEQ + qpos) * DM + 512 + h * 64;
#pragma unroll
            for (int dt = 0; dt < 2; ++dt)
#pragma unroll
                for (int g = 0; g < 4; ++g) { u32x2 o; o.x = pk2(OT[dt][4 * g] * inv, OT[dt][4 * g + 1] * inv); o.y = pk2(OT[dt][4 * g + 2] * inv, OT[dt][4 * g + 3] * inv);
                    *(u32x2*)(orow + 32 * dt + 8 * g + 4 * hh) = o; }
        }
        { TP_B(3) if (pp < 2) __syncthreads(); TP_E(3) }
    };
#pragma unroll 1
    for (int p2 = 0; p2 < 2; ++p2) { pass(2 * p2, kfA, vrA, kfB, vrB); pass(2 * p2 + 1, kfB, vrB, kfA, vrA); }
#undef ATT_LOAD
#undef ATT_TILE
    TP_E(1)
    if (TPROBE && TPROBE < 10 && (tid & 63) == 0 && w == (TPWAVE)) { atomicAdd((unsigned*)(ws + WS_CTL) + 512, tacc); atomicAdd((unsigned*)(ws + WS_CTL) + 513, ttot); }
}

DI float softplus_f(float x) { return x > 15.f ? x : __logf(1.0f + __expf(x)); }
DI unsigned short hsel(const u32x4& v, int c) { const unsigned w = (c >> 1) == 0 ? v.x : ((c >> 1) == 1 ? v.y : ((c >> 1) == 2 ? v.z : v.w)); return (unsigned short)((c & 1) ? (w >> 16) : (w & 0xffffu)); }
DI void mamba_unit(const Params& P, int l, int u, LAS unsigned char* lds) {
    const int dir = u & 1, h = (u >> 1) & 3, b = u >> 3, g = h >> 1;
    const int tid = tid_opaque(P.wv), lane_f = tid & 63, w = __builtin_amdgcn_readfirstlane(tid >> 6);
    LAS unsigned char* wl = lds + w * 15616;
    LAS unsigned short* xdT = (LAS unsigned short*)wl;
    LAS unsigned short* xwT = xdT + 64 * 40;
    LAS unsigned short* BT = xwT + 64 * 40;
    LAS float* dtv = (LAS float*)(wl + 15360);
    LAS float* acum = dtv + 32;
    LAS float* Atot = (LAS float*)(lds + 8 * 15616);
    unsigned char* ws = P.ws; unsigned char* dsc = (unsigned char*)P.out;
    const bf16_t* xbc = (const bf16_t*)(dsc + DO_MXBC) + (size_t)b * SEQ * 512;
    const float* dtr = (const float*)(ws + WS_DT) + (size_t)b * SEQ * 8 + dir * 4 + h;
    bf16_t* MYD = (bf16_t*)(dir ? (ws + WS_MYB) : (dsc + DO_MY)) + (size_t)b * SEQ * 256 + h * 64;
    float* stsc = (float*)(dsc + DO_MST) + (size_t)u * (8 * 4096);
    const float dtb = P.m_dt_bias[l * 8 + dir * 4 + h], Aneg = -expf(P.m_A_log[l * 8 + dir * 4 + h]);
    __syncthreads();
#define MTK(c0, j) (dir ? (c0) + 31 - (j) : (c0) + (j))
#define MCH(ci) (256 * w + 32 * (dir ? 7 - (ci) : (ci)))
#pragma unroll 1
    for (int pass = 0; pass < 2; ++pass) {
        int lane_p = lane_f; asm volatile("" : "+v"(lane_p));
        const int lane = lane_p, c32 = lane_p & 31, hh = lane_p >> 5, tg = lane_p >> 3, cg = lane_p & 7;
        f32x16 ST[2][2];
#pragma unroll
        for (int a = 0; a < 2; ++a)
#pragma unroll
            for (int q = 0; q < 2; ++q)
#pragma unroll
                for (int i = 0; i < 16; ++i) ST[a][q][i] = 0.f;
        if (pass == 1) {
            const int nv = dir ? 7 - w : w;
            for (int k = 0; k < nv; ++k) { const int v = dir ? 7 - k : k; const float dec = Atot[v];
                const f32x4* sp = (const f32x4*)(stsc + (size_t)v * 4096 + lane * 64);
#pragma unroll
                for (int a = 0; a < 2; ++a)
#pragma unroll
                    for (int q = 0; q < 2; ++q)
#pragma unroll
                        for (int i4 = 0; i4 < 4; ++i4) { const f32x4 t = sp[(a * 2 + q) * 4 + i4];
                            ST[a][q][4 * i4] = ST[a][q][4 * i4] * dec + t.x; ST[a][q][4 * i4 + 1] = ST[a][q][4 * i4 + 1] * dec + t.y; ST[a][q][4 * i4 + 2] = ST[a][q][4 * i4 + 2] * dec + t.z; ST[a][q][4 * i4 + 3] = ST[a][q][4 * i4 + 3] * dec + t.w; } }
        }
        float atot = 0.f;
        u32x4 rx[4], rB[4]; float rdt;
        { const int c0 = MCH(0);
#pragma unroll
          for (int i = 0; i < 4; ++i) { const unsigned ro = (unsigned)(MTK(c0, 4 * tg + i) * 512 + 8 * cg) * 2u; rx[i] = ldg16(xbc + h * 64, ro); rB[i] = ldg16(xbc + 256 + g * 64, ro); }
          rdt = *(const float*)((const char*)dtr + (unsigned)(MTK(c0, c32) * 32)); }
#pragma unroll 1
        for (int ci = 0; ci < 8; ++ci) {
            int lane_i = lane; asm volatile("" : "+v"(lane_i));
            const int c32 = lane_i & 31, hh = lane_i >> 5, tg = lane_i >> 3, cg = lane_i & 7;
            const int c0 = MCH(ci);
            {
                const float dt = softplus_f(rdt + dtb);
                float ac = dt * Aneg;
#pragma unroll
                for (int o = 1; o < 32; o <<= 1) { const float t = __shfl_up(ac, o, 32); if (c32 >= o) ac += t; }
                if (lane < 32) { dtv[c32] = dt; acum[c32] = ac; }
            }
            LDS_WAIT();
            const float aend = acum[31];
            {
                const f32x4 d4 = *(const LAS f32x4*)(dtv + 4 * tg), a4 = *(const LAS f32x4*)(acum + 4 * tg);
                const float dj[4] = {d4.x, d4.y, d4.z, d4.w};
                const float wj[4] = {__expf(aend - a4.x), __expf(aend - a4.y), __expf(aend - a4.z), __expf(aend - a4.w)};
#pragma unroll
                for (int c = 0; c < 8; ++c) {
                    float xd[4]; unsigned short bb[4];
#pragma unroll
                    for (int i = 0; i < 4; ++i) { xd[i] = bf2f(hsel(rx[i], c)) * dj[i]; bb[i] = hsel(rB[i], c); }
                    *(LAS u32x2*)(xdT + (8 * cg + c) * 40 + 4 * tg) = (u32x2){pk2(xd[0], xd[1]), pk2(xd[2], xd[3])};
                    *(LAS u32x2*)(xwT + (8 * cg + c) * 40 + 4 * tg) = (u32x2){pk2(xd[0] * wj[0], xd[1] * wj[1]), pk2(xd[2] * wj[2], xd[3] * wj[3])};
                    *(LAS u32x2*)(BT + (8 * cg + c) * 40 + 4 * tg) = (u32x2){(unsigned)bb[0] | ((unsigned)bb[1] << 16), (unsigned)bb[2] | ((unsigned)bb[3] << 16)};
                }
            }
            if (ci < 7) { const int c1 = MCH(ci + 1);
#pragma unroll
                for (int i = 0; i < 4; ++i) { const unsigned ro = (unsigned)(MTK(c1, 4 * tg + i) * 512 + 8 * cg) * 2u; rx[i] = ldg16(xbc + h * 64, ro); rB[i] = ldg16(xbc + 256 + g * 64, ro); }
                rdt = *(const float*)((const char*)dtr + (unsigned)(MTK(c1, c32) * 32)); }
            LDS_WAIT();
            if (pass == 1) {
                const unsigned bro = (unsigned)(MTK(c0, c32) * 512 + 8 * hh) * 2u;
                f32x16 GT;
#pragma unroll
                for (int i = 0; i < 16; ++i) GT[i] = 0.f;
#pragma unroll
                for (int ks = 0; ks < 4; ++ks) GT = MFMA32(__builtin_bit_cast(bf16x8, ldg16(xbc + 256 + g * 64 + 16 * ks, bro)), __builtin_bit_cast(bf16x8, ldg16(xbc + 384 + g * 64 + 16 * ks, bro)), GT);
                const float acl = acum[c32];
#pragma unroll
                for (int i = 0; i < 16; ++i) { const int s = crow(i, hh); GT[i] = (s <= c32) ? GT[i] * __expf(acl - acum[s]) : 0.f; }
                f32x16 Y[2];
#pragma unroll
                for (int pt = 0; pt < 2; ++pt)
#pragma unroll
                    for (int i = 0; i < 16; ++i) Y[pt][i] = 0.f;
#pragma unroll
                for (int s = 0; s < 2; ++s) { const bf16x8 pa = PACK_STEP(GT, s);
#pragma unroll
                    for (int pt = 0; pt < 2; ++pt) { const LAS unsigned short* xr = xdT + (32 * pt + c32) * 40 + 16 * s + 4 * hh;
                        Y[pt] = MFMA32(pa, cat44(*(const LAS u32x2*)xr, *(const LAS u32x2*)(xr + 8)), Y[pt]); } }
                const unsigned cro = (unsigned)(MTK(c0, c32) * 512 + 4 * hh) * 2u;
                const float el = __expf(acl);
#pragma unroll
                for (int nt = 0; nt < 2; ++nt)
#pragma unroll
                    for (int s = 0; s < 2; ++s) { const u32x2 clo = ldg8(xbc + 384 + g * 64 + 32 * nt + 16 * s, cro), chi = ldg8(xbc + 384 + g * 64 + 32 * nt + 16 * s + 8, cro);
                        const bf16x8 ca = mk8(pk2(bflo(clo.x) * el, bfhi(clo.x) * el), pk2(bflo(clo.y) * el, bfhi(clo.y) * el), pk2(bflo(chi.x) * el, bfhi(chi.x) * el), pk2(bflo(chi.y) * el, bfhi(chi.y) * el));
#pragma unroll
                        for (int pt = 0; pt < 2; ++pt) Y[pt] = MFMA32(ca, PACK_STEP(ST[nt][pt], s), Y[pt]); }
#pragma unroll
                for (int i = 0; i < 16; ++i) { const unsigned oo = (unsigned)(MTK(c0, crow(i, hh)) * 256 + c32) * 2u; stg2(MYD, oo, f2bf(Y[0][i])); stg2(MYD + 32, oo, f2bf(Y[1][i])); }
            }
            {
                const float de = __expf(aend);
#pragma unroll
                for (int nt = 0; nt < 2; ++nt)
#pragma unroll
                    for (int pt = 0; pt < 2; ++pt)
#pragma unroll
                        for (int i = 0; i < 16; ++i) ST[nt][pt][i] *= de;
#pragma unroll
                for (int s = 0; s < 2; ++s)
#pragma unroll
                    for (int nt = 0; nt < 2; ++nt) { const bf16x8 ba = *(const LAS bf16x8*)(BT + (32 * nt + c32) * 40 + 16 * s + 8 * hh);
#pragma unroll
                        for (int pt = 0; pt < 2; ++pt) ST[nt][pt] = MFMA32(ba, *(const LAS bf16x8*)(xwT + (32 * pt + c32) * 40 + 16 * s + 8 * hh), ST[nt][pt]); }
            }
            atot += aend;
            LDS_WAIT();
        }
        if (pass == 0) {
            f32x4* sp = (f32x4*)(stsc + (size_t)w * 4096 + lane * 64);
#pragma unroll
            for (int a = 0; a < 2; ++a)
#pragma unroll
                for (int q = 0; q < 2; ++q)
#pragma unroll
                    for (int i4 = 0; i4 < 4; ++i4) sp[(a * 2 + q) * 4 + i4] = (f32x4){ST[a][q][4 * i4], ST[a][q][4 * i4 + 1], ST[a][q][4 * i4 + 2], ST[a][q][4 * i4 + 3]};
            if (lane == 0) Atot[w] = __expf(atot);
            VM_WAIT(); __syncthreads();
        }
    }
#undef MTK
#undef MCH
    __syncthreads();
}

DI void hgrn_unit(const Params& P, int l, int u, LAS unsigned char* lds) {
    const int dir = u & 1, h = (u >> 1) & 3, b = u >> 3;
    const int tid = tid_opaque(P.wv), lane_f = tid & 63, w = __builtin_amdgcn_readfirstlane(tid >> 6);
    LAS unsigned char* wl = lds + w * 15104;
    LAS unsigned short* qd = (LAS unsigned short*)wl;
    LAS unsigned short* kd = qd + 32 * 72;
    LAS unsigned short* vT = kd + 32 * 72;
    LAS float* eref = (LAS float*)(wl + 14336);
    LAS float* eglr = eref + 64;
    LAS float* egl = eglr + 64;
    LAS float* lbt = (LAS float*)(lds + 8 * 15104 + 2048 + w * 512);
    LAS float* gsum = lbt + 64;
    LAS float* Atot = (LAS float*)(lds + 8 * 15104);
    unsigned char* ws = P.ws; unsigned char* dsc = (unsigned char*)P.out;
    const bf16_t* proj = (const bf16_t*)(ws + WS_PROJ) + (size_t)b * SEQ * NPROJ;
    bf16_t* OD = (dir ? (bf16_t*)(ws + WS_OB) + (size_t)b * SEQ * 256 + h * 64 : (bf16_t*)(ws + WS_HN) + (size_t)b * SEQ * DM + 768 + h * 64);
    const int ostride = dir ? 256 : DM;
    float* stsc = (float*)(dsc + DO_HST) + (size_t)u * (8 * 4096);
    __syncthreads();
    { float lb = 0.f;
      if (l == 1) { const float h0 = P.hg_lb[(0 * 2 + dir) * 256 + h * 64 + lane_f], h1 = P.hg_lb[(1 * 2 + dir) * 256 + h * 64 + lane_f]; lb = 1.0f / (1.0f + expf(h0 - h1)); }
      lbt[lane_f] = lb; }
    LDS_WAIT();
#define HTK(c0, j) (dir ? (c0) + 31 - (j) : (c0) + (j))
#define HCH(ci) (256 * w + 32 * (dir ? 7 - (ci) : (ci)))
#pragma unroll 1
    for (int pass = 0; pass < 2; ++pass) {
        int lane_p = lane_f; asm volatile("" : "+v"(lane_p));
        const int lane = lane_p, c32 = lane_p & 31, hh = lane_p >> 5, tg = lane_p >> 3, cg = lane_p & 7;
        f32x16 S[2][2];
#pragma unroll
        for (int a = 0; a < 2; ++a)
#pragma unroll
            for (int q = 0; q < 2; ++q)
#pragma unroll
                for (int i = 0; i < 16; ++i) S[a][q][i] = 0.f;
        if (pass == 1) {
            const int nv = dir ? 7 - w : w;
            for (int k = 0; k < nv; ++k) { const int v = dir ? 7 - k : k; const LAS float* at = Atot + v * 64;
                const f32x4* sp = (const f32x4*)(stsc + (size_t)v * 4096 + lane * 64);
#pragma unroll
                for (int a = 0; a < 2; ++a)
#pragma unroll
                    for (int i4 = 0; i4 < 4; ++i4) { const f32x4 dec = *(const LAS f32x4*)(at + 32 * a + 8 * i4 + 4 * hh);
#pragma unroll
                        for (int q = 0; q < 2; ++q) { const f32x4 t = sp[(a * 2 + q) * 4 + i4];
                            S[a][q][4 * i4] = S[a][q][4 * i4] * dec.x + t.x; S[a][q][4 * i4 + 1] = S[a][q][4 * i4 + 1] * dec.y + t.y; S[a][q][4 * i4 + 2] = S[a][q][4 * i4 + 2] * dec.z + t.z; S[a][q][4 * i4 + 3] = S[a][q][4 * i4 + 3] * dec.w + t.w; } } }
        }
        gsum[lane] = 1.0f;
        u32x4 rf[4], rq[4];
        { const int c0 = HCH(0);
#pragma unroll
          for (int i = 0; i < 4; ++i) { const unsigned ro = (unsigned)(HTK(c0, 4 * tg + i) * NPROJ + 8 * cg) * 2u;
              rf[i] = ldg16(proj + PC_HF + dir * 256 + h * 64, ro); rq[i] = (pass == 1) ? ldg16(proj + PC_HQ + h * 64, ro) : (u32x4){0u, 0u, 0u, 0u}; } }
#pragma unroll 1
        for (int ci = 0; ci < 8; ++ci) {
            int lane_i = lane; asm volatile("" : "+v"(lane_i));
            const int c32 = lane_i & 31, hh = lane_i >> 5, tg = lane_i >> 3, cg = lane_i & 7;
            const int c0 = HCH(ci);
            {
                float qprev[4], kprev[4];
                u32x4 rv[4];
#pragma unroll
                for (int i = 0; i < 4; ++i) { const unsigned ro = (unsigned)(HTK(c0, 4 * tg + i) * NPROJ + 8 * cg) * 2u; rv[i] = ldg16(proj + PC_HI + h * 64, ro); }
                const f32x4 lb0 = *(const LAS f32x4*)(lbt + 8 * cg), lb1 = *(const LAS f32x4*)(lbt + 8 * cg + 4);
                const float lbv[8] = {lb0.x, lb0.y, lb0.z, lb0.w, lb1.x, lb1.y, lb1.z, lb1.w};
#pragma unroll
                for (int c = 0; c < 8; ++c) {
                    const float lb = lbv[c], oml = 1.0f - lb;
                    float en[4], cD[4], cN[4];
#pragma unroll
                    for (int i = 0; i < 4; ++i) { const float fpre = bf2f(hsel(rf[i], c)); const float e_ = fminf(__expf(-fpre), 1.0e9f); en[i] = e_;
                        const float dd = 1.0f + e_, nn = 1.0f + lb * e_; cD[i] = (i == 0) ? dd : cD[i - 1] * dd; cN[i] = (i == 0) ? nn : cN[i - 1] * nn; }
                    float iD[4], iN[4]; iD[3] = __builtin_amdgcn_rcpf(cD[3]); iN[3] = __builtin_amdgcn_rcpf(cN[3]);
#pragma unroll
                    for (int i = 3; i > 0; --i) { iD[i - 1] = iD[i] * (1.0f + en[i]); iN[i - 1] = iN[i] * (1.0f + lb * en[i]); }
                    const float own = cN[3] * iD[3];
                    float lsh = dpp_f<0x118>(own); asm volatile("" : "+v"(lsh));
                    const float lowv = (tg & 1) ? lsh : 1.0f;
                    const float rup = own * lowv;
                    float rro = dpp_f<0x128>(rup); asm volatile("" : "+v"(rro));
                    const float T = (tg & 1) ? rup : rro;
                    const auto s16 = __builtin_amdgcn_permlane16_swap(__float_as_uint(T), __float_as_uint(T), false, false);
                    const float Tp = ((lane >> 4) & 1) ? __uint_as_float(s16[0]) : __uint_as_float(s16[1]);
                    const float PT = T * Tp;
                    const auto s32 = __builtin_amdgcn_permlane32_swap(__float_as_uint(PT), __float_as_uint(PT), false, false);
                    const float pref = __uint_as_float(s32[0]), plast = pref * __uint_as_float(s32[1]);
                    const float excl = (((lane >> 4) & 1) ? Tp : 1.0f) * (((lane >> 5) & 1) ? pref : 1.0f) * ((tg & 1) ? lowv : 1.0f);
                    const float ipref = __builtin_amdgcn_rcpf(pref);
                    if (tg == 0) { eref[8 * cg + c] = pref; eglr[8 * cg + c] = plast * ipref; egl[8 * cg + c] = plast; gsum[8 * cg + c] *= plast; }
                    float kv[4], qv[4];
                    const float Kc = oml * pref * __builtin_amdgcn_rcpf(excl), Qc = excl * ipref;
#pragma unroll
                    for (int i = 0; i < 4; ++i) { kv[i] = Kc * (en[i] * ((i == 0) ? 1.0f : cD[i - 1])) * iN[i];
                        if (pass == 1) { const float qr = bf2f(hsel(rq[i], c)); qv[i] = qr * __builtin_amdgcn_rcpf(1.0f + __expf(-qr)) * (Qc * (cN[i] * iD[i])); } else qv[i] = 0.f; }
                    if (c & 1) {
#pragma unroll
                        for (int i = 0; i < 4; ++i) { *(LAS unsigned*)(kd + (4 * tg + i) * 72 + 8 * cg + c - 1) = pk2(kprev[i], kv[i]);
                            if (pass == 1) *(LAS unsigned*)(qd + (4 * tg + i) * 72 + 8 * cg + c - 1) = pk2(qprev[i], qv[i]); }
                    } else {
#pragma unroll
                        for (int i = 0; i < 4; ++i) { kprev[i] = kv[i]; qprev[i] = qv[i]; }
                    }
                }
#pragma unroll
                for (int c = 0; c < 8; ++c) { unsigned short vb[4];
#pragma unroll
                    for (int i = 0; i < 4; ++i) vb[i] = hsel(rv[i], c);
                    *(LAS u32x2*)(vT + (8 * cg + c) * 40 + 4 * tg) = (u32x2){(unsigned)vb[0] | ((unsigned)vb[1] << 16), (unsigned)vb[2] | ((unsigned)vb[3] << 16)}; }
            }
            if (ci < 7) { const int c1 = HCH(ci + 1);
#pragma unroll
                for (int i = 0; i < 4; ++i) { const unsigned ro = (unsigned)(HTK(c1, 4 * tg + i) * NPROJ + 8 * cg) * 2u;
                    rf[i] = ldg16(proj + PC_HF + dir * 256 + h * 64, ro); if (pass == 1) rq[i] = ldg16(proj + PC_HQ + h * 64, ro); } }
            LDS_WAIT(); __builtin_amdgcn_sched_barrier(0);
            bf16x8 vperm[2][2];
#pragma unroll
            for (int s = 0; s < 2; ++s)
#pragma unroll
                for (int pt = 0; pt < 2; ++pt) { const LAS unsigned short* vr = vT + (32 * pt + c32) * 40 + 16 * s + 4 * hh; vperm[s][pt] = cat44(*(const LAS u32x2*)vr, *(const LAS u32x2*)(vr + 8)); }
            if (pass == 1) {
                f32x16 SC;
#pragma unroll
                for (int i = 0; i < 16; ++i) SC[i] = 0.f;
#pragma unroll
                for (int ks = 0; ks < 4; ++ks) SC = MFMA32(*(const LAS bf16x8*)(kd + c32 * 72 + 16 * ks + 8 * hh), *(const LAS bf16x8*)(qd + c32 * 72 + 16 * ks + 8 * hh), SC);
#pragma unroll
                for (int i = 0; i < 16; ++i) SC[i] = (crow(i, hh) <= c32) ? SC[i] : 0.f;
                const bf16x8 pa0 = PACK_STEP(SC, 0), pa1 = PACK_STEP(SC, 1);
                bf16x8 qa[2][2];
#pragma unroll
                for (int et = 0; et < 2; ++et)
#pragma unroll
                    for (int s = 0; s < 2; ++s) { const LAS unsigned short* qr = qd + c32 * 72 + 32 * et + 16 * s + 4 * hh; qa[et][s] = cat44(*(const LAS u32x2*)qr, *(const LAS u32x2*)(qr + 8)); }
#pragma unroll
                for (int pt = 0; pt < 2; ++pt) {
                    f32x16 O;
#pragma unroll
                    for (int i = 0; i < 16; ++i) O[i] = 0.f;
                    O = MFMA32(pa0, vperm[0][pt], O); O = MFMA32(pa1, vperm[1][pt], O);
#pragma unroll
                    for (int et = 0; et < 2; ++et)
#pragma unroll
                        for (int s = 0; s < 2; ++s) { const f32x4 e0 = *(const LAS f32x4*)(eref + 32 * et + 16 * s + 4 * hh), e1 = *(const LAS f32x4*)(eref + 32 * et + 16 * s + 8 + 4 * hh);
                            const f32x16& sv = S[et][pt];
                            const bf16x8 sb = mk8(pk2(sv[8 * s] * e0.x, sv[8 * s + 1] * e0.y), pk2(sv[8 * s + 2] * e0.z, sv[8 * s + 3] * e0.w), pk2(sv[8 * s + 4] * e1.x, sv[8 * s + 5] * e1.y), pk2(sv[8 * s + 6] * e1.z, sv[8 * s + 7] * e1.w));
                            O = MFMA32(qa[et][s], sb, O); }
#pragma unroll
                    for (int i = 0; i < 16; ++i) { const unsigned oo = (unsigned)(HTK(c0, crow(i, hh)) * ostride + c32) * 2u; stg2(OD + 32 * pt, oo, f2bf(O[i])); }
                    __builtin_amdgcn_sched_barrier(0);
                }
            }
            __builtin_amdgcn_sched_barrier(0);
            {
#pragma unroll
                for (int et = 0; et < 2; ++et) {
                    f32x16 X;
#pragma unroll
                    for (int i = 0; i < 16; ++i) X[i] = 0.f;
#pragma unroll
                    for (int s = 0; s < 2; ++s) { unsigned idw[4];
#pragma unroll
                        for (int j = 0; j < 4; ++j) { const int k0 = 16 * s + 8 * hh + 2 * j; idw[j] = (k0 == c32 ? 0x3f80u : 0u) | (k0 + 1 == c32 ? 0x3f800000u : 0u); }
                        X = MFMA32(*(const LAS bf16x8*)(kd + c32 * 72 + 32 * et + 16 * s + 8 * hh), mk8(idw[0], idw[1], idw[2], idw[3]), X); }
                    const float sc = eglr[32 * et + c32];
#pragma unroll
                    for (int i = 0; i < 16; ++i) X[i] *= sc;
                    float dg[16];
#pragma unroll
                    for (int i = 0; i < 16; ++i) dg[i] = egl[32 * et + crow(i, hh)];
#pragma unroll
                    for (int pt = 0; pt < 2; ++pt) {
#pragma unroll
                        for (int i = 0; i < 16; ++i) S[et][pt][i] *= dg[i];
#pragma unroll
                        for (int s = 0; s < 2; ++s) S[et][pt] = MFMA32(PACK_STEP(X, s), vperm[s][pt], S[et][pt]); }
                }
            }
            LDS_WAIT();
        }
        if (pass == 0) {
            f32x4* sp = (f32x4*)(stsc + (size_t)w * 4096 + lane * 64);
#pragma unroll
            for (int a = 0; a < 2; ++a)
#pragma unroll
                for (int q = 0; q < 2; ++q)
#pragma unroll
                    for (int i4 = 0; i4 < 4; ++i4) sp[(a * 2 + q) * 4 + i4] = (f32x4){S[a][q][4 * i4], S[a][q][4 * i4 + 1], S[a][q][4 * i4 + 2], S[a][q][4 * i4 + 3]};
            LDS_WAIT(); Atot[w * 64 + lane] = gsum[lane];
            VM_WAIT(); __syncthreads();
        }
    }
#undef HTK
#undef HCH
    __syncthreads();
}

DI void phase_mixers(const Params& P, int l, LAS unsigned char* lds, int G, int bid) {
#ifndef REP_PHASE
#define REP_PHASE -1
#endif
#define MREPS(k) _Pragma("unroll 1") for (int _r = 0; _r < ((REP_PHASE == (k)) ? 2 : 1); ++_r)
    if (EN_HY) MREPS(30) for (int c = bid; c < 256; c += G) hyena_unit(P, c, lds);
    if (EN_AT) MREPS(31) { int bias_h = -1;
        if ((G & 7) == 0) { const int xcd = bid & 7, j = bid >> 3, per = G >> 3;
            for (int base = 0; base < NB * 4 * 8; base += G) { const int u = base + xcd * per + j; if (u < NB * 4 * 8) attn_unit(P, u, lds, bias_h); } }
        else for (int u = bid; u < NB * 4 * 8; u += G) attn_unit(P, u, lds, bias_h); }
    if (EN_MA) MREPS(32) for (int u = bid; u < 256; u += G) mamba_unit(P, l, u, lds);
    if (EN_HG) MREPS(33) for (int u = bid; u < 256; u += G) hgrn_unit(P, l, u, lds);
}

constexpr int N_PHASES = 21;
#if TPROBE >= 40 && TPROBE < 50
#define PCTL , (unsigned*)(ws + WS_CTL)
#else
#define PCTL
#endif
#ifndef REP_PHASE
#define REP_PHASE -1
#endif
#define REPS(k) for (int _rep = 0, _nrep = ((REP_PHASE == (k)) && ((k) != 0 && (k) != 5 || l == 0)) ? 2 : 1; _rep < _nrep; ++_rep)
__global__ void __launch_bounds__(512, 2) fwd_kernel(Params Pin) {
    Params P = Pin; P.wv = __builtin_amdgcn_readfirstlane((int)(threadIdx.x >> 6));
    extern __shared__ __attribute__((aligned(16))) unsigned char lds_raw[];
    LAS unsigned char* lds = (LAS unsigned char*)lds_raw;
    volatile LAS unsigned* MISC = (volatile LAS unsigned*)(lds + LDS_MISC);
    if (threadIdx.x < 64) MISC[threadIdx.x] = 0u;
    __syncthreads();
    unsigned char* ws = P.ws;
    const int lo = P.ph_lo, hi = P.ph_hi;
    XcdBarrier bar; bar.bar = (unsigned*)(ws + WS_CTL) + CW_BAR; bar.x = 0; bar.st = nullptr;
    if (hi - lo > 1) bar = xcd_barrier_post((unsigned*)(ws + WS_CTL) + CW_BAR, MISC + 8);
#define IN(k) (lo <= (k) && (k) < hi)
#ifndef TPSEAM
#define TPSEAM -1
#endif
#if TPROBE == 20
#define SEAM(k) do { if (IN(k) && IN((k) + 1)) { const unsigned _t0 = TP_T(); xcd_barrier(bar); if (TPSEAM < 0 || ((k) % 10) == TPSEAM) gb_wait += TP_T() - _t0; } } while (0)
#else
#define SEAM(k) do { if (IN(k) && IN((k) + 1)) xcd_barrier(bar); } while (0)
#endif
    unsigned gb_wait = 0; const unsigned gb_t0 = TPROBE == 20 ? TP_T() : 0u;
#pragma unroll 1
    for (int l = 0; l < 2; ++l) {
        int G = gridDim.x, bid = blockIdx.x; asm volatile("" : "+s"(G), "+s"(bid));
        const int p0 = 10 * l;
        if (IN(p0 + 0)) { _Pragma("unroll 1") REPS(0) phase_pre(P, l, lds); }
        SEAM(p0 + 0);
        if (IN(p0 + 1)) { _Pragma("unroll 1") REPS(1) {
            pg8::StaticOrder S; S.init(NTOK / 256, NPROJ / 256, G, bid); AddrPlain AD{DM, 0}; EpiProj E{(bf16_t*)(ws + WS_PROJ), (const float*)(ws + WS_MSQ)};
            pg8::gemm_phase(lds, (const char*)(ws + WS_XB), (const char*)(ws + WS_WIN), DM, S, AD, E, P.wv PCTL);
        } }
        SEAM(p0 + 1);
        if (IN(p0 + 2)) { _Pragma("unroll 1") REPS(2) phase_premix(P, l, lds); }
        SEAM(p0 + 2);
        if (IN(p0 + 3)) { _Pragma("unroll 1") REPS(3) phase_mixers(P, l, lds, G, bid); }
        SEAM(p0 + 3);
        if (IN(p0 + 4)) { _Pragma("unroll 1") REPS(4) phase_finalize(P, l); }
        SEAM(p0 + 4);
        if (IN(p0 + 5)) { _Pragma("unroll 1") REPS(5) {
            pg8::StaticOrder S; S.init(NTOK / 256, DM / 256, G, bid); AddrPlain AD{DM, 0}; EpiRes E{nullptr, (const bf16_t*)(ws + WS_XB), (bf16_t*)(ws + WS_XB)};
            pg8::gemm_phase(lds, (const char*)(ws + WS_HN), (const char*)(ws + WS_WOUT), DM, S, AD, E, P.wv PCTL);
        } }
        SEAM(p0 + 5);
        if (IN(p0 + 6)) { if (EN_MOE) { _Pragma("unroll 1") REPS(6) phase_ffnpre(P, l, lds); } }
        SEAM(p0 + 6);
        if (IN(p0 + 7)) { if (EN_MOE) { _Pragma("unroll 1") REPS(7) phase_topk(P, l, lds); } }
        SEAM(p0 + 7);
        if (IN(p0 + 8)) { if (EN_MOE) _Pragma("unroll 1") REPS(8) {
            pg8::StaticOrder S; S.init(NSLOT / 256, 2048 / 256, G, bid);
#if MOE_F8
            AddrGateUp8 AD{(const int*)(ws + WS_SELI)}; EpiGateUp8 E{(unsigned char*)P.out + DO_HDN, (const float*)(ws + WS_SELR)};
            pg8::gemm_phase<EpiGateUp8, pg8::StaticOrder, AddrGateUp8, true>(lds, (const char*)(ws + WS_HN), (const char*)(ws + WS_WGU), DM, S, AD, E, P.wv PCTL);
#else
            AddrGateUp AD{(const int*)(ws + WS_SELI)}; EpiGateUp E{(bf16_t*)((unsigned char*)P.out + DO_HDN), (const float*)(ws + WS_SELR)};
            pg8::gemm_phase(lds, (const char*)(ws + WS_HN), (const char*)(ws + WS_WGU), DM, S, AD, E, P.wv PCTL);
#endif
        } }
        SEAM(p0 + 8);
        if (IN(p0 + 9)) { if (EN_MOE) _Pragma("unroll 1") REPS(9) {
            pg8::StaticOrder S; S.init(NSLOT / 256, DM / 256, G, bid);
#if MOE_F8
            EpiDown E{(unsigned char*)(ws + WS_YE), (const float*)(ws + WS_SELG)};
            AddrDown8 AD{}; pg8::gemm_phase<EpiDown, pg8::StaticOrder, AddrDown8, true>(lds, (const char*)P.out + DO_HDN, (const char*)(ws + WS_WD), DM, S, AD, E, P.wv PCTL);
#else
            EpiDown E{(unsigned char*)(ws + WS_YE), (const float*)(ws + WS_SELG)};
            AddrDown AD{}; pg8::gemm_phase(lds, (const char*)P.out + DO_HDN, (const char*)(ws + WS_WD), DM, S, AD, E, P.wv PCTL);
#endif
        } }
        SEAM(p0 + 9);
    }
#ifdef PROBE_BARS
    if (hi - lo > 1) for (int i = 0; i < PROBE_BARS; ++i) xcd_barrier(bar);
#endif
    if (IN(20)) phase_final(P);
#ifndef TPOFF
#define TPOFF 0.5f
#endif
#if TPROBE == 20
    if (tid_opaque(P.wv) == 0) { atomicAdd((unsigned*)(ws + WS_CTL) + 512, gb_wait); atomicAdd((unsigned*)(ws + WS_CTL) + 513, (TP_T() - gb_t0) / 5u); }
    xcd_barrier(bar);
#endif
#if TPROBE
    __syncthreads();
    if (blockIdx.x == 0 && tid_opaque(P.wv) == 0) {
        const float a = (float)__hip_atomic_load((unsigned*)(ws + WS_CTL) + 512, __ATOMIC_RELAXED, __HIP_MEMORY_SCOPE_AGENT), t = (float)__hip_atomic_load((unsigned*)(ws + WS_CTL) + 513, __ATOMIC_RELAXED, __HIP_MEMORY_SCOPE_AGENT);
        P.out[0] = TPROBE == 99 ? 1.0e6f : (TPROBE == 20 && TPSEAM >= 0) ? (floorf(2.0f * log2f(a / t * 200.0f) + TPOFF) * 1.0e5f) : (floorf(a / t * 20.0f + TPOFF) * 1.0e5f); }
#endif
#undef IN
#undef SEAM
}

#ifndef N_LAUNCH_MODE
#define N_LAUNCH_MODE 1
#endif
extern "C" void kernel_launch(void* const* d_in, const int* in_sizes, int n_in, void* d_out, int out_size, void* d_ws, size_t ws_size, hipStream_t stream) {
    static int grid = 0;
    if (grid == 0) {
        if (n_in != 27 || in_sizes[0] != NTOK * DM || out_size != NTOK * DM || ws_size < WS_END) {
            fprintf(stderr, "kernel_launch: unexpected shapes (n_in %d, in0 %d, out %d, ws %zu, need %zu)\n", n_in, n_in > 0 ? in_sizes[0] : -1, out_size, ws_size, (size_t)WS_END); grid = -1; return; }
        int dev = 0, cus = 0, per_cu = 0;
        if (hipGetDevice(&dev) != hipSuccess || hipDeviceGetAttribute(&cus, hipDeviceAttributeMultiprocessorCount, dev) != hipSuccess) { grid = -1; return; }
        if (hipFuncSetAttribute((const void*)fwd_kernel, hipFuncAttributeMaxDynamicSharedMemorySize, LDS_BYTES) != hipSuccess) { fprintf(stderr, "kernel_launch: hipFuncSetAttribute failed\n"); grid = -1; return; }
        if (hipOccupancyMaxActiveBlocksPerMultiprocessor(&per_cu, (const void*)fwd_kernel, 512, LDS_BYTES) != hipSuccess || per_cu < 1) { fprintf(stderr, "kernel_launch: occupancy query says %d\n", per_cu); (void)hipGetLastError(); }
        grid = cus;
    }
    if (grid < 0) return;
    if (hipMemsetAsync((char*)d_ws + WS_CTL, 0, CTL_ZERO_BYTES, stream) != hipSuccess) return;
    Params p{};
    const float** pp = (const float**)&p;
    for (int i = 0; i < 27; ++i) pp[i] = (const float*)d_in[i];
    p.out = (float*)d_out; p.ws = (unsigned char*)d_ws;
    if (N_LAUNCH_MODE == 1) { p.ph_lo = 0; p.ph_hi = N_PHASES; hipLaunchKernelGGL(fwd_kernel, dim3(grid), dim3(512), LDS_BYTES, stream, p); }
    else for (int k = 0; k < N_PHASES; ++k) { p.ph_lo = k; p.ph_hi = k + 1; hipLaunchKernelGGL(fwd_kernel, dim3(grid), dim3(512), LDS_BYTES, stream, p); }
}
```

```cpp
#define N_LAUNCH_MODE 1
#include <hip/hip_runtime.h>
#include <cstdio>
#include <cstdint>

#define LAS __attribute__((address_space(3)))
#define DI __device__ __forceinline__
typedef unsigned short bf16_t;
typedef short bf16x8 __attribute__((ext_vector_type(8)));
typedef short s16x4 __attribute__((ext_vector_type(4)));
typedef float f32x2 __attribute__((ext_vector_type(2)));
typedef float f32x4 __attribute__((ext_vector_type(4)));
typedef float f32x16 __attribute__((ext_vector_type(16)));
typedef unsigned u32x2 __attribute__((ext_vector_type(2)));
typedef unsigned u32x4 __attribute__((ext_vector_type(4)));
typedef int i32x4 __attribute__((ext_vector_type(4)));
typedef __bf16 bfv2 __attribute__((ext_vector_type(2)));

DI unsigned pk2(float lo, float hi) { f32x2 v = {lo, hi}; return __builtin_bit_cast(unsigned, __builtin_convertvector(v, bfv2)); }
DI unsigned short f2bf(float f) { return (unsigned short)(pk2(f, 0.f) & 0xffffu); }
DI float bf2f(unsigned short b) { return __uint_as_float((unsigned)b << 16); }
DI float bflo(unsigned u) { return __uint_as_float(u << 16); }
DI float bfhi(unsigned u) { return __uint_as_float(u & 0xffff0000u); }
DI unsigned pk4_fp8(float a, float b, float c, float d) {
    a = __builtin_amdgcn_fmed3f(a, -440.f, 440.f); b = __builtin_amdgcn_fmed3f(b, -440.f, 440.f); c = __builtin_amdgcn_fmed3f(c, -440.f, 440.f); d = __builtin_amdgcn_fmed3f(d, -440.f, 440.f);
    int v = 0; v = __builtin_amdgcn_cvt_pk_fp8_f32(a, b, v, false); v = __builtin_amdgcn_cvt_pk_fp8_f32(c, d, v, true); return (unsigned)v; }
DI int lane_now() { int ln; asm volatile("v_mbcnt_lo_u32_b32 %0, -1, 0\n\tv_mbcnt_hi_u32_b32 %0, -1, %0" : "=v"(ln)); return ln; }
template <class T> DI T bperm_(int idx4, T v) { return __builtin_bit_cast(T, __builtin_amdgcn_ds_bpermute(idx4, __builtin_bit_cast(int, v))); }
template <class T> DI T shfl_xor_l(T v, int m, int self) { return bperm_(((self ^ m) & 63) << 2, v); }
template <class T> DI T shfl_up_l(T v, int o, int self, int width = 64) { int idx = self - o; if (idx < (self & ~(width - 1))) idx = self; return bperm_(idx << 2, v); }
template <class T> DI T shfl_xor_(T v, int m) { return shfl_xor_l(v, m, lane_now()); }
template <class T> DI T shfl_up_(T v, int o, int width = 64) { return shfl_up_l(v, o, lane_now(), width); }
template <class T> DI T shfl_(T v, int src) { return bperm_((src & 63) << 2, v); }
#ifndef HIP_SHFL
#define __shfl_xor shfl_xor_
#define __shfl_up shfl_up_
#define __shfl shfl_
#endif
DI float xhalf_max(float x) { const auto r = __builtin_amdgcn_permlane32_swap(__float_as_uint(x), __float_as_uint(x), false, false); return fmaxf(__uint_as_float(r[0]), __uint_as_float(r[1])); }
DI float xhalf_sum(float x) { const auto r = __builtin_amdgcn_permlane32_swap(__float_as_uint(x), __float_as_uint(x), false, false); return __uint_as_float(r[0]) + __uint_as_float(r[1]); }
template <int CTRL> DI float dpp_f(float x) { return __builtin_bit_cast(float, __builtin_amdgcn_update_dpp(0, __builtin_bit_cast(int, x), CTRL, 0xF, 0xF, true)); }
DI float x16_sum(float x) { const auto r = __builtin_amdgcn_permlane16_swap(__float_as_uint(x), __float_as_uint(x), false, false); return __uint_as_float(r[0]) + __uint_as_float(r[1]); }
DI float row_sum16(float x) { x += dpp_f<0x128>(x); x += dpp_f<0x124>(x); x += dpp_f<0x122>(x); x += dpp_f<0x121>(x); return x; }
DI float grp_sum8(float x) { x += dpp_f<0xB1>(x); x += dpp_f<0x4E>(x); x += dpp_f<0x141>(x); return x; }
DI float grp_max16(float x) { x = fmaxf(x, dpp_f<0xB1>(x)); x = fmaxf(x, dpp_f<0x4E>(x)); x = fmaxf(x, dpp_f<0x141>(x)); x = fmaxf(x, dpp_f<0x128>(x)); return x; }
DI float wave_sum(float v) { return xhalf_sum(x16_sum(row_sum16(v))); }
DI float silu_f(float x) { return x * __builtin_amdgcn_rcpf(1.0f + __expf(-x)); }
DI float sigmoid_f(float x) { return __builtin_amdgcn_rcpf(1.0f + __expf(-x)); }
#ifdef OLD_TID
DI int tid_opaque(int wv) { int t = wv * 64 + (int)__builtin_amdgcn_mbcnt_hi(~0u, __builtin_amdgcn_mbcnt_lo(~0u, 0u)); asm volatile("" : "+v"(t)); return t; }
#else
DI int tid_opaque(int wv) { int ln; asm volatile("v_mbcnt_lo_u32_b32 %0, -1, 0\n\tv_mbcnt_hi_u32_b32 %0, -1, %0" : "=v"(ln) :: "memory"); return wv * 64 + ln; }
#endif
DI bf16x8 mk8u(unsigned a, unsigned b, unsigned c, unsigned d) { u32x4 v = {a, b, c, d}; return __builtin_bit_cast(bf16x8, v); }
#define LDS_WAIT() asm volatile("s_waitcnt lgkmcnt(0)" ::: "memory")
#define VM_WAIT() asm volatile("s_waitcnt vmcnt(0)" ::: "memory")
#define MFMA32(a, b, c) __builtin_amdgcn_mfma_f32_32x32x16_bf16((a), (b), (c), 0, 0, 0)

constexpr int NB = 32, SEQ = 2048, DM = 1024, NTOK = NB * SEQ;
constexpr int NIN_REF = 3592, NPROJ = 3584;
constexpr int PC_HY = 0, PC_MZ = 768, PC_MX = 1024, PC_AQ = 1536, PC_AK = 1792, PC_AV = 2048, PC_HQ = 2304, PC_HF = 2560, PC_HI = 3072, PC_HG = 3328;
constexpr int NEXP = 16, CAP = 256, NSLOT = NB * NEXP * CAP;
constexpr float EPSN = 1e-6f;

constexpr size_t MiB = 1u << 20;
constexpr size_t WS_CTL = 0, CTL_ZERO_BYTES = 64 * 1024;
constexpr size_t WS_DT = 1 * MiB, WS_AFF = 3 * MiB, WS_SLOT = 7 * MiB, WS_SELI = 11 * MiB, WS_SELG = 11 * MiB + 512 * 1024, WS_KFILT = 12 * MiB, WS_MSQ = 14 * MiB, WS_RS = 15 * MiB, WS_SELR = 15 * MiB + 512 * 1024;
constexpr size_t WS_XB = 64 * MiB, WS_WIN = 320 * MiB, WS_WOUT = 327 * MiB, WS_WGU = 329 * MiB, WS_WD = 393 * MiB, WS_HN = 432 * MiB, WS_PROJ = 560 * MiB, WS_YE = WS_PROJ, WS_END = 1008 * MiB, WS_MYB = WS_WGU, WS_OB = WS_WGU + 32 * MiB;
constexpr size_t DO_HW = 0, DO_HX0 = 32 * MiB, DO_YAT = 64 * MiB, DO_MXBC = 96 * MiB, DO_MY = 160 * MiB, DO_MST = 192 * MiB, DO_HST = 224 * MiB, DO_HDN = 0;
constexpr int CW_BAR = 1024;

constexpr int LDS_MISC = 163840 - 256, LDS_BYTES = 163840;

struct Params {
    const float *x, *w_in, *w_out, *norm_mix_w, *norm_ffn_w, *hy_conv_w, *hy_w1, *hy_b1, *hy_w2, *hy_b2, *hy_freq, *hy_w3, *hy_fbias,
                *m_conv_w, *m_conv_b, *m_dt_bias, *m_A_log, *m_D, *m_norm_w, *rel_bias, *hg_lb, *hg_norm_w, *router_w, *moe_wg, *moe_wu, *moe_wd, *final_w;
    float* out; unsigned char* ws;
    int ph_lo, ph_hi, wv, pad;
};

#define XB_TMO      128
#define XB_XCNT(j)  (256  + 64 * (j))
#define XB_XSUB(j)  (1280 + 64 * (j))
#define XB_XGEN(j)  (2304 + 64 * (j))
#define XB_TOP      3328
#define XB_TOPGEN   3392
#define XCD_BAR_WORDS 3456
#define XB_SPIN_CAP (1u << 18)
__device__ __forceinline__ unsigned xb_ld(unsigned* p)              { return __hip_atomic_load(p, __ATOMIC_RELAXED, __HIP_MEMORY_SCOPE_AGENT); }
__device__ __forceinline__ unsigned xb_add(unsigned* p, unsigned v) { return __hip_atomic_fetch_add(p, v, __ATOMIC_RELAXED, __HIP_MEMORY_SCOPE_AGENT); }
__device__ __forceinline__ unsigned xb_xcc_id() { return (unsigned)__builtin_amdgcn_s_getreg((3 << 11) | 20) & 0xFu; }
#define XB_SPIN(cond, bar) do { unsigned _sp = 0; while (cond) { __builtin_amdgcn_s_sleep(1); \
    if ((++_sp & 255u) == 0u) { if (xb_ld(&(bar)[XB_TMO])) break; if (_sp > XB_SPIN_CAP) { atomicAdd(&(bar)[XB_TMO], 1u); break; } } } } while (0)
struct XcdBarrier { unsigned* bar; unsigned x; volatile LAS unsigned* st; };
__device__ __forceinline__ XcdBarrier xcd_barrier_post(unsigned* bar, volatile LAS unsigned* st) {
    XcdBarrier b; b.bar = bar; b.x = xb_xcc_id(); b.st = st;
    if (threadIdx.x == 0) (void)xb_add(&bar[XB_XCNT(b.x)], 1u);
    return b;
}
__device__ __forceinline__ void xcd_barrier_complete(unsigned* bar, unsigned x, unsigned& nloc, unsigned& nx) {
    const unsigned G = gridDim.x * gridDim.y * gridDim.z;
    unsigned sum, cnt, mine, sp = 0u;
    for (;;) {
        sum = 0u; cnt = 0u; mine = 0u;
#pragma unroll
        for (unsigned j = 0; j < 16; ++j) { const unsigned c = xb_ld(&bar[XB_XCNT(j)]); sum += c; cnt += (c > 0u) ? 1u : 0u; mine = (j == x) ? c : mine; }
        if (sum == G) break;
        __builtin_amdgcn_s_sleep(1);
        if ((++sp & 255u) == 0u) { if (xb_ld(&bar[XB_TMO])) break; if (sp > XB_SPIN_CAP) { atomicAdd(&bar[XB_TMO], 1u); break; } }
    }
    nloc = mine > 0u ? mine : 1u; nx = cnt > 0u ? cnt : 1u;
}
__device__ __forceinline__ void xcd_barrier(const XcdBarrier& b) {
    asm volatile("s_waitcnt vmcnt(0)" ::: "memory");
    __syncthreads();
    if (threadIdx.x == 0) {
        unsigned* bar = b.bar; asm volatile("" : "+s"(bar));
        __builtin_amdgcn_s_waitcnt(0);
        unsigned nloc = b.st[0], nx = b.st[1];
        if (nloc == 0u) { xcd_barrier_complete(bar, b.x, nloc, nx); b.st[0] = nloc; b.st[1] = nx; }
        const unsigned old = xb_add(&bar[XB_XSUB(b.x)], 1u);
        const unsigned gen = old / nloc;
        if (old + 1u == (gen + 1u) * nloc) {
            __builtin_amdgcn_fence(__ATOMIC_RELEASE, "agent");
            asm volatile("s_waitcnt vmcnt(0)" ::: "memory");
            const unsigned og = xb_add(&bar[XB_TOP], 1u);
            const unsigned tg = og / nx;
            if (og + 1u == (tg + 1u) * nx) xb_add(&bar[XB_TOPGEN], 1u);
            else XB_SPIN(xb_ld(&bar[XB_TOPGEN]) == tg, bar);
            __builtin_amdgcn_fence(__ATOMIC_ACQUIRE, "agent");
            xb_add(&bar[XB_XGEN(b.x)], 1u);
            asm volatile("s_waitcnt vmcnt(0)" ::: "memory");
        } else {
            XB_SPIN(xb_ld(&bar[XB_XGEN(b.x)]) == gen, bar);
            __builtin_amdgcn_fence(__ATOMIC_ACQUIRE, "agent");
            asm volatile("s_waitcnt vmcnt(0)" ::: "memory");
        }
    }
    __syncthreads();
}

namespace pg8 {
constexpr int BM = 256, BK = 64, HALF = 128, HTB = HALF * BK * 2, STAGE_BYTES = 8 * HTB, NXCD = 8, WGM = 8;
__host__ __device__ __forceinline__ int lds_byte(int r, int c) { const int st = (r >> 4) * 2 + (c >> 5), rr = r & 15, cc = c & 31, ob = rr * 64 + cc * 2; return st * 1024 + (ob ^ (((ob >> 9) & 1) << 5)); }
__host__ __device__ __forceinline__ void stage_rc(int b, int& R, int& C) { const int st = b / 1024, sb = b % 1024, swz = sb ^ (((sb >> 9) & 1) << 5); R = (st >> 1) * 16 + swz / 64; C = (st & 1) * 32 + (swz % 64) / 2; }
__host__ __device__ __forceinline__ int perm32(int rho) { const int n = rho >> 4, i = rho & 15; return 8 * (i >> 2) + 4 * n + (i & 3); }
struct Unit { int pm, pn; };
typedef int i32x8 __attribute__((ext_vector_type(8)));
typedef int i32x32 __attribute__((ext_vector_type(32)));
#define INS4(V, P, X) do { const i32x4 _x = (X); (V)[(P)] = _x.x; (V)[(P) + 1] = _x.y; (V)[(P) + 2] = _x.z; (V)[(P) + 3] = _x.w; } while (0)
#define EXT8(V, P) ((i32x8){(V)[(P)], (V)[(P) + 1], (V)[(P) + 2], (V)[(P) + 3], (V)[(P) + 4], (V)[(P) + 5], (V)[(P) + 6], (V)[(P) + 7]})
DI i32x8 cat88(bf16x8 lo, bf16x8 hi) { const i32x4 a = __builtin_bit_cast(i32x4, lo), b = __builtin_bit_cast(i32x4, hi); return (i32x8){a.x, a.y, a.z, a.w, b.x, b.y, b.z, b.w}; }
struct StaticOrder {
    int nM, nN, nwg, G, c;
    __device__ void init(int nM_, int nN_, int G_, int c_) { nM = nM_; nN = nN_; nwg = nM * nN; G = G_; c = c_; }
    __device__ bool next(int i, Unit& u) const {
        const long L = (long)i * G + c; if (L >= nwg) return false;
        int wgid = (int)L; { const int q = nwg / NXCD, r = nwg % NXCD, xcd = wgid % NXCD, off = wgid / NXCD; wgid = (xcd < r ? xcd * (q + 1) : r * (q + 1) + (xcd - r) * q) + off; }
        const int nig = WGM * nN, gid = wgid / nig, fm = gid * WGM, gsz = (nM - fm) < WGM ? (nM - fm) : WGM;
        u.pm = fm + ((wgid % nig) % gsz); u.pn = (wgid % nig) / gsz; return true;
    }
};
#ifndef TPROBE
#define TPROBE 0
#endif
#ifndef TPGEMM
#define TPGEMM 0
#endif
#define GP_T() ({ asm volatile("" ::: "memory"); unsigned _t = (unsigned)__builtin_amdgcn_s_memrealtime(); asm volatile("" ::: "memory"); _t; })
#define GP_ON(k) (TPROBE == (k) && Epi::PID == TPGEMM)
template <class Epi, class Sched, class Addr, bool F8 = false>
__device__ __forceinline__ void gemm_phase(LAS unsigned char* lds, const char* Abase, const char* Bbase, int K, const Sched& S, const Addr& AD, const Epi& E, int wv, unsigned* lds_ws_ctl = nullptr) {
    const int tid = tid_opaque(wv), wid = __builtin_amdgcn_readfirstlane(tid >> 6), lane = tid & 63, wr = wid >> 2, wc = wid & 3, fr = lane & 15, fq = lane >> 4;
    unsigned gp_acc = 0, gp_tot = 0, gp_t0 = 0, gp_t1 = 0; if (TPROBE >= 40 && TPROBE < 50 && Epi::PID == TPGEMM) gp_t0 = GP_T();
    const int KB = F8 ? K : 2 * K;
    const int nt = KB / 128;
    int Rr[2]; unsigned Cc[2], voffB[2], voffA[2];
#pragma unroll
    for (int i = 0; i < 2; ++i) { int R, C; stage_rc(tid * 16 + i * 8192, R, C); const int Rb = Epi::PERM ? ((R & ~31) + perm32(R & 31)) : R;
        Rr[i] = R; Cc[i] = (unsigned)C * 2u; voffA[i] = (unsigned)(R * KB + C * 2); voffB[i] = (unsigned)(Rb * KB + C * 2); }
    const size_t kstep = (size_t)(BK * 2);
    const size_t hstep = (size_t)HALF * KB;
    const unsigned ldsw = (unsigned)wid * 1024u;
    const int aoff = F8 ? lds_byte(wr * 64 + fr, fq * 16) : lds_byte(wr * 64 + fr, fq * 8), boff = F8 ? lds_byte(wc * 32 + fr, fq * 16) : lds_byte(wc * 32 + fr, fq * 8);
    const int aoff1 = F8 ? lds_byte(wr * 64 + fr, fq * 16 + 8) : aoff + 1024, boff1 = F8 ? lds_byte(wc * 32 + fr, fq * 16 + 8) : boff + 1024;
#define PG8_SA(b, h) (((b) * 2 + (h)) * HTB)
#define PG8_SB(b, h) ((4 + (b) * 2 + (h)) * HTB)
#define PG8_STAGE(bufoff, gbase, voff) do { _Pragma("unroll") for (int _i = 0; _i < 2; ++_i) \
        __builtin_amdgcn_global_load_lds((const unsigned*)((const char*)(gbase) + (voff)[_i]), (LAS unsigned*)(lds + (bufoff) + ldsw + _i * 8192), 16, 0, 0); } while (0)
#define PG8_STAGE_A(bufoff, kb, h, un) do { if constexpr (Addr::LOADS) { _Pragma("unroll") for (int _i = 0; _i < 2; ++_i) \
        __builtin_amdgcn_global_load_lds((const unsigned*)(Abase + (kb) + ((un) ? on[h][_i] : oc[h][_i])), (LAS unsigned*)(lds + (bufoff) + ldsw + _i * 8192), 16, 0, 0); } \
      else { const char* _ab = ((un) ? nA : cA) + (kb) + (size_t)(h) * hstep; _Pragma("unroll") for (int _i = 0; _i < 2; ++_i) \
        __builtin_amdgcn_global_load_lds((const unsigned*)(_ab + voffA[_i]), (LAS unsigned*)(lds + (bufoff) + ldsw + _i * 8192), 16, 0, 0); } } while (0)
#define PG8_BSEL_B0 0
#define PG8_BSEL_B1 16
#define PG8_LDA(dst, b, h) do { if constexpr (F8) { _Pragma("unroll") for (int m = 0; m < 4; ++m) { INS4(AA, 8 * m, *(const LAS i32x4*)(lds + PG8_SA(b, h) + aoff + m * 2048)); INS4(AA, 8 * m + 4, *(const LAS i32x4*)(lds + PG8_SA(b, h) + aoff + 16 + m * 2048)); } } \
      else { _Pragma("unroll") for (int m = 0; m < 4; ++m) _Pragma("unroll") for (int k = 0; k < 2; ++k) dst[m][k] = *(const LAS bf16x8*)(lds + PG8_SA(b, h) + (k ? aoff1 : aoff) + m * 2048); } } while (0)
#define PG8_LDB(dst, b, h) do { if constexpr (F8) { _Pragma("unroll") for (int n = 0; n < 2; ++n) { INS4(BB, PG8_BSEL_##dst + 8 * n, *(const LAS i32x4*)(lds + PG8_SB(b, h) + boff + n * 2048)); INS4(BB, PG8_BSEL_##dst + 8 * n + 4, *(const LAS i32x4*)(lds + PG8_SB(b, h) + boff + 16 + n * 2048)); } } \
      else { _Pragma("unroll") for (int n = 0; n < 2; ++n) _Pragma("unroll") for (int k = 0; k < 2; ++k) dst[n][k] = *(const LAS bf16x8*)(lds + PG8_SB(b, h) + (k ? boff1 : boff) + n * 2048); } } while (0)
#define PG8_MMA(ai, bj, At, Bt) do { __builtin_amdgcn_s_setprio(1); if constexpr (F8) { _Pragma("unroll") for (int m = 0; m < 4; ++m) _Pragma("unroll") for (int n = 0; n < 2; ++n) \
        { const i32x8 _b8 = EXT8(BB, PG8_BSEL_##Bt + 8 * n), _a8 = EXT8(AA, 8 * m); \
          asm volatile("s_nop 1\n\tv_mfma_scale_f32_16x16x128_f8f6f4 %0, %1, %2, %0, %3, %4 op_sel_hi:[0,0,0]" : "+v"(acc[ai][bj][m][n]) : "v"(_b8), "v"(_a8), "v"(scw), "v"(scx)); } } \
      else { _Pragma("unroll") for (int m = 0; m < 4; ++m) _Pragma("unroll") for (int n = 0; n < 2; ++n) _Pragma("unroll") for (int k = 0; k < 2; ++k) \
        acc[ai][bj][m][n] = __builtin_amdgcn_mfma_f32_16x16x32_bf16(Bt[n][k], At[m][k], acc[ai][bj][m][n], 0, 0, 0); } __builtin_amdgcn_s_setprio(0); } while (0)
#define PG8_WAIT_V(n) asm volatile("s_waitcnt vmcnt(" #n ")" ::: "memory")
#define PG8_WAIT_L(n) asm volatile("s_waitcnt lgkmcnt(" #n ")" ::: "memory")
#define PG8_BAR __builtin_amdgcn_s_barrier()
#define PG8_SCHED __builtin_amdgcn_sched_barrier(0)
    int scw = 0, scx = 0; if constexpr (F8) { scw = Addr::SC_W; scx = Addr::SC_X; } (void)scw; (void)scx;
    Unit cur, nxt; int ui = 0;
    if (!S.next(0, cur)) return;
#ifdef STAG_TICKS
    {
        const unsigned long long t0 = __builtin_amdgcn_s_memrealtime(); const unsigned long long dl = (unsigned long long)(((blockIdx.x >> 3) & 7) * STAG_TICKS);
        while (__builtin_amdgcn_s_memrealtime() - t0 < dl) __builtin_amdgcn_s_sleep(16);
    }
#endif
    f32x4 acc[2][2][4][2];
#pragma unroll
    for (int a = 0; a < 2; ++a)
#pragma unroll
        for (int b = 0; b < 2; ++b)
#pragma unroll
            for (int m = 0; m < 4; ++m)
#pragma unroll
                for (int n = 0; n < 2; ++n) acc[a][b][m][n] = (f32x4){0.f, 0.f, 0.f, 0.f};
    bf16x8 At[4][2], B0[2][2], B1[2][2]; i32x32 AA, BB; (void)At; (void)B0; (void)B1; (void)AA; (void)BB;
    unsigned oc[2][2], on[2][2];
    const char* cA = Abase; const char* nA = Abase;
    if constexpr (Epi::ROWTAB) {
        float tv[8]; bool tok[8];
#pragma unroll
        for (int t = 0; t < 8; ++t) { const int idx = tid + 512 * t; Unit tu; tok[t] = S.next(idx >> 8, tu); tv[t] = tok[t] ? E.rowscale(tu, idx & 255) : 0.f; }
#pragma unroll
        for (int t = 0; t < 8; ++t) if (tok[t]) ((LAS float*)(lds + STAGE_BYTES + 8192))[tid + 512 * t] = tv[t];
        if constexpr (!Addr::LOADS) __syncthreads();
    }
    if constexpr (Addr::LOADS) {
        {
            unsigned short tk[8]; bool tok[8];
#pragma unroll
            for (int t = 0; t < 8; ++t) { const int idx = tid + 512 * t; Unit tu; tok[t] = S.next(idx >> 8, tu); tk[t] = tok[t] ? AD.arow_tok(tu, idx & 255) : (unsigned short)0; }
#pragma unroll
            for (int t = 0; t < 8; ++t) if (tok[t]) ((LAS unsigned short*)(lds + STAGE_BYTES))[tid + 512 * t] = tk[t];
            __syncthreads();
        }
#pragma unroll
        for (int h = 0; h < 2; ++h)
#pragma unroll
            for (int i = 0; i < 2; ++i) { oc[h][i] = AD.arow_lds(lds + STAGE_BYTES, 0, cur, h * HALF + Rr[i]) + Cc[i]; on[h][i] = oc[h][i]; }
        PG8_WAIT_V(0);
    } else { cA = Abase + AD.arow(cur, 0); nA = cA; }
    const char* cB = Bbase + AD.boff(cur);
    PG8_STAGE(PG8_SB(0, 0), cB, voffB); PG8_STAGE_A(PG8_SA(0, 0), 0, 0, false); PG8_STAGE(PG8_SB(0, 1), cB + hstep, voffB); PG8_STAGE_A(PG8_SA(0, 1), 0, 1, false);
    if (wr == 1) PG8_BAR;
    PG8_WAIT_V(4); PG8_BAR;
    PG8_STAGE(PG8_SB(1, 0), cB + kstep, voffB); PG8_STAGE_A(PG8_SA(1, 0), kstep, 0, false); PG8_STAGE(PG8_SB(1, 1), cB + hstep + kstep, voffB);
    PG8_WAIT_V(6); PG8_BAR;
    for (;;) {
        const bool has_next = S.next(ui + 1, nxt);
        if (has_next) {
            if constexpr (Addr::LOADS) {
#pragma unroll
                for (int h = 0; h < 2; ++h)
#pragma unroll
                    for (int i = 0; i < 2; ++i) on[h][i] = AD.arow_lds(lds + STAGE_BYTES, ui + 1, nxt, h * HALF + Rr[i]) + Cc[i];
            } else nA = Abase + AD.arow(nxt, 0);
        } else nA = cA;
        const char* nB = has_next ? Bbase + AD.boff(nxt) : cB;
        if (GP_ON(41)) gp_t1 = GP_T();
#pragma unroll 1
        for (int t = 0; t < nt; t += 2) {
            if (GP_ON(43) && t == 0) gp_t1 = GP_T();
            if (GP_ON(44) && t == 2) gp_t1 = GP_T();
            const bool last = (t == nt - 2);
            const bool un = last && has_next;
            const size_t k1 = (size_t)(t + 1) * kstep;
            const size_t k2 = last ? 0 : (size_t)(t + 2) * kstep, k3 = k2 + kstep;
            const char* b2 = last ? nB : cB + (size_t)(t + 2) * kstep;
            const char* b3 = b2 + kstep;
            PG8_LDB(B0, 0, 0); PG8_SCHED; PG8_LDA(At, 0, 0); PG8_STAGE_A(PG8_SA(1, 1), k1, 1, false);
            PG8_WAIT_L(8); PG8_BAR; PG8_WAIT_L(0); PG8_MMA(0, 0, At, B0); PG8_BAR; PG8_SCHED;
            PG8_LDB(B1, 0, 1); PG8_STAGE(PG8_SB(0, 0), b2, voffB);
            PG8_BAR; PG8_WAIT_L(0); PG8_MMA(0, 1, At, B1); PG8_BAR;
            PG8_LDA(At, 0, 1); PG8_STAGE_A(PG8_SA(0, 0), k2, 0, un);
            PG8_BAR; PG8_WAIT_L(0); PG8_MMA(1, 0, At, B0); PG8_BAR; PG8_SCHED;
            PG8_STAGE(PG8_SB(0, 1), b2 + hstep, voffB);
            PG8_WAIT_V(6); PG8_BAR; PG8_MMA(1, 1, At, B1); PG8_BAR;
            PG8_LDB(B0, 1, 0); PG8_SCHED; PG8_LDA(At, 1, 0); PG8_STAGE_A(PG8_SA(0, 1), k2, 1, un);
            PG8_WAIT_L(8); PG8_BAR; PG8_WAIT_L(0); PG8_MMA(0, 0, At, B0); PG8_BAR; PG8_SCHED;
            PG8_LDB(B1, 1, 1); PG8_STAGE(PG8_SB(1, 0), b3, voffB);
            PG8_BAR; PG8_WAIT_L(0); PG8_MMA(0, 1, At, B1); PG8_BAR;
            PG8_LDA(At, 1, 1); PG8_STAGE_A(PG8_SA(1, 0), k3, 0, un);
            PG8_BAR; PG8_WAIT_L(0); PG8_MMA(1, 0, At, B0); PG8_BAR; PG8_SCHED;
            PG8_STAGE(PG8_SB(1, 1), b3 + hstep, voffB);
            PG8_WAIT_V(6); PG8_BAR; PG8_MMA(1, 1, At, B1); PG8_BAR;
            if (GP_ON(43) && t == 0) gp_acc += GP_T() - gp_t1;
            if (GP_ON(44) && t == 2) gp_acc += GP_T() - gp_t1;
        }
        if (GP_ON(41)) gp_acc += GP_T() - gp_t1;
        if (GP_ON(42)) gp_t1 = GP_T();
        if constexpr (F8) asm volatile("s_nop 15\n\ts_nop 15" ::: "memory");
        E(acc, cur, wr, wc, fr, fq, (const LAS float*)(lds + STAGE_BYTES + 8192) + ui * 256);
        if (GP_ON(42)) gp_acc += GP_T() - gp_t1;
        if (!has_next) break;
#pragma unroll
        for (int a = 0; a < 2; ++a)
#pragma unroll
            for (int b = 0; b < 2; ++b)
#pragma unroll
                for (int m = 0; m < 4; ++m)
#pragma unroll
                    for (int n = 0; n < 2; ++n) acc[a][b][m][n] = (f32x4){0.f, 0.f, 0.f, 0.f};
        cur = nxt; cB = nB; cA = nA; ++ui;
        if constexpr (Addr::LOADS) {
#pragma unroll
            for (int h = 0; h < 2; ++h)
#pragma unroll
                for (int i = 0; i < 2; ++i) oc[h][i] = on[h][i]; }
    }
    PG8_WAIT_V(0);
    if (wr == 0) PG8_BAR;
    PG8_BAR;
    if (TPROBE >= 40 && TPROBE < 50 && Epi::PID == TPGEMM && tid == 0) { gp_tot = GP_T() - gp_t0; atomicAdd((unsigned*)lds_ws_ctl + 512, gp_acc); atomicAdd((unsigned*)lds_ws_ctl + 513, gp_tot); }
#undef PG8_SA
#undef PG8_SB
#undef PG8_STAGE
#undef PG8_STAGE_A
#undef PG8_BSEL_B0
#undef PG8_BSEL_B1
#undef PG8_LDA
#undef PG8_LDB
#undef PG8_MMA
#undef PG8_WAIT_V
#undef PG8_WAIT_L
#undef PG8_BAR
#undef PG8_SCHED
}
}

#ifndef EN_HY
#define EN_HY 1
#endif
#ifndef EN_MA
#define EN_MA 1
#endif
#ifndef EN_AT
#define EN_AT 1
#endif
#ifndef EN_HG
#define EN_HG 1
#endif
#ifndef EN_MOE
#define EN_MOE 1
#endif
#ifndef MOE_F8
#define MOE_F8 1
#endif

DI void transpose_item(const float* W, int ld, int k0, int n0, bf16_t* dst, int drow0, float scale, LAS float* scr, int lane, const float* kw = nullptr) {
    {
        const int rs = lane >> 3, cq = (lane & 7) * 4;
        f32x4 v[8];
#pragma unroll
        for (int i = 0; i < 8; ++i) v[i] = __builtin_nontemporal_load((const f32x4*)(W + (size_t)(k0 + 8 * i + rs) * ld + n0 + cq));
#pragma unroll
        for (int i = 0; i < 8; ++i) { LAS float* d = scr + (8 * i + rs) * 33 + cq; d[0] = v[i].x; d[1] = v[i].y; d[2] = v[i].z; d[3] = v[i].w; }
    }
    LDS_WAIT();
    const int c = lane & 7;
    float sk[8];
#pragma unroll
    for (int i = 0; i < 8; ++i) sk[i] = kw ? scale * kw[k0 + 8 * c + i] : scale;
#pragma unroll
    for (int j = 0; j < 4; ++j) { const int n = (lane >> 3) + 8 * j; const LAS float* s = scr + (8 * c) * 33 + n;
        u32x4 o; o.x = pk2(s[0 * 33] * sk[0], s[1 * 33] * sk[1]); o.y = pk2(s[2 * 33] * sk[2], s[3 * 33] * sk[3]); o.z = pk2(s[4 * 33] * sk[4], s[5 * 33] * sk[5]); o.w = pk2(s[6 * 33] * sk[6], s[7 * 33] * sk[7]);
        *(u32x4*)(dst + (size_t)(drow0 + n) * 1024 + k0 + 8 * c) = o; }
    LDS_WAIT();
}

DI void transpose_item_f8(const float* W, int ld, int k0, int n0, unsigned char* dst, int drow0, float scale, LAS float* scr, int lane, const float* kw = nullptr) {
    {   const int rs = lane >> 3, cq = (lane & 7) * 4;
        f32x4 v[8];
#pragma unroll
        for (int i = 0; i < 8; ++i) v[i] = __builtin_nontemporal_load((const f32x4*)(W + (size_t)(k0 + 8 * i + rs) * ld + n0 + cq));
#pragma unroll
        for (int i = 0; i < 8; ++i) { LAS float* d = scr + (8 * i + rs) * 33 + cq; d[0] = v[i].x; d[1] = v[i].y; d[2] = v[i].z; d[3] = v[i].w; }
    }
    LDS_WAIT();
    const int c = lane & 7;
    float sk[8];
#pragma unroll
    for (int i = 0; i < 8; ++i) sk[i] = kw ? scale * kw[k0 + 8 * c + i] : scale;
#pragma unroll
    for (int j = 0; j < 4; ++j) { const int n = (lane >> 3) + 8 * j; const LAS float* s = scr + (8 * c) * 33 + n;
        u32x2 o; o.x = pk4_fp8(s[0 * 33] * sk[0], s[1 * 33] * sk[1], s[2 * 33] * sk[2], s[3 * 33] * sk[3]); o.y = pk4_fp8(s[4 * 33] * sk[4], s[5 * 33] * sk[5], s[6 * 33] * sk[6], s[7 * 33] * sk[7]);
        *(u32x2*)(dst + (size_t)(drow0 + n) * 1024 + k0 + 8 * c) = o; }
    LDS_WAIT();
}

#define RDL(x, i) __uint_as_float(__builtin_amdgcn_readlane(__float_as_uint(x), (i)))
DI void hyena_filter_pos(const Params& P, int l, int pos, int lane, bf16_t* kfilt) {
    const float TWO_PI = 6.283185307179586f;
    const float tpos = (float)pos * (1.0f / 2047.0f);
    float z = 0.f;
    if (lane == 0) z = tpos;
    else if (lane <= 32) { const int bnd = (lane - 1) & 15; const float f = 1e-4f + (float)bnd * ((15.0f - 1e-4f) / 15.0f);
        const float angp = TWO_PI * (float)pos / 2048.0f; const float ang = angp * f; z = (lane <= 16) ? cosf(ang) : -sinf(ang); }
    const float* w1 = P.hy_w1 + (size_t)l * 33 * 64; const float* w2 = P.hy_w2 + (size_t)l * 64 * 64; const float* w3 = P.hy_w3 + (size_t)l * 64 * 512;
    const float fr = P.hy_freq[l * 64 + lane];
    float a = P.hy_b1[l * 64 + lane];
#pragma unroll 11
    for (int i = 0; i < 33; ++i) a += RDL(z, i) * w1[i * 64 + lane];
    const float h1 = sinf(fr * a);
    float a2 = P.hy_b2[l * 64 + lane];
#pragma unroll 16
    for (int i = 0; i < 64; ++i) a2 += RDL(h1, i) * w2[i * 64 + lane];
    const float h2 = sinf(fr * a2);
    float h3[8];
#pragma unroll
    for (int k = 0; k < 8; ++k) h3[k] = 0.f;
#pragma unroll 1
    for (int i0 = 0; i0 < 64; i0 += 8) { float wv[8][8];
#pragma unroll
        for (int ii = 0; ii < 8; ++ii)
#pragma unroll
            for (int k = 0; k < 8; ++k) wv[ii][k] = w3[(i0 + ii) * 512 + k * 64 + lane];
        asm volatile("" ::: "memory");
#pragma unroll
        for (int ii = 0; ii < 8; ++ii) { const float hv = RDL(h2, i0 + ii);
#pragma unroll
            for (int k = 0; k < 8; ++k) h3[k] += hv * wv[ii][k]; } }
    const float min_decay = -3.0701134573253944f, max_decay = -15.350567286626972f;
#pragma unroll
    for (int k = 0; k < 8; ++k) { const int cp = k * 64 + lane, c = cp & 255;
        const float delta = fabsf(min_decay + (float)c * ((max_decay - min_decay) / 255.0f));
        float v = h3[k] * expf(-tpos * delta);
        if (cp < 256) { if (pos == 0) { v += P.hy_fbias[l * 256 + c]; kfilt[(size_t)c * 4096 + 4095] = 0; } kfilt[(size_t)c * 4096 + 2047 - pos] = f2bf(v); }
        else if (pos >= 1) kfilt[(size_t)c * 4096 + 2047 + pos] = f2bf(v); }
}
#undef RDL

struct SelRows { int cnt; unsigned o0, o1, o2, o3; };
DI SelRows sel_compact(int sl, int b) {
    SelRows r; r.cnt = 0; r.o0 = r.o1 = r.o2 = r.o3 = 0u;
#pragma unroll
    for (int e = 0; e < 16; ++e) { const int s = __builtin_amdgcn_readlane(sl, e); const bool on = s >= 0; const unsigned v = (unsigned)((b * 16 + e) * 256 + s);
        r.o0 = (on && r.cnt == 0) ? v : r.o0; r.o1 = (on && r.cnt == 1) ? v : r.o1; r.o2 = (on && r.cnt == 2) ? v : r.o2; r.o3 = (on && r.cnt == 3) ? v : r.o3; r.cnt += on ? 1 : 0; }
    return r;
}
typedef float f32x2_ __attribute__((ext_vector_type(2)));
DI void ye_load(const unsigned char* YE, unsigned o, int lane, unsigned (&t)[4]) { const unsigned* yr = (const unsigned*)(YE + (size_t)o * DM) + lane;
#pragma unroll
    for (int j = 0; j < 4; ++j) t[j] = yr[64 * j]; }
DI void ye_add(f32x4 (&v)[4], const unsigned (&t)[4]) {
#pragma unroll
    for (int j = 0; j < 4; ++j) { const f32x2_ a = __builtin_amdgcn_cvt_pk_f32_fp8((int)t[j], false), b = __builtin_amdgcn_cvt_pk_f32_fp8((int)t[j], true);
        v[j].x += a.x * (1.0f / 64.0f); v[j].y += a.y * (1.0f / 64.0f); v[j].z += b.x * (1.0f / 64.0f); v[j].w += b.y * (1.0f / 64.0f); } }
template <bool FINAL>
DI void pre_rows2(const Params& P, int l, const int (&m)[2], int lane, const LAS f32x4* dtw, const float* nw, const int (&slp)[2]) {
    unsigned char* ws = P.ws;
    bf16_t* XB = (bf16_t*)(ws + WS_XB);
    const bool first = (!FINAL && l == 0);
    f32x4 v[2][4];
    if (first) {
#pragma unroll
        for (int k = 0; k < 2; ++k) { const f32x4* xr = (const f32x4*)(P.x + (size_t)m[k] * DM) + lane;
#pragma unroll
            for (int j = 0; j < 4; ++j) v[k][j] = xr[64 * j]; }
    } else {
        u32x2 xh[2][4];
#pragma unroll
        for (int k = 0; k < 2; ++k) { const u32x2* xr = (const u32x2*)(XB + (size_t)m[k] * DM) + lane;
#pragma unroll
            for (int j = 0; j < 4; ++j) xh[k][j] = xr[64 * j]; }
#pragma unroll
        for (int k = 0; k < 2; ++k)
#pragma unroll
            for (int j = 0; j < 4; ++j) v[k][j] = (f32x4){bflo(xh[k][j].x), bfhi(xh[k][j].x), bflo(xh[k][j].y), bfhi(xh[k][j].y)};
    }
    if (!first && EN_MOE) {
        const unsigned char* YE = (const unsigned char*)(ws + WS_YE); const int* slot = (const int*)(ws + WS_SLOT);
        int sl[2]; SelRows sr[2]; (void)slot;
#pragma unroll
        for (int k = 0; k < 2; ++k) sl[k] = slp[k];
#pragma unroll
        for (int k = 0; k < 2; ++k) sr[k] = sel_compact(sl[k], m[k] >> 11);
        unsigned t[2][4][4];
#pragma unroll
        for (int k = 0; k < 2; ++k) { if (sr[k].cnt > 0) ye_load(YE, sr[k].o0, lane, t[k][0]); if (sr[k].cnt > 1) ye_load(YE, sr[k].o1, lane, t[k][1]);
            if (sr[k].cnt > 2) ye_load(YE, sr[k].o2, lane, t[k][2]); if (sr[k].cnt > 3) ye_load(YE, sr[k].o3, lane, t[k][3]); }
#pragma unroll
        for (int k = 0; k < 2; ++k) { if (sr[k].cnt > 0) ye_add(v[k], t[k][0]); if (sr[k].cnt > 1) ye_add(v[k], t[k][1]); if (sr[k].cnt > 2) ye_add(v[k], t[k][2]); if (sr[k].cnt > 3) ye_add(v[k], t[k][3]);
            if (sr[k].cnt > 4) {
                int seen = 0; const int b = m[k] >> 11;
                for (int e = 0; e < 16; ++e) { const int s = __builtin_amdgcn_readlane(sl[k], e);
                    if (s >= 0) { if (seen >= 4) { unsigned tt[4]; ye_load(YE, (unsigned)((b * 16 + e) * 256 + s), lane, tt); ye_add(v[k], tt); } ++seen; } } } }
    }
    float rr[2];
#pragma unroll
    for (int k = 0; k < 2; ++k) {
        float s = 0.f;
#pragma unroll
        for (int j = 0; j < 4; ++j) s += (v[k][j].x * v[k][j].x + v[k][j].y * v[k][j].y) + (v[k][j].z * v[k][j].z + v[k][j].w * v[k][j].w);
        rr[k] = __builtin_amdgcn_rsqf(wave_sum(s) * (1.0f / DM) + EPSN);
    }
    if (FINAL) {
        f32x4 wv[4];
#pragma unroll
        for (int j = 0; j < 4; ++j) wv[j] = ((const f32x4*)nw)[64 * j + lane];
        asm volatile("" ::: "memory");
#pragma unroll
        for (int k = 0; k < 2; ++k) { f32x4* o = (f32x4*)(P.out + (size_t)m[k] * DM) + lane;
#pragma unroll
            for (int j = 0; j < 4; ++j) o[64 * j] = v[k][j] * rr[k] * wv[j]; }
        return;
    }
    {
#pragma unroll
        for (int k = 0; k < 2; ++k) { u32x2* o = (u32x2*)(XB + (size_t)m[k] * DM) + lane;
#pragma unroll
            for (int j = 0; j < 4; ++j) o[64 * j] = (u32x2){pk2(v[k][j].x, v[k][j].y), pk2(v[k][j].z, v[k][j].w)}; } }
    float d[2][8];
#pragma unroll
    for (int k = 0; k < 2; ++k)
#pragma unroll
        for (int c = 0; c < 8; ++c) d[k][c] = 0.f;
#pragma unroll
    for (int j = 0; j < 4; ++j) {
#pragma unroll
        for (int q = 0; q < 4; ++q) { const f32x4 w0 = dtw[((j * 4 + q) * 2 + 0) * 64 + lane], w1 = dtw[((j * 4 + q) * 2 + 1) * 64 + lane];
#pragma unroll
            for (int k = 0; k < 2; ++k) { const float xv = q == 0 ? v[k][j].x : (q == 1 ? v[k][j].y : (q == 2 ? v[k][j].z : v[k][j].w));
                d[k][0] += xv * w0.x; d[k][1] += xv * w0.y; d[k][2] += xv * w0.z; d[k][3] += xv * w0.w; d[k][4] += xv * w1.x; d[k][5] += xv * w1.y; d[k][6] += xv * w1.z; d[k][7] += xv * w1.w; } }
    }
#pragma unroll
    for (int k = 0; k < 2; ++k) {
        float mine = 0.f;
#pragma unroll
        for (int c = 0; c < 8; ++c) { const float t2 = wave_sum(d[k][c]); mine = (lane == c) ? t2 : mine; }
        if (lane < 8) ((float*)(ws + WS_DT))[(size_t)m[k] * 8 + lane] = mine * rr[k];
        if (lane == 8) ((float*)(ws + WS_MSQ))[m[k]] = rr[k];
    }
    (void)nw;
}

DI void phase_pre(const Params& P, int l, LAS unsigned char* lds) {
    const int tid = tid_opaque(P.wv), lane = tid & 63, wave = tid >> 6;
    const int gw = blockIdx.x * 8 + wave, NGW = gridDim.x * 8;
    unsigned char* ws = P.ws;
    LAS float* dtwf = (LAS float*)lds;
    const float* win_ = P.w_in; asm volatile("" : "+s"(win_));
    {
        float wa[16], wb[16];
#pragma unroll
        for (int t = 0; t < 16; ++t) { const int i = tid + 512 * t, k = i >> 3, c = i & 7; wa[t] = P.norm_mix_w[l * DM + k]; wb[t] = win_[((size_t)l * DM + k) * NIN_REF + 1536 + c]; }
#pragma unroll
        for (int t = 0; t < 16; ++t) { const int i = tid + 512 * t, k = i >> 3, c = i & 7; const int j = k >> 8, ln = (k & 255) >> 2, q = k & 3;
            dtwf[((((j * 4 + q) * 2 + (c >> 2)) * 64 + ln) << 2) + (c & 3)] = wa[t] * wb[t]; }
    }
    __syncthreads();
    if (EN_HY) for (int pos = gw; pos < SEQ; pos += NGW) hyena_filter_pos(P, l, pos, lane, (bf16_t*)(ws + WS_KFILT));
    {
        LAS float* scr = (LAS float*)(lds + 32768 + wave * 8448);
        constexpr int I_A = 16 * 48, I_B = 16 * 64, I_O = 16 * 32, I_E = 16 * 32 * 16;
        constexpr int NITEMS = I_A + I_B + I_O; (void)I_E;
        bf16_t* WinT = (bf16_t*)(ws + WS_WIN); bf16_t* WoutT = (bf16_t*)(ws + WS_WOUT); bf16_t* WguT = (bf16_t*)(ws + WS_WGU); bf16_t* WdT = (bf16_t*)(ws + WS_WD);
        for (int it = gw; it < NITEMS; it += NGW) {
            int r = it;
            if (r < I_A) { const int kb = r / 48, nb = r % 48; transpose_item(P.w_in + (size_t)l * DM * NIN_REF, NIN_REF, 64 * kb, 32 * nb, WinT, 32 * nb, 1.0f, scr, lane, P.norm_mix_w + l * DM); continue; } r -= I_A;
            if (r < I_B) { const int kb = r / 64, nb = r % 64; const int drow = 1536 + 32 * nb; transpose_item(P.w_in + (size_t)l * DM * NIN_REF, NIN_REF, 64 * kb, 1544 + 32 * nb, WinT, drow, drow < PC_AK ? 0.125f * 1.4426950408889634f : 1.0f  , scr, lane, P.norm_mix_w + l * DM); continue; } r -= I_B;
            { const int kb = r / 32, nb = r % 32; transpose_item(P.w_out + (size_t)l * DM * DM, DM, 64 * kb, 32 * nb, WoutT, 32 * nb, 1.0f, scr, lane); }
            (void)WguT; (void)WdT;
        }
    }
    const float* nw = P.norm_mix_w + l * DM;
    {
        const int* slotp = (const int*)(ws + WS_SLOT); const bool comb = (l != 0) && EN_MOE;
        int sln[2] = {0, 0};
        if (comb && gw < NTOK) { sln[0] = slotp[(size_t)gw * 16 + (lane & 15)]; sln[1] = slotp[(size_t)((gw + NGW < NTOK) ? gw + NGW : gw) * 16 + (lane & 15)]; }
        for (int m = gw; m < NTOK; m += 2 * NGW) { asm volatile("" ::: "memory"); const int mm[2] = {m, (m + NGW < NTOK) ? m + NGW : m};
            const int slc[2] = {sln[0], sln[1]}; const int mn = m + 2 * NGW;
            if (comb && mn < NTOK) { sln[0] = slotp[(size_t)mn * 16 + (lane & 15)]; sln[1] = slotp[(size_t)((mn + NGW < NTOK) ? mn + NGW : mn) * 16 + (lane & 15)]; }
            pre_rows2<false>(P, l, mm, lane, (const LAS f32x4*)dtwf, nw, slc); }
    }
}
DI void phase_final(const Params& P) {
    const int tid = tid_opaque(P.wv), lane = tid & 63, wave = tid >> 6;
    const int gw = blockIdx.x * 8 + wave, NGW = gridDim.x * 8;
    {
        const int* slotp = (const int*)(P.ws + WS_SLOT); const bool comb = EN_MOE;
        int sln[2] = {0, 0};
        if (comb && gw < NTOK) { sln[0] = slotp[(size_t)gw * 16 + (lane & 15)]; sln[1] = slotp[(size_t)((gw + NGW < NTOK) ? gw + NGW : gw) * 16 + (lane & 15)]; }
        for (int m = gw; m < NTOK; m += 2 * NGW) { const int mm[2] = {m, (m + NGW < NTOK) ? m + NGW : m};
            const int slc[2] = {sln[0], sln[1]}; const int mn = m + 2 * NGW;
            if (comb && mn < NTOK) { sln[0] = slotp[(size_t)mn * 16 + (lane & 15)]; sln[1] = slotp[(size_t)((mn + NGW < NTOK) ? mn + NGW : mn) * 16 + (lane & 15)]; }
            pre_rows2<true>(P, 1, mm, lane, nullptr, P.final_w, slc); }
    }
}

struct AddrPlain { static constexpr bool LOADS = false; int K; int nb_rows;
    DI unsigned arow(const pg8::Unit& u, int r) const { return (unsigned)(u.pm * 256 + r) * (unsigned)(K * 2); }
    DI size_t boff(const pg8::Unit& u) const { return (size_t)u.pn * 256 * K * 2; } };
DI int moe_panel(int r) { return (r & 31) * 16 + (r >> 5); }
struct AddrGateUp { static constexpr bool LOADS = true; const int* seli;
    DI unsigned arow(const pg8::Unit& u, int r) const { const int b = u.pm & 31; const int t = seli[moe_panel(u.pm) * 256 + r]; return (unsigned)(b * SEQ + t) * (unsigned)(DM * 2); }
    DI unsigned short arow_tok(const pg8::Unit& u, int r) const { return (unsigned short)seli[moe_panel(u.pm) * 256 + r]; }
    DI unsigned arow_lds(const LAS unsigned char* tab, int k, const pg8::Unit& u, int r) const { const int b = u.pm & 31; const int t = ((const LAS unsigned short*)tab)[k * 256 + r]; return (unsigned)(b * SEQ + t) * (unsigned)(DM * 2); }
    DI size_t boff(const pg8::Unit& u) const { return ((size_t)(u.pm >> 5) * 2048 + (size_t)u.pn * 256) * DM * 2; } };
struct AddrGateUp8 { static constexpr bool LOADS = true; static constexpr int SC_W = 0x79797979, SC_X = 0x7f7f7f7f; const int* seli;
    DI unsigned arow(const pg8::Unit& u, int r) const { const int b = u.pm & 31; const int t = seli[moe_panel(u.pm) * 256 + r]; return (unsigned)(b * SEQ + t) * (unsigned)DM; }
    DI unsigned short arow_tok(const pg8::Unit& u, int r) const { return (unsigned short)seli[moe_panel(u.pm) * 256 + r]; }
    DI unsigned arow_lds(const LAS unsigned char* tab, int k, const pg8::Unit& u, int r) const { const int b = u.pm & 31; const int t = ((const LAS unsigned short*)tab)[k * 256 + r]; return (unsigned)(b * SEQ + t) * (unsigned)DM; }
    DI size_t boff(const pg8::Unit& u) const { return ((size_t)(u.pm >> 5) * 2048 + (size_t)u.pn * 256) * DM; } };
struct AddrDown8 { static constexpr bool LOADS = false; static constexpr int SC_W = 0x79797979, SC_X = 0x7c7c7c7c;
    DI unsigned arow(const pg8::Unit& u, int r) const { return (unsigned)(moe_panel(u.pm) * 256 + r) * (unsigned)DM; }
    DI size_t boff(const pg8::Unit& u) const { return ((size_t)(u.pm >> 5) * 1024 + (size_t)u.pn * 256) * DM; } };
struct AddrDown { static constexpr bool LOADS = false;
    DI unsigned arow(const pg8::Unit& u, int r) const { return (unsigned)(moe_panel(u.pm) * 256 + r) * (unsigned)(DM * 2); }
    DI size_t boff(const pg8::Unit& u) const { return ((size_t)(u.pm >> 5) * 1024 + (size_t)u.pn * 256) * DM * 2; } };

struct EpiProj { static constexpr int PID = 1; static constexpr bool PERM = true, ROWTAB = true; bf16_t* O; const float* rsm;
    DI float rowscale(const pg8::Unit& u, int r) const { return rsm[u.pm * 256 + r]; }
    DI void operator()(const f32x4 (&acc)[2][2][4][2], const pg8::Unit& u, int wr, int wc, int fr, int fq, const LAS float* rtab) const {
        const int row0 = u.pm * 256 + wr * 64 + fr, col0 = u.pn * 256 + wc * 32 + 8 * fq;
#pragma unroll
        for (int ai = 0; ai < 2; ++ai)
#pragma unroll
            for (int m = 0; m < 4; ++m) { bf16_t* rowp = O + (size_t)(row0 + ai * 128 + m * 16) * NPROJ + col0; const float g = rtab[wr * 64 + fr + ai * 128 + m * 16];
#pragma unroll
                for (int bj = 0; bj < 2; ++bj) { const f32x4 v0 = acc[ai][bj][m][0] * g, v1 = acc[ai][bj][m][1] * g;
                    u32x4 w; w.x = pk2(v0[0], v0[1]); w.y = pk2(v0[2], v0[3]); w.z = pk2(v1[0], v1[1]); w.w = pk2(v1[2], v1[3]);
                    *(u32x4*)(rowp + bj * 128) = w; } }
    } };
struct EpiRes { static constexpr int PID = 5; static constexpr bool PERM = true, ROWTAB = false; const float* base32; const bf16_t* base16; bf16_t* out;
    DI void operator()(const f32x4 (&acc)[2][2][4][2], const pg8::Unit& u, int wr, int wc, int fr, int fq, const LAS float* rtab) const {
        const int row0 = u.pm * 256 + wr * 64 + fr, col0 = u.pn * 256 + wc * 32 + 8 * fq;
        u32x4 bs[2][4][2];
#pragma unroll
        for (int ai = 0; ai < 2; ++ai)
#pragma unroll
            for (int m = 0; m < 4; ++m)
#pragma unroll
                for (int bj = 0; bj < 2; ++bj) bs[ai][m][bj] = *(const u32x4*)(base16 + (size_t)(row0 + ai * 128 + m * 16) * DM + col0 + bj * 128);
        asm volatile("" ::: "memory");
#pragma unroll
        for (int ai = 0; ai < 2; ++ai)
#pragma unroll
            for (int m = 0; m < 4; ++m) { const size_t off = (size_t)(row0 + ai * 128 + m * 16) * DM + col0;
#pragma unroll
                for (int bj = 0; bj < 2; ++bj) { const u32x4 b4 = bs[ai][m][bj];
                    const f32x4 v0 = acc[ai][bj][m][0] + (f32x4){bflo(b4.x), bfhi(b4.x), bflo(b4.y), bfhi(b4.y)}, v1 = acc[ai][bj][m][1] + (f32x4){bflo(b4.z), bfhi(b4.z), bflo(b4.w), bfhi(b4.w)};
                    u32x4 w; w.x = pk2(v0[0], v0[1]); w.y = pk2(v0[2], v0[3]); w.z = pk2(v1[0], v1[1]); w.w = pk2(v1[2], v1[3]);
                    *(u32x4*)(out + off + bj * 128) = w; } }
    } };
struct EpiGateUp { static constexpr int PID = 18; static constexpr bool PERM = true, ROWTAB = true; bf16_t* H; const float* selr;
    DI float rowscale(const pg8::Unit& u, int r) const { return selr[moe_panel(u.pm) * 256 + r]; }
    DI void operator()(const f32x4 (&acc)[2][2][4][2], const pg8::Unit& u, int wr, int wc, int fr, int fq, const LAS float* rtab) const {
        const int row0 = moe_panel(u.pm) * 256 + wr * 64 + fr, col0 = u.pn * 128 + wc * 32 + 8 * fq;
#pragma unroll
        for (int ai = 0; ai < 2; ++ai)
#pragma unroll
            for (int m = 0; m < 4; ++m) { bf16_t* rowp = H + (size_t)(row0 + ai * 128 + m * 16) * DM + col0; const float rr = rtab[wr * 64 + fr + ai * 128 + m * 16];
                float hv[8];
#pragma unroll
                for (int n = 0; n < 2; ++n)
#pragma unroll
                    for (int j = 0; j < 4; ++j) { const float g = acc[ai][0][m][n][j] * rr, up = acc[ai][1][m][n][j] * rr; hv[n * 4 + j] = silu_f(g) * up; }
                u32x4 w; w.x = pk2(hv[0], hv[1]); w.y = pk2(hv[2], hv[3]); w.z = pk2(hv[4], hv[5]); w.w = pk2(hv[6], hv[7]);
                *(u32x4*)rowp = w; }
    } };
struct EpiGateUp8 { static constexpr int PID = 8; static constexpr bool PERM = true, ROWTAB = true; unsigned char* H; const float* selr;
    DI float rowscale(const pg8::Unit& u, int r) const { return selr[moe_panel(u.pm) * 256 + r]; }
    DI void operator()(const f32x4 (&acc)[2][2][4][2], const pg8::Unit& u, int wr, int wc, int fr, int fq, const LAS float* rtab) const {
        const int row0 = moe_panel(u.pm) * 256 + wr * 64 + fr, col0 = u.pn * 128 + wc * 32 + 8 * fq;
#pragma unroll
        for (int ai = 0; ai < 2; ++ai)
#pragma unroll
            for (int m = 0; m < 4; ++m) { unsigned char* rowp = H + (size_t)(row0 + ai * 128 + m * 16) * DM + col0; const float rr = rtab[wr * 64 + fr + ai * 128 + m * 16]; const float c1 = -1.4426950408889634f * rr, k2 = 8.0f * rr * rr;
                float hv[8];
#pragma unroll
                for (int n = 0; n < 2; ++n)
#pragma unroll
                    for (int j = 0; j < 4; ++j) { const float g = acc[ai][0][m][n][j], up = acc[ai][1][m][n][j];
                        hv[n * 4 + j] = (g * up) * (k2 * __builtin_amdgcn_rcpf(1.0f + __builtin_amdgcn_exp2f(g * c1))); }
                *(u32x2*)rowp = (u32x2){pk4_fp8(hv[0], hv[1], hv[2], hv[3]), pk4_fp8(hv[4], hv[5], hv[6], hv[7])}; }
    } };
struct EpiDown { static constexpr int PID = 9; static constexpr bool PERM = true, ROWTAB = true; unsigned char* Y; const float* gate;
    DI float rowscale(const pg8::Unit& u, int r) const { return gate[moe_panel(u.pm) * 256 + r]; }
    DI void operator()(const f32x4 (&acc)[2][2][4][2], const pg8::Unit& u, int wr, int wc, int fr, int fq, const LAS float* rtab) const {
        const int row0 = moe_panel(u.pm) * 256 + wr * 64 + fr, col0 = u.pn * 256 + wc * 32 + 8 * fq;
#pragma unroll
        for (int ai = 0; ai < 2; ++ai)
#pragma unroll
            for (int m = 0; m < 4; ++m) { const int row = row0 + ai * 128 + m * 16; const float g = rtab[wr * 64 + fr + ai * 128 + m * 16] * 64.0f; unsigned char* rowp = Y + (size_t)row * DM + col0;
#pragma unroll
                for (int bj = 0; bj < 2; ++bj) { const f32x4 v0 = acc[ai][bj][m][0] * g, v1 = acc[ai][bj][m][1] * g;
                    *(u32x2*)(rowp + bj * 128) = (u32x2){pk4_fp8(v0[0], v0[1], v0[2], v0[3]), pk4_fp8(v1[0], v1[1], v1[2], v1[3])}; } }
    } };

DI void phase_premix(const Params& P, int l, LAS unsigned char* lds) {
    const int tid = tid_opaque(P.wv), lane = tid & 63, wave = tid >> 6;
    const int gw = blockIdx.x * 8 + wave, NGW = gridDim.x * 8;
    unsigned char* ws = P.ws;
    const bf16_t* proj = (const bf16_t*)(ws + WS_PROJ);
    unsigned char* dsc = (unsigned char*)P.out;
    if (EN_HY) {
        bf16_t* HW = (bf16_t*)(dsc + DO_HW); bf16_t* HX0 = (bf16_t*)(dsc + DO_HX0);
        const float* cw = P.hy_conv_w + (size_t)l * 3 * 768;
        LAS unsigned char* tl = lds + wave * 15616;
        const int rsub = lane >> 3, cch = lane & 7;
        const int i16 = lane & 15, trq = i16 >> 2, trp = i16 & 3, g16 = lane >> 4;
        const unsigned troff = (unsigned)(trq * 144 + (16 * g16 + 4 * trp) * 2);
        u32x4 rin[5][3];
#define HYPM_LOAD(IT) do { const int ct_ = (IT) & 3, tt_ = ((IT) >> 2) & 63, b_ = (IT) >> 8; const int t0_ = tt_ * 32; \
            const bf16_t* pr_ = proj + ((size_t)b_ * SEQ) * NPROJ + ct_ * 64 + 8 * cch; \
            _Pragma("unroll") for (int i = 0; i < 5; ++i) { const int rr = rsub + 8 * i; const int t = t0_ - 1 + rr; const bool ok = (rr < 34) && (t >= 0) && (t < SEQ); \
                const bf16_t* q = pr_ + (size_t)(ok ? t : 0) * NPROJ; \
                _Pragma("unroll") for (int a = 0; a < 3; ++a) { rin[i][a] = *(const u32x4*)(q + 256 * a); if (!ok) rin[i][a] = (u32x4){0u, 0u, 0u, 0u}; } } } while (0)
        if (gw < NB * 64 * 4) HYPM_LOAD(gw);
        for (int it = gw; it < NB * 64 * 4; it += NGW) {
            const int ct = it & 3, tt = (it >> 2) & 63, b = it >> 8;
            const int c = ct * 64 + lane, t0 = tt * 32;
#pragma unroll
            for (int i = 0; i < 5; ++i) { const int rr = rsub + 8 * i;
#pragma unroll
                for (int a = 0; a < 3; ++a) if (rr < 36) *(LAS u32x4*)(tl + a * 5184 + rr * 144 + 16 * cch) = rin[i][a]; }
            float w0[3], w1[3], w2[3];
#pragma unroll
            for (int j = 0; j < 3; ++j) { w0[j] = cw[j * 768 + c]; w1[j] = cw[j * 768 + 256 + c]; w2[j] = cw[j * 768 + 512 + c]; }
            if (it + NGW < NB * 64 * 4) HYPM_LOAD(it + NGW);
            LDS_WAIT();
            float p0[4], p1[4], p2[4];
            unsigned hwv[16], hxv[16];
#pragma unroll
            for (int j = 0; j < 9; ++j) {
                const s16x4 r0 = __builtin_amdgcn_ds_read_tr16_b64_v4i16((LAS s16x4*)(tl + 0 * 5184 + troff + (4 * j) * 144));
                const s16x4 r1 = __builtin_amdgcn_ds_read_tr16_b64_v4i16((LAS s16x4*)(tl + 1 * 5184 + troff + (4 * j) * 144));
                const s16x4 r2 = __builtin_amdgcn_ds_read_tr16_b64_v4i16((LAS s16x4*)(tl + 2 * 5184 + troff + (4 * j) * 144));
                float c0[4], c1[4], c2[4];
#pragma unroll
                for (int k = 0; k < 4; ++k) { c0[k] = bf2f((unsigned short)r0[k]); c1[k] = bf2f((unsigned short)r1[k]); c2[k] = bf2f((unsigned short)r2[k]); }
                if (j > 0) {
                    float u0[4], hv[4];
#pragma unroll
                    for (int k = 0; k < 4; ++k) { const float a0 = p0[k], a1 = p1[k], a2 = p2[k];
                        const float b0 = (k < 3) ? p0[k + 1] : c0[0], b1 = (k < 3) ? p1[k + 1] : c1[0], b2 = (k < 3) ? p2[k + 1] : c2[0];
                        const float d0 = (k < 2) ? p0[k + 2] : c0[k - 2], d1 = (k < 2) ? p1[k + 2] : c1[k - 2], d2 = (k < 2) ? p2[k + 2] : c2[k - 2];
                        u0[k] = w0[0] * a0 + w0[1] * b0 + w0[2] * d0;
                        hv[k] = (w2[0] * a2 + w2[1] * b2 + w2[2] * d2) * (w1[0] * a1 + w1[1] * b1 + w1[2] * d1); }
                    hwv[2 * (j - 1)] = pk2(hv[0], hv[1]); hwv[2 * (j - 1) + 1] = pk2(hv[2], hv[3]); hxv[2 * (j - 1)] = pk2(u0[0], u0[1]); hxv[2 * (j - 1) + 1] = pk2(u0[2], u0[3]);
                }
#pragma unroll
                for (int k = 0; k < 4; ++k) { p0[k] = c0[k]; p1[k] = c1[k]; p2[k] = c2[k]; }
            }
            bf16_t* hwp = HW + ((size_t)c * NB + b) * SEQ + t0; bf16_t* hxp = HX0 + ((size_t)c * NB + b) * SEQ + t0;
#pragma unroll
            for (int k = 0; k < 4; ++k) { *(u32x4*)(hwp + 8 * k) = (u32x4){hwv[4 * k], hwv[4 * k + 1], hwv[4 * k + 2], hwv[4 * k + 3]}; *(u32x4*)(hxp + 8 * k) = (u32x4){hxv[4 * k], hxv[4 * k + 1], hxv[4 * k + 2], hxv[4 * k + 3]}; }
            LDS_WAIT();
        }
    }
    if (EN_MA) {
        bf16_t* MX = (bf16_t*)(dsc + DO_MXBC);
        const float* cw = P.m_conv_w + (size_t)l * 5 * 512; const float* cb = P.m_conv_b + (size_t)l * 512;
        const int gt = blockIdx.x * 512 + tid, NGT = gridDim.x * 512;
        u32x4 rn[8];
#define MCV_LOAD(IT) do { const int ch_ = ((IT) & 63) * 8, m0_ = ((IT) >> 6) * 4, t0_ = m0_ & (SEQ - 1); \
            _Pragma("unroll") for (int j = 0; j < 8; ++j) { const int tt = t0_ + j - 2; const bool ok = (tt >= 0) && (tt < SEQ); \
                rn[j] = *(const u32x4*)(proj + (size_t)(ok ? m0_ + j - 2 : m0_) * NPROJ + PC_MX + ch_); if (!ok) rn[j] = (u32x4){0u, 0u, 0u, 0u}; } } while (0)
        if (gt < (NTOK / 4) * 64) MCV_LOAD(gt);
        for (int it = gt; it < (NTOK / 4) * 64; it += NGT) {
            const int ch = (it & 63) * 8, m0 = (it >> 6) * 4;
            u32x4 rw[8];
#pragma unroll
            for (int j = 0; j < 8; ++j) rw[j] = rn[j];
            f32x4 wa[5], wb[5];
#pragma unroll
            for (int j = 0; j < 5; ++j) { wa[j] = *(const f32x4*)(cw + j * 512 + ch); wb[j] = *(const f32x4*)(cw + j * 512 + ch + 4); }
            const f32x4 ba = *(const f32x4*)(cb + ch), bb = *(const f32x4*)(cb + ch + 4);
            if (it + NGT < (NTOK / 4) * 64) MCV_LOAD(it + NGT);
#pragma unroll
            for (int k = 0; k < 4; ++k) {
                float a[8] = {ba.x, ba.y, ba.z, ba.w, bb.x, bb.y, bb.z, bb.w};
#pragma unroll
                for (int j = 0; j < 5; ++j) { const u32x4 v = rw[k + j];
                    a[0] += wa[j].x * bflo(v.x); a[1] += wa[j].y * bfhi(v.x); a[2] += wa[j].z * bflo(v.y); a[3] += wa[j].w * bfhi(v.y);
                    a[4] += wb[j].x * bflo(v.z); a[5] += wb[j].y * bfhi(v.z); a[6] += wb[j].z * bflo(v.w); a[7] += wb[j].w * bfhi(v.w); }
                u32x4 o; o.x = pk2(silu_f(a[0]), silu_f(a[1])); o.y = pk2(silu_f(a[2]), silu_f(a[3])); o.z = pk2(silu_f(a[4]), silu_f(a[5])); o.w = pk2(silu_f(a[6]), silu_f(a[7]));
                *(u32x4*)(MX + (size_t)(m0 + k) * 512 + ch) = o;
            }
        }
#undef MCV_LOAD
    }
}

DI void phase_finalize(const Params& P, int l) {
    const int tid = tid_opaque(P.wv), lane = tid & 63, wave = tid >> 6;
    const int gw = blockIdx.x * 8 + wave, NGW = gridDim.x * 8;
    unsigned char* ws = P.ws; unsigned char* dsc = (unsigned char*)P.out;
    bf16_t* MIX = (bf16_t*)(ws + WS_HN);
    {
        const bf16_t* YAT = (const bf16_t*)(dsc + DO_YAT);
        for (int it = gw; it < NB * 32 * 4; it += NGW) {
            const int ct = it & 3, tt = (it >> 2) & 31, b = it >> 7;
            const int c = ct * 64 + lane, t0 = tt * 64;
            const bf16_t* src = YAT + ((size_t)c * NB + b) * SEQ + t0;
            bf16_t* dst = MIX + ((size_t)b * SEQ + t0) * DM + c;
            u32x4 vv[8];
#pragma unroll
            for (int j = 0; j < 8; ++j) vv[j] = EN_HY ? *(const u32x4*)(src + 8 * j) : (u32x4){0u, 0u, 0u, 0u};
            asm volatile("" ::: "memory");
#pragma unroll
            for (int j = 0; j < 8; ++j) { const unsigned w[4] = {vv[j].x, vv[j].y, vv[j].z, vv[j].w};
#pragma unroll
                for (int i = 0; i < 8; ++i) dst[(size_t)(8 * j + i) * DM] = (bf16_t)((i & 1) ? (w[i >> 1] >> 16) : (w[i >> 1] & 0xffffu)); }
        }
    }
    {
        const bf16_t* MYF = (const bf16_t*)(dsc + DO_MY); const bf16_t* MYB = (const bf16_t*)(ws + WS_MYB); const bf16_t* MX = (const bf16_t*)(dsc + DO_MXBC);
        const bf16_t* OB = (const bf16_t*)(ws + WS_OB); const bf16_t* proj = (const bf16_t*)(ws + WS_PROJ);
        const float* nwm = P.m_norm_w + l * 256; const float* nwh = P.hg_norm_w + l * 64;
        const int gt = blockIdx.x * 512 + tid, NGT = gridDim.x * 512;
        for (int it = gt; it < NTOK * 32; it += NGT) {
            const int ch = (it & 31) * 8, m = it >> 5;
            const u32x4 yf = *(const u32x4*)(MYF + (size_t)m * 256 + ch), yb = *(const u32x4*)(MYB + (size_t)m * 256 + ch), xv = *(const u32x4*)(MX + (size_t)m * 512 + ch), zv = *(const u32x4*)(proj + (size_t)m * NPROJ + PC_MZ + ch);
            const u32x4 of = *(const u32x4*)(MIX + (size_t)m * DM + 768 + ch), ob = *(const u32x4*)(OB + (size_t)m * 256 + ch), gv = *(const u32x4*)(proj + (size_t)m * NPROJ + PC_HG + ch);
            u32x4 o = {0u, 0u, 0u, 0u};
            if (EN_MA) {
                const float Dk = P.m_D[l * 4 + (ch >> 6)];
                const unsigned yfw[4] = {yf.x, yf.y, yf.z, yf.w}, ybw[4] = {yb.x, yb.y, yb.z, yb.w}, xw[4] = {xv.x, xv.y, xv.z, xv.w}, zw[4] = {zv.x, zv.y, zv.z, zv.w};
                float y[8]; float sq = 0.f;
#pragma unroll
                for (int j = 0; j < 4; ++j) { y[2 * j] = (bflo(yfw[j]) + bflo(ybw[j]) + Dk * bflo(xw[j])) * silu_f(bflo(zw[j])); y[2 * j + 1] = (bfhi(yfw[j]) + bfhi(ybw[j]) + Dk * bfhi(xw[j])) * silu_f(bfhi(zw[j]));
                    sq += y[2 * j] * y[2 * j] + y[2 * j + 1] * y[2 * j + 1]; }
                sq = x16_sum(row_sum16(sq));
                const float r = __builtin_amdgcn_rsqf(sq * (1.0f / 256.0f) + EPSN);
                const f32x4 wa = *(const f32x4*)(nwm + ch), wb = *(const f32x4*)(nwm + ch + 4);
                o.x = pk2(y[0] * r * wa.x, y[1] * r * wa.y); o.y = pk2(y[2] * r * wa.z, y[3] * r * wa.w); o.z = pk2(y[4] * r * wb.x, y[5] * r * wb.y); o.w = pk2(y[6] * r * wb.z, y[7] * r * wb.w);
            }
            *(u32x4*)(MIX + (size_t)m * DM + 256 + ch) = o;
            if (EN_HG) {
                const unsigned ofw[4] = {of.x, of.y, of.z, of.w}, obw[4] = {ob.x, ob.y, ob.z, ob.w}, gw4[4] = {gv.x, gv.y, gv.z, gv.w};
                float y[8]; float sq = 0.f;
#pragma unroll
                for (int j = 0; j < 4; ++j) { y[2 * j] = bflo(ofw[j]) + bflo(obw[j]); y[2 * j + 1] = bfhi(ofw[j]) + bfhi(obw[j]); sq += y[2 * j] * y[2 * j] + y[2 * j + 1] * y[2 * j + 1]; }
                sq = grp_sum8(sq);
                const float r = __builtin_amdgcn_rsqf(sq * (1.0f / 64.0f) + EPSN);
                const f32x4 wa = *(const f32x4*)(nwh + (ch & 63)), wb = *(const f32x4*)(nwh + (ch & 63) + 4);
                u32x4 oh;
                oh.x = pk2(y[0] * r * wa.x * silu_f(bflo(gw4[0])), y[1] * r * wa.y * silu_f(bfhi(gw4[0]))); oh.y = pk2(y[2] * r * wa.z * silu_f(bflo(gw4[1])), y[3] * r * wa.w * silu_f(bfhi(gw4[1])));
                oh.z = pk2(y[4] * r * wb.x * silu_f(bflo(gw4[2])), y[5] * r * wb.y * silu_f(bfhi(gw4[2]))); oh.w = pk2(y[6] * r * wb.z * silu_f(bflo(gw4[3])), y[7] * r * wb.w * silu_f(bfhi(gw4[3])));
                *(u32x4*)(MIX + (size_t)m * DM + 768 + ch) = oh;
            }
        }
    }
#if !EN_AT || !EN_HG
    {
        const int gt = blockIdx.x * 512 + tid, NGT = gridDim.x * 512;
        for (int it = gt; it < NTOK * 32; it += NGT) { const int ch = (it & 31) * 8, m = it >> 5;
            if (!EN_AT) *(u32x4*)(MIX + (size_t)m * DM + 512 + ch) = (u32x4){0u, 0u, 0u, 0u};
            if (!EN_HG) *(u32x4*)(MIX + (size_t)m * DM + 768 + ch) = (u32x4){0u, 0u, 0u, 0u}; }
    }
#endif
}

DI void phase_ffnpre(const Params& P, int l, LAS unsigned char* lds) {
    const int tid = tid_opaque(P.wv), lane = tid & 63, wave = tid >> 6, r = lane & 15, q = lane >> 4;
    const int gw = blockIdx.x * 8 + wave, NGW = gridDim.x * 8;
    unsigned char* ws = P.ws;
    LAS u32x4* Wh = (LAS u32x4*)lds;
    LAS u32x4* Wl = Wh + 32 * 64;
    for (int i = tid; i < 32 * 64; i += 512) { const int s = i >> 6, ln = i & 63, e = ln & 15, qq = ln >> 4; float wv[8]; unsigned hi[4], lo[4];
#pragma unroll
        for (int j = 0; j < 8; ++j) { const int k = 32 * s + 8 * qq + j; wv[j] = P.norm_ffn_w[l * DM + k] * P.router_w[((size_t)l * DM + k) * 16 + e]; }
#pragma unroll
        for (int j = 0; j < 4; ++j) { hi[j] = pk2(wv[2 * j], wv[2 * j + 1]); lo[j] = pk2(wv[2 * j] - bflo(hi[j]), wv[2 * j + 1] - bfhi(hi[j])); }
        Wh[i] = (u32x4){hi[0], hi[1], hi[2], hi[3]}; Wl[i] = (u32x4){lo[0], lo[1], lo[2], lo[3]}; }
    __syncthreads();
    const bf16_t* XB = (const bf16_t*)(ws + WS_XB); const float* nw = P.norm_ffn_w + l * DM + 8 * q;
    float* aff = (float*)(ws + WS_AFF); float* rs = (float*)(ws + WS_RS);
    bf16_t* XN = (bf16_t*)(ws + WS_HN);
    for (int grp = gw; grp < NTOK / 16; grp += NGW) {
        const int m0 = grp * 16;
        const bf16_t* xrow = XB + (size_t)(m0 + r) * DM + 8 * q; bf16_t* orow = XN + (size_t)(m0 + r) * DM + 8 * q; unsigned char* orow8 = (unsigned char*)XN + (size_t)(m0 + r) * DM + 8 * q; (void)orow; (void)orow8;
        f32x4 acc = {0.f, 0.f, 0.f, 0.f}; float ss = 0.f;
        u32x4 xa[8], xb[8];
#pragma unroll
        for (int j = 0; j < 8; ++j) xa[j] = *(const u32x4*)(xrow + 32 * j);
#pragma unroll
        for (int blk = 0; blk < 4; ++blk) {
            if (blk < 3) {
#pragma unroll
                for (int j = 0; j < 8; ++j) xb[j] = *(const u32x4*)(xrow + 32 * (8 * (blk + 1) + j)); }
            asm volatile("" ::: "memory");
#pragma unroll
            for (int j = 0; j < 8; ++j) { const int s = 8 * blk + j; const u32x4 xv = xa[j];
                const f32x4 a = {bflo(xv.x), bfhi(xv.x), bflo(xv.y), bfhi(xv.y)}, b = {bflo(xv.z), bfhi(xv.z), bflo(xv.w), bfhi(xv.w)};
                ss += (a.x * a.x + a.y * a.y) + (a.z * a.z + a.w * a.w) + (b.x * b.x + b.y * b.y) + (b.z * b.z + b.w * b.w);
                const bf16x8 ah = __builtin_bit_cast(bf16x8, xv);
                const bf16x8 wh = __builtin_bit_cast(bf16x8, Wh[s * 64 + lane]), wl = __builtin_bit_cast(bf16x8, Wl[s * 64 + lane]);
                acc = __builtin_amdgcn_mfma_f32_16x16x32_bf16(ah, wh, acc, 0, 0, 0);
                acc = __builtin_amdgcn_mfma_f32_16x16x32_bf16(ah, wl, acc, 0, 0, 0);
#if MOE_F8
                *(u32x2*)(orow8 + 32 * s) = (u32x2){pk4_fp8(a.x, a.y, a.z, a.w), pk4_fp8(b.x, b.y, b.z, b.w)};
#else
                *(u32x4*)(orow + 32 * s) = xv;
#endif
            }
            asm volatile("" ::: "memory");
#pragma unroll
            for (int j = 0; j < 8; ++j) xa[j] = xb[j];
        }
        ss = xhalf_sum(x16_sum(ss));
        const float rinv = __builtin_amdgcn_rsqf(ss * (1.0f / DM) + EPSN);
        if (q == 0) rs[m0 + r] = rinv;
#pragma unroll
        for (int i = 0; i < 4; ++i) {
            const float lg = acc[i] * __shfl(rinv, 4 * q + i);
            const float mx = grp_max16(lg);
            const float ex = expf(lg - mx); const float se = row_sum16(ex);
            const int m = m0 + 4 * q + i;
            aff[((size_t)(m >> 11) * 16 + r) * SEQ + (m & (SEQ - 1))] = ex / se;
        }
    }
}

DI int wave_sum_i(int v) {
#pragma unroll
    for (int o = 1; o < 64; o <<= 1) v += __shfl_xor(v, o);
    return v;
}
DI int half_excl_scan(int c, int lane, int hw, LAS int* ws4, int* tot) {
    int inc = c;
#pragma unroll
    for (int o = 1; o < 64; o <<= 1) { const int t = __shfl_up(inc, o); if (lane >= o) inc += t; }
    if (lane == 63) ws4[hw] = inc;
    __syncthreads();
    int base = 0, total = 0;
#pragma unroll
    for (int w = 0; w < 4; ++w) { const int t = ws4[w]; base += (w < hw) ? t : 0; total += t; }
    *tot = total;
    return base + inc - c;
}
DI void phase_topk(const Params& P, int l, LAS unsigned char* lds) {
    const int tid = tid_opaque(P.wv), lane = tid & 63, wave = tid >> 6;
    unsigned char* ws = P.ws;
    const float* aff = (const float*)(ws + WS_AFF); const float* rs = (const float*)(ws + WS_RS);
    int* slot = (int*)(ws + WS_SLOT); int* seli = (int*)(ws + WS_SELI); float* selg = (float*)(ws + WS_SELG); float* selr = (float*)(ws + WS_SELR);
    const int half = wave >> 2, hw = wave & 3, ht = tid & 255;
    LAS int* wsum = (LAS int*)lds + half * 64;
    for (int u0 = blockIdx.x; u0 < NB * NEXP; u0 += 2 * gridDim.x) {
        const int u = u0 + half * gridDim.x; const bool live = u < NB * NEXP; const int uu = live ? u : u0;
        const int b = uu >> 4, e = uu & 15;
        __syncthreads();
        const u32x4 ka = *(const u32x4*)(aff + (size_t)uu * SEQ + 8 * ht), kb = *(const u32x4*)(aff + (size_t)uu * SEQ + 8 * ht + 4);
        const unsigned kk[8] = {ka.x, ka.y, ka.z, ka.w, kb.x, kb.y, kb.z, kb.w};
        const f32x4 ra = *(const f32x4*)(rs + (size_t)b * SEQ + 8 * ht), rb = *(const f32x4*)(rs + (size_t)b * SEQ + 8 * ht + 4);
        const float rsv[8] = {ra.x, ra.y, ra.z, ra.w, rb.x, rb.y, rb.z, rb.w};
        unsigned prefix = 0u;
#pragma unroll 1
        for (int bit = 30; bit >= 0; bit -= (bit == 30 ? 1 : 2)) {
            const unsigned hi = 1u << bit, lo = (bit == 30) ? 0u : (1u << (bit - 1));
            const unsigned c1 = prefix | hi, c0 = prefix | lo, c3 = prefix | hi | lo;
            int n1 = 0, n0 = 0, n3 = 0;
#pragma unroll
            for (int j = 0; j < 8; ++j) { n1 += __builtin_popcountll(__ballot(kk[j] >= c1)); n0 += __builtin_popcountll(__ballot(kk[j] >= c0)); n3 += __builtin_popcountll(__ballot(kk[j] >= c3)); }
            const int par = (bit & 2) ? 12 : 0;
            if (lane == 0) { wsum[par + hw * 3] = n1; wsum[par + hw * 3 + 1] = n0; wsum[par + hw * 3 + 2] = n3; }
            __syncthreads();
            int t1 = 0, t0 = 0, t3 = 0;
#pragma unroll
            for (int q = 0; q < 4; ++q) { t1 += wsum[par + q * 3]; t0 += wsum[par + q * 3 + 1]; t3 += wsum[par + q * 3 + 2]; }
            if (bit == 30) { if (t1 >= CAP) prefix = c1; }
            else if (t1 >= CAP) prefix = (t3 >= CAP) ? c3 : c1;
            else if (t0 >= CAP) prefix = c0;
        }
        const unsigned thr = prefix;
        int cgt = 0, ceq = 0;
#pragma unroll
        for (int j = 0; j < 8; ++j) { cgt += (kk[j] > thr) ? 1 : 0; ceq += (kk[j] == thr) ? 1 : 0; }
        int ngt; (void)half_excl_scan(cgt, lane, hw, wsum + 32, &ngt);
        const int need = CAP - ngt;
        int neq; int eqr = half_excl_scan(ceq, lane, hw, wsum + 36, &neq);
        bool sel[8]; int cs = 0;
#pragma unroll
        for (int j = 0; j < 8; ++j) { const bool eq = kk[j] == thr; sel[j] = (kk[j] > thr) || (eq && eqr < need); eqr += eq ? 1 : 0; cs += sel[j] ? 1 : 0; }
        int nsel; int sb = half_excl_scan(cs, lane, hw, wsum + 40, &nsel);
        if (live) {
#pragma unroll
            for (int j = 0; j < 8; ++j) { const int i = 8 * ht + j;
                slot[((size_t)b * SEQ + i) * 16 + e] = sel[j] ? sb : -1;
                if (sel[j]) { seli[u * CAP + sb] = i; selg[u * CAP + sb] = __uint_as_float(kk[j]); selr[u * CAP + sb] = rsv[j]; ++sb; } }
        }
    }
    __syncthreads();
    {
        const int gw = blockIdx.x * 8 + wave, NGW = gridDim.x * 8;
        LAS float* scr = (LAS float*)(lds + 4096 + wave * 8448);
        bf16_t* WguT = (bf16_t*)(ws + WS_WGU); bf16_t* WdT = (bf16_t*)(ws + WS_WD);
        constexpr int I_E = 16 * 32 * 16;
        for (int it = gw; it < 3 * I_E; it += NGW) {
            const int which = it / I_E; const int r = it - which * I_E;
            const int e = r / 512, kb = (r % 512) / 32, nb = r % 32;
            const size_t wofs = ((size_t)l * NEXP + e) * DM * DM;
#if MOE_F8
            if (which == 0)      transpose_item_f8(P.moe_wg + wofs, DM, 64 * kb, 32 * nb, (unsigned char*)WguT, e * 2048 + ((32 * nb) >> 7) * 256 + ((32 * nb) & 127), 64.0f, scr, lane, P.norm_ffn_w + l * DM);
            else if (which == 1) transpose_item_f8(P.moe_wu + wofs, DM, 64 * kb, 32 * nb, (unsigned char*)WguT, e * 2048 + ((32 * nb) >> 7) * 256 + 128 + ((32 * nb) & 127), 64.0f, scr, lane, P.norm_ffn_w + l * DM);
            else                 transpose_item_f8(P.moe_wd + wofs, DM, 64 * kb, 32 * nb, (unsigned char*)WdT, e * 1024 + 32 * nb, 64.0f, scr, lane);
#else
            if (which == 0)      transpose_item(P.moe_wg + wofs, DM, 64 * kb, 32 * nb, WguT, e * 2048 + ((32 * nb) >> 7) * 256 + ((32 * nb) & 127), 1.0f, scr, lane);
            else if (which == 1) transpose_item(P.moe_wu + wofs, DM, 64 * kb, 32 * nb, WguT, e * 2048 + ((32 * nb) >> 7) * 256 + 128 + ((32 * nb) & 127), 1.0f, scr, lane);
            else                 transpose_item(P.moe_wd + wofs, DM, 64 * kb, 32 * nb, WdT, e * 1024 + 32 * nb, 1.0f, scr, lane);
#endif
        }
    }
}

DI bf16x8 mk8(unsigned a, unsigned b, unsigned c, unsigned d) { u32x4 v = {a, b, c, d}; return __builtin_bit_cast(bf16x8, v); }
DI bf16x8 cat44(u32x2 lo, u32x2 hi) { u32x4 v = {lo.x, lo.y, hi.x, hi.y}; return __builtin_bit_cast(bf16x8, v); }
DI u32x4 ldg16(const void* ub, unsigned off) { return *(const u32x4*)((const char*)ub + off); }
DI u32x2 ldg8(const void* ub, unsigned off) { return *(const u32x2*)((const char*)ub + off); }
DI void stg2(void* ub, unsigned off, unsigned short v) { *(unsigned short*)((char*)ub + off) = v; }
DI int crow(int reg, int hh) { return (reg & 3) + 8 * (reg >> 2) + 4 * hh; }
#define PACK_STEP(x, s) mk8(pk2((x)[8 * (s)], (x)[8 * (s) + 1]), pk2((x)[8 * (s) + 2], (x)[8 * (s) + 3]), pk2((x)[8 * (s) + 4], (x)[8 * (s) + 5]), pk2((x)[8 * (s) + 6], (x)[8 * (s) + 7]))

#ifndef TPROBE
#define TPROBE 0
#endif
#ifndef TPWAVE
#define TPWAVE 0
#endif
#define TP_T() ({ asm volatile("" ::: "memory"); unsigned _t = (unsigned)__builtin_amdgcn_s_memrealtime(); asm volatile("" ::: "memory"); _t; })
#define TP_B(k) unsigned _tp##k = 0; if (TPROBE == (k) || ((k) == 1 && TPROBE)) _tp##k = TP_T();
#define TP_E(k) if ((k) == 1 && TPROBE) ttot += TP_T() - _tp##k; else if (TPROBE == (k)) tacc += TP_T() - _tp##k;
#ifndef HYD
#define HYD 4
#endif
DI void hyena_unit(const Params& P, int c, LAS unsigned char* lds) {
    const int tid = tid_opaque(P.wv), lane = tid & 63, w = __builtin_amdgcn_readfirstlane(tid >> 6), r = lane & 31, hh = lane >> 5;
    constexpr int CPS = 8224;
    unsigned char* ws = P.ws; unsigned char* dsc = (unsigned char*)P.out;
    const bf16_t* kf = (const bf16_t*)(ws + WS_KFILT) + (size_t)c * 4096;
    unsigned tacc = 0, ttot = 0;
    TP_B(1)
    __syncthreads();
    TP_B(81)
    {
        const u32x4 a = *(const u32x4*)(kf + 8 * tid), b = (tid < 511) ? *(const u32x4*)(kf + 8 * tid + 8) : (u32x4){0u, 0u, 0u, 0u};
        const unsigned d[9] = {a.x, a.y, a.z, a.w, b.x, b.y, b.z, b.w, 0u};
#pragma unroll
        for (int p = 0; p < 8; ++p) { const int m = p >> 1; u32x4 o;
            if (p & 1) { o.x = __builtin_amdgcn_alignbit(d[m + 1], d[m], 16); o.y = __builtin_amdgcn_alignbit(d[m + 2], d[m + 1], 16); o.z = __builtin_amdgcn_alignbit(d[m + 3], d[m + 2], 16); o.w = __builtin_amdgcn_alignbit(d[m + 4], d[m + 3], 16); }
            else { o.x = d[m]; o.y = d[m + 1]; o.z = d[m + 2]; o.w = d[m + 3]; }
            *(LAS u32x4*)(lds + p * CPS + tid * 16) = o; }
    }
    __syncthreads();
    TP_E(81)
    const bf16_t* hw = (const bf16_t*)(dsc + DO_HW) + ((size_t)c * NB + r) * SEQ + 8 * hh;
    f32x16 acc[8];
#pragma unroll
    for (int i = 0; i < 8; ++i)
#pragma unroll
        for (int q = 0; q < 16; ++q) acc[i][q] = 0.f;
    const int p = 7 - (r & 7);
    const LAS unsigned char* abase = lds + p * CPS + (2047 - 256 * w - r + 8 * hh - p) * 2;
    LAS unsigned char* Bt = lds + 8 * CPS;
    const bf16_t* hws = (const bf16_t*)(dsc + DO_HW) + ((size_t)c * NB + (tid >> 4)) * SEQ + 4 * (tid & 15);
    const unsigned bwo = (unsigned)((tid >> 4) * 144 + (tid & 15) * 8), bro = (unsigned)(r * 144 + 16 * hh);
    TP_B(82)
    u32x2 bpre[HYD];
#pragma unroll
    for (int d = 0; d < HYD; ++d) bpre[d] = *(const u32x2*)(hws + 64 * d);
    *(LAS u32x2*)(Bt + bwo) = bpre[0];
    __syncthreads();
#pragma unroll 1
    for (int s8 = 0; s8 < SEQ; s8 += 64 * HYD) {
#pragma unroll
        for (int d = 0; d < HYD; ++d) { const int sb = s8 + 64 * d;
            if (sb + 64 < SEQ) *(LAS u32x2*)(Bt + ((d + 1) & 1) * 4608 + bwo) = bpre[(d + 1) % HYD];
            if (sb + 64 * HYD < SEQ) bpre[d] = *(const u32x2*)(hws + sb + 64 * HYD);
#pragma unroll
            for (int j = 0; j < 4; ++j) { const int s0 = sb + 16 * j; const bf16x8 bfr = *(const LAS bf16x8*)(Bt + (d & 1) * 4608 + bro + 32 * j);
#pragma unroll
                for (int i = 0; i < 8; ++i) { const bf16x8 afr = *(const LAS bf16x8*)(abase + (s0 - 32 * i) * 2); acc[i] = MFMA32(afr, bfr, acc[i]); }
                __builtin_amdgcn_sched_barrier(0); }
            __syncthreads(); }
    }
    TP_E(82)
    TP_B(83)
    const bf16_t* hx = (const bf16_t*)(dsc + DO_HX0) + ((size_t)c * NB + r) * SEQ;
    bf16_t* ya = (bf16_t*)(dsc + DO_YAT) + ((size_t)c * NB + r) * SEQ;
    u32x2 xg[8][4];
#pragma unroll
    for (int i = 0; i < 8; ++i)
#pragma unroll
        for (int g = 0; g < 4; ++g) xg[i][g] = *(const u32x2*)(hx + 256 * w + 32 * i + 8 * g + 4 * hh);
    asm volatile("" ::: "memory");
#pragma unroll
    for (int i = 0; i < 8; ++i)
#pragma unroll
        for (int g = 0; g < 4; ++g) { const int t = 256 * w + 32 * i + 8 * g + 4 * hh;
            const u32x2 xv = xg[i][g];
            u32x2 o; o.x = pk2(acc[i][4 * g] * bflo(xv.x), acc[i][4 * g + 1] * bfhi(xv.x)); o.y = pk2(acc[i][4 * g + 2] * bflo(xv.y), acc[i][4 * g + 3] * bfhi(xv.y));
            *(u32x2*)(ya + t) = o; }
    TP_E(83)
    TP_E(1)
    if (TPROBE >= 80 && TPROBE < 90 && lane == 0 && w == (TPWAVE)) { atomicAdd((unsigned*)(ws + WS_CTL) + 512, tacc); atomicAdd((unsigned*)(ws + WS_CTL) + 513, ttot); }
}

DI int t5_bucket(int rel) {
    const int ret = rel > 0 ? 16 : 0; const int n = rel < 0 ? -rel : rel;
    if (n < 8) return ret + n;
    const float nf = (float)n;
    int large = 8 + (int)(logf(nf / 8.0f) / 4.852030263919617f * 8.0f);
    large = large < 15 ? large : 15;
    return ret + large;
}
#ifndef ATT_FAST
#define ATT_FAST 0
#endif
struct AttPass { int d, rho, uq0, nq; };
DI AttPass att_pass(int pp, int Q0, int w) {
    AttPass a;
    if (pp == 0) { a.d = 1; a.rho = 0; a.uq0 = Q0 + 32 * w; a.nq = 32; }
    else if (pp == 1) { a.d = 4; a.rho = w & 3; a.uq0 = (Q0 >> 2) + 32 * (w >> 2); a.nq = 32; }
    else { a.d = 16; a.rho = 2 * w + (pp - 2); a.uq0 = Q0 >> 4; a.nq = 16; }
    return a;
}
DI void attn_unit(const Params& P, int u, LAS unsigned char* lds, int& bias_h) {
    unsigned tacc = 0, ttot = 0;
    const int qb = u & 7, h = (u >> 3) & 3, b = u >> 5;
    const int tid = tid_opaque(P.wv), lane = tid & 63, w = __builtin_amdgcn_readfirstlane(tid >> 6), c = lane & 31, hh = lane >> 5;
    LAS float* Ost = (LAS float*)lds;
    LAS float* Mst = (LAS float*)(lds + 69632);
    LAS float* Lst = Mst + 256;
    LAS float* biasT = (LAS float*)(lds + 69632 + 2048);
    LAS unsigned char* Vr = lds + 69632 + 2048 + 12800 + w * 6144;
    unsigned char* ws = P.ws;
    TP_B(1)
    { TP_B(3) __syncthreads(); TP_E(3) }
    if (bias_h != h) {
        const float* relb = P.rel_bias; asm volatile("" : "+s"(relb));
        for (int i = tid; i < 4 * 768; i += 512) { const int s = i / 768, jx = i - 768 * s; const int pat = jx >> 8, rel = (jx & 255) - 128, dd = pat == 0 ? 1 : (pat == 1 ? 4 : 16);
            biasT[s * 784 + jx + s] = (rel >= -64 && rel <= 64) ? relb[t5_bucket(rel * dd) * 4 + h] * 1.4426950408889634f : -INFINITY; }
        __syncthreads();
        bias_h = h;
    }
    const bf16_t* pb = (const bf16_t*)(ws + WS_PROJ) + (size_t)b * SEQ * NPROJ;
    bf16_t* MIX = (bf16_t*)(ws + WS_HN);
    const int Q0 = qb * 256;
    const int i16 = lane & 15, trq = i16 >> 2, trp = i16 & 3;
    const unsigned troff = (unsigned)((4 * hh + trq) * 192 + (16 * ((lane >> 4) & 1) + 4 * trp) * 2);
    const int r8 = lane >> 3, j8 = lane & 7;
#define ATT_LOAD(KF, VR, KT, AP) do { const int nsub_ = SEQ / (AP).d, tlo_ = (AP).uq0 - 64 + 32 * (KT); \
        if (ATT_FAST && tlo_ >= 0 && tlo_ + 31 < nsub_) {                   \
            const unsigned lo_ = (unsigned)(r8 * (AP).d * NPROJ + 8 * j8) * 2u; \
            _Pragma("unroll") for (int i = 0; i < 4; ++i) { const bf16_t* b_ = pb + (size_t)(((tlo_ + 8 * i) * (AP).d + (AP).rho) * NPROJ + h * 64); \
                KF[i] = __builtin_bit_cast(bf16x8, ldg16(b_ + PC_AK, lo_)); VR[i] = ldg16(b_ + PC_AV, lo_); } \
        } else { \
            _Pragma("unroll") for (int i = 0; i < 4; ++i) { const int ukr_ = tlo_ + 8 * i + r8; const int ukc_ = ukr_ < 0 ? 0 : (ukr_ >= nsub_ ? nsub_ - 1 : ukr_); \
                const unsigned ko_ = (unsigned)((ukc_ * (AP).d + (AP).rho) * NPROJ + h * 64 + 8 * j8) * 2u; \
                KF[i] = __builtin_bit_cast(bf16x8, ldg16(pb + PC_AK, ko_)); VR[i] = ldg16(pb + PC_AV, ko_); } } } while (0)
#define ATT_TILE(KF, VR, KT, NEXTLOAD) do { const int kt = (KT); \
        bf16x8 kq_[4]; \
        f32x16 st;                                                          \
        _Pragma("unroll") for (int g = 0; g < 4; ++g) { const f32x4 bv_ = *(const LAS f32x4*)(tb4 + 32 * kt + 8 * g); st[4 * g] = bv_.x; st[4 * g + 1] = bv_.y; st[4 * g + 2] = bv_.z; st[4 * g + 3] = bv_.w; } \
        _Pragma("unroll") for (int i = 0; i < 4; ++i) *(LAS bf16x8*)(Vr + (8 * i + r8) * 144 + 16 * j8) = KF[i]; \
        _Pragma("unroll") for (int ks = 0; ks < 4; ++ks) kq_[ks] = *(const LAS bf16x8*)(Vr + c * 144 + 32 * ks + 16 * hh); \
        _Pragma("unroll") for (int i = 0; i < 4; ++i) *(LAS u32x4*)(Vr + (8 * i + r8) * 192 + 16 * j8) = VR[i]; \
        _Pragma("unroll") for (int ks = 0; ks < 4; ++ks) st = MFMA32(kq_[ks], qf[ks], st); \
        NEXTLOAD; \
        float tmax = -INFINITY; float lg[16]; \
        { const int tlo = uk0 + 32 * kt; \
          if (tlo >= 0 && tlo + 31 < nsub) { \
            _Pragma("unroll") for (int q = 0; q < 16; ++q) { lg[q] = st[q]; tmax = fmaxf(tmax, lg[q]); } \
          } else { \
            _Pragma("unroll") for (int q = 0; q < 16; ++q) { const int uk = tlo + crow(q, hh); lg[q] = (uk >= 0 && uk < nsub) ? st[q] : -INFINITY; tmax = fmaxf(tmax, lg[q]); } \
          } } \
        tmax = xhalf_max(tmax); \
        if (__any(tmax > mrun + 8.0f)) { const float mnew = fmaxf(mrun, tmax), alpha = __builtin_amdgcn_exp2f(mrun - mnew); lrun *= alpha; mrun = mnew; \
            _Pragma("unroll") for (int dt = 0; dt < 2; ++dt) _Pragma("unroll") for (int q = 0; q < 16; ++q) OT[dt][q] *= alpha; } \
        float psum = 0.f; \
        _Pragma("unroll") for (int q = 0; q < 16; ++q) { lg[q] = __builtin_amdgcn_exp2f(lg[q] - mrun); psum += lg[q]; } \
        lrun += xhalf_sum(psum); \
        LDS_WAIT(); \
        _Pragma("unroll") for (int s = 0; s < 2; ++s) { const bf16x8 pf = PACK_STEP(lg, s); \
            _Pragma("unroll") for (int dt = 0; dt < 2; ++dt) { \
                const s16x4 lo = __builtin_amdgcn_ds_read_tr16_b64_v4i16((LAS s16x4*)(Vr + troff + (16 * s) * 192 + 64 * dt)); \
                const s16x4 hi = __builtin_amdgcn_ds_read_tr16_b64_v4i16((LAS s16x4*)(Vr + troff + (16 * s + 8) * 192 + 64 * dt)); \
                OT[dt] = MFMA32(__builtin_shufflevector(lo, hi, 0, 1, 2, 3, 4, 5, 6, 7), pf, OT[dt]); } } \
        LDS_WAIT(); } while (0)
    bf16x8 kfA[4], kfB[4]; u32x4 vrA[4], vrB[4];
    bf16x8 qnext[4];
    { const AttPass a0 = att_pass(0, Q0, w);
      ATT_LOAD(kfA, vrA, 0, a0); ATT_LOAD(kfB, vrB, 1, a0);
      const int qpos0 = a0.uq0 + c;
#pragma unroll
      for (int ks = 0; ks < 4; ++ks) qnext[ks] = *(const bf16x8*)(pb + (size_t)qpos0 * NPROJ + PC_AQ + h * 64 + 16 * ks + 8 * hh); }
    auto pass = [&](const int pp, bf16x8 (&kf0)[4], u32x4 (&vr0)[4], bf16x8 (&kf1)[4], u32x4 (&vr1)[4]) __attribute__((always_inline)) {
        const int pat = pp < 2 ? pp : 2;
        const AttPass ap = att_pass(pp, Q0, w), an = att_pass(pp < 3 ? pp + 1 : 3, Q0, w);
        const int d = ap.d, rho = ap.rho, uq0 = ap.uq0, nq = ap.nq;
        const int uk0 = uq0 - 64, nsub = SEQ / d;
        const int cq = (c < nq) ? c : c - nq;
        const int qpos = (uq0 + cq) * d + rho, ql = qpos - Q0;
        const LAS float* tb4 = biasT + (cq & 3) * 784 + pat * 256 + (64 - cq + 4 * hh + (cq & 3));
        bf16x8 qf[4];
#pragma unroll
        for (int ks = 0; ks < 4; ++ks) qf[ks] = qnext[ks];
        if (pp < 3) {
            const int cq2 = (c < an.nq) ? c : c - an.nq; const int qpos2 = (an.uq0 + cq2) * an.d + an.rho;
#pragma unroll
            for (int ks = 0; ks < 4; ++ks) qnext[ks] = *(const bf16x8*)(pb + (size_t)qpos2 * NPROJ + PC_AQ + h * 64 + 16 * ks + 8 * hh); }
        float mrun = -1.0e30f, lrun = 0.f; f32x16 OT[2];
#pragma unroll
        for (int dt = 0; dt < 2; ++dt)
#pragma unroll
            for (int q = 0; q < 16; ++q) OT[dt][q] = 0.f;
        if (pat != 0) { mrun = Mst[ql]; lrun = Lst[ql];
#pragma unroll
            for (int dt = 0; dt < 2; ++dt)
#pragma unroll
                for (int g = 0; g < 4; ++g) { const f32x4 v = *(const LAS f32x4*)(Ost + ql * 68 + 32 * dt + 8 * g + 4 * hh);
                    OT[dt][4 * g] = v.x; OT[dt][4 * g + 1] = v.y; OT[dt][4 * g + 2] = v.z; OT[dt][4 * g + 3] = v.w; } }
        { TP_B(2)
        ATT_TILE(kf0, vr0, 0, ATT_LOAD(kf0, vr0, 2, ap)); ATT_TILE(kf1, vr1, 1, ATT_LOAD(kf1, vr1, 3, ap)); ATT_TILE(kf0, vr0, 2, ATT_LOAD(kf0, vr0, 4, ap));
        ATT_TILE(kf1, vr1, 3, if (pp < 3) { AttPass an_ = an; asm volatile("" : "+s"(an_.d), "+s"(an_.rho), "+s"(an_.uq0)); ATT_LOAD(kf1, vr1, 0, an_); });
        ATT_TILE(kf0, vr0, 4, if (pp < 3) { AttPass an_ = an; asm volatile("" : "+s"(an_.d), "+s"(an_.rho), "+s"(an_.uq0)); ATT_LOAD(kf0, vr0, 1, an_); });
        TP_E(2) }
        if (pat != 2) {
            if (hh == 0) { Mst[ql] = mrun; Lst[ql] = lrun; }
#pragma unroll
            for (int dt = 0; dt < 2; ++dt)
#pragma unroll
                for (int g = 0; g < 4; ++g) *(LAS f32x4*)(Ost + ql * 68 + 32 * dt + 8 * g + 4 * hh) = (f32x4){OT[dt][4 * g], OT[dt][4 * g + 1], OT[dt][4 * g + 2], OT[dt][4 * g + 3]};
        } else if (c < 16) {
            const float inv = __builtin_amdgcn_rcpf(lrun);
            bf16_t* orow = MIX + ((size_t)b * SEQ + qpos) * DM + 512 + h * 64;
#pragma unroll
            for (int dt = 0; dt < 2; ++dt)
#pragma unroll
                for (int g = 0; g < 4; ++g) { u32x2 o; o.x = pk2(OT[dt][4 * g] * inv, OT[dt][4 * g + 1] * inv); o.y = pk2(OT[dt][4 * g + 2] * inv, OT[dt][4 * g + 3] * inv);
                    *(u32x2*)(orow + 32 * dt + 8 * g + 4 * hh) = o; }
        }
        { TP_B(3) if (pp < 2) __syncthreads(); TP_E(3) }
    };
#pragma unroll 1
    for (int p2 = 0; p2 < 2; ++p2) { pass(2 * p2, kfA, vrA, kfB, vrB); pass(2 * p2 + 1, kfB, vrB, kfA, vrA); }
#undef ATT_LOAD
#undef ATT_TILE
    TP_E(1)
    if (TPROBE && TPROBE < 10 && (tid & 63) == 0 && w == (TPWAVE)) { atomicAdd((unsigned*)(ws + WS_CTL) + 512, tacc); atomicAdd((unsigned*)(ws + WS_CTL) + 513, ttot); }
}

DI float softplus_f(float x) { return x > 15.f ? x : __logf(1.0f + __expf(x)); }
DI unsigned short hsel(const u32x4& v, int c) { const unsigned w = (c >> 1) == 0 ? v.x : ((c >> 1) == 1 ? v.y : ((c >> 1) == 2 ? v.z : v.w)); return (unsigned short)((c & 1) ? (w >> 16) : (w & 0xffffu)); }
DI void mamba_unit(const Params& P, int l, int u, LAS unsigned char* lds) {
    const int dir = u & 1, h = (u >> 1) & 3, b = u >> 3, g = h >> 1;
    const int tid = tid_opaque(P.wv), lane_f = tid & 63, w = __builtin_amdgcn_readfirstlane(tid >> 6);
    LAS unsigned char* wl = lds + w * 15616;
    LAS unsigned short* xdT = (LAS unsigned short*)wl;
    LAS unsigned short* xwT = xdT + 64 * 40;
    LAS unsigned short* BT = xwT + 64 * 40;
    LAS float* dtv = (LAS float*)(wl + 15360);
    LAS float* acum = dtv + 32;
    LAS float* Atot = (LAS float*)(lds + 8 * 15616);
    unsigned char* ws = P.ws; unsigned char* dsc = (unsigned char*)P.out;
    const bf16_t* xbc = (const bf16_t*)(dsc + DO_MXBC) + (size_t)b * SEQ * 512;
    const float* dtr = (const float*)(ws + WS_DT) + (size_t)b * SEQ * 8 + dir * 4 + h;
    bf16_t* MYD = (bf16_t*)(dir ? (ws + WS_MYB) : (dsc + DO_MY)) + (size_t)b * SEQ * 256 + h * 64;
    float* stsc = (float*)(dsc + DO_MST) + (size_t)u * (8 * 4096);
    const float dtb = P.m_dt_bias[l * 8 + dir * 4 + h], Aneg = -expf(P.m_A_log[l * 8 + dir * 4 + h]);
    __syncthreads();
#define MTK(c0, j) (dir ? (c0) + 31 - (j) : (c0) + (j))
#define MCH(ci) (256 * w + 32 * (dir ? 7 - (ci) : (ci)))
#pragma unroll 1
    for (int pass = 0; pass < 2; ++pass) {
        int lane_p = lane_f; asm volatile("" : "+v"(lane_p));
        const int lane = lane_p, c32 = lane_p & 31, hh = lane_p >> 5, tg = lane_p >> 3, cg = lane_p & 7;
        f32x16 ST[2][2];
#pragma unroll
        for (int a = 0; a < 2; ++a)
#pragma unroll
            for (int q = 0; q < 2; ++q)
#pragma unroll
                for (int i = 0; i < 16; ++i) ST[a][q][i] = 0.f;
        if (pass == 1) {
            const int nv = dir ? 7 - w : w;
            for (int k = 0; k < nv; ++k) { const int v = dir ? 7 - k : k; const float dec = Atot[v];
                const f32x4* sp = (const f32x4*)(stsc + (size_t)v * 4096 + lane * 64);
#pragma unroll
                for (int a = 0; a < 2; ++a)
#pragma unroll
                    for (int q = 0; q < 2; ++q)
#pragma unroll
                        for (int i4 = 0; i4 < 4; ++i4) { const f32x4 t = sp[(a * 2 + q) * 4 + i4];
                            ST[a][q][4 * i4] = ST[a][q][4 * i4] * dec + t.x; ST[a][q][4 * i4 + 1] = ST[a][q][4 * i4 + 1] * dec + t.y; ST[a][q][4 * i4 + 2] = ST[a][q][4 * i4 + 2] * dec + t.z; ST[a][q][4 * i4 + 3] = ST[a][q][4 * i4 + 3] * dec + t.w; } }
        }
        float atot = 0.f;
        u32x4 rx[4], rB[4]; float rdt;
        { const int c0 = MCH(0);
#pragma unroll
          for (int i = 0; i < 4; ++i) { const unsigned ro = (unsigned)(MTK(c0, 4 * tg + i) * 512 + 8 * cg) * 2u; rx[i] = ldg16(xbc + h * 64, ro); rB[i] = ldg16(xbc + 256 + g * 64, ro); }
          rdt = *(const float*)((const char*)dtr + (unsigned)(MTK(c0, c32) * 32)); }
#pragma unroll 1
        for (int ci = 0; ci < 8; ++ci) {
            int lane_i = lane; asm volatile("" : "+v"(lane_i));
            const int c32 = lane_i & 31, hh = lane_i >> 5, tg = lane_i >> 3, cg = lane_i & 7;
            const int c0 = MCH(ci);
            {
                const float dt = softplus_f(rdt + dtb);
                float ac = dt * Aneg;
                ac += dpp_f<0x111>(ac); ac += dpp_f<0x112>(ac); ac += dpp_f<0x114>(ac); ac += dpp_f<0x118>(ac);
                ac += __builtin_bit_cast(float, __builtin_amdgcn_update_dpp(0, __builtin_bit_cast(int, ac), 0x142, 0xA, 0xF, false));
                if (lane < 32) { dtv[c32] = dt; acum[c32] = ac; }
            }
            LDS_WAIT();
            const float aend = acum[31];
            {
                const f32x4 d4 = *(const LAS f32x4*)(dtv + 4 * tg), a4 = *(const LAS f32x4*)(acum + 4 * tg);
                const float dj[4] = {d4.x, d4.y, d4.z, d4.w};
                const float wj[4] = {__expf(aend - a4.x), __expf(aend - a4.y), __expf(aend - a4.z), __expf(aend - a4.w)};
#pragma unroll
                for (int c = 0; c < 8; ++c) {
                    float xd[4]; unsigned short bb[4];
#pragma unroll
                    for (int i = 0; i < 4; ++i) { xd[i] = bf2f(hsel(rx[i], c)) * dj[i]; bb[i] = hsel(rB[i], c); }
                    *(LAS u32x2*)(xdT + (8 * cg + c) * 40 + 4 * tg) = (u32x2){pk2(xd[0], xd[1]), pk2(xd[2], xd[3])};
                    *(LAS u32x2*)(xwT + (8 * cg + c) * 40 + 4 * tg) = (u32x2){pk2(xd[0] * wj[0], xd[1] * wj[1]), pk2(xd[2] * wj[2], xd[3] * wj[3])};
                    *(LAS u32x2*)(BT + (8 * cg + c) * 40 + 4 * tg) = (u32x2){(unsigned)bb[0] | ((unsigned)bb[1] << 16), (unsigned)bb[2] | ((unsigned)bb[3] << 16)};
                }
            }
            u32x4 gB[4], gC[4]; u32x2 cLo[2][2], cHi[2][2];
            if (pass == 1) { const unsigned bro_ = (unsigned)(MTK(c0, c32) * 512 + 8 * hh) * 2u, cro_ = (unsigned)(MTK(c0, c32) * 512 + 4 * hh) * 2u;
#pragma unroll
                for (int ks = 0; ks < 4; ++ks) { gB[ks] = ldg16(xbc + 256 + g * 64 + 16 * ks, bro_); gC[ks] = ldg16(xbc + 384 + g * 64 + 16 * ks, bro_); }
#pragma unroll
                for (int nt = 0; nt < 2; ++nt)
#pragma unroll
                    for (int s = 0; s < 2; ++s) { cLo[nt][s] = ldg8(xbc + 384 + g * 64 + 32 * nt + 16 * s, cro_); cHi[nt][s] = ldg8(xbc + 384 + g * 64 + 32 * nt + 16 * s + 8, cro_); } }
            if (ci < 7) { const int c1 = MCH(ci + 1);
#pragma unroll
                for (int i = 0; i < 4; ++i) { const unsigned ro = (unsigned)(MTK(c1, 4 * tg + i) * 512 + 8 * cg) * 2u; rx[i] = ldg16(xbc + h * 64, ro); rB[i] = ldg16(xbc + 256 + g * 64, ro); }
                rdt = *(const float*)((const char*)dtr + (unsigned)(MTK(c1, c32) * 32)); }
            LDS_WAIT();
            if (pass == 1) {
                f32x16 GT;
#pragma unroll
                for (int i = 0; i < 16; ++i) GT[i] = 0.f;
#pragma unroll
                for (int ks = 0; ks < 4; ++ks) GT = MFMA32(__builtin_bit_cast(bf16x8, gB[ks]), __builtin_bit_cast(bf16x8, gC[ks]), GT);
                const float acl = acum[c32];
#pragma unroll
                for (int i = 0; i < 16; ++i) { const int s = crow(i, hh); GT[i] = (s <= c32) ? GT[i] * __expf(acl - acum[s]) : 0.f; }
                f32x16 Y[2];
#pragma unroll
                for (int pt = 0; pt < 2; ++pt)
#pragma unroll
                    for (int i = 0; i < 16; ++i) Y[pt][i] = 0.f;
#pragma unroll
                for (int s = 0; s < 2; ++s) { const bf16x8 pa = PACK_STEP(GT, s);
#pragma unroll
                    for (int pt = 0; pt < 2; ++pt) { const LAS unsigned short* xr = xdT + (32 * pt + c32) * 40 + 16 * s + 4 * hh;
                        Y[pt] = MFMA32(pa, cat44(*(const LAS u32x2*)xr, *(const LAS u32x2*)(xr + 8)), Y[pt]); } }
                const float el = __expf(acl);
#pragma unroll
                for (int nt = 0; nt < 2; ++nt)
#pragma unroll
                    for (int s = 0; s < 2; ++s) { const u32x2 clo = cLo[nt][s], chi = cHi[nt][s];
                        const bf16x8 ca = mk8(pk2(bflo(clo.x) * el, bfhi(clo.x) * el), pk2(bflo(clo.y) * el, bfhi(clo.y) * el), pk2(bflo(chi.x) * el, bfhi(chi.x) * el), pk2(bflo(chi.y) * el, bfhi(chi.y) * el));
#pragma unroll
                        for (int pt = 0; pt < 2; ++pt) Y[pt] = MFMA32(ca, PACK_STEP(ST[nt][pt], s), Y[pt]); }
#pragma unroll
                for (int i = 0; i < 16; ++i) { const unsigned oo = (unsigned)(MTK(c0, crow(i, hh)) * 256 + c32) * 2u; stg2(MYD, oo, f2bf(Y[0][i])); stg2(MYD + 32, oo, f2bf(Y[1][i])); }
            }
            {
                const float de = __expf(aend);
#pragma unroll
                for (int nt = 0; nt < 2; ++nt)
#pragma unroll
                    for (int pt = 0; pt < 2; ++pt)
#pragma unroll
                        for (int i = 0; i < 16; ++i) ST[nt][pt][i] *= de;
#pragma unroll
                for (int s = 0; s < 2; ++s)
#pragma unroll
                    for (int nt = 0; nt < 2; ++nt) { const bf16x8 ba = *(const LAS bf16x8*)(BT + (32 * nt + c32) * 40 + 16 * s + 8 * hh);
#pragma unroll
                        for (int pt = 0; pt < 2; ++pt) ST[nt][pt] = MFMA32(ba, *(const LAS bf16x8*)(xwT + (32 * pt + c32) * 40 + 16 * s + 8 * hh), ST[nt][pt]); }
            }
            atot += aend;
            LDS_WAIT();
        }
        if (pass == 0) {
            f32x4* sp = (f32x4*)(stsc + (size_t)w * 4096 + lane * 64);
#pragma unroll
            for (int a = 0; a < 2; ++a)
#pragma unroll
                for (int q = 0; q < 2; ++q)
#pragma unroll
                    for (int i4 = 0; i4 < 4; ++i4) sp[(a * 2 + q) * 4 + i4] = (f32x4){ST[a][q][4 * i4], ST[a][q][4 * i4 + 1], ST[a][q][4 * i4 + 2], ST[a][q][4 * i4 + 3]};
            if (lane == 0) Atot[w] = __expf(atot);
            VM_WAIT(); __syncthreads();
        }
    }
#undef MTK
#undef MCH
    __syncthreads();
}

DI void hgrn_unit(const Params& P, int l, int u, LAS unsigned char* lds) {
    const int dir = u & 1, h = (u >> 1) & 3, b = u >> 3;
    const int tid = tid_opaque(P.wv), lane_f = tid & 63, w = __builtin_amdgcn_readfirstlane(tid >> 6);
    LAS unsigned char* wl = lds + w * 15104;
    LAS unsigned short* qd = (LAS unsigned short*)wl;
    LAS unsigned short* kd = qd + 32 * 72;
    LAS unsigned short* vT = kd + 32 * 72;
    LAS float* eref = (LAS float*)(wl + 14336);
    LAS float* eglr = eref + 64;
    LAS float* egl = eglr + 64;
    LAS float* lbt = (LAS float*)(lds + 8 * 15104 + 2048 + w * 512);
    LAS float* gsum = lbt + 64;
    LAS float* Atot = (LAS float*)(lds + 8 * 15104);
    unsigned char* ws = P.ws; unsigned char* dsc = (unsigned char*)P.out;
    const bf16_t* proj = (const bf16_t*)(ws + WS_PROJ) + (size_t)b * SEQ * NPROJ;
    bf16_t* OD = (dir ? (bf16_t*)(ws + WS_OB) + (size_t)b * SEQ * 256 + h * 64 : (bf16_t*)(ws + WS_HN) + (size_t)b * SEQ * DM + 768 + h * 64);
    const int ostride = dir ? 256 : DM;
    float* stsc = (float*)(dsc + DO_HST) + (size_t)u * (8 * 4096);
    __syncthreads();
    { float lb = 0.f;
      if (l == 1) { const float h0 = P.hg_lb[(0 * 2 + dir) * 256 + h * 64 + lane_f], h1 = P.hg_lb[(1 * 2 + dir) * 256 + h * 64 + lane_f]; lb = 1.0f / (1.0f + expf(h0 - h1)); }
      lbt[lane_f] = lb; }
    LDS_WAIT();
#define HTK(c0, j) (dir ? (c0) + 31 - (j) : (c0) + (j))
#define HCH(ci) (256 * w + 32 * (dir ? 7 - (ci) : (ci)))
#pragma unroll 1
    for (int pass = 0; pass < 2; ++pass) {
        int lane_p = lane_f; asm volatile("" : "+v"(lane_p));
        const int lane = lane_p, c32 = lane_p & 31, hh = lane_p >> 5, tg = lane_p >> 3, cg = lane_p & 7;
        f32x16 S[2][2];
#pragma unroll
        for (int a = 0; a < 2; ++a)
#pragma unroll
            for (int q = 0; q < 2; ++q)
#pragma unroll
                for (int i = 0; i < 16; ++i) S[a][q][i] = 0.f;
        if (pass == 1) {
            const int nv = dir ? 7 - w : w;
            for (int k = 0; k < nv; ++k) { const int v = dir ? 7 - k : k; const LAS float* at = Atot + v * 64;
                const f32x4* sp = (const f32x4*)(stsc + (size_t)v * 4096 + lane * 64);
#pragma unroll
                for (int a = 0; a < 2; ++a)
#pragma unroll
                    for (int i4 = 0; i4 < 4; ++i4) { const f32x4 dec = *(const LAS f32x4*)(at + 32 * a + 8 * i4 + 4 * hh);
#pragma unroll
                        for (int q = 0; q < 2; ++q) { const f32x4 t = sp[(a * 2 + q) * 4 + i4];
                            S[a][q][4 * i4] = S[a][q][4 * i4] * dec.x + t.x; S[a][q][4 * i4 + 1] = S[a][q][4 * i4 + 1] * dec.y + t.y; S[a][q][4 * i4 + 2] = S[a][q][4 * i4 + 2] * dec.z + t.z; S[a][q][4 * i4 + 3] = S[a][q][4 * i4 + 3] * dec.w + t.w; } } }
        }
        float gs[8];
#pragma unroll
        for (int c = 0; c < 8; ++c) gs[c] = 1.0f;
        u32x4 rf[4], rq[4];
        { const int c0 = HCH(0);
#pragma unroll
          for (int i = 0; i < 4; ++i) { const unsigned ro = (unsigned)(HTK(c0, 4 * tg + i) * NPROJ + 8 * cg) * 2u;
              rf[i] = ldg16(proj + PC_HF + dir * 256 + h * 64, ro); rq[i] = (pass == 1) ? ldg16(proj + PC_HQ + h * 64, ro) : (u32x4){0u, 0u, 0u, 0u}; } }
#pragma unroll 1
        for (int ci = 0; ci < 8; ++ci) {
            int lane_i = lane; asm volatile("" : "+v"(lane_i));
            const int c32 = lane_i & 31, hh = lane_i >> 5, tg = lane_i >> 3, cg = lane_i & 7;
            const int c0 = HCH(ci);
            {
                float qprev[4], kprev[4];
                u32x4 rv[4];
#pragma unroll
                for (int i = 0; i < 4; ++i) { const unsigned ro = (unsigned)(HTK(c0, 4 * tg + i) * NPROJ + 8 * cg) * 2u; rv[i] = ldg16(proj + PC_HI + h * 64, ro); }
                const f32x4 lb0 = *(const LAS f32x4*)(lbt + 8 * cg), lb1 = *(const LAS f32x4*)(lbt + 8 * cg + 4);
                const float lbv[8] = {lb0.x, lb0.y, lb0.z, lb0.w, lb1.x, lb1.y, lb1.z, lb1.w};
                auto gates = [&](auto p1c) __attribute__((always_inline)) { constexpr bool P1 = decltype(p1c)::value;
#pragma unroll
                for (int c = 0; c < 8; ++c) {
                    const float lb = lbv[c], oml = 1.0f - lb;
                    float en[4], cD[4], cN[4];
#pragma unroll
                    for (int i = 0; i < 4; ++i) { const float fpre = bf2f(hsel(rf[i], c)); const float e_ = fminf(__expf(-fpre), 1.0e9f); en[i] = e_;
                        const float dd = 1.0f + e_, nn = 1.0f + lb * e_; cD[i] = (i == 0) ? dd : cD[i - 1] * dd; cN[i] = (i == 0) ? nn : cN[i - 1] * nn; }
                    float iD[4], iN[4]; iD[3] = __builtin_amdgcn_rcpf(cD[3]); iN[3] = __builtin_amdgcn_rcpf(cN[3]);
#pragma unroll
                    for (int i = 3; i > 0; --i) { iD[i - 1] = iD[i] * (1.0f + en[i]); iN[i - 1] = iN[i] * (1.0f + lb * en[i]); }
                    const float own = cN[3] * iD[3];
                    float lsh = dpp_f<0x118>(own); asm volatile("" : "+v"(lsh));
                    const float lowv = (tg & 1) ? lsh : 1.0f;
                    const float rup = own * lowv;
                    float rro = dpp_f<0x128>(rup); asm volatile("" : "+v"(rro));
                    const float T = (tg & 1) ? rup : rro;
                    const auto s16 = __builtin_amdgcn_permlane16_swap(__float_as_uint(T), __float_as_uint(T), false, false);
                    const float Tp = ((lane >> 4) & 1) ? __uint_as_float(s16[0]) : __uint_as_float(s16[1]);
                    const float PT = T * Tp;
                    const auto s32 = __builtin_amdgcn_permlane32_swap(__float_as_uint(PT), __float_as_uint(PT), false, false);
                    const float pref = __uint_as_float(s32[0]), plast = pref * __uint_as_float(s32[1]);
                    const float excl = (((lane >> 4) & 1) ? Tp : 1.0f) * (((lane >> 5) & 1) ? pref : 1.0f) * ((tg & 1) ? lowv : 1.0f);
                    const float ipref = __builtin_amdgcn_rcpf(pref);
                    gs[c] *= plast;
                    if (tg == 0) { eref[8 * cg + c] = pref; eglr[8 * cg + c] = plast * ipref; egl[8 * cg + c] = plast; }
                    float kv[4], qv[4];
                    const float Kc = oml * pref * __builtin_amdgcn_rcpf(excl), Qc = excl * ipref;
#pragma unroll
                    for (int i = 0; i < 4; ++i) { kv[i] = Kc * (en[i] * ((i == 0) ? 1.0f : cD[i - 1])) * iN[i];
                        if (P1) { const float qr = bf2f(hsel(rq[i], c)); qv[i] = qr * __builtin_amdgcn_rcpf(1.0f + __expf(-qr)) * (Qc * (cN[i] * iD[i])); } else qv[i] = 0.f; }
                    if (c & 1) {
#pragma unroll
                        for (int i = 0; i < 4; ++i) { *(LAS unsigned*)(kd + (4 * tg + i) * 72 + 8 * cg + c - 1) = pk2(kprev[i], kv[i]);
                            if (P1) *(LAS unsigned*)(qd + (4 * tg + i) * 72 + 8 * cg + c - 1) = pk2(qprev[i], qv[i]); }
                    } else {
#pragma unroll
                        for (int i = 0; i < 4; ++i) { kprev[i] = kv[i]; qprev[i] = qv[i]; }
                    }
                }
                };
                if (pass == 1) gates(std::integral_constant<bool, true>()); else gates(std::integral_constant<bool, false>());
#pragma unroll
                for (int c = 0; c < 8; ++c) { unsigned short vb[4];
#pragma unroll
                    for (int i = 0; i < 4; ++i) vb[i] = hsel(rv[i], c);
                    *(LAS u32x2*)(vT + (8 * cg + c) * 40 + 4 * tg) = (u32x2){(unsigned)vb[0] | ((unsigned)vb[1] << 16), (unsigned)vb[2] | ((unsigned)vb[3] << 16)}; }
            }
            if (ci < 7) { const int c1 = HCH(ci + 1);
#pragma unroll
                for (int i = 0; i < 4; ++i) { const unsigned ro = (unsigned)(HTK(c1, 4 * tg + i) * NPROJ + 8 * cg) * 2u;
                    rf[i] = ldg16(proj + PC_HF + dir * 256 + h * 64, ro); if (pass == 1) rq[i] = ldg16(proj + PC_HQ + h * 64, ro); } }
            LDS_WAIT(); __builtin_amdgcn_sched_barrier(0);
            bf16x8 vperm[2][2];
#pragma unroll
            for (int s = 0; s < 2; ++s)
#pragma unroll
                for (int pt = 0; pt < 2; ++pt) { const LAS unsigned short* vr = vT + (32 * pt + c32) * 40 + 16 * s + 4 * hh; vperm[s][pt] = cat44(*(const LAS u32x2*)vr, *(const LAS u32x2*)(vr + 8)); }
            if (pass == 1) {
                f32x16 SC;
#pragma unroll
                for (int i = 0; i < 16; ++i) SC[i] = 0.f;
#pragma unroll
                for (int ks = 0; ks < 4; ++ks) SC = MFMA32(*(const LAS bf16x8*)(kd + c32 * 72 + 16 * ks + 8 * hh), *(const LAS bf16x8*)(qd + c32 * 72 + 16 * ks + 8 * hh), SC);
#pragma unroll
                for (int i = 0; i < 16; ++i) SC[i] = (crow(i, hh) <= c32) ? SC[i] : 0.f;
                const bf16x8 pa0 = PACK_STEP(SC, 0), pa1 = PACK_STEP(SC, 1);
                bf16x8 qa[2][2];
#pragma unroll
                for (int et = 0; et < 2; ++et)
#pragma unroll
                    for (int s = 0; s < 2; ++s) { const LAS unsigned short* qr = qd + c32 * 72 + 32 * et + 16 * s + 4 * hh; qa[et][s] = cat44(*(const LAS u32x2*)qr, *(const LAS u32x2*)(qr + 8)); }
#pragma unroll
                for (int pt = 0; pt < 2; ++pt) {
                    f32x16 O;
#pragma unroll
                    for (int i = 0; i < 16; ++i) O[i] = 0.f;
                    O = MFMA32(pa0, vperm[0][pt], O); O = MFMA32(pa1, vperm[1][pt], O);
#pragma unroll
                    for (int et = 0; et < 2; ++et)
#pragma unroll
                        for (int s = 0; s < 2; ++s) { const f32x4 e0 = *(const LAS f32x4*)(eref + 32 * et + 16 * s + 4 * hh), e1 = *(const LAS f32x4*)(eref + 32 * et + 16 * s + 8 + 4 * hh);
                            const f32x16& sv = S[et][pt];
                            const bf16x8 sb = mk8(pk2(sv[8 * s] * e0.x, sv[8 * s + 1] * e0.y), pk2(sv[8 * s + 2] * e0.z, sv[8 * s + 3] * e0.w), pk2(sv[8 * s + 4] * e1.x, sv[8 * s + 5] * e1.y), pk2(sv[8 * s + 6] * e1.z, sv[8 * s + 7] * e1.w));
                            O = MFMA32(qa[et][s], sb, O); }
#pragma unroll
                    for (int i = 0; i < 16; ++i) { const unsigned oo = (unsigned)(HTK(c0, crow(i, hh)) * ostride + c32) * 2u; stg2(OD + 32 * pt, oo, f2bf(O[i])); }
                    __builtin_amdgcn_sched_barrier(0);
                }
            }
            __builtin_amdgcn_sched_barrier(0);
            {
#pragma unroll
                for (int et = 0; et < 2; ++et) {
                    f32x16 X;
#pragma unroll
                    for (int i = 0; i < 16; ++i) X[i] = 0.f;
#pragma unroll
                    for (int s = 0; s < 2; ++s) { unsigned idw[4];
#pragma unroll
                        for (int j = 0; j < 4; ++j) { const int k0 = 16 * s + 8 * hh + 2 * j; idw[j] = (k0 == c32 ? 0x3f80u : 0u) | (k0 + 1 == c32 ? 0x3f800000u : 0u); }
                        X = MFMA32(*(const LAS bf16x8*)(kd + c32 * 72 + 32 * et + 16 * s + 8 * hh), mk8(idw[0], idw[1], idw[2], idw[3]), X); }
                    const float sc = eglr[32 * et + c32];
#pragma unroll
                    for (int i = 0; i < 16; ++i) X[i] *= sc;
                    float dg[16];
#pragma unroll
                    for (int i = 0; i < 16; ++i) dg[i] = egl[32 * et + crow(i, hh)];
#pragma unroll
                    for (int pt = 0; pt < 2; ++pt) {
#pragma unroll
                        for (int i = 0; i < 16; ++i) S[et][pt][i] *= dg[i];
#pragma unroll
                        for (int s = 0; s < 2; ++s) S[et][pt] = MFMA32(PACK_STEP(X, s), vperm[s][pt], S[et][pt]); }
                }
            }
            LDS_WAIT();
        }
        if (pass == 0) {
            f32x4* sp = (f32x4*)(stsc + (size_t)w * 4096 + lane * 64);
#pragma unroll
            for (int a = 0; a < 2; ++a)
#pragma unroll
                for (int q = 0; q < 2; ++q)
#pragma unroll
                    for (int i4 = 0; i4 < 4; ++i4) sp[(a * 2 + q) * 4 + i4] = (f32x4){S[a][q][4 * i4], S[a][q][4 * i4 + 1], S[a][q][4 * i4 + 2], S[a][q][4 * i4 + 3]};
            if (tg == 0) { *(LAS f32x4*)(Atot + w * 64 + 8 * cg) = (f32x4){gs[0], gs[1], gs[2], gs[3]}; *(LAS f32x4*)(Atot + w * 64 + 8 * cg + 4) = (f32x4){gs[4], gs[5], gs[6], gs[7]}; }
            VM_WAIT(); __syncthreads();
        }
    }
#undef HTK
#undef HCH
    __syncthreads();
}

DI void phase_mixers(const Params& P, int l, LAS unsigned char* lds, int G, int bid) {
#ifndef REP_PHASE
#define REP_PHASE -1
#endif
#define MREPS(k) _Pragma("unroll 1") for (int _r = 0; _r < ((REP_PHASE == (k)) ? 2 : 1); ++_r)
    if (EN_HY) MREPS(30) for (int c = bid; c < 256; c += G) hyena_unit(P, c, lds);
    if (EN_AT) MREPS(31) { int bias_h = -1;
        if ((G & 7) == 0) { const int xcd = bid & 7, j = bid >> 3, per = G >> 3;
            for (int base = 0; base < NB * 4 * 8; base += G) { const int u = base + xcd * per + j; if (u < NB * 4 * 8) attn_unit(P, u, lds, bias_h); } }
        else for (int u = bid; u < NB * 4 * 8; u += G) attn_unit(P, u, lds, bias_h); }
    if (EN_MA) MREPS(32) for (int u = bid; u < 256; u += G) mamba_unit(P, l, u, lds);
    if (EN_HG) MREPS(33) for (int u = bid; u < 256; u += G) hgrn_unit(P, l, u, lds);
}

constexpr int N_PHASES = 21;
#if TPROBE >= 40 && TPROBE < 50
#define PCTL , (unsigned*)(ws + WS_CTL)
#else
#define PCTL
#endif
#ifndef REP_PHASE
#define REP_PHASE -1
#endif
#define REPS(k) for (int _rep = 0, _nrep = ((REP_PHASE == (k)) && ((k) != 0 && (k) != 5 || l == 0)) ? 2 : 1; _rep < _nrep; ++_rep)
__global__ void __launch_bounds__(512, 2) fwd_kernel(Params Pin) {
    Params P = Pin; P.wv = __builtin_amdgcn_readfirstlane((int)(threadIdx.x >> 6));
    extern __shared__ __attribute__((aligned(16))) unsigned char lds_raw[];
    LAS unsigned char* lds = (LAS unsigned char*)lds_raw;
    volatile LAS unsigned* MISC = (volatile LAS unsigned*)(lds + LDS_MISC);
    if (threadIdx.x < 64) MISC[threadIdx.x] = 0u;
    __syncthreads();
    unsigned char* ws = P.ws;
    const int lo = P.ph_lo, hi = P.ph_hi;
    XcdBarrier bar; bar.bar = (unsigned*)(ws + WS_CTL) + CW_BAR; bar.x = 0; bar.st = nullptr;
    if (hi - lo > 1) bar = xcd_barrier_post((unsigned*)(ws + WS_CTL) + CW_BAR, MISC + 8);
#define IN(k) (lo <= (k) && (k) < hi)
#ifndef TPSEAM
#define TPSEAM -1
#endif
#if TPROBE == 20
#define SEAM(k) do { if (IN(k) && IN((k) + 1)) { const unsigned _t0 = TP_T(); xcd_barrier(bar); if (TPSEAM < 0 || ((k) % 10) == TPSEAM) gb_wait += TP_T() - _t0; } } while (0)
#else
#define SEAM(k) do { if (IN(k) && IN((k) + 1)) xcd_barrier(bar); } while (0)
#endif
    unsigned gb_wait = 0; const unsigned gb_t0 = TPROBE == 20 ? TP_T() : 0u;
#pragma unroll 1
    for (int l = 0; l < 2; ++l) {
        int G = gridDim.x, bid = blockIdx.x; asm volatile("" : "+s"(G), "+s"(bid));
        const int p0 = 10 * l;
        if (IN(p0 + 0)) { _Pragma("unroll 1") REPS(0) phase_pre(P, l, lds); }
        SEAM(p0 + 0);
        if (IN(p0 + 1)) { _Pragma("unroll 1") REPS(1) {
            pg8::StaticOrder S; S.init(NTOK / 256, NPROJ / 256, G, bid); AddrPlain AD{DM, 0}; EpiProj E{(bf16_t*)(ws + WS_PROJ), (const float*)(ws + WS_MSQ)};
            pg8::gemm_phase(lds, (const char*)(ws + WS_XB), (const char*)(ws + WS_WIN), DM, S, AD, E, P.wv PCTL);
        } }
        SEAM(p0 + 1);
        if (IN(p0 + 2)) { _Pragma("unroll 1") REPS(2) phase_premix(P, l, lds); }
        SEAM(p0 + 2);
        if (IN(p0 + 3)) { _Pragma("unroll 1") REPS(3) phase_mixers(P, l, lds, G, bid); }
        SEAM(p0 + 3);
        if (IN(p0 + 4)) { _Pragma("unroll 1") REPS(4) phase_finalize(P, l); }
        SEAM(p0 + 4);
        if (IN(p0 + 5)) { _Pragma("unroll 1") REPS(5) {
            pg8::StaticOrder S; S.init(NTOK / 256, DM / 256, G, bid); AddrPlain AD{DM, 0}; EpiRes E{nullptr, (const bf16_t*)(ws + WS_XB), (bf16_t*)(ws + WS_XB)};
            pg8::gemm_phase(lds, (const char*)(ws + WS_HN), (const char*)(ws + WS_WOUT), DM, S, AD, E, P.wv PCTL);
        } }
        SEAM(p0 + 5);
        if (IN(p0 + 6)) { if (EN_MOE) { _Pragma("unroll 1") REPS(6) phase_ffnpre(P, l, lds); } }
        SEAM(p0 + 6);
        if (IN(p0 + 7)) { if (EN_MOE) { _Pragma("unroll 1") REPS(7) phase_topk(P, l, lds); } }
        SEAM(p0 + 7);
        if (IN(p0 + 8)) { if (EN_MOE) _Pragma("unroll 1") REPS(8) {
            pg8::StaticOrder S; S.init(NSLOT / 256, 2048 / 256, G, bid);
#if MOE_F8
            AddrGateUp8 AD{(const int*)(ws + WS_SELI)}; EpiGateUp8 E{(unsigned char*)P.out + DO_HDN, (const float*)(ws + WS_SELR)};
            pg8::gemm_phase<EpiGateUp8, pg8::StaticOrder, AddrGateUp8, true>(lds, (const char*)(ws + WS_HN), (const char*)(ws + WS_WGU), DM, S, AD, E, P.wv PCTL);
#else
            AddrGateUp AD{(const int*)(ws + WS_SELI)}; EpiGateUp E{(bf16_t*)((unsigned char*)P.out + DO_HDN), (const float*)(ws + WS_SELR)};
            pg8::gemm_phase(lds, (const char*)(ws + WS_HN), (const char*)(ws + WS_WGU), DM, S, AD, E, P.wv PCTL);
#endif
        } }
        SEAM(p0 + 8);
        if (IN(p0 + 9)) { if (EN_MOE) _Pragma("unroll 1") REPS(9) {
            pg8::StaticOrder S; S.init(NSLOT / 256, DM / 256, G, bid);
#if MOE_F8
            EpiDown E{(unsigned char*)(ws + WS_YE), (const float*)(ws + WS_SELG)};
            AddrDown8 AD{}; pg8::gemm_phase<EpiDown, pg8::StaticOrder, AddrDown8, true>(lds, (const char*)P.out + DO_HDN, (const char*)(ws + WS_WD), DM, S, AD, E, P.wv PCTL);
#else
            EpiDown E{(unsigned char*)(ws + WS_YE), (const float*)(ws + WS_SELG)};
            AddrDown AD{}; pg8::gemm_phase(lds, (const char*)P.out + DO_HDN, (const char*)(ws + WS_WD), DM, S, AD, E, P.wv PCTL);
#endif
        } }
        SEAM(p0 + 9);
    }
#ifdef PROBE_BARS
    if (hi - lo > 1) for (int i = 0; i < PROBE_BARS; ++i) xcd_barrier(bar);
#endif
    if (IN(20)) phase_final(P);
#ifndef TPOFF
#define TPOFF 0.5f
#endif
#if TPROBE == 20
    if (tid_opaque(P.wv) == 0) { atomicAdd((unsigned*)(ws + WS_CTL) + 512, gb_wait); atomicAdd((unsigned*)(ws + WS_CTL) + 513, (TP_T() - gb_t0) / 5u); }
    xcd_barrier(bar);
#endif
#if TPROBE
    __syncthreads();
    if (blockIdx.x == 0 && tid_opaque(P.wv) == 0) {
        const float a = (float)__hip_atomic_load((unsigned*)(ws + WS_CTL) + 512, __ATOMIC_RELAXED, __HIP_MEMORY_SCOPE_AGENT), t = (float)__hip_atomic_load((unsigned*)(ws + WS_CTL) + 513, __ATOMIC_RELAXED, __HIP_MEMORY_SCOPE_AGENT);
        P.out[0] = TPROBE == 99 ? 1.0e6f : (TPROBE == 20 && TPSEAM >= 0) ? (floorf(2.0f * log2f(a / t * 200.0f) + TPOFF) * 1.0e5f) : (floorf(a / t * 20.0f + TPOFF) * 1.0e5f); }
#endif
#undef IN
#undef SEAM
}

#ifndef N_LAUNCH_MODE
#define N_LAUNCH_MODE 1
#endif
extern "C" void kernel_launch(void* const* d_in, const int* in_sizes, int n_in, void* d_out, int out_size, void* d_ws, size_t ws_size, hipStream_t stream) {
    static int grid = 0;
    if (grid == 0) {
        if (n_in != 27 || in_sizes[0] != NTOK * DM || out_size != NTOK * DM || ws_size < WS_END) {
            fprintf(stderr, "kernel_launch: unexpected shapes (n_in %d, in0 %d, out %d, ws %zu, need %zu)\n", n_in, n_in > 0 ? in_sizes[0] : -1, out_size, ws_size, (size_t)WS_END); grid = -1; return; }
        int dev = 0, cus = 0, per_cu = 0;
        if (hipGetDevice(&dev) != hipSuccess || hipDeviceGetAttribute(&cus, hipDeviceAttributeMultiprocessorCount, dev) != hipSuccess) { grid = -1; return; }
        if (hipFuncSetAttribute((const void*)fwd_kernel, hipFuncAttributeMaxDynamicSharedMemorySize, LDS_BYTES) != hipSuccess) { fprintf(stderr, "kernel_launch: hipFuncSetAttribute failed\n"); grid = -1; return; }
        if (hipOccupancyMaxActiveBlocksPerMultiprocessor(&per_cu, (const void*)fwd_kernel, 512, LDS_BYTES) != hipSuccess || per_cu < 1) { fprintf(stderr, "kernel_launch: occupancy query says %d\n", per_cu); (void)hipGetLastError(); }
        grid = cus;
    }
    if (grid < 0) return;
    if (hipMemsetAsync((char*)d_ws + WS_CTL, 0, CTL_ZERO_BYTES, stream) != hipSuccess) return;
    Params p{};
    const float** pp = (const float**)&p;
    for (int i = 0; i < 27; ++i) pp[i] = (const float*)d_in[i];
    p.out = (float*)d_out; p.ws = (unsigned char*)d_ws;
    if (N_LAUNCH_MODE == 1) { p.ph_lo = 0; p.ph_hi = N_PHASES; hipLaunchKernelGGL(fwd_kernel, dim3(grid), dim3(512), LDS_BYTES, stream, p); }
    else for (int k = 0; k < N_PHASES; ++k) { p.ph_lo = k; p.ph_hi = k + 1; hipLaunchKernelGGL(fwd_kernel, dim3(grid), dim3(512), LDS_BYTES, stream, p); }
}
```
